# Optimizing an MI355X kernel written in HIP

```python
import math
import jax, jax.numpy as jnp
from jax import lax
import numpy as np

D_MODEL = 1024
BATCH = 8
SEQ = 2048
DEPTH = 1
DEC_BATCH = 128
DEC_SEQ = 8
PAST_LEN = 16384
PAGE_SIZE = 128

M_HEADS = 4
M_V = (2 * D_MODEL) // M_HEADS
M_QK = M_V // 2
M_QK_W = M_HEADS * M_QK
M_V_W = M_HEADS * M_V
S_INNER = 2 * D_MODEL
S_HEADDIM = 64
S_HEADS = S_INNER // S_HEADDIM
S_GROUPS = 4
S_HPG = S_HEADS // S_GROUPS
S_STATE = 128
S_CONV_CH = S_INNER + 2 * S_GROUPS * S_STATE
CONV_W = 4
D_FF = 2816
CHUNK = 128
EPS = 1e-6
N_MOD = 9
SPLITS = (M_QK_W, M_QK_W, M_V_W, M_V_W, M_HEADS, M_HEADS, S_INNER, S_CONV_CH, S_HEADS, D_MODEL, D_MODEL)
IN_W = 2 * M_QK_W + 2 * M_V_W + 2 * M_HEADS + S_INNER + S_CONV_CH + S_HEADS + 2 * D_MODEL

kernel_name = 'hybrid_mlstm_ssd_macaron_adaln_step'


def _rmsnorm(x, g):
    x32 = x.astype(jnp.float32)
    y = x32 * lax.rsqrt(jnp.mean(x32 * x32, axis=-1, keepdims=True) + EPS)
    return (y * g.astype(jnp.float32)).astype(x.dtype)


def _modulate(xn, shift, scale):
    return xn * (1.0 + scale[:, None, :]) + shift[:, None, :]


def _swiglu(u, w1, w3, w2):
    return (jax.nn.silu(u @ w1) * (u @ w3)) @ w2


def _split_cols(a):
    idx = np.cumsum(np.array(SPLITS))[:-1].tolist()
    return jnp.split(a, idx, axis=-1)


def _causal_conv(x, buf, w, b):
    T = x.shape[1]
    xp = jnp.concatenate([buf, x], axis=1)
    out = xp[:, 0:T] * w[0]
    for j in range(1, CONV_W):
        out = out + xp[:, j:j + T] * w[j]
    return out + b, xp[:, -(CONV_W - 1):]


def _to_chunks(a, L):
    B, T = a.shape[0], a.shape[1]
    return jnp.moveaxis(a.reshape((B, T // L, L) + a.shape[2:]), 1, 0)


def _from_chunks(a):
    a = jnp.moveaxis(a, 0, 1)
    return a.reshape((a.shape[0], a.shape[1] * a.shape[2]) + a.shape[3:])


def _mlstm(q, k, v, i_pre, f_pre, C0, n0, m0):
    T = q.shape[1]
    L = math.gcd(T, CHUNK)
    f32 = jnp.float32
    q = q.astype(f32)
    k = k.astype(f32) * (M_QK ** -0.5)
    v = v.astype(f32)
    ig = i_pre.astype(f32)
    lf = jax.nn.log_sigmoid(f_pre.astype(f32))
    mask = jnp.tril(jnp.ones((L, L), dtype=bool))[None, :, :, None]

    def step(carry, inp):
        C, n, m = carry
        qc, kc, vc, ic, lfc = inp
        b = jnp.cumsum(lfc, axis=1)
        dmat = jnp.where(mask, b[:, :, None, :] - b[:, None, :, :] + ic[:, None, :, :], -jnp.inf)
        inter = b + m[:, None, :]
        mt = jnp.maximum(inter, jnp.max(dmat, axis=2))
        w_tok = jnp.exp(dmat - mt[:, :, None, :])
        w_st = jnp.exp(inter - mt)
        s = jnp.einsum('bthd,bshd->btsh', qc, kc) * w_tok
        num = jnp.einsum('btsh,bshv->bthv', s, vc) + w_st[..., None] * jnp.einsum('bthd,bhdv->bthv', qc, C)
        den = jnp.sum(s, axis=2) + w_st * jnp.einsum('bthd,bhd->bth', qc, n)
        h = num / jnp.maximum(jnp.abs(den), jnp.exp(-mt))[..., None]
        m_new = mt[:, -1]
        b_last = b[:, -1]
        ws = jnp.exp(b_last[:, None, :] - b + ic - m_new[:, None, :])
        decay = jnp.exp(b_last + m - m_new)
        C_new = decay[..., None, None] * C + jnp.einsum('bsh,bshd,bshv->bhdv', ws, kc, vc)
        n_new = decay[..., None] * n + jnp.einsum('bsh,bshd->bhd', ws, kc)
        return (C_new, n_new, m_new), h

    xs = (_to_chunks(q, L), _to_chunks(k, L), _to_chunks(v, L), _to_chunks(ig, L), _to_chunks(lf, L))
    (C1, n1, m1), h = lax.scan(step, (C0.astype(f32), n0.astype(f32), m0.astype(f32)), xs)
    return _from_chunks(h), C1, n1, m1


def _ssd(x, dt, A, Bm, Cm, h0):
    T = x.shape[1]
    L = math.gcd(T, CHUNK)
    mask = jnp.tril(jnp.ones((L, L), dtype=bool))[None, :, :, None, None]

    def step(h, inp):
        xc, dtc, bc, cc = inp
        cum = jnp.cumsum(dtc * A, axis=1)
        lmat = jnp.exp(jnp.where(mask, cum[:, :, None] - cum[:, None, :], -jnp.inf))
        xdt = xc * dtc[..., None]
        cb = jnp.einsum('btgn,bsgn->btsg', cc, bc)
        y = (jnp.einsum('btsg,btsge,bsgep->btgep', cb, lmat, xdt)
             + jnp.exp(cum)[..., None] * jnp.einsum('btgn,bgepn->btgep', cc, h))
        decay = jnp.exp(cum[:, -1:] - cum)
        h_new = (jnp.exp(cum[:, -1])[..., None, None] * h
                 + jnp.einsum('bsgn,bsge,bsgep->bgepn', bc, decay, xdt))
        return h_new, y

    xs = (_to_chunks(x, L), _to_chunks(dt, L), _to_chunks(Bm, L), _to_chunks(Cm, L))
    h1, y = lax.scan(step, h0, xs)
    return _from_chunks(y), h1


def _layer(x, c, st, p):
    C0, n0, m0, mconv0, ssm0, sconv0 = st
    Bsz, T, _ = x.shape
    f32 = jnp.float32
    mod = jax.nn.silu(c) @ p['ada_w'] + p['ada_b']
    sh1, sc1, g1, sh2, sc2, g2, sh3, sc3, g3 = jnp.split(mod, N_MOD, axis=-1)
    u = _modulate(_rmsnorm(x, p['norm_ff1']), sh1, sc1)
    x = x + 0.5 * g1[:, None, :] * _swiglu(u, p['ff1_w1'], p['ff1_w3'], p['ff1_w2'])
    u = _modulate(_rmsnorm(x, p['norm_mix']), sh2, sc2)
    mq, mk, mv, mo, mi, mf, z, xbc, dtp, ga, gb = _split_cols(u @ p['w_in'])
    qk, mconv1 = _causal_conv(jnp.concatenate([mq, mk], axis=-1), mconv0, p['m_conv_w'], p['m_conv_b'])
    qk = jax.nn.silu(qk)
    q = qk[..., :M_QK_W].reshape(Bsz, T, M_HEADS, M_QK)
    k = qk[..., M_QK_W:].reshape(Bsz, T, M_HEADS, M_QK)
    v = mv.reshape(Bsz, T, M_HEADS, M_V)
    i_pre = mi + p['m_if_b'][:M_HEADS]
    f_pre = mf + p['m_if_b'][M_HEADS:]
    hm, C1, n1, m1 = _mlstm(q, k, v, i_pre, f_pre, C0, n0, m0)
    mu = jnp.mean(hm, axis=-1, keepdims=True)
    var = jnp.mean(jnp.square(hm - mu), axis=-1, keepdims=True)
    hm = (hm - mu) * lax.rsqrt(var + EPS) * p['m_head_g'].astype(f32).reshape(M_HEADS, M_V)
    hm = hm * jax.nn.sigmoid(mo.astype(f32)).reshape(Bsz, T, M_HEADS, M_V)
    ya = hm.reshape(Bsz, T, M_V_W).astype(x.dtype) @ p['w_pa']
    xbc, sconv1 = _causal_conv(xbc, sconv0, p['s_conv_w'], p['s_conv_b'])
    xbc = jax.nn.silu(xbc).astype(f32)
    xs = xbc[..., :S_INNER].reshape(Bsz, T, S_GROUPS, S_HPG, S_HEADDIM)
    Bm = xbc[..., S_INNER:S_INNER + S_GROUPS * S_STATE].reshape(Bsz, T, S_GROUPS, S_STATE)
    Cm = xbc[..., S_INNER + S_GROUPS * S_STATE:].reshape(Bsz, T, S_GROUPS, S_STATE)
    dt = jax.nn.softplus((dtp + p['s_dt_bias']).astype(f32)).reshape(Bsz, T, S_GROUPS, S_HPG)
    A = -jnp.exp(p['s_A_log'].astype(f32)).reshape(S_GROUPS, S_HPG)
    h0 = ssm0.astype(f32).reshape(Bsz, S_GROUPS, S_HPG, S_HEADDIM, S_STATE)
    ys, h1 = _ssd(xs, dt, A, Bm, Cm, h0)
    ys = ys + p['s_D'].astype(f32).reshape(S_GROUPS, S_HPG)[..., None] * xs
    gated = ys.reshape(Bsz, T, S_INNER) * jax.nn.silu(z.astype(f32))
    gg = gated.reshape(Bsz, T, S_GROUPS, S_INNER // S_GROUPS)
    gg = gg * lax.rsqrt(jnp.mean(gg * gg, axis=-1, keepdims=True) + EPS)
    gated = gg.reshape(Bsz, T, S_INNER) * p['s_norm_g'].astype(f32)
    yb = gated.astype(x.dtype) @ p['w_pb']
    ssm1 = h1.reshape(Bsz, S_HEADS, S_HEADDIM, S_STATE)
    merged = jax.nn.sigmoid(ga) * ya + jax.nn.sigmoid(gb) * yb
    x = x + g2[:, None, :] * (merged @ p['w_out'])
    u = _modulate(_rmsnorm(x, p['norm_ff2']), sh3, sc3)
    x = x + 0.5 * g3[:, None, :] * _swiglu(u, p['ff2_w1'], p['ff2_w3'], p['ff2_w2'])
    return x, (C1, n1, m1, mconv1, ssm1, sconv1)


def setup_inputs(seed: int = 0) -> dict:
    key = jax.random.key(seed)
    ks = iter(jax.random.split(key, 48))
    f32 = jnp.float32

    def nrm(shape, scale):
        return jax.random.normal(next(ks), shape, f32) * scale

    def gain(shape):
        return 1.0 + nrm(shape, 0.05)

    D = D_MODEL
    dt0 = jnp.exp(jax.random.uniform(next(ks), (DEPTH, S_HEADS), f32, math.log(1e-3), math.log(1e-1)))
    f_bias = jnp.linspace(3.0, 6.0, M_HEADS, dtype=f32)[None, :] + nrm((DEPTH, M_HEADS), 0.1)
    return {
        'x_prompt': nrm((BATCH, SEQ, D), 1.0),
        'x_sample': nrm((DEC_BATCH, DEC_SEQ, D), 1.0),
        'c_prompt': nrm((BATCH, D), 1.0),
        'c_sample': nrm((DEC_BATCH, D), 1.0),
        'state_mlstm_C': nrm((DEPTH, DEC_BATCH, M_HEADS, M_QK, M_V), M_QK ** -0.5),
        'state_mlstm_n': nrm((DEPTH, DEC_BATCH, M_HEADS, M_QK), M_QK ** -0.5),
        'state_mlstm_m': nrm((DEPTH, DEC_BATCH, M_HEADS), 0.5),
        'state_mlstm_conv': nrm((DEPTH, DEC_BATCH, CONV_W - 1, 2 * M_QK_W), 1.0),
        'state_ssm': nrm((DEPTH, DEC_BATCH, S_HEADS, S_HEADDIM, S_STATE), 0.1),
        'state_ssm_conv': nrm((DEPTH, DEC_BATCH, CONV_W - 1, S_CONV_CH), 1.0),
        'ada_w': nrm((DEPTH, D, N_MOD * D), 0.5 * D ** -0.5),
        'ada_b': nrm((DEPTH, N_MOD * D), 0.02),
        'norm_ff1': gain((DEPTH, D)),
        'ff1_w1': nrm((DEPTH, D, D_FF), D ** -0.5),
        'ff1_w3': nrm((DEPTH, D, D_FF), D ** -0.5),
        'ff1_w2': nrm((DEPTH, D_FF, D), D_FF ** -0.5),
        'norm_mix': gain((DEPTH, D)),
        'w_in': nrm((DEPTH, D, IN_W), D ** -0.5),
        'm_conv_w': nrm((DEPTH, CONV_W, 2 * M_QK_W), CONV_W ** -0.5),
        'm_conv_b': nrm((DEPTH, 2 * M_QK_W), 0.02),
        'm_if_b': jnp.concatenate([nrm((DEPTH, M_HEADS), 0.1), f_bias], axis=-1),
        'm_head_g': gain((DEPTH, M_V_W)),
        'w_pa': nrm((DEPTH, M_V_W, D), M_V_W ** -0.5),
        's_conv_w': nrm((DEPTH, CONV_W, S_CONV_CH), CONV_W ** -0.5),
        's_conv_b': nrm((DEPTH, S_CONV_CH), 0.02),
        's_dt_bias': dt0 + jnp.log(-jnp.expm1(-dt0)),
        's_A_log': jnp.log(jax.random.uniform(next(ks), (DEPTH, S_HEADS), f32, 1.0, 16.0)),
        's_D': 1.0 + nrm((DEPTH, S_HEADS), 0.1),
        's_norm_g': gain((DEPTH, S_INNER)),
        'w_pb': nrm((DEPTH, S_INNER, D), S_INNER ** -0.5),
        'w_out': nrm((DEPTH, D, D), D ** -0.5),
        'norm_ff2': gain((DEPTH, D)),
        'ff2_w1': nrm((DEPTH, D, D_FF), D ** -0.5),
        'ff2_w3': nrm((DEPTH, D, D_FF), D ** -0.5),
        'ff2_w2': nrm((DEPTH, D_FF, D), D_FF ** -0.5),
        'final_norm': gain((D,)),
    }


def reference(x_prompt, x_sample, c_prompt, c_sample, state_mlstm_C, state_mlstm_n, state_mlstm_m,
              state_mlstm_conv, state_ssm, state_ssm_conv, ada_w, ada_b, norm_ff1, ff1_w1, ff1_w3,
              ff1_w2, norm_mix, w_in, m_conv_w, m_conv_b, m_if_b, m_head_g, w_pa, s_conv_w, s_conv_b,
              s_dt_bias, s_A_log, s_D, s_norm_g, w_pb, w_out, norm_ff2, ff2_w1, ff2_w3, ff2_w2,
              final_norm):
    f32 = jnp.float32
    Bp = x_prompt.shape[0]
    hp, hs = x_prompt, x_sample
    new_p, new_s = [], []
    for l in range(DEPTH):
        p = {'ada_w': ada_w[l], 'ada_b': ada_b[l], 'norm_ff1': norm_ff1[l], 'ff1_w1': ff1_w1[l],
             'ff1_w3': ff1_w3[l], 'ff1_w2': ff1_w2[l], 'norm_mix': norm_mix[l], 'w_in': w_in[l],
             'm_conv_w': m_conv_w[l], 'm_conv_b': m_conv_b[l], 'm_if_b': m_if_b[l],
             'm_head_g': m_head_g[l], 'w_pa': w_pa[l], 's_conv_w': s_conv_w[l],
             's_conv_b': s_conv_b[l], 's_dt_bias': s_dt_bias[l], 's_A_log': s_A_log[l],
             's_D': s_D[l], 's_norm_g': s_norm_g[l], 'w_pb': w_pb[l], 'w_out': w_out[l],
             'norm_ff2': norm_ff2[l], 'ff2_w1': ff2_w1[l], 'ff2_w3': ff2_w3[l], 'ff2_w2': ff2_w2[l]}
        st_p = (jnp.zeros((Bp, M_HEADS, M_QK, M_V), f32),
                jnp.zeros((Bp, M_HEADS, M_QK), f32),
                jnp.zeros((Bp, M_HEADS), f32),
                jnp.zeros((Bp, CONV_W - 1, 2 * M_QK_W), x_prompt.dtype),
                jnp.zeros((Bp, S_HEADS, S_HEADDIM, S_STATE), f32),
                jnp.zeros((Bp, CONV_W - 1, S_CONV_CH), x_prompt.dtype))
        st_s = (state_mlstm_C[l], state_mlstm_n[l], state_mlstm_m[l], state_mlstm_conv[l],
                state_ssm[l], state_ssm_conv[l])
        hp, sp = _layer(hp, c_prompt, st_p, p)
        hs, ss = _layer(hs, c_sample, st_s, p)
        new_p.append(sp)
        new_s.append(ss)
    y_prompt = _rmsnorm(hp, final_norm)
    y_sample = _rmsnorm(hs, final_norm)
    pC, pn, pm, pmc, pssm, psc = [jnp.stack([s[i] for s in new_p]) for i in range(6)]
    sC, sn, sm, smc, sssm, ssc = [jnp.stack([s[i] for s in new_s]) for i in range(6)]
    return (y_prompt, y_sample, pC, pn, pm, pmc, pssm, psc, sC, sn, sm, smc, sssm, ssc)
```

```cpp
#include <hip/hip_runtime.h>
#include <hip/hip_cooperative_groups.h>
#include <cstdio>
#include <cstdint>
namespace cg = cooperative_groups;

#ifndef MK_LAUNCH_PER_PHASE
#define MK_LAUNCH_PER_PHASE 0
#endif

constexpr int DM = 1024, SEQ = 2048, NBP = 8, NBS = 128, TS = 8;
constexpr int MP = NBP * SEQ, MS = NBS * TS, MT = MP + MS, NBID = NBP + NBS;
constexpr int DFF = 2816, NMOD = 9 * DM;
constexpr int ZP = 13568;
constexpr int ZQ = 0, ZK = 1024, ZV = 2048, ZO = 4096, ZZ = 6144, ZX = 8192, ZGA = 11264, ZGB = 12288, ZG = 13312;
constexpr float EPS = 1e-6f;
constexpr int NTHREADS = 512;

constexpr size_t MiB = 1u << 20;
constexpr size_t WS_CTL = 0;
constexpr size_t WS_WUP1 = 1 * MiB;
constexpr size_t WS_WDN1 = WS_WUP1 + 11 * MiB;
constexpr size_t WS_WUP2 = WS_WDN1 + 6 * MiB;
constexpr size_t WS_WDN2 = WS_WUP2 + 11 * MiB;
constexpr size_t WS_WIN = WS_WDN2 + 6 * MiB;
constexpr size_t WS_WPA = WS_WIN + 27 * MiB;
constexpr size_t WS_WPB = WS_WPA + 4 * MiB;
constexpr size_t WS_WOUT = WS_WPB + 4 * MiB;
constexpr size_t WS_MOD = WS_WOUT + 2 * MiB;
constexpr size_t WS_U = WS_MOD + 5 * MiB;
constexpr size_t WS_H = WS_U + 34 * MiB;
constexpr size_t WS_X1 = WS_H + 94 * MiB;
constexpr size_t WS_ZIN = WS_X1 + 68 * MiB;
constexpr size_t WS_GATES = WS_ZIN + 451 * MiB;
constexpr size_t WS_YS = WS_GATES + 5 * MiB;
constexpr size_t WS_DEN = WS_YS + 68 * MiB;
constexpr size_t WS_HA = WS_DEN + 1 * MiB;
constexpr size_t WS_HB = WS_HA + 68 * MiB;
constexpr size_t WS_CV = WS_HA;
constexpr size_t WS_XS = WS_CV + 170 * MiB;
constexpr size_t WS_U2 = WS_ZIN;
constexpr size_t WS_FDN1 = WS_XS + 4 * MiB;
constexpr size_t WS_FDN2 = WS_FDN1 + 6 * MiB;
constexpr size_t WS_FPA = WS_FDN2 + 6 * MiB;
constexpr size_t WS_FPB = WS_FPA + 4 * MiB;
constexpr size_t WS_FOUT = WS_FPB + 4 * MiB;
constexpr size_t WS_FG = WS_FOUT + 2 * MiB;
constexpr size_t WS_END = WS_FG + 1 * MiB;
constexpr int CW_CNT = 4096, CNT_STRIDE = 5120;
constexpr size_t WS_NUM = WS_H;
constexpr size_t WS_TMP = WS_YS;
static_assert(WS_END <= 1024 * MiB, "workspace map");

#define LAS __attribute__((address_space(3)))
typedef unsigned short bf16_t;
typedef short bf16x8 __attribute__((ext_vector_type(8)));
typedef short s16x4 __attribute__((ext_vector_type(4)));
typedef float f32x4 __attribute__((ext_vector_type(4)));
typedef float f32x2 __attribute__((ext_vector_type(2)));
typedef unsigned u32x4 __attribute__((ext_vector_type(4)));
typedef unsigned u32x2 __attribute__((ext_vector_type(2)));

typedef __bf16 bf16x2_t __attribute__((ext_vector_type(2)));
__device__ __forceinline__ unsigned cvt_pk_bf16(float lo, float hi) { const bf16x2_t v = {(__bf16)lo, (__bf16)hi}; return __builtin_bit_cast(unsigned, v); }
__device__ __forceinline__ float bf2f(unsigned short b) { return __uint_as_float(((unsigned)b) << 16); }
__device__ __forceinline__ float bflo(unsigned w) { return __uint_as_float(w << 16); }
__device__ __forceinline__ float bfhi(unsigned w) { return __uint_as_float(w & 0xffff0000u); }
__device__ __forceinline__ float fast_exp(float x) { return __builtin_amdgcn_exp2f(x * 1.4426950408889634f); }
__device__ __forceinline__ float sigmoidf_(float x) { return __builtin_amdgcn_rcpf(1.0f + fast_exp(-x)); }
__device__ __forceinline__ float siluf_(float x) { return x * sigmoidf_(x); }
__device__ __forceinline__ u32x4 pack8(const float (&v)[8], float s) {
    u32x4 w; w.x = cvt_pk_bf16(v[0] * s, v[1] * s); w.y = cvt_pk_bf16(v[2] * s, v[3] * s); w.z = cvt_pk_bf16(v[4] * s, v[5] * s); w.w = cvt_pk_bf16(v[6] * s, v[7] * s); return w;
}
__device__ __forceinline__ u32x2 pack4(const f32x4 v) { u32x2 w; w.x = cvt_pk_bf16(v[0], v[1]); w.y = cvt_pk_bf16(v[2], v[3]); return w; }
__device__ __forceinline__ void unpack8(const u32x4 v, float (&x)[8]) { x[0] = bflo(v.x); x[1] = bfhi(v.x); x[2] = bflo(v.y); x[3] = bfhi(v.y); x[4] = bflo(v.z); x[5] = bfhi(v.z); x[6] = bflo(v.w); x[7] = bfhi(v.w); }
__device__ __forceinline__ size_t fo_index(int r, int k, int K) { return ((size_t)((r >> 4) * (K >> 5) + (k >> 5))) * 512 + (size_t)((((r & 15) + 16 * ((k >> 3) & 3)) << 3) + (k & 7)); }
__device__ __forceinline__ float wave_scan_add(float v) {
    v += __builtin_bit_cast(float, __builtin_amdgcn_update_dpp(0, __builtin_bit_cast(int, v), 0x111, 0xf, 0xf, true));
    v += __builtin_bit_cast(float, __builtin_amdgcn_update_dpp(0, __builtin_bit_cast(int, v), 0x112, 0xf, 0xf, true));
    v += __builtin_bit_cast(float, __builtin_amdgcn_update_dpp(0, __builtin_bit_cast(int, v), 0x114, 0xf, 0xf, true));
    v += __builtin_bit_cast(float, __builtin_amdgcn_update_dpp(0, __builtin_bit_cast(int, v), 0x118, 0xf, 0xf, true));
    v += __builtin_bit_cast(float, __builtin_amdgcn_update_dpp(0, __builtin_bit_cast(int, v), 0x142, 0xa, 0xf, true));
    v += __builtin_bit_cast(float, __builtin_amdgcn_update_dpp(0, __builtin_bit_cast(int, v), 0x143, 0xc, 0xf, true));
    return v;
}
__device__ __forceinline__ float wave_scan_max(float v) {
    const int ninf = (int)0xff800000u;
    v = fmaxf(v, __builtin_bit_cast(float, __builtin_amdgcn_update_dpp(ninf, __builtin_bit_cast(int, v), 0x111, 0xf, 0xf, false)));
    v = fmaxf(v, __builtin_bit_cast(float, __builtin_amdgcn_update_dpp(ninf, __builtin_bit_cast(int, v), 0x112, 0xf, 0xf, false)));
    v = fmaxf(v, __builtin_bit_cast(float, __builtin_amdgcn_update_dpp(ninf, __builtin_bit_cast(int, v), 0x114, 0xf, 0xf, false)));
    v = fmaxf(v, __builtin_bit_cast(float, __builtin_amdgcn_update_dpp(ninf, __builtin_bit_cast(int, v), 0x118, 0xf, 0xf, false)));
    v = fmaxf(v, __builtin_bit_cast(float, __builtin_amdgcn_update_dpp(ninf, __builtin_bit_cast(int, v), 0x142, 0xa, 0xf, false)));
    v = fmaxf(v, __builtin_bit_cast(float, __builtin_amdgcn_update_dpp(ninf, __builtin_bit_cast(int, v), 0x143, 0xc, 0xf, false)));
    return v;
}
__device__ __forceinline__ float wave_sum(float v) { return __builtin_bit_cast(float, __builtin_amdgcn_readlane(__builtin_bit_cast(int, wave_scan_add(v)), 63)); }

struct Params {
    const float* in[36];
    float* out;
    unsigned char* ws;
    int ph_lo, ph_hi, itm, pad;
};

namespace pg8 {
constexpr int BM = 256, BK = 64, HALF = 128, HTB = HALF * BK * 2, STAGE_BYTES = 8 * HTB, NXCD = 8, WGM = 8;
__host__ __device__ __forceinline__ int lds_byte(int r, int c) { const int st = (r >> 4) * 2 + (c >> 5), rr = r & 15, cc = c & 31, ob = rr * 64 + cc * 2; return st * 1024 + (ob ^ (((ob >> 9) & 1) << 5)); }
__host__ __device__ __forceinline__ void stage_rc(int b, int& R, int& C) { const int st = b / 1024, sb = b % 1024, swz = sb ^ (((sb >> 9) & 1) << 5); R = (st >> 1) * 16 + swz / 64; C = (st & 1) * 32 + (swz % 64) / 2; }
__host__ __device__ __forceinline__ int perm32(int rho) { const int n = rho >> 4, i = rho & 15; return 8 * (i >> 2) + 4 * n + (i & 3); }

struct Unit { int pm, pn, w; };
struct Gemm { const bf16_t* A0; const bf16_t* A1; const bf16_t* B0; const bf16_t* B1; int K; };

struct OrderSample { int c;
    __device__ bool next(int i, Unit& u) const { if (i > 0 || c >= 208) return false; const int x = c & 7, j = c >> 3; u.pm = 64 + (x >> 1); u.pn = (x & 1) * 26 + j; u.w = 0; return true; } };
struct OrderPrompt { int c;
    __device__ bool next(int i, Unit& u) const { const int x = c & 7, j = c >> 3; int q; if (j < 24) { if (i >= 17) return false; q = i * 24 + j; } else { if (i >= 1) return false; q = 408 + (j - 24); }
        u.pm = 8 * x + (q & 7); u.pn = q >> 3; u.w = 0; return true; } };
struct Order {
    int nM, nN, nwg, G, c, dual;
    __device__ void init(int M, int N, int G_, int c_, int dual_) { nM = M / BM; nN = N / BM; nwg = nM * nN; G = G_; c = c_; dual = dual_; }
    __device__ void init_from(int M, int N, int G_, int c_, int first, int lim) { nM = M / BM; nN = N / BM; nwg = lim; G = G_; c = first + c_; dual = 0; }
    __device__ bool next(int i, Unit& u) const {
        const int ti = dual ? (i >> 1) : i;
        const long L = (long)ti * G + c; if (L >= nwg) return false;
        int wgid = (int)L; { const int tot = nM * nN, q = tot / NXCD, r = tot % NXCD, xcd = wgid % NXCD, off = wgid / NXCD; wgid = (xcd < r ? xcd * (q + 1) : r * (q + 1) + (xcd - r) * q) + off; }
        const int nig = WGM * nN, gid = wgid / nig, fm = gid * WGM, gsz = (nM - fm) < WGM ? (nM - fm) : WGM;
        u.pm = fm + ((wgid % nig) % gsz); u.pn = (wgid % nig) / gsz; u.w = dual ? (i & 1) : 0; return true;
    }
};

template <class Epi, bool ALIGN_EPI = true, class Ord = Order>
__device__ __forceinline__ void gemm_phase(LAS unsigned char* lds, const Gemm g, const Ord& S, const Epi E) {
    const int tid = threadIdx.x, wid = __builtin_amdgcn_readfirstlane(tid >> 6), lane = tid & 63, wr = wid >> 2, wc = wid & 3, fr = lane & 15, fq = lane >> 4;
    const int K = g.K, nt = K / BK;
    unsigned voffA[2], voffB[2];
#pragma unroll
    for (int i = 0; i < 2; ++i) { int R, C; stage_rc(tid * 16 + i * 8192, R, C); const int Rb = Epi::PERM ? ((R & ~31) + perm32(R & 31)) : R;
        voffA[i] = (unsigned)(R * K + C) * 2u; voffB[i] = (unsigned)(Rb * K + C) * 2u; }
    const size_t kstep = (size_t)(BK * 2);
    const size_t hstep = (size_t)HALF * K * 2;
    const size_t tstep = 2 * hstep;
    const unsigned ldsw = (unsigned)wid * 1024u;
    const int aoff = lds_byte(wr * 64 + fr, fq * 8), boff = lds_byte(wc * 32 + fr, fq * 8);
#define PG8_SA(b, h) (((b) * 2 + (h)) * HTB)
#define PG8_SB(b, h) ((4 + (b) * 2 + (h)) * HTB)
#define PG8_STAGE(bufoff, gbase, voff) do { _Pragma("unroll") for (int _i = 0; _i < 2; ++_i) \
        __builtin_amdgcn_global_load_lds((const unsigned*)((const char*)(gbase) + (voff)[_i]), (LAS unsigned*)(lds + (bufoff) + ldsw + _i * 8192), 16, 0, 0); } while (0)
#define PG8_LDA(dst, b, h) do { _Pragma("unroll") for (int m = 0; m < 4; ++m) _Pragma("unroll") for (int k = 0; k < 2; ++k) dst[m][k] = *(const LAS bf16x8*)(lds + PG8_SA(b, h) + aoff + m * 2048 + k * 1024); } while (0)
#define PG8_LDB(dst, b, h) do { _Pragma("unroll") for (int n = 0; n < 2; ++n) _Pragma("unroll") for (int k = 0; k < 2; ++k) dst[n][k] = *(const LAS bf16x8*)(lds + PG8_SB(b, h) + boff + n * 2048 + k * 1024); } while (0)
#define PG8_MMA(ai, bj, At, Bt) do { __builtin_amdgcn_s_setprio(1); _Pragma("unroll") for (int m = 0; m < 4; ++m) _Pragma("unroll") for (int n = 0; n < 2; ++n) _Pragma("unroll") for (int k = 0; k < 2; ++k) \
        acc[ai][bj][m][n] = __builtin_amdgcn_mfma_f32_16x16x32_bf16(Bt[n][k], At[m][k], acc[ai][bj][m][n], 0, 0, 0); __builtin_amdgcn_s_setprio(0); } while (0)
#define PG8_WAIT_V(n) asm volatile("s_waitcnt vmcnt(" #n ")" ::: "memory")
#define PG8_WAIT_L(n) asm volatile("s_waitcnt lgkmcnt(" #n ")" ::: "memory")
#define PG8_BAR __builtin_amdgcn_s_barrier()
#define PG8_SCHED __builtin_amdgcn_sched_barrier(0)
    Unit cur, nxt; int ui = 0;
    if (!S.next(0, cur)) return;
    f32x4 acc[2][2][4][2];
#pragma unroll
    for (int a = 0; a < 2; ++a)
#pragma unroll
        for (int b = 0; b < 2; ++b)
#pragma unroll
            for (int m = 0; m < 4; ++m)
#pragma unroll
                for (int n = 0; n < 2; ++n) acc[a][b][m][n] = (f32x4){0.f, 0.f, 0.f, 0.f};
    bf16x8 At[4][2], B0[2][2], B1[2][2];
    const char* cA = (const char*)(cur.w ? g.A1 : g.A0) + (size_t)cur.pm * tstep; const char* cB = (const char*)(cur.w ? g.B1 : g.B0) + (size_t)cur.pn * tstep;
    PG8_STAGE(PG8_SB(0, 0), cB, voffB); PG8_STAGE(PG8_SB(0, 1), cB + hstep, voffB); PG8_STAGE(PG8_SA(0, 0), cA, voffA); PG8_STAGE(PG8_SA(0, 1), cA + hstep, voffA);
    if (wr == 1) PG8_BAR;
    PG8_WAIT_V(2); PG8_BAR;
    PG8_STAGE(PG8_SB(1, 0), cB + kstep, voffB); PG8_STAGE(PG8_SA(1, 0), cA + kstep, voffA); PG8_STAGE(PG8_SB(1, 1), cB + hstep + kstep, voffB);
    PG8_WAIT_V(6); PG8_BAR;
    for (;;) {
        const bool has_next = S.next(ui + 1, nxt);
        const char* nA = has_next ? (const char*)(nxt.w ? g.A1 : g.A0) + (size_t)nxt.pm * tstep : cA; const char* nB = has_next ? (const char*)(nxt.w ? g.B1 : g.B0) + (size_t)nxt.pn * tstep : cB;
        for (int t = 0; t < nt; t += 2) {
            const bool last = (t == nt - 2);
            const char* a1 = cA + (size_t)(t + 1) * kstep;
            const char* a2 = last ? nA : cA + (size_t)(t + 2) * kstep; const char* b2 = last ? nB : cB + (size_t)(t + 2) * kstep;
            const char* a3 = a2 + kstep; const char* b3 = b2 + kstep;
            PG8_LDB(B0, 0, 0); PG8_LDB(B1, 0, 1); PG8_SCHED; PG8_LDA(At, 0, 0); PG8_STAGE(PG8_SA(1, 1), a1 + hstep, voffA);
            PG8_WAIT_V(8); PG8_WAIT_L(0); PG8_BAR; PG8_MMA(0, 0, At, B0); PG8_MMA(0, 1, At, B1); PG8_BAR; PG8_SCHED;
            PG8_LDA(At, 0, 1); PG8_STAGE(PG8_SB(0, 0), b2, voffB); PG8_STAGE(PG8_SB(0, 1), b2 + hstep, voffB); PG8_STAGE(PG8_SA(0, 0), a2, voffA);
            PG8_WAIT_V(8); PG8_WAIT_L(0); PG8_BAR; PG8_MMA(1, 0, At, B0); PG8_MMA(1, 1, At, B1); PG8_BAR; PG8_SCHED;
            PG8_LDB(B0, 1, 0); PG8_LDB(B1, 1, 1); PG8_SCHED; PG8_LDA(At, 1, 0); PG8_STAGE(PG8_SA(0, 1), a2 + hstep, voffA);
            PG8_WAIT_V(8); PG8_WAIT_L(0); PG8_BAR; PG8_MMA(0, 0, At, B0); PG8_MMA(0, 1, At, B1); PG8_BAR; PG8_SCHED;
            PG8_LDA(At, 1, 1); PG8_STAGE(PG8_SB(1, 0), b3, voffB); PG8_STAGE(PG8_SB(1, 1), b3 + hstep, voffB); PG8_STAGE(PG8_SA(1, 0), a3, voffA);
            PG8_WAIT_V(8); PG8_WAIT_L(0); PG8_BAR; PG8_MMA(1, 0, At, B0); PG8_MMA(1, 1, At, B1); PG8_BAR; PG8_SCHED;
        }
        if constexpr (ALIGN_EPI) { if (wr == 0) PG8_BAR; }
        if constexpr (!Epi::AFTER_DRAIN) E(acc, cur, wr, wc, fr, fq);
        if (!has_next) break;
#pragma unroll
        for (int a = 0; a < 2; ++a)
#pragma unroll
            for (int b = 0; b < 2; ++b)
#pragma unroll
                for (int m = 0; m < 4; ++m)
#pragma unroll
                    for (int n = 0; n < 2; ++n) acc[a][b][m][n] = (f32x4){0.f, 0.f, 0.f, 0.f};
        cur = nxt; cA = nA; cB = nB; ++ui;
        if constexpr (ALIGN_EPI) { if (wr == 1) PG8_BAR; }
    }
    PG8_WAIT_V(0);
    if constexpr (!ALIGN_EPI) { if (wr == 0) PG8_BAR; }
    PG8_BAR;
    if constexpr (Epi::AFTER_DRAIN) E.fused(acc, cur, wr, wc, fr, fq, lds, wid, lane);
#undef PG8_SA
#undef PG8_SB
#undef PG8_STAGE
#undef PG8_LDA
#undef PG8_LDB
#undef PG8_MMA
#undef PG8_WAIT_V
#undef PG8_WAIT_L
#undef PG8_BAR
#undef PG8_SCHED
}

__device__ __forceinline__ int bid_of_row(int row) { return row < MP ? (row >> 11) : (NBP + ((row - MP) >> 3)); }

struct EpiSwiGLU {
    static constexpr bool PERM = true, AFTER_DRAIN = false;
    bf16_t* H;
    __device__ __forceinline__ void operator()(const f32x4 (&acc)[2][2][4][2], const Unit& u, int wr, int wc, int fr, int fq) const {
        const int row0 = u.pm * BM + wr * 64 + fr, hc0 = u.pn * 128 + wc * 32 + 8 * fq;
#pragma unroll
        for (int ai = 0; ai < 2; ++ai)
#pragma unroll
            for (int m = 0; m < 4; ++m) { const f32x4 a0 = acc[ai][0][m][0], a1 = acc[ai][0][m][1], b0 = acc[ai][1][m][0], b1 = acc[ai][1][m][1];
                u32x4 w; w.x = cvt_pk_bf16(siluf_(a0[0]) * b0[0], siluf_(a0[1]) * b0[1]); w.y = cvt_pk_bf16(siluf_(a0[2]) * b0[2], siluf_(a0[3]) * b0[3]);
                w.z = cvt_pk_bf16(siluf_(a1[0]) * b1[0], siluf_(a1[1]) * b1[1]); w.w = cvt_pk_bf16(siluf_(a1[2]) * b1[2], siluf_(a1[3]) * b1[3]);
                const int row = row0 + ai * HALF + m * 16;
                if (u.pm < MP / BM) *(u32x4*)(H + (size_t)row * DFF + hc0) = w;
                else *(u32x4*)(H + (size_t)MP * DFF + fo_index(row - MP, hc0, DFF)) = w; }
    }
};
struct EpiResid {
    static constexpr bool PERM = false, AFTER_DRAIN = false;
    const float* xin_p; const float* xin_s; float* out; const float* gmod; float coef;
    __device__ __forceinline__ void operator()(const f32x4 (&acc)[2][2][4][2], const Unit& u, int wr, int wc, int fr, int fq) const {
        const int row0 = u.pm * BM + wr * 64 + fr, col0 = u.pn * BM + wc * 32 + 4 * fq;
#pragma unroll
        for (int ai = 0; ai < 2; ++ai)
#pragma unroll
            for (int m = 0; m < 4; ++m) { const int row = row0 + ai * HALF + m * 16;
                const float* xr = (row < MP ? xin_p + (size_t)row * DM : xin_s + (size_t)(row - MP) * DM) + col0;
                const float* gr = gmod + (size_t)bid_of_row(row) * NMOD + col0; float* orow = out + (size_t)row * DM + col0;
#pragma unroll
                for (int bj = 0; bj < 2; ++bj)
#pragma unroll
                    for (int n = 0; n < 2; ++n) { const int o = bj * HALF + n * 16; const f32x4 xv = *(const f32x4*)(xr + o), gv = *(const f32x4*)(gr + o);
                        *(f32x4*)(orow + o) = xv + coef * gv * acc[ai][bj][m][n]; } }
    }
};

__device__ __forceinline__ void panel_wait(unsigned* cnt, unsigned need) {
    unsigned spins = 0;
    while ((unsigned)__builtin_amdgcn_readfirstlane(__hip_atomic_load(cnt, __ATOMIC_RELAXED, __HIP_MEMORY_SCOPE_AGENT)) < need) { if (++spins > (1u << 20)) break; __builtin_amdgcn_s_sleep(2); }
    __builtin_amdgcn_fence(__ATOMIC_ACQUIRE, "agent");
}
template <bool FINAL>
struct EpiResidNorm {
    static constexpr bool PERM = false, AFTER_DRAIN = true;
    const float* xin; float* Xout; const float* gmod; const float* gw; const float* shmod; const float* scmod; bf16_t* Uout; float* Yout; float* XS; unsigned* cnt; float coef; int pad_;
    __device__ __forceinline__ void fused(f32x4 (&acc)[2][2][4][2], const Unit& u, int wr, int wc, int fr, int fq, LAS unsigned char* lds, int wid, int lane) const {
        LAS float* P = (LAS float*)lds; LAS float* S = (LAS float*)(lds + 4096);
        const float* const xin_ = xin; float* const Xout_ = Xout; const float* const gmod_ = gmod; const float coef_ = coef; const float* const gw_ = gw; const float* const shmod_ = shmod; const float* const scmod_ = scmod;
        bf16_t* const Uout_ = Uout; float* const Yout_ = Yout; float* const XS_ = XS; unsigned* const cnt_ = cnt;
        const int b = u.pm >> 3, col0 = u.pn * BM + wc * 32 + 4 * fq, rowt = wr * 64 + fr;
        { f32x4 gv[2][2];
#pragma unroll
          for (int bj = 0; bj < 2; ++bj)
#pragma unroll
              for (int n = 0; n < 2; ++n) gv[bj][n] = coef_ * *(const f32x4*)(gmod_ + (size_t)b * NMOD + col0 + bj * HALF + n * 16);
#pragma unroll
          for (int ai = 0; ai < 2; ++ai)
#pragma unroll
              for (int m = 0; m < 4; ++m) { const int rt = rowt + ai * HALF + m * 16; const float* xr = xin_ + (size_t)(u.pm * BM + rt) * DM + col0; float ss = 0.f;
#pragma unroll
                  for (int bj = 0; bj < 2; ++bj)
#pragma unroll
                      for (int n = 0; n < 2; ++n) { const f32x4 x = *(const f32x4*)(xr + bj * HALF + n * 16) + gv[bj][n] * acc[ai][bj][m][n]; acc[ai][bj][m][n] = x; ss += (x[0] * x[0] + x[1] * x[1]) + (x[2] * x[2] + x[3] * x[3]); }
                  ss += __shfl_xor(ss, 16); ss += __shfl_xor(ss, 32);
                  if (fq == 0) P[rt * 4 + wc] = ss;
                  asm volatile("" ::: "memory"); } }
        __syncthreads();
        const int r32 = wid * 32 + (lane & 31); float* slot = XS_ + (size_t)(u.pm * BM + r32) * 16;
        if (lane < 32) { const f32x4 pp = *(const LAS f32x4*)(P + r32 * 4); __hip_atomic_store(slot + u.pn, (pp[0] + pp[1]) + (pp[2] + pp[3]), __ATOMIC_RELAXED, __HIP_MEMORY_SCOPE_AGENT); }
        asm volatile("s_waitcnt vmcnt(0)" ::: "memory");
        if (lane == 0) __hip_atomic_fetch_add(cnt_ + 64 * u.pm, 1u, __ATOMIC_RELAXED, __HIP_MEMORY_SCOPE_AGENT);
        if (wid == 0) panel_wait(cnt_ + 64 * u.pm, 32u);
        asm volatile("s_waitcnt vmcnt(0) lgkmcnt(0)" ::: "memory");
        __syncthreads();
        if (lane < 32) { float tot = 0.f;
#pragma unroll
            for (int t = 0; t < 4; ++t) tot += __hip_atomic_load(slot + t, __ATOMIC_RELAXED, __HIP_MEMORY_SCOPE_AGENT);
            S[r32] = 1.0f / sqrtf(tot * (1.0f / DM) + EPS); }
        __syncthreads();
        f32x4 fac[2][2], shv[2][2];
#pragma unroll
        for (int bj = 0; bj < 2; ++bj)
#pragma unroll
            for (int n = 0; n < 2; ++n) { const int c = col0 + bj * HALF + n * 16; fac[bj][n] = *(const f32x4*)(gw_ + c);
                if constexpr (!FINAL) { fac[bj][n] = fac[bj][n] * (1.0f + *(const f32x4*)(scmod_ + (size_t)b * NMOD + c)); shv[bj][n] = *(const f32x4*)(shmod_ + (size_t)b * NMOD + c); } }
#pragma unroll
        for (int ai = 0; ai < 2; ++ai)
#pragma unroll
            for (int m = 0; m < 4; ++m) { const int rt = rowt + ai * HALF + m * 16; const size_t off = (size_t)(u.pm * BM + rt) * DM + col0; const float r = S[rt];
#pragma unroll
                for (int bj = 0; bj < 2; ++bj)
#pragma unroll
                    for (int n = 0; n < 2; ++n) { const f32x4 x = acc[ai][bj][m][n]; const int o = bj * HALF + n * 16;
                        if constexpr (FINAL) *(f32x4*)(Yout_ + off + o) = x * r * fac[bj][n];
                        else { *(f32x4*)(Xout_ + off + o) = x; *(u32x2*)(Uout_ + off + o) = pack4(x * r * fac[bj][n] + shv[bj][n]); } } }
    }
};
struct EpiZin {
    static constexpr bool PERM = true, AFTER_DRAIN = false;
    bf16_t* Z; float* gates;
    __device__ __forceinline__ void operator()(const f32x4 (&acc)[2][2][4][2], const Unit& u, int wr, int wc, int fr, int fq) const {
        const int row0 = u.pm * BM + wr * 64 + fr;
        {
            const int col0 = u.pn * BM + wc * 32 + 8 * fq;
#pragma unroll
            for (int ai = 0; ai < 2; ++ai)
#pragma unroll
                for (int m = 0; m < 4; ++m) { bf16_t* rp = Z + (size_t)(row0 + ai * HALF + m * 16) * ZP + col0;
#pragma unroll
                    for (int bj = 0; bj < 2; ++bj) { const f32x4 v0 = acc[ai][bj][m][0], v1 = acc[ai][bj][m][1];
                        u32x4 w; w.x = cvt_pk_bf16(v0[0], v0[1]); w.y = cvt_pk_bf16(v0[2], v0[3]); w.z = cvt_pk_bf16(v1[0], v1[1]); w.w = cvt_pk_bf16(v1[2], v1[3]);
                        *(u32x4*)(rp + bj * HALF) = w; } }
        }
    }
};
struct EpiMerge {
    static constexpr bool PERM = true, AFTER_DRAIN = false;
    const bf16_t* Z; float* tmp; bf16_t* U;
    __device__ __forceinline__ void operator()(const f32x4 (&acc)[2][2][4][2], const Unit& u, int wr, int wc, int fr, int fq) const {
        const int row0 = u.pm * BM + wr * 64 + fr, col0 = u.pn * BM + wc * 32 + 8 * fq;
        const int zoff = u.w ? ZGB : ZGA;
#pragma unroll
        for (int ai = 0; ai < 2; ++ai)
#pragma unroll
            for (int m = 0; m < 4; ++m) { const int row = row0 + ai * HALF + m * 16;
#pragma unroll
                for (int bj = 0; bj < 2; ++bj) { const int c = col0 + bj * HALF;
                    const u32x4 gz = *(const u32x4*)(Z + (size_t)row * ZP + zoff + c);
                    f32x4 s0, s1; s0[0] = sigmoidf_(bflo(gz.x)); s0[1] = sigmoidf_(bfhi(gz.x)); s0[2] = sigmoidf_(bflo(gz.y)); s0[3] = sigmoidf_(bfhi(gz.y));
                    s1[0] = sigmoidf_(bflo(gz.z)); s1[1] = sigmoidf_(bfhi(gz.z)); s1[2] = sigmoidf_(bflo(gz.w)); s1[3] = sigmoidf_(bfhi(gz.w));
                    f32x4 v0 = s0 * acc[ai][bj][m][0], v1 = s1 * acc[ai][bj][m][1];
                    u32x4* up = (u32x4*)(U + (size_t)row * DM + c);
                    if (u.w != 0) { const u32x4 pv = *up; v0[0] += bflo(pv.x); v0[1] += bfhi(pv.x); v0[2] += bflo(pv.y); v0[3] += bfhi(pv.y); v1[0] += bflo(pv.z); v1[1] += bfhi(pv.z); v1[2] += bflo(pv.w); v1[3] += bfhi(pv.w); }
                    u32x4 w; w.x = cvt_pk_bf16(v0[0], v0[1]); w.y = cvt_pk_bf16(v0[2], v0[3]); w.z = cvt_pk_bf16(v1[0], v1[1]); w.w = cvt_pk_bf16(v1[2], v1[3]);
                    *up = w; } }
    }
};
}


struct Frame {
    LAS unsigned char* lds;
    int tid, lane, wave, G, bx;
    float* out; unsigned char* ws;
};
constexpr int PTAB_OFF = 140288;
__device__ __forceinline__ const float* pin_ld(const Frame& F, const int k) {
    const volatile LAS unsigned* T = (const volatile LAS unsigned*)(F.lds + PTAB_OFF);
    const unsigned lo = (unsigned)__builtin_amdgcn_readfirstlane((int)T[2 * k]), hi = (unsigned)__builtin_amdgcn_readfirstlane((int)T[2 * k + 1]);
    return (const float*)(((uint64_t)hi << 32) | (uint64_t)lo);
}
#define PIN(k) pin_ld(F, (k))

template <int KTOT, bool FOA, bool FOB>
__device__ __forceinline__ void small_gemm_partials(LAS unsigned char* lds, const bf16_t* A, const bf16_t* Bt, int wave, int lane) {
    const int fr = lane & 15, fq = lane >> 4; constexpr int NKS = KTOT / 256; const int T0 = wave * NKS;
    const bf16_t* ap = A + (size_t)fr * KTOT + 8 * fq; const bf16_t* bp = Bt + (size_t)fr * KTOT + 8 * fq;
    f32x4 acc[4][4];
#pragma unroll
    for (int i = 0; i < 4; ++i)
#pragma unroll
        for (int j = 0; j < 4; ++j) acc[i][j] = (f32x4){0.f, 0.f, 0.f, 0.f};
    bf16x8 a[4][4], b[4][4];
#define SG_LOAD(slot, t) do { const int T_ = T0 + (t), ko_ = 32 * T_; _Pragma("unroll") for (int i = 0; i < 4; ++i) { \
        if constexpr (FOA) a[slot][i] = *(const bf16x8*)(A + ((size_t)(i * (KTOT / 32) + T_)) * 512 + 8 * lane); else a[slot][i] = *(const bf16x8*)(ap + (size_t)(16 * i) * KTOT + ko_); \
        if constexpr (FOB) b[slot][i] = *(const bf16x8*)(Bt + ((size_t)(i * (KTOT / 32) + T_)) * 512 + 8 * lane); else b[slot][i] = *(const bf16x8*)(bp + (size_t)(16 * i) * KTOT + ko_); } } while (0)
#pragma unroll
    for (int t = 0; t < 4 && t < NKS; ++t) SG_LOAD(t, t);
    __builtin_amdgcn_sched_barrier(0);
#pragma unroll
    for (int t = 0; t < NKS; ++t) {
#pragma unroll
        for (int tn = 0; tn < 4; ++tn)
#pragma unroll
            for (int tm = 0; tm < 4; ++tm) acc[tn][tm] = __builtin_amdgcn_mfma_f32_16x16x32_bf16(b[t & 3][tn], a[t & 3][tm], acc[tn][tm], 0, 0, 0);
        __builtin_amdgcn_sched_barrier(0);
        if (t + 4 < NKS) { SG_LOAD(t & 3, t + 4); __builtin_amdgcn_sched_barrier(0); } }
#undef SG_LOAD
    LAS f32x4* PART = (LAS f32x4*)lds;
#pragma unroll
    for (int tn = 0; tn < 4; ++tn)
#pragma unroll
        for (int tm = 0; tm < 4; ++tm) PART[(wave * 16 + tn * 4 + tm) * 64 + lane] = acc[tn][tm];
}
__device__ __forceinline__ f32x4 small_gemm_sum(LAS unsigned char* lds, int tid, int j) {
    const LAS f32x4* PART = (const LAS f32x4*)lds; const int tile = 8 * j + (tid >> 6), ln = tid & 63; f32x4 sum = PART[tile * 64 + ln];
#pragma unroll
    for (int wv = 1; wv < 8; ++wv) sum += PART[(wv * 16 + tile) * 64 + ln];
    return sum;
}
template <int KTOT>
__device__ __forceinline__ void small_phase_resid(Frame& F, const bf16_t* A, const bf16_t* Bt, const float* xin_s, float* out, const float* gmod, float coef) {
    for (int st = F.bx; st < 256; st += F.G) { const int x = st & 7, j = st >> 3, sm = 4 * (x >> 1) + (j >> 3), sn = 8 * (x & 1) + (j & 7);
        __syncthreads();
        small_gemm_partials<KTOT, true, true>(F.lds, A + (size_t)(MP + 64 * sm) * KTOT, Bt + (size_t)(64 * sn) * KTOT, F.wave, F.lane);
        __syncthreads();
#pragma unroll
        for (int j = 0; j < 2; ++j) { const f32x4 v = small_gemm_sum(F.lds, F.tid, j); const int tile = 8 * j + (F.tid >> 6), tn = tile >> 2, tm = tile & 3;
            const int ms = 64 * sm + 16 * tm + (F.lane & 15), n = 64 * sn + 16 * tn + 4 * (F.lane >> 4), row = MP + ms;
            const f32x4 xv = *(const f32x4*)(xin_s + (size_t)ms * DM + n), gv = *(const f32x4*)(gmod + (size_t)pg8::bid_of_row(row) * NMOD + n);
            *(f32x4*)(out + (size_t)row * DM + n) = xv + coef * gv * v; } }
}
template <int KTOT, bool FINAL>
__device__ __forceinline__ void small_phase_resid_norm(Frame& F, const bf16_t* A, const bf16_t* Bt, const float* xin_s, float* Xout, const float* gmod, float coef,
                                                       const float* gw, const float* shmod, const float* scmod, bf16_t* Uout, float* Yout, float* XS, unsigned* cnt) {
    LAS float* P2 = (LAS float*)(F.lds + 131072); LAS float* S2 = (LAS float*)(F.lds + 131072 + 512);
    for (int st = F.bx; st < 256; st += F.G) { const int x = st & 7, j0 = st >> 3, sm = 4 * (x >> 1) + (j0 >> 3), sn = 8 * (x & 1) + (j0 & 7);
        __syncthreads();
        small_gemm_partials<KTOT, true, true>(F.lds, A + (size_t)(MP + 64 * sm) * KTOT, Bt + (size_t)(64 * sn) * KTOT, F.wave, F.lane);
        __syncthreads();
        const int fr = F.lane & 15, fq = F.lane >> 4, tm = F.wave & 3, rl = 16 * tm + fr, ms = 64 * sm + rl, row = MP + ms, bid = NBP + (ms >> 3);
        f32x4 xn[2]; float ss = 0.f;
#pragma unroll
        for (int j = 0; j < 2; ++j) { const int n = 64 * sn + 16 * (2 * j + (F.wave >> 2)) + 4 * fq;
            const f32x4 x4 = *(const f32x4*)(xin_s + (size_t)ms * DM + n) + coef * *(const f32x4*)(gmod + (size_t)bid * NMOD + n) * small_gemm_sum(F.lds, F.tid, j);
            xn[j] = x4; ss += (x4[0] * x4[0] + x4[1] * x4[1]) + (x4[2] * x4[2] + x4[3] * x4[3]); }
        ss += __shfl_xor(ss, 16); ss += __shfl_xor(ss, 32);
        if (fq == 0) P2[(F.wave >> 2) * 64 + rl] = ss;
        __syncthreads();
        float* slot = XS + (size_t)(MP + 64 * sm + F.lane) * 16;
        if (F.wave == 0) { __hip_atomic_store(slot + sn, P2[F.lane] + P2[64 + F.lane], __ATOMIC_RELAXED, __HIP_MEMORY_SCOPE_AGENT);
            asm volatile("s_waitcnt vmcnt(0)" ::: "memory");
            if (F.lane == 0) __hip_atomic_fetch_add(cnt + 64 * (64 + sm), 1u, __ATOMIC_RELAXED, __HIP_MEMORY_SCOPE_AGENT);
            pg8::panel_wait(cnt + 64 * (64 + sm), 16u);
            float tot = 0.f;
#pragma unroll
            for (int t = 0; t < 16; ++t) tot += __hip_atomic_load(slot + t, __ATOMIC_RELAXED, __HIP_MEMORY_SCOPE_AGENT);
            S2[F.lane] = 1.0f / sqrtf(tot * (1.0f / DM) + EPS); }
        __syncthreads();
        const float r = S2[rl];
#pragma unroll
        for (int j = 0; j < 2; ++j) { const int n = 64 * sn + 16 * (2 * j + (F.wave >> 2)) + 4 * fq; const f32x4 g4 = *(const f32x4*)(gw + n);
            if constexpr (FINAL) *(f32x4*)(Yout + (size_t)row * DM + n) = xn[j] * r * g4;
            else { *(f32x4*)(Xout + (size_t)row * DM + n) = xn[j];
                *(u32x2*)(Uout + (size_t)row * DM + n) = pack4(xn[j] * r * g4 * (1.0f + *(const f32x4*)(scmod + (size_t)bid * NMOD + n)) + *(const f32x4*)(shmod + (size_t)bid * NMOD + n)); } } }
}
__device__ __forceinline__ void small_gates_tile(Frame& F, const bf16_t* U, const bf16_t* Wg, float* gates, const int st) {
    {
        __syncthreads();
        small_gemm_partials<DM, false, true>(F.lds, U + (size_t)(64 * st) * DM, Wg, F.wave, F.lane);
        __syncthreads();
#pragma unroll
        for (int j = 0; j < 2; ++j) { const f32x4 v = small_gemm_sum(F.lds, F.tid, j); const int tile = 8 * j + (F.tid >> 6), tn = tile >> 2, tm = tile & 3;
            *(f32x4*)(gates + (size_t)(64 * st + 16 * tm + (F.lane & 15)) * 64 + 16 * tn + 4 * (F.lane >> 4)) = v; } }
}
__device__ __forceinline__ void small_phase_merge(Frame& F, const bf16_t* HA, const bf16_t* HB, const bf16_t* WA, const bf16_t* WB, const bf16_t* Z, bf16_t* U) {
    for (int st = F.bx; st < 256; st += F.G) { const int x = st & 7, j = st >> 3, sm = 4 * (x >> 1) + (j >> 3), sn = 8 * (x & 1) + (j & 7); f32x4 va[2], vb[2];
        __syncthreads();
        small_gemm_partials<2048, true, true>(F.lds, HA + (size_t)(MP + 64 * sm) * 2048, WA + (size_t)(64 * sn) * 2048, F.wave, F.lane);
        __syncthreads();
        va[0] = small_gemm_sum(F.lds, F.tid, 0); va[1] = small_gemm_sum(F.lds, F.tid, 1);
        __syncthreads();
        small_gemm_partials<2048, true, true>(F.lds, HB + (size_t)(MP + 64 * sm) * 2048, WB + (size_t)(64 * sn) * 2048, F.wave, F.lane);
        __syncthreads();
        vb[0] = small_gemm_sum(F.lds, F.tid, 0); vb[1] = small_gemm_sum(F.lds, F.tid, 1);
#pragma unroll
        for (int j = 0; j < 2; ++j) { const int tile = 8 * j + (F.tid >> 6), tn = tile >> 2, tm = tile & 3;
            const int row = MP + 64 * sm + 16 * tm + (F.lane & 15), n = 64 * sn + 16 * tn + 4 * (F.lane >> 4);
            const u32x2 ga = *(const u32x2*)(Z + (size_t)row * ZP + ZGA + n), gb = *(const u32x2*)(Z + (size_t)row * ZP + ZGB + n);
            f32x4 o; o[0] = sigmoidf_(bflo(ga.x)) * va[j][0] + sigmoidf_(bflo(gb.x)) * vb[j][0]; o[1] = sigmoidf_(bfhi(ga.x)) * va[j][1] + sigmoidf_(bfhi(gb.x)) * vb[j][1];
            o[2] = sigmoidf_(bflo(ga.y)) * va[j][2] + sigmoidf_(bflo(gb.y)) * vb[j][2]; o[3] = sigmoidf_(bfhi(ga.y)) * va[j][3] + sigmoidf_(bfhi(gb.y)) * vb[j][3];
            *(u32x2*)(U + (size_t)MP * DM + fo_index(row - MP, n, DM)) = pack4(o); } }
}

#define GAS __attribute__((address_space(1)))
#define XB_TMO      128
#define XB_XCNT(j)  (256  + 64 * (j))
#define XB_XSUB(j)  (1280 + 64 * (j))
#define XB_XGEN(j)  (2304 + 64 * (j))
#define XB_TOP      3328
#define XB_TOPGEN   3392
#define XCD_BAR_WORDS 3456
#define XB_SPIN_CAP (1u << 22)
__device__ __forceinline__ unsigned xb_ld(unsigned* p)              { return __hip_atomic_load(p, __ATOMIC_RELAXED, __HIP_MEMORY_SCOPE_AGENT); }
__device__ __forceinline__ unsigned xb_add(unsigned* p, unsigned v) { return __hip_atomic_fetch_add(p, v, __ATOMIC_RELAXED, __HIP_MEMORY_SCOPE_AGENT); }
__device__ __forceinline__ unsigned xb_xcc_id() { return (unsigned)__builtin_amdgcn_s_getreg((3 << 11) | 20) & 0xFu; }
#define XB_SPIN(cond, bar) do { unsigned _sp = 0; while (cond) { __builtin_amdgcn_s_sleep(1); \
    if ((++_sp & 255u) == 0u) { if (xb_ld(&(bar)[XB_TMO])) break; if (_sp > XB_SPIN_CAP) { atomicAdd(&(bar)[XB_TMO], 1u); break; } } } } while (0)
struct XcdBarrier { unsigned* bar; unsigned x; volatile LAS unsigned* st; };
__device__ __forceinline__ XcdBarrier xcd_barrier_post(unsigned* bar, volatile LAS unsigned* st) {
    XcdBarrier b; b.bar = bar; b.x = xb_xcc_id(); b.st = st;
    if (threadIdx.x == 0) (void)xb_add(&bar[XB_XCNT(b.x)], 1u);
    return b;
}
__device__ __forceinline__ void xcd_barrier_complete(unsigned* bar, unsigned x, unsigned& nloc, unsigned& nx) {
    const unsigned G = gridDim.x * gridDim.y * gridDim.z;
    unsigned sum, cnt, mine, sp = 0u;
    for (;;) {
        sum = 0u; cnt = 0u; mine = 0u;
#pragma unroll
        for (unsigned j = 0; j < 16; ++j) { const unsigned c = xb_ld(&bar[XB_XCNT(j)]); sum += c; cnt += (c > 0u) ? 1u : 0u; mine = (j == x) ? c : mine; }
        if (sum == G) break;
        __builtin_amdgcn_s_sleep(1);
        if ((++sp & 255u) == 0u) { if (xb_ld(&bar[XB_TMO])) break; if (sp > XB_SPIN_CAP) { atomicAdd(&bar[XB_TMO], 1u); break; } }
    }
    nloc = mine > 0u ? mine : 1u; nx = cnt > 0u ? cnt : 1u;
}
__device__ __forceinline__ void xcd_barrier(const XcdBarrier& b) {
    asm volatile("s_waitcnt vmcnt(0)" ::: "memory");
    __syncthreads();
    if (threadIdx.x == 0) {
        unsigned* bar = b.bar;
        __builtin_amdgcn_s_waitcnt(0);
        unsigned nloc = b.st[0], nx = b.st[1];
        if (nloc == 0u) { xcd_barrier_complete(bar, b.x, nloc, nx); b.st[0] = nloc; b.st[1] = nx; }
        const unsigned old = xb_add(&bar[XB_XSUB(b.x)], 1u);
        const unsigned gen = old / nloc;
        if (old + 1u == (gen + 1u) * nloc) {
            __builtin_amdgcn_fence(__ATOMIC_RELEASE, "agent");
            asm volatile("s_waitcnt vmcnt(0)" ::: "memory");
            const unsigned og = xb_add(&bar[XB_TOP], 1u);
            const unsigned tg = og / nx;
            if (og + 1u == (tg + 1u) * nx) xb_add(&bar[XB_TOPGEN], 1u);
            else XB_SPIN(xb_ld(&bar[XB_TOPGEN]) == tg, bar);
            __builtin_amdgcn_fence(__ATOMIC_ACQUIRE, "agent");
            xb_add(&bar[XB_XGEN(b.x)], 1u);
            asm volatile("s_waitcnt vmcnt(0)" ::: "memory");
        } else {
            XB_SPIN(xb_ld(&bar[XB_XGEN(b.x)]) == gen, bar);
            __builtin_amdgcn_fence(__ATOMIC_ACQUIRE, "agent");
            asm volatile("s_waitcnt vmcnt(0)" ::: "memory");
        }
    }
    __syncthreads();
}


template <class SrcFn>
__device__ __forceinline__ void transpose_item(const SrcFn& src, int K, bf16_t* WT, LAS float* scr, int item, int lane, int nblk, bf16_t* WF = nullptr, int fo_row0 = 0) {
    const int kb = item / nblk, nb = item % nblk, k0 = 64 * kb, n0 = 32 * nb;
    const size_t stride = (size_t)src.stride(); const float* colp = src(n0 + (lane & 31));
    float tv[32];
#pragma unroll
    for (int i = 0; i < 32; ++i) { const int kk = 2 * i + (lane >> 5); tv[i] = colp ? colp[(size_t)(k0 + kk) * stride] : 0.f; }
#pragma unroll
    for (int i = 0; i < 32; ++i) { const int kk = 2 * i + (lane >> 5); scr[kk * 33 + (lane & 31)] = tv[i]; }
    asm volatile("s_waitcnt lgkmcnt(0)" ::: "memory");
    const int c = lane & 7;
#pragma unroll
    for (int j = 0; j < 4; ++j) { const int n = (lane >> 3) + 8 * j; const LAS float* s = scr + (8 * c) * 33 + n;
        u32x4 o; o.x = cvt_pk_bf16(s[0 * 33], s[1 * 33]); o.y = cvt_pk_bf16(s[2 * 33], s[3 * 33]); o.z = cvt_pk_bf16(s[4 * 33], s[5 * 33]); o.w = cvt_pk_bf16(s[6 * 33], s[7 * 33]);
        *(u32x4*)(WT + (size_t)(n0 + n) * K + k0 + 8 * c) = o;
        if (WF != nullptr && n0 >= fo_row0) *(u32x4*)(WF + fo_index(n0 + n - fo_row0, k0 + 8 * c, K)) = o; }
    asm volatile("s_waitcnt lgkmcnt(0)" ::: "memory");
}
struct SrcPlain { const float* W; int N; __device__ __forceinline__ int stride() const { return N; } __device__ __forceinline__ const float* operator()(int n) const { return W + n; } };
struct SrcUp { const float* W1; const float* W3; __device__ __forceinline__ int stride() const { return DFF; } __device__ __forceinline__ const float* operator()(int n) const { const int T = n >> 8, i = n & 255; const uintptr_t a = (uintptr_t)W1, b = (uintptr_t)W3, msk = (uintptr_t)0 - (uintptr_t)(i >> 7);
        return (const float*)((a & ~msk) | (b & msk)) + 128 * T + (i & 127); } };
struct SrcWin { const float* W; __device__ __forceinline__ int stride() const { return 13352; } __device__ __forceinline__ const float* operator()(int r) const { int o;
        if (r < 6144) o = r; else if (r < 8192) o = 6152 + (r - 6144); else if (r < 11264) o = 8200 + (r - 8192); else if (r < 13312) o = 11304 + (r - 11264);
        else if (r < 13320) o = 6144 + (r - 13312); else if (r < 13352) o = 11272 + (r - 13320); else return nullptr;
        return W + o; } };

template <int PPART>
__device__ __forceinline__ void phase_prep(Frame& F, const Params& p) {
    LAS float* scr = (LAS float*)(F.lds + F.wave * 16384);
    const int gw = (PPART == 0 ? F.bx : F.bx - 192) * 8 + F.wave, NGW = (PPART == 0 ? F.G : 64) * 8;
    bf16_t* wup1 = (bf16_t*)(F.ws + WS_WUP1); bf16_t* wdn1 = (bf16_t*)(F.ws + WS_WDN1); bf16_t* wup2 = (bf16_t*)(F.ws + WS_WUP2); bf16_t* wdn2 = (bf16_t*)(F.ws + WS_WDN2);
    bf16_t* win = (bf16_t*)(F.ws + WS_WIN); bf16_t* wpa = (bf16_t*)(F.ws + WS_WPA); bf16_t* wpb = (bf16_t*)(F.ws + WS_WPB); bf16_t* wout = (bf16_t*)(F.ws + WS_WOUT);
    constexpr int I_UP = (DM / 64) * (2 * DFF / 32), I_DN = (DFF / 64) * (DM / 32), I_IN = (DM / 64) * (ZP / 32), I_P = (2048 / 64) * (DM / 32), I_O = (DM / 64) * (DM / 32);
    constexpr int NITEMS = 2 * I_UP + 2 * I_DN + I_IN + 2 * I_P + I_O;
    for (int it = (PPART == 0 ? 0 : I_UP) + gw; it < (PPART == 0 ? I_UP : NITEMS); it += NGW) {
        int r = it;
        if (r < I_UP) { transpose_item(SrcUp{PIN(13), PIN(14)}, DM, wup1, scr, r, F.lane, 2 * DFF / 32); continue; } r -= I_UP;
        if (r < I_UP) { transpose_item(SrcUp{PIN(32), PIN(33)}, DM, wup2, scr, r, F.lane, 2 * DFF / 32); continue; } r -= I_UP;
        if (r < I_DN) { transpose_item(SrcPlain{PIN(15), DM}, DFF, wdn1, scr, r, F.lane, DM / 32, (bf16_t*)(F.ws + WS_FDN1)); continue; } r -= I_DN;
        if (r < I_DN) { transpose_item(SrcPlain{PIN(34), DM}, DFF, wdn2, scr, r, F.lane, DM / 32, (bf16_t*)(F.ws + WS_FDN2)); continue; } r -= I_DN;
        if (r < I_IN) { transpose_item(SrcWin{PIN(17)}, DM, win, scr, r, F.lane, ZP / 32, (bf16_t*)(F.ws + WS_FG), ZG); continue; } r -= I_IN;
        if (r < I_P) { transpose_item(SrcPlain{PIN(22), DM}, 2048, wpa, scr, r, F.lane, DM / 32, (bf16_t*)(F.ws + WS_FPA)); continue; } r -= I_P;
        if (r < I_P) { transpose_item(SrcPlain{PIN(29), DM}, 2048, wpb, scr, r, F.lane, DM / 32, (bf16_t*)(F.ws + WS_FPB)); continue; } r -= I_P;
        transpose_item(SrcPlain{PIN(30), DM}, DM, wout, scr, r, F.lane, DM / 32, (bf16_t*)(F.ws + WS_FOUT));
    }
    __syncthreads();
    if constexpr (PPART != 0) return;
    const float* ada_w = PIN(10); const float* ada_b = PIN(11); float* mod = (float*)(F.ws + WS_MOD);
    LAS f32x4* PART = (LAS f32x4*)F.lds;
    const int lane = F.lane, w = F.wave, fr = lane & 15, fq = lane >> 4;
    for (int nt = F.bx; nt < NMOD / 16; nt += F.G) {
        f32x4 acc[9];
#pragma unroll
        for (int rt = 0; rt < 9; ++rt) acc[rt] = (f32x4){0.f, 0.f, 0.f, 0.f};
#pragma unroll 1
        for (int ks = 0; ks < 4; ++ks) {
            const int k0 = 128 * w + 32 * ks + 8 * fq;
            float wv[8];
#pragma unroll
            for (int j = 0; j < 8; ++j) wv[j] = ada_w[(size_t)(k0 + j) * NMOD + 16 * nt + fr];
            bf16x8 bfr; { const u32x4 t = pack8(wv, 1.0f); bfr = __builtin_bit_cast(bf16x8, t); }
#pragma unroll
            for (int rt = 0; rt < 9; ++rt) { const int r = 16 * rt + fr; float x[8];
                if (r < NBID) { const float* cr = (r < NBP ? PIN(2) + (size_t)r * DM : PIN(3) + (size_t)(r - NBP) * DM) + k0; const f32x4 c0 = *(const f32x4*)cr, c1 = *(const f32x4*)(cr + 4);
#pragma unroll
                    for (int e = 0; e < 4; ++e) { x[e] = siluf_(c0[e]); x[4 + e] = siluf_(c1[e]); } }
                else {
#pragma unroll
                    for (int e = 0; e < 8; ++e) x[e] = 0.f; }
                const u32x4 t = pack8(x, 1.0f);
                acc[rt] = __builtin_amdgcn_mfma_f32_16x16x32_bf16(__builtin_bit_cast(bf16x8, t), bfr, acc[rt], 0, 0, 0); }
        }
        __syncthreads();
#pragma unroll
        for (int rt = 0; rt < 9; ++rt) PART[(w * 9 + rt) * 64 + lane] = acc[rt];
        __syncthreads();
        for (int idx = F.tid; idx < 9 * 64; idx += NTHREADS) { const int rt = idx >> 6, ln = idx & 63; f32x4 sum = PART[rt * 64 + ln];
#pragma unroll
            for (int ww = 1; ww < 8; ++ww) sum += PART[(ww * 9 + rt) * 64 + ln];
            const int n = 16 * nt + (ln & 15); const float bv = ada_b[n];
#pragma unroll
            for (int r = 0; r < 4; ++r) { const int row = 16 * rt + 4 * (ln >> 4) + r; if (row < NBID) mod[(size_t)row * NMOD + n] = sum[r] + bv; } }
    }
}

__device__ __forceinline__ void phase_norm_mod(Frame& F, const float* xp, const float* xs, const float* gw, int shoff, int scoff, bf16_t* U) {
    const float* mod = (const float*)(F.ws + WS_MOD);
    const int gwv = F.bx * 8 + F.wave, NGW = F.G * 8;
    f32x4 g[4];
#pragma unroll
    for (int j = 0; j < 4; ++j) g[j] = *(const f32x4*)(gw + 4 * F.lane + 256 * j);
    for (int m = gwv; m < MT; m += NGW) {
        const float* xr = m < MP ? xp + (size_t)m * DM : xs + (size_t)(m - MP) * DM;
        const float* mr = mod + (size_t)pg8::bid_of_row(m) * NMOD;
        f32x4 v[4]; float s = 0.f;
#pragma unroll
        for (int j = 0; j < 4; ++j) { v[j] = *(const f32x4*)(xr + 4 * F.lane + 256 * j); s += (v[j][0] * v[j][0] + v[j][1] * v[j][1]) + (v[j][2] * v[j][2] + v[j][3] * v[j][3]); }
        const float r = 1.0f / sqrtf(wave_sum(s) * (1.0f / DM) + EPS);
#pragma unroll
        for (int j = 0; j < 4; ++j) { const f32x4 sh = *(const f32x4*)(mr + shoff + 4 * F.lane + 256 * j), scv = *(const f32x4*)(mr + scoff + 4 * F.lane + 256 * j);
            const f32x4 o = (v[j] * r * g[j]) * (1.0f + scv) + sh;
            u32x2 w; w.x = cvt_pk_bf16(o[0], o[1]); w.y = cvt_pk_bf16(o[2], o[3]);
            *(u32x2*)(U + (size_t)m * DM + 4 * F.lane + 256 * j) = w; }
    }
}
__device__ __forceinline__ void phase_final_norm(Frame& F, float* Y, const float* gw) {
    const int gwv = F.bx * 8 + F.wave, NGW = F.G * 8;
    f32x4 g[4];
#pragma unroll
    for (int j = 0; j < 4; ++j) g[j] = *(const f32x4*)(gw + 4 * F.lane + 256 * j);
    for (int m = gwv; m < MT; m += NGW) {
        float* xr = Y + (size_t)m * DM;
        f32x4 v[4]; float s = 0.f;
#pragma unroll
        for (int j = 0; j < 4; ++j) { v[j] = *(const f32x4*)(xr + 4 * F.lane + 256 * j); s += (v[j][0] * v[j][0] + v[j][1] * v[j][1]) + (v[j][2] * v[j][2] + v[j][3] * v[j][3]); }
        const float r = 1.0f / sqrtf(wave_sum(s) * (1.0f / DM) + EPS);
#pragma unroll
        for (int j = 0; j < 4; ++j) *(f32x4*)(xr + 4 * F.lane + 256 * j) = v[j] * r * g[j];
    }
}

constexpr size_t O_Y = 0, O_PC = 17825792, O_PN = 22020096, O_PM = 22028288, O_PMC = 22028320, O_PSSM = 22077472, O_PSC = 24174624,
                 O_SC = 24248352, O_SN = 91357216, O_SM = 91488288, O_SMC = 91488800, O_SSSM = 92275232, O_SSC = 125829664, O_END = 127009312;
constexpr int CVP = 5120;

__device__ __forceinline__ bf16x8 frag_row(LAS unsigned char* base, int stride, int row0, int k0, int lane) {
    return *(const LAS bf16x8*)(base + (row0 + (lane & 15)) * stride + (k0 + 8 * (lane >> 4)) * 2);
}
__device__ __forceinline__ bf16x8 frag_tr(LAS unsigned char* base, int stride, int krow0, int col0, int lane) {
    const int g = lane >> 4, q = (lane & 15) >> 2, pp = lane & 3;
    LAS unsigned char* a = base + (krow0 + 8 * g + q) * stride + (col0 + 4 * pp) * 2;
    const s16x4 lo = __builtin_amdgcn_ds_read_tr16_b64_v4i16((LAS s16x4*)a);
    const s16x4 hi = __builtin_amdgcn_ds_read_tr16_b64_v4i16((LAS s16x4*)(a + 4 * stride));
    return (bf16x8){lo.x, lo.y, lo.z, lo.w, hi.x, hi.y, hi.z, hi.w};
}
#define MFMA16(a, b, c) __builtin_amdgcn_mfma_f32_16x16x32_bf16((a), (b), (c), 0, 0, 0)

__device__ __forceinline__ float fast_log1pexp_neg(float ax) { return __builtin_amdgcn_logf(1.0f + fast_exp(-ax)) * 0.6931471805599453f; }
__device__ __forceinline__ float logsigmoidf_(float x) { return fminf(x, 0.f) - log1pf(expf(-fabsf(x))); }
__device__ __forceinline__ float softplusf_(float x) { return fmaxf(x, 0.f) + log1pf(expf(-fabsf(x))); }

__device__ __forceinline__ void conv_item(Frame& F, const Params& p, const int it) {
    const bf16_t* Z = (const bf16_t*)(F.ws + WS_ZIN); bf16_t* CV = (bf16_t*)(F.ws + WS_CV);
    const int lane = F.lane;
    {
        int m0, tb, nrows, strip; const float* hist = nullptr;
        if (it < 5120) { const int b = it / 640, r = it % 640; strip = r % 10; tb = (r / 10) * 32; m0 = b * SEQ; nrows = 32; }
        else { const int j = it - 5120, bs = j / 10; strip = j % 10; tb = 0; m0 = MP + bs * TS; nrows = 8; hist = strip < 4 ? PIN(7) + (size_t)bs * 3 * 2048 : PIN(9) + (size_t)bs * 3 * 3072; }
        const bool isM = strip < 4;
        const int c = strip * 512 + 8 * lane, zc = isM ? c : ZX + (c - 2048), cc = isM ? c : c - 2048, cs = isM ? 2048 : 3072;
        const float* cw = isM ? PIN(18) : PIN(23); const float* cb = isM ? PIN(19) : PIN(24);
        const float scl = (strip == 2 || strip == 3) ? 0.0625f : 1.0f;
        float w[4][8], bb[8], x0[8], x1[8], x2[8];
#pragma unroll
        for (int j = 0; j < 4; ++j) { const f32x4 a = *(const f32x4*)(cw + (size_t)j * cs + cc), b = *(const f32x4*)(cw + (size_t)j * cs + cc + 4);
#pragma unroll
            for (int e = 0; e < 4; ++e) { w[j][e] = a[e]; w[j][4 + e] = b[e]; } }
        { const f32x4 a = *(const f32x4*)(cb + cc), b = *(const f32x4*)(cb + cc + 4);
#pragma unroll
            for (int e = 0; e < 4; ++e) { bb[e] = a[e]; bb[4 + e] = b[e]; } }
        if (tb > 0) { unpack8(*(const u32x4*)(Z + (size_t)(m0 + tb - 3) * ZP + zc), x0); unpack8(*(const u32x4*)(Z + (size_t)(m0 + tb - 2) * ZP + zc), x1); unpack8(*(const u32x4*)(Z + (size_t)(m0 + tb - 1) * ZP + zc), x2); }
        else if (hist != nullptr) {
#pragma unroll
            for (int e = 0; e < 8; ++e) { x0[e] = hist[cc + e]; x1[e] = hist[cs + cc + e]; x2[e] = hist[2 * cs + cc + e]; } }
        else {
#pragma unroll
            for (int e = 0; e < 8; ++e) { x0[e] = 0.f; x1[e] = 0.f; x2[e] = 0.f; } }
        for (int t = 0; t < nrows; t += 8) {
            u32x4 raw[8];
#pragma unroll
            for (int i = 0; i < 8; ++i) raw[i] = *(const u32x4*)(Z + (size_t)(m0 + tb + t + i) * ZP + zc);
#pragma unroll
            for (int i = 0; i < 8; ++i) { float x3[8], o[8]; unpack8(raw[i], x3);
#pragma unroll
                for (int e = 0; e < 8; ++e) { o[e] = siluf_(bb[e] + w[0][e] * x0[e] + w[1][e] * x1[e] + w[2][e] * x2[e] + w[3][e] * x3[e]); x0[e] = x1[e]; x1[e] = x2[e]; x2[e] = x3[e]; }
                *(u32x4*)(CV + (size_t)(m0 + tb + t + i) * CVP + c) = pack8(o, scl); }
        }
    }
}
constexpr int NS_EARLY = 64;
__device__ __forceinline__ void phase_conv(Frame& F, const Params& p) {
    const int gw = F.bx * 8 + F.wave, NGW = F.G * 8;
    for (int it = gw; it < 5120 + 1280 - 10 * NS_EARLY; it += NGW) conv_item(F, p, it < 5120 ? it : it + 10 * NS_EARLY);
}

constexpr int QSTR = 528, VSTR = 144;
constexpr int L_QS = 0, L_KS = 33792, L_CT = 67584, L_VS = 101376, L_VW = 110592, L_SB = 119808, L_SCAL = 129024, L_NST = 132096, L_QNP = 133120, L_DENP = 135168;

__device__ __forceinline__ float mlstm_scan(float ipre, float fpre, int lane, float mstate, LAS float* sc) {
    const float lf = fminf(fpre, 0.f) - fast_log1pexp_neg(fabsf(fpre));
    const float b = wave_scan_add(lf);
    const float a = ipre - b;
    const float cm = wave_scan_max(a);
    const float A = fmaxf(mstate, cm);
    const float Alast = __shfl(A, 63), blast = __shfl(b, 63);
    sc[lane] = a; sc[64 + lane] = A; sc[128 + lane] = fast_exp(mstate - A); sc[192 + lane] = fast_exp(-(b + A)); sc[256 + lane] = fast_exp(a - Alast);
    if (lane == 0) sc[320] = fast_exp(mstate - Alast);
    return blast + Alast;
}

__device__ __forceinline__ void mlstm_prompt_item(Frame& F, const Params& p, const int b, const int h, const int vs) {
    LAS unsigned char* L = F.lds;
    const int tid = F.tid, lane = F.lane, w = F.wave, fr = lane & 15, fq = lane >> 4;
    const bf16_t* Z = (const bf16_t*)(F.ws + WS_ZIN); const bf16_t* CV = (const bf16_t*)(F.ws + WS_CV); const float* GT = (const float*)(F.ws + WS_GATES);
    bf16_t* NUM = (bf16_t*)(F.ws + WS_NUM); float* DEN = (float*)(F.ws + WS_DEN);
    const float ifbi = PIN(20)[h], ifbf = PIN(20)[4 + h];
    constexpr int nch = SEQ / 64; const int m0 = b * SEQ;
    LAS float* SC = (LAS float*)(L + L_SCAL); LAS unsigned char* NSTB = L + L_NST; LAS float* DENP = (LAS float*)(L + L_DENP);
    f32x4 cacc[2][4];
#pragma unroll
    for (int dt = 0; dt < 2; ++dt)
#pragma unroll
        for (int vi = 0; vi < 4; ++vi) cacc[dt][vi] = (f32x4){0.f, 0.f, 0.f, 0.f};
    f32x4 nacc[2] = {{0.f, 0.f, 0.f, 0.f}, {0.f, 0.f, 0.f, 0.f}};
    float mstate = 0.f;
    u32x4 pq[4], pk[4], pv; float gi = 0.f, gf = 0.f;
    const bf16_t* qsrc = CV + (size_t)(m0 + (tid >> 5)) * CVP + h * 256 + 8 * (tid & 31);
    const bf16_t* vsrc = Z + (size_t)(m0 + (tid >> 3)) * ZP + ZV + h * 512 + vs * 64 + 8 * (tid & 7);
    const float* gsrc = GT + (size_t)(m0 + lane) * 64 + h;
#define ML_LOAD(c) do { _Pragma("unroll") for (int i = 0; i < 4; ++i) { pq[i] = *(const u32x4*)(qsrc + (size_t)((c) * 64 + 16 * i) * CVP); pk[i] = *(const u32x4*)(qsrc + (size_t)((c) * 64 + 16 * i) * CVP + 1024); } \
        pv = *(const u32x4*)(vsrc + (size_t)((c) * 64) * ZP); if (w == 0) { gi = gsrc[(size_t)((c) * 64) * 64]; gf = gsrc[(size_t)((c) * 64) * 64 + 4]; } } while (0)
    u32x2 numst[2] = {{0u, 0u}, {0u, 0u}}; float denst = 0.f;
    bf16_t* numdst = NUM + (size_t)(m0 + 16 * (w & 3) + fr) * 2048 + h * 512 + vs * 64 + 32 * (w >> 2) + 4 * fq;
#define ML_STORE(c) do { *(u32x2*)(numdst + (size_t)((c) * 64) * 2048) = numst[0]; *(u32x2*)(numdst + (size_t)((c) * 64) * 2048 + 16) = numst[1]; \
        if (vs == 0 && w < 4 && fq == 0) DEN[(size_t)(m0 + (c) * 64 + 16 * w + fr) * 4 + h] = denst; } while (0)
    ML_LOAD(0);
    __syncthreads();
#pragma unroll
    for (int dt = 0; dt < 2; ++dt)
#pragma unroll
        for (int vi = 0; vi < 4; ++vi) *(LAS u32x2*)(L + L_CT + (16 * vi + fr) * QSTR + (32 * w + 16 * dt + 4 * fq) * 2) = (u32x2){0u, 0u};
    if (tid < 128) *(LAS unsigned*)(NSTB + 4 * tid) = 0u;
    if (w == 0) mstate = mlstm_scan(gi + ifbi, gf + ifbf, lane, mstate, SC);
    __syncthreads();
    for (int c = 0; c < nch; ++c) {
        const int t0 = 64 * c; LAS float* sc = SC + (c & 1) * 384;
#pragma unroll
        for (int i = 0; i < 4; ++i) { const int v = tid + NTHREADS * i, row = v >> 5, c16 = v & 31; *(LAS u32x4*)(L + L_QS + row * QSTR + 16 * c16) = pq[i]; *(LAS u32x4*)(L + L_KS + row * QSTR + 16 * c16) = pk[i]; }
        { const int row = tid >> 3, c8 = tid & 7; *(LAS u32x4*)(L + L_VS + row * VSTR + 16 * c8) = pv; float x[8]; unpack8(pv, x); *(LAS u32x4*)(L + L_VW + row * VSTR + 16 * c8) = pack8(x, sc[256 + row]); }
        __syncthreads();
        if (c > 0) { ML_STORE(c - 1); }
        if (c + 1 < nch) ML_LOAD(c + 1);
        const int ti = w & 3, hf = w >> 2;
        bf16x8 qf[8];
#pragma unroll
        for (int k = 0; k < 8; ++k) qf[k] = frag_row(L + L_QS, QSTR, 16 * ti, 32 * k, lane);
        { f32x4 sacc[2] = {{0.f, 0.f, 0.f, 0.f}, {0.f, 0.f, 0.f, 0.f}};
#pragma unroll
          for (int j = 0; j < 2; ++j) { const int si = 2 * hf + j; if (si <= ti) {
#pragma unroll
                  for (int k = 0; k < 8; ++k) sacc[j] = MFMA16(frag_row(L + L_KS, QSTR, 16 * si, 32 * k, lane), qf[k], sacc[j]); } }
          const int t = 16 * ti + fr; const float At = sc[64 + t]; float dpart = 0.f;
#pragma unroll
          for (int j = 0; j < 2; ++j) { const int si = 2 * hf + j, s0 = 16 * si + 4 * fq; const f32x4 av = *(const LAS f32x4*)(sc + s0); f32x4 vv;
#pragma unroll
              for (int r = 0; r < 4; ++r) { const float wgt = (s0 + r <= t) ? fast_exp(av[r] - At) : 0.f; vv[r] = (si <= ti) ? sacc[j][r] * wgt : 0.f; dpart += vv[r]; }
              *(LAS u32x2*)(L + L_SB + t * VSTR + s0 * 2) = pack4(vv); }
          dpart += __shfl_xor(dpart, 16); dpart += __shfl_xor(dpart, 32);
          if (lane < 16) DENP[hf * 64 + 16 * ti + lane] = dpart; }
        __syncthreads();
        { f32x4 uacc[2] = {{0.f, 0.f, 0.f, 0.f}, {0.f, 0.f, 0.f, 0.f}};
#pragma unroll
          for (int j = 0; j < 2; ++j) { const int vi = 2 * hf + j;
#pragma unroll
              for (int k = 0; k < 8; ++k) uacc[j] = MFMA16(frag_row(L + L_CT, QSTR, 16 * vi, 32 * k, lane), qf[k], uacc[j]); }
          const float wst = sc[128 + 16 * ti + fr]; uacc[0] *= wst; uacc[1] *= wst;
#pragma unroll
          for (int ks = 0; ks < 2; ++ks) if (32 * ks <= 16 * ti + 15) { const bf16x8 sb = frag_row(L + L_SB, VSTR, 16 * ti, 32 * ks, lane);
#pragma unroll
              for (int j = 0; j < 2; ++j) uacc[j] = MFMA16(frag_tr(L + L_VS, VSTR, 32 * ks, 16 * (2 * hf + j), lane), sb, uacc[j]); }
          numst[0] = pack4(uacc[0]); numst[1] = pack4(uacc[1]); }
        if (vs == 0 && hf == 0) {
            f32x4 qn = {0.f, 0.f, 0.f, 0.f};
#pragma unroll
            for (int k = 0; k < 8; ++k) { u32x4 nv = *(const LAS u32x4*)(NSTB + 64 * k + 16 * fq); if (fr != 0) nv = (u32x4){0u, 0u, 0u, 0u};
                qn = MFMA16(__builtin_bit_cast(bf16x8, nv), qf[k], qn); }
            const int t = 16 * ti + fr; const float den = DENP[t] + DENP[64 + t] + sc[128 + t] * qn[0];
            denst = fmaxf(fabsf(den), sc[192 + t]); }
        { const float decay = sc[320];
#pragma unroll
          for (int dt = 0; dt < 2; ++dt)
#pragma unroll
              for (int vi = 0; vi < 4; ++vi) cacc[dt][vi] *= decay;
#pragma unroll
          for (int ks = 0; ks < 2; ++ks) { bf16x8 ka[2];
#pragma unroll
              for (int dt = 0; dt < 2; ++dt) ka[dt] = frag_tr(L + L_KS, QSTR, 32 * ks, 32 * w + 16 * dt, lane);
#pragma unroll
              for (int vi = 0; vi < 4; ++vi) { const bf16x8 vb = frag_tr(L + L_VW, VSTR, 32 * ks, 16 * vi, lane);
#pragma unroll
                  for (int dt = 0; dt < 2; ++dt) cacc[dt][vi] = MFMA16(ka[dt], vb, cacc[dt][vi]); } }
          if (vs == 0) { nacc[0] *= decay; nacc[1] *= decay;
#pragma unroll
              for (int ks = 0; ks < 2; ++ks) { const f32x4 w0 = *(const LAS f32x4*)(sc + 256 + 32 * ks + 8 * fq), w1 = *(const LAS f32x4*)(sc + 256 + 32 * ks + 8 * fq + 4);
                  u32x4 wv; wv.x = cvt_pk_bf16(w0[0], w0[1]); wv.y = cvt_pk_bf16(w0[2], w0[3]); wv.z = cvt_pk_bf16(w1[0], w1[1]); wv.w = cvt_pk_bf16(w1[2], w1[3]);
                  if (fr != 0) wv = (u32x4){0u, 0u, 0u, 0u};
#pragma unroll
                  for (int dt = 0; dt < 2; ++dt) nacc[dt] = MFMA16(frag_tr(L + L_KS, QSTR, 32 * ks, 32 * w + 16 * dt, lane), __builtin_bit_cast(bf16x8, wv), nacc[dt]); } } }
        if (w == 0 && c + 1 < nch) mstate = mlstm_scan(gi + ifbi, gf + ifbf, lane, mstate, SC + ((c + 1) & 1) * 384);
        __syncthreads();
#pragma unroll
        for (int dt = 0; dt < 2; ++dt)
#pragma unroll
            for (int vi = 0; vi < 4; ++vi) *(LAS u32x2*)(L + L_CT + (16 * vi + fr) * QSTR + (32 * w + 16 * dt + 4 * fq) * 2) = pack4(cacc[dt][vi]);
        if (vs == 0 && fr == 0) {
#pragma unroll
            for (int dt = 0; dt < 2; ++dt) *(LAS u32x2*)(NSTB + (32 * w + 16 * dt + 4 * fq) * 2) = pack4(nacc[dt]); }
    }
    ML_STORE(nch - 1);
#undef ML_LOAD
#undef ML_STORE
    float* Cout = F.out + O_PC + (size_t)(b * 4 + h) * 131072;
#pragma unroll
    for (int dt = 0; dt < 2; ++dt)
#pragma unroll
        for (int vi = 0; vi < 4; ++vi)
#pragma unroll
            for (int r = 0; r < 4; ++r) { const int d = 32 * w + 16 * dt + 4 * fq + r, v = 16 * vi + fr; Cout[(size_t)d * 512 + vs * 64 + v] = cacc[dt][vi][r]; }
    if (vs == 0) { if (fr == 0) {
#pragma unroll
            for (int dt = 0; dt < 2; ++dt)
#pragma unroll
                for (int r = 0; r < 4; ++r) F.out[O_PN + (size_t)(b * 4 + h) * 256 + 32 * w + 16 * dt + 4 * fq + r] = nacc[dt][r]; }
        if (tid == 0) F.out[O_PM + b * 4 + h] = mstate; }
}

constexpr int XSTR = 144, BSTR = 272;
constexpr int S_XS = 0, S_XD = 9216, S_XW = 18432, S_BS = 27648, S_CS = 45056, S_HS = 62464, S_GB = 79872, S_SCAL = 89088;

__device__ __forceinline__ void ssd_scan(float dtp, float Ae, int lane, LAS float* sc) {
    const float dt = fmaxf(dtp, 0.f) + fast_log1pexp_neg(fabsf(dtp));
    const float cum = wave_scan_add(dt * Ae);
    const float cl = __shfl(cum, 63);
    sc[lane] = cum; sc[64 + lane] = dt; sc[128 + lane] = fast_exp(cl - cum); sc[192 + lane] = fast_exp(cum);
    if (lane == 0) sc[256] = fast_exp(cl);
}

__device__ __forceinline__ void ssd_prompt_item(Frame& F, const Params& p, const int b, const int e) {
    LAS unsigned char* L = F.lds;
    const int tid = F.tid, lane = F.lane, w = F.wave, fr = lane & 15, fq = lane >> 4;
    const bf16_t* CV = (const bf16_t*)(F.ws + WS_CV); const float* GT = (const float*)(F.ws + WS_GATES);
    bf16_t* YS = (bf16_t*)(F.ws + WS_YS);
    const int g = e >> 3, m0 = b * SEQ; constexpr int nch = SEQ / 64;
    const float dtb = PIN(25)[e], Ae = -expf(PIN(26)[e]), De = PIN(27)[e];
    LAS float* SC = (LAS float*)(L + S_SCAL);
    f32x4 hacc[4];
#pragma unroll
    for (int pi = 0; pi < 4; ++pi) hacc[pi] = (f32x4){0.f, 0.f, 0.f, 0.f};
    u32x4 px, pb[2], pc[2]; float gd = 0.f;
    const bf16_t* xsrc = CV + (size_t)(m0 + (tid >> 3)) * CVP + 2048 + e * 64 + 8 * (tid & 7);
    const bf16_t* bsrc = CV + (size_t)(m0 + (tid >> 4)) * CVP + 4096 + g * 128 + 8 * (tid & 15);
    const float* gsrc = GT + (size_t)(m0 + lane) * 64 + 8 + e;
#define SD_LOAD(c) do { px = *(const u32x4*)(xsrc + (size_t)((c) * 64) * CVP); _Pragma("unroll") for (int i = 0; i < 2; ++i) { pb[i] = *(const u32x4*)(bsrc + (size_t)((c) * 64 + 32 * i) * CVP); pc[i] = *(const u32x4*)(bsrc + (size_t)((c) * 64 + 32 * i) * CVP + 512); } \
        if (w == 0) gd = gsrc[(size_t)((c) * 64) * 64]; } while (0)
    u32x2 yst[2] = {{0u, 0u}, {0u, 0u}};
    bf16_t* ydst = YS + (size_t)(m0 + 16 * (w & 3) + fr) * 2048 + e * 64 + 32 * (w >> 2) + 4 * fq;
#define SD_STORE(c) do { *(u32x2*)(ydst + (size_t)((c) * 64) * 2048) = yst[0]; *(u32x2*)(ydst + (size_t)((c) * 64) * 2048 + 16) = yst[1]; } while (0)
    SD_LOAD(0);
    __syncthreads();
#pragma unroll
    for (int pi = 0; pi < 4; ++pi) *(LAS u32x2*)(L + S_HS + (16 * pi + fr) * BSTR + (16 * w + 4 * fq) * 2) = (u32x2){0u, 0u};
    if (w == 0) ssd_scan(gd + dtb, Ae, lane, SC);
    __syncthreads();
    for (int c = 0; c < nch; ++c) {
        const int t0 = 64 * c; LAS float* sc = SC + (c & 1) * 320;
        { const int row = tid >> 3, c8 = tid & 7; const float dt = sc[64 + row], ed = sc[128 + row]; float x[8]; unpack8(px, x);
          *(LAS u32x4*)(L + S_XS + row * XSTR + 16 * c8) = px; *(LAS u32x4*)(L + S_XD + row * XSTR + 16 * c8) = pack8(x, dt); *(LAS u32x4*)(L + S_XW + row * XSTR + 16 * c8) = pack8(x, dt * ed); }
#pragma unroll
        for (int i = 0; i < 2; ++i) { const int row = (tid >> 4) + 32 * i, c16 = tid & 15; *(LAS u32x4*)(L + S_BS + row * BSTR + 16 * c16) = pb[i]; *(LAS u32x4*)(L + S_CS + row * BSTR + 16 * c16) = pc[i]; }
        __syncthreads();
        if (c > 0) { SD_STORE(c - 1); }
        if (c + 1 < nch) SD_LOAD(c + 1);
        const int ti = w & 3, hf = w >> 2;
        bf16x8 cf[4];
#pragma unroll
        for (int k = 0; k < 4; ++k) cf[k] = frag_row(L + S_CS, BSTR, 16 * ti, 32 * k, lane);
        { f32x4 gacc[2] = {{0.f, 0.f, 0.f, 0.f}, {0.f, 0.f, 0.f, 0.f}};
#pragma unroll
          for (int j = 0; j < 2; ++j) { const int si = 2 * hf + j; if (si <= ti) {
#pragma unroll
                  for (int k = 0; k < 4; ++k) gacc[j] = MFMA16(frag_row(L + S_BS, BSTR, 16 * si, 32 * k, lane), cf[k], gacc[j]); } }
          const int t = 16 * ti + fr; const float cumt = sc[t];
#pragma unroll
          for (int j = 0; j < 2; ++j) { const int si = 2 * hf + j, s0 = 16 * si + 4 * fq; const f32x4 cs = *(const LAS f32x4*)(sc + s0); f32x4 vv;
#pragma unroll
              for (int r = 0; r < 4; ++r) vv[r] = (si <= ti && s0 + r <= t) ? gacc[j][r] * fast_exp(cumt - cs[r]) : 0.f;
              *(LAS u32x2*)(L + S_GB + t * XSTR + s0 * 2) = pack4(vv); } }
        __syncthreads();
        { f32x4 yacc[2] = {{0.f, 0.f, 0.f, 0.f}, {0.f, 0.f, 0.f, 0.f}};
#pragma unroll
          for (int j = 0; j < 2; ++j) { const int pi = 2 * hf + j;
#pragma unroll
              for (int k = 0; k < 4; ++k) yacc[j] = MFMA16(frag_row(L + S_HS, BSTR, 16 * pi, 32 * k, lane), cf[k], yacc[j]); }
          const int t = 16 * ti + fr; const float ec = sc[192 + t]; yacc[0] *= ec; yacc[1] *= ec;
#pragma unroll
          for (int ks = 0; ks < 2; ++ks) if (32 * ks <= 16 * ti + 15) { const bf16x8 gb = frag_row(L + S_GB, XSTR, 16 * ti, 32 * ks, lane);
#pragma unroll
              for (int j = 0; j < 2; ++j) yacc[j] = MFMA16(frag_tr(L + S_XD, XSTR, 32 * ks, 16 * (2 * hf + j), lane), gb, yacc[j]); }
#pragma unroll
          for (int j = 0; j < 2; ++j) { const int p0 = 16 * (2 * hf + j) + 4 * fq; const u32x2 xv = *(const LAS u32x2*)(L + S_XS + t * XSTR + p0 * 2);
              f32x4 y = yacc[j]; y[0] += De * bflo(xv.x); y[1] += De * bfhi(xv.x); y[2] += De * bflo(xv.y); y[3] += De * bfhi(xv.y);
              yst[j] = pack4(y); } }
        { const float eall = sc[256];
#pragma unroll
          for (int pi = 0; pi < 4; ++pi) hacc[pi] *= eall;
#pragma unroll
          for (int ks = 0; ks < 2; ++ks) { const bf16x8 ba = frag_tr(L + S_BS, BSTR, 32 * ks, 16 * w, lane);
#pragma unroll
              for (int pi = 0; pi < 4; ++pi) hacc[pi] = MFMA16(ba, frag_tr(L + S_XW, XSTR, 32 * ks, 16 * pi, lane), hacc[pi]); } }
        if (w == 0 && c + 1 < nch) ssd_scan(gd + dtb, Ae, lane, SC + ((c + 1) & 1) * 320);
        __syncthreads();
#pragma unroll
        for (int pi = 0; pi < 4; ++pi) *(LAS u32x2*)(L + S_HS + (16 * pi + fr) * BSTR + (16 * w + 4 * fq) * 2) = pack4(hacc[pi]);
    }
    SD_STORE(nch - 1);
#undef SD_LOAD
#undef SD_STORE
    float* hout = F.out + O_PSSM + (size_t)(b * 32 + e) * 8192;
#pragma unroll
    for (int pi = 0; pi < 4; ++pi) *(f32x4*)(hout + (size_t)(16 * pi + fr) * 128 + 16 * w + 4 * fq) = hacc[pi];
}

__device__ __forceinline__ void mlstm_sample_item(Frame& F, const Params& p, const int bs, const int h) {
    LAS unsigned char* L = F.lds; const int tid = F.tid, lane = F.lane, w = F.wave;
    const bf16_t* Z = (const bf16_t*)(F.ws + WS_ZIN); const bf16_t* CV = (const bf16_t*)(F.ws + WS_CV); const float* GT = (const float*)(F.ws + WS_GATES);
    bf16_t* NUM = (bf16_t*)(F.ws + WS_NUM); float* DEN = (float*)(F.ws + WS_DEN);
    const int m0 = MP + bs * TS;
    const float* C0 = PIN(4) + (size_t)(bs * 4 + h) * 131072; float* C1 = F.out + O_SC + (size_t)(bs * 4 + h) * 131072;
    LAS float* QKW = (LAS float*)L; LAS float* RED = (LAS float*)(L + 16384); LAS float* NS = (LAS float*)(L + 81920);
    LAS float* SCs = (LAS float*)(L + 82944); LAS float* SW = (LAS float*)(L + 83200); LAS float* QN = (LAS float*)(L + 83456);
    const int v4 = tid & 127, dp = tid >> 7;
    f32x4 vreg[8];
#pragma unroll
    for (int s = 0; s < 8; ++s) { const u32x2 vv = *(const u32x2*)(Z + (size_t)(m0 + s) * ZP + ZV + h * 512 + 4 * v4); vreg[s] = (f32x4){bflo(vv.x), bfhi(vv.x), bflo(vv.y), bfhi(vv.y)}; }
    const u32x4 qk = *(const u32x4*)(CV + (size_t)(m0 + ((tid >> 5) & 7)) * CVP + (tid >> 8) * 1024 + h * 256 + 8 * (tid & 31));
    const float n0v = tid < 256 ? PIN(5)[(size_t)(bs * 4 + h) * 256 + tid] : 0.f;
    __syncthreads();
    { const int isk = tid >> 8, t = (tid >> 5) & 7, c16 = tid & 31; float x[8]; unpack8(qk, x);
#pragma unroll
      for (int e = 0; e < 8; ++e) QKW[(8 * c16 + e) * 16 + isk * 8 + t] = x[e]; }
    if (tid < 256) NS[tid] = n0v;
    if (w == 0) {
        const bool valid = lane < 8; const float mstate = PIN(6)[bs * 4 + h];
        float ipre = 0.f, fpre = 0.f; if (valid) { ipre = GT[(size_t)(m0 + lane) * 64 + h] + PIN(20)[h]; fpre = GT[(size_t)(m0 + lane) * 64 + 4 + h] + PIN(20)[4 + h]; }
        float bsum = valid ? logsigmoidf_(fpre) : 0.f;
#pragma unroll
        for (int o = 1; o < 8; o <<= 1) { const float u = __shfl_up(bsum, o); if (lane >= o) bsum += u; }
        const float a = valid ? ipre - bsum : -INFINITY;
        float cm = a;
#pragma unroll
        for (int o = 1; o < 8; o <<= 1) { const float u = __shfl_up(cm, o); if (lane >= o) cm = fmaxf(cm, u); }
        const float A = fmaxf(mstate, cm); const float Alast = __shfl(A, 7), blast = __shfl(bsum, 7);
        if (valid) { SCs[lane] = a; SCs[8 + lane] = A; SCs[16 + lane] = expf(mstate - A); SCs[24 + lane] = expf(-(bsum + A)); SCs[32 + lane] = expf(a - Alast); }
        if (lane == 0) { SCs[40] = expf(mstate - Alast); F.out[O_SM + bs * 4 + h] = blast + Alast; }
    }
    __syncthreads();
    { const int pr = tid >> 3, part = tid & 7, t = pr >> 3, s = pr & 7; float acc = 0.f;
#pragma unroll 8
      for (int dd = 0; dd < 32; ++dd) { const int d = part * 32 + dd; acc += QKW[d * 16 + t] * QKW[d * 16 + 8 + s]; }
      acc += __shfl_xor(acc, 1); acc += __shfl_xor(acc, 2); acc += __shfl_xor(acc, 4);
      if (part == 0) SW[t * 8 + s] = (s <= t) ? acc * expf(SCs[s] - SCs[8 + t]) : 0.f; }
    if (tid < 64) { const int t = tid >> 3, part = tid & 7; float acc = 0.f;
#pragma unroll 8
      for (int dd = 0; dd < 32; ++dd) { const int d = part * 32 + dd; acc += QKW[d * 16 + t] * NS[d]; }
      acc += __shfl_xor(acc, 1); acc += __shfl_xor(acc, 2); acc += __shfl_xor(acc, 4);
      if (part == 0) QN[t] = acc; }
    if (tid >= 256) { const int d = tid - 256; float s = 0.f;
#pragma unroll
        for (int si = 0; si < 8; ++si) s += SCs[32 + si] * QKW[d * 16 + 8 + si];
        F.out[O_SN + (size_t)(bs * 4 + h) * 256 + d] = SCs[40] * NS[d] + s; }
    __syncthreads();
    if (tid < 8) { const int t = tid; float den = 0.f;
#pragma unroll
        for (int s = 0; s < 8; ++s) den += SW[t * 8 + s];
        den += SCs[16 + t] * QN[t]; DEN[(size_t)(m0 + t) * 4 + h] = fmaxf(fabsf(den), SCs[24 + t]); }
    if (tid >= 256) { const int d = tid - 256;
#pragma unroll
        for (int si = 0; si < 8; ++si) QKW[d * 16 + 8 + si] *= SCs[32 + si]; }
    __syncthreads();
    { const float decay = SCs[40];
      f32x4 acc[8];
#pragma unroll
      for (int t = 0; t < 8; ++t) acc[t] = (f32x4){0.f, 0.f, 0.f, 0.f};
      const float* cin = C0 + (size_t)(dp * 64) * 512 + 4 * v4; float* cout = C1 + (size_t)(dp * 64) * 512 + 4 * v4;
#pragma unroll 1
      for (int d0 = 0; d0 < 64; d0 += 8) {
          f32x4 cc[8];
#pragma unroll
          for (int i = 0; i < 8; ++i) cc[i] = __builtin_nontemporal_load((const f32x4*)(cin + (size_t)(d0 + i) * 512));
#pragma unroll
          for (int i = 0; i < 8; ++i) { const LAS float* qp = QKW + (dp * 64 + d0 + i) * 16;
              const f32x4 q0 = *(const LAS f32x4*)qp, q1 = *(const LAS f32x4*)(qp + 4), k0 = *(const LAS f32x4*)(qp + 8), k1 = *(const LAS f32x4*)(qp + 12);
              f32x4 cn = decay * cc[i];
#pragma unroll
              for (int t = 0; t < 4; ++t) { acc[t] += q0[t] * cc[i]; acc[4 + t] += q1[t] * cc[i]; cn += k0[t] * vreg[t]; cn += k1[t] * vreg[4 + t]; }
              __builtin_nontemporal_store(cn, (f32x4*)(cout + (size_t)(d0 + i) * 512)); }
      }
#pragma unroll
      for (int t = 0; t < 8; ++t) *(LAS f32x4*)(RED + (size_t)(dp * 8 + t) * 512 + 4 * v4) = acc[t]; }
    __syncthreads();
    { const int t = tid >> 6, v8 = tid & 63; float s[8];
#pragma unroll
      for (int e = 0; e < 8; ++e) s[e] = 0.f;
#pragma unroll
      for (int dpp = 0; dpp < 4; ++dpp) { const f32x4 a = *(const LAS f32x4*)(RED + (size_t)(dpp * 8 + t) * 512 + 8 * v8), b = *(const LAS f32x4*)(RED + (size_t)(dpp * 8 + t) * 512 + 8 * v8 + 4);
#pragma unroll
          for (int e = 0; e < 4; ++e) { s[e] += a[e]; s[4 + e] += b[e]; } }
      const float wst = SCs[16 + t];
#pragma unroll
      for (int e = 0; e < 8; ++e) s[e] *= wst;
      for (int si = 0; si <= t; ++si) { const float sw = SW[t * 8 + si]; float x[8]; unpack8(*(const u32x4*)(Z + (size_t)(m0 + si) * ZP + ZV + h * 512 + 8 * v8), x);
#pragma unroll
          for (int e = 0; e < 8; ++e) s[e] += sw * x[e]; }
      *(u32x4*)(NUM + (size_t)(m0 + t) * 2048 + h * 512 + 8 * v8) = pack8(s, 1.0f); }
}

__device__ __forceinline__ void ssd_sample_item(Frame& F, const Params& p, const int bs, const int g) {
    LAS unsigned char* L = F.lds; const int tid = F.tid, lane = F.lane, w = F.wave;
    const bf16_t* CV = (const bf16_t*)(F.ws + WS_CV); const float* GT = (const float*)(F.ws + WS_GATES); bf16_t* YS = (bf16_t*)(F.ws + WS_YS);
    const int m0 = MP + bs * TS;
    LAS float* BSf = (LAS float*)L; LAS float* CSf = (LAS float*)(L + 4096); LAS float* XF = (LAS float*)(L + 8192); LAS float* XWt = (LAS float*)(L + 24576);
    LAS float* XDt = (LAS float*)(L + 40960); LAS float* SC2 = (LAS float*)(L + 57344); LAS float* CB = (LAS float*)(L + 58432); LAS float* YP = (LAS float*)(L + 59392);
    const u32x4 xr = *(const u32x4*)(CV + (size_t)(m0 + (tid >> 6)) * CVP + 2048 + g * 512 + 8 * (tid & 63));
    u32x4 bcr = {0u, 0u, 0u, 0u};
    if (tid < 256) bcr = *(const u32x4*)(CV + (size_t)(m0 + ((tid >> 4) & 7)) * CVP + 4096 + (tid >> 7) * 512 + g * 128 + 8 * (tid & 15));
    __syncthreads();
    { float x[8]; unpack8(xr, x); const int t = tid >> 6, c8 = tid & 63;
#pragma unroll
      for (int e = 0; e < 8; ++e) XF[t * 512 + 8 * c8 + e] = x[e]; }
    if (tid < 256) { float x[8]; unpack8(bcr, x); const int isC = tid >> 7, t = (tid >> 4) & 7, c16 = tid & 15; LAS float* dst = isC ? CSf : BSf;
#pragma unroll
      for (int e = 0; e < 8; ++e) dst[t * 128 + 8 * c16 + e] = x[e]; }
    { const int e = g * 8 + w; const bool valid = lane < 8; const float Ae = -expf(PIN(26)[e]);
      const float dt = valid ? softplusf_(GT[(size_t)(m0 + lane) * 64 + 8 + e] + PIN(25)[e]) : 0.f;
      float cum = dt * Ae;
#pragma unroll
      for (int o = 1; o < 8; o <<= 1) { const float u = __shfl_up(cum, o); if (lane >= o) cum += u; }
      const float cl = __shfl(cum, 7);
      if (valid) { SC2[w * 32 + lane] = cum; SC2[w * 32 + 8 + lane] = dt; SC2[w * 32 + 16 + lane] = expf(cl - cum); SC2[w * 32 + 24 + lane] = expf(cum); }
      if (lane == 0) SC2[256 + w] = expf(cl); }
    __syncthreads();
    { const int pr = tid >> 3, part = tid & 7, t = pr >> 3, s = pr & 7; float acc = 0.f;
#pragma unroll
      for (int nn = 0; nn < 16; ++nn) { const int n = part * 16 + nn; acc += CSf[t * 128 + n] * BSf[s * 128 + n]; }
      acc += __shfl_xor(acc, 1); acc += __shfl_xor(acc, 2); acc += __shfl_xor(acc, 4);
      if (part == 0) CB[t * 8 + s] = acc; }
    { const int el = tid >> 6;
#pragma unroll
      for (int s = 0; s < 8; ++s) { const float x = XF[s * 512 + tid], dt = SC2[el * 32 + 8 + s], ed = SC2[el * 32 + 16 + s]; XDt[tid * 8 + s] = x * dt; XWt[tid * 8 + s] = x * dt * ed; } }
    __syncthreads();
    { const int n8 = tid & 15, prow = tid >> 4;
      float Bn[8][8], Cn[8][8];
#pragma unroll
      for (int s = 0; s < 8; ++s) { const f32x4 b0 = *(const LAS f32x4*)(BSf + s * 128 + 8 * n8), b1 = *(const LAS f32x4*)(BSf + s * 128 + 8 * n8 + 4), c0 = *(const LAS f32x4*)(CSf + s * 128 + 8 * n8), c1 = *(const LAS f32x4*)(CSf + s * 128 + 8 * n8 + 4);
#pragma unroll
          for (int j = 0; j < 4; ++j) { Bn[s][j] = b0[j]; Bn[s][4 + j] = b1[j]; Cn[s][j] = c0[j]; Cn[s][4 + j] = c1[j]; } }
      const float* hin = PIN(8) + (size_t)(bs * 32 + g * 8) * 8192 + 8 * n8; float* hout = F.out + O_SSSM + (size_t)(bs * 32 + g * 8) * 8192 + 8 * n8;
#pragma unroll 1
      for (int it = 0; it < 16; it += 2) {
          f32x4 hv[2][2];
#pragma unroll
          for (int u = 0; u < 2; ++u) { const int row = (it + u) * 32 + prow; hv[u][0] = __builtin_nontemporal_load((const f32x4*)(hin + (size_t)row * 128)); hv[u][1] = __builtin_nontemporal_load((const f32x4*)(hin + (size_t)row * 128 + 4)); }
#pragma unroll
          for (int u = 0; u < 2; ++u) { const int row = (it + u) * 32 + prow; const float eall = SC2[256 + (row >> 6)];
              const f32x4 xw0 = *(const LAS f32x4*)(XWt + row * 8), xw1 = *(const LAS f32x4*)(XWt + row * 8 + 4);
              float hh[8], hn[8], yp[8];
#pragma unroll
              for (int j = 0; j < 4; ++j) { hh[j] = hv[u][0][j]; hh[4 + j] = hv[u][1][j]; }
#pragma unroll
              for (int j = 0; j < 8; ++j) hn[j] = eall * hh[j];
#pragma unroll
              for (int s = 0; s < 8; ++s) { const float xw = s < 4 ? xw0[s & 3] : xw1[s & 3]; float y = 0.f;
#pragma unroll
                  for (int j = 0; j < 8; ++j) { hn[j] += xw * Bn[s][j]; y += Cn[s][j] * hh[j]; }
                  yp[s] = y; }
              f32x4 o0 = {hn[0], hn[1], hn[2], hn[3]}, o1 = {hn[4], hn[5], hn[6], hn[7]};
              __builtin_nontemporal_store(o0, (f32x4*)(hout + (size_t)row * 128)); __builtin_nontemporal_store(o1, (f32x4*)(hout + (size_t)row * 128 + 4));
#pragma unroll
              for (int s = 0; s < 8; ++s) { float y = yp[s]; y += __shfl_xor(y, 1); y += __shfl_xor(y, 2); y += __shfl_xor(y, 4); y += __shfl_xor(y, 8); yp[s] = y; }
              if (n8 == 0) { *(LAS f32x4*)(YP + row * 8) = (f32x4){yp[0], yp[1], yp[2], yp[3]}; *(LAS f32x4*)(YP + row * 8 + 4) = (f32x4){yp[4], yp[5], yp[6], yp[7]}; } }
      } }
    __syncthreads();
    { const int row = tid, el = row >> 6, pp = row & 63, e = g * 8 + el; const float De = PIN(27)[e];
#pragma unroll
      for (int t = 0; t < 8; ++t) { const float cumt = SC2[el * 32 + t]; float y = SC2[el * 32 + 24 + t] * YP[row * 8 + t];
#pragma unroll
          for (int s = 0; s < 8; ++s) if (s <= t) y += CB[t * 8 + s] * expf(cumt - SC2[el * 32 + s]) * XDt[row * 8 + s];
          y += De * XF[t * 512 + row];
          YS[(size_t)(m0 + t) * 2048 + e * 64 + pp] = (bf16_t)(cvt_pk_bf16(y, 0.f) & 0xffffu); } }
}

#ifndef IT_MASK
#define IT_MASK 15
#endif
__device__ __forceinline__ void phase_mixer(Frame& F, const Params& p, const int itm = IT_MASK) {
    if (itm & 1) { for (int it = F.bx; it < 256; it += F.G) { const int x = it & 7, j = it >> 3, pair = x * 4 + (j >> 3); mlstm_prompt_item(F, p, pair >> 2, pair & 3, j & 7); } }
    if (itm & 2) { for (int it = F.bx; it < 256; it += F.G) { const int x = it & 7, j = it >> 3, grp = x * 4 + (j >> 3); ssd_prompt_item(F, p, grp >> 2, (grp & 3) * 8 + (j & 7)); } }
    if (itm & 4) { for (int it = F.bx; it < 4 * (NBS - NS_EARLY); it += F.G) mlstm_sample_item(F, p, NS_EARLY + (it >> 2), it & 3); }
    if (itm & 8) { for (int it = F.bx; it < 4 * (NBS - NS_EARLY); it += F.G) ssd_sample_item(F, p, NS_EARLY + (it >> 2), it & 3); }
}

__device__ __forceinline__ void phase_finish(Frame& F, const Params& p) {
    const bf16_t* Z = (const bf16_t*)(F.ws + WS_ZIN); const bf16_t* NUM = (const bf16_t*)(F.ws + WS_NUM); const bf16_t* YS = (const bf16_t*)(F.ws + WS_YS);
    const float* DEN = (const float*)(F.ws + WS_DEN); bf16_t* HA = (bf16_t*)(F.ws + WS_HA); bf16_t* HB = (bf16_t*)(F.ws + WS_HB);
    const float* hg = PIN(21); const float* sg = PIN(28);
    const int gwv = F.bx * 8 + F.wave, NGW = F.G * 8, lane = F.lane;
    for (int m = gwv; m < MT; m += NGW) {
#pragma unroll
        for (int h = 0; h < 4; ++h) {
            float x[8], o[8], gz[8]; unpack8(*(const u32x4*)(NUM + (size_t)m * 2048 + h * 512 + 8 * lane), x);
            float s = 0.f;
#pragma unroll
            for (int e = 0; e < 8; ++e) s += x[e];
            const float mu = wave_sum(s) * (1.0f / 512.0f); float q = 0.f;
#pragma unroll
            for (int e = 0; e < 8; ++e) { x[e] -= mu; q += x[e] * x[e]; }
            const float var = wave_sum(q) * (1.0f / 512.0f), Dv = DEN[(size_t)m * 4 + h];
            const float rs = 1.0f / sqrtf(var + EPS * Dv * Dv);
            unpack8(*(const u32x4*)(Z + (size_t)m * ZP + ZO + h * 512 + 8 * lane), gz);
            const f32x4 g0 = *(const f32x4*)(hg + h * 512 + 8 * lane), g1 = *(const f32x4*)(hg + h * 512 + 8 * lane + 4);
#pragma unroll
            for (int e = 0; e < 8; ++e) o[e] = x[e] * rs * (e < 4 ? g0[e & 3] : g1[e & 3]) * sigmoidf_(gz[e]);
            *(u32x4*)(m < MP ? HA + (size_t)m * 2048 + h * 512 + 8 * lane : HA + (size_t)MP * 2048 + fo_index(m - MP, h * 512 + 8 * lane, 2048)) = pack8(o, 1.0f);
        }
#pragma unroll
        for (int gq = 0; gq < 4; ++gq) {
            float y[8], zz[8]; unpack8(*(const u32x4*)(YS + (size_t)m * 2048 + gq * 512 + 8 * lane), y); unpack8(*(const u32x4*)(Z + (size_t)m * ZP + ZZ + gq * 512 + 8 * lane), zz);
            float q = 0.f;
#pragma unroll
            for (int e = 0; e < 8; ++e) { y[e] *= siluf_(zz[e]); q += y[e] * y[e]; }
            const float rs = 1.0f / sqrtf(wave_sum(q) * (1.0f / 512.0f) + EPS);
            const f32x4 g0 = *(const f32x4*)(sg + gq * 512 + 8 * lane), g1 = *(const f32x4*)(sg + gq * 512 + 8 * lane + 4);
#pragma unroll
            for (int e = 0; e < 8; ++e) y[e] = y[e] * rs * (e < 4 ? g0[e & 3] : g1[e & 3]);
            *(u32x4*)(m < MP ? HB + (size_t)m * 2048 + gq * 512 + 8 * lane : HB + (size_t)MP * 2048 + fo_index(m - MP, gq * 512 + 8 * lane, 2048)) = pack8(y, 1.0f);
        }
    }
    const int gt = F.bx * NTHREADS + F.tid, NGT = F.G * NTHREADS;
    constexpr int N1 = NBP * 3 * 2048, N2 = NBS * 3 * 2048, N3 = NBP * 3 * 3072, N4 = NBS * 3 * 3072;
    for (int i = gt; i < N1 + N2 + N3 + N4; i += NGT) {
        int j = i;
        if (j < N1) { const int b = j / 6144, r = (j / 2048) % 3, ch = j % 2048; F.out[O_PMC + j] = bf2f(Z[(size_t)(b * SEQ + SEQ - 3 + r) * ZP + ch]); continue; } j -= N1;
        if (j < N2) { const int b = j / 6144, r = (j / 2048) % 3, ch = j % 2048; F.out[O_SMC + j] = bf2f(Z[(size_t)(MP + b * TS + TS - 3 + r) * ZP + ch]); continue; } j -= N2;
        if (j < N3) { const int b = j / 9216, r = (j / 3072) % 3, ch = j % 3072; F.out[O_PSC + j] = bf2f(Z[(size_t)(b * SEQ + SEQ - 3 + r) * ZP + ZX + ch]); continue; } j -= N3;
        { const int b = j / 9216, r = (j / 3072) % 3, ch = j % 3072; F.out[O_SSC + j] = bf2f(Z[(size_t)(MP + b * TS + TS - 3 + r) * ZP + ZX + ch]); }
    }
}


#ifndef STAG_LEVELS
#define STAG_LEVELS 8
#endif
#ifndef STAG_SLEEP
#define STAG_SLEEP 16
#endif
__device__ __forceinline__ void stagger_start(const Frame& F) { const int sl = (F.bx >> 3) & (STAG_LEVELS - 1); for (int q = 0; q < sl; ++q) __builtin_amdgcn_s_sleep(STAG_SLEEP); }

constexpr int LDS_BYTES = 147456;
constexpr int NPHASE = 15;

__global__ void __launch_bounds__(NTHREADS, 2) fwd_kernel(Params p) {
    extern __shared__ __attribute__((aligned(16))) unsigned char lds_raw[];
    Frame F;
    F.lds = (LAS unsigned char*)lds_raw;
    F.tid = threadIdx.x; F.lane = F.tid & 63; F.wave = __builtin_amdgcn_readfirstlane(F.tid >> 6);
    F.G = gridDim.x; F.bx = blockIdx.x;
    F.out = p.out; F.ws = p.ws;
    unsigned char* ws = p.ws;
    bf16_t* U = (bf16_t*)(ws + WS_U); bf16_t* H = (bf16_t*)(ws + WS_H); float* X1 = (float*)(ws + WS_X1);
    bf16_t* ZIN = (bf16_t*)(ws + WS_ZIN); float* GATES = (float*)(ws + WS_GATES); float* MOD = (float*)(ws + WS_MOD);
    const int lo = p.ph_lo, hi = p.ph_hi;
#ifndef PH_MASK
#define PH_MASK 0xfffff
#endif
#define IN(k) (((PH_MASK >> (k)) & 1) && lo <= (k) && (k) < hi)
#ifndef DUP_MASK
#define DUP_MASK 0
#endif
#define DUP(k) ((DUP_MASK >> (k)) & 1)
    volatile LAS unsigned* MISC = (volatile LAS unsigned*)(F.lds + LDS_BYTES - 64);
    if (F.tid < 16) MISC[F.tid] = 0u;
    if (F.tid == 0) { volatile LAS unsigned* T = (volatile LAS unsigned*)(F.lds + PTAB_OFF);
#pragma unroll
        for (int k = 0; k < 36; ++k) { const uint64_t a = (uint64_t)p.in[k]; T[2 * k] = (unsigned)a; T[2 * k + 1] = (unsigned)(a >> 32); } }
    __syncthreads();
    XcdBarrier bar; bar.bar = (unsigned*)(ws + WS_CTL); bar.x = 0; bar.st = nullptr;
    if (hi - lo > 1) bar = xcd_barrier_post((unsigned*)(ws + WS_CTL), MISC);
#define SEAM(k) do { if (IN(k) && IN((k) + 1)) { xcd_barrier(bar); } } while (0)

    if (IN(0)) { phase_prep<0>(F, p); } SEAM(0);
    if (IN(1)) { phase_norm_mod(F, PIN(0), PIN(1), PIN(12), 0 * DM, 1 * DM, U); if (DUP(1)) phase_norm_mod(F, PIN(0), PIN(1), PIN(12), 0 * DM, 1 * DM, U); } SEAM(1);
    if (IN(2)) { pg8::Gemm g{U, U, (const bf16_t*)(ws + WS_WUP1), (const bf16_t*)(ws + WS_WUP1), DM}; pg8::Order S;
        if (F.bx < 192) { stagger_start(F); S.init_from(MT, 2 * DFF, 192, F.bx, 0, 1344); } else { phase_prep<1>(F, p); S.init_from(MT, 2 * DFF, 64, F.bx - 192, 1344, 1496); }
        pg8::EpiSwiGLU E{H}; pg8::gemm_phase(F.lds, g, S, E); if (DUP(2)) pg8::gemm_phase(F.lds, g, S, E); } SEAM(2);
    float* XS = (float*)(ws + WS_XS); unsigned* CNT = (unsigned*)(ws + WS_CTL) + CW_CNT; bf16_t* U2 = (bf16_t*)(ws + WS_U2);
    if (IN(3)) { stagger_start(F); pg8::Gemm g{H, H, (const bf16_t*)(ws + WS_WDN1), (const bf16_t*)(ws + WS_WDN1), DFF}; pg8::Order S; S.init(MP, DM, F.G, F.bx, 0);
        pg8::EpiResidNorm<false> E{PIN(0), X1, MOD + 2 * DM, PIN(16), MOD + 3 * DM, MOD + 4 * DM, U, nullptr, XS, CNT, 0.5f, 0}; pg8::gemm_phase(F.lds, g, S, E);
        small_phase_resid_norm<DFF, false>(F, H, (const bf16_t*)(ws + WS_FDN1), PIN(1), X1, MOD + 2 * DM, 0.5f, PIN(16), MOD + 3 * DM, MOD + 4 * DM, U, nullptr, XS, CNT); } SEAM(3);
    if (IN(5)) {
        const pg8::Gemm g{U, U, (const bf16_t*)(ws + WS_WIN), (const bf16_t*)(ws + WS_WIN), DM}; const pg8::EpiZin E{ZIN, GATES};
        { stagger_start(F); const pg8::OrderSample S{F.bx}; pg8::gemm_phase<pg8::EpiZin, true, pg8::OrderSample>(F.lds, g, S, E); }
        if (F.bx >= 208 && F.bx < 224) small_gates_tile(F, U, (const bf16_t*)(ws + WS_FG), GATES, MP / 64 + (F.bx - 208));
        if (F.bx >= 224) { for (int k = 0; k < 4; ++k) small_gates_tile(F, U, (const bf16_t*)(ws + WS_FG), GATES, 4 * (F.bx - 224) + k); }
        xcd_barrier(bar);
        if (F.bx >= 192) {
            const int s0 = F.bx - 192;
            for (int k = F.wave; k < 10; k += 8) conv_item(F, p, 5120 + 10 * s0 + k);
            asm volatile("s_waitcnt vmcnt(0)" ::: "memory"); __syncthreads(); __builtin_amdgcn_fence(__ATOMIC_ACQUIRE, "agent");
#pragma unroll 1
            for (int k = 0; k < 4; ++k) mlstm_sample_item(F, p, s0, k);
#pragma unroll 1
            for (int k = 0; k < 4; ++k) ssd_sample_item(F, p, s0, k);
            for (int k = 0; k < 2; ++k) small_gates_tile(F, U, (const bf16_t*)(ws + WS_FG), GATES, 128 + 2 * s0 + k);
        } else stagger_start(F);
        __syncthreads();
        { const pg8::OrderPrompt S{F.bx}; pg8::gemm_phase<pg8::EpiZin, true, pg8::OrderPrompt>(F.lds, g, S, E); }
        } SEAM(5);
    if (IN(6)) { phase_conv(F, p); if (DUP(6)) phase_conv(F, p); } SEAM(6);
    #ifndef DUP_IT
#define DUP_IT 15
#endif
    if (IN(7)) { phase_mixer(F, p, p.itm); } SEAM(7);
    if (IN(8)) { phase_finish(F, p); if (DUP(8)) phase_finish(F, p); } SEAM(8);
    if (IN(9)) { stagger_start(F); pg8::Gemm g{(const bf16_t*)(ws + WS_HA), (const bf16_t*)(ws + WS_HB), (const bf16_t*)(ws + WS_WPA), (const bf16_t*)(ws + WS_WPB), 2048}; pg8::Order S; S.init(MP, DM, F.G, F.bx, 1);
        pg8::EpiMerge E{ZIN, (float*)(ws + WS_TMP), U}; pg8::gemm_phase(F.lds, g, S, E);
        small_phase_merge(F, (const bf16_t*)(ws + WS_HA), (const bf16_t*)(ws + WS_HB), (const bf16_t*)(ws + WS_FPA), (const bf16_t*)(ws + WS_FPB), ZIN, U); } SEAM(9);
    if (IN(10)) { stagger_start(F); pg8::Gemm g{U, U, (const bf16_t*)(ws + WS_WOUT), (const bf16_t*)(ws + WS_WOUT), DM}; pg8::Order S; S.init(MP, DM, F.G, F.bx, 0);
        pg8::EpiResidNorm<false> E{X1, X1, MOD + 5 * DM, PIN(31), MOD + 6 * DM, MOD + 7 * DM, U2, nullptr, XS + (size_t)MT * 16, CNT + CNT_STRIDE, 1.0f, 0}; pg8::gemm_phase(F.lds, g, S, E);
        small_phase_resid_norm<DM, false>(F, U, (const bf16_t*)(ws + WS_FOUT), X1 + (size_t)MP * DM, X1, MOD + 5 * DM, 1.0f, PIN(31), MOD + 6 * DM, MOD + 7 * DM, U2, nullptr, XS + (size_t)MT * 16, CNT + CNT_STRIDE); } SEAM(10);
    if (IN(12)) { stagger_start(F); pg8::Gemm g{U2, U2, (const bf16_t*)(ws + WS_WUP2), (const bf16_t*)(ws + WS_WUP2), DM}; pg8::Order S; S.init(MT, 2 * DFF, F.G, F.bx, 0);
        pg8::EpiSwiGLU E{H}; pg8::gemm_phase(F.lds, g, S, E); } SEAM(12);
    if (IN(13)) { stagger_start(F); pg8::Gemm g{H, H, (const bf16_t*)(ws + WS_WDN2), (const bf16_t*)(ws + WS_WDN2), DFF}; pg8::Order S; S.init(MP, DM, F.G, F.bx, 0);
        pg8::EpiResidNorm<true> E{X1, nullptr, MOD + 8 * DM, PIN(35), nullptr, nullptr, nullptr, p.out, XS + (size_t)2 * MT * 16, CNT + 2 * CNT_STRIDE, 0.5f, 0}; pg8::gemm_phase(F.lds, g, S, E);
        small_phase_resid_norm<DFF, true>(F, H, (const bf16_t*)(ws + WS_FDN2), X1 + (size_t)MP * DM, nullptr, MOD + 8 * DM, 0.5f, PIN(35), nullptr, nullptr, nullptr, p.out, XS + (size_t)2 * MT * 16, CNT + 2 * CNT_STRIDE); }
#undef IN
#undef SEAM
}

extern "C" void kernel_launch(void* const* d_in, const int* in_sizes, int n_in, void* d_out, int out_size, void* d_ws, size_t ws_size, hipStream_t stream) {
    static int grid = 0;
    if (grid == 0) {
        if (n_in != 36 || ws_size < WS_END) { fprintf(stderr, "kernel_launch: expected 36 inputs and >= %zu bytes of workspace (got %d, %zu)\n", (size_t)WS_END, n_in, ws_size); grid = -1; return; }
        int dev = 0, cus = 0, per_cu = 0;
        hipGetDevice(&dev); hipDeviceGetAttribute(&cus, hipDeviceAttributeMultiprocessorCount, dev);
        hipFuncSetAttribute((const void*)fwd_kernel, hipFuncAttributeMaxDynamicSharedMemorySize, LDS_BYTES);
        hipOccupancyMaxActiveBlocksPerMultiprocessor(&per_cu, (const void*)fwd_kernel, NTHREADS, LDS_BYTES);
        if (per_cu < 1) { fprintf(stderr, "kernel_launch: occupancy query says %d blocks per CU\n", per_cu); grid = -1; return; }
        grid = cus;
        if (grid != 256) { fprintf(stderr, "kernel_launch: the fused-norm GEMM epilogues need exactly 256 workgroups (one 256x256 tile each); this device has %d CUs\n", cus); grid = -1; return; }
    }
    if (grid < 0) return;
    Params p{};
    for (int i = 0; i < 36; ++i) p.in[i] = (const float*)d_in[i];
    p.out = (float*)d_out; p.ws = (unsigned char*)d_ws; p.itm = 15;
#if MK_LAUNCH_PER_PHASE
    for (int ph = 0; ph < NPHASE; ++ph) { p.ph_lo = ph; p.ph_hi = ph + 1; hipLaunchKernelGGL(fwd_kernel, dim3(grid), dim3(NTHREADS), LDS_BYTES, stream, p); }
#else
    p.ph_lo = 0; p.ph_hi = NPHASE;
    if (hipMemsetAsync((char*)d_ws + WS_CTL, 0, 98304, stream) != hipSuccess) { fprintf(stderr, "kernel_launch: memset of the barrier words failed\n"); return; }
    void* args[] = {&p};
    hipError_t e = hipLaunchCooperativeKernel((const void*)fwd_kernel, dim3(grid), dim3(NTHREADS), args, LDS_BYTES, stream);
    if (e != hipSuccess) fprintf(stderr, "cooperative launch failed: %s (grid %d)\n", hipGetErrorString(e), grid);
#ifdef PROBE_PH
    for (int r = 0; r < PROBE_REPS; ++r) { Params q = p; q.ph_lo = PROBE_PH; q.ph_hi = PROBE_PH + 1; q.itm = PROBE_ITM; hipLaunchKernelGGL(fwd_kernel, dim3(grid), dim3(NTHREADS), LDS_BYTES, stream, q); }
#endif
#endif
}
```

```cpp
#include <hip/hip_runtime.h>
#include <hip/hip_cooperative_groups.h>
#include <cstdio>
#include <cstdint>
namespace cg = cooperative_groups;

#ifndef MK_LAUNCH_PER_PHASE
#define MK_LAUNCH_PER_PHASE 0
#endif

constexpr int DM = 1024, SEQ = 2048, NBP = 8, NBS = 128, TS = 8;
constexpr int MP = NBP * SEQ, MS = NBS * TS, MT = MP + MS, NBID = NBP + NBS;
constexpr int DFF = 2816, NMOD = 9 * DM;
constexpr int ZP = 13568;
constexpr int ZQ = 0, ZK = 1024, ZV = 2048, ZO = 4096, ZZ = 6144, ZX = 8192, ZGA = 11264, ZGB = 12288, ZG = 13312;
constexpr float EPS = 1e-6f;
constexpr int NTHREADS = 512;

constexpr size_t MiB = 1u << 20;
constexpr size_t WS_CTL = 0;
constexpr size_t WS_WUP1 = 1 * MiB;
constexpr size_t WS_WDN1 = WS_WUP1 + 11 * MiB;
constexpr size_t WS_WUP2 = WS_WDN1 + 6 * MiB;
constexpr size_t WS_WDN2 = WS_WUP2 + 11 * MiB;
constexpr size_t WS_WIN = WS_WDN2 + 6 * MiB;
constexpr size_t WS_WPA = WS_WIN + 27 * MiB;
constexpr size_t WS_WPB = WS_WPA + 4 * MiB;
constexpr size_t WS_WOUT = WS_WPB + 4 * MiB;
constexpr size_t WS_MOD = WS_WOUT + 2 * MiB;
constexpr size_t WS_U = WS_MOD + 5 * MiB;
constexpr size_t WS_H = WS_U + 34 * MiB;
constexpr size_t WS_X1 = WS_H + 94 * MiB;
constexpr size_t WS_ZIN = WS_X1 + 68 * MiB;
constexpr size_t WS_GATES = WS_ZIN + 451 * MiB;
constexpr size_t WS_YS = WS_GATES + 5 * MiB;
constexpr size_t WS_DEN = WS_YS + 68 * MiB;
constexpr size_t WS_HA = WS_DEN + 1 * MiB;
constexpr size_t WS_HB = WS_HA + 68 * MiB;
constexpr size_t WS_CV = WS_HA;
constexpr size_t WS_XS = WS_CV + 170 * MiB;
constexpr size_t WS_U2 = WS_ZIN;
constexpr size_t WS_FDN1 = WS_XS + 4 * MiB;
constexpr size_t WS_FDN2 = WS_FDN1 + 6 * MiB;
constexpr size_t WS_FPA = WS_FDN2 + 6 * MiB;
constexpr size_t WS_FPB = WS_FPA + 4 * MiB;
constexpr size_t WS_FOUT = WS_FPB + 4 * MiB;
constexpr size_t WS_FG = WS_FOUT + 2 * MiB;
constexpr size_t WS_END = WS_FG + 1 * MiB;
constexpr int CW_CNT = 4096, CNT_STRIDE = 5120;
constexpr size_t WS_NUM = WS_H;
constexpr size_t WS_TMP = WS_YS;
static_assert(WS_END <= 1024 * MiB, "workspace map");

#define LAS __attribute__((address_space(3)))
typedef unsigned short bf16_t;
typedef short bf16x8 __attribute__((ext_vector_type(8)));
typedef short s16x4 __attribute__((ext_vector_type(4)));
typedef float f32x4 __attribute__((ext_vector_type(4)));
typedef float f32x2 __attribute__((ext_vector_type(2)));
typedef unsigned u32x4 __attribute__((ext_vector_type(4)));
typedef unsigned u32x2 __attribute__((ext_vector_type(2)));

typedef __bf16 bf16x2_t __attribute__((ext_vector_type(2)));
__device__ __forceinline__ unsigned cvt_pk_bf16(float lo, float hi) { const bf16x2_t v = {(__bf16)lo, (__bf16)hi}; return __builtin_bit_cast(unsigned, v); }
__device__ __forceinline__ float bf2f(unsigned short b) { return __uint_as_float(((unsigned)b) << 16); }
__device__ __forceinline__ float bflo(unsigned w) { return __uint_as_float(w << 16); }
__device__ __forceinline__ float bfhi(unsigned w) { return __uint_as_float(w & 0xffff0000u); }
__device__ __forceinline__ float fast_exp(float x) { return __builtin_amdgcn_exp2f(x * 1.4426950408889634f); }
__device__ __forceinline__ float sigmoidf_(float x) { return __builtin_amdgcn_rcpf(1.0f + fast_exp(-x)); }
__device__ __forceinline__ float siluf_(float x) { return x * sigmoidf_(x); }
__device__ __forceinline__ u32x4 pack8(const float (&v)[8], float s) {
    u32x4 w; w.x = cvt_pk_bf16(v[0] * s, v[1] * s); w.y = cvt_pk_bf16(v[2] * s, v[3] * s); w.z = cvt_pk_bf16(v[4] * s, v[5] * s); w.w = cvt_pk_bf16(v[6] * s, v[7] * s); return w;
}
__device__ __forceinline__ u32x2 pack4(const f32x4 v) { u32x2 w; w.x = cvt_pk_bf16(v[0], v[1]); w.y = cvt_pk_bf16(v[2], v[3]); return w; }
__device__ __forceinline__ void unpack8(const u32x4 v, float (&x)[8]) { x[0] = bflo(v.x); x[1] = bfhi(v.x); x[2] = bflo(v.y); x[3] = bfhi(v.y); x[4] = bflo(v.z); x[5] = bfhi(v.z); x[6] = bflo(v.w); x[7] = bfhi(v.w); }
__device__ __forceinline__ size_t fo_index(int r, int k, int K) { return ((size_t)((r >> 4) * (K >> 5) + (k >> 5))) * 512 + (size_t)((((r & 15) + 16 * ((k >> 3) & 3)) << 3) + (k & 7)); }
__device__ __forceinline__ float wave_scan_add(float v) {
    v += __builtin_bit_cast(float, __builtin_amdgcn_update_dpp(0, __builtin_bit_cast(int, v), 0x111, 0xf, 0xf, true));
    v += __builtin_bit_cast(float, __builtin_amdgcn_update_dpp(0, __builtin_bit_cast(int, v), 0x112, 0xf, 0xf, true));
    v += __builtin_bit_cast(float, __builtin_amdgcn_update_dpp(0, __builtin_bit_cast(int, v), 0x114, 0xf, 0xf, true));
    v += __builtin_bit_cast(float, __builtin_amdgcn_update_dpp(0, __builtin_bit_cast(int, v), 0x118, 0xf, 0xf, true));
    v += __builtin_bit_cast(float, __builtin_amdgcn_update_dpp(0, __builtin_bit_cast(int, v), 0x142, 0xa, 0xf, true));
    v += __builtin_bit_cast(float, __builtin_amdgcn_update_dpp(0, __builtin_bit_cast(int, v), 0x143, 0xc, 0xf, true));
    return v;
}
__device__ __forceinline__ float wave_scan_max(float v) {
    const int ninf = (int)0xff800000u;
    v = fmaxf(v, __builtin_bit_cast(float, __builtin_amdgcn_update_dpp(ninf, __builtin_bit_cast(int, v), 0x111, 0xf, 0xf, false)));
    v = fmaxf(v, __builtin_bit_cast(float, __builtin_amdgcn_update_dpp(ninf, __builtin_bit_cast(int, v), 0x112, 0xf, 0xf, false)));
    v = fmaxf(v, __builtin_bit_cast(float, __builtin_amdgcn_update_dpp(ninf, __builtin_bit_cast(int, v), 0x114, 0xf, 0xf, false)));
    v = fmaxf(v, __builtin_bit_cast(float, __builtin_amdgcn_update_dpp(ninf, __builtin_bit_cast(int, v), 0x118, 0xf, 0xf, false)));
    v = fmaxf(v, __builtin_bit_cast(float, __builtin_amdgcn_update_dpp(ninf, __builtin_bit_cast(int, v), 0x142, 0xa, 0xf, false)));
    v = fmaxf(v, __builtin_bit_cast(float, __builtin_amdgcn_update_dpp(ninf, __builtin_bit_cast(int, v), 0x143, 0xc, 0xf, false)));
    return v;
}
__device__ __forceinline__ float wave_sum(float v) { return __builtin_bit_cast(float, __builtin_amdgcn_readlane(__builtin_bit_cast(int, wave_scan_add(v)), 63)); }

struct Params {
    const float* in[36];
    float* out;
    unsigned char* ws;
    int ph_lo, ph_hi, itm, pad;
};

namespace pg8 {
constexpr int BM = 256, BK = 64, HALF = 128, HTB = HALF * BK * 2, STAGE_BYTES = 8 * HTB, NXCD = 8, WGM = 8;
__host__ __device__ __forceinline__ int lds_byte(int r, int c) { const int st = (r >> 4) * 2 + (c >> 5), rr = r & 15, cc = c & 31, ob = rr * 64 + cc * 2; return st * 1024 + (ob ^ (((ob >> 9) & 1) << 5)); }
__host__ __device__ __forceinline__ void stage_rc(int b, int& R, int& C) { const int st = b / 1024, sb = b % 1024, swz = sb ^ (((sb >> 9) & 1) << 5); R = (st >> 1) * 16 + swz / 64; C = (st & 1) * 32 + (swz % 64) / 2; }
__host__ __device__ __forceinline__ int perm32(int rho) { const int n = rho >> 4, i = rho & 15; return 8 * (i >> 2) + 4 * n + (i & 3); }

struct Unit { int pm, pn, w; };
struct Gemm { const bf16_t* A0; const bf16_t* A1; const bf16_t* B0; const bf16_t* B1; int K; };

struct OrderSample { int c;
    __device__ bool next(int i, Unit& u) const { if (i > 0 || c >= 208) return false; const int x = c & 7, j = c >> 3; u.pm = 64 + (x >> 1); u.pn = (x & 1) * 26 + j; u.w = 0; return true; } };
struct OrderPrompt { int c;
    __device__ bool next(int i, Unit& u) const { const int x = c & 7, j = c >> 3; int q; if (j < 24) { if (i >= 17) return false; q = i * 24 + j; } else { if (i >= 1) return false; q = 408 + (j - 24); }
        u.pm = 8 * x + (q & 7); u.pn = q >> 3; u.w = 0; return true; } };
struct Order {
    int nM, nN, nwg, G, c, dual;
    __device__ void init(int M, int N, int G_, int c_, int dual_) { nM = M / BM; nN = N / BM; nwg = nM * nN; G = G_; c = c_; dual = dual_; }
    __device__ void init_from(int M, int N, int G_, int c_, int first, int lim) { nM = M / BM; nN = N / BM; nwg = lim; G = G_; c = first + c_; dual = 0; }
    __device__ bool next(int i, Unit& u) const {
        const int ti = dual ? (i >> 1) : i;
        const long L = (long)ti * G + c; if (L >= nwg) return false;
        int wgid = (int)L; { const int tot = nM * nN, q = tot / NXCD, r = tot % NXCD, xcd = wgid % NXCD, off = wgid / NXCD; wgid = (xcd < r ? xcd * (q + 1) : r * (q + 1) + (xcd - r) * q) + off; }
        const int nig = WGM * nN, gid = wgid / nig, fm = gid * WGM, gsz = (nM - fm) < WGM ? (nM - fm) : WGM;
        u.pm = fm + ((wgid % nig) % gsz); u.pn = (wgid % nig) / gsz; u.w = dual ? (i & 1) : 0; return true;
    }
};

template <class Epi, bool ALIGN_EPI = true, class Ord = Order>
__device__ __forceinline__ void gemm_phase(LAS unsigned char* lds, const Gemm g, const Ord& S, const Epi E) {
    const int tid = threadIdx.x, wid = __builtin_amdgcn_readfirstlane(tid >> 6), lane = tid & 63, wr = wid >> 2, wc = wid & 3, fr = lane & 15, fq = lane >> 4;
    const int K = g.K, nt = K / BK;
    unsigned voffA[2], voffB[2];
#pragma unroll
    for (int i = 0; i < 2; ++i) { int R, C; stage_rc(tid * 16 + i * 8192, R, C); const int Rb = Epi::PERM ? ((R & ~31) + perm32(R & 31)) : R;
        voffA[i] = (unsigned)(R * K + C) * 2u; voffB[i] = (unsigned)(Rb * K + C) * 2u; }
    const size_t kstep = (size_t)(BK * 2);
    const size_t hstep = (size_t)HALF * K * 2;
    const size_t tstep = 2 * hstep;
    const unsigned ldsw = (unsigned)wid * 1024u;
    const int aoff = lds_byte(wr * 64 + fr, fq * 8), boff = lds_byte(wc * 32 + fr, fq * 8);
#define PG8_SA(b, h) (((b) * 2 + (h)) * HTB)
#define PG8_SB(b, h) ((4 + (b) * 2 + (h)) * HTB)
#define PG8_STAGE(bufoff, gbase, voff) do { _Pragma("unroll") for (int _i = 0; _i < 2; ++_i) \
        __builtin_amdgcn_global_load_lds((const unsigned*)((const char*)(gbase) + (voff)[_i]), (LAS unsigned*)(lds + (bufoff) + ldsw + _i * 8192), 16, 0, 0); } while (0)
#define PG8_LDA(dst, b, h) do { _Pragma("unroll") for (int m = 0; m < 4; ++m) _Pragma("unroll") for (int k = 0; k < 2; ++k) dst[m][k] = *(const LAS bf16x8*)(lds + PG8_SA(b, h) + aoff + m * 2048 + k * 1024); } while (0)
#define PG8_LDB(dst, b, h) do { _Pragma("unroll") for (int n = 0; n < 2; ++n) _Pragma("unroll") for (int k = 0; k < 2; ++k) dst[n][k] = *(const LAS bf16x8*)(lds + PG8_SB(b, h) + boff + n * 2048 + k * 1024); } while (0)
#define PG8_MMA(ai, bj, At, Bt) do { __builtin_amdgcn_s_setprio(1); _Pragma("unroll") for (int m = 0; m < 4; ++m) _Pragma("unroll") for (int n = 0; n < 2; ++n) _Pragma("unroll") for (int k = 0; k < 2; ++k) \
        acc[ai][bj][m][n] = __builtin_amdgcn_mfma_f32_16x16x32_bf16(Bt[n][k], At[m][k], acc[ai][bj][m][n], 0, 0, 0); __builtin_amdgcn_s_setprio(0); } while (0)
#define PG8_WAIT_V(n) asm volatile("s_waitcnt vmcnt(" #n ")" ::: "memory")
#define PG8_WAIT_L(n) asm volatile("s_waitcnt lgkmcnt(" #n ")" ::: "memory")
#define PG8_BAR __builtin_amdgcn_s_barrier()
#define PG8_SCHED __builtin_amdgcn_sched_barrier(0)
    Unit cur, nxt; int ui = 0;
    if (!S.next(0, cur)) return;
    f32x4 acc[2][2][4][2];
#pragma unroll
    for (int a = 0; a < 2; ++a)
#pragma unroll
        for (int b = 0; b < 2; ++b)
#pragma unroll
            for (int m = 0; m < 4; ++m)
#pragma unroll
                for (int n = 0; n < 2; ++n) acc[a][b][m][n] = (f32x4){0.f, 0.f, 0.f, 0.f};
    bf16x8 At[4][2], B0[2][2], B1[2][2];
    const char* cA = (const char*)(cur.w ? g.A1 : g.A0) + (size_t)cur.pm * tstep; const char* cB = (const char*)(cur.w ? g.B1 : g.B0) + (size_t)cur.pn * tstep;
    PG8_STAGE(PG8_SB(0, 0), cB, voffB); PG8_STAGE(PG8_SB(0, 1), cB + hstep, voffB); PG8_STAGE(PG8_SA(0, 0), cA, voffA); PG8_STAGE(PG8_SA(0, 1), cA + hstep, voffA);
    if (wr == 1) PG8_BAR;
    PG8_WAIT_V(2); PG8_BAR;
    PG8_STAGE(PG8_SB(1, 0), cB + kstep, voffB); PG8_STAGE(PG8_SA(1, 0), cA + kstep, voffA); PG8_STAGE(PG8_SB(1, 1), cB + hstep + kstep, voffB);
    PG8_WAIT_V(6); PG8_BAR;
    for (;;) {
        const bool has_next = S.next(ui + 1, nxt);
        const char* nA = has_next ? (const char*)(nxt.w ? g.A1 : g.A0) + (size_t)nxt.pm * tstep : cA; const char* nB = has_next ? (const char*)(nxt.w ? g.B1 : g.B0) + (size_t)nxt.pn * tstep : cB;
        for (int t = 0; t < nt; t += 2) {
            const bool last = (t == nt - 2);
            const char* a1 = cA + (size_t)(t + 1) * kstep;
            const char* a2 = last ? nA : cA + (size_t)(t + 2) * kstep; const char* b2 = last ? nB : cB + (size_t)(t + 2) * kstep;
            const char* a3 = a2 + kstep; const char* b3 = b2 + kstep;
            PG8_LDB(B0, 0, 0); PG8_LDB(B1, 0, 1); PG8_SCHED; PG8_LDA(At, 0, 0); PG8_STAGE(PG8_SA(1, 1), a1 + hstep, voffA);
            PG8_WAIT_V(8); PG8_WAIT_L(0); PG8_BAR; PG8_MMA(0, 0, At, B0); PG8_MMA(0, 1, At, B1); PG8_BAR; PG8_SCHED;
            PG8_LDA(At, 0, 1); PG8_STAGE(PG8_SB(0, 0), b2, voffB); PG8_STAGE(PG8_SB(0, 1), b2 + hstep, voffB); PG8_STAGE(PG8_SA(0, 0), a2, voffA);
            PG8_WAIT_V(8); PG8_WAIT_L(0); PG8_BAR; PG8_MMA(1, 0, At, B0); PG8_MMA(1, 1, At, B1); PG8_BAR; PG8_SCHED;
            PG8_LDB(B0, 1, 0); PG8_LDB(B1, 1, 1); PG8_SCHED; PG8_LDA(At, 1, 0); PG8_STAGE(PG8_SA(0, 1), a2 + hstep, voffA);
            PG8_WAIT_V(8); PG8_WAIT_L(0); PG8_BAR; PG8_MMA(0, 0, At, B0); PG8_MMA(0, 1, At, B1); PG8_BAR; PG8_SCHED;
            PG8_LDA(At, 1, 1); PG8_STAGE(PG8_SB(1, 0), b3, voffB); PG8_STAGE(PG8_SB(1, 1), b3 + hstep, voffB); PG8_STAGE(PG8_SA(1, 0), a3, voffA);
            PG8_WAIT_V(8); PG8_WAIT_L(0); PG8_BAR; PG8_MMA(1, 0, At, B0); PG8_MMA(1, 1, At, B1); PG8_BAR; PG8_SCHED;
        }
        if constexpr (ALIGN_EPI) { if (wr == 0) PG8_BAR; }
        if constexpr (!Epi::AFTER_DRAIN) E(acc, cur, wr, wc, fr, fq);
        if (!has_next) break;
#pragma unroll
        for (int a = 0; a < 2; ++a)
#pragma unroll
            for (int b = 0; b < 2; ++b)
#pragma unroll
                for (int m = 0; m < 4; ++m)
#pragma unroll
                    for (int n = 0; n < 2; ++n) acc[a][b][m][n] = (f32x4){0.f, 0.f, 0.f, 0.f};
        cur = nxt; cA = nA; cB = nB; ++ui;
        if constexpr (ALIGN_EPI) { if (wr == 1) PG8_BAR; }
    }
    PG8_WAIT_V(0);
    if constexpr (!ALIGN_EPI) { if (wr == 0) PG8_BAR; }
    PG8_BAR;
    if constexpr (Epi::AFTER_DRAIN) E.fused(acc, cur, wr, wc, fr, fq, lds, wid, lane);
#undef PG8_SA
#undef PG8_SB
#undef PG8_STAGE
#undef PG8_LDA
#undef PG8_LDB
#undef PG8_MMA
#undef PG8_WAIT_V
#undef PG8_WAIT_L
#undef PG8_BAR
#undef PG8_SCHED
}

__device__ __forceinline__ int bid_of_row(int row) { return row < MP ? (row >> 11) : (NBP + ((row - MP) >> 3)); }

struct EpiSwiGLU {
    static constexpr bool PERM = true, AFTER_DRAIN = false;
    bf16_t* H;
    __device__ __forceinline__ void operator()(const f32x4 (&acc)[2][2][4][2], const Unit& u, int wr, int wc, int fr, int fq) const {
        const int row0 = u.pm * BM + wr * 64 + fr, hc0 = u.pn * 128 + wc * 32 + 8 * fq;
#pragma unroll
        for (int ai = 0; ai < 2; ++ai)
#pragma unroll
            for (int m = 0; m < 4; ++m) { const f32x4 a0 = acc[ai][0][m][0], a1 = acc[ai][0][m][1], b0 = acc[ai][1][m][0], b1 = acc[ai][1][m][1];
                u32x4 w; w.x = cvt_pk_bf16(siluf_(a0[0]) * b0[0], siluf_(a0[1]) * b0[1]); w.y = cvt_pk_bf16(siluf_(a0[2]) * b0[2], siluf_(a0[3]) * b0[3]);
                w.z = cvt_pk_bf16(siluf_(a1[0]) * b1[0], siluf_(a1[1]) * b1[1]); w.w = cvt_pk_bf16(siluf_(a1[2]) * b1[2], siluf_(a1[3]) * b1[3]);
                const int row = row0 + ai * HALF + m * 16;
                if (u.pm < MP / BM) *(u32x4*)(H + (size_t)row * DFF + hc0) = w;
                else *(u32x4*)(H + (size_t)MP * DFF + fo_index(row - MP, hc0, DFF)) = w; }
    }
};
struct EpiResid {
    static constexpr bool PERM = false, AFTER_DRAIN = false;
    const float* xin_p; const float* xin_s; float* out; const float* gmod; float coef;
    __device__ __forceinline__ void operator()(const f32x4 (&acc)[2][2][4][2], const Unit& u, int wr, int wc, int fr, int fq) const {
        const int row0 = u.pm * BM + wr * 64 + fr, col0 = u.pn * BM + wc * 32 + 4 * fq;
#pragma unroll
        for (int ai = 0; ai < 2; ++ai)
#pragma unroll
            for (int m = 0; m < 4; ++m) { const int row = row0 + ai * HALF + m * 16;
                const float* xr = (row < MP ? xin_p + (size_t)row * DM : xin_s + (size_t)(row - MP) * DM) + col0;
                const float* gr = gmod + (size_t)bid_of_row(row) * NMOD + col0; float* orow = out + (size_t)row * DM + col0;
#pragma unroll
                for (int bj = 0; bj < 2; ++bj)
#pragma unroll
                    for (int n = 0; n < 2; ++n) { const int o = bj * HALF + n * 16; const f32x4 xv = *(const f32x4*)(xr + o), gv = *(const f32x4*)(gr + o);
                        *(f32x4*)(orow + o) = xv + coef * gv * acc[ai][bj][m][n]; } }
    }
};

__device__ __forceinline__ void panel_wait(unsigned* cnt, unsigned need) {
    unsigned spins = 0;
    while ((unsigned)__builtin_amdgcn_readfirstlane(__hip_atomic_load(cnt, __ATOMIC_RELAXED, __HIP_MEMORY_SCOPE_AGENT)) < need) { if (++spins > (1u << 20)) break; __builtin_amdgcn_s_sleep(2); }
    __builtin_amdgcn_fence(__ATOMIC_ACQUIRE, "agent");
}
template <bool FINAL>
struct EpiResidNorm {
    static constexpr bool PERM = false, AFTER_DRAIN = true;
    const float* xin; float* Xout; const float* gmod; const float* gw; const float* shmod; const float* scmod; bf16_t* Uout; float* Yout; float* XS; unsigned* cnt; float coef; int pad_;
    __device__ __forceinline__ void fused(f32x4 (&acc)[2][2][4][2], const Unit& u, int wr, int wc, int fr, int fq, LAS unsigned char* lds, int wid, int lane) const {
        LAS float* P = (LAS float*)lds; LAS float* S = (LAS float*)(lds + 4096);
        const float* const xin_ = xin; float* const Xout_ = Xout; const float* const gmod_ = gmod; const float coef_ = coef; const float* const gw_ = gw; const float* const shmod_ = shmod; const float* const scmod_ = scmod;
        bf16_t* const Uout_ = Uout; float* const Yout_ = Yout; float* const XS_ = XS; unsigned* const cnt_ = cnt;
        const int b = u.pm >> 3, col0 = u.pn * BM + wc * 32 + 4 * fq, rowt = wr * 64 + fr;
        { f32x4 gv[2][2];
#pragma unroll
          for (int bj = 0; bj < 2; ++bj)
#pragma unroll
              for (int n = 0; n < 2; ++n) gv[bj][n] = coef_ * *(const f32x4*)(gmod_ + (size_t)b * NMOD + col0 + bj * HALF + n * 16);
#pragma unroll
          for (int ai = 0; ai < 2; ++ai)
#pragma unroll
              for (int m = 0; m < 4; ++m) { const int rt = rowt + ai * HALF + m * 16; const float* xr = xin_ + (size_t)(u.pm * BM + rt) * DM + col0; float ss = 0.f;
#pragma unroll
                  for (int bj = 0; bj < 2; ++bj)
#pragma unroll
                      for (int n = 0; n < 2; ++n) { const f32x4 x = *(const f32x4*)(xr + bj * HALF + n * 16) + gv[bj][n] * acc[ai][bj][m][n]; acc[ai][bj][m][n] = x; ss += (x[0] * x[0] + x[1] * x[1]) + (x[2] * x[2] + x[3] * x[3]); }
                  ss += __shfl_xor(ss, 16); ss += __shfl_xor(ss, 32);
                  if (fq == 0) P[rt * 4 + wc] = ss;
                  asm volatile("" ::: "memory"); } }
        __syncthreads();
        const int r32 = wid * 32 + (lane & 31); float* slot = XS_ + (size_t)(u.pm * BM + r32) * 16;
        if (lane < 32) { const f32x4 pp = *(const LAS f32x4*)(P + r32 * 4); __hip_atomic_store(slot + u.pn, (pp[0] + pp[1]) + (pp[2] + pp[3]), __ATOMIC_RELAXED, __HIP_MEMORY_SCOPE_AGENT); }
        asm volatile("s_waitcnt vmcnt(0)" ::: "memory");
        if (lane == 0) __hip_atomic_fetch_add(cnt_ + 64 * u.pm, 1u, __ATOMIC_RELAXED, __HIP_MEMORY_SCOPE_AGENT);
        if (wid == 0) panel_wait(cnt_ + 64 * u.pm, 32u);
        asm volatile("s_waitcnt vmcnt(0) lgkmcnt(0)" ::: "memory");
        __syncthreads();
        if (lane < 32) { float tot = 0.f;
#pragma unroll
            for (int t = 0; t < 4; ++t) tot += __hip_atomic_load(slot + t, __ATOMIC_RELAXED, __HIP_MEMORY_SCOPE_AGENT);
            S[r32] = 1.0f / sqrtf(tot * (1.0f / DM) + EPS); }
        __syncthreads();
        f32x4 fac[2][2], shv[2][2];
#pragma unroll
        for (int bj = 0; bj < 2; ++bj)
#pragma unroll
            for (int n = 0; n < 2; ++n) { const int c = col0 + bj * HALF + n * 16; fac[bj][n] = *(const f32x4*)(gw_ + c);
                if constexpr (!FINAL) { fac[bj][n] = fac[bj][n] * (1.0f + *(const f32x4*)(scmod_ + (size_t)b * NMOD + c)); shv[bj][n] = *(const f32x4*)(shmod_ + (size_t)b * NMOD + c); } }
#pragma unroll
        for (int ai = 0; ai < 2; ++ai)
#pragma unroll
            for (int m = 0; m < 4; ++m) { const int rt = rowt + ai * HALF + m * 16; const size_t off = (size_t)(u.pm * BM + rt) * DM + col0; const float r = S[rt];
#pragma unroll
                for (int bj = 0; bj < 2; ++bj)
#pragma unroll
                    for (int n = 0; n < 2; ++n) { const f32x4 x = acc[ai][bj][m][n]; const int o = bj * HALF + n * 16;
                        if constexpr (FINAL) *(f32x4*)(Yout_ + off + o) = x * r * fac[bj][n];
                        else { *(f32x4*)(Xout_ + off + o) = x; *(u32x2*)(Uout_ + off + o) = pack4(x * r * fac[bj][n] + shv[bj][n]); } } }
    }
};
struct EpiZin {
    static constexpr bool PERM = true, AFTER_DRAIN = false;
    bf16_t* Z; float* gates;
    __device__ __forceinline__ void operator()(const f32x4 (&acc)[2][2][4][2], const Unit& u, int wr, int wc, int fr, int fq) const {
        const int row0 = u.pm * BM + wr * 64 + fr;
        {
            const int col0 = u.pn * BM + wc * 32 + 8 * fq;
#pragma unroll
            for (int ai = 0; ai < 2; ++ai)
#pragma unroll
                for (int m = 0; m < 4; ++m) { bf16_t* rp = Z + (size_t)(row0 + ai * HALF + m * 16) * ZP + col0;
#pragma unroll
                    for (int bj = 0; bj < 2; ++bj) { const f32x4 v0 = acc[ai][bj][m][0], v1 = acc[ai][bj][m][1];
                        u32x4 w; w.x = cvt_pk_bf16(v0[0], v0[1]); w.y = cvt_pk_bf16(v0[2], v0[3]); w.z = cvt_pk_bf16(v1[0], v1[1]); w.w = cvt_pk_bf16(v1[2], v1[3]);
                        *(u32x4*)(rp + bj * HALF) = w; } }
        }
    }
};
struct EpiMerge {
    static constexpr bool PERM = true, AFTER_DRAIN = false;
    const bf16_t* Z; float* tmp; bf16_t* U;
    __device__ __forceinline__ void operator()(const f32x4 (&acc)[2][2][4][2], const Unit& u, int wr, int wc, int fr, int fq) const {
        const int row0 = u.pm * BM + wr * 64 + fr, col0 = u.pn * BM + wc * 32 + 8 * fq;
        const int zoff = u.w ? ZGB : ZGA;
#pragma unroll
        for (int ai = 0; ai < 2; ++ai)
#pragma unroll
            for (int m = 0; m < 4; ++m) { const int row = row0 + ai * HALF + m * 16;
#pragma unroll
                for (int bj = 0; bj < 2; ++bj) { const int c = col0 + bj * HALF;
                    const u32x4 gz = *(const u32x4*)(Z + (size_t)row * ZP + zoff + c);
                    f32x4 s0, s1; s0[0] = sigmoidf_(bflo(gz.x)); s0[1] = sigmoidf_(bfhi(gz.x)); s0[2] = sigmoidf_(bflo(gz.y)); s0[3] = sigmoidf_(bfhi(gz.y));
                    s1[0] = sigmoidf_(bflo(gz.z)); s1[1] = sigmoidf_(bfhi(gz.z)); s1[2] = sigmoidf_(bflo(gz.w)); s1[3] = sigmoidf_(bfhi(gz.w));
                    f32x4 v0 = s0 * acc[ai][bj][m][0], v1 = s1 * acc[ai][bj][m][1];
                    u32x4* up = (u32x4*)(U + (size_t)row * DM + c);
                    if (u.w != 0) { const u32x4 pv = *up; v0[0] += bflo(pv.x); v0[1] += bfhi(pv.x); v0[2] += bflo(pv.y); v0[3] += bfhi(pv.y); v1[0] += bflo(pv.z); v1[1] += bfhi(pv.z); v1[2] += bflo(pv.w); v1[3] += bfhi(pv.w); }
                    u32x4 w; w.x = cvt_pk_bf16(v0[0], v0[1]); w.y = cvt_pk_bf16(v0[2], v0[3]); w.z = cvt_pk_bf16(v1[0], v1[1]); w.w = cvt_pk_bf16(v1[2], v1[3]);
                    *up = w; } }
    }
};
}


struct Frame {
    LAS unsigned char* lds;
    int tid, lane, wave, G, bx;
    float* out; unsigned char* ws;
};
constexpr int PTAB_OFF = 147072;
__device__ __forceinline__ const float* pin_ld(const Frame& F, const int k) {
    const volatile LAS unsigned* T = (const volatile LAS unsigned*)(F.lds + PTAB_OFF);
    const unsigned lo = (unsigned)__builtin_amdgcn_readfirstlane((int)T[2 * k]), hi = (unsigned)__builtin_amdgcn_readfirstlane((int)T[2 * k + 1]);
    return (const float*)(((uint64_t)hi << 32) | (uint64_t)lo);
}
#define PIN(k) pin_ld(F, (k))

template <int KTOT, bool FOA, bool FOB>
__device__ __forceinline__ void small_gemm_partials(LAS unsigned char* lds, const bf16_t* A, const bf16_t* Bt, int wave, int lane) {
    const int fr = lane & 15, fq = lane >> 4; constexpr int NKS = KTOT / 256; const int T0 = wave * NKS;
    const bf16_t* ap = A + (size_t)fr * KTOT + 8 * fq; const bf16_t* bp = Bt + (size_t)fr * KTOT + 8 * fq;
    f32x4 acc[4][4];
#pragma unroll
    for (int i = 0; i < 4; ++i)
#pragma unroll
        for (int j = 0; j < 4; ++j) acc[i][j] = (f32x4){0.f, 0.f, 0.f, 0.f};
    bf16x8 a[4][4], b[4][4];
#define SG_LOAD(slot, t) do { const int T_ = T0 + (t), ko_ = 32 * T_; _Pragma("unroll") for (int i = 0; i < 4; ++i) { \
        if constexpr (FOA) a[slot][i] = *(const bf16x8*)(A + ((size_t)(i * (KTOT / 32) + T_)) * 512 + 8 * lane); else a[slot][i] = *(const bf16x8*)(ap + (size_t)(16 * i) * KTOT + ko_); \
        if constexpr (FOB) b[slot][i] = *(const bf16x8*)(Bt + ((size_t)(i * (KTOT / 32) + T_)) * 512 + 8 * lane); else b[slot][i] = *(const bf16x8*)(bp + (size_t)(16 * i) * KTOT + ko_); } } while (0)
#pragma unroll
    for (int t = 0; t < 4 && t < NKS; ++t) SG_LOAD(t, t);
    __builtin_amdgcn_sched_barrier(0);
#pragma unroll
    for (int t = 0; t < NKS; ++t) {
#pragma unroll
        for (int tn = 0; tn < 4; ++tn)
#pragma unroll
            for (int tm = 0; tm < 4; ++tm) acc[tn][tm] = __builtin_amdgcn_mfma_f32_16x16x32_bf16(b[t & 3][tn], a[t & 3][tm], acc[tn][tm], 0, 0, 0);
        __builtin_amdgcn_sched_barrier(0);
        if (t + 4 < NKS) { SG_LOAD(t & 3, t + 4); __builtin_amdgcn_sched_barrier(0); } }
#undef SG_LOAD
    LAS f32x4* PART = (LAS f32x4*)lds;
#pragma unroll
    for (int tn = 0; tn < 4; ++tn)
#pragma unroll
        for (int tm = 0; tm < 4; ++tm) PART[(wave * 16 + tn * 4 + tm) * 64 + lane] = acc[tn][tm];
}
__device__ __forceinline__ f32x4 small_gemm_sum(LAS unsigned char* lds, int tid, int j) {
    const LAS f32x4* PART = (const LAS f32x4*)lds; const int tile = 8 * j + (tid >> 6), ln = tid & 63; f32x4 sum = PART[tile * 64 + ln];
#pragma unroll
    for (int wv = 1; wv < 8; ++wv) sum += PART[(wv * 16 + tile) * 64 + ln];
    return sum;
}
template <int KTOT>
__device__ __forceinline__ void small_phase_resid(Frame& F, const bf16_t* A, const bf16_t* Bt, const float* xin_s, float* out, const float* gmod, float coef) {
    for (int st = F.bx; st < 256; st += F.G) { const int x = st & 7, j = st >> 3, sm = 4 * (x >> 1) + (j >> 3), sn = 8 * (x & 1) + (j & 7);
        __syncthreads();
        small_gemm_partials<KTOT, true, true>(F.lds, A + (size_t)(MP + 64 * sm) * KTOT, Bt + (size_t)(64 * sn) * KTOT, F.wave, F.lane);
        __syncthreads();
#pragma unroll
        for (int j = 0; j < 2; ++j) { const f32x4 v = small_gemm_sum(F.lds, F.tid, j); const int tile = 8 * j + (F.tid >> 6), tn = tile >> 2, tm = tile & 3;
            const int ms = 64 * sm + 16 * tm + (F.lane & 15), n = 64 * sn + 16 * tn + 4 * (F.lane >> 4), row = MP + ms;
            const f32x4 xv = *(const f32x4*)(xin_s + (size_t)ms * DM + n), gv = *(const f32x4*)(gmod + (size_t)pg8::bid_of_row(row) * NMOD + n);
            *(f32x4*)(out + (size_t)row * DM + n) = xv + coef * gv * v; } }
}
template <int KTOT, bool FINAL>
__device__ __forceinline__ void small_phase_resid_norm(Frame& F, const bf16_t* A, const bf16_t* Bt, const float* xin_s, float* Xout, const float* gmod, float coef,
                                                       const float* gw, const float* shmod, const float* scmod, bf16_t* Uout, float* Yout, float* XS, unsigned* cnt) {
    LAS float* P2 = (LAS float*)(F.lds + 131072); LAS float* S2 = (LAS float*)(F.lds + 131072 + 512);
    for (int st = F.bx; st < 256; st += F.G) { const int x = st & 7, j0 = st >> 3, sm = 4 * (x >> 1) + (j0 >> 3), sn = 8 * (x & 1) + (j0 & 7);
        __syncthreads();
        small_gemm_partials<KTOT, true, true>(F.lds, A + (size_t)(MP + 64 * sm) * KTOT, Bt + (size_t)(64 * sn) * KTOT, F.wave, F.lane);
        __syncthreads();
        const int fr = F.lane & 15, fq = F.lane >> 4, tm = F.wave & 3, rl = 16 * tm + fr, ms = 64 * sm + rl, row = MP + ms, bid = NBP + (ms >> 3);
        f32x4 xn[2]; float ss = 0.f;
#pragma unroll
        for (int j = 0; j < 2; ++j) { const int n = 64 * sn + 16 * (2 * j + (F.wave >> 2)) + 4 * fq;
            const f32x4 x4 = *(const f32x4*)(xin_s + (size_t)ms * DM + n) + coef * *(const f32x4*)(gmod + (size_t)bid * NMOD + n) * small_gemm_sum(F.lds, F.tid, j);
            xn[j] = x4; ss += (x4[0] * x4[0] + x4[1] * x4[1]) + (x4[2] * x4[2] + x4[3] * x4[3]); }
        ss += __shfl_xor(ss, 16); ss += __shfl_xor(ss, 32);
        if (fq == 0) P2[(F.wave >> 2) * 64 + rl] = ss;
        __syncthreads();
        float* slot = XS + (size_t)(MP + 64 * sm + F.lane) * 16;
        if (F.wave == 0) { __hip_atomic_store(slot + sn, P2[F.lane] + P2[64 + F.lane], __ATOMIC_RELAXED, __HIP_MEMORY_SCOPE_AGENT);
            asm volatile("s_waitcnt vmcnt(0)" ::: "memory");
            if (F.lane == 0) __hip_atomic_fetch_add(cnt + 64 * (64 + sm), 1u, __ATOMIC_RELAXED, __HIP_MEMORY_SCOPE_AGENT);
            pg8::panel_wait(cnt + 64 * (64 + sm), 16u);
            float tot = 0.f;
#pragma unroll
            for (int t = 0; t < 16; ++t) tot += __hip_atomic_load(slot + t, __ATOMIC_RELAXED, __HIP_MEMORY_SCOPE_AGENT);
            S2[F.lane] = 1.0f / sqrtf(tot * (1.0f / DM) + EPS); }
        __syncthreads();
        const float r = S2[rl];
#pragma unroll
        for (int j = 0; j < 2; ++j) { const int n = 64 * sn + 16 * (2 * j + (F.wave >> 2)) + 4 * fq; const f32x4 g4 = *(const f32x4*)(gw + n);
            if constexpr (FINAL) *(f32x4*)(Yout + (size_t)row * DM + n) = xn[j] * r * g4;
            else { *(f32x4*)(Xout + (size_t)row * DM + n) = xn[j];
                *(u32x2*)(Uout + (size_t)row * DM + n) = pack4(xn[j] * r * g4 * (1.0f + *(const f32x4*)(scmod + (size_t)bid * NMOD + n)) + *(const f32x4*)(shmod + (size_t)bid * NMOD + n)); } } }
}
__device__ __forceinline__ void small_gates_tile(Frame& F, const bf16_t* U, const bf16_t* Wg, float* gates, const int st) {
    {
        __syncthreads();
        small_gemm_partials<DM, false, true>(F.lds, U + (size_t)(64 * st) * DM, Wg, F.wave, F.lane);
        __syncthreads();
#pragma unroll
        for (int j = 0; j < 2; ++j) { const f32x4 v = small_gemm_sum(F.lds, F.tid, j); const int tile = 8 * j + (F.tid >> 6), tn = tile >> 2, tm = tile & 3;
            *(f32x4*)(gates + (size_t)(64 * st + 16 * tm + (F.lane & 15)) * 64 + 16 * tn + 4 * (F.lane >> 4)) = v; } }
}
__device__ __forceinline__ void small_phase_merge(Frame& F, const bf16_t* HA, const bf16_t* HB, const bf16_t* WA, const bf16_t* WB, const bf16_t* Z, bf16_t* U) {
    for (int st = F.bx; st < 256; st += F.G) { const int x = st & 7, j = st >> 3, sm = 4 * (x >> 1) + (j >> 3), sn = 8 * (x & 1) + (j & 7); f32x4 va[2], vb[2];
        __syncthreads();
        small_gemm_partials<2048, true, true>(F.lds, HA + (size_t)(MP + 64 * sm) * 2048, WA + (size_t)(64 * sn) * 2048, F.wave, F.lane);
        __syncthreads();
        va[0] = small_gemm_sum(F.lds, F.tid, 0); va[1] = small_gemm_sum(F.lds, F.tid, 1);
        __syncthreads();
        small_gemm_partials<2048, true, true>(F.lds, HB + (size_t)(MP + 64 * sm) * 2048, WB + (size_t)(64 * sn) * 2048, F.wave, F.lane);
        __syncthreads();
        vb[0] = small_gemm_sum(F.lds, F.tid, 0); vb[1] = small_gemm_sum(F.lds, F.tid, 1);
#pragma unroll
        for (int j = 0; j < 2; ++j) { const int tile = 8 * j + (F.tid >> 6), tn = tile >> 2, tm = tile & 3;
            const int row = MP + 64 * sm + 16 * tm + (F.lane & 15), n = 64 * sn + 16 * tn + 4 * (F.lane >> 4);
            const u32x2 ga = *(const u32x2*)(Z + (size_t)row * ZP + ZGA + n), gb = *(const u32x2*)(Z + (size_t)row * ZP + ZGB + n);
            f32x4 o; o[0] = sigmoidf_(bflo(ga.x)) * va[j][0] + sigmoidf_(bflo(gb.x)) * vb[j][0]; o[1] = sigmoidf_(bfhi(ga.x)) * va[j][1] + sigmoidf_(bfhi(gb.x)) * vb[j][1];
            o[2] = sigmoidf_(bflo(ga.y)) * va[j][2] + sigmoidf_(bflo(gb.y)) * vb[j][2]; o[3] = sigmoidf_(bfhi(ga.y)) * va[j][3] + sigmoidf_(bfhi(gb.y)) * vb[j][3];
            *(u32x2*)(U + (size_t)MP * DM + fo_index(row - MP, n, DM)) = pack4(o); } }
}

#define GAS __attribute__((address_space(1)))
#define XB_TMO      128
#define XB_XCNT(j)  (256  + 64 * (j))
#define XB_XSUB(j)  (1280 + 64 * (j))
#define XB_XGEN(j)  (2304 + 64 * (j))
#define XB_TOP      3328
#define XB_TOPGEN   3392
#define XCD_BAR_WORDS 3456
#define XB_SPIN_CAP (1u << 22)
__device__ __forceinline__ unsigned xb_ld(unsigned* p)              { return __hip_atomic_load(p, __ATOMIC_RELAXED, __HIP_MEMORY_SCOPE_AGENT); }
__device__ __forceinline__ unsigned xb_add(unsigned* p, unsigned v) { return __hip_atomic_fetch_add(p, v, __ATOMIC_RELAXED, __HIP_MEMORY_SCOPE_AGENT); }
__device__ __forceinline__ unsigned xb_xcc_id() { return (unsigned)__builtin_amdgcn_s_getreg((3 << 11) | 20) & 0xFu; }
#define XB_SPIN(cond, bar) do { unsigned _sp = 0; while (cond) { __builtin_amdgcn_s_sleep(1); \
    if ((++_sp & 255u) == 0u) { if (xb_ld(&(bar)[XB_TMO])) break; if (_sp > XB_SPIN_CAP) { atomicAdd(&(bar)[XB_TMO], 1u); break; } } } } while (0)
struct XcdBarrier { unsigned* bar; unsigned x; volatile LAS unsigned* st; };
__device__ __forceinline__ XcdBarrier xcd_barrier_post(unsigned* bar, volatile LAS unsigned* st) {
    XcdBarrier b; b.bar = bar; b.x = xb_xcc_id(); b.st = st;
    if (threadIdx.x == 0) (void)xb_add(&bar[XB_XCNT(b.x)], 1u);
    return b;
}
__device__ __forceinline__ void xcd_barrier_complete(unsigned* bar, unsigned x, unsigned& nloc, unsigned& nx) {
    const unsigned G = gridDim.x * gridDim.y * gridDim.z;
    unsigned sum, cnt, mine, sp = 0u;
    for (;;) {
        sum = 0u; cnt = 0u; mine = 0u;
#pragma unroll
        for (unsigned j = 0; j < 16; ++j) { const unsigned c = xb_ld(&bar[XB_XCNT(j)]); sum += c; cnt += (c > 0u) ? 1u : 0u; mine = (j == x) ? c : mine; }
        if (sum == G) break;
        __builtin_amdgcn_s_sleep(1);
        if ((++sp & 255u) == 0u) { if (xb_ld(&bar[XB_TMO])) break; if (sp > XB_SPIN_CAP) { atomicAdd(&bar[XB_TMO], 1u); break; } }
    }
    nloc = mine > 0u ? mine : 1u; nx = cnt > 0u ? cnt : 1u;
}
__device__ __forceinline__ void xcd_barrier(const XcdBarrier& b) {
    asm volatile("s_waitcnt vmcnt(0)" ::: "memory");
    __syncthreads();
    if (threadIdx.x == 0) {
        unsigned* bar = b.bar;
        __builtin_amdgcn_s_waitcnt(0);
        unsigned nloc = b.st[0], nx = b.st[1];
        if (nloc == 0u) { xcd_barrier_complete(bar, b.x, nloc, nx); b.st[0] = nloc; b.st[1] = nx; }
        const unsigned old = xb_add(&bar[XB_XSUB(b.x)], 1u);
        const unsigned gen = old / nloc;
        if (old + 1u == (gen + 1u) * nloc) {
            __builtin_amdgcn_fence(__ATOMIC_RELEASE, "agent");
            asm volatile("s_waitcnt vmcnt(0)" ::: "memory");
            const unsigned og = xb_add(&bar[XB_TOP], 1u);
            const unsigned tg = og / nx;
            if (og + 1u == (tg + 1u) * nx) xb_add(&bar[XB_TOPGEN], 1u);
            else XB_SPIN(xb_ld(&bar[XB_TOPGEN]) == tg, bar);
            __builtin_amdgcn_fence(__ATOMIC_ACQUIRE, "agent");
            xb_add(&bar[XB_XGEN(b.x)], 1u);
            asm volatile("s_waitcnt vmcnt(0)" ::: "memory");
        } else {
            XB_SPIN(xb_ld(&bar[XB_XGEN(b.x)]) == gen, bar);
            __builtin_amdgcn_fence(__ATOMIC_ACQUIRE, "agent");
            asm volatile("s_waitcnt vmcnt(0)" ::: "memory");
        }
    }
    __syncthreads();
}


template <class SrcFn>
__device__ __forceinline__ void transpose_item(const SrcFn& src, int K, bf16_t* WT, LAS float* scr, int item, int lane, int nblk, bf16_t* WF = nullptr, int fo_row0 = 0) {
    const int kb = item / nblk, nb = item % nblk, k0 = 64 * kb, n0 = 32 * nb;
    const size_t stride = (size_t)src.stride(); const float* colp = src(n0 + (lane & 31));
    float tv[32];
#pragma unroll
    for (int i = 0; i < 32; ++i) { const int kk = 2 * i + (lane >> 5); tv[i] = colp ? colp[(size_t)(k0 + kk) * stride] : 0.f; }
#pragma unroll
    for (int i = 0; i < 32; ++i) { const int kk = 2 * i + (lane >> 5); scr[kk * 33 + (lane & 31)] = tv[i]; }
    asm volatile("s_waitcnt lgkmcnt(0)" ::: "memory");
    const int c = lane & 7;
#pragma unroll
    for (int j = 0; j < 4; ++j) { const int n = (lane >> 3) + 8 * j; const LAS float* s = scr + (8 * c) * 33 + n;
        u32x4 o; o.x = cvt_pk_bf16(s[0 * 33], s[1 * 33]); o.y = cvt_pk_bf16(s[2 * 33], s[3 * 33]); o.z = cvt_pk_bf16(s[4 * 33], s[5 * 33]); o.w = cvt_pk_bf16(s[6 * 33], s[7 * 33]);
        *(u32x4*)(WT + (size_t)(n0 + n) * K + k0 + 8 * c) = o;
        if (WF != nullptr && n0 >= fo_row0) *(u32x4*)(WF + fo_index(n0 + n - fo_row0, k0 + 8 * c, K)) = o; }
    asm volatile("s_waitcnt lgkmcnt(0)" ::: "memory");
}
struct SrcPlain { const float* W; int N; __device__ __forceinline__ int stride() const { return N; } __device__ __forceinline__ const float* operator()(int n) const { return W + n; } };
struct SrcUp { const float* W1; const float* W3; __device__ __forceinline__ int stride() const { return DFF; } __device__ __forceinline__ const float* operator()(int n) const { const int T = n >> 8, i = n & 255; const uintptr_t a = (uintptr_t)W1, b = (uintptr_t)W3, msk = (uintptr_t)0 - (uintptr_t)(i >> 7);
        return (const float*)((a & ~msk) | (b & msk)) + 128 * T + (i & 127); } };
struct SrcWin { const float* W; __device__ __forceinline__ int stride() const { return 13352; } __device__ __forceinline__ const float* operator()(int r) const { int o;
        if (r < 6144) o = r; else if (r < 8192) o = 6152 + (r - 6144); else if (r < 11264) o = 8200 + (r - 8192); else if (r < 13312) o = 11304 + (r - 11264);
        else if (r < 13320) o = 6144 + (r - 13312); else if (r < 13352) o = 11272 + (r - 13320); else return nullptr;
        return W + o; } };

template <int PPART>
__device__ __forceinline__ void phase_prep(Frame& F, const Params& p) {
    LAS float* scr = (LAS float*)(F.lds + F.wave * 16384);
    const int gw = (PPART == 0 ? F.bx : F.bx - 192) * 8 + F.wave, NGW = (PPART == 0 ? F.G : 64) * 8;
    bf16_t* wup1 = (bf16_t*)(F.ws + WS_WUP1); bf16_t* wdn1 = (bf16_t*)(F.ws + WS_WDN1); bf16_t* wup2 = (bf16_t*)(F.ws + WS_WUP2); bf16_t* wdn2 = (bf16_t*)(F.ws + WS_WDN2);
    bf16_t* win = (bf16_t*)(F.ws + WS_WIN); bf16_t* wpa = (bf16_t*)(F.ws + WS_WPA); bf16_t* wpb = (bf16_t*)(F.ws + WS_WPB); bf16_t* wout = (bf16_t*)(F.ws + WS_WOUT);
    constexpr int I_UP = (DM / 64) * (2 * DFF / 32), I_DN = (DFF / 64) * (DM / 32), I_IN = (DM / 64) * (ZP / 32), I_P = (2048 / 64) * (DM / 32), I_O = (DM / 64) * (DM / 32);
    constexpr int NITEMS = 2 * I_UP + 2 * I_DN + I_IN + 2 * I_P + I_O;
    for (int it = (PPART == 0 ? 0 : I_UP) + gw; it < (PPART == 0 ? I_UP : NITEMS); it += NGW) {
        int r = it;
        if (r < I_UP) { transpose_item(SrcUp{PIN(13), PIN(14)}, DM, wup1, scr, r, F.lane, 2 * DFF / 32); continue; } r -= I_UP;
        if (r < I_UP) { transpose_item(SrcUp{PIN(32), PIN(33)}, DM, wup2, scr, r, F.lane, 2 * DFF / 32); continue; } r -= I_UP;
        if (r < I_DN) { transpose_item(SrcPlain{PIN(15), DM}, DFF, wdn1, scr, r, F.lane, DM / 32, (bf16_t*)(F.ws + WS_FDN1)); continue; } r -= I_DN;
        if (r < I_DN) { transpose_item(SrcPlain{PIN(34), DM}, DFF, wdn2, scr, r, F.lane, DM / 32, (bf16_t*)(F.ws + WS_FDN2)); continue; } r -= I_DN;
        if (r < I_IN) { transpose_item(SrcWin{PIN(17)}, DM, win, scr, r, F.lane, ZP / 32, (bf16_t*)(F.ws + WS_FG), ZG); continue; } r -= I_IN;
        if (r < I_P) { transpose_item(SrcPlain{PIN(22), DM}, 2048, wpa, scr, r, F.lane, DM / 32, (bf16_t*)(F.ws + WS_FPA)); continue; } r -= I_P;
        if (r < I_P) { transpose_item(SrcPlain{PIN(29), DM}, 2048, wpb, scr, r, F.lane, DM / 32, (bf16_t*)(F.ws + WS_FPB)); continue; } r -= I_P;
        transpose_item(SrcPlain{PIN(30), DM}, DM, wout, scr, r, F.lane, DM / 32, (bf16_t*)(F.ws + WS_FOUT));
    }
    __syncthreads();
    if constexpr (PPART != 0) return;
    const float* ada_w = PIN(10); const float* ada_b = PIN(11); float* mod = (float*)(F.ws + WS_MOD);
    LAS f32x4* PART = (LAS f32x4*)F.lds;
    const int lane = F.lane, w = F.wave, fr = lane & 15, fq = lane >> 4;
    for (int nt = F.bx; nt < NMOD / 16; nt += F.G) {
        f32x4 acc[9];
#pragma unroll
        for (int rt = 0; rt < 9; ++rt) acc[rt] = (f32x4){0.f, 0.f, 0.f, 0.f};
#pragma unroll 1
        for (int ks = 0; ks < 4; ++ks) {
            const int k0 = 128 * w + 32 * ks + 8 * fq;
            float wv[8];
#pragma unroll
            for (int j = 0; j < 8; ++j) wv[j] = ada_w[(size_t)(k0 + j) * NMOD + 16 * nt + fr];
            bf16x8 bfr; { const u32x4 t = pack8(wv, 1.0f); bfr = __builtin_bit_cast(bf16x8, t); }
#pragma unroll
            for (int rt = 0; rt < 9; ++rt) { const int r = 16 * rt + fr; float x[8];
                if (r < NBID) { const float* cr = (r < NBP ? PIN(2) + (size_t)r * DM : PIN(3) + (size_t)(r - NBP) * DM) + k0; const f32x4 c0 = *(const f32x4*)cr, c1 = *(const f32x4*)(cr + 4);
#pragma unroll
                    for (int e = 0; e < 4; ++e) { x[e] = siluf_(c0[e]); x[4 + e] = siluf_(c1[e]); } }
                else {
#pragma unroll
                    for (int e = 0; e < 8; ++e) x[e] = 0.f; }
                const u32x4 t = pack8(x, 1.0f);
                acc[rt] = __builtin_amdgcn_mfma_f32_16x16x32_bf16(__builtin_bit_cast(bf16x8, t), bfr, acc[rt], 0, 0, 0); }
        }
        __syncthreads();
#pragma unroll
        for (int rt = 0; rt < 9; ++rt) PART[(w * 9 + rt) * 64 + lane] = acc[rt];
        __syncthreads();
        for (int idx = F.tid; idx < 9 * 64; idx += NTHREADS) { const int rt = idx >> 6, ln = idx & 63; f32x4 sum = PART[rt * 64 + ln];
#pragma unroll
            for (int ww = 1; ww < 8; ++ww) sum += PART[(ww * 9 + rt) * 64 + ln];
            const int n = 16 * nt + (ln & 15); const float bv = ada_b[n];
#pragma unroll
            for (int r = 0; r < 4; ++r) { const int row = 16 * rt + 4 * (ln >> 4) + r; if (row < NBID) mod[(size_t)row * NMOD + n] = sum[r] + bv; } }
    }
}

__device__ __forceinline__ void phase_norm_mod(Frame& F, const float* xp, const float* xs, const float* gw, int shoff, int scoff, bf16_t* U) {
    const float* mod = (const float*)(F.ws + WS_MOD);
    const int gwv = F.bx * 8 + F.wave, NGW = F.G * 8;
    f32x4 g[4];
#pragma unroll
    for (int j = 0; j < 4; ++j) g[j] = *(const f32x4*)(gw + 4 * F.lane + 256 * j);
    for (int m = gwv; m < MT; m += NGW) {
        const float* xr = m < MP ? xp + (size_t)m * DM : xs + (size_t)(m - MP) * DM;
        const float* mr = mod + (size_t)pg8::bid_of_row(m) * NMOD;
        f32x4 v[4]; float s = 0.f;
#pragma unroll
        for (int j = 0; j < 4; ++j) { v[j] = *(const f32x4*)(xr + 4 * F.lane + 256 * j); s += (v[j][0] * v[j][0] + v[j][1] * v[j][1]) + (v[j][2] * v[j][2] + v[j][3] * v[j][3]); }
        const float r = 1.0f / sqrtf(wave_sum(s) * (1.0f / DM) + EPS);
#pragma unroll
        for (int j = 0; j < 4; ++j) { const f32x4 sh = *(const f32x4*)(mr + shoff + 4 * F.lane + 256 * j), scv = *(const f32x4*)(mr + scoff + 4 * F.lane + 256 * j);
            const f32x4 o = (v[j] * r * g[j]) * (1.0f + scv) + sh;
            u32x2 w; w.x = cvt_pk_bf16(o[0], o[1]); w.y = cvt_pk_bf16(o[2], o[3]);
            *(u32x2*)(U + (size_t)m * DM + 4 * F.lane + 256 * j) = w; }
    }
}
__device__ __forceinline__ void phase_final_norm(Frame& F, float* Y, const float* gw) {
    const int gwv = F.bx * 8 + F.wave, NGW = F.G * 8;
    f32x4 g[4];
#pragma unroll
    for (int j = 0; j < 4; ++j) g[j] = *(const f32x4*)(gw + 4 * F.lane + 256 * j);
    for (int m = gwv; m < MT; m += NGW) {
        float* xr = Y + (size_t)m * DM;
        f32x4 v[4]; float s = 0.f;
#pragma unroll
        for (int j = 0; j < 4; ++j) { v[j] = *(const f32x4*)(xr + 4 * F.lane + 256 * j); s += (v[j][0] * v[j][0] + v[j][1] * v[j][1]) + (v[j][2] * v[j][2] + v[j][3] * v[j][3]); }
        const float r = 1.0f / sqrtf(wave_sum(s) * (1.0f / DM) + EPS);
#pragma unroll
        for (int j = 0; j < 4; ++j) *(f32x4*)(xr + 4 * F.lane + 256 * j) = v[j] * r * g[j];
    }
}

constexpr size_t O_Y = 0, O_PC = 17825792, O_PN = 22020096, O_PM = 22028288, O_PMC = 22028320, O_PSSM = 22077472, O_PSC = 24174624,
                 O_SC = 24248352, O_SN = 91357216, O_SM = 91488288, O_SMC = 91488800, O_SSSM = 92275232, O_SSC = 125829664, O_END = 127009312;
constexpr int CVP = 5120;

__device__ __forceinline__ bf16x8 frag_row(LAS unsigned char* base, int stride, int row0, int k0, int lane) {
    return *(const LAS bf16x8*)(base + (row0 + (lane & 15)) * stride + (k0 + 8 * (lane >> 4)) * 2);
}
__device__ __forceinline__ bf16x8 frag_tr(LAS unsigned char* base, int stride, int krow0, int col0, int lane) {
    const int g = lane >> 4, q = (lane & 15) >> 2, pp = lane & 3;
    LAS unsigned char* a = base + (krow0 + 8 * g + q) * stride + (col0 + 4 * pp) * 2;
    const s16x4 lo = __builtin_amdgcn_ds_read_tr16_b64_v4i16((LAS s16x4*)a);
    const s16x4 hi = __builtin_amdgcn_ds_read_tr16_b64_v4i16((LAS s16x4*)(a + 4 * stride));
    return (bf16x8){lo.x, lo.y, lo.z, lo.w, hi.x, hi.y, hi.z, hi.w};
}
#define MFMA16(a, b, c) __builtin_amdgcn_mfma_f32_16x16x32_bf16((a), (b), (c), 0, 0, 0)

__device__ __forceinline__ float fast_log1pexp_neg(float ax) { return __builtin_amdgcn_logf(1.0f + fast_exp(-ax)) * 0.6931471805599453f; }
__device__ __forceinline__ float logsigmoidf_(float x) { return fminf(x, 0.f) - log1pf(expf(-fabsf(x))); }
__device__ __forceinline__ float softplusf_(float x) { return fmaxf(x, 0.f) + log1pf(expf(-fabsf(x))); }

__device__ __forceinline__ void conv_item(Frame& F, const Params& p, const int it) {
    const bf16_t* Z = (const bf16_t*)(F.ws + WS_ZIN); bf16_t* CV = (bf16_t*)(F.ws + WS_CV);
    const int lane = F.lane;
    {
        int m0, tb, nrows, strip; const float* hist = nullptr;
        if (it < 5120) { const int b = it / 640, r = it % 640; strip = r % 10; tb = (r / 10) * 32; m0 = b * SEQ; nrows = 32; }
        else { const int j = it - 5120, bs = j / 10; strip = j % 10; tb = 0; m0 = MP + bs * TS; nrows = 8; hist = strip < 4 ? PIN(7) + (size_t)bs * 3 * 2048 : PIN(9) + (size_t)bs * 3 * 3072; }
        const bool isM = strip < 4;
        const int c = strip * 512 + 8 * lane, zc = isM ? c : ZX + (c - 2048), cc = isM ? c : c - 2048, cs = isM ? 2048 : 3072;
        const float* cw = isM ? PIN(18) : PIN(23); const float* cb = isM ? PIN(19) : PIN(24);
        const float scl = (strip == 2 || strip == 3) ? 0.0625f : 1.0f;
        float w[4][8], bb[8], x0[8], x1[8], x2[8];
#pragma unroll
        for (int j = 0; j < 4; ++j) { const f32x4 a = *(const f32x4*)(cw + (size_t)j * cs + cc), b = *(const f32x4*)(cw + (size_t)j * cs + cc + 4);
#pragma unroll
            for (int e = 0; e < 4; ++e) { w[j][e] = a[e]; w[j][4 + e] = b[e]; } }
        { const f32x4 a = *(const f32x4*)(cb + cc), b = *(const f32x4*)(cb + cc + 4);
#pragma unroll
            for (int e = 0; e < 4; ++e) { bb[e] = a[e]; bb[4 + e] = b[e]; } }
        if (tb > 0) { unpack8(*(const u32x4*)(Z + (size_t)(m0 + tb - 3) * ZP + zc), x0); unpack8(*(const u32x4*)(Z + (size_t)(m0 + tb - 2) * ZP + zc), x1); unpack8(*(const u32x4*)(Z + (size_t)(m0 + tb - 1) * ZP + zc), x2); }
        else if (hist != nullptr) {
#pragma unroll
            for (int e = 0; e < 8; ++e) { x0[e] = hist[cc + e]; x1[e] = hist[cs + cc + e]; x2[e] = hist[2 * cs + cc + e]; } }
        else {
#pragma unroll
            for (int e = 0; e < 8; ++e) { x0[e] = 0.f; x1[e] = 0.f; x2[e] = 0.f; } }
        for (int t = 0; t < nrows; t += 8) {
            u32x4 raw[8];
#pragma unroll
            for (int i = 0; i < 8; ++i) raw[i] = *(const u32x4*)(Z + (size_t)(m0 + tb + t + i) * ZP + zc);
#pragma unroll
            for (int i = 0; i < 8; ++i) { float x3[8], o[8]; unpack8(raw[i], x3);
#pragma unroll
                for (int e = 0; e < 8; ++e) { o[e] = siluf_(bb[e] + w[0][e] * x0[e] + w[1][e] * x1[e] + w[2][e] * x2[e] + w[3][e] * x3[e]); x0[e] = x1[e]; x1[e] = x2[e]; x2[e] = x3[e]; }
                *(u32x4*)(CV + (size_t)(m0 + tb + t + i) * CVP + c) = pack8(o, scl); }
        }
    }
}
constexpr int NS_EARLY = 64;
__device__ __forceinline__ void phase_conv(Frame& F, const Params& p) {
    const int gw = F.bx * 8 + F.wave, NGW = F.G * 8;
    for (int it = gw; it < 5120 + 1280 - 10 * NS_EARLY; it += NGW) conv_item(F, p, it < 5120 ? it : it + 10 * NS_EARLY);
}

constexpr int QSTR = 528, VSTR = 144;
constexpr int L_QS = 0, L_KS = 33792, L_CT = 67584, L_VS = 101376, L_VW = 110592, L_SB = 119808, L_SCAL = 129024, L_NST = 132096, L_QNP = 133120, L_DENP = 135168, L_NUMB = 135680;

__device__ __forceinline__ float mlstm_scan(float ipre, float fpre, int lane, float mstate, LAS float* sc) {
    const float lf = fminf(fpre, 0.f) - fast_log1pexp_neg(fabsf(fpre));
    const float b = wave_scan_add(lf);
    const float a = ipre - b;
    const float cm = wave_scan_max(a);
    const float A = fmaxf(mstate, cm);
    const float Alast = __shfl(A, 63), blast = __shfl(b, 63);
    sc[lane] = a; sc[64 + lane] = A; sc[128 + lane] = fast_exp(mstate - A); sc[192 + lane] = fast_exp(-(b + A)); sc[256 + lane] = fast_exp(a - Alast);
    if (lane == 0) sc[320] = fast_exp(mstate - Alast);
    return blast + Alast;
}

__device__ __forceinline__ void mlstm_prompt_item(Frame& F, const Params& p, const int b, const int h, const int vs) {
    LAS unsigned char* L = F.lds;
    const int tid = F.tid, lane = F.lane, w = F.wave, fr = lane & 15, fq = lane >> 4;
    const bf16_t* Z = (const bf16_t*)(F.ws + WS_ZIN); const bf16_t* CV = (const bf16_t*)(F.ws + WS_CV); const float* GT = (const float*)(F.ws + WS_GATES);
    bf16_t* NUM = (bf16_t*)(F.ws + WS_NUM); float* DEN = (float*)(F.ws + WS_DEN);
    const float ifbi = PIN(20)[h], ifbf = PIN(20)[4 + h];
    constexpr int nch = SEQ / 64; const int m0 = b * SEQ;
    LAS float* SC = (LAS float*)(L + L_SCAL); LAS unsigned char* NSTB = L + L_NST; LAS float* DENP = (LAS float*)(L + L_DENP);
    f32x4 cacc[2][4];
#pragma unroll
    for (int dt = 0; dt < 2; ++dt)
#pragma unroll
        for (int vi = 0; vi < 4; ++vi) cacc[dt][vi] = (f32x4){0.f, 0.f, 0.f, 0.f};
    f32x4 nacc[2] = {{0.f, 0.f, 0.f, 0.f}, {0.f, 0.f, 0.f, 0.f}};
    float mstate = 0.f;
    u32x4 pq[4], pk[4], pv; float gi = 0.f, gf = 0.f;
    const bf16_t* qsrc = CV + (size_t)(m0 + (tid >> 5)) * CVP + h * 256 + 8 * (tid & 31);
    const bf16_t* vsrc = Z + (size_t)(m0 + (tid >> 3)) * ZP + ZV + h * 512 + vs * 64 + 8 * (tid & 7);
    const float* gsrc = GT + (size_t)(m0 + lane) * 64 + h;
#define ML_LOAD(c) do { _Pragma("unroll") for (int i = 0; i < 4; ++i) { pq[i] = *(const u32x4*)(qsrc + (size_t)((c) * 64 + 16 * i) * CVP); pk[i] = *(const u32x4*)(qsrc + (size_t)((c) * 64 + 16 * i) * CVP + 1024); } \
        pv = *(const u32x4*)(vsrc + (size_t)((c) * 64) * ZP); if (w == 0) { gi = gsrc[(size_t)((c) * 64) * 64]; gf = gsrc[(size_t)((c) * 64) * 64 + 4]; } } while (0)
    u32x4 numst = {0u, 0u, 0u, 0u}; float denst = 0.f;
    bf16_t* numdst = NUM + (size_t)(m0 + (tid >> 3)) * 2048 + h * 512 + vs * 64 + 8 * (tid & 7);
#define ML_STORE(c) do { *(u32x4*)(numdst + (size_t)((c) * 64) * 2048) = numst; \
        if (vs == 0 && w < 4 && fq == 0) DEN[(size_t)(m0 + (c) * 64 + 16 * w + fr) * 4 + h] = denst; } while (0)
    ML_LOAD(0);
    __syncthreads();
#pragma unroll
    for (int dt = 0; dt < 2; ++dt)
#pragma unroll
        for (int vi = 0; vi < 4; ++vi) *(LAS u32x2*)(L + L_CT + (16 * vi + fr) * QSTR + (32 * w + 16 * dt + 4 * fq) * 2) = (u32x2){0u, 0u};
    if (tid < 128) *(LAS unsigned*)(NSTB + 4 * tid) = 0u;
    if (w == 0) mstate = mlstm_scan(gi + ifbi, gf + ifbf, lane, mstate, SC);
    __syncthreads();
    for (int c = 0; c < nch; ++c) {
        const int t0 = 64 * c; LAS float* sc = SC + (c & 1) * 384;
#pragma unroll
        for (int i = 0; i < 4; ++i) { const int v = tid + NTHREADS * i, row = v >> 5, c16 = v & 31; *(LAS u32x4*)(L + L_QS + row * QSTR + 16 * c16) = pq[i]; *(LAS u32x4*)(L + L_KS + row * QSTR + 16 * c16) = pk[i]; }
        { const int row = tid >> 3, c8 = tid & 7; *(LAS u32x4*)(L + L_VS + row * VSTR + 16 * c8) = pv; float x[8]; unpack8(pv, x); *(LAS u32x4*)(L + L_VW + row * VSTR + 16 * c8) = pack8(x, sc[256 + row]); }
        __syncthreads();
        if (c > 0) { ML_STORE(c - 1); }
        if (c + 1 < nch) ML_LOAD(c + 1);
        const int ti = w & 3, hf = w >> 2;
        bf16x8 qf[8];
#pragma unroll
        for (int k = 0; k < 8; ++k) qf[k] = frag_row(L + L_QS, QSTR, 16 * ti, 32 * k, lane);
        { f32x4 sacc[2] = {{0.f, 0.f, 0.f, 0.f}, {0.f, 0.f, 0.f, 0.f}};
#pragma unroll
          for (int j = 0; j < 2; ++j) { const int si = 2 * hf + j; if (si <= ti) {
#pragma unroll
                  for (int k = 0; k < 8; ++k) sacc[j] = MFMA16(frag_row(L + L_KS, QSTR, 16 * si, 32 * k, lane), qf[k], sacc[j]); } }
          const int t = 16 * ti + fr; const float At = sc[64 + t]; float dpart = 0.f;
#pragma unroll
          for (int j = 0; j < 2; ++j) { const int si = 2 * hf + j, s0 = 16 * si + 4 * fq; const f32x4 av = *(const LAS f32x4*)(sc + s0); f32x4 vv;
#pragma unroll
              for (int r = 0; r < 4; ++r) { const float wgt = (s0 + r <= t) ? fast_exp(av[r] - At) : 0.f; vv[r] = (si <= ti) ? sacc[j][r] * wgt : 0.f; dpart += vv[r]; }
              *(LAS u32x2*)(L + L_SB + t * VSTR + s0 * 2) = pack4(vv); }
          dpart += __shfl_xor(dpart, 16); dpart += __shfl_xor(dpart, 32);
          if (lane < 16) DENP[hf * 64 + 16 * ti + lane] = dpart; }
        __syncthreads();
        { f32x4 uacc[2] = {{0.f, 0.f, 0.f, 0.f}, {0.f, 0.f, 0.f, 0.f}};
#pragma unroll
          for (int j = 0; j < 2; ++j) { const int vi = 2 * hf + j;
#pragma unroll
              for (int k = 0; k < 8; ++k) uacc[j] = MFMA16(frag_row(L + L_CT, QSTR, 16 * vi, 32 * k, lane), qf[k], uacc[j]); }
          const float wst = sc[128 + 16 * ti + fr]; uacc[0] *= wst; uacc[1] *= wst;
#pragma unroll
          for (int ks = 0; ks < 2; ++ks) if (32 * ks <= 16 * ti + 15) { const bf16x8 sb = frag_row(L + L_SB, VSTR, 16 * ti, 32 * ks, lane);
#pragma unroll
              for (int j = 0; j < 2; ++j) uacc[j] = MFMA16(frag_tr(L + L_VS, VSTR, 32 * ks, 16 * (2 * hf + j), lane), sb, uacc[j]); }
#pragma unroll
          for (int j = 0; j < 2; ++j) *(LAS u32x2*)(L + L_NUMB + (16 * ti + fr) * VSTR + (16 * (2 * hf + j) + 4 * fq) * 2) = pack4(uacc[j]); }
        if (vs == 0 && hf == 0) {
            f32x4 qn = {0.f, 0.f, 0.f, 0.f};
#pragma unroll
            for (int k = 0; k < 8; ++k) { u32x4 nv = *(const LAS u32x4*)(NSTB + 64 * k + 16 * fq); if (fr != 0) nv = (u32x4){0u, 0u, 0u, 0u};
                qn = MFMA16(__builtin_bit_cast(bf16x8, nv), qf[k], qn); }
            const int t = 16 * ti + fr; const float den = DENP[t] + DENP[64 + t] + sc[128 + t] * qn[0];
            denst = fmaxf(fabsf(den), sc[192 + t]); }
        { const float decay = sc[320];
#pragma unroll
          for (int dt = 0; dt < 2; ++dt)
#pragma unroll
              for (int vi = 0; vi < 4; ++vi) cacc[dt][vi] *= decay;
#pragma unroll
          for (int ks = 0; ks < 2; ++ks) { bf16x8 ka[2];
#pragma unroll
              for (int dt = 0; dt < 2; ++dt) ka[dt] = frag_tr(L + L_KS, QSTR, 32 * ks, 32 * w + 16 * dt, lane);
#pragma unroll
              for (int vi = 0; vi < 4; ++vi) { const bf16x8 vb = frag_tr(L + L_VW, VSTR, 32 * ks, 16 * vi, lane);
#pragma unroll
                  for (int dt = 0; dt < 2; ++dt) cacc[dt][vi] = MFMA16(ka[dt], vb, cacc[dt][vi]); } }
          if (vs == 0) { nacc[0] *= decay; nacc[1] *= decay;
#pragma unroll
              for (int ks = 0; ks < 2; ++ks) { const f32x4 w0 = *(const LAS f32x4*)(sc + 256 + 32 * ks + 8 * fq), w1 = *(const LAS f32x4*)(sc + 256 + 32 * ks + 8 * fq + 4);
                  u32x4 wv; wv.x = cvt_pk_bf16(w0[0], w0[1]); wv.y = cvt_pk_bf16(w0[2], w0[3]); wv.z = cvt_pk_bf16(w1[0], w1[1]); wv.w = cvt_pk_bf16(w1[2], w1[3]);
                  if (fr != 0) wv = (u32x4){0u, 0u, 0u, 0u};
#pragma unroll
                  for (int dt = 0; dt < 2; ++dt) nacc[dt] = MFMA16(frag_tr(L + L_KS, QSTR, 32 * ks, 32 * w + 16 * dt, lane), __builtin_bit_cast(bf16x8, wv), nacc[dt]); } } }
        if (w == 0 && c + 1 < nch) mstate = mlstm_scan(gi + ifbi, gf + ifbf, lane, mstate, SC + ((c + 1) & 1) * 384);
        __syncthreads();
        numst = *(const LAS u32x4*)(L + L_NUMB + (tid >> 3) * VSTR + 16 * (tid & 7));
#pragma unroll
        for (int dt = 0; dt < 2; ++dt)
#pragma unroll
            for (int vi = 0; vi < 4; ++vi) *(LAS u32x2*)(L + L_CT + (16 * vi + fr) * QSTR + (32 * w + 16 * dt + 4 * fq) * 2) = pack4(cacc[dt][vi]);
        if (vs == 0 && fr == 0) {
#pragma unroll
            for (int dt = 0; dt < 2; ++dt) *(LAS u32x2*)(NSTB + (32 * w + 16 * dt + 4 * fq) * 2) = pack4(nacc[dt]); }
    }
    ML_STORE(nch - 1);
#undef ML_LOAD
#undef ML_STORE
    float* Cout = F.out + O_PC + (size_t)(b * 4 + h) * 131072;
#pragma unroll
    for (int dt = 0; dt < 2; ++dt)
#pragma unroll
        for (int vi = 0; vi < 4; ++vi)
#pragma unroll
            for (int r = 0; r < 4; ++r) { const int d = 32 * w + 16 * dt + 4 * fq + r, v = 16 * vi + fr; Cout[(size_t)d * 512 + vs * 64 + v] = cacc[dt][vi][r]; }
    if (vs == 0) { if (fr == 0) {
#pragma unroll
            for (int dt = 0; dt < 2; ++dt)
#pragma unroll
                for (int r = 0; r < 4; ++r) F.out[O_PN + (size_t)(b * 4 + h) * 256 + 32 * w + 16 * dt + 4 * fq + r] = nacc[dt][r]; }
        if (tid == 0) F.out[O_PM + b * 4 + h] = mstate; }
}

constexpr int XSTR = 144, BSTR = 272;
constexpr int S_XS = 0, S_XD = 9216, S_XW = 18432, S_BS = 27648, S_CS = 45056, S_HS = 62464, S_GB = 79872, S_SCAL = 89088, S_YB = 98304;

__device__ __forceinline__ void ssd_scan(float dtp, float Ae, int lane, LAS float* sc) {
    const float dt = fmaxf(dtp, 0.f) + fast_log1pexp_neg(fabsf(dtp));
    const float cum = wave_scan_add(dt * Ae);
    const float cl = __shfl(cum, 63);
    sc[lane] = cum; sc[64 + lane] = dt; sc[128 + lane] = fast_exp(cl - cum); sc[192 + lane] = fast_exp(cum);
    if (lane == 0) sc[256] = fast_exp(cl);
}

__device__ __forceinline__ void ssd_prompt_item(Frame& F, const Params& p, const int b, const int e) {
    LAS unsigned char* L = F.lds;
    const int tid = F.tid, lane = F.lane, w = F.wave, fr = lane & 15, fq = lane >> 4;
    const bf16_t* CV = (const bf16_t*)(F.ws + WS_CV); const float* GT = (const float*)(F.ws + WS_GATES);
    bf16_t* YS = (bf16_t*)(F.ws + WS_YS);
    const int g = e >> 3, m0 = b * SEQ; constexpr int nch = SEQ / 64;
    const float dtb = PIN(25)[e], Ae = -expf(PIN(26)[e]), De = PIN(27)[e];
    LAS float* SC = (LAS float*)(L + S_SCAL);
    f32x4 hacc[4];
#pragma unroll
    for (int pi = 0; pi < 4; ++pi) hacc[pi] = (f32x4){0.f, 0.f, 0.f, 0.f};
    u32x4 px, pb[2], pc[2]; float gd = 0.f;
    const bf16_t* xsrc = CV + (size_t)(m0 + (tid >> 3)) * CVP + 2048 + e * 64 + 8 * (tid & 7);
    const bf16_t* bsrc = CV + (size_t)(m0 + (tid >> 4)) * CVP + 4096 + g * 128 + 8 * (tid & 15);
    const float* gsrc = GT + (size_t)(m0 + lane) * 64 + 8 + e;
#define SD_LOAD(c) do { px = *(const u32x4*)(xsrc + (size_t)((c) * 64) * CVP); _Pragma("unroll") for (int i = 0; i < 2; ++i) { pb[i] = *(const u32x4*)(bsrc + (size_t)((c) * 64 + 32 * i) * CVP); pc[i] = *(const u32x4*)(bsrc + (size_t)((c) * 64 + 32 * i) * CVP + 512); } \
        if (w == 0) gd = gsrc[(size_t)((c) * 64) * 64]; } while (0)
    u32x4 yst = {0u, 0u, 0u, 0u};
    bf16_t* ydst = YS + (size_t)(m0 + (tid >> 3)) * 2048 + e * 64 + 8 * (tid & 7);
#define SD_STORE(c) do { *(u32x4*)(ydst + (size_t)((c) * 64) * 2048) = yst; } while (0)
    SD_LOAD(0);
    __syncthreads();
#pragma unroll
    for (int pi = 0; pi < 4; ++pi) *(LAS u32x2*)(L + S_HS + (16 * pi + fr) * BSTR + (16 * w + 4 * fq) * 2) = (u32x2){0u, 0u};
    if (w == 0) ssd_scan(gd + dtb, Ae, lane, SC);
    __syncthreads();
    for (int c = 0; c < nch; ++c) {
        const int t0 = 64 * c; LAS float* sc = SC + (c & 1) * 320;
        { const int row = tid >> 3, c8 = tid & 7; const float dt = sc[64 + row], ed = sc[128 + row]; float x[8]; unpack8(px, x);
          *(LAS u32x4*)(L + S_XS + row * XSTR + 16 * c8) = px; *(LAS u32x4*)(L + S_XD + row * XSTR + 16 * c8) = pack8(x, dt); *(LAS u32x4*)(L + S_XW + row * XSTR + 16 * c8) = pack8(x, dt * ed); }
#pragma unroll
        for (int i = 0; i < 2; ++i) { const int row = (tid >> 4) + 32 * i, c16 = tid & 15; *(LAS u32x4*)(L + S_BS + row * BSTR + 16 * c16) = pb[i]; *(LAS u32x4*)(L + S_CS + row * BSTR + 16 * c16) = pc[i]; }
        __syncthreads();
        if (c > 0) { SD_STORE(c - 1); }
        if (c + 1 < nch) SD_LOAD(c + 1);
        const int ti = w & 3, hf = w >> 2;
        bf16x8 cf[4];
#pragma unroll
        for (int k = 0; k < 4; ++k) cf[k] = frag_row(L + S_CS, BSTR, 16 * ti, 32 * k, lane);
        { f32x4 gacc[2] = {{0.f, 0.f, 0.f, 0.f}, {0.f, 0.f, 0.f, 0.f}};
#pragma unroll
          for (int j = 0; j < 2; ++j) { const int si = 2 * hf + j; if (si <= ti) {
#pragma unroll
                  for (int k = 0; k < 4; ++k) gacc[j] = MFMA16(frag_row(L + S_BS, BSTR, 16 * si, 32 * k, lane), cf[k], gacc[j]); } }
          const int t = 16 * ti + fr; const float cumt = sc[t];
#pragma unroll
          for (int j = 0; j < 2; ++j) { const int si = 2 * hf + j, s0 = 16 * si + 4 * fq; const f32x4 cs = *(const LAS f32x4*)(sc + s0); f32x4 vv;
#pragma unroll
              for (int r = 0; r < 4; ++r) vv[r] = (si <= ti && s0 + r <= t) ? gacc[j][r] * fast_exp(cumt - cs[r]) : 0.f;
              *(LAS u32x2*)(L + S_GB + t * XSTR + s0 * 2) = pack4(vv); } }
        __syncthreads();
        { f32x4 yacc[2] = {{0.f, 0.f, 0.f, 0.f}, {0.f, 0.f, 0.f, 0.f}};
#pragma unroll
          for (int j = 0; j < 2; ++j) { const int pi = 2 * hf + j;
#pragma unroll
              for (int k = 0; k < 4; ++k) yacc[j] = MFMA16(frag_row(L + S_HS, BSTR, 16 * pi, 32 * k, lane), cf[k], yacc[j]); }
          const int t = 16 * ti + fr; const float ec = sc[192 + t]; yacc[0] *= ec; yacc[1] *= ec;
#pragma unroll
          for (int ks = 0; ks < 2; ++ks) if (32 * ks <= 16 * ti + 15) { const bf16x8 gb = frag_row(L + S_GB, XSTR, 16 * ti, 32 * ks, lane);
#pragma unroll
              for (int j = 0; j < 2; ++j) yacc[j] = MFMA16(frag_tr(L + S_XD, XSTR, 32 * ks, 16 * (2 * hf + j), lane), gb, yacc[j]); }
#pragma unroll
          for (int j = 0; j < 2; ++j) { const int p0 = 16 * (2 * hf + j) + 4 * fq; const u32x2 xv = *(const LAS u32x2*)(L + S_XS + t * XSTR + p0 * 2);
              f32x4 y = yacc[j]; y[0] += De * bflo(xv.x); y[1] += De * bfhi(xv.x); y[2] += De * bflo(xv.y); y[3] += De * bfhi(xv.y);
              *(LAS u32x2*)(L + S_YB + t * XSTR + p0 * 2) = pack4(y); } }
        { const float eall = sc[256];
#pragma unroll
          for (int pi = 0; pi < 4; ++pi) hacc[pi] *= eall;
#pragma unroll
          for (int ks = 0; ks < 2; ++ks) { const bf16x8 ba = frag_tr(L + S_BS, BSTR, 32 * ks, 16 * w, lane);
#pragma unroll
              for (int pi = 0; pi < 4; ++pi) hacc[pi] = MFMA16(ba, frag_tr(L + S_XW, XSTR, 32 * ks, 16 * pi, lane), hacc[pi]); } }
        if (w == 0 && c + 1 < nch) ssd_scan(gd + dtb, Ae, lane, SC + ((c + 1) & 1) * 320);
        __syncthreads();
        yst = *(const LAS u32x4*)(L + S_YB + (tid >> 3) * XSTR + 16 * (tid & 7));
#pragma unroll
        for (int pi = 0; pi < 4; ++pi) *(LAS u32x2*)(L + S_HS + (16 * pi + fr) * BSTR + (16 * w + 4 * fq) * 2) = pack4(hacc[pi]);
    }
    SD_STORE(nch - 1);
#undef SD_LOAD
#undef SD_STORE
    float* hout = F.out + O_PSSM + (size_t)(b * 32 + e) * 8192;
#pragma unroll
    for (int pi = 0; pi < 4; ++pi) *(f32x4*)(hout + (size_t)(16 * pi + fr) * 128 + 16 * w + 4 * fq) = hacc[pi];
}

__device__ __forceinline__ void mlstm_sample_item(Frame& F, const Params& p, const int bs, const int h) {
    LAS unsigned char* L = F.lds; const int tid = F.tid, lane = F.lane, w = F.wave;
    const bf16_t* Z = (const bf16_t*)(F.ws + WS_ZIN); const bf16_t* CV = (const bf16_t*)(F.ws + WS_CV); const float* GT = (const float*)(F.ws + WS_GATES);
    bf16_t* NUM = (bf16_t*)(F.ws + WS_NUM); float* DEN = (float*)(F.ws + WS_DEN);
    const int m0 = MP + bs * TS;
    const float* C0 = PIN(4) + (size_t)(bs * 4 + h) * 131072; float* C1 = F.out + O_SC + (size_t)(bs * 4 + h) * 131072;
    LAS float* QKW = (LAS float*)L; LAS float* RED = (LAS float*)(L + 16384); LAS float* NS = (LAS float*)(L + 81920);
    LAS float* SCs = (LAS float*)(L + 82944); LAS float* SW = (LAS float*)(L + 83200); LAS float* QN = (LAS float*)(L + 83456);
    const int v4 = tid & 127, dp = tid >> 7;
    f32x4 vreg[8];
#pragma unroll
    for (int s = 0; s < 8; ++s) { const u32x2 vv = *(const u32x2*)(Z + (size_t)(m0 + s) * ZP + ZV + h * 512 + 4 * v4); vreg[s] = (f32x4){bflo(vv.x), bfhi(vv.x), bflo(vv.y), bfhi(vv.y)}; }
    const u32x4 qk = *(const u32x4*)(CV + (size_t)(m0 + ((tid >> 5) & 7)) * CVP + (tid >> 8) * 1024 + h * 256 + 8 * (tid & 31));
    const float n0v = tid < 256 ? PIN(5)[(size_t)(bs * 4 + h) * 256 + tid] : 0.f;
    __syncthreads();
    { const int isk = tid >> 8, t = (tid >> 5) & 7, c16 = tid & 31; float x[8]; unpack8(qk, x);
#pragma unroll
      for (int e = 0; e < 8; ++e) QKW[(8 * c16 + e) * 16 + isk * 8 + t] = x[e]; }
    if (tid < 256) NS[tid] = n0v;
    if (w == 0) {
        const bool valid = lane < 8; const float mstate = PIN(6)[bs * 4 + h];
        float ipre = 0.f, fpre = 0.f; if (valid) { ipre = GT[(size_t)(m0 + lane) * 64 + h] + PIN(20)[h]; fpre = GT[(size_t)(m0 + lane) * 64 + 4 + h] + PIN(20)[4 + h]; }
        float bsum = valid ? logsigmoidf_(fpre) : 0.f;
#pragma unroll
        for (int o = 1; o < 8; o <<= 1) { const float u = __shfl_up(bsum, o); if (lane >= o) bsum += u; }
        const float a = valid ? ipre - bsum : -INFINITY;
        float cm = a;
#pragma unroll
        for (int o = 1; o < 8; o <<= 1) { const float u = __shfl_up(cm, o); if (lane >= o) cm = fmaxf(cm, u); }
        const float A = fmaxf(mstate, cm); const float Alast = __shfl(A, 7), blast = __shfl(bsum, 7);
        if (valid) { SCs[lane] = a; SCs[8 + lane] = A; SCs[16 + lane] = expf(mstate - A); SCs[24 + lane] = expf(-(bsum + A)); SCs[32 + lane] = expf(a - Alast); }
        if (lane == 0) { SCs[40] = expf(mstate - Alast); F.out[O_SM + bs * 4 + h] = blast + Alast; }
    }
    __syncthreads();
    { const int pr = tid >> 3, part = tid & 7, t = pr >> 3, s = pr & 7; float acc = 0.f;
#pragma unroll 8
      for (int dd = 0; dd < 32; ++dd) { const int d = part * 32 + dd; acc += QKW[d * 16 + t] * QKW[d * 16 + 8 + s]; }
      acc += __shfl_xor(acc, 1); acc += __shfl_xor(acc, 2); acc += __shfl_xor(acc, 4);
      if (part == 0) SW[t * 8 + s] = (s <= t) ? acc * expf(SCs[s] - SCs[8 + t]) : 0.f; }
    if (tid < 64) { const int t = tid >> 3, part = tid & 7; float acc = 0.f;
#pragma unroll 8
      for (int dd = 0; dd < 32; ++dd) { const int d = part * 32 + dd; acc += QKW[d * 16 + t] * NS[d]; }
      acc += __shfl_xor(acc, 1); acc += __shfl_xor(acc, 2); acc += __shfl_xor(acc, 4);
      if (part == 0) QN[t] = acc; }
    if (tid >= 256) { const int d = tid - 256; float s = 0.f;
#pragma unroll
        for (int si = 0; si < 8; ++si) s += SCs[32 + si] * QKW[d * 16 + 8 + si];
        F.out[O_SN + (size_t)(bs * 4 + h) * 256 + d] = SCs[40] * NS[d] + s; }
    __syncthreads();
    if (tid < 8) { const int t = tid; float den = 0.f;
#pragma unroll
        for (int s = 0; s < 8; ++s) den += SW[t * 8 + s];
        den += SCs[16 + t] * QN[t]; DEN[(size_t)(m0 + t) * 4 + h] = fmaxf(fabsf(den), SCs[24 + t]); }
    if (tid >= 256) { const int d = tid - 256;
#pragma unroll
        for (int si = 0; si < 8; ++si) QKW[d * 16 + 8 + si] *= SCs[32 + si]; }
    __syncthreads();
    { const float decay = SCs[40];
      f32x4 acc[8];
#pragma unroll
      for (int t = 0; t < 8; ++t) acc[t] = (f32x4){0.f, 0.f, 0.f, 0.f};
      const float* cin = C0 + (size_t)(dp * 64) * 512 + 4 * v4; float* cout = C1 + (size_t)(dp * 64) * 512 + 4 * v4;
#pragma unroll 1
      for (int d0 = 0; d0 < 64; d0 += 8) {
          f32x4 cc[8];
#pragma unroll
          for (int i = 0; i < 8; ++i) cc[i] = __builtin_nontemporal_load((const f32x4*)(cin + (size_t)(d0 + i) * 512));
#pragma unroll
          for (int i = 0; i < 8; ++i) { const LAS float* qp = QKW + (dp * 64 + d0 + i) * 16;
              const f32x4 q0 = *(const LAS f32x4*)qp, q1 = *(const LAS f32x4*)(qp + 4), k0 = *(const LAS f32x4*)(qp + 8), k1 = *(const LAS f32x4*)(qp + 12);
              f32x4 cn = decay * cc[i];
#pragma unroll
              for (int t = 0; t < 4; ++t) { acc[t] += q0[t] * cc[i]; acc[4 + t] += q1[t] * cc[i]; cn += k0[t] * vreg[t]; cn += k1[t] * vreg[4 + t]; }
              __builtin_nontemporal_store(cn, (f32x4*)(cout + (size_t)(d0 + i) * 512)); }
      }
#pragma unroll
      for (int t = 0; t < 8; ++t) *(LAS f32x4*)(RED + (size_t)(dp * 8 + t) * 512 + 4 * v4) = acc[t]; }
    __syncthreads();
    { const int t = tid >> 6, v8 = tid & 63; float s[8];
#pragma unroll
      for (int e = 0; e < 8; ++e) s[e] = 0.f;
#pragma unroll
      for (int dpp = 0; dpp < 4; ++dpp) { const f32x4 a = *(const LAS f32x4*)(RED + (size_t)(dpp * 8 + t) * 512 + 8 * v8), b = *(const LAS f32x4*)(RED + (size_t)(dpp * 8 + t) * 512 + 8 * v8 + 4);
#pragma unroll
          for (int e = 0; e < 4; ++e) { s[e] += a[e]; s[4 + e] += b[e]; } }
      const float wst = SCs[16 + t];
#pragma unroll
      for (int e = 0; e < 8; ++e) s[e] *= wst;
      for (int si = 0; si <= t; ++si) { const float sw = SW[t * 8 + si]; float x[8]; unpack8(*(const u32x4*)(Z + (size_t)(m0 + si) * ZP + ZV + h * 512 + 8 * v8), x);
#pragma unroll
          for (int e = 0; e < 8; ++e) s[e] += sw * x[e]; }
      *(u32x4*)(NUM + (size_t)(m0 + t) * 2048 + h * 512 + 8 * v8) = pack8(s, 1.0f); }
}

__device__ __forceinline__ void ssd_sample_item(Frame& F, const Params& p, const int bs, const int g) {
    LAS unsigned char* L = F.lds; const int tid = F.tid, lane = F.lane, w = F.wave;
    const bf16_t* CV = (const bf16_t*)(F.ws + WS_CV); const float* GT = (const float*)(F.ws + WS_GATES); bf16_t* YS = (bf16_t*)(F.ws + WS_YS);
    const int m0 = MP + bs * TS;
    LAS float* BSf = (LAS float*)L; LAS float* CSf = (LAS float*)(L + 4096); LAS float* XF = (LAS float*)(L + 8192); LAS float* XWt = (LAS float*)(L + 24576);
    LAS float* XDt = (LAS float*)(L + 40960); LAS float* SC2 = (LAS float*)(L + 57344); LAS float* CB = (LAS float*)(L + 58432); LAS float* YP = (LAS float*)(L + 59392);
    const u32x4 xr = *(const u32x4*)(CV + (size_t)(m0 + (tid >> 6)) * CVP + 2048 + g * 512 + 8 * (tid & 63));
    u32x4 bcr = {0u, 0u, 0u, 0u};
    if (tid < 256) bcr = *(const u32x4*)(CV + (size_t)(m0 + ((tid >> 4) & 7)) * CVP + 4096 + (tid >> 7) * 512 + g * 128 + 8 * (tid & 15));
    __syncthreads();
    { float x[8]; unpack8(xr, x); const int t = tid >> 6, c8 = tid & 63;
#pragma unroll
      for (int e = 0; e < 8; ++e) XF[t * 512 + 8 * c8 + e] = x[e]; }
    if (tid < 256) { float x[8]; unpack8(bcr, x); const int isC = tid >> 7, t = (tid >> 4) & 7, c16 = tid & 15; LAS float* dst = isC ? CSf : BSf;
#pragma unroll
      for (int e = 0; e < 8; ++e) dst[t * 128 + 8 * c16 + e] = x[e]; }
    { const int e = g * 8 + w; const bool valid = lane < 8; const float Ae = -expf(PIN(26)[e]);
      const float dt = valid ? softplusf_(GT[(size_t)(m0 + lane) * 64 + 8 + e] + PIN(25)[e]) : 0.f;
      float cum = dt * Ae;
#pragma unroll
      for (int o = 1; o < 8; o <<= 1) { const float u = __shfl_up(cum, o); if (lane >= o) cum += u; }
      const float cl = __shfl(cum, 7);
      if (valid) { SC2[w * 32 + lane] = cum; SC2[w * 32 + 8 + lane] = dt; SC2[w * 32 + 16 + lane] = expf(cl - cum); SC2[w * 32 + 24 + lane] = expf(cum); }
      if (lane == 0) SC2[256 + w] = expf(cl); }
    __syncthreads();
    { const int pr = tid >> 3, part = tid & 7, t = pr >> 3, s = pr & 7; float acc = 0.f;
#pragma unroll
      for (int nn = 0; nn < 16; ++nn) { const int n = part * 16 + nn; acc += CSf[t * 128 + n] * BSf[s * 128 + n]; }
      acc += __shfl_xor(acc, 1); acc += __shfl_xor(acc, 2); acc += __shfl_xor(acc, 4);
      if (part == 0) CB[t * 8 + s] = acc; }
    { const int el = tid >> 6;
#pragma unroll
      for (int s = 0; s < 8; ++s) { const float x = XF[s * 512 + tid], dt = SC2[el * 32 + 8 + s], ed = SC2[el * 32 + 16 + s]; XDt[tid * 8 + s] = x * dt; XWt[tid * 8 + s] = x * dt * ed; } }
    __syncthreads();
    { const int n8 = tid & 15, prow = tid >> 4;
      float Bn[8][8], Cn[8][8];
#pragma unroll
      for (int s = 0; s < 8; ++s) { const f32x4 b0 = *(const LAS f32x4*)(BSf + s * 128 + 8 * n8), b1 = *(const LAS f32x4*)(BSf + s * 128 + 8 * n8 + 4), c0 = *(const LAS f32x4*)(CSf + s * 128 + 8 * n8), c1 = *(const LAS f32x4*)(CSf + s * 128 + 8 * n8 + 4);
#pragma unroll
          for (int j = 0; j < 4; ++j) { Bn[s][j] = b0[j]; Bn[s][4 + j] = b1[j]; Cn[s][j] = c0[j]; Cn[s][4 + j] = c1[j]; } }
      const float* hin = PIN(8) + (size_t)(bs * 32 + g * 8) * 8192 + 8 * n8; float* hout = F.out + O_SSSM + (size_t)(bs * 32 + g * 8) * 8192 + 8 * n8;
#pragma unroll 1
      for (int it = 0; it < 16; it += 2) {
          f32x4 hv[2][2];
#pragma unroll
          for (int u = 0; u < 2; ++u) { const int row = (it + u) * 32 + prow; hv[u][0] = __builtin_nontemporal_load((const f32x4*)(hin + (size_t)row * 128)); hv[u][1] = __builtin_nontemporal_load((const f32x4*)(hin + (size_t)row * 128 + 4)); }
#pragma unroll
          for (int u = 0; u < 2; ++u) { const int row = (it + u) * 32 + prow; const float eall = SC2[256 + (row >> 6)];
              const f32x4 xw0 = *(const LAS f32x4*)(XWt + row * 8), xw1 = *(const LAS f32x4*)(XWt + row * 8 + 4);
              float hh[8], hn[8], yp[8];
#pragma unroll
              for (int j = 0; j < 4; ++j) { hh[j] = hv[u][0][j]; hh[4 + j] = hv[u][1][j]; }
#pragma unroll
              for (int j = 0; j < 8; ++j) hn[j] = eall * hh[j];
#pragma unroll
              for (int s = 0; s < 8; ++s) { const float xw = s < 4 ? xw0[s & 3] : xw1[s & 3]; float y = 0.f;
#pragma unroll
                  for (int j = 0; j < 8; ++j) { hn[j] += xw * Bn[s][j]; y += Cn[s][j] * hh[j]; }
                  yp[s] = y; }
              f32x4 o0 = {hn[0], hn[1], hn[2], hn[3]}, o1 = {hn[4], hn[5], hn[6], hn[7]};
              __builtin_nontemporal_store(o0, (f32x4*)(hout + (size_t)row * 128)); __builtin_nontemporal_store(o1, (f32x4*)(hout + (size_t)row * 128 + 4));
#pragma unroll
              for (int s = 0; s < 8; ++s) { float y = yp[s]; y += __shfl_xor(y, 1); y += __shfl_xor(y, 2); y += __shfl_xor(y, 4); y += __shfl_xor(y, 8); yp[s] = y; }
              if (n8 == 0) { *(LAS f32x4*)(YP + row * 8) = (f32x4){yp[0], yp[1], yp[2], yp[3]}; *(LAS f32x4*)(YP + row * 8 + 4) = (f32x4){yp[4], yp[5], yp[6], yp[7]}; } }
      } }
    __syncthreads();
    { const int row = tid, el = row >> 6, pp = row & 63, e = g * 8 + el; const float De = PIN(27)[e];
#pragma unroll
      for (int t = 0; t < 8; ++t) { const float cumt = SC2[el * 32 + t]; float y = SC2[el * 32 + 24 + t] * YP[row * 8 + t];
#pragma unroll
          for (int s = 0; s < 8; ++s) if (s <= t) y += CB[t * 8 + s] * expf(cumt - SC2[el * 32 + s]) * XDt[row * 8 + s];
          y += De * XF[t * 512 + row];
          YS[(size_t)(m0 + t) * 2048 + e * 64 + pp] = (bf16_t)(cvt_pk_bf16(y, 0.f) & 0xffffu); } }
}

#ifndef IT_MASK
#define IT_MASK 15
#endif
__device__ __forceinline__ void phase_mixer(Frame& F, const Params& p, const int itm = IT_MASK) {
    if (itm & 1) { for (int it = F.bx; it < 256; it += F.G) { const int x = it & 7, j = it >> 3, pair = x * 4 + (j >> 3); mlstm_prompt_item(F, p, pair >> 2, pair & 3, j & 7); } }
    if (itm & 2) { for (int it = F.bx; it < 256; it += F.G) { const int x = it & 7, j = it >> 3, grp = x * 4 + (j >> 3); ssd_prompt_item(F, p, grp >> 2, (grp & 3) * 8 + (j & 7)); } }
    if (itm & 4) { for (int it = F.bx; it < 4 * (NBS - NS_EARLY); it += F.G) mlstm_sample_item(F, p, NS_EARLY + (it >> 2), it & 3); }
    if (itm & 8) { for (int it = F.bx; it < 4 * (NBS - NS_EARLY); it += F.G) ssd_sample_item(F, p, NS_EARLY + (it >> 2), it & 3); }
}

__device__ __forceinline__ void phase_finish(Frame& F, const Params& p) {
    const bf16_t* Z = (const bf16_t*)(F.ws + WS_ZIN); const bf16_t* NUM = (const bf16_t*)(F.ws + WS_NUM); const bf16_t* YS = (const bf16_t*)(F.ws + WS_YS);
    const float* DEN = (const float*)(F.ws + WS_DEN); bf16_t* HA = (bf16_t*)(F.ws + WS_HA); bf16_t* HB = (bf16_t*)(F.ws + WS_HB);
    const float* hg = PIN(21); const float* sg = PIN(28);
    const int gwv = F.bx * 8 + F.wave, NGW = F.G * 8, lane = F.lane;
    for (int m = gwv; m < MT; m += NGW) {
#pragma unroll
        for (int h = 0; h < 4; ++h) {
            float x[8], o[8], gz[8]; unpack8(*(const u32x4*)(NUM + (size_t)m * 2048 + h * 512 + 8 * lane), x);
            float s = 0.f;
#pragma unroll
            for (int e = 0; e < 8; ++e) s += x[e];
            const float mu = wave_sum(s) * (1.0f / 512.0f); float q = 0.f;
#pragma unroll
            for (int e = 0; e < 8; ++e) { x[e] -= mu; q += x[e] * x[e]; }
            const float var = wave_sum(q) * (1.0f / 512.0f), Dv = DEN[(size_t)m * 4 + h];
            const float rs = 1.0f / sqrtf(var + EPS * Dv * Dv);
            unpack8(*(const u32x4*)(Z + (size_t)m * ZP + ZO + h * 512 + 8 * lane), gz);
            const f32x4 g0 = *(const f32x4*)(hg + h * 512 + 8 * lane), g1 = *(const f32x4*)(hg + h * 512 + 8 * lane + 4);
#pragma unroll
            for (int e = 0; e < 8; ++e) o[e] = x[e] * rs * (e < 4 ? g0[e & 3] : g1[e & 3]) * sigmoidf_(gz[e]);
            *(u32x4*)(m < MP ? HA + (size_t)m * 2048 + h * 512 + 8 * lane : HA + (size_t)MP * 2048 + fo_index(m - MP, h * 512 + 8 * lane, 2048)) = pack8(o, 1.0f);
        }
#pragma unroll
        for (int gq = 0; gq < 4; ++gq) {
            float y[8], zz[8]; unpack8(*(const u32x4*)(YS + (size_t)m * 2048 + gq * 512 + 8 * lane), y); unpack8(*(const u32x4*)(Z + (size_t)m * ZP + ZZ + gq * 512 + 8 * lane), zz);
            float q = 0.f;
#pragma unroll
            for (int e = 0; e < 8; ++e) { y[e] *= siluf_(zz[e]); q += y[e] * y[e]; }
            const float rs = 1.0f / sqrtf(wave_sum(q) * (1.0f / 512.0f) + EPS);
            const f32x4 g0 = *(const f32x4*)(sg + gq * 512 + 8 * lane), g1 = *(const f32x4*)(sg + gq * 512 + 8 * lane + 4);
#pragma unroll
            for (int e = 0; e < 8; ++e) y[e] = y[e] * rs * (e < 4 ? g0[e & 3] : g1[e & 3]);
            *(u32x4*)(m < MP ? HB + (size_t)m * 2048 + gq * 512 + 8 * lane : HB + (size_t)MP * 2048 + fo_index(m - MP, gq * 512 + 8 * lane, 2048)) = pack8(y, 1.0f);
        }
    }
    const int gt = F.bx * NTHREADS + F.tid, NGT = F.G * NTHREADS;
    constexpr int N1 = NBP * 3 * 2048, N2 = NBS * 3 * 2048, N3 = NBP * 3 * 3072, N4 = NBS * 3 * 3072;
    for (int i = gt; i < N1 + N2 + N3 + N4; i += NGT) {
        int j = i;
        if (j < N1) { const int b = j / 6144, r = (j / 2048) % 3, ch = j % 2048; F.out[O_PMC + j] = bf2f(Z[(size_t)(b * SEQ + SEQ - 3 + r) * ZP + ch]); continue; } j -= N1;
        if (j < N2) { const int b = j / 6144, r = (j / 2048) % 3, ch = j % 2048; F.out[O_SMC + j] = bf2f(Z[(size_t)(MP + b * TS + TS - 3 + r) * ZP + ch]); continue; } j -= N2;
        if (j < N3) { const int b = j / 9216, r = (j / 3072) % 3, ch = j % 3072; F.out[O_PSC + j] = bf2f(Z[(size_t)(b * SEQ + SEQ - 3 + r) * ZP + ZX + ch]); continue; } j -= N3;
        { const int b = j / 9216, r = (j / 3072) % 3, ch = j % 3072; F.out[O_SSC + j] = bf2f(Z[(size_t)(MP + b * TS + TS - 3 + r) * ZP + ZX + ch]); }
    }
}


#ifndef STAG_LEVELS
#define STAG_LEVELS 8
#endif
#ifndef STAG_SLEEP
#define STAG_SLEEP 16
#endif
__device__ __forceinline__ void stagger_start(const Frame& F) { const int sl = (F.bx >> 3) & (STAG_LEVELS - 1); for (int q = 0; q < sl; ++q) __builtin_amdgcn_s_sleep(STAG_SLEEP); }

constexpr int LDS_BYTES = 147456;
constexpr int NPHASE = 15;

__global__ void __launch_bounds__(NTHREADS, 2) fwd_kernel(Params p) {
    extern __shared__ __attribute__((aligned(16))) unsigned char lds_raw[];
    Frame F;
    F.lds = (LAS unsigned char*)lds_raw;
    F.tid = threadIdx.x; F.lane = F.tid & 63; F.wave = __builtin_amdgcn_readfirstlane(F.tid >> 6);
    F.G = gridDim.x; F.bx = blockIdx.x;
    F.out = p.out; F.ws = p.ws;
    unsigned char* ws = p.ws;
    bf16_t* U = (bf16_t*)(ws + WS_U); bf16_t* H = (bf16_t*)(ws + WS_H); float* X1 = (float*)(ws + WS_X1);
    bf16_t* ZIN = (bf16_t*)(ws + WS_ZIN); float* GATES = (float*)(ws + WS_GATES); float* MOD = (float*)(ws + WS_MOD);
    const int lo = p.ph_lo, hi = p.ph_hi;
#ifndef PH_MASK
#define PH_MASK 0xfffff
#endif
#define IN(k) (((PH_MASK >> (k)) & 1) && lo <= (k) && (k) < hi)
#ifndef DUP_MASK
#define DUP_MASK 0
#endif
#define DUP(k) ((DUP_MASK >> (k)) & 1)
    volatile LAS unsigned* MISC = (volatile LAS unsigned*)(F.lds + LDS_BYTES - 64);
    if (F.tid < 16) MISC[F.tid] = 0u;
    if (F.tid == 0) { volatile LAS unsigned* T = (volatile LAS unsigned*)(F.lds + PTAB_OFF);
#pragma unroll
        for (int k = 0; k < 36; ++k) { const uint64_t a = (uint64_t)p.in[k]; T[2 * k] = (unsigned)a; T[2 * k + 1] = (unsigned)(a >> 32); } }
    __syncthreads();
    XcdBarrier bar; bar.bar = (unsigned*)(ws + WS_CTL); bar.x = 0; bar.st = nullptr;
    if (hi - lo > 1) bar = xcd_barrier_post((unsigned*)(ws + WS_CTL), MISC);
#define SEAM(k) do { if (IN(k) && IN((k) + 1)) { xcd_barrier(bar); } } while (0)

    if (IN(0)) { phase_prep<0>(F, p); } SEAM(0);
    if (IN(1)) { phase_norm_mod(F, PIN(0), PIN(1), PIN(12), 0 * DM, 1 * DM, U); if (DUP(1)) phase_norm_mod(F, PIN(0), PIN(1), PIN(12), 0 * DM, 1 * DM, U); } SEAM(1);
    if (IN(2)) { pg8::Gemm g{U, U, (const bf16_t*)(ws + WS_WUP1), (const bf16_t*)(ws + WS_WUP1), DM}; pg8::Order S;
        if (F.bx < 192) { stagger_start(F); S.init_from(MT, 2 * DFF, 192, F.bx, 0, 1344); } else { phase_prep<1>(F, p); S.init_from(MT, 2 * DFF, 64, F.bx - 192, 1344, 1496); }
        pg8::EpiSwiGLU E{H}; pg8::gemm_phase(F.lds, g, S, E); if (DUP(2)) pg8::gemm_phase(F.lds, g, S, E); } SEAM(2);
    float* XS = (float*)(ws + WS_XS); unsigned* CNT = (unsigned*)(ws + WS_CTL) + CW_CNT; bf16_t* U2 = (bf16_t*)(ws + WS_U2);
    if (IN(3)) { stagger_start(F); pg8::Gemm g{H, H, (const bf16_t*)(ws + WS_WDN1), (const bf16_t*)(ws + WS_WDN1), DFF}; pg8::Order S; S.init(MP, DM, F.G, F.bx, 0);
        pg8::EpiResidNorm<false> E{PIN(0), X1, MOD + 2 * DM, PIN(16), MOD + 3 * DM, MOD + 4 * DM, U, nullptr, XS, CNT, 0.5f, 0}; pg8::gemm_phase(F.lds, g, S, E);
        small_phase_resid_norm<DFF, false>(F, H, (const bf16_t*)(ws + WS_FDN1), PIN(1), X1, MOD + 2 * DM, 0.5f, PIN(16), MOD + 3 * DM, MOD + 4 * DM, U, nullptr, XS, CNT); } SEAM(3);
    if (IN(5)) {
        const pg8::Gemm g{U, U, (const bf16_t*)(ws + WS_WIN), (const bf16_t*)(ws + WS_WIN), DM}; const pg8::EpiZin E{ZIN, GATES};
        { stagger_start(F); const pg8::OrderSample S{F.bx}; pg8::gemm_phase<pg8::EpiZin, true, pg8::OrderSample>(F.lds, g, S, E); }
        if (F.bx >= 208 && F.bx < 224) small_gates_tile(F, U, (const bf16_t*)(ws + WS_FG), GATES, MP / 64 + (F.bx - 208));
        if (F.bx >= 224) { for (int k = 0; k < 4; ++k) small_gates_tile(F, U, (const bf16_t*)(ws + WS_FG), GATES, 4 * (F.bx - 224) + k); }
        xcd_barrier(bar);
        if (F.bx >= 192) {
            const int s0 = F.bx - 192;
            for (int k = F.wave; k < 10; k += 8) conv_item(F, p, 5120 + 10 * s0 + k);
            asm volatile("s_waitcnt vmcnt(0)" ::: "memory"); __syncthreads(); __builtin_amdgcn_fence(__ATOMIC_ACQUIRE, "agent");
#pragma unroll 1
            for (int k = 0; k < 4; ++k) mlstm_sample_item(F, p, s0, k);
#pragma unroll 1
            for (int k = 0; k < 4; ++k) ssd_sample_item(F, p, s0, k);
            for (int k = 0; k < 2; ++k) small_gates_tile(F, U, (const bf16_t*)(ws + WS_FG), GATES, 128 + 2 * s0 + k);
        } else stagger_start(F);
        __syncthreads();
        { const pg8::OrderPrompt S{F.bx}; pg8::gemm_phase<pg8::EpiZin, true, pg8::OrderPrompt>(F.lds, g, S, E); }
        } SEAM(5);
    if (IN(6)) { phase_conv(F, p); if (DUP(6)) phase_conv(F, p); } SEAM(6);
    #ifndef DUP_IT
#define DUP_IT 15
#endif
    if (IN(7)) { phase_mixer(F, p, p.itm); } SEAM(7);
    if (IN(8)) { phase_finish(F, p); if (DUP(8)) phase_finish(F, p); } SEAM(8);
    if (IN(9)) { stagger_start(F); pg8::Gemm g{(const bf16_t*)(ws + WS_HA), (const bf16_t*)(ws + WS_HB), (const bf16_t*)(ws + WS_WPA), (const bf16_t*)(ws + WS_WPB), 2048}; pg8::Order S; S.init(MP, DM, F.G, F.bx, 1);
        pg8::EpiMerge E{ZIN, (float*)(ws + WS_TMP), U}; pg8::gemm_phase(F.lds, g, S, E);
        small_phase_merge(F, (const bf16_t*)(ws + WS_HA), (const bf16_t*)(ws + WS_HB), (const bf16_t*)(ws + WS_FPA), (const bf16_t*)(ws + WS_FPB), ZIN, U); } SEAM(9);
    if (IN(10)) { stagger_start(F); pg8::Gemm g{U, U, (const bf16_t*)(ws + WS_WOUT), (const bf16_t*)(ws + WS_WOUT), DM}; pg8::Order S; S.init(MP, DM, F.G, F.bx, 0);
        pg8::EpiResidNorm<false> E{X1, X1, MOD + 5 * DM, PIN(31), MOD + 6 * DM, MOD + 7 * DM, U2, nullptr, XS + (size_t)MT * 16, CNT + CNT_STRIDE, 1.0f, 0}; pg8::gemm_phase(F.lds, g, S, E);
        small_phase_resid_norm<DM, false>(F, U, (const bf16_t*)(ws + WS_FOUT), X1 + (size_t)MP * DM, X1, MOD + 5 * DM, 1.0f, PIN(31), MOD + 6 * DM, MOD + 7 * DM, U2, nullptr, XS + (size_t)MT * 16, CNT + CNT_STRIDE); } SEAM(10);
    if (IN(12)) { stagger_start(F); pg8::Gemm g{U2, U2, (const bf16_t*)(ws + WS_WUP2), (const bf16_t*)(ws + WS_WUP2), DM}; pg8::Order S; S.init(MT, 2 * DFF, F.G, F.bx, 0);
        pg8::EpiSwiGLU E{H}; pg8::gemm_phase(F.lds, g, S, E); } SEAM(12);
    if (IN(13)) { stagger_start(F); pg8::Gemm g{H, H, (const bf16_t*)(ws + WS_WDN2), (const bf16_t*)(ws + WS_WDN2), DFF}; pg8::Order S; S.init(MP, DM, F.G, F.bx, 0);
        pg8::EpiResidNorm<true> E{X1, nullptr, MOD + 8 * DM, PIN(35), nullptr, nullptr, nullptr, p.out, XS + (size_t)2 * MT * 16, CNT + 2 * CNT_STRIDE, 0.5f, 0}; pg8::gemm_phase(F.lds, g, S, E);
        small_phase_resid_norm<DFF, true>(F, H, (const bf16_t*)(ws + WS_FDN2), X1 + (size_t)MP * DM, nullptr, MOD + 8 * DM, 0.5f, PIN(35), nullptr, nullptr, nullptr, p.out, XS + (size_t)2 * MT * 16, CNT + 2 * CNT_STRIDE); }
#undef IN
#undef SEAM
}

extern "C" void kernel_launch(void* const* d_in, const int* in_sizes, int n_in, void* d_out, int out_size, void* d_ws, size_t ws_size, hipStream_t stream) {
    static int grid = 0;
    if (grid == 0) {
        if (n_in != 36 || ws_size < WS_END) { fprintf(stderr, "kernel_launch: expected 36 inputs and >= %zu bytes of workspace (got %d, %zu)\n", (size_t)WS_END, n_in, ws_size); grid = -1; return; }
        int dev = 0, cus = 0, per_cu = 0;
        hipGetDevice(&dev); hipDeviceGetAttribute(&cus, hipDeviceAttributeMultiprocessorCount, dev);
        hipFuncSetAttribute((const void*)fwd_kernel, hipFuncAttributeMaxDynamicSharedMemorySize, LDS_BYTES);
        hipOccupancyMaxActiveBlocksPerMultiprocessor(&per_cu, (const void*)fwd_kernel, NTHREADS, LDS_BYTES);
        if (per_cu < 1) { fprintf(stderr, "kernel_launch: occupancy query says %d blocks per CU\n", per_cu); grid = -1; return; }
        grid = cus;
        if (grid != 256) { fprintf(stderr, "kernel_launch: the fused-norm GEMM epilogues need exactly 256 workgroups (one 256x256 tile each); this device has %d CUs\n", cus); grid = -1; return; }
    }
    if (grid < 0) return;
    Params p{};
    for (int i = 0; i < 36; ++i) p.in[i] = (const float*)d_in[i];
    p.out = (float*)d_out; p.ws = (unsigned char*)d_ws; p.itm = 15;
#if MK_LAUNCH_PER_PHASE
    for (int ph = 0; ph < NPHASE; ++ph) { p.ph_lo = ph; p.ph_hi = ph + 1; hipLaunchKernelGGL(fwd_kernel, dim3(grid), dim3(NTHREADS), LDS_BYTES, stream, p); }
#else
    p.ph_lo = 0; p.ph_hi = NPHASE;
    if (hipMemsetAsync((char*)d_ws + WS_CTL, 0, 98304, stream) != hipSuccess) { fprintf(stderr, "kernel_launch: memset of the barrier words failed\n"); return; }
    void* args[] = {&p};
    hipError_t e = hipLaunchCooperativeKernel((const void*)fwd_kernel, dim3(grid), dim3(NTHREADS), args, LDS_BYTES, stream);
    if (e != hipSuccess) fprintf(stderr, "cooperative launch failed: %s (grid %d)\n", hipGetErrorString(e), grid);
#ifdef PROBE_PH
    for (int r = 0; r < PROBE_REPS; ++r) { Params q = p; q.ph_lo = PROBE_PH; q.ph_hi = PROBE_PH + 1; q.itm = PROBE_ITM; hipLaunchKernelGGL(fwd_kernel, dim3(grid), dim3(NTHREADS), LDS_BYTES, stream, q); }
#endif
#endif
}
```

```cpp
#include <hip/hip_runtime.h>
#include <hip/hip_cooperative_groups.h>
#include <cstdio>
#include <cstdint>
namespace cg = cooperative_groups;

#ifndef MK_LAUNCH_PER_PHASE
#define MK_LAUNCH_PER_PHASE 0
#endif

constexpr int DM = 1024, SEQ = 2048, NBP = 8, NBS = 128, TS = 8;
constexpr int MP = NBP * SEQ, MS = NBS * TS, MT = MP + MS, NBID = NBP + NBS;
constexpr int DFF = 2816, NMOD = 9 * DM;
constexpr int ZP = 13568;
constexpr int ZQ = 0, ZK = 1024, ZV = 2048, ZO = 4096, ZZ = 6144, ZX = 8192, ZGA = 11264, ZGB = 12288, ZG = 13312;
constexpr float EPS = 1e-6f;
constexpr int NTHREADS = 512;

constexpr size_t MiB = 1u << 20;
constexpr size_t WS_CTL = 0;
constexpr size_t WS_WUP1 = 1 * MiB;
constexpr size_t WS_WDN1 = WS_WUP1 + 11 * MiB;
constexpr size_t WS_WUP2 = WS_WDN1 + 6 * MiB;
constexpr size_t WS_WDN2 = WS_WUP2 + 11 * MiB;
constexpr size_t WS_WIN = WS_WDN2 + 6 * MiB;
constexpr size_t WS_WPA = WS_WIN + 27 * MiB;
constexpr size_t WS_WPB = WS_WPA + 4 * MiB;
constexpr size_t WS_WOUT = WS_WPB + 4 * MiB;
constexpr size_t WS_MOD = WS_WOUT + 2 * MiB;
constexpr size_t WS_U = WS_MOD + 5 * MiB;
constexpr size_t WS_H = WS_U + 34 * MiB;
constexpr size_t WS_X1 = WS_H + 94 * MiB;
constexpr size_t WS_ZIN = WS_X1 + 68 * MiB;
constexpr size_t WS_GATES = WS_ZIN + 451 * MiB;
constexpr size_t WS_YS = WS_GATES + 5 * MiB;
constexpr size_t WS_DEN = WS_YS + 68 * MiB;
constexpr size_t WS_HA = WS_DEN + 1 * MiB;
constexpr size_t WS_HB = WS_HA + 68 * MiB;
constexpr size_t WS_CV = WS_HA;
constexpr size_t WS_XS = WS_CV + 170 * MiB;
constexpr size_t WS_U2 = WS_ZIN;
constexpr size_t WS_FDN1 = WS_XS + 4 * MiB;
constexpr size_t WS_FDN2 = WS_FDN1 + 6 * MiB;
constexpr size_t WS_FPA = WS_FDN2 + 6 * MiB;
constexpr size_t WS_FPB = WS_FPA + 4 * MiB;
constexpr size_t WS_FOUT = WS_FPB + 4 * MiB;
constexpr size_t WS_FG = WS_FOUT + 2 * MiB;
constexpr size_t WS_END = WS_FG + 1 * MiB;
constexpr int CW_CNT = 4096, CNT_STRIDE = 5120;
constexpr size_t WS_NUM = WS_H;
constexpr size_t WS_TMP = WS_YS;
static_assert(WS_END <= 1024 * MiB, "workspace map");

#define LAS __attribute__((address_space(3)))
typedef unsigned short bf16_t;
typedef short bf16x8 __attribute__((ext_vector_type(8)));
typedef short s16x4 __attribute__((ext_vector_type(4)));
typedef float f32x4 __attribute__((ext_vector_type(4)));
typedef float f32x2 __attribute__((ext_vector_type(2)));
typedef unsigned u32x4 __attribute__((ext_vector_type(4)));
typedef unsigned u32x2 __attribute__((ext_vector_type(2)));

typedef __bf16 bf16x2_t __attribute__((ext_vector_type(2)));
__device__ __forceinline__ unsigned cvt_pk_bf16(float lo, float hi) { const bf16x2_t v = {(__bf16)lo, (__bf16)hi}; return __builtin_bit_cast(unsigned, v); }
__device__ __forceinline__ float bf2f(unsigned short b) { return __uint_as_float(((unsigned)b) << 16); }
__device__ __forceinline__ float bflo(unsigned w) { return __uint_as_float(w << 16); }
__device__ __forceinline__ float bfhi(unsigned w) { return __uint_as_float(w & 0xffff0000u); }
__device__ __forceinline__ float fast_exp(float x) { return __builtin_amdgcn_exp2f(x * 1.4426950408889634f); }
__device__ __forceinline__ float sigmoidf_(float x) { return __builtin_amdgcn_rcpf(1.0f + fast_exp(-x)); }
__device__ __forceinline__ float siluf_(float x) { return x * sigmoidf_(x); }
__device__ __forceinline__ u32x4 pack8(const float (&v)[8], float s) {
    u32x4 w; w.x = cvt_pk_bf16(v[0] * s, v[1] * s); w.y = cvt_pk_bf16(v[2] * s, v[3] * s); w.z = cvt_pk_bf16(v[4] * s, v[5] * s); w.w = cvt_pk_bf16(v[6] * s, v[7] * s); return w;
}
__device__ __forceinline__ u32x2 pack4(const f32x4 v) { u32x2 w; w.x = cvt_pk_bf16(v[0], v[1]); w.y = cvt_pk_bf16(v[2], v[3]); return w; }
__device__ __forceinline__ void unpack8(const u32x4 v, float (&x)[8]) { x[0] = bflo(v.x); x[1] = bfhi(v.x); x[2] = bflo(v.y); x[3] = bfhi(v.y); x[4] = bflo(v.z); x[5] = bfhi(v.z); x[6] = bflo(v.w); x[7] = bfhi(v.w); }
__device__ __forceinline__ size_t fo_index(int r, int k, int K) { return ((size_t)((r >> 4) * (K >> 5) + (k >> 5))) * 512 + (size_t)((((r & 15) + 16 * ((k >> 3) & 3)) << 3) + (k & 7)); }
__device__ __forceinline__ float wave_scan_add(float v) {
    v += __builtin_bit_cast(float, __builtin_amdgcn_update_dpp(0, __builtin_bit_cast(int, v), 0x111, 0xf, 0xf, true));
    v += __builtin_bit_cast(float, __builtin_amdgcn_update_dpp(0, __builtin_bit_cast(int, v), 0x112, 0xf, 0xf, true));
    v += __builtin_bit_cast(float, __builtin_amdgcn_update_dpp(0, __builtin_bit_cast(int, v), 0x114, 0xf, 0xf, true));
    v += __builtin_bit_cast(float, __builtin_amdgcn_update_dpp(0, __builtin_bit_cast(int, v), 0x118, 0xf, 0xf, true));
    v += __builtin_bit_cast(float, __builtin_amdgcn_update_dpp(0, __builtin_bit_cast(int, v), 0x142, 0xa, 0xf, true));
    v += __builtin_bit_cast(float, __builtin_amdgcn_update_dpp(0, __builtin_bit_cast(int, v), 0x143, 0xc, 0xf, true));
    return v;
}
__device__ __forceinline__ float wave_scan_max(float v) {
    const int ninf = (int)0xff800000u;
    v = fmaxf(v, __builtin_bit_cast(float, __builtin_amdgcn_update_dpp(ninf, __builtin_bit_cast(int, v), 0x111, 0xf, 0xf, false)));
    v = fmaxf(v, __builtin_bit_cast(float, __builtin_amdgcn_update_dpp(ninf, __builtin_bit_cast(int, v), 0x112, 0xf, 0xf, false)));
    v = fmaxf(v, __builtin_bit_cast(float, __builtin_amdgcn_update_dpp(ninf, __builtin_bit_cast(int, v), 0x114, 0xf, 0xf, false)));
    v = fmaxf(v, __builtin_bit_cast(float, __builtin_amdgcn_update_dpp(ninf, __builtin_bit_cast(int, v), 0x118, 0xf, 0xf, false)));
    v = fmaxf(v, __builtin_bit_cast(float, __builtin_amdgcn_update_dpp(ninf, __builtin_bit_cast(int, v), 0x142, 0xa, 0xf, false)));
    v = fmaxf(v, __builtin_bit_cast(float, __builtin_amdgcn_update_dpp(ninf, __builtin_bit_cast(int, v), 0x143, 0xc, 0xf, false)));
    return v;
}
__device__ __forceinline__ float wave_sum(float v) { return __builtin_bit_cast(float, __builtin_amdgcn_readlane(__builtin_bit_cast(int, wave_scan_add(v)), 63)); }

struct Params {
    const float* in[36];
    float* out;
    unsigned char* ws;
    int ph_lo, ph_hi, itm, pad;
};

namespace pg8 {
constexpr int BM = 256, BK = 64, HALF = 128, HTB = HALF * BK * 2, STAGE_BYTES = 8 * HTB, NXCD = 8, WGM = 8;
__host__ __device__ __forceinline__ int lds_byte(int r, int c) { const int st = (r >> 4) * 2 + (c >> 5), rr = r & 15, cc = c & 31, ob = rr * 64 + cc * 2; return st * 1024 + (ob ^ (((ob >> 9) & 1) << 5)); }
__host__ __device__ __forceinline__ void stage_rc(int b, int& R, int& C) { const int st = b / 1024, sb = b % 1024, swz = sb ^ (((sb >> 9) & 1) << 5); R = (st >> 1) * 16 + swz / 64; C = (st & 1) * 32 + (swz % 64) / 2; }
__host__ __device__ __forceinline__ int perm32(int rho) { const int n = rho >> 4, i = rho & 15; return 8 * (i >> 2) + 4 * n + (i & 3); }

struct Unit { int pm, pn, w; };
struct Gemm { const bf16_t* A0; const bf16_t* A1; const bf16_t* B0; const bf16_t* B1; int K; };

struct OrderSample { int c;
    __device__ bool next(int i, Unit& u) const { if (i > 0 || c >= 208) return false; const int x = c & 7, j = c >> 3; u.pm = 64 + (x >> 1); u.pn = (x & 1) * 26 + j; u.w = 0; return true; } };
struct OrderPrompt { int c;
    __device__ bool next(int i, Unit& u) const { const int x = c & 7, j = c >> 3; int q; if (j < 24) { if (i >= 17) return false; q = i * 24 + j; } else { if (i >= 1) return false; q = 408 + (j - 24); }
        u.pm = 8 * x + (q & 7); u.pn = q >> 3; u.w = 0; return true; } };
struct Order {
    int nM, nN, nwg, G, c, dual;
    __device__ void init(int M, int N, int G_, int c_, int dual_) { nM = M / BM; nN = N / BM; nwg = nM * nN; G = G_; c = c_; dual = dual_; }
    __device__ void init_from(int M, int N, int G_, int c_, int first, int lim) { nM = M / BM; nN = N / BM; nwg = lim; G = G_; c = first + c_; dual = 0; }
    __device__ bool next(int i, Unit& u) const {
        const int ti = dual ? (i >> 1) : i;
        const long L = (long)ti * G + c; if (L >= nwg) return false;
        int wgid = (int)L; { const int tot = nM * nN, q = tot / NXCD, r = tot % NXCD, xcd = wgid % NXCD, off = wgid / NXCD; wgid = (xcd < r ? xcd * (q + 1) : r * (q + 1) + (xcd - r) * q) + off; }
        const int nig = WGM * nN, gid = wgid / nig, fm = gid * WGM, gsz = (nM - fm) < WGM ? (nM - fm) : WGM;
        u.pm = fm + ((wgid % nig) % gsz); u.pn = (wgid % nig) / gsz; u.w = dual ? (i & 1) : 0; return true;
    }
};

template <class Epi, bool ALIGN_EPI = true, class Ord = Order>
__device__ __forceinline__ void gemm_phase(LAS unsigned char* lds, const Gemm g, const Ord& S, const Epi E) {
    const int tid = threadIdx.x, wid = __builtin_amdgcn_readfirstlane(tid >> 6), lane = tid & 63, wr = wid >> 2, wc = wid & 3, fr = lane & 15, fq = lane >> 4;
    const int K = g.K, nt = K / BK;
    unsigned voffA[2], voffB[2];
#pragma unroll
    for (int i = 0; i < 2; ++i) { int R, C; stage_rc(tid * 16 + i * 8192, R, C); const int Rb = Epi::PERM ? ((R & ~31) + perm32(R & 31)) : R;
        voffA[i] = (unsigned)(R * K + C) * 2u; voffB[i] = (unsigned)(Rb * K + C) * 2u; }
    const size_t kstep = (size_t)(BK * 2);
    const size_t hstep = (size_t)HALF * K * 2;
    const size_t tstep = 2 * hstep;
    const unsigned ldsw = (unsigned)wid * 1024u;
    const int aoff = lds_byte(wr * 64 + fr, fq * 8), boff = lds_byte(wc * 32 + fr, fq * 8);
#define PG8_SA(b, h) (((b) * 2 + (h)) * HTB)
#define PG8_SB(b, h) ((4 + (b) * 2 + (h)) * HTB)
#define PG8_STAGE(bufoff, gbase, voff) do { _Pragma("unroll") for (int _i = 0; _i < 2; ++_i) \
        __builtin_amdgcn_global_load_lds((const unsigned*)((const char*)(gbase) + (voff)[_i]), (LAS unsigned*)(lds + (bufoff) + ldsw + _i * 8192), 16, 0, 0); } while (0)
#define PG8_LDA(dst, b, h) do { _Pragma("unroll") for (int m = 0; m < 4; ++m) _Pragma("unroll") for (int k = 0; k < 2; ++k) dst[m][k] = *(const LAS bf16x8*)(lds + PG8_SA(b, h) + aoff + m * 2048 + k * 1024); } while (0)
#define PG8_LDB(dst, b, h) do { _Pragma("unroll") for (int n = 0; n < 2; ++n) _Pragma("unroll") for (int k = 0; k < 2; ++k) dst[n][k] = *(const LAS bf16x8*)(lds + PG8_SB(b, h) + boff + n * 2048 + k * 1024); } while (0)
#define PG8_MMA(ai, bj, At, Bt) do { __builtin_amdgcn_s_setprio(1); _Pragma("unroll") for (int m = 0; m < 4; ++m) _Pragma("unroll") for (int n = 0; n < 2; ++n) _Pragma("unroll") for (int k = 0; k < 2; ++k) \
        acc[ai][bj][m][n] = __builtin_amdgcn_mfma_f32_16x16x32_bf16(Bt[n][k], At[m][k], acc[ai][bj][m][n], 0, 0, 0); __builtin_amdgcn_s_setprio(0); } while (0)
#define PG8_WAIT_V(n) asm volatile("s_waitcnt vmcnt(" #n ")" ::: "memory")
#define PG8_WAIT_L(n) asm volatile("s_waitcnt lgkmcnt(" #n ")" ::: "memory")
#define PG8_BAR __builtin_amdgcn_s_barrier()
#define PG8_SCHED __builtin_amdgcn_sched_barrier(0)
    Unit cur, nxt; int ui = 0;
    if (!S.next(0, cur)) return;
    f32x4 acc[2][2][4][2];
#pragma unroll
    for (int a = 0; a < 2; ++a)
#pragma unroll
        for (int b = 0; b < 2; ++b)
#pragma unroll
            for (int m = 0; m < 4; ++m)
#pragma unroll
                for (int n = 0; n < 2; ++n) acc[a][b][m][n] = (f32x4){0.f, 0.f, 0.f, 0.f};
    bf16x8 At[4][2], B0[2][2], B1[2][2];
    const char* cA = (const char*)(cur.w ? g.A1 : g.A0) + (size_t)cur.pm * tstep; const char* cB = (const char*)(cur.w ? g.B1 : g.B0) + (size_t)cur.pn * tstep;
    PG8_STAGE(PG8_SB(0, 0), cB, voffB); PG8_STAGE(PG8_SB(0, 1), cB + hstep, voffB); PG8_STAGE(PG8_SA(0, 0), cA, voffA); PG8_STAGE(PG8_SA(0, 1), cA + hstep, voffA);
    if (wr == 1) PG8_BAR;
    PG8_WAIT_V(2); PG8_BAR;
    PG8_STAGE(PG8_SB(1, 0), cB + kstep, voffB); PG8_STAGE(PG8_SA(1, 0), cA + kstep, voffA); PG8_STAGE(PG8_SB(1, 1), cB + hstep + kstep, voffB);
    PG8_WAIT_V(6); PG8_BAR;
    for (;;) {
        const bool has_next = S.next(ui + 1, nxt);
        const char* nA = has_next ? (const char*)(nxt.w ? g.A1 : g.A0) + (size_t)nxt.pm * tstep : cA; const char* nB = has_next ? (const char*)(nxt.w ? g.B1 : g.B0) + (size_t)nxt.pn * tstep : cB;
        for (int t = 0; t < nt; t += 2) {
            const bool last = (t == nt - 2);
            const char* a1 = cA + (size_t)(t + 1) * kstep;
            const char* a2 = last ? nA : cA + (size_t)(t + 2) * kstep; const char* b2 = last ? nB : cB + (size_t)(t + 2) * kstep;
            const char* a3 = a2 + kstep; const char* b3 = b2 + kstep;
            PG8_LDB(B0, 0, 0); PG8_LDB(B1, 0, 1); PG8_SCHED; PG8_LDA(At, 0, 0); PG8_STAGE(PG8_SA(1, 1), a1 + hstep, voffA);
            PG8_WAIT_V(8); PG8_WAIT_L(0); PG8_BAR; PG8_MMA(0, 0, At, B0); PG8_MMA(0, 1, At, B1); PG8_BAR; PG8_SCHED;
            PG8_LDA(At, 0, 1); PG8_STAGE(PG8_SB(0, 0), b2, voffB); PG8_STAGE(PG8_SB(0, 1), b2 + hstep, voffB); PG8_STAGE(PG8_SA(0, 0), a2, voffA);
            PG8_WAIT_V(8); PG8_WAIT_L(0); PG8_BAR; PG8_MMA(1, 0, At, B0); PG8_MMA(1, 1, At, B1); PG8_BAR; PG8_SCHED;
            PG8_LDB(B0, 1, 0); PG8_LDB(B1, 1, 1); PG8_SCHED; PG8_LDA(At, 1, 0); PG8_STAGE(PG8_SA(0, 1), a2 + hstep, voffA);
            PG8_WAIT_V(8); PG8_WAIT_L(0); PG8_BAR; PG8_MMA(0, 0, At, B0); PG8_MMA(0, 1, At, B1); PG8_BAR; PG8_SCHED;
            PG8_LDA(At, 1, 1); PG8_STAGE(PG8_SB(1, 0), b3, voffB); PG8_STAGE(PG8_SB(1, 1), b3 + hstep, voffB); PG8_STAGE(PG8_SA(1, 0), a3, voffA);
            PG8_WAIT_V(8); PG8_WAIT_L(0); PG8_BAR; PG8_MMA(1, 0, At, B0); PG8_MMA(1, 1, At, B1); PG8_BAR; PG8_SCHED;
        }
        if constexpr (ALIGN_EPI) { if (wr == 0) PG8_BAR; }
        if constexpr (!Epi::AFTER_DRAIN) E(acc, cur, wr, wc, fr, fq);
        if (!has_next) break;
#pragma unroll
        for (int a = 0; a < 2; ++a)
#pragma unroll
            for (int b = 0; b < 2; ++b)
#pragma unroll
                for (int m = 0; m < 4; ++m)
#pragma unroll
                    for (int n = 0; n < 2; ++n) acc[a][b][m][n] = (f32x4){0.f, 0.f, 0.f, 0.f};
        cur = nxt; cA = nA; cB = nB; ++ui;
        if constexpr (ALIGN_EPI) { if (wr == 1) PG8_BAR; }
    }
    PG8_WAIT_V(0);
    if constexpr (!ALIGN_EPI) { if (wr == 0) PG8_BAR; }
    PG8_BAR;
    if constexpr (Epi::AFTER_DRAIN) E.fused(acc, cur, wr, wc, fr, fq, lds, wid, lane);
#undef PG8_SA
#undef PG8_SB
#undef PG8_STAGE
#undef PG8_LDA
#undef PG8_LDB
#undef PG8_MMA
#undef PG8_WAIT_V
#undef PG8_WAIT_L
#undef PG8_BAR
#undef PG8_SCHED
}

__device__ __forceinline__ int bid_of_row(int row) { return row < MP ? (row >> 11) : (NBP + ((row - MP) >> 3)); }

struct EpiSwiGLU {
    static constexpr bool PERM = true, AFTER_DRAIN = false;
    bf16_t* H;
    __device__ __forceinline__ void operator()(const f32x4 (&acc)[2][2][4][2], const Unit& u, int wr, int wc, int fr, int fq) const {
        const int row0 = u.pm * BM + wr * 64 + fr, hc0 = u.pn * 128 + wc * 32 + 8 * fq;
#pragma unroll
        for (int ai = 0; ai < 2; ++ai)
#pragma unroll
            for (int m = 0; m < 4; ++m) { const f32x4 a0 = acc[ai][0][m][0], a1 = acc[ai][0][m][1], b0 = acc[ai][1][m][0], b1 = acc[ai][1][m][1];
                u32x4 w; w.x = cvt_pk_bf16(siluf_(a0[0]) * b0[0], siluf_(a0[1]) * b0[1]); w.y = cvt_pk_bf16(siluf_(a0[2]) * b0[2], siluf_(a0[3]) * b0[3]);
                w.z = cvt_pk_bf16(siluf_(a1[0]) * b1[0], siluf_(a1[1]) * b1[1]); w.w = cvt_pk_bf16(siluf_(a1[2]) * b1[2], siluf_(a1[3]) * b1[3]);
                const int row = row0 + ai * HALF + m * 16;
                if (u.pm < MP / BM) *(u32x4*)(H + (size_t)row * DFF + hc0) = w;
                else *(u32x4*)(H + (size_t)MP * DFF + fo_index(row - MP, hc0, DFF)) = w; }
    }
};
struct EpiResid {
    static constexpr bool PERM = false, AFTER_DRAIN = false;
    const float* xin_p; const float* xin_s; float* out; const float* gmod; float coef;
    __device__ __forceinline__ void operator()(const f32x4 (&acc)[2][2][4][2], const Unit& u, int wr, int wc, int fr, int fq) const {
        const int row0 = u.pm * BM + wr * 64 + fr, col0 = u.pn * BM + wc * 32 + 4 * fq;
#pragma unroll
        for (int ai = 0; ai < 2; ++ai)
#pragma unroll
            for (int m = 0; m < 4; ++m) { const int row = row0 + ai * HALF + m * 16;
                const float* xr = (row < MP ? xin_p + (size_t)row * DM : xin_s + (size_t)(row - MP) * DM) + col0;
                const float* gr = gmod + (size_t)bid_of_row(row) * NMOD + col0; float* orow = out + (size_t)row * DM + col0;
#pragma unroll
                for (int bj = 0; bj < 2; ++bj)
#pragma unroll
                    for (int n = 0; n < 2; ++n) { const int o = bj * HALF + n * 16; const f32x4 xv = *(const f32x4*)(xr + o), gv = *(const f32x4*)(gr + o);
                        *(f32x4*)(orow + o) = xv + coef * gv * acc[ai][bj][m][n]; } }
    }
};

__device__ __forceinline__ void panel_wait(unsigned* cnt, unsigned need) {
    unsigned spins = 0;
    while ((unsigned)__builtin_amdgcn_readfirstlane(__hip_atomic_load(cnt, __ATOMIC_RELAXED, __HIP_MEMORY_SCOPE_AGENT)) < need) { if (++spins > (1u << 20)) break; __builtin_amdgcn_s_sleep(2); }
    __builtin_amdgcn_fence(__ATOMIC_ACQUIRE, "agent");
}
template <bool FINAL>
struct EpiResidNorm {
    static constexpr bool PERM = true, AFTER_DRAIN = true;
    const float* xin; float* Xout; const float* gmod; const float* gw; const float* shmod; const float* scmod; bf16_t* Uout; float* Yout; float* XS; unsigned* cnt; float coef; int pad_;
    __device__ __forceinline__ void fused(f32x4 (&acc)[2][2][4][2], const Unit& u, int wr, int wc, int fr, int fq, LAS unsigned char* lds, int wid, int lane) const {
        LAS float* P = (LAS float*)lds; LAS float* S = (LAS float*)(lds + 4096);
        const float* const xin_ = xin; float* const Xout_ = Xout; const float* const gmod_ = gmod; const float coef_ = coef; const float* const gw_ = gw; const float* const shmod_ = shmod; const float* const scmod_ = scmod;
        bf16_t* const Uout_ = Uout; float* const Yout_ = Yout; float* const XS_ = XS; unsigned* const cnt_ = cnt;
        const int b = u.pm >> 3, col0 = u.pn * BM + wc * 32 + 8 * fq, rowt = wr * 64 + fr;
        { f32x4 gv[2][2];
#pragma unroll
          for (int bj = 0; bj < 2; ++bj)
#pragma unroll
              for (int n = 0; n < 2; ++n) gv[bj][n] = coef_ * *(const f32x4*)(gmod_ + (size_t)b * NMOD + col0 + bj * HALF + n * 4);
#pragma unroll
          for (int ai = 0; ai < 2; ++ai)
#pragma unroll
              for (int m = 0; m < 4; ++m) { const int rt = rowt + ai * HALF + m * 16; const float* xr = xin_ + (size_t)(u.pm * BM + rt) * DM + col0; float ss = 0.f;
#pragma unroll
                  for (int bj = 0; bj < 2; ++bj)
#pragma unroll
                      for (int n = 0; n < 2; ++n) { const f32x4 x = *(const f32x4*)(xr + bj * HALF + n * 4) + gv[bj][n] * acc[ai][bj][m][n]; acc[ai][bj][m][n] = x; ss += (x[0] * x[0] + x[1] * x[1]) + (x[2] * x[2] + x[3] * x[3]); }
                  ss += __shfl_xor(ss, 16); ss += __shfl_xor(ss, 32);
                  if (fq == 0) P[rt * 4 + wc] = ss;
                  asm volatile("" ::: "memory"); } }
        __syncthreads();
        const int r32 = wid * 32 + (lane & 31); float* slot = XS_ + (size_t)(u.pm * BM + r32) * 16;
        if (lane < 32) { const f32x4 pp = *(const LAS f32x4*)(P + r32 * 4); __hip_atomic_store(slot + u.pn, (pp[0] + pp[1]) + (pp[2] + pp[3]), __ATOMIC_RELAXED, __HIP_MEMORY_SCOPE_AGENT); }
        asm volatile("s_waitcnt vmcnt(0)" ::: "memory");
        if (lane == 0) __hip_atomic_fetch_add(cnt_ + 64 * u.pm, 1u, __ATOMIC_RELAXED, __HIP_MEMORY_SCOPE_AGENT);
        if (wid == 0) panel_wait(cnt_ + 64 * u.pm, 32u);
        asm volatile("s_waitcnt vmcnt(0) lgkmcnt(0)" ::: "memory");
        __syncthreads();
        if (lane < 32) { float tot = 0.f;
#pragma unroll
            for (int t = 0; t < 4; ++t) tot += __hip_atomic_load(slot + t, __ATOMIC_RELAXED, __HIP_MEMORY_SCOPE_AGENT);
            S[r32] = 1.0f / sqrtf(tot * (1.0f / DM) + EPS); }
        __syncthreads();
        f32x4 fac[2][2], shv[2][2];
#pragma unroll
        for (int bj = 0; bj < 2; ++bj)
#pragma unroll
            for (int n = 0; n < 2; ++n) { const int c = col0 + bj * HALF + n * 4; fac[bj][n] = *(const f32x4*)(gw_ + c);
                if constexpr (!FINAL) { fac[bj][n] = fac[bj][n] * (1.0f + *(const f32x4*)(scmod_ + (size_t)b * NMOD + c)); shv[bj][n] = *(const f32x4*)(shmod_ + (size_t)b * NMOD + c); } }
#pragma unroll
        for (int ai = 0; ai < 2; ++ai)
#pragma unroll
            for (int m = 0; m < 4; ++m) { const int rt = rowt + ai * HALF + m * 16; const size_t off = (size_t)(u.pm * BM + rt) * DM + col0; const float r = S[rt];
#pragma unroll
                for (int bj = 0; bj < 2; ++bj) { const f32x4 x0 = acc[ai][bj][m][0], x1 = acc[ai][bj][m][1]; const int o = bj * HALF;
                    if constexpr (FINAL) { *(f32x4*)(Yout_ + off + o) = x0 * r * fac[bj][0]; *(f32x4*)(Yout_ + off + o + 4) = x1 * r * fac[bj][1]; }
                    else { *(f32x4*)(Xout_ + off + o) = x0; *(f32x4*)(Xout_ + off + o + 4) = x1;
                        const u32x2 w0 = pack4(x0 * r * fac[bj][0] + shv[bj][0]), w1 = pack4(x1 * r * fac[bj][1] + shv[bj][1]);
                        *(u32x4*)(Uout_ + off + o) = (u32x4){w0.x, w0.y, w1.x, w1.y}; } } }
    }
};
struct EpiZin {
    static constexpr bool PERM = true, AFTER_DRAIN = false;
    bf16_t* Z; float* gates;
    __device__ __forceinline__ void operator()(const f32x4 (&acc)[2][2][4][2], const Unit& u, int wr, int wc, int fr, int fq) const {
        const int row0 = u.pm * BM + wr * 64 + fr;
        {
            const int col0 = u.pn * BM + wc * 32 + 8 * fq;
#pragma unroll
            for (int ai = 0; ai < 2; ++ai)
#pragma unroll
                for (int m = 0; m < 4; ++m) { bf16_t* rp = Z + (size_t)(row0 + ai * HALF + m * 16) * ZP + col0;
#pragma unroll
                    for (int bj = 0; bj < 2; ++bj) { const f32x4 v0 = acc[ai][bj][m][0], v1 = acc[ai][bj][m][1];
                        u32x4 w; w.x = cvt_pk_bf16(v0[0], v0[1]); w.y = cvt_pk_bf16(v0[2], v0[3]); w.z = cvt_pk_bf16(v1[0], v1[1]); w.w = cvt_pk_bf16(v1[2], v1[3]);
                        *(u32x4*)(rp + bj * HALF) = w; } }
        }
    }
};
struct EpiMerge {
    static constexpr bool PERM = true, AFTER_DRAIN = false;
    const bf16_t* Z; float* tmp; bf16_t* U;
    __device__ __forceinline__ void operator()(const f32x4 (&acc)[2][2][4][2], const Unit& u, int wr, int wc, int fr, int fq) const {
        const int row0 = u.pm * BM + wr * 64 + fr, col0 = u.pn * BM + wc * 32 + 8 * fq;
        const int zoff = u.w ? ZGB : ZGA;
#pragma unroll
        for (int ai = 0; ai < 2; ++ai)
#pragma unroll
            for (int m = 0; m < 4; ++m) { const int row = row0 + ai * HALF + m * 16;
#pragma unroll
                for (int bj = 0; bj < 2; ++bj) { const int c = col0 + bj * HALF;
                    const u32x4 gz = *(const u32x4*)(Z + (size_t)row * ZP + zoff + c);
                    f32x4 s0, s1; s0[0] = sigmoidf_(bflo(gz.x)); s0[1] = sigmoidf_(bfhi(gz.x)); s0[2] = sigmoidf_(bflo(gz.y)); s0[3] = sigmoidf_(bfhi(gz.y));
                    s1[0] = sigmoidf_(bflo(gz.z)); s1[1] = sigmoidf_(bfhi(gz.z)); s1[2] = sigmoidf_(bflo(gz.w)); s1[3] = sigmoidf_(bfhi(gz.w));
                    f32x4 v0 = s0 * acc[ai][bj][m][0], v1 = s1 * acc[ai][bj][m][1];
                    u32x4* up = (u32x4*)(U + (size_t)row * DM + c);
                    if (u.w != 0) { const u32x4 pv = *up; v0[0] += bflo(pv.x); v0[1] += bfhi(pv.x); v0[2] += bflo(pv.y); v0[3] += bfhi(pv.y); v1[0] += bflo(pv.z); v1[1] += bfhi(pv.z); v1[2] += bflo(pv.w); v1[3] += bfhi(pv.w); }
                    u32x4 w; w.x = cvt_pk_bf16(v0[0], v0[1]); w.y = cvt_pk_bf16(v0[2], v0[3]); w.z = cvt_pk_bf16(v1[0], v1[1]); w.w = cvt_pk_bf16(v1[2], v1[3]);
                    *up = w; } }
    }
};
}


struct Frame {
    LAS unsigned char* lds;
    int tid, lane, wave, G, bx;
    float* out; unsigned char* ws;
};
constexpr int PTAB_OFF = 147072;
__device__ __forceinline__ const float* pin_ld(const Frame& F, const int k) {
    const volatile LAS unsigned* T = (const volatile LAS unsigned*)(F.lds + PTAB_OFF);
    const unsigned lo = (unsigned)__builtin_amdgcn_readfirstlane((int)T[2 * k]), hi = (unsigned)__builtin_amdgcn_readfirstlane((int)T[2 * k + 1]);
    return (const float*)(((uint64_t)hi << 32) | (uint64_t)lo);
}
#define PIN(k) pin_ld(F, (k))

template <int KTOT, bool FOA, bool FOB>
__device__ __forceinline__ void small_gemm_partials(LAS unsigned char* lds, const bf16_t* A, const bf16_t* Bt, int wave, int lane) {
    const int fr = lane & 15, fq = lane >> 4; constexpr int NKS = KTOT / 256; const int T0 = wave * NKS;
    const bf16_t* ap = A + (size_t)fr * KTOT + 8 * fq; const bf16_t* bp = Bt + (size_t)fr * KTOT + 8 * fq;
    f32x4 acc[4][4];
#pragma unroll
    for (int i = 0; i < 4; ++i)
#pragma unroll
        for (int j = 0; j < 4; ++j) acc[i][j] = (f32x4){0.f, 0.f, 0.f, 0.f};
    bf16x8 a[4][4], b[4][4];
#define SG_LOAD(slot, t) do { const int T_ = T0 + (t), ko_ = 32 * T_; _Pragma("unroll") for (int i = 0; i < 4; ++i) { \
        if constexpr (FOA) a[slot][i] = *(const bf16x8*)(A + ((size_t)(i * (KTOT / 32) + T_)) * 512 + 8 * lane); else a[slot][i] = *(const bf16x8*)(ap + (size_t)(16 * i) * KTOT + ko_); \
        if constexpr (FOB) b[slot][i] = *(const bf16x8*)(Bt + ((size_t)(i * (KTOT / 32) + T_)) * 512 + 8 * lane); else b[slot][i] = *(const bf16x8*)(bp + (size_t)(16 * i) * KTOT + ko_); } } while (0)
#pragma unroll
    for (int t = 0; t < 4 && t < NKS; ++t) SG_LOAD(t, t);
    __builtin_amdgcn_sched_barrier(0);
#pragma unroll
    for (int t = 0; t < NKS; ++t) {
#pragma unroll
        for (int tn = 0; tn < 4; ++tn)
#pragma unroll
            for (int tm = 0; tm < 4; ++tm) acc[tn][tm] = __builtin_amdgcn_mfma_f32_16x16x32_bf16(b[t & 3][tn], a[t & 3][tm], acc[tn][tm], 0, 0, 0);
        __builtin_amdgcn_sched_barrier(0);
        if (t + 4 < NKS) { SG_LOAD(t & 3, t + 4); __builtin_amdgcn_sched_barrier(0); } }
#undef SG_LOAD
    LAS f32x4* PART = (LAS f32x4*)lds;
#pragma unroll
    for (int tn = 0; tn < 4; ++tn)
#pragma unroll
        for (int tm = 0; tm < 4; ++tm) PART[(wave * 16 + tn * 4 + tm) * 64 + lane] = acc[tn][tm];
}
__device__ __forceinline__ f32x4 small_gemm_sum(LAS unsigned char* lds, int tid, int j) {
    const LAS f32x4* PART = (const LAS f32x4*)lds; const int tile = 8 * j + (tid >> 6), ln = tid & 63; f32x4 sum = PART[tile * 64 + ln];
#pragma unroll
    for (int wv = 1; wv < 8; ++wv) sum += PART[(wv * 16 + tile) * 64 + ln];
    return sum;
}
template <int KTOT>
__device__ __forceinline__ void small_phase_resid(Frame& F, const bf16_t* A, const bf16_t* Bt, const float* xin_s, float* out, const float* gmod, float coef) {
    for (int st = F.bx; st < 256; st += F.G) { const int x = st & 7, j = st >> 3, sm = 4 * (x >> 1) + (j >> 3), sn = 8 * (x & 1) + (j & 7);
        __syncthreads();
        small_gemm_partials<KTOT, true, true>(F.lds, A + (size_t)(MP + 64 * sm) * KTOT, Bt + (size_t)(64 * sn) * KTOT, F.wave, F.lane);
        __syncthreads();
#pragma unroll
        for (int j = 0; j < 2; ++j) { const f32x4 v = small_gemm_sum(F.lds, F.tid, j); const int tile = 8 * j + (F.tid >> 6), tn = tile >> 2, tm = tile & 3;
            const int ms = 64 * sm + 16 * tm + (F.lane & 15), n = 64 * sn + 16 * tn + 4 * (F.lane >> 4), row = MP + ms;
            const f32x4 xv = *(const f32x4*)(xin_s + (size_t)ms * DM + n), gv = *(const f32x4*)(gmod + (size_t)pg8::bid_of_row(row) * NMOD + n);
            *(f32x4*)(out + (size_t)row * DM + n) = xv + coef * gv * v; } }
}
template <int KTOT, bool FINAL>
__device__ __forceinline__ void small_phase_resid_norm(Frame& F, const bf16_t* A, const bf16_t* Bt, const float* xin_s, float* Xout, const float* gmod, float coef,
                                                       const float* gw, const float* shmod, const float* scmod, bf16_t* Uout, float* Yout, float* XS, unsigned* cnt) {
    LAS float* P2 = (LAS float*)(F.lds + 131072); LAS float* S2 = (LAS float*)(F.lds + 131072 + 512);
    for (int st = F.bx; st < 256; st += F.G) { const int x = st & 7, j0 = st >> 3, sm = 4 * (x >> 1) + (j0 >> 3), sn = 8 * (x & 1) + (j0 & 7);
        __syncthreads();
        small_gemm_partials<KTOT, true, true>(F.lds, A + (size_t)(MP + 64 * sm) * KTOT, Bt + (size_t)(64 * sn) * KTOT, F.wave, F.lane);
        __syncthreads();
        const int fr = F.lane & 15, fq = F.lane >> 4, tm = F.wave & 3, rl = 16 * tm + fr, ms = 64 * sm + rl, row = MP + ms, bid = NBP + (ms >> 3);
        f32x4 xn[2]; float ss = 0.f;
#pragma unroll
        for (int j = 0; j < 2; ++j) { const int n = 64 * sn + 16 * (2 * j + (F.wave >> 2)) + 4 * fq;
            const f32x4 x4 = *(const f32x4*)(xin_s + (size_t)ms * DM + n) + coef * *(const f32x4*)(gmod + (size_t)bid * NMOD + n) * small_gemm_sum(F.lds, F.tid, j);
            xn[j] = x4; ss += (x4[0] * x4[0] + x4[1] * x4[1]) + (x4[2] * x4[2] + x4[3] * x4[3]); }
        ss += __shfl_xor(ss, 16); ss += __shfl_xor(ss, 32);
        if (fq == 0) P2[(F.wave >> 2) * 64 + rl] = ss;
        __syncthreads();
        float* slot = XS + (size_t)(MP + 64 * sm + F.lane) * 16;
        if (F.wave == 0) { __hip_atomic_store(slot + sn, P2[F.lane] + P2[64 + F.lane], __ATOMIC_RELAXED, __HIP_MEMORY_SCOPE_AGENT);
            asm volatile("s_waitcnt vmcnt(0)" ::: "memory");
            if (F.lane == 0) __hip_atomic_fetch_add(cnt + 64 * (64 + sm), 1u, __ATOMIC_RELAXED, __HIP_MEMORY_SCOPE_AGENT);
            pg8::panel_wait(cnt + 64 * (64 + sm), 16u);
            float tot = 0.f;
#pragma unroll
            for (int t = 0; t < 16; ++t) tot += __hip_atomic_load(slot + t, __ATOMIC_RELAXED, __HIP_MEMORY_SCOPE_AGENT);
            S2[F.lane] = 1.0f / sqrtf(tot * (1.0f / DM) + EPS); }
        __syncthreads();
        const float r = S2[rl];
#pragma unroll
        for (int j = 0; j < 2; ++j) { const int n = 64 * sn + 16 * (2 * j + (F.wave >> 2)) + 4 * fq; const f32x4 g4 = *(const f32x4*)(gw + n);
            if constexpr (FINAL) *(f32x4*)(Yout + (size_t)row * DM + n) = xn[j] * r * g4;
            else { *(f32x4*)(Xout + (size_t)row * DM + n) = xn[j];
                *(u32x2*)(Uout + (size_t)row * DM + n) = pack4(xn[j] * r * g4 * (1.0f + *(const f32x4*)(scmod + (size_t)bid * NMOD + n)) + *(const f32x4*)(shmod + (size_t)bid * NMOD + n)); } } }
}
__device__ __forceinline__ void small_gates_tile(Frame& F, const bf16_t* U, const bf16_t* Wg, float* gates, const int st) {
    {
        __syncthreads();
        small_gemm_partials<DM, false, true>(F.lds, U + (size_t)(64 * st) * DM, Wg, F.wave, F.lane);
        __syncthreads();
#pragma unroll
        for (int j = 0; j < 2; ++j) { const f32x4 v = small_gemm_sum(F.lds, F.tid, j); const int tile = 8 * j + (F.tid >> 6), tn = tile >> 2, tm = tile & 3;
            *(f32x4*)(gates + (size_t)(64 * st + 16 * tm + (F.lane & 15)) * 64 + 16 * tn + 4 * (F.lane >> 4)) = v; } }
}
__device__ __forceinline__ void small_phase_merge(Frame& F, const bf16_t* HA, const bf16_t* HB, const bf16_t* WA, const bf16_t* WB, const bf16_t* Z, bf16_t* U) {
    for (int st = F.bx; st < 256; st += F.G) { const int x = st & 7, j = st >> 3, sm = 4 * (x >> 1) + (j >> 3), sn = 8 * (x & 1) + (j & 7); f32x4 va[2], vb[2];
        __syncthreads();
        small_gemm_partials<2048, true, true>(F.lds, HA + (size_t)(MP + 64 * sm) * 2048, WA + (size_t)(64 * sn) * 2048, F.wave, F.lane);
        __syncthreads();
        va[0] = small_gemm_sum(F.lds, F.tid, 0); va[1] = small_gemm_sum(F.lds, F.tid, 1);
        __syncthreads();
        small_gemm_partials<2048, true, true>(F.lds, HB + (size_t)(MP + 64 * sm) * 2048, WB + (size_t)(64 * sn) * 2048, F.wave, F.lane);
        __syncthreads();
        vb[0] = small_gemm_sum(F.lds, F.tid, 0); vb[1] = small_gemm_sum(F.lds, F.tid, 1);
#pragma unroll
        for (int j = 0; j < 2; ++j) { const int tile = 8 * j + (F.tid >> 6), tn = tile >> 2, tm = tile & 3;
            const int row = MP + 64 * sm + 16 * tm + (F.lane & 15), n = 64 * sn + 16 * tn + 4 * (F.lane >> 4);
            const u32x2 ga = *(const u32x2*)(Z + (size_t)row * ZP + ZGA + n), gb = *(const u32x2*)(Z + (size_t)row * ZP + ZGB + n);
            f32x4 o; o[0] = sigmoidf_(bflo(ga.x)) * va[j][0] + sigmoidf_(bflo(gb.x)) * vb[j][0]; o[1] = sigmoidf_(bfhi(ga.x)) * va[j][1] + sigmoidf_(bfhi(gb.x)) * vb[j][1];
            o[2] = sigmoidf_(bflo(ga.y)) * va[j][2] + sigmoidf_(bflo(gb.y)) * vb[j][2]; o[3] = sigmoidf_(bfhi(ga.y)) * va[j][3] + sigmoidf_(bfhi(gb.y)) * vb[j][3];
            *(u32x2*)(U + (size_t)MP * DM + fo_index(row - MP, n, DM)) = pack4(o); } }
}

#define GAS __attribute__((address_space(1)))
#define XB_TMO      128
#define XB_XCNT(j)  (256  + 64 * (j))
#define XB_XSUB(j)  (1280 + 64 * (j))
#define XB_XGEN(j)  (2304 + 64 * (j))
#define XB_TOP      3328
#define XB_TOPGEN   3392
#define XCD_BAR_WORDS 3456
#define XB_SPIN_CAP (1u << 22)
__device__ __forceinline__ unsigned xb_ld(unsigned* p)              { return __hip_atomic_load(p, __ATOMIC_RELAXED, __HIP_MEMORY_SCOPE_AGENT); }
__device__ __forceinline__ unsigned xb_add(unsigned* p, unsigned v) { return __hip_atomic_fetch_add(p, v, __ATOMIC_RELAXED, __HIP_MEMORY_SCOPE_AGENT); }
__device__ __forceinline__ unsigned xb_xcc_id() { return (unsigned)__builtin_amdgcn_s_getreg((3 << 11) | 20) & 0xFu; }
#define XB_SPIN(cond, bar) do { unsigned _sp = 0; while (cond) { __builtin_amdgcn_s_sleep(1); \
    if ((++_sp & 255u) == 0u) { if (xb_ld(&(bar)[XB_TMO])) break; if (_sp > XB_SPIN_CAP) { atomicAdd(&(bar)[XB_TMO], 1u); break; } } } } while (0)
struct XcdBarrier { unsigned* bar; unsigned x; volatile LAS unsigned* st; };
__device__ __forceinline__ XcdBarrier xcd_barrier_post(unsigned* bar, volatile LAS unsigned* st) {
    XcdBarrier b; b.bar = bar; b.x = xb_xcc_id(); b.st = st;
    if (threadIdx.x == 0) (void)xb_add(&bar[XB_XCNT(b.x)], 1u);
    return b;
}
__device__ __forceinline__ void xcd_barrier_complete(unsigned* bar, unsigned x, unsigned& nloc, unsigned& nx) {
    const unsigned G = gridDim.x * gridDim.y * gridDim.z;
    unsigned sum, cnt, mine, sp = 0u;
    for (;;) {
        sum = 0u; cnt = 0u; mine = 0u;
#pragma unroll
        for (unsigned j = 0; j < 16; ++j) { const unsigned c = xb_ld(&bar[XB_XCNT(j)]); sum += c; cnt += (c > 0u) ? 1u : 0u; mine = (j == x) ? c : mine; }
        if (sum == G) break;
        __builtin_amdgcn_s_sleep(1);
        if ((++sp & 255u) == 0u) { if (xb_ld(&bar[XB_TMO])) break; if (sp > XB_SPIN_CAP) { atomicAdd(&bar[XB_TMO], 1u); break; } }
    }
    nloc = mine > 0u ? mine : 1u; nx = cnt > 0u ? cnt : 1u;
}
__device__ __forceinline__ void xcd_barrier(const XcdBarrier& b) {
    asm volatile("s_waitcnt vmcnt(0)" ::: "memory");
    __syncthreads();
    if (threadIdx.x == 0) {
        unsigned* bar = b.bar;
        __builtin_amdgcn_s_waitcnt(0);
        unsigned nloc = b.st[0], nx = b.st[1];
        if (nloc == 0u) { xcd_barrier_complete(bar, b.x, nloc, nx); b.st[0] = nloc; b.st[1] = nx; }
        const unsigned old = xb_add(&bar[XB_XSUB(b.x)], 1u);
        const unsigned gen = old / nloc;
        if (old + 1u == (gen + 1u) * nloc) {
            __builtin_amdgcn_fence(__ATOMIC_RELEASE, "agent");
            asm volatile("s_waitcnt vmcnt(0)" ::: "memory");
            const unsigned og = xb_add(&bar[XB_TOP], 1u);
            const unsigned tg = og / nx;
            if (og + 1u == (tg + 1u) * nx) xb_add(&bar[XB_TOPGEN], 1u);
            else XB_SPIN(xb_ld(&bar[XB_TOPGEN]) == tg, bar);
            __builtin_amdgcn_fence(__ATOMIC_ACQUIRE, "agent");
            xb_add(&bar[XB_XGEN(b.x)], 1u);
            asm volatile("s_waitcnt vmcnt(0)" ::: "memory");
        } else {
            XB_SPIN(xb_ld(&bar[XB_XGEN(b.x)]) == gen, bar);
            __builtin_amdgcn_fence(__ATOMIC_ACQUIRE, "agent");
            asm volatile("s_waitcnt vmcnt(0)" ::: "memory");
        }
    }
    __syncthreads();
}


template <class SrcFn>
__device__ __forceinline__ void transpose_item(const SrcFn& src, int K, bf16_t* WT, LAS float* scr, int item, int lane, int nblk, bf16_t* WF = nullptr, int fo_row0 = 0) {
    const int kb = item / nblk, nb = item % nblk, k0 = 64 * kb, n0 = 32 * nb;
    const size_t stride = (size_t)src.stride(); const float* colp = src(n0 + (lane & 31));
    float tv[32];
#pragma unroll
    for (int i = 0; i < 32; ++i) { const int kk = 2 * i + (lane >> 5); tv[i] = colp ? colp[(size_t)(k0 + kk) * stride] : 0.f; }
#pragma unroll
    for (int i = 0; i < 32; ++i) { const int kk = 2 * i + (lane >> 5); scr[kk * 33 + (lane & 31)] = tv[i]; }
    asm volatile("s_waitcnt lgkmcnt(0)" ::: "memory");
    const int c = lane & 7;
#pragma unroll
    for (int j = 0; j < 4; ++j) { const int n = (lane >> 3) + 8 * j; const LAS float* s = scr + (8 * c) * 33 + n;
        u32x4 o; o.x = cvt_pk_bf16(s[0 * 33], s[1 * 33]); o.y = cvt_pk_bf16(s[2 * 33], s[3 * 33]); o.z = cvt_pk_bf16(s[4 * 33], s[5 * 33]); o.w = cvt_pk_bf16(s[6 * 33], s[7 * 33]);
        *(u32x4*)(WT + (size_t)(n0 + n) * K + k0 + 8 * c) = o;
        if (WF != nullptr && n0 >= fo_row0) *(u32x4*)(WF + fo_index(n0 + n - fo_row0, k0 + 8 * c, K)) = o; }
    asm volatile("s_waitcnt lgkmcnt(0)" ::: "memory");
}
struct SrcPlain { const float* W; int N; __device__ __forceinline__ int stride() const { return N; } __device__ __forceinline__ const float* operator()(int n) const { return W + n; } };
struct SrcUp { const float* W1; const float* W3; __device__ __forceinline__ int stride() const { return DFF; } __device__ __forceinline__ const float* operator()(int n) const { const int T = n >> 8, i = n & 255; const uintptr_t a = (uintptr_t)W1, b = (uintptr_t)W3, msk = (uintptr_t)0 - (uintptr_t)(i >> 7);
        return (const float*)((a & ~msk) | (b & msk)) + 128 * T + (i & 127); } };
struct SrcWin { const float* W; __device__ __forceinline__ int stride() const { return 13352; } __device__ __forceinline__ const float* operator()(int r) const { int o;
        if (r < 6144) o = r; else if (r < 8192) o = 6152 + (r - 6144); else if (r < 11264) o = 8200 + (r - 8192); else if (r < 13312) o = 11304 + (r - 11264);
        else if (r < 13320) o = 6144 + (r - 13312); else if (r < 13352) o = 11272 + (r - 13320); else return nullptr;
        return W + o; } };

template <int PPART>
__device__ __forceinline__ void phase_prep(Frame& F, const Params& p) {
    LAS float* scr = (LAS float*)(F.lds + F.wave * 16384);
    const int gw = (PPART == 0 ? F.bx : F.bx - 192) * 8 + F.wave, NGW = (PPART == 0 ? F.G : 64) * 8;
    bf16_t* wup1 = (bf16_t*)(F.ws + WS_WUP1); bf16_t* wdn1 = (bf16_t*)(F.ws + WS_WDN1); bf16_t* wup2 = (bf16_t*)(F.ws + WS_WUP2); bf16_t* wdn2 = (bf16_t*)(F.ws + WS_WDN2);
    bf16_t* win = (bf16_t*)(F.ws + WS_WIN); bf16_t* wpa = (bf16_t*)(F.ws + WS_WPA); bf16_t* wpb = (bf16_t*)(F.ws + WS_WPB); bf16_t* wout = (bf16_t*)(F.ws + WS_WOUT);
    constexpr int I_UP = (DM / 64) * (2 * DFF / 32), I_DN = (DFF / 64) * (DM / 32), I_IN = (DM / 64) * (ZP / 32), I_P = (2048 / 64) * (DM / 32), I_O = (DM / 64) * (DM / 32);
    constexpr int NITEMS = 2 * I_UP + 2 * I_DN + I_IN + 2 * I_P + I_O;
    for (int it = (PPART == 0 ? 0 : I_UP) + gw; it < (PPART == 0 ? I_UP : NITEMS); it += NGW) {
        int r = it;
        if (r < I_UP) { transpose_item(SrcUp{PIN(13), PIN(14)}, DM, wup1, scr, r, F.lane, 2 * DFF / 32); continue; } r -= I_UP;
        if (r < I_UP) { transpose_item(SrcUp{PIN(32), PIN(33)}, DM, wup2, scr, r, F.lane, 2 * DFF / 32); continue; } r -= I_UP;
        if (r < I_DN) { transpose_item(SrcPlain{PIN(15), DM}, DFF, wdn1, scr, r, F.lane, DM / 32, (bf16_t*)(F.ws + WS_FDN1)); continue; } r -= I_DN;
        if (r < I_DN) { transpose_item(SrcPlain{PIN(34), DM}, DFF, wdn2, scr, r, F.lane, DM / 32, (bf16_t*)(F.ws + WS_FDN2)); continue; } r -= I_DN;
        if (r < I_IN) { transpose_item(SrcWin{PIN(17)}, DM, win, scr, r, F.lane, ZP / 32, (bf16_t*)(F.ws + WS_FG), ZG); continue; } r -= I_IN;
        if (r < I_P) { transpose_item(SrcPlain{PIN(22), DM}, 2048, wpa, scr, r, F.lane, DM / 32, (bf16_t*)(F.ws + WS_FPA)); continue; } r -= I_P;
        if (r < I_P) { transpose_item(SrcPlain{PIN(29), DM}, 2048, wpb, scr, r, F.lane, DM / 32, (bf16_t*)(F.ws + WS_FPB)); continue; } r -= I_P;
        transpose_item(SrcPlain{PIN(30), DM}, DM, wout, scr, r, F.lane, DM / 32, (bf16_t*)(F.ws + WS_FOUT));
    }
    __syncthreads();
    if constexpr (PPART != 0) return;
    const float* ada_w = PIN(10); const float* ada_b = PIN(11); float* mod = (float*)(F.ws + WS_MOD);
    LAS f32x4* PART = (LAS f32x4*)F.lds;
    const int lane = F.lane, w = F.wave, fr = lane & 15, fq = lane >> 4;
    for (int nt = F.bx; nt < NMOD / 16; nt += F.G) {
        f32x4 acc[9];
#pragma unroll
        for (int rt = 0; rt < 9; ++rt) acc[rt] = (f32x4){0.f, 0.f, 0.f, 0.f};
#pragma unroll 1
        for (int ks = 0; ks < 4; ++ks) {
            const int k0 = 128 * w + 32 * ks + 8 * fq;
            float wv[8];
#pragma unroll
            for (int j = 0; j < 8; ++j) wv[j] = ada_w[(size_t)(k0 + j) * NMOD + 16 * nt + fr];
            bf16x8 bfr; { const u32x4 t = pack8(wv, 1.0f); bfr = __builtin_bit_cast(bf16x8, t); }
#pragma unroll
            for (int rt = 0; rt < 9; ++rt) { const int r = 16 * rt + fr; float x[8];
                if (r < NBID) { const float* cr = (r < NBP ? PIN(2) + (size_t)r * DM : PIN(3) + (size_t)(r - NBP) * DM) + k0; const f32x4 c0 = *(const f32x4*)cr, c1 = *(const f32x4*)(cr + 4);
#pragma unroll
                    for (int e = 0; e < 4; ++e) { x[e] = siluf_(c0[e]); x[4 + e] = siluf_(c1[e]); } }
                else {
#pragma unroll
                    for (int e = 0; e < 8; ++e) x[e] = 0.f; }
                const u32x4 t = pack8(x, 1.0f);
                acc[rt] = __builtin_amdgcn_mfma_f32_16x16x32_bf16(__builtin_bit_cast(bf16x8, t), bfr, acc[rt], 0, 0, 0); }
        }
        __syncthreads();
#pragma unroll
        for (int rt = 0; rt < 9; ++rt) PART[(w * 9 + rt) * 64 + lane] = acc[rt];
        __syncthreads();
        for (int idx = F.tid; idx < 9 * 64; idx += NTHREADS) { const int rt = idx >> 6, ln = idx & 63; f32x4 sum = PART[rt * 64 + ln];
#pragma unroll
            for (int ww = 1; ww < 8; ++ww) sum += PART[(ww * 9 + rt) * 64 + ln];
            const int n = 16 * nt + (ln & 15); const float bv = ada_b[n];
#pragma unroll
            for (int r = 0; r < 4; ++r) { const int row = 16 * rt + 4 * (ln >> 4) + r; if (row < NBID) mod[(size_t)row * NMOD + n] = sum[r] + bv; } }
    }
}

__device__ __forceinline__ void phase_norm_mod(Frame& F, const float* xp, const float* xs, const float* gw, int shoff, int scoff, bf16_t* U) {
    const float* mod = (const float*)(F.ws + WS_MOD);
    const int gwv = F.bx * 8 + F.wave, NGW = F.G * 8;
    f32x4 g[4];
#pragma unroll
    for (int j = 0; j < 4; ++j) g[j] = *(const f32x4*)(gw + 4 * F.lane + 256 * j);
    for (int m = gwv; m < MT; m += NGW) {
        const float* xr = m < MP ? xp + (size_t)m * DM : xs + (size_t)(m - MP) * DM;
        const float* mr = mod + (size_t)pg8::bid_of_row(m) * NMOD;
        f32x4 v[4]; float s = 0.f;
#pragma unroll
        for (int j = 0; j < 4; ++j) { v[j] = *(const f32x4*)(xr + 4 * F.lane + 256 * j); s += (v[j][0] * v[j][0] + v[j][1] * v[j][1]) + (v[j][2] * v[j][2] + v[j][3] * v[j][3]); }
        const float r = 1.0f / sqrtf(wave_sum(s) * (1.0f / DM) + EPS);
#pragma unroll
        for (int j = 0; j < 4; ++j) { const f32x4 sh = *(const f32x4*)(mr + shoff + 4 * F.lane + 256 * j), scv = *(const f32x4*)(mr + scoff + 4 * F.lane + 256 * j);
            const f32x4 o = (v[j] * r * g[j]) * (1.0f + scv) + sh;
            u32x2 w; w.x = cvt_pk_bf16(o[0], o[1]); w.y = cvt_pk_bf16(o[2], o[3]);
            *(u32x2*)(U + (size_t)m * DM + 4 * F.lane + 256 * j) = w; }
    }
}
__device__ __forceinline__ void phase_final_norm(Frame& F, float* Y, const float* gw) {
    const int gwv = F.bx * 8 + F.wave, NGW = F.G * 8;
    f32x4 g[4];
#pragma unroll
    for (int j = 0; j < 4; ++j) g[j] = *(const f32x4*)(gw + 4 * F.lane + 256 * j);
    for (int m = gwv; m < MT; m += NGW) {
        float* xr = Y + (size_t)m * DM;
        f32x4 v[4]; float s = 0.f;
#pragma unroll
        for (int j = 0; j < 4; ++j) { v[j] = *(const f32x4*)(xr + 4 * F.lane + 256 * j); s += (v[j][0] * v[j][0] + v[j][1] * v[j][1]) + (v[j][2] * v[j][2] + v[j][3] * v[j][3]); }
        const float r = 1.0f / sqrtf(wave_sum(s) * (1.0f / DM) + EPS);
#pragma unroll
        for (int j = 0; j < 4; ++j) *(f32x4*)(xr + 4 * F.lane + 256 * j) = v[j] * r * g[j];
    }
}

constexpr size_t O_Y = 0, O_PC = 17825792, O_PN = 22020096, O_PM = 22028288, O_PMC = 22028320, O_PSSM = 22077472, O_PSC = 24174624,
                 O_SC = 24248352, O_SN = 91357216, O_SM = 91488288, O_SMC = 91488800, O_SSSM = 92275232, O_SSC = 125829664, O_END = 127009312;
constexpr int CVP = 5120;

__device__ __forceinline__ bf16x8 frag_row(LAS unsigned char* base, int stride, int row0, int k0, int lane) {
    return *(const LAS bf16x8*)(base + (row0 + (lane & 15)) * stride + (k0 + 8 * (lane >> 4)) * 2);
}
__device__ __forceinline__ bf16x8 frag_tr(LAS unsigned char* base, int stride, int krow0, int col0, int lane) {
    const int g = lane >> 4, q = (lane & 15) >> 2, pp = lane & 3;
    LAS unsigned char* a = base + (krow0 + 8 * g + q) * stride + (col0 + 4 * pp) * 2;
    const s16x4 lo = __builtin_amdgcn_ds_read_tr16_b64_v4i16((LAS s16x4*)a);
    const s16x4 hi = __builtin_amdgcn_ds_read_tr16_b64_v4i16((LAS s16x4*)(a + 4 * stride));
    return (bf16x8){lo.x, lo.y, lo.z, lo.w, hi.x, hi.y, hi.z, hi.w};
}
#define MFMA16(a, b, c) __builtin_amdgcn_mfma_f32_16x16x32_bf16((a), (b), (c), 0, 0, 0)

__device__ __forceinline__ float fast_log1pexp_neg(float ax) { return __builtin_amdgcn_logf(1.0f + fast_exp(-ax)) * 0.6931471805599453f; }
__device__ __forceinline__ float logsigmoidf_(float x) { return fminf(x, 0.f) - log1pf(expf(-fabsf(x))); }
__device__ __forceinline__ float softplusf_(float x) { return fmaxf(x, 0.f) + log1pf(expf(-fabsf(x))); }

__device__ __forceinline__ void conv_item(Frame& F, const Params& p, const int it) {
    const bf16_t* Z = (const bf16_t*)(F.ws + WS_ZIN); bf16_t* CV = (bf16_t*)(F.ws + WS_CV);
    const int lane = F.lane;
    {
        int m0, tb, nrows, strip; const float* hist = nullptr;
        if (it < 5120) { const int b = it / 640, r = it % 640; strip = r % 10; tb = (r / 10) * 32; m0 = b * SEQ; nrows = 32; }
        else { const int j = it - 5120, bs = j / 10; strip = j % 10; tb = 0; m0 = MP + bs * TS; nrows = 8; hist = strip < 4 ? PIN(7) + (size_t)bs * 3 * 2048 : PIN(9) + (size_t)bs * 3 * 3072; }
        const bool isM = strip < 4;
        const int c = strip * 512 + 8 * lane, zc = isM ? c : ZX + (c - 2048), cc = isM ? c : c - 2048, cs = isM ? 2048 : 3072;
        const float* cw = isM ? PIN(18) : PIN(23); const float* cb = isM ? PIN(19) : PIN(24);
        const float scl = (strip == 2 || strip == 3) ? 0.0625f : 1.0f;
        float w[4][8], bb[8], x0[8], x1[8], x2[8];
#pragma unroll
        for (int j = 0; j < 4; ++j) { const f32x4 a = *(const f32x4*)(cw + (size_t)j * cs + cc), b = *(const f32x4*)(cw + (size_t)j * cs + cc + 4);
#pragma unroll
            for (int e = 0; e < 4; ++e) { w[j][e] = a[e]; w[j][4 + e] = b[e]; } }
        { const f32x4 a = *(const f32x4*)(cb + cc), b = *(const f32x4*)(cb + cc + 4);
#pragma unroll
            for (int e = 0; e < 4; ++e) { bb[e] = a[e]; bb[4 + e] = b[e]; } }
        if (tb > 0) { unpack8(*(const u32x4*)(Z + (size_t)(m0 + tb - 3) * ZP + zc), x0); unpack8(*(const u32x4*)(Z + (size_t)(m0 + tb - 2) * ZP + zc), x1); unpack8(*(const u32x4*)(Z + (size_t)(m0 + tb - 1) * ZP + zc), x2); }
        else if (hist != nullptr) {
#pragma unroll
            for (int e = 0; e < 8; ++e) { x0[e] = hist[cc + e]; x1[e] = hist[cs + cc + e]; x2[e] = hist[2 * cs + cc + e]; } }
        else {
#pragma unroll
            for (int e = 0; e < 8; ++e) { x0[e] = 0.f; x1[e] = 0.f; x2[e] = 0.f; } }
        for (int t = 0; t < nrows; t += 8) {
            u32x4 raw[8];
#pragma unroll
            for (int i = 0; i < 8; ++i) raw[i] = *(const u32x4*)(Z + (size_t)(m0 + tb + t + i) * ZP + zc);
#pragma unroll
            for (int i = 0; i < 8; ++i) { float x3[8], o[8]; unpack8(raw[i], x3);
#pragma unroll
                for (int e = 0; e < 8; ++e) { o[e] = siluf_(bb[e] + w[0][e] * x0[e] + w[1][e] * x1[e] + w[2][e] * x2[e] + w[3][e] * x3[e]); x0[e] = x1[e]; x1[e] = x2[e]; x2[e] = x3[e]; }
                *(u32x4*)(CV + (size_t)(m0 + tb + t + i) * CVP + c) = pack8(o, scl); }
        }
    }
}
constexpr int NS_EARLY = 64;
__device__ __forceinline__ void phase_conv(Frame& F, const Params& p) {
    const int gw = F.bx * 8 + F.wave, NGW = F.G * 8;
    for (int it = gw; it < 5120 + 1280 - 10 * NS_EARLY; it += NGW) conv_item(F, p, it < 5120 ? it : it + 10 * NS_EARLY);
}

constexpr int QSTR = 528, VSTR = 144;
constexpr int L_QS = 0, L_KS = 33792, L_CT = 67584, L_VS = 101376, L_VW = 110592, L_SB = 119808, L_SCAL = 129024, L_NST = 132096, L_QNP = 133120, L_DENP = 135168, L_NUMB = 135680;

__device__ __forceinline__ float mlstm_scan(float ipre, float fpre, int lane, float mstate, LAS float* sc) {
    const float lf = fminf(fpre, 0.f) - fast_log1pexp_neg(fabsf(fpre));
    const float b = wave_scan_add(lf);
    const float a = ipre - b;
    const float cm = wave_scan_max(a);
    const float A = fmaxf(mstate, cm);
    const float Alast = __shfl(A, 63), blast = __shfl(b, 63);
    sc[lane] = a; sc[64 + lane] = A; sc[128 + lane] = fast_exp(mstate - A); sc[192 + lane] = fast_exp(-(b + A)); sc[256 + lane] = fast_exp(a - Alast);
    if (lane == 0) sc[320] = fast_exp(mstate - Alast);
    return blast + Alast;
}

__device__ __forceinline__ void mlstm_prompt_item(Frame& F, const Params& p, const int b, const int h, const int vs) {
    LAS unsigned char* L = F.lds;
    const int tid = F.tid, lane = F.lane, w = F.wave, fr = lane & 15, fq = lane >> 4;
    const bf16_t* Z = (const bf16_t*)(F.ws + WS_ZIN); const bf16_t* CV = (const bf16_t*)(F.ws + WS_CV); const float* GT = (const float*)(F.ws + WS_GATES);
    bf16_t* NUM = (bf16_t*)(F.ws + WS_NUM); float* DEN = (float*)(F.ws + WS_DEN);
    const float ifbi = PIN(20)[h], ifbf = PIN(20)[4 + h];
    constexpr int nch = SEQ / 64; const int m0 = b * SEQ;
    LAS float* SC = (LAS float*)(L + L_SCAL); LAS unsigned char* NSTB = L + L_NST; LAS float* DENP = (LAS float*)(L + L_DENP);
    f32x4 cacc[2][4];
#pragma unroll
    for (int dt = 0; dt < 2; ++dt)
#pragma unroll
        for (int vi = 0; vi < 4; ++vi) cacc[dt][vi] = (f32x4){0.f, 0.f, 0.f, 0.f};
    f32x4 nacc[2] = {{0.f, 0.f, 0.f, 0.f}, {0.f, 0.f, 0.f, 0.f}};
    float mstate = 0.f;
    u32x4 pq[4], pk[4], pv; float gi = 0.f, gf = 0.f;
    const bf16_t* qsrc = CV + (size_t)(m0 + (tid >> 5)) * CVP + h * 256 + 8 * (tid & 31);
    const bf16_t* vsrc = Z + (size_t)(m0 + (tid >> 3)) * ZP + ZV + h * 512 + vs * 64 + 8 * (tid & 7);
    const float* gsrc = GT + (size_t)(m0 + lane) * 64 + h;
#define ML_LOAD(c) do { _Pragma("unroll") for (int i = 0; i < 4; ++i) { pq[i] = *(const u32x4*)(qsrc + (size_t)((c) * 64 + 16 * i) * CVP); pk[i] = *(const u32x4*)(qsrc + (size_t)((c) * 64 + 16 * i) * CVP + 1024); } \
        pv = *(const u32x4*)(vsrc + (size_t)((c) * 64) * ZP); if (w == 0) { gi = gsrc[(size_t)((c) * 64) * 64]; gf = gsrc[(size_t)((c) * 64) * 64 + 4]; } } while (0)
    u32x4 numst = {0u, 0u, 0u, 0u}; float denst = 0.f;
    bf16_t* numdst = NUM + (size_t)(m0 + (tid >> 3)) * 2048 + h * 512 + vs * 64 + 8 * (tid & 7);
#define ML_STORE(c) do { *(u32x4*)(numdst + (size_t)((c) * 64) * 2048) = numst; \
        if (vs == 0 && w < 4 && fq == 0) DEN[(size_t)(m0 + (c) * 64 + 16 * w + fr) * 4 + h] = denst; } while (0)
    ML_LOAD(0);
    __syncthreads();
#pragma unroll
    for (int dt = 0; dt < 2; ++dt)
#pragma unroll
        for (int vi = 0; vi < 4; ++vi) *(LAS u32x2*)(L + L_CT + (16 * vi + fr) * QSTR + (32 * w + 16 * dt + 4 * fq) * 2) = (u32x2){0u, 0u};
    if (tid < 128) *(LAS unsigned*)(NSTB + 4 * tid) = 0u;
    if (w == 0) mstate = mlstm_scan(gi + ifbi, gf + ifbf, lane, mstate, SC);
    __syncthreads();
    for (int c = 0; c < nch; ++c) {
        const int t0 = 64 * c; LAS float* sc = SC + (c & 1) * 384;
#pragma unroll
        for (int i = 0; i < 4; ++i) { const int v = tid + NTHREADS * i, row = v >> 5, c16 = v & 31; *(LAS u32x4*)(L + L_QS + row * QSTR + 16 * c16) = pq[i]; *(LAS u32x4*)(L + L_KS + row * QSTR + 16 * c16) = pk[i]; }
        { const int row = tid >> 3, c8 = tid & 7; *(LAS u32x4*)(L + L_VS + row * VSTR + 16 * c8) = pv; float x[8]; unpack8(pv, x); *(LAS u32x4*)(L + L_VW + row * VSTR + 16 * c8) = pack8(x, sc[256 + row]); }
        __syncthreads();
        if (c > 0) { ML_STORE(c - 1); }
        if (c + 1 < nch) ML_LOAD(c + 1);
        const int ti = w & 3, hf = w >> 2;
        bf16x8 qf[8];
#pragma unroll
        for (int k = 0; k < 8; ++k) qf[k] = frag_row(L + L_QS, QSTR, 16 * ti, 32 * k, lane);
        { f32x4 sacc[2] = {{0.f, 0.f, 0.f, 0.f}, {0.f, 0.f, 0.f, 0.f}};
#pragma unroll
          for (int j = 0; j < 2; ++j) { const int si = 2 * hf + j; if (si <= ti) {
#pragma unroll
                  for (int k = 0; k < 8; ++k) sacc[j] = MFMA16(frag_row(L + L_KS, QSTR, 16 * si, 32 * k, lane), qf[k], sacc[j]); } }
          const int t = 16 * ti + fr; const float At = sc[64 + t]; float dpart = 0.f;
#pragma unroll
          for (int j = 0; j < 2; ++j) { const int si = 2 * hf + j, s0 = 16 * si + 4 * fq; const f32x4 av = *(const LAS f32x4*)(sc + s0); f32x4 vv;
#pragma unroll
              for (int r = 0; r < 4; ++r) { const float wgt = (s0 + r <= t) ? fast_exp(av[r] - At) : 0.f; vv[r] = (si <= ti) ? sacc[j][r] * wgt : 0.f; dpart += vv[r]; }
              *(LAS u32x2*)(L + L_SB + t * VSTR + s0 * 2) = pack4(vv); }
          dpart += __shfl_xor(dpart, 16); dpart += __shfl_xor(dpart, 32);
          if (lane < 16) DENP[hf * 64 + 16 * ti + lane] = dpart; }
        __syncthreads();
        { f32x4 uacc[2] = {{0.f, 0.f, 0.f, 0.f}, {0.f, 0.f, 0.f, 0.f}};
#pragma unroll
          for (int j = 0; j < 2; ++j) { const int vi = 2 * hf + j;
#pragma unroll
              for (int k = 0; k < 8; ++k) uacc[j] = MFMA16(frag_row(L + L_CT, QSTR, 16 * vi, 32 * k, lane), qf[k], uacc[j]); }
          const float wst = sc[128 + 16 * ti + fr]; uacc[0] *= wst; uacc[1] *= wst;
#pragma unroll
          for (int ks = 0; ks < 2; ++ks) if (32 * ks <= 16 * ti + 15) { const bf16x8 sb = frag_row(L + L_SB, VSTR, 16 * ti, 32 * ks, lane);
#pragma unroll
              for (int j = 0; j < 2; ++j) uacc[j] = MFMA16(frag_tr(L + L_VS, VSTR, 32 * ks, 16 * (2 * hf + j), lane), sb, uacc[j]); }
#pragma unroll
          for (int j = 0; j < 2; ++j) *(LAS u32x2*)(L + L_NUMB + (16 * ti + fr) * VSTR + (16 * (2 * hf + j) + 4 * fq) * 2) = pack4(uacc[j]); }
        if (vs == 0 && hf == 0) {
            f32x4 qn = {0.f, 0.f, 0.f, 0.f};
#pragma unroll
            for (int k = 0; k < 8; ++k) { u32x4 nv = *(const LAS u32x4*)(NSTB + 64 * k + 16 * fq); if (fr != 0) nv = (u32x4){0u, 0u, 0u, 0u};
                qn = MFMA16(__builtin_bit_cast(bf16x8, nv), qf[k], qn); }
            const int t = 16 * ti + fr; const float den = DENP[t] + DENP[64 + t] + sc[128 + t] * qn[0];
            denst = fmaxf(fabsf(den), sc[192 + t]); }
        { const float decay = sc[320];
#pragma unroll
          for (int dt = 0; dt < 2; ++dt)
#pragma unroll
              for (int vi = 0; vi < 4; ++vi) cacc[dt][vi] *= decay;
#pragma unroll
          for (int ks = 0; ks < 2; ++ks) { bf16x8 ka[2];
#pragma unroll
              for (int dt = 0; dt < 2; ++dt) ka[dt] = frag_tr(L + L_KS, QSTR, 32 * ks, 32 * w + 16 * dt, lane);
#pragma unroll
              for (int vi = 0; vi < 4; ++vi) { const bf16x8 vb = frag_tr(L + L_VW, VSTR, 32 * ks, 16 * vi, lane);
#pragma unroll
                  for (int dt = 0; dt < 2; ++dt) cacc[dt][vi] = MFMA16(ka[dt], vb, cacc[dt][vi]); } }
          if (vs == 0) { nacc[0] *= decay; nacc[1] *= decay;
#pragma unroll
              for (int ks = 0; ks < 2; ++ks) { const f32x4 w0 = *(const LAS f32x4*)(sc + 256 + 32 * ks + 8 * fq), w1 = *(const LAS f32x4*)(sc + 256 + 32 * ks + 8 * fq + 4);
                  u32x4 wv; wv.x = cvt_pk_bf16(w0[0], w0[1]); wv.y = cvt_pk_bf16(w0[2], w0[3]); wv.z = cvt_pk_bf16(w1[0], w1[1]); wv.w = cvt_pk_bf16(w1[2], w1[3]);
                  if (fr != 0) wv = (u32x4){0u, 0u, 0u, 0u};
#pragma unroll
                  for (int dt = 0; dt < 2; ++dt) nacc[dt] = MFMA16(frag_tr(L + L_KS, QSTR, 32 * ks, 32 * w + 16 * dt, lane), __builtin_bit_cast(bf16x8, wv), nacc[dt]); } } }
        if (w == 0 && c + 1 < nch) mstate = mlstm_scan(gi + ifbi, gf + ifbf, lane, mstate, SC + ((c + 1) & 1) * 384);
        __syncthreads();
        numst = *(const LAS u32x4*)(L + L_NUMB + (tid >> 3) * VSTR + 16 * (tid & 7));
#pragma unroll
        for (int dt = 0; dt < 2; ++dt)
#pragma unroll
            for (int vi = 0; vi < 4; ++vi) *(LAS u32x2*)(L + L_CT + (16 * vi + fr) * QSTR + (32 * w + 16 * dt + 4 * fq) * 2) = pack4(cacc[dt][vi]);
        if (vs == 0 && fr == 0) {
#pragma unroll
            for (int dt = 0; dt < 2; ++dt) *(LAS u32x2*)(NSTB + (32 * w + 16 * dt + 4 * fq) * 2) = pack4(nacc[dt]); }
    }
    ML_STORE(nch - 1);
#undef ML_LOAD
#undef ML_STORE
    float* Cout = F.out + O_PC + (size_t)(b * 4 + h) * 131072;
#pragma unroll
    for (int dt = 0; dt < 2; ++dt)
#pragma unroll
        for (int vi = 0; vi < 4; ++vi)
#pragma unroll
            for (int r = 0; r < 4; ++r) { const int d = 32 * w + 16 * dt + 4 * fq + r, v = 16 * vi + fr; Cout[(size_t)d * 512 + vs * 64 + v] = cacc[dt][vi][r]; }
    if (vs == 0) { if (fr == 0) {
#pragma unroll
            for (int dt = 0; dt < 2; ++dt)
#pragma unroll
                for (int r = 0; r < 4; ++r) F.out[O_PN + (size_t)(b * 4 + h) * 256 + 32 * w + 16 * dt + 4 * fq + r] = nacc[dt][r]; }
        if (tid == 0) F.out[O_PM + b * 4 + h] = mstate; }
}

constexpr int XSTR = 144, BSTR = 272;
constexpr int S_XS = 0, S_XD = 9216, S_XW = 18432, S_BS = 27648, S_CS = 45056, S_HS = 62464, S_GB = 79872, S_SCAL = 89088, S_YB = 98304;

__device__ __forceinline__ void ssd_scan(float dtp, float Ae, int lane, LAS float* sc) {
    const float dt = fmaxf(dtp, 0.f) + fast_log1pexp_neg(fabsf(dtp));
    const float cum = wave_scan_add(dt * Ae);
    const float cl = __shfl(cum, 63);
    sc[lane] = cum; sc[64 + lane] = dt; sc[128 + lane] = fast_exp(cl - cum); sc[192 + lane] = fast_exp(cum);
    if (lane == 0) sc[256] = fast_exp(cl);
}

__device__ __forceinline__ void ssd_prompt_item(Frame& F, const Params& p, const int b, const int e) {
    LAS unsigned char* L = F.lds;
    const int tid = F.tid, lane = F.lane, w = F.wave, fr = lane & 15, fq = lane >> 4;
    const bf16_t* CV = (const bf16_t*)(F.ws + WS_CV); const float* GT = (const float*)(F.ws + WS_GATES);
    bf16_t* YS = (bf16_t*)(F.ws + WS_YS);
    const int g = e >> 3, m0 = b * SEQ; constexpr int nch = SEQ / 64;
    const float dtb = PIN(25)[e], Ae = -expf(PIN(26)[e]), De = PIN(27)[e];
    LAS float* SC = (LAS float*)(L + S_SCAL);
    f32x4 hacc[4];
#pragma unroll
    for (int pi = 0; pi < 4; ++pi) hacc[pi] = (f32x4){0.f, 0.f, 0.f, 0.f};
    u32x4 px, pb[2], pc[2]; float gd = 0.f;
    const bf16_t* xsrc = CV + (size_t)(m0 + (tid >> 3)) * CVP + 2048 + e * 64 + 8 * (tid & 7);
    const bf16_t* bsrc = CV + (size_t)(m0 + (tid >> 4)) * CVP + 4096 + g * 128 + 8 * (tid & 15);
    const float* gsrc = GT + (size_t)(m0 + lane) * 64 + 8 + e;
#define SD_LOAD(c) do { px = *(const u32x4*)(xsrc + (size_t)((c) * 64) * CVP); _Pragma("unroll") for (int i = 0; i < 2; ++i) { pb[i] = *(const u32x4*)(bsrc + (size_t)((c) * 64 + 32 * i) * CVP); pc[i] = *(const u32x4*)(bsrc + (size_t)((c) * 64 + 32 * i) * CVP + 512); } \
        if (w == 0) gd = gsrc[(size_t)((c) * 64) * 64]; } while (0)
    u32x4 yst = {0u, 0u, 0u, 0u};
    bf16_t* ydst = YS + (size_t)(m0 + (tid >> 3)) * 2048 + e * 64 + 8 * (tid & 7);
#define SD_STORE(c) do { *(u32x4*)(ydst + (size_t)((c) * 64) * 2048) = yst; } while (0)
    SD_LOAD(0);
    __syncthreads();
#pragma unroll
    for (int pi = 0; pi < 4; ++pi) *(LAS u32x2*)(L + S_HS + (16 * pi + fr) * BSTR + (16 * w + 4 * fq) * 2) = (u32x2){0u, 0u};
    if (w == 0) ssd_scan(gd + dtb, Ae, lane, SC);
    __syncthreads();
    for (int c = 0; c < nch; ++c) {
        const int t0 = 64 * c; LAS float* sc = SC + (c & 1) * 320;
        { const int row = tid >> 3, c8 = tid & 7; const float dt = sc[64 + row], ed = sc[128 + row]; float x[8]; unpack8(px, x);
          *(LAS u32x4*)(L + S_XS + row * XSTR + 16 * c8) = px; *(LAS u32x4*)(L + S_XD + row * XSTR + 16 * c8) = pack8(x, dt); *(LAS u32x4*)(L + S_XW + row * XSTR + 16 * c8) = pack8(x, dt * ed); }
#pragma unroll
        for (int i = 0; i < 2; ++i) { const int row = (tid >> 4) + 32 * i, c16 = tid & 15; *(LAS u32x4*)(L + S_BS + row * BSTR + 16 * c16) = pb[i]; *(LAS u32x4*)(L + S_CS + row * BSTR + 16 * c16) = pc[i]; }
        __syncthreads();
        if (c > 0) { SD_STORE(c - 1); }
        if (c + 1 < nch) SD_LOAD(c + 1);
        const int ti = w & 3, hf = w >> 2;
        bf16x8 cf[4];
#pragma unroll
        for (int k = 0; k < 4; ++k) cf[k] = frag_row(L + S_CS, BSTR, 16 * ti, 32 * k, lane);
        { f32x4 gacc[2] = {{0.f, 0.f, 0.f, 0.f}, {0.f, 0.f, 0.f, 0.f}};
#pragma unroll
          for (int j = 0; j < 2; ++j) { const int si = 2 * hf + j; if (si <= ti) {
#pragma unroll
                  for (int k = 0; k < 4; ++k) gacc[j] = MFMA16(frag_row(L + S_BS, BSTR, 16 * si, 32 * k, lane), cf[k], gacc[j]); } }
          const int t = 16 * ti + fr; const float cumt = sc[t];
#pragma unroll
          for (int j = 0; j < 2; ++j) { const int si = 2 * hf + j, s0 = 16 * si + 4 * fq; const f32x4 cs = *(const LAS f32x4*)(sc + s0); f32x4 vv;
#pragma unroll
              for (int r = 0; r < 4; ++r) vv[r] = (si <= ti && s0 + r <= t) ? gacc[j][r] * fast_exp(cumt - cs[r]) : 0.f;
              *(LAS u32x2*)(L + S_GB + t * XSTR + s0 * 2) = pack4(vv); } }
        __syncthreads();
        { f32x4 yacc[2] = {{0.f, 0.f, 0.f, 0.f}, {0.f, 0.f, 0.f, 0.f}};
#pragma unroll
          for (int j = 0; j < 2; ++j) { const int pi = 2 * hf + j;
#pragma unroll
              for (int k = 0; k < 4; ++k) yacc[j] = MFMA16(frag_row(L + S_HS, BSTR, 16 * pi, 32 * k, lane), cf[k], yacc[j]); }
          const int t = 16 * ti + fr; const float ec = sc[192 + t]; yacc[0] *= ec; yacc[1] *= ec;
#pragma unroll
          for (int ks = 0; ks < 2; ++ks) if (32 * ks <= 16 * ti + 15) { const bf16x8 gb = frag_row(L + S_GB, XSTR, 16 * ti, 32 * ks, lane);
#pragma unroll
              for (int j = 0; j < 2; ++j) yacc[j] = MFMA16(frag_tr(L + S_XD, XSTR, 32 * ks, 16 * (2 * hf + j), lane), gb, yacc[j]); }
#pragma unroll
          for (int j = 0; j < 2; ++j) { const int p0 = 16 * (2 * hf + j) + 4 * fq; const u32x2 xv = *(const LAS u32x2*)(L + S_XS + t * XSTR + p0 * 2);
              f32x4 y = yacc[j]; y[0] += De * bflo(xv.x); y[1] += De * bfhi(xv.x); y[2] += De * bflo(xv.y); y[3] += De * bfhi(xv.y);
              *(LAS u32x2*)(L + S_YB + t * XSTR + p0 * 2) = pack4(y); } }
        { const float eall = sc[256];
#pragma unroll
          for (int pi = 0; pi < 4; ++pi) hacc[pi] *= eall;
#pragma unroll
          for (int ks = 0; ks < 2; ++ks) { const bf16x8 ba = frag_tr(L + S_BS, BSTR, 32 * ks, 16 * w, lane);
#pragma unroll
              for (int pi = 0; pi < 4; ++pi) hacc[pi] = MFMA16(ba, frag_tr(L + S_XW, XSTR, 32 * ks, 16 * pi, lane), hacc[pi]); } }
        if (w == 0 && c + 1 < nch) ssd_scan(gd + dtb, Ae, lane, SC + ((c + 1) & 1) * 320);
        __syncthreads();
        yst = *(const LAS u32x4*)(L + S_YB + (tid >> 3) * XSTR + 16 * (tid & 7));
#pragma unroll
        for (int pi = 0; pi < 4; ++pi) *(LAS u32x2*)(L + S_HS + (16 * pi + fr) * BSTR + (16 * w + 4 * fq) * 2) = pack4(hacc[pi]);
    }
    SD_STORE(nch - 1);
#undef SD_LOAD
#undef SD_STORE
    float* hout = F.out + O_PSSM + (size_t)(b * 32 + e) * 8192;
#pragma unroll
    for (int pi = 0; pi < 4; ++pi) *(f32x4*)(hout + (size_t)(16 * pi + fr) * 128 + 16 * w + 4 * fq) = hacc[pi];
}

__device__ __forceinline__ void mlstm_sample_item(Frame& F, const Params& p, const int bs, const int h) {
    LAS unsigned char* L = F.lds; const int tid = F.tid, lane = F.lane, w = F.wave;
    const bf16_t* Z = (const bf16_t*)(F.ws + WS_ZIN); const bf16_t* CV = (const bf16_t*)(F.ws + WS_CV); const float* GT = (const float*)(F.ws + WS_GATES);
    bf16_t* NUM = (bf16_t*)(F.ws + WS_NUM); float* DEN = (float*)(F.ws + WS_DEN);
    const int m0 = MP + bs * TS;
    const float* C0 = PIN(4) + (size_t)(bs * 4 + h) * 131072; float* C1 = F.out + O_SC + (size_t)(bs * 4 + h) * 131072;
    LAS float* QKW = (LAS float*)L; LAS float* RED = (LAS float*)(L + 16384); LAS float* NS = (LAS float*)(L + 81920);
    LAS float* SCs = (LAS float*)(L + 82944); LAS float* SW = (LAS float*)(L + 83200); LAS float* QN = (LAS float*)(L + 83456);
    const int v4 = tid & 127, dp = tid >> 7;
    f32x4 vreg[8];
#pragma unroll
    for (int s = 0; s < 8; ++s) { const u32x2 vv = *(const u32x2*)(Z + (size_t)(m0 + s) * ZP + ZV + h * 512 + 4 * v4); vreg[s] = (f32x4){bflo(vv.x), bfhi(vv.x), bflo(vv.y), bfhi(vv.y)}; }
    const u32x4 qk = *(const u32x4*)(CV + (size_t)(m0 + ((tid >> 5) & 7)) * CVP + (tid >> 8) * 1024 + h * 256 + 8 * (tid & 31));
    const float n0v = tid < 256 ? PIN(5)[(size_t)(bs * 4 + h) * 256 + tid] : 0.f;
    __syncthreads();
    { const int isk = tid >> 8, t = (tid >> 5) & 7, c16 = tid & 31; float x[8]; unpack8(qk, x);
#pragma unroll
      for (int e = 0; e < 8; ++e) QKW[(8 * c16 + e) * 16 + isk * 8 + t] = x[e]; }
    if (tid < 256) NS[tid] = n0v;
    if (w == 0) {
        const bool valid = lane < 8; const float mstate = PIN(6)[bs * 4 + h];
        float ipre = 0.f, fpre = 0.f; if (valid) { ipre = GT[(size_t)(m0 + lane) * 64 + h] + PIN(20)[h]; fpre = GT[(size_t)(m0 + lane) * 64 + 4 + h] + PIN(20)[4 + h]; }
        float bsum = valid ? logsigmoidf_(fpre) : 0.f;
#pragma unroll
        for (int o = 1; o < 8; o <<= 1) { const float u = __shfl_up(bsum, o); if (lane >= o) bsum += u; }
        const float a = valid ? ipre - bsum : -INFINITY;
        float cm = a;
#pragma unroll
        for (int o = 1; o < 8; o <<= 1) { const float u = __shfl_up(cm, o); if (lane >= o) cm = fmaxf(cm, u); }
        const float A = fmaxf(mstate, cm); const float Alast = __shfl(A, 7), blast = __shfl(bsum, 7);
        if (valid) { SCs[lane] = a; SCs[8 + lane] = A; SCs[16 + lane] = expf(mstate - A); SCs[24 + lane] = expf(-(bsum + A)); SCs[32 + lane] = expf(a - Alast); }
        if (lane == 0) { SCs[40] = expf(mstate - Alast); F.out[O_SM + bs * 4 + h] = blast + Alast; }
    }
    __syncthreads();
    { const int pr = tid >> 3, part = tid & 7, t = pr >> 3, s = pr & 7; float acc = 0.f;
#pragma unroll 8
      for (int dd = 0; dd < 32; ++dd) { const int d = part * 32 + dd; acc += QKW[d * 16 + t] * QKW[d * 16 + 8 + s]; }
      acc += __shfl_xor(acc, 1); acc += __shfl_xor(acc, 2); acc += __shfl_xor(acc, 4);
      if (part == 0) SW[t * 8 + s] = (s <= t) ? acc * expf(SCs[s] - SCs[8 + t]) : 0.f; }
    if (tid < 64) { const int t = tid >> 3, part = tid & 7; float acc = 0.f;
#pragma unroll 8
      for (int dd = 0; dd < 32; ++dd) { const int d = part * 32 + dd; acc += QKW[d * 16 + t] * NS[d]; }
      acc += __shfl_xor(acc, 1); acc += __shfl_xor(acc, 2); acc += __shfl_xor(acc, 4);
      if (part == 0) QN[t] = acc; }
    if (tid >= 256) { const int d = tid - 256; float s = 0.f;
#pragma unroll
        for (int si = 0; si < 8; ++si) s += SCs[32 + si] * QKW[d * 16 + 8 + si];
        F.out[O_SN + (size_t)(bs * 4 + h) * 256 + d] = SCs[40] * NS[d] + s; }
    __syncthreads();
    if (tid < 8) { const int t = tid; float den = 0.f;
#pragma unroll
        for (int s = 0; s < 8; ++s) den += SW[t * 8 + s];
        den += SCs[16 + t] * QN[t]; DEN[(size_t)(m0 + t) * 4 + h] = fmaxf(fabsf(den), SCs[24 + t]); }
    if (tid >= 256) { const int d = tid - 256;
#pragma unroll
        for (int si = 0; si < 8; ++si) QKW[d * 16 + 8 + si] *= SCs[32 + si]; }
    __syncthreads();
    { const float decay = SCs[40];
      f32x4 acc[8];
#pragma unroll
      for (int t = 0; t < 8; ++t) acc[t] = (f32x4){0.f, 0.f, 0.f, 0.f};
      const float* cin = C0 + (size_t)(dp * 64) * 512 + 4 * v4; float* cout = C1 + (size_t)(dp * 64) * 512 + 4 * v4;
#pragma unroll 1
      for (int d0 = 0; d0 < 64; d0 += 8) {
          f32x4 cc[8];
#pragma unroll
          for (int i = 0; i < 8; ++i) cc[i] = __builtin_nontemporal_load((const f32x4*)(cin + (size_t)(d0 + i) * 512));
#pragma unroll
          for (int i = 0; i < 8; ++i) { const LAS float* qp = QKW + (dp * 64 + d0 + i) * 16;
              const f32x4 q0 = *(const LAS f32x4*)qp, q1 = *(const LAS f32x4*)(qp + 4), k0 = *(const LAS f32x4*)(qp + 8), k1 = *(const LAS f32x4*)(qp + 12);
              f32x4 cn = decay * cc[i];
#pragma unroll
              for (int t = 0; t < 4; ++t) { acc[t] += q0[t] * cc[i]; acc[4 + t] += q1[t] * cc[i]; cn += k0[t] * vreg[t]; cn += k1[t] * vreg[4 + t]; }
              __builtin_nontemporal_store(cn, (f32x4*)(cout + (size_t)(d0 + i) * 512)); }
      }
#pragma unroll
      for (int t = 0; t < 8; ++t) *(LAS f32x4*)(RED + (size_t)(dp * 8 + t) * 512 + 4 * v4) = acc[t]; }
    __syncthreads();
    { const int t = tid >> 6, v8 = tid & 63; float s[8];
#pragma unroll
      for (int e = 0; e < 8; ++e) s[e] = 0.f;
#pragma unroll
      for (int dpp = 0; dpp < 4; ++dpp) { const f32x4 a = *(const LAS f32x4*)(RED + (size_t)(dpp * 8 + t) * 512 + 8 * v8), b = *(const LAS f32x4*)(RED + (size_t)(dpp * 8 + t) * 512 + 8 * v8 + 4);
#pragma unroll
          for (int e = 0; e < 4; ++e) { s[e] += a[e]; s[4 + e] += b[e]; } }
      const float wst = SCs[16 + t];
#pragma unroll
      for (int e = 0; e < 8; ++e) s[e] *= wst;
      for (int si = 0; si <= t; ++si) { const float sw = SW[t * 8 + si]; float x[8]; unpack8(*(const u32x4*)(Z + (size_t)(m0 + si) * ZP + ZV + h * 512 + 8 * v8), x);
#pragma unroll
          for (int e = 0; e < 8; ++e) s[e] += sw * x[e]; }
      *(u32x4*)(NUM + (size_t)(m0 + t) * 2048 + h * 512 + 8 * v8) = pack8(s, 1.0f); }
}

__device__ __forceinline__ void ssd_sample_item(Frame& F, const Params& p, const int bs, const int g) {
    LAS unsigned char* L = F.lds; const int tid = F.tid, lane = F.lane, w = F.wave;
    const bf16_t* CV = (const bf16_t*)(F.ws + WS_CV); const float* GT = (const float*)(F.ws + WS_GATES); bf16_t* YS = (bf16_t*)(F.ws + WS_YS);
    const int m0 = MP + bs * TS;
    LAS float* BSf = (LAS float*)L; LAS float* CSf = (LAS float*)(L + 4096); LAS float* XF = (LAS float*)(L + 8192); LAS float* XWt = (LAS float*)(L + 24576);
    LAS float* XDt = (LAS float*)(L + 40960); LAS float* SC2 = (LAS float*)(L + 57344); LAS float* CB = (LAS float*)(L + 58432); LAS float* YP = (LAS float*)(L + 59392);
    const u32x4 xr = *(const u32x4*)(CV + (size_t)(m0 + (tid >> 6)) * CVP + 2048 + g * 512 + 8 * (tid & 63));
    u32x4 bcr = {0u, 0u, 0u, 0u};
    if (tid < 256) bcr = *(const u32x4*)(CV + (size_t)(m0 + ((tid >> 4) & 7)) * CVP + 4096 + (tid >> 7) * 512 + g * 128 + 8 * (tid & 15));
    __syncthreads();
    { float x[8]; unpack8(xr, x); const int t = tid >> 6, c8 = tid & 63;
#pragma unroll
      for (int e = 0; e < 8; ++e) XF[t * 512 + 8 * c8 + e] = x[e]; }
    if (tid < 256) { float x[8]; unpack8(bcr, x); const int isC = tid >> 7, t = (tid >> 4) & 7, c16 = tid & 15; LAS float* dst = isC ? CSf : BSf;
#pragma unroll
      for (int e = 0; e < 8; ++e) dst[t * 128 + 8 * c16 + e] = x[e]; }
    { const int e = g * 8 + w; const bool valid = lane < 8; const float Ae = -expf(PIN(26)[e]);
      const float dt = valid ? softplusf_(GT[(size_t)(m0 + lane) * 64 + 8 + e] + PIN(25)[e]) : 0.f;
      float cum = dt * Ae;
#pragma unroll
      for (int o = 1; o < 8; o <<= 1) { const float u = __shfl_up(cum, o); if (lane >= o) cum += u; }
      const float cl = __shfl(cum, 7);
      if (valid) { SC2[w * 32 + lane] = cum; SC2[w * 32 + 8 + lane] = dt; SC2[w * 32 + 16 + lane] = expf(cl - cum); SC2[w * 32 + 24 + lane] = expf(cum); }
      if (lane == 0) SC2[256 + w] = expf(cl); }
    __syncthreads();
    { const int pr = tid >> 3, part = tid & 7, t = pr >> 3, s = pr & 7; float acc = 0.f;
#pragma unroll
      for (int nn = 0; nn < 16; ++nn) { const int n = part * 16 + nn; acc += CSf[t * 128 + n] * BSf[s * 128 + n]; }
      acc += __shfl_xor(acc, 1); acc += __shfl_xor(acc, 2); acc += __shfl_xor(acc, 4);
      if (part == 0) CB[t * 8 + s] = acc; }
    { const int el = tid >> 6;
#pragma unroll
      for (int s = 0; s < 8; ++s) { const float x = XF[s * 512 + tid], dt = SC2[el * 32 + 8 + s], ed = SC2[el * 32 + 16 + s]; XDt[tid * 8 + s] = x * dt; XWt[tid * 8 + s] = x * dt * ed; } }
    __syncthreads();
    { const int n8 = tid & 15, prow = tid >> 4;
      float Bn[8][8], Cn[8][8];
#pragma unroll
      for (int s = 0; s < 8; ++s) { const f32x4 b0 = *(const LAS f32x4*)(BSf + s * 128 + 8 * n8), b1 = *(const LAS f32x4*)(BSf + s * 128 + 8 * n8 + 4), c0 = *(const LAS f32x4*)(CSf + s * 128 + 8 * n8), c1 = *(const LAS f32x4*)(CSf + s * 128 + 8 * n8 + 4);
#pragma unroll
          for (int j = 0; j < 4; ++j) { Bn[s][j] = b0[j]; Bn[s][4 + j] = b1[j]; Cn[s][j] = c0[j]; Cn[s][4 + j] = c1[j]; } }
      const float* hin = PIN(8) + (size_t)(bs * 32 + g * 8) * 8192 + 8 * n8; float* hout = F.out + O_SSSM + (size_t)(bs * 32 + g * 8) * 8192 + 8 * n8;
#pragma unroll 1
      for (int it = 0; it < 16; it += 2) {
          f32x4 hv[2][2];
#pragma unroll
          for (int u = 0; u < 2; ++u) { const int row = (it + u) * 32 + prow; hv[u][0] = __builtin_nontemporal_load((const f32x4*)(hin + (size_t)row * 128)); hv[u][1] = __builtin_nontemporal_load((const f32x4*)(hin + (size_t)row * 128 + 4)); }
#pragma unroll
          for (int u = 0; u < 2; ++u) { const int row = (it + u) * 32 + prow; const float eall = SC2[256 + (row >> 6)];
              const f32x4 xw0 = *(const LAS f32x4*)(XWt + row * 8), xw1 = *(const LAS f32x4*)(XWt + row * 8 + 4);
              float hh[8], hn[8], yp[8];
#pragma unroll
              for (int j = 0; j < 4; ++j) { hh[j] = hv[u][0][j]; hh[4 + j] = hv[u][1][j]; }
#pragma unroll
              for (int j = 0; j < 8; ++j) hn[j] = eall * hh[j];
#pragma unroll
              for (int s = 0; s < 8; ++s) { const float xw = s < 4 ? xw0[s & 3] : xw1[s & 3]; float y = 0.f;
#pragma unroll
                  for (int j = 0; j < 8; ++j) { hn[j] += xw * Bn[s][j]; y += Cn[s][j] * hh[j]; }
                  yp[s] = y; }
              f32x4 o0 = {hn[0], hn[1], hn[2], hn[3]}, o1 = {hn[4], hn[5], hn[6], hn[7]};
              __builtin_nontemporal_store(o0, (f32x4*)(hout + (size_t)row * 128)); __builtin_nontemporal_store(o1, (f32x4*)(hout + (size_t)row * 128 + 4));
#pragma unroll
              for (int s = 0; s < 8; ++s) { float y = yp[s]; y += __shfl_xor(y, 1); y += __shfl_xor(y, 2); y += __shfl_xor(y, 4); y += __shfl_xor(y, 8); yp[s] = y; }
              if (n8 == 0) { *(LAS f32x4*)(YP + row * 8) = (f32x4){yp[0], yp[1], yp[2], yp[3]}; *(LAS f32x4*)(YP + row * 8 + 4) = (f32x4){yp[4], yp[5], yp[6], yp[7]}; } }
      } }
    __syncthreads();
    { const int row = tid, el = row >> 6, pp = row & 63, e = g * 8 + el; const float De = PIN(27)[e];
#pragma unroll
      for (int t = 0; t < 8; ++t) { const float cumt = SC2[el * 32 + t]; float y = SC2[el * 32 + 24 + t] * YP[row * 8 + t];
#pragma unroll
          for (int s = 0; s < 8; ++s) if (s <= t) y += CB[t * 8 + s] * expf(cumt - SC2[el * 32 + s]) * XDt[row * 8 + s];
          y += De * XF[t * 512 + row];
          YS[(size_t)(m0 + t) * 2048 + e * 64 + pp] = (bf16_t)(cvt_pk_bf16(y, 0.f) & 0xffffu); } }
}

#ifndef IT_MASK
#define IT_MASK 15
#endif
__device__ __forceinline__ void phase_mixer(Frame& F, const Params& p, const int itm = IT_MASK) {
    if (itm & 1) { for (int it = F.bx; it < 256; it += F.G) { const int x = it & 7, j = it >> 3, pair = x * 4 + (j >> 3); mlstm_prompt_item(F, p, pair >> 2, pair & 3, j & 7); } }
    if (itm & 2) { for (int it = F.bx; it < 256; it += F.G) { const int x = it & 7, j = it >> 3, grp = x * 4 + (j >> 3); ssd_prompt_item(F, p, grp >> 2, (grp & 3) * 8 + (j & 7)); } }
    if (itm & 4) { for (int it = F.bx; it < 4 * (NBS - NS_EARLY); it += F.G) mlstm_sample_item(F, p, NS_EARLY + (it >> 2), it & 3); }
    if (itm & 8) { for (int it = F.bx; it < 4 * (NBS - NS_EARLY); it += F.G) ssd_sample_item(F, p, NS_EARLY + (it >> 2), it & 3); }
}

__device__ __forceinline__ void phase_finish(Frame& F, const Params& p) {
    const bf16_t* Z = (const bf16_t*)(F.ws + WS_ZIN); const bf16_t* NUM = (const bf16_t*)(F.ws + WS_NUM); const bf16_t* YS = (const bf16_t*)(F.ws + WS_YS);
    const float* DEN = (const float*)(F.ws + WS_DEN); bf16_t* HA = (bf16_t*)(F.ws + WS_HA); bf16_t* HB = (bf16_t*)(F.ws + WS_HB);
    const float* hg = PIN(21); const float* sg = PIN(28);
    const int gwv = F.bx * 8 + F.wave, NGW = F.G * 8, lane = F.lane;
    for (int m = gwv; m < MT; m += NGW) {
#pragma unroll
        for (int h = 0; h < 4; ++h) {
            float x[8], o[8], gz[8]; unpack8(*(const u32x4*)(NUM + (size_t)m * 2048 + h * 512 + 8 * lane), x);
            float s = 0.f;
#pragma unroll
            for (int e = 0; e < 8; ++e) s += x[e];
            const float mu = wave_sum(s) * (1.0f / 512.0f); float q = 0.f;
#pragma unroll
            for (int e = 0; e < 8; ++e) { x[e] -= mu; q += x[e] * x[e]; }
            const float var = wave_sum(q) * (1.0f / 512.0f), Dv = DEN[(size_t)m * 4 + h];
            const float rs = 1.0f / sqrtf(var + EPS * Dv * Dv);
            unpack8(*(const u32x4*)(Z + (size_t)m * ZP + ZO + h * 512 + 8 * lane), gz);
            const f32x4 g0 = *(const f32x4*)(hg + h * 512 + 8 * lane), g1 = *(const f32x4*)(hg + h * 512 + 8 * lane + 4);
#pragma unroll
            for (int e = 0; e < 8; ++e) o[e] = x[e] * rs * (e < 4 ? g0[e & 3] : g1[e & 3]) * sigmoidf_(gz[e]);
            *(u32x4*)(m < MP ? HA + (size_t)m * 2048 + h * 512 + 8 * lane : HA + (size_t)MP * 2048 + fo_index(m - MP, h * 512 + 8 * lane, 2048)) = pack8(o, 1.0f);
        }
#pragma unroll
        for (int gq = 0; gq < 4; ++gq) {
            float y[8], zz[8]; unpack8(*(const u32x4*)(YS + (size_t)m * 2048 + gq * 512 + 8 * lane), y); unpack8(*(const u32x4*)(Z + (size_t)m * ZP + ZZ + gq * 512 + 8 * lane), zz);
            float q = 0.f;
#pragma unroll
            for (int e = 0; e < 8; ++e) { y[e] *= siluf_(zz[e]); q += y[e] * y[e]; }
            const float rs = 1.0f / sqrtf(wave_sum(q) * (1.0f / 512.0f) + EPS);
            const f32x4 g0 = *(const f32x4*)(sg + gq * 512 + 8 * lane), g1 = *(const f32x4*)(sg + gq * 512 + 8 * lane + 4);
#pragma unroll
            for (int e = 0; e < 8; ++e) y[e] = y[e] * rs * (e < 4 ? g0[e & 3] : g1[e & 3]);
            *(u32x4*)(m < MP ? HB + (size_t)m * 2048 + gq * 512 + 8 * lane : HB + (size_t)MP * 2048 + fo_index(m - MP, gq * 512 + 8 * lane, 2048)) = pack8(y, 1.0f);
        }
    }
    const int gt = F.bx * NTHREADS + F.tid, NGT = F.G * NTHREADS;
    constexpr int N1 = NBP * 3 * 2048, N2 = NBS * 3 * 2048, N3 = NBP * 3 * 3072, N4 = NBS * 3 * 3072;
    for (int i = gt; i < N1 + N2 + N3 + N4; i += NGT) {
        int j = i;
        if (j < N1) { const int b = j / 6144, r = (j / 2048) % 3, ch = j % 2048; F.out[O_PMC + j] = bf2f(Z[(size_t)(b * SEQ + SEQ - 3 + r) * ZP + ch]); continue; } j -= N1;
        if (j < N2) { const int b = j / 6144, r = (j / 2048) % 3, ch = j % 2048; F.out[O_SMC + j] = bf2f(Z[(size_t)(MP + b * TS + TS - 3 + r) * ZP + ch]); continue; } j -= N2;
        if (j < N3) { const int b = j / 9216, r = (j / 3072) % 3, ch = j % 3072; F.out[O_PSC + j] = bf2f(Z[(size_t)(b * SEQ + SEQ - 3 + r) * ZP + ZX + ch]); continue; } j -= N3;
        { const int b = j / 9216, r = (j / 3072) % 3, ch = j % 3072; F.out[O_SSC + j] = bf2f(Z[(size_t)(MP + b * TS + TS - 3 + r) * ZP + ZX + ch]); }
    }
}


#ifndef STAG_LEVELS
#define STAG_LEVELS 8
#endif
#ifndef STAG_SLEEP
#define STAG_SLEEP 16
#endif
__device__ __forceinline__ void stagger_start(const Frame& F) { const int sl = (F.bx >> 3) & (STAG_LEVELS - 1); for (int q = 0; q < sl; ++q) __builtin_amdgcn_s_sleep(STAG_SLEEP); }

constexpr int LDS_BYTES = 147456;
constexpr int NPHASE = 15;

__global__ void __launch_bounds__(NTHREADS, 2) fwd_kernel(Params p) {
    extern __shared__ __attribute__((aligned(16))) unsigned char lds_raw[];
    Frame F;
    F.lds = (LAS unsigned char*)lds_raw;
    F.tid = threadIdx.x; F.lane = F.tid & 63; F.wave = __builtin_amdgcn_readfirstlane(F.tid >> 6);
    F.G = gridDim.x; F.bx = blockIdx.x;
    F.out = p.out; F.ws = p.ws;
    unsigned char* ws = p.ws;
    bf16_t* U = (bf16_t*)(ws + WS_U); bf16_t* H = (bf16_t*)(ws + WS_H); float* X1 = (float*)(ws + WS_X1);
    bf16_t* ZIN = (bf16_t*)(ws + WS_ZIN); float* GATES = (float*)(ws + WS_GATES); float* MOD = (float*)(ws + WS_MOD);
    const int lo = p.ph_lo, hi = p.ph_hi;
#ifndef PH_MASK
#define PH_MASK 0xfffff
#endif
#define IN(k) (((PH_MASK >> (k)) & 1) && lo <= (k) && (k) < hi)
#ifndef DUP_MASK
#define DUP_MASK 0
#endif
#define DUP(k) ((DUP_MASK >> (k)) & 1)
    volatile LAS unsigned* MISC = (volatile LAS unsigned*)(F.lds + LDS_BYTES - 64);
    if (F.tid < 16) MISC[F.tid] = 0u;
    if (F.tid == 0) { volatile LAS unsigned* T = (volatile LAS unsigned*)(F.lds + PTAB_OFF);
#pragma unroll
        for (int k = 0; k < 36; ++k) { const uint64_t a = (uint64_t)p.in[k]; T[2 * k] = (unsigned)a; T[2 * k + 1] = (unsigned)(a >> 32); } }
    __syncthreads();
    XcdBarrier bar; bar.bar = (unsigned*)(ws + WS_CTL); bar.x = 0; bar.st = nullptr;
    if (hi - lo > 1) bar = xcd_barrier_post((unsigned*)(ws + WS_CTL), MISC);
#define SEAM(k) do { if (IN(k) && IN((k) + 1)) { xcd_barrier(bar); } } while (0)

    if (IN(0)) { phase_prep<0>(F, p); } SEAM(0);
    if (IN(1)) { phase_norm_mod(F, PIN(0), PIN(1), PIN(12), 0 * DM, 1 * DM, U); if (DUP(1)) phase_norm_mod(F, PIN(0), PIN(1), PIN(12), 0 * DM, 1 * DM, U); } SEAM(1);
    if (IN(2)) { pg8::Gemm g{U, U, (const bf16_t*)(ws + WS_WUP1), (const bf16_t*)(ws + WS_WUP1), DM}; pg8::Order S;
        if (F.bx < 192) { stagger_start(F); S.init_from(MT, 2 * DFF, 192, F.bx, 0, 1344); } else { phase_prep<1>(F, p); S.init_from(MT, 2 * DFF, 64, F.bx - 192, 1344, 1496); }
        pg8::EpiSwiGLU E{H}; pg8::gemm_phase(F.lds, g, S, E); if (DUP(2)) pg8::gemm_phase(F.lds, g, S, E); } SEAM(2);
    float* XS = (float*)(ws + WS_XS); unsigned* CNT = (unsigned*)(ws + WS_CTL) + CW_CNT; bf16_t* U2 = (bf16_t*)(ws + WS_U2);
    if (IN(3)) { stagger_start(F); pg8::Gemm g{H, H, (const bf16_t*)(ws + WS_WDN1), (const bf16_t*)(ws + WS_WDN1), DFF}; pg8::Order S; S.init(MP, DM, F.G, F.bx, 0);
        pg8::EpiResidNorm<false> E{PIN(0), X1, MOD + 2 * DM, PIN(16), MOD + 3 * DM, MOD + 4 * DM, U, nullptr, XS, CNT, 0.5f, 0}; pg8::gemm_phase(F.lds, g, S, E);
        small_phase_resid_norm<DFF, false>(F, H, (const bf16_t*)(ws + WS_FDN1), PIN(1), X1, MOD + 2 * DM, 0.5f, PIN(16), MOD + 3 * DM, MOD + 4 * DM, U, nullptr, XS, CNT); } SEAM(3);
    if (IN(5)) {
        const pg8::Gemm g{U, U, (const bf16_t*)(ws + WS_WIN), (const bf16_t*)(ws + WS_WIN), DM}; const pg8::EpiZin E{ZIN, GATES};
        { stagger_start(F); const pg8::OrderSample S{F.bx}; pg8::gemm_phase<pg8::EpiZin, true, pg8::OrderSample>(F.lds, g, S, E); }
        if (F.bx >= 208 && F.bx < 224) small_gates_tile(F, U, (const bf16_t*)(ws + WS_FG), GATES, MP / 64 + (F.bx - 208));
        if (F.bx >= 224) { for (int k = 0; k < 4; ++k) small_gates_tile(F, U, (const bf16_t*)(ws + WS_FG), GATES, 4 * (F.bx - 224) + k); }
        xcd_barrier(bar);
        if (F.bx >= 192) {
            const int s0 = F.bx - 192;
            for (int k = F.wave; k < 10; k += 8) conv_item(F, p, 5120 + 10 * s0 + k);
            asm volatile("s_waitcnt vmcnt(0)" ::: "memory"); __syncthreads(); __builtin_amdgcn_fence(__ATOMIC_ACQUIRE, "agent");
#pragma unroll 1
            for (int k = 0; k < 4; ++k) mlstm_sample_item(F, p, s0, k);
#pragma unroll 1
            for (int k = 0; k < 4; ++k) ssd_sample_item(F, p, s0, k);
            for (int k = 0; k < 2; ++k) small_gates_tile(F, U, (const bf16_t*)(ws + WS_FG), GATES, 128 + 2 * s0 + k);
        } else stagger_start(F);
        __syncthreads();
        { const pg8::OrderPrompt S{F.bx}; pg8::gemm_phase<pg8::EpiZin, true, pg8::OrderPrompt>(F.lds, g, S, E); }
        } SEAM(5);
    if (IN(6)) { phase_conv(F, p); if (DUP(6)) phase_conv(F, p); } SEAM(6);
    #ifndef DUP_IT
#define DUP_IT 15
#endif
    if (IN(7)) { phase_mixer(F, p, p.itm); } SEAM(7);
    if (IN(8)) { phase_finish(F, p); if (DUP(8)) phase_finish(F, p); } SEAM(8);
    if (IN(9)) { stagger_start(F); pg8::Gemm g{(const bf16_t*)(ws + WS_HA), (const bf16_t*)(ws + WS_HB), (const bf16_t*)(ws + WS_WPA), (const bf16_t*)(ws + WS_WPB), 2048}; pg8::Order S; S.init(MP, DM, F.G, F.bx, 1);
        pg8::EpiMerge E{ZIN, (float*)(ws + WS_TMP), U}; pg8::gemm_phase(F.lds, g, S, E);
        small_phase_merge(F, (const bf16_t*)(ws + WS_HA), (const bf16_t*)(ws + WS_HB), (const bf16_t*)(ws + WS_FPA), (const bf16_t*)(ws + WS_FPB), ZIN, U); } SEAM(9);
    if (IN(10)) { stagger_start(F); pg8::Gemm g{U, U, (const bf16_t*)(ws + WS_WOUT), (const bf16_t*)(ws + WS_WOUT), DM}; pg8::Order S; S.init(MP, DM, F.G, F.bx, 0);
        pg8::EpiResidNorm<false> E{X1, X1, MOD + 5 * DM, PIN(31), MOD + 6 * DM, MOD + 7 * DM, U2, nullptr, XS + (size_t)MT * 16, CNT + CNT_STRIDE, 1.0f, 0}; pg8::gemm_phase(F.lds, g, S, E);
        small_phase_resid_norm<DM, false>(F, U, (const bf16_t*)(ws + WS_FOUT), X1 + (size_t)MP * DM, X1, MOD + 5 * DM, 1.0f, PIN(31), MOD + 6 * DM, MOD + 7 * DM, U2, nullptr, XS + (size_t)MT * 16, CNT + CNT_STRIDE); } SEAM(10);
    if (IN(12)) { stagger_start(F); pg8::Gemm g{U2, U2, (const bf16_t*)(ws + WS_WUP2), (const bf16_t*)(ws + WS_WUP2), DM}; pg8::Order S; S.init(MT, 2 * DFF, F.G, F.bx, 0);
        pg8::EpiSwiGLU E{H}; pg8::gemm_phase(F.lds, g, S, E); } SEAM(12);
    if (IN(13)) { stagger_start(F); pg8::Gemm g{H, H, (const bf16_t*)(ws + WS_WDN2), (const bf16_t*)(ws + WS_WDN2), DFF}; pg8::Order S; S.init(MP, DM, F.G, F.bx, 0);
        pg8::EpiResidNorm<true> E{X1, nullptr, MOD + 8 * DM, PIN(35), nullptr, nullptr, nullptr, p.out, XS + (size_t)2 * MT * 16, CNT + 2 * CNT_STRIDE, 0.5f, 0}; pg8::gemm_phase(F.lds, g, S, E);
        small_phase_resid_norm<DFF, true>(F, H, (const bf16_t*)(ws + WS_FDN2), X1 + (size_t)MP * DM, nullptr, MOD + 8 * DM, 0.5f, PIN(35), nullptr, nullptr, nullptr, p.out, XS + (size_t)2 * MT * 16, CNT + 2 * CNT_STRIDE); }
#undef IN
#undef SEAM
}

extern "C" void kernel_launch(void* const* d_in, const int* in_sizes, int n_in, void* d_out, int out_size, void* d_ws, size_t ws_size, hipStream_t stream) {
    static int grid = 0;
    if (grid == 0) {
        if (n_in != 36 || ws_size < WS_END) { fprintf(stderr, "kernel_launch: expected 36 inputs and >= %zu bytes of workspace (got %d, %zu)\n", (size_t)WS_END, n_in, ws_size); grid = -1; return; }
        int dev = 0, cus = 0, per_cu = 0;
        hipGetDevice(&dev); hipDeviceGetAttribute(&cus, hipDeviceAttributeMultiprocessorCount, dev);
        hipFuncSetAttribute((const void*)fwd_kernel, hipFuncAttributeMaxDynamicSharedMemorySize, LDS_BYTES);
        hipOccupancyMaxActiveBlocksPerMultiprocessor(&per_cu, (const void*)fwd_kernel, NTHREADS, LDS_BYTES);
        if (per_cu < 1) { fprintf(stderr, "kernel_launch: occupancy query says %d blocks per CU\n", per_cu); grid = -1; return; }
        grid = cus;
        if (grid != 256) { fprintf(stderr, "kernel_launch: the fused-norm GEMM epilogues need exactly 256 workgroups (one 256x256 tile each); this device has %d CUs\n", cus); grid = -1; return; }
    }
    if (grid < 0) return;
    Params p{};
    for (int i = 0; i < 36; ++i) p.in[i] = (const float*)d_in[i];
    p.out = (float*)d_out; p.ws = (unsigned char*)d_ws; p.itm = 15;
#if MK_LAUNCH_PER_PHASE
    for (int ph = 0; ph < NPHASE; ++ph) { p.ph_lo = ph; p.ph_hi = ph + 1; hipLaunchKernelGGL(fwd_kernel, dim3(grid), dim3(NTHREADS), LDS_BYTES, stream, p); }
#else
    p.ph_lo = 0; p.ph_hi = NPHASE;
    if (hipMemsetAsync((char*)d_ws + WS_CTL, 0, 98304, stream) != hipSuccess) { fprintf(stderr, "kernel_launch: memset of the barrier words failed\n"); return; }
    void* args[] = {&p};
    hipError_t e = hipLaunchCooperativeKernel((const void*)fwd_kernel, dim3(grid), dim3(NTHREADS), args, LDS_BYTES, stream);
    if (e != hipSuccess) fprintf(stderr, "cooperative launch failed: %s (grid %d)\n", hipGetErrorString(e), grid);
#ifdef PROBE_PH
    for (int r = 0; r < PROBE_REPS; ++r) { Params q = p; q.ph_lo = PROBE_PH; q.ph_hi = PROBE_PH + 1; q.itm = PROBE_ITM; hipLaunchKernelGGL(fwd_kernel, dim3(grid), dim3(NTHREADS), LDS_BYTES, stream, q); }
#endif
#endif
}
```

```cpp
#include <hip/hip_runtime.h>
#include <hip/hip_cooperative_groups.h>
#include <cstdio>
#include <cstdint>
namespace cg = cooperative_groups;

#ifndef MK_LAUNCH_PER_PHASE
#define MK_LAUNCH_PER_PHASE 0
#endif

constexpr int DM = 1024, SEQ = 2048, NBP = 8, NBS = 128, TS = 8;
constexpr int MP = NBP * SEQ, MS = NBS * TS, MT = MP + MS, NBID = NBP + NBS;
constexpr int DFF = 2816, NMOD = 9 * DM;
constexpr int ZP = 13568;
constexpr int ZQ = 0, ZK = 1024, ZV = 2048, ZO = 4096, ZZ = 6144, ZX = 8192, ZGA = 11264, ZGB = 12288, ZG = 13312;
constexpr float EPS = 1e-6f;
constexpr int NTHREADS = 512;

constexpr size_t MiB = 1u << 20;
constexpr size_t WS_CTL = 0;
constexpr size_t WS_WUP1 = 1 * MiB;
constexpr size_t WS_WDN1 = WS_WUP1 + 11 * MiB;
constexpr size_t WS_WUP2 = WS_WDN1 + 6 * MiB;
constexpr size_t WS_WDN2 = WS_WUP2 + 11 * MiB;
constexpr size_t WS_WIN = WS_WDN2 + 6 * MiB;
constexpr size_t WS_WPA = WS_WIN + 27 * MiB;
constexpr size_t WS_WPB = WS_WPA + 4 * MiB;
constexpr size_t WS_WOUT = WS_WPB + 4 * MiB;
constexpr size_t WS_MOD = WS_WOUT + 2 * MiB;
constexpr size_t WS_U = WS_MOD + 5 * MiB;
constexpr size_t WS_H = WS_U + 34 * MiB;
constexpr size_t WS_X1 = WS_H + 94 * MiB;
constexpr size_t WS_ZIN = WS_X1 + 68 * MiB;
constexpr size_t WS_GATES = WS_ZIN + 451 * MiB;
constexpr size_t WS_YS = WS_GATES + 5 * MiB;
constexpr size_t WS_DEN = WS_YS + 68 * MiB;
constexpr size_t WS_HA = WS_DEN + 1 * MiB;
constexpr size_t WS_HB = WS_HA + 68 * MiB;
constexpr size_t WS_CV = WS_HA;
constexpr size_t WS_XS = WS_CV + 170 * MiB;
constexpr size_t WS_U2 = WS_ZIN;
constexpr size_t WS_FDN1 = WS_XS + 4 * MiB;
constexpr size_t WS_FDN2 = WS_FDN1 + 6 * MiB;
constexpr size_t WS_FPA = WS_FDN2 + 6 * MiB;
constexpr size_t WS_FPB = WS_FPA + 4 * MiB;
constexpr size_t WS_FOUT = WS_FPB + 4 * MiB;
constexpr size_t WS_FG = WS_FOUT + 2 * MiB;
constexpr size_t WS_SC = WS_FG + 1 * MiB;
constexpr size_t WS_END = WS_SC + 1 * MiB;
constexpr int CW_CNT = 4096, CNT_STRIDE = 5120;
constexpr size_t WS_NUM = WS_H;
constexpr size_t WS_TMP = WS_YS;
static_assert(WS_END <= 1024 * MiB, "workspace map");

#define LAS __attribute__((address_space(3)))
typedef unsigned short bf16_t;
typedef short bf16x8 __attribute__((ext_vector_type(8)));
typedef short s16x4 __attribute__((ext_vector_type(4)));
typedef float f32x4 __attribute__((ext_vector_type(4)));
typedef float f32x2 __attribute__((ext_vector_type(2)));
typedef unsigned u32x4 __attribute__((ext_vector_type(4)));
typedef unsigned u32x2 __attribute__((ext_vector_type(2)));

typedef __bf16 bf16x2_t __attribute__((ext_vector_type(2)));
__device__ __forceinline__ unsigned cvt_pk_bf16(float lo, float hi) { const bf16x2_t v = {(__bf16)lo, (__bf16)hi}; return __builtin_bit_cast(unsigned, v); }
__device__ __forceinline__ float bf2f(unsigned short b) { return __uint_as_float(((unsigned)b) << 16); }
__device__ __forceinline__ float bflo(unsigned w) { return __uint_as_float(w << 16); }
__device__ __forceinline__ float bfhi(unsigned w) { return __uint_as_float(w & 0xffff0000u); }
__device__ __forceinline__ float fast_exp(float x) { return __builtin_amdgcn_exp2f(x * 1.4426950408889634f); }
__device__ __forceinline__ float sigmoidf_(float x) { return __builtin_amdgcn_rcpf(1.0f + fast_exp(-x)); }
__device__ __forceinline__ float siluf_(float x) { return x * sigmoidf_(x); }
__device__ __forceinline__ u32x4 pack8(const float (&v)[8], float s) {
    u32x4 w; w.x = cvt_pk_bf16(v[0] * s, v[1] * s); w.y = cvt_pk_bf16(v[2] * s, v[3] * s); w.z = cvt_pk_bf16(v[4] * s, v[5] * s); w.w = cvt_pk_bf16(v[6] * s, v[7] * s); return w;
}
__device__ __forceinline__ u32x2 pack4(const f32x4 v) { u32x2 w; w.x = cvt_pk_bf16(v[0], v[1]); w.y = cvt_pk_bf16(v[2], v[3]); return w; }
__device__ __forceinline__ void unpack8(const u32x4 v, float (&x)[8]) { x[0] = bflo(v.x); x[1] = bfhi(v.x); x[2] = bflo(v.y); x[3] = bfhi(v.y); x[4] = bflo(v.z); x[5] = bfhi(v.z); x[6] = bflo(v.w); x[7] = bfhi(v.w); }
__device__ __forceinline__ size_t fo_index(int r, int k, int K) { return ((size_t)((r >> 4) * (K >> 5) + (k >> 5))) * 512 + (size_t)((((r & 15) + 16 * ((k >> 3) & 3)) << 3) + (k & 7)); }
__device__ __forceinline__ float wave_scan_add(float v) {
    v += __builtin_bit_cast(float, __builtin_amdgcn_update_dpp(0, __builtin_bit_cast(int, v), 0x111, 0xf, 0xf, true));
    v += __builtin_bit_cast(float, __builtin_amdgcn_update_dpp(0, __builtin_bit_cast(int, v), 0x112, 0xf, 0xf, true));
    v += __builtin_bit_cast(float, __builtin_amdgcn_update_dpp(0, __builtin_bit_cast(int, v), 0x114, 0xf, 0xf, true));
    v += __builtin_bit_cast(float, __builtin_amdgcn_update_dpp(0, __builtin_bit_cast(int, v), 0x118, 0xf, 0xf, true));
    v += __builtin_bit_cast(float, __builtin_amdgcn_update_dpp(0, __builtin_bit_cast(int, v), 0x142, 0xa, 0xf, true));
    v += __builtin_bit_cast(float, __builtin_amdgcn_update_dpp(0, __builtin_bit_cast(int, v), 0x143, 0xc, 0xf, true));
    return v;
}
__device__ __forceinline__ float wave_scan_max(float v) {
    const int ninf = (int)0xff800000u;
    v = fmaxf(v, __builtin_bit_cast(float, __builtin_amdgcn_update_dpp(ninf, __builtin_bit_cast(int, v), 0x111, 0xf, 0xf, false)));
    v = fmaxf(v, __builtin_bit_cast(float, __builtin_amdgcn_update_dpp(ninf, __builtin_bit_cast(int, v), 0x112, 0xf, 0xf, false)));
    v = fmaxf(v, __builtin_bit_cast(float, __builtin_amdgcn_update_dpp(ninf, __builtin_bit_cast(int, v), 0x114, 0xf, 0xf, false)));
    v = fmaxf(v, __builtin_bit_cast(float, __builtin_amdgcn_update_dpp(ninf, __builtin_bit_cast(int, v), 0x118, 0xf, 0xf, false)));
    v = fmaxf(v, __builtin_bit_cast(float, __builtin_amdgcn_update_dpp(ninf, __builtin_bit_cast(int, v), 0x142, 0xa, 0xf, false)));
    v = fmaxf(v, __builtin_bit_cast(float, __builtin_amdgcn_update_dpp(ninf, __builtin_bit_cast(int, v), 0x143, 0xc, 0xf, false)));
    return v;
}
__device__ __forceinline__ float wave_sum(float v) { return __builtin_bit_cast(float, __builtin_amdgcn_readlane(__builtin_bit_cast(int, wave_scan_add(v)), 63)); }

struct Params {
    const float* in[36];
    float* out;
    unsigned char* ws;
    int ph_lo, ph_hi, itm, pad;
};

namespace pg8 {
constexpr int BM = 256, BK = 64, HALF = 128, HTB = HALF * BK * 2, STAGE_BYTES = 8 * HTB, NXCD = 8, WGM = 8;
__host__ __device__ __forceinline__ int lds_byte(int r, int c) { const int st = (r >> 4) * 2 + (c >> 5), rr = r & 15, cc = c & 31, ob = rr * 64 + cc * 2; return st * 1024 + (ob ^ (((ob >> 9) & 1) << 5)); }
__host__ __device__ __forceinline__ void stage_rc(int b, int& R, int& C) { const int st = b / 1024, sb = b % 1024, swz = sb ^ (((sb >> 9) & 1) << 5); R = (st >> 1) * 16 + swz / 64; C = (st & 1) * 32 + (swz % 64) / 2; }
__host__ __device__ __forceinline__ int perm32(int rho) { const int n = rho >> 4, i = rho & 15; return 8 * (i >> 2) + 4 * n + (i & 3); }

struct Unit { int pm, pn, w; };
struct Gemm { const bf16_t* A0; const bf16_t* A1; const bf16_t* B0; const bf16_t* B1; int K; };

struct OrderSample { int c;
    __device__ bool next(int i, Unit& u) const { if (i > 0 || c >= 208) return false; const int x = c & 7, j = c >> 3; u.pm = 64 + (x >> 1); u.pn = (x & 1) * 26 + j; u.w = 0; return true; } };
struct OrderPrompt { int c;
    __device__ bool next(int i, Unit& u) const { const int x = c & 7, j = c >> 3; int q; if (j < 24) { if (i >= 17) return false; q = i * 24 + j; } else { if (i >= 1) return false; q = 408 + (j - 24); }
        u.pm = 8 * x + (q & 7); u.pn = q >> 3; u.w = 0; return true; } };
struct Order {
    int nM, nN, nwg, G, c, dual;
    __device__ void init(int M, int N, int G_, int c_, int dual_) { nM = M / BM; nN = N / BM; nwg = nM * nN; G = G_; c = c_; dual = dual_; }
    __device__ void init_from(int M, int N, int G_, int c_, int first, int lim) { nM = M / BM; nN = N / BM; nwg = lim; G = G_; c = first + c_; dual = 0; }
    __device__ bool next(int i, Unit& u) const {
        const int ti = dual ? (i >> 1) : i;
        const long L = (long)ti * G + c; if (L >= nwg) return false;
        int wgid = (int)L; { const int tot = nM * nN, q = tot / NXCD, r = tot % NXCD, xcd = wgid % NXCD, off = wgid / NXCD; wgid = (xcd < r ? xcd * (q + 1) : r * (q + 1) + (xcd - r) * q) + off; }
        const int nig = WGM * nN, gid = wgid / nig, fm = gid * WGM, gsz = (nM - fm) < WGM ? (nM - fm) : WGM;
        u.pm = fm + ((wgid % nig) % gsz); u.pn = (wgid % nig) / gsz; u.w = dual ? (i & 1) : 0; return true;
    }
};

template <class Epi, bool ALIGN_EPI = true, class Ord = Order>
__device__ __forceinline__ void gemm_phase(LAS unsigned char* lds, const Gemm g, const Ord& S, const Epi E) {
    const int tid = threadIdx.x, wid = __builtin_amdgcn_readfirstlane(tid >> 6), lane = tid & 63, wr = wid >> 2, wc = wid & 3, fr = lane & 15, fq = lane >> 4;
    const int K = g.K, nt = K / BK;
    unsigned voffA[2], voffB[2];
#pragma unroll
    for (int i = 0; i < 2; ++i) { int R, C; stage_rc(tid * 16 + i * 8192, R, C); const int Rb = Epi::PERM ? ((R & ~31) + perm32(R & 31)) : R;
        voffA[i] = (unsigned)(R * K + C) * 2u; voffB[i] = (unsigned)(Rb * K + C) * 2u; }
    const size_t kstep = (size_t)(BK * 2);
    const size_t hstep = (size_t)HALF * K * 2;
    const size_t tstep = 2 * hstep;
    const unsigned ldsw = (unsigned)wid * 1024u;
    const int aoff = lds_byte(wr * 64 + fr, fq * 8), boff = lds_byte(wc * 32 + fr, fq * 8);
#define PG8_SA(b, h) (((b) * 2 + (h)) * HTB)
#define PG8_SB(b, h) ((4 + (b) * 2 + (h)) * HTB)
#define PG8_STAGE(bufoff, gbase, voff) do { _Pragma("unroll") for (int _i = 0; _i < 2; ++_i) \
        __builtin_amdgcn_global_load_lds((const unsigned*)((const char*)(gbase) + (voff)[_i]), (LAS unsigned*)(lds + (bufoff) + ldsw + _i * 8192), 16, 0, 0); } while (0)
#define PG8_LDA(dst, b, h) do { _Pragma("unroll") for (int m = 0; m < 4; ++m) _Pragma("unroll") for (int k = 0; k < 2; ++k) dst[m][k] = *(const LAS bf16x8*)(lds + PG8_SA(b, h) + aoff + m * 2048 + k * 1024); } while (0)
#define PG8_LDB(dst, b, h) do { _Pragma("unroll") for (int n = 0; n < 2; ++n) _Pragma("unroll") for (int k = 0; k < 2; ++k) dst[n][k] = *(const LAS bf16x8*)(lds + PG8_SB(b, h) + boff + n * 2048 + k * 1024); } while (0)
#define PG8_MMA(ai, bj, At, Bt) do { __builtin_amdgcn_s_setprio(1); _Pragma("unroll") for (int m = 0; m < 4; ++m) _Pragma("unroll") for (int n = 0; n < 2; ++n) _Pragma("unroll") for (int k = 0; k < 2; ++k) \
        acc[ai][bj][m][n] = __builtin_amdgcn_mfma_f32_16x16x32_bf16(Bt[n][k], At[m][k], acc[ai][bj][m][n], 0, 0, 0); __builtin_amdgcn_s_setprio(0); } while (0)
#define PG8_WAIT_V(n) asm volatile("s_waitcnt vmcnt(" #n ")" ::: "memory")
#define PG8_WAIT_L(n) asm volatile("s_waitcnt lgkmcnt(" #n ")" ::: "memory")
#define PG8_BAR __builtin_amdgcn_s_barrier()
#define PG8_SCHED __builtin_amdgcn_sched_barrier(0)
    Unit cur, nxt; int ui = 0;
    if (!S.next(0, cur)) return;
    f32x4 acc[2][2][4][2];
#pragma unroll
    for (int a = 0; a < 2; ++a)
#pragma unroll
        for (int b = 0; b < 2; ++b)
#pragma unroll
            for (int m = 0; m < 4; ++m)
#pragma unroll
                for (int n = 0; n < 2; ++n) acc[a][b][m][n] = (f32x4){0.f, 0.f, 0.f, 0.f};
    bf16x8 At[4][2], B0[2][2], B1[2][2];
    const char* cA = (const char*)(cur.w ? g.A1 : g.A0) + (size_t)cur.pm * tstep; const char* cB = (const char*)(cur.w ? g.B1 : g.B0) + (size_t)cur.pn * tstep;
    PG8_STAGE(PG8_SB(0, 0), cB, voffB); PG8_STAGE(PG8_SB(0, 1), cB + hstep, voffB); PG8_STAGE(PG8_SA(0, 0), cA, voffA); PG8_STAGE(PG8_SA(0, 1), cA + hstep, voffA);
    if (wr == 1) PG8_BAR;
    PG8_WAIT_V(2); PG8_BAR;
    PG8_STAGE(PG8_SB(1, 0), cB + kstep, voffB); PG8_STAGE(PG8_SA(1, 0), cA + kstep, voffA); PG8_STAGE(PG8_SB(1, 1), cB + hstep + kstep, voffB);
    PG8_WAIT_V(6); PG8_BAR;
    for (;;) {
        const bool has_next = S.next(ui + 1, nxt);
        const char* nA = has_next ? (const char*)(nxt.w ? g.A1 : g.A0) + (size_t)nxt.pm * tstep : cA; const char* nB = has_next ? (const char*)(nxt.w ? g.B1 : g.B0) + (size_t)nxt.pn * tstep : cB;
        for (int t = 0; t < nt; t += 2) {
            const bool last = (t == nt - 2);
            const char* a1 = cA + (size_t)(t + 1) * kstep;
            const char* a2 = last ? nA : cA + (size_t)(t + 2) * kstep; const char* b2 = last ? nB : cB + (size_t)(t + 2) * kstep;
            const char* a3 = a2 + kstep; const char* b3 = b2 + kstep;
            PG8_LDB(B0, 0, 0); PG8_LDB(B1, 0, 1); PG8_SCHED; PG8_LDA(At, 0, 0); PG8_STAGE(PG8_SA(1, 1), a1 + hstep, voffA);
            PG8_WAIT_V(8); PG8_WAIT_L(0); PG8_BAR; PG8_MMA(0, 0, At, B0); PG8_MMA(0, 1, At, B1); PG8_BAR; PG8_SCHED;
            PG8_LDA(At, 0, 1); PG8_STAGE(PG8_SB(0, 0), b2, voffB); PG8_STAGE(PG8_SB(0, 1), b2 + hstep, voffB); PG8_STAGE(PG8_SA(0, 0), a2, voffA);
            PG8_WAIT_V(8); PG8_WAIT_L(0); PG8_BAR; PG8_MMA(1, 0, At, B0); PG8_MMA(1, 1, At, B1); PG8_BAR; PG8_SCHED;
            PG8_LDB(B0, 1, 0); PG8_LDB(B1, 1, 1); PG8_SCHED; PG8_LDA(At, 1, 0); PG8_STAGE(PG8_SA(0, 1), a2 + hstep, voffA);
            PG8_WAIT_V(8); PG8_WAIT_L(0); PG8_BAR; PG8_MMA(0, 0, At, B0); PG8_MMA(0, 1, At, B1); PG8_BAR; PG8_SCHED;
            PG8_LDA(At, 1, 1); PG8_STAGE(PG8_SB(1, 0), b3, voffB); PG8_STAGE(PG8_SB(1, 1), b3 + hstep, voffB); PG8_STAGE(PG8_SA(1, 0), a3, voffA);
            PG8_WAIT_V(8); PG8_WAIT_L(0); PG8_BAR; PG8_MMA(1, 0, At, B0); PG8_MMA(1, 1, At, B1); PG8_BAR; PG8_SCHED;
        }
        if constexpr (ALIGN_EPI) { if (wr == 0) PG8_BAR; }
        if constexpr (!Epi::AFTER_DRAIN) E(acc, cur, wr, wc, fr, fq);
        if (!has_next) break;
#pragma unroll
        for (int a = 0; a < 2; ++a)
#pragma unroll
            for (int b = 0; b < 2; ++b)
#pragma unroll
                for (int m = 0; m < 4; ++m)
#pragma unroll
                    for (int n = 0; n < 2; ++n) acc[a][b][m][n] = (f32x4){0.f, 0.f, 0.f, 0.f};
        cur = nxt; cA = nA; cB = nB; ++ui;
        if constexpr (ALIGN_EPI) { if (wr == 1) PG8_BAR; }
    }
    PG8_WAIT_V(0);
    if constexpr (!ALIGN_EPI) { if (wr == 0) PG8_BAR; }
    PG8_BAR;
    if constexpr (Epi::AFTER_DRAIN) E.fused(acc, cur, wr, wc, fr, fq, lds, wid, lane);
#undef PG8_SA
#undef PG8_SB
#undef PG8_STAGE
#undef PG8_LDA
#undef PG8_LDB
#undef PG8_MMA
#undef PG8_WAIT_V
#undef PG8_WAIT_L
#undef PG8_BAR
#undef PG8_SCHED
}

__device__ __forceinline__ int bid_of_row(int row) { return row < MP ? (row >> 11) : (NBP + ((row - MP) >> 3)); }

struct EpiSwiGLU {
    static constexpr bool PERM = true, AFTER_DRAIN = false;
    bf16_t* H;
    __device__ __forceinline__ void operator()(const f32x4 (&acc)[2][2][4][2], const Unit& u, int wr, int wc, int fr, int fq) const {
        const int row0 = u.pm * BM + wr * 64 + fr, hc0 = u.pn * 128 + wc * 32 + 8 * fq;
#pragma unroll
        for (int ai = 0; ai < 2; ++ai)
#pragma unroll
            for (int m = 0; m < 4; ++m) { const f32x4 a0 = acc[ai][0][m][0], a1 = acc[ai][0][m][1], b0 = acc[ai][1][m][0], b1 = acc[ai][1][m][1];
                u32x4 w; w.x = cvt_pk_bf16(siluf_(a0[0]) * b0[0], siluf_(a0[1]) * b0[1]); w.y = cvt_pk_bf16(siluf_(a0[2]) * b0[2], siluf_(a0[3]) * b0[3]);
                w.z = cvt_pk_bf16(siluf_(a1[0]) * b1[0], siluf_(a1[1]) * b1[1]); w.w = cvt_pk_bf16(siluf_(a1[2]) * b1[2], siluf_(a1[3]) * b1[3]);
                const int row = row0 + ai * HALF + m * 16;
                if (u.pm < MP / BM) *(u32x4*)(H + (size_t)row * DFF + hc0) = w;
                else *(u32x4*)(H + (size_t)MP * DFF + fo_index(row - MP, hc0, DFF)) = w; }
    }
};
struct EpiResid {
    static constexpr bool PERM = false, AFTER_DRAIN = false;
    const float* xin_p; const float* xin_s; float* out; const float* gmod; float coef;
    __device__ __forceinline__ void operator()(const f32x4 (&acc)[2][2][4][2], const Unit& u, int wr, int wc, int fr, int fq) const {
        const int row0 = u.pm * BM + wr * 64 + fr, col0 = u.pn * BM + wc * 32 + 4 * fq;
#pragma unroll
        for (int ai = 0; ai < 2; ++ai)
#pragma unroll
            for (int m = 0; m < 4; ++m) { const int row = row0 + ai * HALF + m * 16;
                const float* xr = (row < MP ? xin_p + (size_t)row * DM : xin_s + (size_t)(row - MP) * DM) + col0;
                const float* gr = gmod + (size_t)bid_of_row(row) * NMOD + col0; float* orow = out + (size_t)row * DM + col0;
#pragma unroll
                for (int bj = 0; bj < 2; ++bj)
#pragma unroll
                    for (int n = 0; n < 2; ++n) { const int o = bj * HALF + n * 16; const f32x4 xv = *(const f32x4*)(xr + o), gv = *(const f32x4*)(gr + o);
                        *(f32x4*)(orow + o) = xv + coef * gv * acc[ai][bj][m][n]; } }
    }
};

__device__ __forceinline__ void panel_wait(unsigned* cnt, unsigned need) {
    unsigned spins = 0;
    while ((unsigned)__builtin_amdgcn_readfirstlane(__hip_atomic_load(cnt, __ATOMIC_RELAXED, __HIP_MEMORY_SCOPE_AGENT)) < need) { if (++spins > (1u << 20)) break; __builtin_amdgcn_s_sleep(2); }
    __builtin_amdgcn_fence(__ATOMIC_ACQUIRE, "agent");
}
template <bool FINAL>
struct EpiResidNorm {
    static constexpr bool PERM = true, AFTER_DRAIN = true;
    const float* xin; float* Xout; const float* gmod; const float* gw; const float* shmod; const float* scmod; bf16_t* Uout; float* Yout; float* XS; unsigned* cnt; float coef; int pad_;
    __device__ __forceinline__ void fused(f32x4 (&acc)[2][2][4][2], const Unit& u, int wr, int wc, int fr, int fq, LAS unsigned char* lds, int wid, int lane) const {
        LAS float* P = (LAS float*)lds; LAS float* S = (LAS float*)(lds + 4096);
        const float* const xin_ = xin; float* const Xout_ = Xout; const float* const gmod_ = gmod; const float coef_ = coef; const float* const gw_ = gw; const float* const shmod_ = shmod; const float* const scmod_ = scmod;
        bf16_t* const Uout_ = Uout; float* const Yout_ = Yout; float* const XS_ = XS; unsigned* const cnt_ = cnt;
        const int b = u.pm >> 3, col0 = u.pn * BM + wc * 32 + 8 * fq, rowt = wr * 64 + fr;
        { f32x4 gv[2][2];
#pragma unroll
          for (int bj = 0; bj < 2; ++bj)
#pragma unroll
              for (int n = 0; n < 2; ++n) gv[bj][n] = coef_ * *(const f32x4*)(gmod_ + (size_t)b * NMOD + col0 + bj * HALF + n * 4);
#pragma unroll
          for (int ai = 0; ai < 2; ++ai)
#pragma unroll
              for (int m = 0; m < 4; ++m) { const int rt = rowt + ai * HALF + m * 16; const float* xr = xin_ + (size_t)(u.pm * BM + rt) * DM + col0; float ss = 0.f;
#pragma unroll
                  for (int bj = 0; bj < 2; ++bj)
#pragma unroll
                      for (int n = 0; n < 2; ++n) { const f32x4 x = *(const f32x4*)(xr + bj * HALF + n * 4) + gv[bj][n] * acc[ai][bj][m][n]; acc[ai][bj][m][n] = x; ss += (x[0] * x[0] + x[1] * x[1]) + (x[2] * x[2] + x[3] * x[3]); }
                  ss += __shfl_xor(ss, 16); ss += __shfl_xor(ss, 32);
                  if (fq == 0) P[rt * 4 + wc] = ss;
                  asm volatile("" ::: "memory"); } }
        __syncthreads();
        const int r32 = wid * 32 + (lane & 31); float* slot = XS_ + (size_t)(u.pm * BM + r32) * 16;
        if (lane < 32) { const f32x4 pp = *(const LAS f32x4*)(P + r32 * 4); __hip_atomic_store(slot + u.pn, (pp[0] + pp[1]) + (pp[2] + pp[3]), __ATOMIC_RELAXED, __HIP_MEMORY_SCOPE_AGENT); }
        asm volatile("s_waitcnt vmcnt(0)" ::: "memory");
        if (lane == 0) __hip_atomic_fetch_add(cnt_ + 64 * u.pm, 1u, __ATOMIC_RELAXED, __HIP_MEMORY_SCOPE_AGENT);
        if (wid == 0) panel_wait(cnt_ + 64 * u.pm, 32u);
        asm volatile("s_waitcnt vmcnt(0) lgkmcnt(0)" ::: "memory");
        __syncthreads();
        if (lane < 32) { float tot = 0.f;
#pragma unroll
            for (int t = 0; t < 4; ++t) tot += __hip_atomic_load(slot + t, __ATOMIC_RELAXED, __HIP_MEMORY_SCOPE_AGENT);
            S[r32] = 1.0f / sqrtf(tot * (1.0f / DM) + EPS); }
        __syncthreads();
        f32x4 fac[2][2], shv[2][2];
#pragma unroll
        for (int bj = 0; bj < 2; ++bj)
#pragma unroll
            for (int n = 0; n < 2; ++n) { const int c = col0 + bj * HALF + n * 4; fac[bj][n] = *(const f32x4*)(gw_ + c);
                if constexpr (!FINAL) { fac[bj][n] = fac[bj][n] * (1.0f + *(const f32x4*)(scmod_ + (size_t)b * NMOD + c)); shv[bj][n] = *(const f32x4*)(shmod_ + (size_t)b * NMOD + c); } }
#pragma unroll
        for (int ai = 0; ai < 2; ++ai)
#pragma unroll
            for (int m = 0; m < 4; ++m) { const int rt = rowt + ai * HALF + m * 16; const size_t off = (size_t)(u.pm * BM + rt) * DM + col0; const float r = S[rt];
#pragma unroll
                for (int bj = 0; bj < 2; ++bj) { const f32x4 x0 = acc[ai][bj][m][0], x1 = acc[ai][bj][m][1]; const int o = bj * HALF;
                    if constexpr (FINAL) { *(f32x4*)(Yout_ + off + o) = x0 * r * fac[bj][0]; *(f32x4*)(Yout_ + off + o + 4) = x1 * r * fac[bj][1]; }
                    else { *(f32x4*)(Xout_ + off + o) = x0; *(f32x4*)(Xout_ + off + o + 4) = x1;
                        const u32x2 w0 = pack4(x0 * r * fac[bj][0] + shv[bj][0]), w1 = pack4(x1 * r * fac[bj][1] + shv[bj][1]);
                        *(u32x4*)(Uout_ + off + o) = (u32x4){w0.x, w0.y, w1.x, w1.y}; } } }
    }
};
struct EpiZin {
    static constexpr bool PERM = true, AFTER_DRAIN = false;
    bf16_t* Z; float* gates;
    __device__ __forceinline__ void operator()(const f32x4 (&acc)[2][2][4][2], const Unit& u, int wr, int wc, int fr, int fq) const {
        const int row0 = u.pm * BM + wr * 64 + fr;
        {
            const int col0 = u.pn * BM + wc * 32 + 8 * fq;
#pragma unroll
            for (int ai = 0; ai < 2; ++ai)
#pragma unroll
                for (int m = 0; m < 4; ++m) { bf16_t* rp = Z + (size_t)(row0 + ai * HALF + m * 16) * ZP + col0;
#pragma unroll
                    for (int bj = 0; bj < 2; ++bj) { const f32x4 v0 = acc[ai][bj][m][0], v1 = acc[ai][bj][m][1];
                        u32x4 w; w.x = cvt_pk_bf16(v0[0], v0[1]); w.y = cvt_pk_bf16(v0[2], v0[3]); w.z = cvt_pk_bf16(v1[0], v1[1]); w.w = cvt_pk_bf16(v1[2], v1[3]);
                        *(u32x4*)(rp + bj * HALF) = w; } }
        }
    }
};
struct EpiMerge {
    static constexpr bool PERM = true, AFTER_DRAIN = false;
    const bf16_t* Z; float* tmp; bf16_t* U;
    __device__ __forceinline__ void operator()(const f32x4 (&acc)[2][2][4][2], const Unit& u, int wr, int wc, int fr, int fq) const {
        const int row0 = u.pm * BM + wr * 64 + fr, col0 = u.pn * BM + wc * 32 + 8 * fq;
        const int zoff = u.w ? ZGB : ZGA;
#pragma unroll
        for (int ai = 0; ai < 2; ++ai)
#pragma unroll
            for (int m = 0; m < 4; ++m) { const int row = row0 + ai * HALF + m * 16;
#pragma unroll
                for (int bj = 0; bj < 2; ++bj) { const int c = col0 + bj * HALF;
                    const u32x4 gz = *(const u32x4*)(Z + (size_t)row * ZP + zoff + c);
                    f32x4 s0, s1; s0[0] = sigmoidf_(bflo(gz.x)); s0[1] = sigmoidf_(bfhi(gz.x)); s0[2] = sigmoidf_(bflo(gz.y)); s0[3] = sigmoidf_(bfhi(gz.y));
                    s1[0] = sigmoidf_(bflo(gz.z)); s1[1] = sigmoidf_(bfhi(gz.z)); s1[2] = sigmoidf_(bflo(gz.w)); s1[3] = sigmoidf_(bfhi(gz.w));
                    f32x4 v0 = s0 * acc[ai][bj][m][0], v1 = s1 * acc[ai][bj][m][1];
                    u32x4* up = (u32x4*)(U + (size_t)row * DM + c);
                    if (u.w != 0) { const u32x4 pv = *up; v0[0] += bflo(pv.x); v0[1] += bfhi(pv.x); v0[2] += bflo(pv.y); v0[3] += bfhi(pv.y); v1[0] += bflo(pv.z); v1[1] += bfhi(pv.z); v1[2] += bflo(pv.w); v1[3] += bfhi(pv.w); }
                    u32x4 w; w.x = cvt_pk_bf16(v0[0], v0[1]); w.y = cvt_pk_bf16(v0[2], v0[3]); w.z = cvt_pk_bf16(v1[0], v1[1]); w.w = cvt_pk_bf16(v1[2], v1[3]);
                    *up = w; } }
    }
};
}


struct Frame {
    LAS unsigned char* lds;
    int tid, lane, wave, G, bx;
    float* out; unsigned char* ws;
};
constexpr int PTAB_OFF = 147072;
__device__ __forceinline__ const float* pin_ld(const Frame& F, const int k) {
    const volatile LAS unsigned* T = (const volatile LAS unsigned*)(F.lds + PTAB_OFF);
    const unsigned lo = (unsigned)__builtin_amdgcn_readfirstlane((int)T[2 * k]), hi = (unsigned)__builtin_amdgcn_readfirstlane((int)T[2 * k + 1]);
    return (const float*)(((uint64_t)hi << 32) | (uint64_t)lo);
}
#define PIN(k) pin_ld(F, (k))

template <int KTOT, bool FOA, bool FOB>
__device__ __forceinline__ void small_gemm_partials(LAS unsigned char* lds, const bf16_t* A, const bf16_t* Bt, int wave, int lane) {
    const int fr = lane & 15, fq = lane >> 4; constexpr int NKS = KTOT / 256; const int T0 = wave * NKS;
    const bf16_t* ap = A + (size_t)fr * KTOT + 8 * fq; const bf16_t* bp = Bt + (size_t)fr * KTOT + 8 * fq;
    f32x4 acc[4][4];
#pragma unroll
    for (int i = 0; i < 4; ++i)
#pragma unroll
        for (int j = 0; j < 4; ++j) acc[i][j] = (f32x4){0.f, 0.f, 0.f, 0.f};
    bf16x8 a[4][4], b[4][4];
#define SG_LOAD(slot, t) do { const int T_ = T0 + (t), ko_ = 32 * T_; _Pragma("unroll") for (int i = 0; i < 4; ++i) { \
        if constexpr (FOA) a[slot][i] = *(const bf16x8*)(A + ((size_t)(i * (KTOT / 32) + T_)) * 512 + 8 * lane); else a[slot][i] = *(const bf16x8*)(ap + (size_t)(16 * i) * KTOT + ko_); \
        if constexpr (FOB) b[slot][i] = *(const bf16x8*)(Bt + ((size_t)(i * (KTOT / 32) + T_)) * 512 + 8 * lane); else b[slot][i] = *(const bf16x8*)(bp + (size_t)(16 * i) * KTOT + ko_); } } while (0)
#pragma unroll
    for (int t = 0; t < 4 && t < NKS; ++t) SG_LOAD(t, t);
    __builtin_amdgcn_sched_barrier(0);
#pragma unroll
    for (int t = 0; t < NKS; ++t) {
#pragma unroll
        for (int tn = 0; tn < 4; ++tn)
#pragma unroll
            for (int tm = 0; tm < 4; ++tm) acc[tn][tm] = __builtin_amdgcn_mfma_f32_16x16x32_bf16(b[t & 3][tn], a[t & 3][tm], acc[tn][tm], 0, 0, 0);
        __builtin_amdgcn_sched_barrier(0);
        if (t + 4 < NKS) { SG_LOAD(t & 3, t + 4); __builtin_amdgcn_sched_barrier(0); } }
#undef SG_LOAD
    LAS f32x4* PART = (LAS f32x4*)lds;
#pragma unroll
    for (int tn = 0; tn < 4; ++tn)
#pragma unroll
        for (int tm = 0; tm < 4; ++tm) PART[(wave * 16 + tn * 4 + tm) * 64 + lane] = acc[tn][tm];
}
__device__ __forceinline__ f32x4 small_gemm_sum(LAS unsigned char* lds, int tid, int j) {
    const LAS f32x4* PART = (const LAS f32x4*)lds; const int tile = 8 * j + (tid >> 6), ln = tid & 63; f32x4 sum = PART[tile * 64 + ln];
#pragma unroll
    for (int wv = 1; wv < 8; ++wv) sum += PART[(wv * 16 + tile) * 64 + ln];
    return sum;
}
template <int KTOT>
__device__ __forceinline__ void small_phase_resid(Frame& F, const bf16_t* A, const bf16_t* Bt, const float* xin_s, float* out, const float* gmod, float coef) {
    for (int st = F.bx; st < 256; st += F.G) { const int x = st & 7, j = st >> 3, sm = 4 * (x >> 1) + (j >> 3), sn = 8 * (x & 1) + (j & 7);
        __syncthreads();
        small_gemm_partials<KTOT, true, true>(F.lds, A + (size_t)(MP + 64 * sm) * KTOT, Bt + (size_t)(64 * sn) * KTOT, F.wave, F.lane);
        __syncthreads();
#pragma unroll
        for (int j = 0; j < 2; ++j) { const f32x4 v = small_gemm_sum(F.lds, F.tid, j); const int tile = 8 * j + (F.tid >> 6), tn = tile >> 2, tm = tile & 3;
            const int ms = 64 * sm + 16 * tm + (F.lane & 15), n = 64 * sn + 16 * tn + 4 * (F.lane >> 4), row = MP + ms;
            const f32x4 xv = *(const f32x4*)(xin_s + (size_t)ms * DM + n), gv = *(const f32x4*)(gmod + (size_t)pg8::bid_of_row(row) * NMOD + n);
            *(f32x4*)(out + (size_t)row * DM + n) = xv + coef * gv * v; } }
}
template <int KTOT, bool FINAL>
__device__ __forceinline__ void small_phase_resid_norm(Frame& F, const bf16_t* A, const bf16_t* Bt, const float* xin_s, float* Xout, const float* gmod, float coef,
                                                       const float* gw, const float* shmod, const float* scmod, bf16_t* Uout, float* Yout, float* XS, unsigned* cnt) {
    LAS float* P2 = (LAS float*)(F.lds + 131072); LAS float* S2 = (LAS float*)(F.lds + 131072 + 512);
    for (int st = F.bx; st < 256; st += F.G) { const int x = st & 7, j0 = st >> 3, sm = 4 * (x >> 1) + (j0 >> 3), sn = 8 * (x & 1) + (j0 & 7);
        __syncthreads();
        small_gemm_partials<KTOT, true, true>(F.lds, A + (size_t)(MP + 64 * sm) * KTOT, Bt + (size_t)(64 * sn) * KTOT, F.wave, F.lane);
        __syncthreads();
        const int fr = F.lane & 15, fq = F.lane >> 4, tm = F.wave & 3, rl = 16 * tm + fr, ms = 64 * sm + rl, row = MP + ms, bid = NBP + (ms >> 3);
        f32x4 xn[2]; float ss = 0.f;
#pragma unroll
        for (int j = 0; j < 2; ++j) { const int n = 64 * sn + 16 * (2 * j + (F.wave >> 2)) + 4 * fq;
            const f32x4 x4 = *(const f32x4*)(xin_s + (size_t)ms * DM + n) + coef * *(const f32x4*)(gmod + (size_t)bid * NMOD + n) * small_gemm_sum(F.lds, F.tid, j);
            xn[j] = x4; ss += (x4[0] * x4[0] + x4[1] * x4[1]) + (x4[2] * x4[2] + x4[3] * x4[3]); }
        ss += __shfl_xor(ss, 16); ss += __shfl_xor(ss, 32);
        if (fq == 0) P2[(F.wave >> 2) * 64 + rl] = ss;
        __syncthreads();
        float* slot = XS + (size_t)(MP + 64 * sm + F.lane) * 16;
        if (F.wave == 0) { __hip_atomic_store(slot + sn, P2[F.lane] + P2[64 + F.lane], __ATOMIC_RELAXED, __HIP_MEMORY_SCOPE_AGENT);
            asm volatile("s_waitcnt vmcnt(0)" ::: "memory");
            if (F.lane == 0) __hip_atomic_fetch_add(cnt + 64 * (64 + sm), 1u, __ATOMIC_RELAXED, __HIP_MEMORY_SCOPE_AGENT);
            pg8::panel_wait(cnt + 64 * (64 + sm), 16u);
            float tot = 0.f;
#pragma unroll
            for (int t = 0; t < 16; ++t) tot += __hip_atomic_load(slot + t, __ATOMIC_RELAXED, __HIP_MEMORY_SCOPE_AGENT);
            S2[F.lane] = 1.0f / sqrtf(tot * (1.0f / DM) + EPS); }
        __syncthreads();
        const float r = S2[rl];
#pragma unroll
        for (int j = 0; j < 2; ++j) { const int n = 64 * sn + 16 * (2 * j + (F.wave >> 2)) + 4 * fq; const f32x4 g4 = *(const f32x4*)(gw + n);
            if constexpr (FINAL) *(f32x4*)(Yout + (size_t)row * DM + n) = xn[j] * r * g4;
            else { *(f32x4*)(Xout + (size_t)row * DM + n) = xn[j];
                *(u32x2*)(Uout + (size_t)row * DM + n) = pack4(xn[j] * r * g4 * (1.0f + *(const f32x4*)(scmod + (size_t)bid * NMOD + n)) + *(const f32x4*)(shmod + (size_t)bid * NMOD + n)); } } }
}
__device__ __forceinline__ void small_gates_tile(Frame& F, const bf16_t* U, const bf16_t* Wg, float* gates, const int st) {
    {
        __syncthreads();
        small_gemm_partials<DM, false, true>(F.lds, U + (size_t)(64 * st) * DM, Wg, F.wave, F.lane);
        __syncthreads();
#pragma unroll
        for (int j = 0; j < 2; ++j) { const f32x4 v = small_gemm_sum(F.lds, F.tid, j); const int tile = 8 * j + (F.tid >> 6), tn = tile >> 2, tm = tile & 3;
            *(f32x4*)(gates + (size_t)(64 * st + 16 * tm + (F.lane & 15)) * 64 + 16 * tn + 4 * (F.lane >> 4)) = v; } }
}
__device__ __forceinline__ void small_phase_merge(Frame& F, const bf16_t* HA, const bf16_t* HB, const bf16_t* WA, const bf16_t* WB, const bf16_t* Z, bf16_t* U) {
    for (int st = F.bx; st < 256; st += F.G) { const int x = st & 7, j = st >> 3, sm = 4 * (x >> 1) + (j >> 3), sn = 8 * (x & 1) + (j & 7); f32x4 va[2], vb[2];
        __syncthreads();
        small_gemm_partials<2048, true, true>(F.lds, HA + (size_t)(MP + 64 * sm) * 2048, WA + (size_t)(64 * sn) * 2048, F.wave, F.lane);
        __syncthreads();
        va[0] = small_gemm_sum(F.lds, F.tid, 0); va[1] = small_gemm_sum(F.lds, F.tid, 1);
        __syncthreads();
        small_gemm_partials<2048, true, true>(F.lds, HB + (size_t)(MP + 64 * sm) * 2048, WB + (size_t)(64 * sn) * 2048, F.wave, F.lane);
        __syncthreads();
        vb[0] = small_gemm_sum(F.lds, F.tid, 0); vb[1] = small_gemm_sum(F.lds, F.tid, 1);
#pragma unroll
        for (int j = 0; j < 2; ++j) { const int tile = 8 * j + (F.tid >> 6), tn = tile >> 2, tm = tile & 3;
            const int row = MP + 64 * sm + 16 * tm + (F.lane & 15), n = 64 * sn + 16 * tn + 4 * (F.lane >> 4);
            const u32x2 ga = *(const u32x2*)(Z + (size_t)row * ZP + ZGA + n), gb = *(const u32x2*)(Z + (size_t)row * ZP + ZGB + n);
            f32x4 o; o[0] = sigmoidf_(bflo(ga.x)) * va[j][0] + sigmoidf_(bflo(gb.x)) * vb[j][0]; o[1] = sigmoidf_(bfhi(ga.x)) * va[j][1] + sigmoidf_(bfhi(gb.x)) * vb[j][1];
            o[2] = sigmoidf_(bflo(ga.y)) * va[j][2] + sigmoidf_(bflo(gb.y)) * vb[j][2]; o[3] = sigmoidf_(bfhi(ga.y)) * va[j][3] + sigmoidf_(bfhi(gb.y)) * vb[j][3];
            *(u32x2*)(U + (size_t)MP * DM + fo_index(row - MP, n, DM)) = pack4(o); } }
}

#define GAS __attribute__((address_space(1)))
#define XB_TMO      128
#define XB_XCNT(j)  (256  + 64 * (j))
#define XB_XSUB(j)  (1280 + 64 * (j))
#define XB_XGEN(j)  (2304 + 64 * (j))
#define XB_TOP      3328
#define XB_TOPGEN   3392
#define XCD_BAR_WORDS 3456
#define XB_SPIN_CAP (1u << 22)
__device__ __forceinline__ unsigned xb_ld(unsigned* p)              { return __hip_atomic_load(p, __ATOMIC_RELAXED, __HIP_MEMORY_SCOPE_AGENT); }
__device__ __forceinline__ unsigned xb_add(unsigned* p, unsigned v) { return __hip_atomic_fetch_add(p, v, __ATOMIC_RELAXED, __HIP_MEMORY_SCOPE_AGENT); }
__device__ __forceinline__ unsigned xb_xcc_id() { return (unsigned)__builtin_amdgcn_s_getreg((3 << 11) | 20) & 0xFu; }
#define XB_SPIN(cond, bar) do { unsigned _sp = 0; while (cond) { __builtin_amdgcn_s_sleep(1); \
    if ((++_sp & 255u) == 0u) { if (xb_ld(&(bar)[XB_TMO])) break; if (_sp > XB_SPIN_CAP) { atomicAdd(&(bar)[XB_TMO], 1u); break; } } } } while (0)
struct XcdBarrier { unsigned* bar; unsigned x; volatile LAS unsigned* st; };
__device__ __forceinline__ XcdBarrier xcd_barrier_post(unsigned* bar, volatile LAS unsigned* st) {
    XcdBarrier b; b.bar = bar; b.x = xb_xcc_id(); b.st = st;
    if (threadIdx.x == 0) (void)xb_add(&bar[XB_XCNT(b.x)], 1u);
    return b;
}
__device__ __forceinline__ void xcd_barrier_complete(unsigned* bar, unsigned x, unsigned& nloc, unsigned& nx) {
    const unsigned G = gridDim.x * gridDim.y * gridDim.z;
    unsigned sum, cnt, mine, sp = 0u;
    for (;;) {
        sum = 0u; cnt = 0u; mine = 0u;
#pragma unroll
        for (unsigned j = 0; j < 16; ++j) { const unsigned c = xb_ld(&bar[XB_XCNT(j)]); sum += c; cnt += (c > 0u) ? 1u : 0u; mine = (j == x) ? c : mine; }
        if (sum == G) break;
        __builtin_amdgcn_s_sleep(1);
        if ((++sp & 255u) == 0u) { if (xb_ld(&bar[XB_TMO])) break; if (sp > XB_SPIN_CAP) { atomicAdd(&bar[XB_TMO], 1u); break; } }
    }
    nloc = mine > 0u ? mine : 1u; nx = cnt > 0u ? cnt : 1u;
}
__device__ __forceinline__ void xcd_barrier(const XcdBarrier& b) {
    asm volatile("s_waitcnt vmcnt(0)" ::: "memory");
    __syncthreads();
    if (threadIdx.x == 0) {
        unsigned* bar = b.bar;
        __builtin_amdgcn_s_waitcnt(0);
        unsigned nloc = b.st[0], nx = b.st[1];
        if (nloc == 0u) { xcd_barrier_complete(bar, b.x, nloc, nx); b.st[0] = nloc; b.st[1] = nx; }
        const unsigned old = xb_add(&bar[XB_XSUB(b.x)], 1u);
        const unsigned gen = old / nloc;
        if (old + 1u == (gen + 1u) * nloc) {
            __builtin_amdgcn_fence(__ATOMIC_RELEASE, "agent");
            asm volatile("s_waitcnt vmcnt(0)" ::: "memory");
            const unsigned og = xb_add(&bar[XB_TOP], 1u);
            const unsigned tg = og / nx;
            if (og + 1u == (tg + 1u) * nx) xb_add(&bar[XB_TOPGEN], 1u);
            else XB_SPIN(xb_ld(&bar[XB_TOPGEN]) == tg, bar);
            __builtin_amdgcn_fence(__ATOMIC_ACQUIRE, "agent");
            xb_add(&bar[XB_XGEN(b.x)], 1u);
            asm volatile("s_waitcnt vmcnt(0)" ::: "memory");
        } else {
            XB_SPIN(xb_ld(&bar[XB_XGEN(b.x)]) == gen, bar);
            __builtin_amdgcn_fence(__ATOMIC_ACQUIRE, "agent");
            asm volatile("s_waitcnt vmcnt(0)" ::: "memory");
        }
    }
    __syncthreads();
}


template <class SrcFn>
__device__ __forceinline__ void transpose_item(const SrcFn& src, int K, bf16_t* WT, LAS float* scr, int item, int lane, int nblk, bf16_t* WF = nullptr, int fo_row0 = 0) {
    const int kb = item / nblk, nb = item % nblk, k0 = 64 * kb, n0 = 32 * nb;
    const size_t stride = (size_t)src.stride(); const float* colp = src(n0 + (lane & 31));
    float tv[32];
#pragma unroll
    for (int i = 0; i < 32; ++i) { const int kk = 2 * i + (lane >> 5); tv[i] = colp ? colp[(size_t)(k0 + kk) * stride] : 0.f; }
#pragma unroll
    for (int i = 0; i < 32; ++i) { const int kk = 2 * i + (lane >> 5); scr[kk * 33 + (lane & 31)] = tv[i]; }
    asm volatile("s_waitcnt lgkmcnt(0)" ::: "memory");
    const int c = lane & 7;
#pragma unroll
    for (int j = 0; j < 4; ++j) { const int n = (lane >> 3) + 8 * j; const LAS float* s = scr + (8 * c) * 33 + n;
        u32x4 o; o.x = cvt_pk_bf16(s[0 * 33], s[1 * 33]); o.y = cvt_pk_bf16(s[2 * 33], s[3 * 33]); o.z = cvt_pk_bf16(s[4 * 33], s[5 * 33]); o.w = cvt_pk_bf16(s[6 * 33], s[7 * 33]);
        *(u32x4*)(WT + (size_t)(n0 + n) * K + k0 + 8 * c) = o;
        if (WF != nullptr && n0 >= fo_row0) *(u32x4*)(WF + fo_index(n0 + n - fo_row0, k0 + 8 * c, K)) = o; }
    asm volatile("s_waitcnt lgkmcnt(0)" ::: "memory");
}
struct SrcPlain { const float* W; int N; __device__ __forceinline__ int stride() const { return N; } __device__ __forceinline__ const float* operator()(int n) const { return W + n; } };
struct SrcUp { const float* W1; const float* W3; __device__ __forceinline__ int stride() const { return DFF; } __device__ __forceinline__ const float* operator()(int n) const { const int T = n >> 8, i = n & 255; const uintptr_t a = (uintptr_t)W1, b = (uintptr_t)W3, msk = (uintptr_t)0 - (uintptr_t)(i >> 7);
        return (const float*)((a & ~msk) | (b & msk)) + 128 * T + (i & 127); } };
struct SrcWin { const float* W; __device__ __forceinline__ int stride() const { return 13352; } __device__ __forceinline__ const float* operator()(int r) const { int o;
        if (r < 6144) o = r; else if (r < 8192) o = 6152 + (r - 6144); else if (r < 11264) o = 8200 + (r - 8192); else if (r < 13312) o = 11304 + (r - 11264);
        else if (r < 13320) o = 6144 + (r - 13312); else if (r < 13352) o = 11272 + (r - 13320); else return nullptr;
        return W + o; } };

template <int PPART>
__device__ __forceinline__ void phase_prep(Frame& F, const Params& p) {
    LAS float* scr = (LAS float*)(F.lds + F.wave * 16384);
    const int gw = (PPART == 0 ? F.bx : F.bx - 192) * 8 + F.wave, NGW = (PPART == 0 ? F.G : 64) * 8;
    bf16_t* wup1 = (bf16_t*)(F.ws + WS_WUP1); bf16_t* wdn1 = (bf16_t*)(F.ws + WS_WDN1); bf16_t* wup2 = (bf16_t*)(F.ws + WS_WUP2); bf16_t* wdn2 = (bf16_t*)(F.ws + WS_WDN2);
    bf16_t* win = (bf16_t*)(F.ws + WS_WIN); bf16_t* wpa = (bf16_t*)(F.ws + WS_WPA); bf16_t* wpb = (bf16_t*)(F.ws + WS_WPB); bf16_t* wout = (bf16_t*)(F.ws + WS_WOUT);
    constexpr int I_UP = (DM / 64) * (2 * DFF / 32), I_DN = (DFF / 64) * (DM / 32), I_IN = (DM / 64) * (ZP / 32), I_P = (2048 / 64) * (DM / 32), I_O = (DM / 64) * (DM / 32);
    constexpr int NITEMS = 2 * I_UP + 2 * I_DN + I_IN + 2 * I_P + I_O;
    for (int it = (PPART == 0 ? 0 : I_UP) + gw; it < (PPART == 0 ? I_UP : NITEMS); it += NGW) {
        int r = it;
        if (r < I_UP) { transpose_item(SrcUp{PIN(13), PIN(14)}, DM, wup1, scr, r, F.lane, 2 * DFF / 32); continue; } r -= I_UP;
        if (r < I_UP) { transpose_item(SrcUp{PIN(32), PIN(33)}, DM, wup2, scr, r, F.lane, 2 * DFF / 32); continue; } r -= I_UP;
        if (r < I_DN) { transpose_item(SrcPlain{PIN(15), DM}, DFF, wdn1, scr, r, F.lane, DM / 32, (bf16_t*)(F.ws + WS_FDN1)); continue; } r -= I_DN;
        if (r < I_DN) { transpose_item(SrcPlain{PIN(34), DM}, DFF, wdn2, scr, r, F.lane, DM / 32, (bf16_t*)(F.ws + WS_FDN2)); continue; } r -= I_DN;
        if (r < I_IN) { transpose_item(SrcWin{PIN(17)}, DM, win, scr, r, F.lane, ZP / 32, (bf16_t*)(F.ws + WS_FG), ZG); continue; } r -= I_IN;
        if (r < I_P) { transpose_item(SrcPlain{PIN(22), DM}, 2048, wpa, scr, r, F.lane, DM / 32, (bf16_t*)(F.ws + WS_FPA)); continue; } r -= I_P;
        if (r < I_P) { transpose_item(SrcPlain{PIN(29), DM}, 2048, wpb, scr, r, F.lane, DM / 32, (bf16_t*)(F.ws + WS_FPB)); continue; } r -= I_P;
        transpose_item(SrcPlain{PIN(30), DM}, DM, wout, scr, r, F.lane, DM / 32, (bf16_t*)(F.ws + WS_FOUT));
    }
    __syncthreads();
}
__device__ __forceinline__ void phase_silu_c(Frame& F, const Params& p) {
    const int ch = F.bx * NTHREADS + F.tid;
    if (ch < 144 * 128) { const int r = ch >> 7, k = 8 * (ch & 127); float x[8];
        if (r < NBID) { const float* cr = (r < NBP ? PIN(2) + (size_t)r * DM : PIN(3) + (size_t)(r - NBP) * DM) + k; const f32x4 c0 = *(const f32x4*)cr, c1 = *(const f32x4*)(cr + 4);
#pragma unroll
            for (int e = 0; e < 4; ++e) { x[e] = siluf_(c0[e]); x[4 + e] = siluf_(c1[e]); } }
        else {
#pragma unroll
            for (int e = 0; e < 8; ++e) x[e] = 0.f; }
        *(u32x4*)((bf16_t*)(F.ws + WS_SC) + fo_index(r, k, DM)) = pack8(x, 1.0f); }
}
__device__ __forceinline__ void phase_adaln(Frame& F, const Params& p) {
    const float* ada_w = PIN(10); const float* ada_b = PIN(11); float* mod = (float*)(F.ws + WS_MOD); const bf16_t* SCF = (const bf16_t*)(F.ws + WS_SC);
    LAS f32x4* PART = (LAS f32x4*)F.lds;
    const int lane = F.lane, w = F.wave, fr = lane & 15, fq = lane >> 4;
    const int t0 = F.bx < 64 ? 3 * F.bx : 192 + 2 * (F.bx - 64), nT = F.bx < 64 ? 3 : 2;
    f32x4 acc[3][9];
#pragma unroll
    for (int t = 0; t < 3; ++t)
#pragma unroll
        for (int rt = 0; rt < 9; ++rt) acc[t][rt] = (f32x4){0.f, 0.f, 0.f, 0.f};
#pragma unroll 1
    for (int ks = 0; ks < 4; ++ks) {
        const int k0 = 128 * w + 32 * ks + 8 * fq, kb = 4 * w + ks;
        bf16x8 af[9];
#pragma unroll
        for (int rt = 0; rt < 9; ++rt) af[rt] = *(const bf16x8*)(SCF + ((size_t)(rt * (DM / 32) + kb)) * 512 + 8 * lane);
#pragma unroll
        for (int t = 0; t < 3; ++t) if (t < nT) {
            float wv[8];
#pragma unroll
            for (int j = 0; j < 8; ++j) wv[j] = ada_w[(size_t)(k0 + j) * NMOD + 16 * (t0 + t) + fr];
            bf16x8 bfr; { const u32x4 tt = pack8(wv, 1.0f); bfr = __builtin_bit_cast(bf16x8, tt); }
#pragma unroll
            for (int rt = 0; rt < 9; ++rt) acc[t][rt] = __builtin_amdgcn_mfma_f32_16x16x32_bf16(af[rt], bfr, acc[t][rt], 0, 0, 0); }
    }
#pragma unroll
    for (int t = 0; t < 3; ++t) if (t < nT) {
        __syncthreads();
#pragma unroll
        for (int rt = 0; rt < 9; ++rt) PART[(w * 9 + rt) * 64 + lane] = acc[t][rt];
        __syncthreads();
        for (int idx = F.tid; idx < 9 * 64; idx += NTHREADS) { const int rt = idx >> 6, ln = idx & 63; f32x4 sum = PART[rt * 64 + ln];
#pragma unroll
            for (int ww = 1; ww < 8; ++ww) sum += PART[(ww * 9 + rt) * 64 + ln];
            const int n = 16 * (t0 + t) + (ln & 15); const float bv = ada_b[n];
#pragma unroll
            for (int r = 0; r < 4; ++r) { const int row = 16 * rt + 4 * (ln >> 4) + r; if (row < NBID) mod[(size_t)row * NMOD + n] = sum[r] + bv; } } }
}

__device__ __forceinline__ void phase_norm_mod(Frame& F, const float* xp, const float* xs, const float* gw, int shoff, int scoff, bf16_t* U) {
    const float* mod = (const float*)(F.ws + WS_MOD);
    const int gwv = F.bx * 8 + F.wave, NGW = F.G * 8;
    f32x4 g[4];
#pragma unroll
    for (int j = 0; j < 4; ++j) g[j] = *(const f32x4*)(gw + 4 * F.lane + 256 * j);
    for (int m = gwv; m < MT; m += NGW) {
        const float* xr = m < MP ? xp + (size_t)m * DM : xs + (size_t)(m - MP) * DM;
        const float* mr = mod + (size_t)pg8::bid_of_row(m) * NMOD;
        f32x4 v[4]; float s = 0.f;
#pragma unroll
        for (int j = 0; j < 4; ++j) { v[j] = *(const f32x4*)(xr + 4 * F.lane + 256 * j); s += (v[j][0] * v[j][0] + v[j][1] * v[j][1]) + (v[j][2] * v[j][2] + v[j][3] * v[j][3]); }
        const float r = 1.0f / sqrtf(wave_sum(s) * (1.0f / DM) + EPS);
#pragma unroll
        for (int j = 0; j < 4; ++j) { const f32x4 sh = *(const f32x4*)(mr + shoff + 4 * F.lane + 256 * j), scv = *(const f32x4*)(mr + scoff + 4 * F.lane + 256 * j);
            const f32x4 o = (v[j] * r * g[j]) * (1.0f + scv) + sh;
            u32x2 w; w.x = cvt_pk_bf16(o[0], o[1]); w.y = cvt_pk_bf16(o[2], o[3]);
            *(u32x2*)(U + (size_t)m * DM + 4 * F.lane + 256 * j) = w; }
    }
}
__device__ __forceinline__ void phase_final_norm(Frame& F, float* Y, const float* gw) {
    const int gwv = F.bx * 8 + F.wave, NGW = F.G * 8;
    f32x4 g[4];
#pragma unroll
    for (int j = 0; j < 4; ++j) g[j] = *(const f32x4*)(gw + 4 * F.lane + 256 * j);
    for (int m = gwv; m < MT; m += NGW) {
        float* xr = Y + (size_t)m * DM;
        f32x4 v[4]; float s = 0.f;
#pragma unroll
        for (int j = 0; j < 4; ++j) { v[j] = *(const f32x4*)(xr + 4 * F.lane + 256 * j); s += (v[j][0] * v[j][0] + v[j][1] * v[j][1]) + (v[j][2] * v[j][2] + v[j][3] * v[j][3]); }
        const float r = 1.0f / sqrtf(wave_sum(s) * (1.0f / DM) + EPS);
#pragma unroll
        for (int j = 0; j < 4; ++j) *(f32x4*)(xr + 4 * F.lane + 256 * j) = v[j] * r * g[j];
    }
}

constexpr size_t O_Y = 0, O_PC = 17825792, O_PN = 22020096, O_PM = 22028288, O_PMC = 22028320, O_PSSM = 22077472, O_PSC = 24174624,
                 O_SC = 24248352, O_SN = 91357216, O_SM = 91488288, O_SMC = 91488800, O_SSSM = 92275232, O_SSC = 125829664, O_END = 127009312;
constexpr int CVP = 5120;

__device__ __forceinline__ bf16x8 frag_row(LAS unsigned char* base, int stride, int row0, int k0, int lane) {
    return *(const LAS bf16x8*)(base + (row0 + (lane & 15)) * stride + (k0 + 8 * (lane >> 4)) * 2);
}
__device__ __forceinline__ bf16x8 frag_tr(LAS unsigned char* base, int stride, int krow0, int col0, int lane) {
    const int g = lane >> 4, q = (lane & 15) >> 2, pp = lane & 3;
    LAS unsigned char* a = base + (krow0 + 8 * g + q) * stride + (col0 + 4 * pp) * 2;
    const s16x4 lo = __builtin_amdgcn_ds_read_tr16_b64_v4i16((LAS s16x4*)a);
    const s16x4 hi = __builtin_amdgcn_ds_read_tr16_b64_v4i16((LAS s16x4*)(a + 4 * stride));
    return (bf16x8){lo.x, lo.y, lo.z, lo.w, hi.x, hi.y, hi.z, hi.w};
}
#define MFMA16(a, b, c) __builtin_amdgcn_mfma_f32_16x16x32_bf16((a), (b), (c), 0, 0, 0)

__device__ __forceinline__ float fast_log1pexp_neg(float ax) { return __builtin_amdgcn_logf(1.0f + fast_exp(-ax)) * 0.6931471805599453f; }
__device__ __forceinline__ float logsigmoidf_(float x) { return fminf(x, 0.f) - log1pf(expf(-fabsf(x))); }
__device__ __forceinline__ float softplusf_(float x) { return fmaxf(x, 0.f) + log1pf(expf(-fabsf(x))); }

__device__ __forceinline__ void conv_item(Frame& F, const Params& p, const int it) {
    const bf16_t* Z = (const bf16_t*)(F.ws + WS_ZIN); bf16_t* CV = (bf16_t*)(F.ws + WS_CV);
    const int lane = F.lane;
    {
        int m0, tb, nrows, strip; const float* hist = nullptr;
        if (it < 5120) { const int b = it / 640, r = it % 640; strip = r % 10; tb = (r / 10) * 32; m0 = b * SEQ; nrows = 32; }
        else { const int j = it - 5120, bs = j / 10; strip = j % 10; tb = 0; m0 = MP + bs * TS; nrows = 8; hist = strip < 4 ? PIN(7) + (size_t)bs * 3 * 2048 : PIN(9) + (size_t)bs * 3 * 3072; }
        const bool isM = strip < 4;
        const int c = strip * 512 + 8 * lane, zc = isM ? c : ZX + (c - 2048), cc = isM ? c : c - 2048, cs = isM ? 2048 : 3072;
        const float* cw = isM ? PIN(18) : PIN(23); const float* cb = isM ? PIN(19) : PIN(24);
        const float scl = (strip == 2 || strip == 3) ? 0.0625f : 1.0f;
        float w[4][8], bb[8], x0[8], x1[8], x2[8];
#pragma unroll
        for (int j = 0; j < 4; ++j) { const f32x4 a = *(const f32x4*)(cw + (size_t)j * cs + cc), b = *(const f32x4*)(cw + (size_t)j * cs + cc + 4);
#pragma unroll
            for (int e = 0; e < 4; ++e) { w[j][e] = a[e]; w[j][4 + e] = b[e]; } }
        { const f32x4 a = *(const f32x4*)(cb + cc), b = *(const f32x4*)(cb + cc + 4);
#pragma unroll
            for (int e = 0; e < 4; ++e) { bb[e] = a[e]; bb[4 + e] = b[e]; } }
        if (tb > 0) { unpack8(*(const u32x4*)(Z + (size_t)(m0 + tb - 3) * ZP + zc), x0); unpack8(*(const u32x4*)(Z + (size_t)(m0 + tb - 2) * ZP + zc), x1); unpack8(*(const u32x4*)(Z + (size_t)(m0 + tb - 1) * ZP + zc), x2); }
        else if (hist != nullptr) {
#pragma unroll
            for (int e = 0; e < 8; ++e) { x0[e] = hist[cc + e]; x1[e] = hist[cs + cc + e]; x2[e] = hist[2 * cs + cc + e]; } }
        else {
#pragma unroll
            for (int e = 0; e < 8; ++e) { x0[e] = 0.f; x1[e] = 0.f; x2[e] = 0.f; } }
        for (int t = 0; t < nrows; t += 8) {
            u32x4 raw[8];
#pragma unroll
            for (int i = 0; i < 8; ++i) raw[i] = *(const u32x4*)(Z + (size_t)(m0 + tb + t + i) * ZP + zc);
#pragma unroll
            for (int i = 0; i < 8; ++i) { float x3[8], o[8]; unpack8(raw[i], x3);
#pragma unroll
                for (int e = 0; e < 8; ++e) { o[e] = siluf_(bb[e] + w[0][e] * x0[e] + w[1][e] * x1[e] + w[2][e] * x2[e] + w[3][e] * x3[e]); x0[e] = x1[e]; x1[e] = x2[e]; x2[e] = x3[e]; }
                *(u32x4*)(CV + (size_t)(m0 + tb + t + i) * CVP + c) = pack8(o, scl); }
        }
    }
}
constexpr int NS_EARLY = 64;
__device__ __forceinline__ void phase_conv(Frame& F, const Params& p) {
    const int gw = F.bx * 8 + F.wave, NGW = F.G * 8;
    for (int it = gw; it < 5120 + 1280 - 10 * NS_EARLY; it += NGW) conv_item(F, p, it < 5120 ? it : it + 10 * NS_EARLY);
}

constexpr int QSTR = 528, VSTR = 144;
constexpr int L_QS = 0, L_KS = 33792, L_CT = 67584, L_VS = 101376, L_VW = 110592, L_SB = 119808, L_SCAL = 129024, L_NST = 132096, L_QNP = 133120, L_DENP = 135168, L_NUMB = 135680;

__device__ __forceinline__ float mlstm_scan(float ipre, float fpre, int lane, float mstate, LAS float* sc) {
    const float lf = fminf(fpre, 0.f) - fast_log1pexp_neg(fabsf(fpre));
    const float b = wave_scan_add(lf);
    const float a = ipre - b;
    const float cm = wave_scan_max(a);
    const float A = fmaxf(mstate, cm);
    const float Alast = __shfl(A, 63), blast = __shfl(b, 63);
    sc[lane] = a; sc[64 + lane] = A; sc[128 + lane] = fast_exp(mstate - A); sc[192 + lane] = fast_exp(-(b + A)); sc[256 + lane] = fast_exp(a - Alast);
    if (lane == 0) sc[320] = fast_exp(mstate - Alast);
    return blast + Alast;
}

__device__ __forceinline__ void mlstm_prompt_item(Frame& F, const Params& p, const int b, const int h, const int vs) {
    LAS unsigned char* L = F.lds;
    const int tid = F.tid, lane = F.lane, w = F.wave, fr = lane & 15, fq = lane >> 4;
    const bf16_t* Z = (const bf16_t*)(F.ws + WS_ZIN); const bf16_t* CV = (const bf16_t*)(F.ws + WS_CV); const float* GT = (const float*)(F.ws + WS_GATES);
    bf16_t* NUM = (bf16_t*)(F.ws + WS_NUM); float* DEN = (float*)(F.ws + WS_DEN);
    const float ifbi = PIN(20)[h], ifbf = PIN(20)[4 + h];
    constexpr int nch = SEQ / 64; const int m0 = b * SEQ;
    LAS float* SC = (LAS float*)(L + L_SCAL); LAS unsigned char* NSTB = L + L_NST; LAS float* DENP = (LAS float*)(L + L_DENP);
    f32x4 cacc[2][4];
#pragma unroll
    for (int dt = 0; dt < 2; ++dt)
#pragma unroll
        for (int vi = 0; vi < 4; ++vi) cacc[dt][vi] = (f32x4){0.f, 0.f, 0.f, 0.f};
    f32x4 nacc[2] = {{0.f, 0.f, 0.f, 0.f}, {0.f, 0.f, 0.f, 0.f}};
    float mstate = 0.f;
    u32x4 pq[4], pk[4], pv; float gi = 0.f, gf = 0.f;
    const bf16_t* qsrc = CV + (size_t)(m0 + (tid >> 5)) * CVP + h * 256 + 8 * (tid & 31);
    const bf16_t* vsrc = Z + (size_t)(m0 + (tid >> 3)) * ZP + ZV + h * 512 + vs * 64 + 8 * (tid & 7);
    const float* gsrc = GT + (size_t)(m0 + lane) * 64 + h;
#define ML_LOAD(c) do { _Pragma("unroll") for (int i = 0; i < 4; ++i) { pq[i] = *(const u32x4*)(qsrc + (size_t)((c) * 64 + 16 * i) * CVP); pk[i] = *(const u32x4*)(qsrc + (size_t)((c) * 64 + 16 * i) * CVP + 1024); } \
        pv = *(const u32x4*)(vsrc + (size_t)((c) * 64) * ZP); if (w == 0) { gi = gsrc[(size_t)((c) * 64) * 64]; gf = gsrc[(size_t)((c) * 64) * 64 + 4]; } } while (0)
    u32x4 numst = {0u, 0u, 0u, 0u}; float denst = 0.f;
    bf16_t* numdst = NUM + (size_t)(m0 + (tid >> 3)) * 2048 + h * 512 + vs * 64 + 8 * (tid & 7);
#define ML_STORE(c) do { *(u32x4*)(numdst + (size_t)((c) * 64) * 2048) = numst; \
        if (vs == 0 && w < 4 && fq == 0) DEN[(size_t)(m0 + (c) * 64 + 16 * w + fr) * 4 + h] = denst; } while (0)
    ML_LOAD(0);
    __syncthreads();
#pragma unroll
    for (int dt = 0; dt < 2; ++dt)
#pragma unroll
        for (int vi = 0; vi < 4; ++vi) *(LAS u32x2*)(L + L_CT + (16 * vi + fr) * QSTR + (32 * w + 16 * dt + 4 * fq) * 2) = (u32x2){0u, 0u};
    if (tid < 128) *(LAS unsigned*)(NSTB + 4 * tid) = 0u;
    if (w == 0) mstate = mlstm_scan(gi + ifbi, gf + ifbf, lane, mstate, SC);
    __syncthreads();
    for (int c = 0; c < nch; ++c) {
        const int t0 = 64 * c; LAS float* sc = SC + (c & 1) * 384;
#pragma unroll
        for (int i = 0; i < 4; ++i) { const int v = tid + NTHREADS * i, row = v >> 5, c16 = v & 31; *(LAS u32x4*)(L + L_QS + row * QSTR + 16 * c16) = pq[i]; *(LAS u32x4*)(L + L_KS + row * QSTR + 16 * c16) = pk[i]; }
        { const int row = tid >> 3, c8 = tid & 7; *(LAS u32x4*)(L + L_VS + row * VSTR + 16 * c8) = pv; float x[8]; unpack8(pv, x); *(LAS u32x4*)(L + L_VW + row * VSTR + 16 * c8) = pack8(x, sc[256 + row]); }
        __syncthreads();
        if (c > 0) { ML_STORE(c - 1); }
        if (c + 1 < nch) ML_LOAD(c + 1);
        const int ti = w & 3, hf = w >> 2;
        bf16x8 qf[8];
#pragma unroll
        for (int k = 0; k < 8; ++k) qf[k] = frag_row(L + L_QS, QSTR, 16 * ti, 32 * k, lane);
        { f32x4 sacc[2] = {{0.f, 0.f, 0.f, 0.f}, {0.f, 0.f, 0.f, 0.f}};
#pragma unroll
          for (int j = 0; j < 2; ++j) { const int si = 2 * hf + j; if (si <= ti) {
#pragma unroll
                  for (int k = 0; k < 8; ++k) sacc[j] = MFMA16(frag_row(L + L_KS, QSTR, 16 * si, 32 * k, lane), qf[k], sacc[j]); } }
          const int t = 16 * ti + fr; const float At = sc[64 + t]; float dpart = 0.f;
#pragma unroll
          for (int j = 0; j < 2; ++j) { const int si = 2 * hf + j, s0 = 16 * si + 4 * fq; const f32x4 av = *(const LAS f32x4*)(sc + s0); f32x4 vv;
#pragma unroll
              for (int r = 0; r < 4; ++r) { const float wgt = (s0 + r <= t) ? fast_exp(av[r] - At) : 0.f; vv[r] = (si <= ti) ? sacc[j][r] * wgt : 0.f; dpart += vv[r]; }
              *(LAS u32x2*)(L + L_SB + t * VSTR + s0 * 2) = pack4(vv); }
          dpart += __shfl_xor(dpart, 16); dpart += __shfl_xor(dpart, 32);
          if (lane < 16) DENP[hf * 64 + 16 * ti + lane] = dpart; }
        __syncthreads();
        { f32x4 uacc[2] = {{0.f, 0.f, 0.f, 0.f}, {0.f, 0.f, 0.f, 0.f}};
#pragma unroll
          for (int j = 0; j < 2; ++j) { const int vi = 2 * hf + j;
#pragma unroll
              for (int k = 0; k < 8; ++k) uacc[j] = MFMA16(frag_row(L + L_CT, QSTR, 16 * vi, 32 * k, lane), qf[k], uacc[j]); }
          const float wst = sc[128 + 16 * ti + fr]; uacc[0] *= wst; uacc[1] *= wst;
#pragma unroll
          for (int ks = 0; ks < 2; ++ks) if (32 * ks <= 16 * ti + 15) { const bf16x8 sb = frag_row(L + L_SB, VSTR, 16 * ti, 32 * ks, lane);
#pragma unroll
              for (int j = 0; j < 2; ++j) uacc[j] = MFMA16(frag_tr(L + L_VS, VSTR, 32 * ks, 16 * (2 * hf + j), lane), sb, uacc[j]); }
#pragma unroll
          for (int j = 0; j < 2; ++j) *(LAS u32x2*)(L + L_NUMB + (16 * ti + fr) * VSTR + (16 * (2 * hf + j) + 4 * fq) * 2) = pack4(uacc[j]); }
        if (vs == 0 && hf == 0) {
            f32x4 qn = {0.f, 0.f, 0.f, 0.f};
#pragma unroll
            for (int k = 0; k < 8; ++k) { u32x4 nv = *(const LAS u32x4*)(NSTB + 64 * k + 16 * fq); if (fr != 0) nv = (u32x4){0u, 0u, 0u, 0u};
                qn = MFMA16(__builtin_bit_cast(bf16x8, nv), qf[k], qn); }
            const int t = 16 * ti + fr; const float den = DENP[t] + DENP[64 + t] + sc[128 + t] * qn[0];
            denst = fmaxf(fabsf(den), sc[192 + t]); }
        { const float decay = sc[320];
#pragma unroll
          for (int dt = 0; dt < 2; ++dt)
#pragma unroll
              for (int vi = 0; vi < 4; ++vi) cacc[dt][vi] *= decay;
#pragma unroll
          for (int ks = 0; ks < 2; ++ks) { bf16x8 ka[2];
#pragma unroll
              for (int dt = 0; dt < 2; ++dt) ka[dt] = frag_tr(L + L_KS, QSTR, 32 * ks, 32 * w + 16 * dt, lane);
#pragma unroll
              for (int vi = 0; vi < 4; ++vi) { const bf16x8 vb = frag_tr(L + L_VW, VSTR, 32 * ks, 16 * vi, lane);
#pragma unroll
                  for (int dt = 0; dt < 2; ++dt) cacc[dt][vi] = MFMA16(ka[dt], vb, cacc[dt][vi]); } }
          if (vs == 0) { nacc[0] *= decay; nacc[1] *= decay;
#pragma unroll
              for (int ks = 0; ks < 2; ++ks) { const f32x4 w0 = *(const LAS f32x4*)(sc + 256 + 32 * ks + 8 * fq), w1 = *(const LAS f32x4*)(sc + 256 + 32 * ks + 8 * fq + 4);
                  u32x4 wv; wv.x = cvt_pk_bf16(w0[0], w0[1]); wv.y = cvt_pk_bf16(w0[2], w0[3]); wv.z = cvt_pk_bf16(w1[0], w1[1]); wv.w = cvt_pk_bf16(w1[2], w1[3]);
                  if (fr != 0) wv = (u32x4){0u, 0u, 0u, 0u};
#pragma unroll
                  for (int dt = 0; dt < 2; ++dt) nacc[dt] = MFMA16(frag_tr(L + L_KS, QSTR, 32 * ks, 32 * w + 16 * dt, lane), __builtin_bit_cast(bf16x8, wv), nacc[dt]); } } }
        if (w == 0 && c + 1 < nch) mstate = mlstm_scan(gi + ifbi, gf + ifbf, lane, mstate, SC + ((c + 1) & 1) * 384);
        __syncthreads();
        numst = *(const LAS u32x4*)(L + L_NUMB + (tid >> 3) * VSTR + 16 * (tid & 7));
#pragma unroll
        for (int dt = 0; dt < 2; ++dt)
#pragma unroll
            for (int vi = 0; vi < 4; ++vi) *(LAS u32x2*)(L + L_CT + (16 * vi + fr) * QSTR + (32 * w + 16 * dt + 4 * fq) * 2) = pack4(cacc[dt][vi]);
        if (vs == 0 && fr == 0) {
#pragma unroll
            for (int dt = 0; dt < 2; ++dt) *(LAS u32x2*)(NSTB + (32 * w + 16 * dt + 4 * fq) * 2) = pack4(nacc[dt]); }
    }
    ML_STORE(nch - 1);
#undef ML_LOAD
#undef ML_STORE
    float* Cout = F.out + O_PC + (size_t)(b * 4 + h) * 131072;
#pragma unroll
    for (int dt = 0; dt < 2; ++dt)
#pragma unroll
        for (int vi = 0; vi < 4; ++vi)
#pragma unroll
            for (int r = 0; r < 4; ++r) { const int d = 32 * w + 16 * dt + 4 * fq + r, v = 16 * vi + fr; Cout[(size_t)d * 512 + vs * 64 + v] = cacc[dt][vi][r]; }
    if (vs == 0) { if (fr == 0) {
#pragma unroll
            for (int dt = 0; dt < 2; ++dt)
#pragma unroll
                for (int r = 0; r < 4; ++r) F.out[O_PN + (size_t)(b * 4 + h) * 256 + 32 * w + 16 * dt + 4 * fq + r] = nacc[dt][r]; }
        if (tid == 0) F.out[O_PM + b * 4 + h] = mstate; }
}

constexpr int XSTR = 144, BSTR = 272;
constexpr int S_XS = 0, S_XD = 9216, S_XW = 18432, S_BS = 27648, S_CS = 45056, S_HS = 62464, S_GB = 79872, S_SCAL = 89088, S_YB = 98304;

__device__ __forceinline__ void ssd_scan(float dtp, float Ae, int lane, LAS float* sc) {
    const float dt = fmaxf(dtp, 0.f) + fast_log1pexp_neg(fabsf(dtp));
    const float cum = wave_scan_add(dt * Ae);
    const float cl = __shfl(cum, 63);
    sc[lane] = cum; sc[64 + lane] = dt; sc[128 + lane] = fast_exp(cl - cum); sc[192 + lane] = fast_exp(cum);
    if (lane == 0) sc[256] = fast_exp(cl);
}

__device__ __forceinline__ void ssd_prompt_item(Frame& F, const Params& p, const int b, const int e) {
    LAS unsigned char* L = F.lds;
    const int tid = F.tid, lane = F.lane, w = F.wave, fr = lane & 15, fq = lane >> 4;
    const bf16_t* CV = (const bf16_t*)(F.ws + WS_CV); const float* GT = (const float*)(F.ws + WS_GATES);
    bf16_t* YS = (bf16_t*)(F.ws + WS_YS);
    const int g = e >> 3, m0 = b * SEQ; constexpr int nch = SEQ / 64;
    const float dtb = PIN(25)[e], Ae = -expf(PIN(26)[e]), De = PIN(27)[e];
    LAS float* SC = (LAS float*)(L + S_SCAL);
    f32x4 hacc[4];
#pragma unroll
    for (int pi = 0; pi < 4; ++pi) hacc[pi] = (f32x4){0.f, 0.f, 0.f, 0.f};
    u32x4 px, pb[2], pc[2]; float gd = 0.f;
    const bf16_t* xsrc = CV + (size_t)(m0 + (tid >> 3)) * CVP + 2048 + e * 64 + 8 * (tid & 7);
    const bf16_t* bsrc = CV + (size_t)(m0 + (tid >> 4)) * CVP + 4096 + g * 128 + 8 * (tid & 15);
    const float* gsrc = GT + (size_t)(m0 + lane) * 64 + 8 + e;
#define SD_LOAD(c) do { px = *(const u32x4*)(xsrc + (size_t)((c) * 64) * CVP); _Pragma("unroll") for (int i = 0; i < 2; ++i) { pb[i] = *(const u32x4*)(bsrc + (size_t)((c) * 64 + 32 * i) * CVP); pc[i] = *(const u32x4*)(bsrc + (size_t)((c) * 64 + 32 * i) * CVP + 512); } \
        if (w == 0) gd = gsrc[(size_t)((c) * 64) * 64]; } while (0)
    u32x4 yst = {0u, 0u, 0u, 0u};
    bf16_t* ydst = YS + (size_t)(m0 + (tid >> 3)) * 2048 + e * 64 + 8 * (tid & 7);
#define SD_STORE(c) do { *(u32x4*)(ydst + (size_t)((c) * 64) * 2048) = yst; } while (0)
    SD_LOAD(0);
    __syncthreads();
#pragma unroll
    for (int pi = 0; pi < 4; ++pi) *(LAS u32x2*)(L + S_HS + (16 * pi + fr) * BSTR + (16 * w + 4 * fq) * 2) = (u32x2){0u, 0u};
    if (w == 0) ssd_scan(gd + dtb, Ae, lane, SC);
    __syncthreads();
    for (int c = 0; c < nch; ++c) {
        const int t0 = 64 * c; LAS float* sc = SC + (c & 1) * 320;
        { const int row = tid >> 3, c8 = tid & 7; const float dt = sc[64 + row], ed = sc[128 + row]; float x[8]; unpack8(px, x);
          *(LAS u32x4*)(L + S_XS + row * XSTR + 16 * c8) = px; *(LAS u32x4*)(L + S_XD + row * XSTR + 16 * c8) = pack8(x, dt); *(LAS u32x4*)(L + S_XW + row * XSTR + 16 * c8) = pack8(x, dt * ed); }
#pragma unroll
        for (int i = 0; i < 2; ++i) { const int row = (tid >> 4) + 32 * i, c16 = tid & 15; *(LAS u32x4*)(L + S_BS + row * BSTR + 16 * c16) = pb[i]; *(LAS u32x4*)(L + S_CS + row * BSTR + 16 * c16) = pc[i]; }
        __syncthreads();
        if (c > 0) { SD_STORE(c - 1); }
        if (c + 1 < nch) SD_LOAD(c + 1);
        const int ti = w & 3, hf = w >> 2;
        bf16x8 cf[4];
#pragma unroll
        for (int k = 0; k < 4; ++k) cf[k] = frag_row(L + S_CS, BSTR, 16 * ti, 32 * k, lane);
        { f32x4 gacc[2] = {{0.f, 0.f, 0.f, 0.f}, {0.f, 0.f, 0.f, 0.f}};
#pragma unroll
          for (int j = 0; j < 2; ++j) { const int si = 2 * hf + j; if (si <= ti) {
#pragma unroll
                  for (int k = 0; k < 4; ++k) gacc[j] = MFMA16(frag_row(L + S_BS, BSTR, 16 * si, 32 * k, lane), cf[k], gacc[j]); } }
          const int t = 16 * ti + fr; const float cumt = sc[t];
#pragma unroll
          for (int j = 0; j < 2; ++j) { const int si = 2 * hf + j, s0 = 16 * si + 4 * fq; const f32x4 cs = *(const LAS f32x4*)(sc + s0); f32x4 vv;
#pragma unroll
              for (int r = 0; r < 4; ++r) vv[r] = (si <= ti && s0 + r <= t) ? gacc[j][r] * fast_exp(cumt - cs[r]) : 0.f;
              *(LAS u32x2*)(L + S_GB + t * XSTR + s0 * 2) = pack4(vv); } }
        __syncthreads();
        { f32x4 yacc[2] = {{0.f, 0.f, 0.f, 0.f}, {0.f, 0.f, 0.f, 0.f}};
#pragma unroll
          for (int j = 0; j < 2; ++j) { const int pi = 2 * hf + j;
#pragma unroll
              for (int k = 0; k < 4; ++k) yacc[j] = MFMA16(frag_row(L + S_HS, BSTR, 16 * pi, 32 * k, lane), cf[k], yacc[j]); }
          const int t = 16 * ti + fr; const float ec = sc[192 + t]; yacc[0] *= ec; yacc[1] *= ec;
#pragma unroll
          for (int ks = 0; ks < 2; ++ks) if (32 * ks <= 16 * ti + 15) { const bf16x8 gb = frag_row(L + S_GB, XSTR, 16 * ti, 32 * ks, lane);
#pragma unroll
              for (int j = 0; j < 2; ++j) yacc[j] = MFMA16(frag_tr(L + S_XD, XSTR, 32 * ks, 16 * (2 * hf + j), lane), gb, yacc[j]); }
#pragma unroll
          for (int j = 0; j < 2; ++j) { const int p0 = 16 * (2 * hf + j) + 4 * fq; const u32x2 xv = *(const LAS u32x2*)(L + S_XS + t * XSTR + p0 * 2);
              f32x4 y = yacc[j]; y[0] += De * bflo(xv.x); y[1] += De * bfhi(xv.x); y[2] += De * bflo(xv.y); y[3] += De * bfhi(xv.y);
              *(LAS u32x2*)(L + S_YB + t * XSTR + p0 * 2) = pack4(y); } }
        { const float eall = sc[256];
#pragma unroll
          for (int pi = 0; pi < 4; ++pi) hacc[pi] *= eall;
#pragma unroll
          for (int ks = 0; ks < 2; ++ks) { const bf16x8 ba = frag_tr(L + S_BS, BSTR, 32 * ks, 16 * w, lane);
#pragma unroll
              for (int pi = 0; pi < 4; ++pi) hacc[pi] = MFMA16(ba, frag_tr(L + S_XW, XSTR, 32 * ks, 16 * pi, lane), hacc[pi]); } }
        if (w == 0 && c + 1 < nch) ssd_scan(gd + dtb, Ae, lane, SC + ((c + 1) & 1) * 320);
        __syncthreads();
        yst = *(const LAS u32x4*)(L + S_YB + (tid >> 3) * XSTR + 16 * (tid & 7));
#pragma unroll
        for (int pi = 0; pi < 4; ++pi) *(LAS u32x2*)(L + S_HS + (16 * pi + fr) * BSTR + (16 * w + 4 * fq) * 2) = pack4(hacc[pi]);
    }
    SD_STORE(nch - 1);
#undef SD_LOAD
#undef SD_STORE
    float* hout = F.out + O_PSSM + (size_t)(b * 32 + e) * 8192;
#pragma unroll
    for (int pi = 0; pi < 4; ++pi) *(f32x4*)(hout + (size_t)(16 * pi + fr) * 128 + 16 * w + 4 * fq) = hacc[pi];
}

__device__ __forceinline__ void mlstm_sample_item(Frame& F, const Params& p, const int bs, const int h) {
    LAS unsigned char* L = F.lds; const int tid = F.tid, lane = F.lane, w = F.wave;
    const bf16_t* Z = (const bf16_t*)(F.ws + WS_ZIN); const bf16_t* CV = (const bf16_t*)(F.ws + WS_CV); const float* GT = (const float*)(F.ws + WS_GATES);
    bf16_t* NUM = (bf16_t*)(F.ws + WS_NUM); float* DEN = (float*)(F.ws + WS_DEN);
    const int m0 = MP + bs * TS;
    const float* C0 = PIN(4) + (size_t)(bs * 4 + h) * 131072; float* C1 = F.out + O_SC + (size_t)(bs * 4 + h) * 131072;
    LAS float* QKW = (LAS float*)L; LAS float* RED = (LAS float*)(L + 16384); LAS float* NS = (LAS float*)(L + 81920);
    LAS float* SCs = (LAS float*)(L + 82944); LAS float* SW = (LAS float*)(L + 83200); LAS float* QN = (LAS float*)(L + 83456);
    const int v4 = tid & 127, dp = tid >> 7;
    f32x4 vreg[8];
#pragma unroll
    for (int s = 0; s < 8; ++s) { const u32x2 vv = *(const u32x2*)(Z + (size_t)(m0 + s) * ZP + ZV + h * 512 + 4 * v4); vreg[s] = (f32x4){bflo(vv.x), bfhi(vv.x), bflo(vv.y), bfhi(vv.y)}; }
    const u32x4 qk = *(const u32x4*)(CV + (size_t)(m0 + ((tid >> 5) & 7)) * CVP + (tid >> 8) * 1024 + h * 256 + 8 * (tid & 31));
    const float n0v = tid < 256 ? PIN(5)[(size_t)(bs * 4 + h) * 256 + tid] : 0.f;
    __syncthreads();
    { const int isk = tid >> 8, t = (tid >> 5) & 7, c16 = tid & 31; float x[8]; unpack8(qk, x);
#pragma unroll
      for (int e = 0; e < 8; ++e) QKW[(8 * c16 + e) * 16 + isk * 8 + t] = x[e]; }
    if (tid < 256) NS[tid] = n0v;
    if (w == 0) {
        const bool valid = lane < 8; const float mstate = PIN(6)[bs * 4 + h];
        float ipre = 0.f, fpre = 0.f; if (valid) { ipre = GT[(size_t)(m0 + lane) * 64 + h] + PIN(20)[h]; fpre = GT[(size_t)(m0 + lane) * 64 + 4 + h] + PIN(20)[4 + h]; }
        float bsum = valid ? logsigmoidf_(fpre) : 0.f;
#pragma unroll
        for (int o = 1; o < 8; o <<= 1) { const float u = __shfl_up(bsum, o); if (lane >= o) bsum += u; }
        const float a = valid ? ipre - bsum : -INFINITY;
        float cm = a;
#pragma unroll
        for (int o = 1; o < 8; o <<= 1) { const float u = __shfl_up(cm, o); if (lane >= o) cm = fmaxf(cm, u); }
        const float A = fmaxf(mstate, cm); const float Alast = __shfl(A, 7), blast = __shfl(bsum, 7);
        if (valid) { SCs[lane] = a; SCs[8 + lane] = A; SCs[16 + lane] = expf(mstate - A); SCs[24 + lane] = expf(-(bsum + A)); SCs[32 + lane] = expf(a - Alast); }
        if (lane == 0) { SCs[40] = expf(mstate - Alast); F.out[O_SM + bs * 4 + h] = blast + Alast; }
    }
    __syncthreads();
    { const int pr = tid >> 3, part = tid & 7, t = pr >> 3, s = pr & 7; float acc = 0.f;
#pragma unroll 8
      for (int dd = 0; dd < 32; ++dd) { const int d = part * 32 + dd; acc += QKW[d * 16 + t] * QKW[d * 16 + 8 + s]; }
      acc += __shfl_xor(acc, 1); acc += __shfl_xor(acc, 2); acc += __shfl_xor(acc, 4);
      if (part == 0) SW[t * 8 + s] = (s <= t) ? acc * expf(SCs[s] - SCs[8 + t]) : 0.f; }
    if (tid < 64) { const int t = tid >> 3, part = tid & 7; float acc = 0.f;
#pragma unroll 8
      for (int dd = 0; dd < 32; ++dd) { const int d = part * 32 + dd; acc += QKW[d * 16 + t] * NS[d]; }
      acc += __shfl_xor(acc, 1); acc += __shfl_xor(acc, 2); acc += __shfl_xor(acc, 4);
      if (part == 0) QN[t] = acc; }
    if (tid >= 256) { const int d = tid - 256; float s = 0.f;
#pragma unroll
        for (int si = 0; si < 8; ++si) s += SCs[32 + si] * QKW[d * 16 + 8 + si];
        F.out[O_SN + (size_t)(bs * 4 + h) * 256 + d] = SCs[40] * NS[d] + s; }
    __syncthreads();
    if (tid < 8) { const int t = tid; float den = 0.f;
#pragma unroll
        for (int s = 0; s < 8; ++s) den += SW[t * 8 + s];
        den += SCs[16 + t] * QN[t]; DEN[(size_t)(m0 + t) * 4 + h] = fmaxf(fabsf(den), SCs[24 + t]); }
    if (tid >= 256) { const int d = tid - 256;
#pragma unroll
        for (int si = 0; si < 8; ++si) QKW[d * 16 + 8 + si] *= SCs[32 + si]; }
    __syncthreads();
    { const float decay = SCs[40];
      f32x4 acc[8];
#pragma unroll
      for (int t = 0; t < 8; ++t) acc[t] = (f32x4){0.f, 0.f, 0.f, 0.f};
      const float* cin = C0 + (size_t)(dp * 64) * 512 + 4 * v4; float* cout = C1 + (size_t)(dp * 64) * 512 + 4 * v4;
#pragma unroll 1
      for (int d0 = 0; d0 < 64; d0 += 8) {
          f32x4 cc[8];
#pragma unroll
          for (int i = 0; i < 8; ++i) cc[i] = __builtin_nontemporal_load((const f32x4*)(cin + (size_t)(d0 + i) * 512));
#pragma unroll
          for (int i = 0; i < 8; ++i) { const LAS float* qp = QKW + (dp * 64 + d0 + i) * 16;
              const f32x4 q0 = *(const LAS f32x4*)qp, q1 = *(const LAS f32x4*)(qp + 4), k0 = *(const LAS f32x4*)(qp + 8), k1 = *(const LAS f32x4*)(qp + 12);
              f32x4 cn = decay * cc[i];
#pragma unroll
              for (int t = 0; t < 4; ++t) { acc[t] += q0[t] * cc[i]; acc[4 + t] += q1[t] * cc[i]; cn += k0[t] * vreg[t]; cn += k1[t] * vreg[4 + t]; }
              __builtin_nontemporal_store(cn, (f32x4*)(cout + (size_t)(d0 + i) * 512)); }
      }
#pragma unroll
      for (int t = 0; t < 8; ++t) *(LAS f32x4*)(RED + (size_t)(dp * 8 + t) * 512 + 4 * v4) = acc[t]; }
    __syncthreads();
    { const int t = tid >> 6, v8 = tid & 63; float s[8];
#pragma unroll
      for (int e = 0; e < 8; ++e) s[e] = 0.f;
#pragma unroll
      for (int dpp = 0; dpp < 4; ++dpp) { const f32x4 a = *(const LAS f32x4*)(RED + (size_t)(dpp * 8 + t) * 512 + 8 * v8), b = *(const LAS f32x4*)(RED + (size_t)(dpp * 8 + t) * 512 + 8 * v8 + 4);
#pragma unroll
          for (int e = 0; e < 4; ++e) { s[e] += a[e]; s[4 + e] += b[e]; } }
      const float wst = SCs[16 + t];
#pragma unroll
      for (int e = 0; e < 8; ++e) s[e] *= wst;
      for (int si = 0; si <= t; ++si) { const float sw = SW[t * 8 + si]; float x[8]; unpack8(*(const u32x4*)(Z + (size_t)(m0 + si) * ZP + ZV + h * 512 + 8 * v8), x);
#pragma unroll
          for (int e = 0; e < 8; ++e) s[e] += sw * x[e]; }
      *(u32x4*)(NUM + (size_t)(m0 + t) * 2048 + h * 512 + 8 * v8) = pack8(s, 1.0f); }
}

__device__ __forceinline__ void ssd_sample_item(Frame& F, const Params& p, const int bs, const int g) {
    LAS unsigned char* L = F.lds; const int tid = F.tid, lane = F.lane, w = F.wave;
    const bf16_t* CV = (const bf16_t*)(F.ws + WS_CV); const float* GT = (const float*)(F.ws + WS_GATES); bf16_t* YS = (bf16_t*)(F.ws + WS_YS);
    const int m0 = MP + bs * TS;
    LAS float* BSf = (LAS float*)L; LAS float* CSf = (LAS float*)(L + 4096); LAS float* XF = (LAS float*)(L + 8192); LAS float* XWt = (LAS float*)(L + 24576);
    LAS float* XDt = (LAS float*)(L + 40960); LAS float* SC2 = (LAS float*)(L + 57344); LAS float* CB = (LAS float*)(L + 58432); LAS float* YP = (LAS float*)(L + 59392);
    const u32x4 xr = *(const u32x4*)(CV + (size_t)(m0 + (tid >> 6)) * CVP + 2048 + g * 512 + 8 * (tid & 63));
    u32x4 bcr = {0u, 0u, 0u, 0u};
    if (tid < 256) bcr = *(const u32x4*)(CV + (size_t)(m0 + ((tid >> 4) & 7)) * CVP + 4096 + (tid >> 7) * 512 + g * 128 + 8 * (tid & 15));
    __syncthreads();
    { float x[8]; unpack8(xr, x); const int t = tid >> 6, c8 = tid & 63;
#pragma unroll
      for (int e = 0; e < 8; ++e) XF[t * 512 + 8 * c8 + e] = x[e]; }
    if (tid < 256) { float x[8]; unpack8(bcr, x); const int isC = tid >> 7, t = (tid >> 4) & 7, c16 = tid & 15; LAS float* dst = isC ? CSf : BSf;
#pragma unroll
      for (int e = 0; e < 8; ++e) dst[t * 128 + 8 * c16 + e] = x[e]; }
    { const int e = g * 8 + w; const bool valid = lane < 8; const float Ae = -expf(PIN(26)[e]);
      const float dt = valid ? softplusf_(GT[(size_t)(m0 + lane) * 64 + 8 + e] + PIN(25)[e]) : 0.f;
      float cum = dt * Ae;
#pragma unroll
      for (int o = 1; o < 8; o <<= 1) { const float u = __shfl_up(cum, o); if (lane >= o) cum += u; }
      const float cl = __shfl(cum, 7);
      if (valid) { SC2[w * 32 + lane] = cum; SC2[w * 32 + 8 + lane] = dt; SC2[w * 32 + 16 + lane] = expf(cl - cum); SC2[w * 32 + 24 + lane] = expf(cum); }
      if (lane == 0) SC2[256 + w] = expf(cl); }
    __syncthreads();
    { const int pr = tid >> 3, part = tid & 7, t = pr >> 3, s = pr & 7; float acc = 0.f;
#pragma unroll
      for (int nn = 0; nn < 16; ++nn) { const int n = part * 16 + nn; acc += CSf[t * 128 + n] * BSf[s * 128 + n]; }
      acc += __shfl_xor(acc, 1); acc += __shfl_xor(acc, 2); acc += __shfl_xor(acc, 4);
      if (part == 0) CB[t * 8 + s] = acc; }
    { const int el = tid >> 6;
#pragma unroll
      for (int s = 0; s < 8; ++s) { const float x = XF[s * 512 + tid], dt = SC2[el * 32 + 8 + s], ed = SC2[el * 32 + 16 + s]; XDt[tid * 8 + s] = x * dt; XWt[tid * 8 + s] = x * dt * ed; } }
    __syncthreads();
    { const int n8 = tid & 15, prow = tid >> 4;
      float Bn[8][8], Cn[8][8];
#pragma unroll
      for (int s = 0; s < 8; ++s) { const f32x4 b0 = *(const LAS f32x4*)(BSf + s * 128 + 8 * n8), b1 = *(const LAS f32x4*)(BSf + s * 128 + 8 * n8 + 4), c0 = *(const LAS f32x4*)(CSf + s * 128 + 8 * n8), c1 = *(const LAS f32x4*)(CSf + s * 128 + 8 * n8 + 4);
#pragma unroll
          for (int j = 0; j < 4; ++j) { Bn[s][j] = b0[j]; Bn[s][4 + j] = b1[j]; Cn[s][j] = c0[j]; Cn[s][4 + j] = c1[j]; } }
      const float* hin = PIN(8) + (size_t)(bs * 32 + g * 8) * 8192 + 8 * n8; float* hout = F.out + O_SSSM + (size_t)(bs * 32 + g * 8) * 8192 + 8 * n8;
#pragma unroll 1
      for (int it = 0; it < 16; it += 2) {
          f32x4 hv[2][2];
#pragma unroll
          for (int u = 0; u < 2; ++u) { const int row = (it + u) * 32 + prow; hv[u][0] = __builtin_nontemporal_load((const f32x4*)(hin + (size_t)row * 128)); hv[u][1] = __builtin_nontemporal_load((const f32x4*)(hin + (size_t)row * 128 + 4)); }
#pragma unroll
          for (int u = 0; u < 2; ++u) { const int row = (it + u) * 32 + prow; const float eall = SC2[256 + (row >> 6)];
              const f32x4 xw0 = *(const LAS f32x4*)(XWt + row * 8), xw1 = *(const LAS f32x4*)(XWt + row * 8 + 4);
              float hh[8], hn[8], yp[8];
#pragma unroll
              for (int j = 0; j < 4; ++j) { hh[j] = hv[u][0][j]; hh[4 + j] = hv[u][1][j]; }
#pragma unroll
              for (int j = 0; j < 8; ++j) hn[j] = eall * hh[j];
#pragma unroll
              for (int s = 0; s < 8; ++s) { const float xw = s < 4 ? xw0[s & 3] : xw1[s & 3]; float y = 0.f;
#pragma unroll
                  for (int j = 0; j < 8; ++j) { hn[j] += xw * Bn[s][j]; y += Cn[s][j] * hh[j]; }
                  yp[s] = y; }
              f32x4 o0 = {hn[0], hn[1], hn[2], hn[3]}, o1 = {hn[4], hn[5], hn[6], hn[7]};
              __builtin_nontemporal_store(o0, (f32x4*)(hout + (size_t)row * 128)); __builtin_nontemporal_store(o1, (f32x4*)(hout + (size_t)row * 128 + 4));
#pragma unroll
              for (int s = 0; s < 8; ++s) { float y = yp[s]; y += __shfl_xor(y, 1); y += __shfl_xor(y, 2); y += __shfl_xor(y, 4); y += __shfl_xor(y, 8); yp[s] = y; }
              if (n8 == 0) { *(LAS f32x4*)(YP + row * 8) = (f32x4){yp[0], yp[1], yp[2], yp[3]}; *(LAS f32x4*)(YP + row * 8 + 4) = (f32x4){yp[4], yp[5], yp[6], yp[7]}; } }
      } }
    __syncthreads();
    { const int row = tid, el = row >> 6, pp = row & 63, e = g * 8 + el; const float De = PIN(27)[e];
#pragma unroll
      for (int t = 0; t < 8; ++t) { const float cumt = SC2[el * 32 + t]; float y = SC2[el * 32 + 24 + t] * YP[row * 8 + t];
#pragma unroll
          for (int s = 0; s < 8; ++s) if (s <= t) y += CB[t * 8 + s] * expf(cumt - SC2[el * 32 + s]) * XDt[row * 8 + s];
          y += De * XF[t * 512 + row];
          YS[(size_t)(m0 + t) * 2048 + e * 64 + pp] = (bf16_t)(cvt_pk_bf16(y, 0.f) & 0xffffu); } }
}

#ifndef IT_MASK
#define IT_MASK 15
#endif
__device__ __forceinline__ void phase_mixer(Frame& F, const Params& p, const int itm = IT_MASK) {
    if (itm & 1) { for (int it = F.bx; it < 256; it += F.G) { const int x = it & 7, j = it >> 3, pair = x * 4 + (j >> 3); mlstm_prompt_item(F, p, pair >> 2, pair & 3, j & 7); } }
    if (itm & 2) { for (int it = F.bx; it < 256; it += F.G) { const int x = it & 7, j = it >> 3, grp = x * 4 + (j >> 3); ssd_prompt_item(F, p, grp >> 2, (grp & 3) * 8 + (j & 7)); } }
    if (itm & 4) { for (int it = F.bx; it < 4 * (NBS - NS_EARLY); it += F.G) mlstm_sample_item(F, p, NS_EARLY + (it >> 2), it & 3); }
    if (itm & 8) { for (int it = F.bx; it < 4 * (NBS - NS_EARLY); it += F.G) ssd_sample_item(F, p, NS_EARLY + (it >> 2), it & 3); }
}

__device__ __forceinline__ void phase_finish(Frame& F, const Params& p) {
    const bf16_t* Z = (const bf16_t*)(F.ws + WS_ZIN); const bf16_t* NUM = (const bf16_t*)(F.ws + WS_NUM); const bf16_t* YS = (const bf16_t*)(F.ws + WS_YS);
    const float* DEN = (const float*)(F.ws + WS_DEN); bf16_t* HA = (bf16_t*)(F.ws + WS_HA); bf16_t* HB = (bf16_t*)(F.ws + WS_HB);
    const float* hg = PIN(21); const float* sg = PIN(28);
    const int gwv = F.bx * 8 + F.wave, NGW = F.G * 8, lane = F.lane;
    for (int m = gwv; m < MT; m += NGW) {
#pragma unroll
        for (int h = 0; h < 4; ++h) {
            float x[8], o[8], gz[8]; unpack8(*(const u32x4*)(NUM + (size_t)m * 2048 + h * 512 + 8 * lane), x);
            float s = 0.f;
#pragma unroll
            for (int e = 0; e < 8; ++e) s += x[e];
            const float mu = wave_sum(s) * (1.0f / 512.0f); float q = 0.f;
#pragma unroll
            for (int e = 0; e < 8; ++e) { x[e] -= mu; q += x[e] * x[e]; }
            const float var = wave_sum(q) * (1.0f / 512.0f), Dv = DEN[(size_t)m * 4 + h];
            const float rs = 1.0f / sqrtf(var + EPS * Dv * Dv);
            unpack8(*(const u32x4*)(Z + (size_t)m * ZP + ZO + h * 512 + 8 * lane), gz);
            const f32x4 g0 = *(const f32x4*)(hg + h * 512 + 8 * lane), g1 = *(const f32x4*)(hg + h * 512 + 8 * lane + 4);
#pragma unroll
            for (int e = 0; e < 8; ++e) o[e] = x[e] * rs * (e < 4 ? g0[e & 3] : g1[e & 3]) * sigmoidf_(gz[e]);
            *(u32x4*)(m < MP ? HA + (size_t)m * 2048 + h * 512 + 8 * lane : HA + (size_t)MP * 2048 + fo_index(m - MP, h * 512 + 8 * lane, 2048)) = pack8(o, 1.0f);
        }
#pragma unroll
        for (int gq = 0; gq < 4; ++gq) {
            float y[8], zz[8]; unpack8(*(const u32x4*)(YS + (size_t)m * 2048 + gq * 512 + 8 * lane), y); unpack8(*(const u32x4*)(Z + (size_t)m * ZP + ZZ + gq * 512 + 8 * lane), zz);
            float q = 0.f;
#pragma unroll
            for (int e = 0; e < 8; ++e) { y[e] *= siluf_(zz[e]); q += y[e] * y[e]; }
            const float rs = 1.0f / sqrtf(wave_sum(q) * (1.0f / 512.0f) + EPS);
            const f32x4 g0 = *(const f32x4*)(sg + gq * 512 + 8 * lane), g1 = *(const f32x4*)(sg + gq * 512 + 8 * lane + 4);
#pragma unroll
            for (int e = 0; e < 8; ++e) y[e] = y[e] * rs * (e < 4 ? g0[e & 3] : g1[e & 3]);
            *(u32x4*)(m < MP ? HB + (size_t)m * 2048 + gq * 512 + 8 * lane : HB + (size_t)MP * 2048 + fo_index(m - MP, gq * 512 + 8 * lane, 2048)) = pack8(y, 1.0f);
        }
    }
    const int gt = F.bx * NTHREADS + F.tid, NGT = F.G * NTHREADS;
    constexpr int N1 = NBP * 3 * 2048, N2 = NBS * 3 * 2048, N3 = NBP * 3 * 3072, N4 = NBS * 3 * 3072;
    for (int i = gt; i < N1 + N2 + N3 + N4; i += NGT) {
        int j = i;
        if (j < N1) { const int b = j / 6144, r = (j / 2048) % 3, ch = j % 2048; F.out[O_PMC + j] = bf2f(Z[(size_t)(b * SEQ + SEQ - 3 + r) * ZP + ch]); continue; } j -= N1;
        if (j < N2) { const int b = j / 6144, r = (j / 2048) % 3, ch = j % 2048; F.out[O_SMC + j] = bf2f(Z[(size_t)(MP + b * TS + TS - 3 + r) * ZP + ch]); continue; } j -= N2;
        if (j < N3) { const int b = j / 9216, r = (j / 3072) % 3, ch = j % 3072; F.out[O_PSC + j] = bf2f(Z[(size_t)(b * SEQ + SEQ - 3 + r) * ZP + ZX + ch]); continue; } j -= N3;
        { const int b = j / 9216, r = (j / 3072) % 3, ch = j % 3072; F.out[O_SSC + j] = bf2f(Z[(size_t)(MP + b * TS + TS - 3 + r) * ZP + ZX + ch]); }
    }
}


#ifndef STAG_LEVELS
#define STAG_LEVELS 8
#endif
#ifndef STAG_SLEEP
#define STAG_SLEEP 16
#endif
__device__ __forceinline__ void stagger_start(const Frame& F) { const int sl = (F.bx >> 3) & (STAG_LEVELS - 1); for (int q = 0; q < sl; ++q) __builtin_amdgcn_s_sleep(STAG_SLEEP); }

constexpr int LDS_BYTES = 147456;
constexpr int NPHASE = 15;

__global__ void __launch_bounds__(NTHREADS, 2) fwd_kernel(Params p) {
    extern __shared__ __attribute__((aligned(16))) unsigned char lds_raw[];
    Frame F;
    F.lds = (LAS unsigned char*)lds_raw;
    F.tid = threadIdx.x; F.lane = F.tid & 63; F.wave = __builtin_amdgcn_readfirstlane(F.tid >> 6);
    F.G = gridDim.x; F.bx = blockIdx.x;
    F.out = p.out; F.ws = p.ws;
    unsigned char* ws = p.ws;
    bf16_t* U = (bf16_t*)(ws + WS_U); bf16_t* H = (bf16_t*)(ws + WS_H); float* X1 = (float*)(ws + WS_X1);
    bf16_t* ZIN = (bf16_t*)(ws + WS_ZIN); float* GATES = (float*)(ws + WS_GATES); float* MOD = (float*)(ws + WS_MOD);
    const int lo = p.ph_lo, hi = p.ph_hi;
#ifndef PH_MASK
#define PH_MASK 0xfffff
#endif
#define IN(k) (((PH_MASK >> (k)) & 1) && lo <= (k) && (k) < hi)
#ifndef DUP_MASK
#define DUP_MASK 0
#endif
#define DUP(k) ((DUP_MASK >> (k)) & 1)
    volatile LAS unsigned* MISC = (volatile LAS unsigned*)(F.lds + LDS_BYTES - 64);
    if (F.tid < 16) MISC[F.tid] = 0u;
    if (F.tid == 0) { volatile LAS unsigned* T = (volatile LAS unsigned*)(F.lds + PTAB_OFF);
#pragma unroll
        for (int k = 0; k < 36; ++k) { const uint64_t a = (uint64_t)p.in[k]; T[2 * k] = (unsigned)a; T[2 * k + 1] = (unsigned)(a >> 32); } }
    __syncthreads();
    XcdBarrier bar; bar.bar = (unsigned*)(ws + WS_CTL); bar.x = 0; bar.st = nullptr;
    if (hi - lo > 1) bar = xcd_barrier_post((unsigned*)(ws + WS_CTL), MISC);
#define SEAM(k) do { if (IN(k) && IN((k) + 1)) { xcd_barrier(bar); } } while (0)

    if (IN(0)) { phase_silu_c(F, p); phase_prep<0>(F, p); if (hi - lo > 1) xcd_barrier(bar); phase_adaln(F, p); } SEAM(0);
    if (IN(1)) { phase_norm_mod(F, PIN(0), PIN(1), PIN(12), 0 * DM, 1 * DM, U); if (DUP(1)) phase_norm_mod(F, PIN(0), PIN(1), PIN(12), 0 * DM, 1 * DM, U); } SEAM(1);
    if (IN(2)) { pg8::Gemm g{U, U, (const bf16_t*)(ws + WS_WUP1), (const bf16_t*)(ws + WS_WUP1), DM}; pg8::Order S;
        if (F.bx < 192) { stagger_start(F); S.init_from(MT, 2 * DFF, 192, F.bx, 0, 1344); } else { phase_prep<1>(F, p); S.init_from(MT, 2 * DFF, 64, F.bx - 192, 1344, 1496); }
        pg8::EpiSwiGLU E{H}; pg8::gemm_phase(F.lds, g, S, E); if (DUP(2)) pg8::gemm_phase(F.lds, g, S, E); } SEAM(2);
    float* XS = (float*)(ws + WS_XS); unsigned* CNT = (unsigned*)(ws + WS_CTL) + CW_CNT; bf16_t* U2 = (bf16_t*)(ws + WS_U2);
    if (IN(3)) { stagger_start(F); pg8::Gemm g{H, H, (const bf16_t*)(ws + WS_WDN1), (const bf16_t*)(ws + WS_WDN1), DFF}; pg8::Order S; S.init(MP, DM, F.G, F.bx, 0);
        pg8::EpiResidNorm<false> E{PIN(0), X1, MOD + 2 * DM, PIN(16), MOD + 3 * DM, MOD + 4 * DM, U, nullptr, XS, CNT, 0.5f, 0}; pg8::gemm_phase(F.lds, g, S, E);
        small_phase_resid_norm<DFF, false>(F, H, (const bf16_t*)(ws + WS_FDN1), PIN(1), X1, MOD + 2 * DM, 0.5f, PIN(16), MOD + 3 * DM, MOD + 4 * DM, U, nullptr, XS, CNT); } SEAM(3);
    if (IN(5)) {
        const pg8::Gemm g{U, U, (const bf16_t*)(ws + WS_WIN), (const bf16_t*)(ws + WS_WIN), DM}; const pg8::EpiZin E{ZIN, GATES};
        { stagger_start(F); const pg8::OrderSample S{F.bx}; pg8::gemm_phase<pg8::EpiZin, true, pg8::OrderSample>(F.lds, g, S, E); }
        if (F.bx >= 208 && F.bx < 224) small_gates_tile(F, U, (const bf16_t*)(ws + WS_FG), GATES, MP / 64 + (F.bx - 208));
        if (F.bx >= 224) { for (int k = 0; k < 4; ++k) small_gates_tile(F, U, (const bf16_t*)(ws + WS_FG), GATES, 4 * (F.bx - 224) + k); }
        xcd_barrier(bar);
        if (F.bx >= 192) {
            const int s0 = F.bx - 192;
            for (int k = F.wave; k < 10; k += 8) conv_item(F, p, 5120 + 10 * s0 + k);
            asm volatile("s_waitcnt vmcnt(0)" ::: "memory"); __syncthreads(); __builtin_amdgcn_fence(__ATOMIC_ACQUIRE, "agent");
#pragma unroll 1
            for (int k = 0; k < 4; ++k) mlstm_sample_item(F, p, s0, k);
#pragma unroll 1
            for (int k = 0; k < 4; ++k) ssd_sample_item(F, p, s0, k);
            for (int k = 0; k < 2; ++k) small_gates_tile(F, U, (const bf16_t*)(ws + WS_FG), GATES, 128 + 2 * s0 + k);
        } else stagger_start(F);
        __syncthreads();
        { const pg8::OrderPrompt S{F.bx}; pg8::gemm_phase<pg8::EpiZin, true, pg8::OrderPrompt>(F.lds, g, S, E); }
        } SEAM(5);
    if (IN(6)) { phase_conv(F, p); if (DUP(6)) phase_conv(F, p); } SEAM(6);
    #ifndef DUP_IT
#define DUP_IT 15
#endif
    if (IN(7)) { phase_mixer(F, p, p.itm); } SEAM(7);
    if (IN(8)) { phase_finish(F, p); if (DUP(8)) phase_finish(F, p); } SEAM(8);
    if (IN(9)) { stagger_start(F); pg8::Gemm g{(const bf16_t*)(ws + WS_HA), (const bf16_t*)(ws + WS_HB), (const bf16_t*)(ws + WS_WPA), (const bf16_t*)(ws + WS_WPB), 2048}; pg8::Order S; S.init(MP, DM, F.G, F.bx, 1);
        pg8::EpiMerge E{ZIN, (float*)(ws + WS_TMP), U}; pg8::gemm_phase(F.lds, g, S, E);
        small_phase_merge(F, (const bf16_t*)(ws + WS_HA), (const bf16_t*)(ws + WS_HB), (const bf16_t*)(ws + WS_FPA), (const bf16_t*)(ws + WS_FPB), ZIN, U); } SEAM(9);
    if (IN(10)) { stagger_start(F); pg8::Gemm g{U, U, (const bf16_t*)(ws + WS_WOUT), (const bf16_t*)(ws + WS_WOUT), DM}; pg8::Order S; S.init(MP, DM, F.G, F.bx, 0);
        pg8::EpiResidNorm<false> E{X1, X1, MOD + 5 * DM, PIN(31), MOD + 6 * DM, MOD + 7 * DM, U2, nullptr, XS + (size_t)MT * 16, CNT + CNT_STRIDE, 1.0f, 0}; pg8::gemm_phase(F.lds, g, S, E);
        small_phase_resid_norm<DM, false>(F, U, (const bf16_t*)(ws + WS_FOUT), X1 + (size_t)MP * DM, X1, MOD + 5 * DM, 1.0f, PIN(31), MOD + 6 * DM, MOD + 7 * DM, U2, nullptr, XS + (size_t)MT * 16, CNT + CNT_STRIDE); } SEAM(10);
    if (IN(12)) { stagger_start(F); pg8::Gemm g{U2, U2, (const bf16_t*)(ws + WS_WUP2), (const bf16_t*)(ws + WS_WUP2), DM}; pg8::Order S; S.init(MT, 2 * DFF, F.G, F.bx, 0);
        pg8::EpiSwiGLU E{H}; pg8::gemm_phase(F.lds, g, S, E); } SEAM(12);
    if (IN(13)) { stagger_start(F); pg8::Gemm g{H, H, (const bf16_t*)(ws + WS_WDN2), (const bf16_t*)(ws + WS_WDN2), DFF}; pg8::Order S; S.init(MP, DM, F.G, F.bx, 0);
        pg8::EpiResidNorm<true> E{X1, nullptr, MOD + 8 * DM, PIN(35), nullptr, nullptr, nullptr, p.out, XS + (size_t)2 * MT * 16, CNT + 2 * CNT_STRIDE, 0.5f, 0}; pg8::gemm_phase(F.lds, g, S, E);
        small_phase_resid_norm<DFF, true>(F, H, (const bf16_t*)(ws + WS_FDN2), X1 + (size_t)MP * DM, nullptr, MOD + 8 * DM, 0.5f, PIN(35), nullptr, nullptr, nullptr, p.out, XS + (size_t)2 * MT * 16, CNT + 2 * CNT_STRIDE); }
#undef IN
#undef SEAM
}

extern "C" void kernel_launch(void* const* d_in, const int* in_sizes, int n_in, void* d_out, int out_size, void* d_ws, size_t ws_size, hipStream_t stream) {
    static int grid = 0;
    if (grid == 0) {
        if (n_in != 36 || ws_size < WS_END) { fprintf(stderr, "kernel_launch: expected 36 inputs and >= %zu bytes of workspace (got %d, %zu)\n", (size_t)WS_END, n_in, ws_size); grid = -1; return; }
        int dev = 0, cus = 0, per_cu = 0;
        hipGetDevice(&dev); hipDeviceGetAttribute(&cus, hipDeviceAttributeMultiprocessorCount, dev);
        hipFuncSetAttribute((const void*)fwd_kernel, hipFuncAttributeMaxDynamicSharedMemorySize, LDS_BYTES);
        hipOccupancyMaxActiveBlocksPerMultiprocessor(&per_cu, (const void*)fwd_kernel, NTHREADS, LDS_BYTES);
        if (per_cu < 1) { fprintf(stderr, "kernel_launch: occupancy query says %d blocks per CU\n", per_cu); grid = -1; return; }
        grid = cus;
        if (grid != 256) { fprintf(stderr, "kernel_launch: the fused-norm GEMM epilogues need exactly 256 workgroups (one 256x256 tile each); this device has %d CUs\n", cus); grid = -1; return; }
    }
    if (grid < 0) return;
    Params p{};
    for (int i = 0; i < 36; ++i) p.in[i] = (const float*)d_in[i];
    p.out = (float*)d_out; p.ws = (unsigned char*)d_ws; p.itm = 15;
#if MK_LAUNCH_PER_PHASE
    for (int ph = 0; ph < NPHASE; ++ph) { p.ph_lo = ph; p.ph_hi = ph + 1; hipLaunchKernelGGL(fwd_kernel, dim3(grid), dim3(NTHREADS), LDS_BYTES, stream, p); }
#else
    p.ph_lo = 0; p.ph_hi = NPHASE;
    if (hipMemsetAsync((char*)d_ws + WS_CTL, 0, 98304, stream) != hipSuccess) { fprintf(stderr, "kernel_launch: memset of the barrier words failed\n"); return; }
    void* args[] = {&p};
    hipError_t e = hipLaunchCooperativeKernel((const void*)fwd_kernel, dim3(grid), dim3(NTHREADS), args, LDS_BYTES, stream);
    if (e != hipSuccess) fprintf(stderr, "cooperative launch failed: %s (grid %d)\n", hipGetErrorString(e), grid);
#ifdef PROBE_PH
    for (int r = 0; r < PROBE_REPS; ++r) { Params q = p; q.ph_lo = PROBE_PH; q.ph_hi = PROBE_PH + 1; q.itm = PROBE_ITM; hipLaunchKernelGGL(fwd_kernel, dim3(grid), dim3(NTHREADS), LDS_BYTES, stream, q); }
#endif
#endif
}
```

```cpp
#include <hip/hip_runtime.h>
#include <hip/hip_cooperative_groups.h>
#include <cstdio>
#include <cstdint>
namespace cg = cooperative_groups;

#ifndef MK_LAUNCH_PER_PHASE
#define MK_LAUNCH_PER_PHASE 0
#endif

constexpr int DM = 1024, SEQ = 2048, NBP = 8, NBS = 128, TS = 8;
constexpr int MP = NBP * SEQ, MS = NBS * TS, MT = MP + MS, NBID = NBP + NBS;
constexpr int DFF = 2816, NMOD = 9 * DM;
constexpr int ZP = 13568;
constexpr int ZQ = 0, ZK = 1024, ZV = 2048, ZO = 4096, ZZ = 6144, ZX = 8192, ZGA = 11264, ZGB = 12288, ZG = 13312;
constexpr float EPS = 1e-6f;
constexpr int NTHREADS = 512;

constexpr size_t MiB = 1u << 20;
constexpr size_t WS_CTL = 0;
constexpr size_t WS_WUP1 = 1 * MiB;
constexpr size_t WS_WDN1 = WS_WUP1 + 11 * MiB;
constexpr size_t WS_WUP2 = WS_WDN1 + 6 * MiB;
constexpr size_t WS_WDN2 = WS_WUP2 + 11 * MiB;
constexpr size_t WS_WIN = WS_WDN2 + 6 * MiB;
constexpr size_t WS_WPA = WS_WIN + 27 * MiB;
constexpr size_t WS_WPB = WS_WPA + 4 * MiB;
constexpr size_t WS_WOUT = WS_WPB + 4 * MiB;
constexpr size_t WS_MOD = WS_WOUT + 2 * MiB;
constexpr size_t WS_U = WS_MOD + 5 * MiB;
constexpr size_t WS_H = WS_U + 34 * MiB;
constexpr size_t WS_X1 = WS_H + 94 * MiB;
constexpr size_t WS_ZIN = WS_X1 + 68 * MiB;
constexpr size_t WS_GATES = WS_ZIN + 451 * MiB;
constexpr size_t WS_YS = WS_GATES + 5 * MiB;
constexpr size_t WS_DEN = WS_YS + 68 * MiB;
constexpr size_t WS_HA = WS_DEN + 1 * MiB;
constexpr size_t WS_HB = WS_HA + 68 * MiB;
constexpr size_t WS_CV = WS_HA;
constexpr size_t WS_XS = WS_CV + 170 * MiB;
constexpr size_t WS_U2 = WS_ZIN;
constexpr size_t WS_FDN1 = WS_XS + 4 * MiB;
constexpr size_t WS_FDN2 = WS_FDN1 + 6 * MiB;
constexpr size_t WS_FPA = WS_FDN2 + 6 * MiB;
constexpr size_t WS_FPB = WS_FPA + 4 * MiB;
constexpr size_t WS_FOUT = WS_FPB + 4 * MiB;
constexpr size_t WS_FG = WS_FOUT + 2 * MiB;
constexpr size_t WS_SC = WS_FG + 1 * MiB;
constexpr size_t WS_END = WS_SC + 1 * MiB;
constexpr int CW_CNT = 4096, CNT_STRIDE = 5120;
constexpr size_t WS_NUM = WS_H;
constexpr size_t WS_TMP = WS_YS;
static_assert(WS_END <= 1024 * MiB, "workspace map");

#define LAS __attribute__((address_space(3)))
typedef unsigned short bf16_t;
typedef short bf16x8 __attribute__((ext_vector_type(8)));
typedef short s16x4 __attribute__((ext_vector_type(4)));
typedef float f32x4 __attribute__((ext_vector_type(4)));
typedef float f32x2 __attribute__((ext_vector_type(2)));
typedef unsigned u32x4 __attribute__((ext_vector_type(4)));
typedef int v8i_t __attribute__((ext_vector_type(8)));
typedef unsigned u32x2 __attribute__((ext_vector_type(2)));

typedef __bf16 bf16x2_t __attribute__((ext_vector_type(2)));
__device__ __forceinline__ unsigned cvt_pk_bf16(float lo, float hi) { const bf16x2_t v = {(__bf16)lo, (__bf16)hi}; return __builtin_bit_cast(unsigned, v); }
__device__ __forceinline__ float bf2f(unsigned short b) { return __uint_as_float(((unsigned)b) << 16); }
__device__ __forceinline__ float bflo(unsigned w) { return __uint_as_float(w << 16); }
__device__ __forceinline__ float bfhi(unsigned w) { return __uint_as_float(w & 0xffff0000u); }
constexpr float F8_SA = 8.0f, F8_SW = 1024.0f, F8_INV = 1.0f / (8.0f * 1024.0f);
__device__ __forceinline__ float f8c(float x) { return fminf(fmaxf(x, -448.0f), 448.0f); }
__device__ __forceinline__ unsigned pack4_fp8(float a, float b, float c, float d, float s) {
    int w = 0; w = __builtin_amdgcn_cvt_pk_fp8_f32(f8c(a * s), f8c(b * s), w, false); w = __builtin_amdgcn_cvt_pk_fp8_f32(f8c(c * s), f8c(d * s), w, true); return (unsigned)w; }
__device__ __forceinline__ float fast_exp(float x) { return __builtin_amdgcn_exp2f(x * 1.4426950408889634f); }
__device__ __forceinline__ float sigmoidf_(float x) { return __builtin_amdgcn_rcpf(1.0f + fast_exp(-x)); }
__device__ __forceinline__ float siluf_(float x) { return x * sigmoidf_(x); }
__device__ __forceinline__ u32x4 pack8(const float (&v)[8], float s) {
    u32x4 w; w.x = cvt_pk_bf16(v[0] * s, v[1] * s); w.y = cvt_pk_bf16(v[2] * s, v[3] * s); w.z = cvt_pk_bf16(v[4] * s, v[5] * s); w.w = cvt_pk_bf16(v[6] * s, v[7] * s); return w;
}
__device__ __forceinline__ u32x2 pack4(const f32x4 v) { u32x2 w; w.x = cvt_pk_bf16(v[0], v[1]); w.y = cvt_pk_bf16(v[2], v[3]); return w; }
__device__ __forceinline__ void unpack8(const u32x4 v, float (&x)[8]) { x[0] = bflo(v.x); x[1] = bfhi(v.x); x[2] = bflo(v.y); x[3] = bfhi(v.y); x[4] = bflo(v.z); x[5] = bfhi(v.z); x[6] = bflo(v.w); x[7] = bfhi(v.w); }
__device__ __forceinline__ size_t fo_index(int r, int k, int K) { return ((size_t)((r >> 4) * (K >> 5) + (k >> 5))) * 512 + (size_t)((((r & 15) + 16 * ((k >> 3) & 3)) << 3) + (k & 7)); }
__device__ __forceinline__ float wave_scan_add(float v) {
    v += __builtin_bit_cast(float, __builtin_amdgcn_update_dpp(0, __builtin_bit_cast(int, v), 0x111, 0xf, 0xf, true));
    v += __builtin_bit_cast(float, __builtin_amdgcn_update_dpp(0, __builtin_bit_cast(int, v), 0x112, 0xf, 0xf, true));
    v += __builtin_bit_cast(float, __builtin_amdgcn_update_dpp(0, __builtin_bit_cast(int, v), 0x114, 0xf, 0xf, true));
    v += __builtin_bit_cast(float, __builtin_amdgcn_update_dpp(0, __builtin_bit_cast(int, v), 0x118, 0xf, 0xf, true));
    v += __builtin_bit_cast(float, __builtin_amdgcn_update_dpp(0, __builtin_bit_cast(int, v), 0x142, 0xa, 0xf, true));
    v += __builtin_bit_cast(float, __builtin_amdgcn_update_dpp(0, __builtin_bit_cast(int, v), 0x143, 0xc, 0xf, true));
    return v;
}
__device__ __forceinline__ float wave_scan_max(float v) {
    const int ninf = (int)0xff800000u;
    v = fmaxf(v, __builtin_bit_cast(float, __builtin_amdgcn_update_dpp(ninf, __builtin_bit_cast(int, v), 0x111, 0xf, 0xf, false)));
    v = fmaxf(v, __builtin_bit_cast(float, __builtin_amdgcn_update_dpp(ninf, __builtin_bit_cast(int, v), 0x112, 0xf, 0xf, false)));
    v = fmaxf(v, __builtin_bit_cast(float, __builtin_amdgcn_update_dpp(ninf, __builtin_bit_cast(int, v), 0x114, 0xf, 0xf, false)));
    v = fmaxf(v, __builtin_bit_cast(float, __builtin_amdgcn_update_dpp(ninf, __builtin_bit_cast(int, v), 0x118, 0xf, 0xf, false)));
    v = fmaxf(v, __builtin_bit_cast(float, __builtin_amdgcn_update_dpp(ninf, __builtin_bit_cast(int, v), 0x142, 0xa, 0xf, false)));
    v = fmaxf(v, __builtin_bit_cast(float, __builtin_amdgcn_update_dpp(ninf, __builtin_bit_cast(int, v), 0x143, 0xc, 0xf, false)));
    return v;
}
__device__ __forceinline__ float wave_sum(float v) { return __builtin_bit_cast(float, __builtin_amdgcn_readlane(__builtin_bit_cast(int, wave_scan_add(v)), 63)); }

struct Params {
    const float* in[36];
    float* out;
    unsigned char* ws;
    int ph_lo, ph_hi, itm, pad;
};

namespace pg8 {
constexpr int BM = 256, BK = 64, HALF = 128, HTB = HALF * BK * 2, STAGE_BYTES = 8 * HTB, NXCD = 8, WGM = 8;
__host__ __device__ __forceinline__ int lds_byte(int r, int c) { const int st = (r >> 4) * 2 + (c >> 5), rr = r & 15, cc = c & 31, ob = rr * 64 + cc * 2; return st * 1024 + (ob ^ (((ob >> 9) & 1) << 5)); }
__host__ __device__ __forceinline__ void stage_rc(int b, int& R, int& C) { const int st = b / 1024, sb = b % 1024, swz = sb ^ (((sb >> 9) & 1) << 5); R = (st >> 1) * 16 + swz / 64; C = (st & 1) * 32 + (swz % 64) / 2; }
__host__ __device__ __forceinline__ int perm32(int rho) { const int n = rho >> 4, i = rho & 15; return 8 * (i >> 2) + 4 * n + (i & 3); }

struct Unit { int pm, pn, w; };
struct Gemm { const bf16_t* A0; const bf16_t* A1; const bf16_t* B0; const bf16_t* B1; int K; };
typedef unsigned u32x8_t __attribute__((ext_vector_type(8)));
__device__ __forceinline__ v8i_t cat8(const bf16x8 x0, const bf16x8 x1) { const u32x4 l = __builtin_bit_cast(u32x4, x0), h = __builtin_bit_cast(u32x4, x1); const u32x8_t c = __builtin_shufflevector(l, h, 0, 1, 2, 3, 4, 5, 6, 7); return __builtin_bit_cast(v8i_t, c); }

struct OrderSample { int c;
    __device__ bool next(int i, Unit& u) const { if (i > 0 || c >= 208) return false; const int x = c & 7, j = c >> 3; u.pm = 64 + (x >> 1); u.pn = (x & 1) * 26 + j; u.w = 0; return true; } };
struct OrderPrompt { int c;
    __device__ bool next(int i, Unit& u) const { const int x = c & 7, j = c >> 3; int q; if (j < 24) { if (i >= 17) return false; q = i * 24 + j; } else { if (i >= 1) return false; q = 408 + (j - 24); }
        u.pm = 8 * x + (q & 7); u.pn = q >> 3; u.w = 0; return true; } };
struct Order {
    int nM, nN, nwg, G, c, dual;
    __device__ void init(int M, int N, int G_, int c_, int dual_) { nM = M / BM; nN = N / BM; nwg = nM * nN; G = G_; c = c_; dual = dual_; }
    __device__ void init_from(int M, int N, int G_, int c_, int first, int lim) { nM = M / BM; nN = N / BM; nwg = lim; G = G_; c = first + c_; dual = 0; }
    __device__ bool next(int i, Unit& u) const {
        const int ti = dual ? (i >> 1) : i;
        const long L = (long)ti * G + c; if (L >= nwg) return false;
        int wgid = (int)L; { const int tot = nM * nN, q = tot / NXCD, r = tot % NXCD, xcd = wgid % NXCD, off = wgid / NXCD; wgid = (xcd < r ? xcd * (q + 1) : r * (q + 1) + (xcd - r) * q) + off; }
        const int nig = WGM * nN, gid = wgid / nig, fm = gid * WGM, gsz = (nM - fm) < WGM ? (nM - fm) : WGM;
        u.pm = fm + ((wgid % nig) % gsz); u.pn = (wgid % nig) / gsz; u.w = dual ? (i & 1) : 0; return true;
    }
};

template <class Epi, bool ALIGN_EPI = true, class Ord = Order, bool FP8 = false>
__device__ __forceinline__ void gemm_phase(LAS unsigned char* lds, const Gemm g, const Ord& S, const Epi E) {
    const int tid = threadIdx.x, wid = __builtin_amdgcn_readfirstlane(tid >> 6), lane = tid & 63, wr = wid >> 2, wc = wid & 3, fr = lane & 15, fq = lane >> 4;
    const int K = g.K, nt = K / BK;
    unsigned voffA[2], voffB[2];
#pragma unroll
    for (int i = 0; i < 2; ++i) { int R, C; stage_rc(tid * 16 + i * 8192, R, C); const int Rb = Epi::PERM ? ((R & ~31) + perm32(R & 31)) : R;
        voffA[i] = (unsigned)(R * K + C) * 2u; voffB[i] = (unsigned)(Rb * K + C) * 2u; }
    const size_t kstep = (size_t)(BK * 2);
    const size_t hstep = (size_t)HALF * K * 2;
    const size_t tstep = 2 * hstep;
    const unsigned ldsw = (unsigned)wid * 1024u;
    const int aoff = lds_byte(wr * 64 + fr, fq * 8), boff = lds_byte(wc * 32 + fr, fq * 8);
#define PG8_SA(b, h) (((b) * 2 + (h)) * HTB)
#define PG8_SB(b, h) ((4 + (b) * 2 + (h)) * HTB)
#define PG8_STAGE(bufoff, gbase, voff) do { _Pragma("unroll") for (int _i = 0; _i < 2; ++_i) \
        __builtin_amdgcn_global_load_lds((const unsigned*)((const char*)(gbase) + (voff)[_i]), (LAS unsigned*)(lds + (bufoff) + ldsw + _i * 8192), 16, 0, 0); } while (0)
#define PG8_LDA(dst, b, h) do { _Pragma("unroll") for (int m = 0; m < 4; ++m) _Pragma("unroll") for (int k = 0; k < 2; ++k) dst[m][k] = *(const LAS bf16x8*)(lds + PG8_SA(b, h) + aoff + m * 2048 + k * 1024); } while (0)
#define PG8_LDB(dst, b, h) do { _Pragma("unroll") for (int n = 0; n < 2; ++n) _Pragma("unroll") for (int k = 0; k < 2; ++k) dst[n][k] = *(const LAS bf16x8*)(lds + PG8_SB(b, h) + boff + n * 2048 + k * 1024); } while (0)
#define PG8_CAT8(x0, x1) cat8((x0), (x1))
#define PG8_MMA(ai, bj, At, Bt) do { __builtin_amdgcn_s_setprio(1); _Pragma("unroll") for (int m = 0; m < 4; ++m) _Pragma("unroll") for (int n = 0; n < 2; ++n) { \
        if constexpr (FP8) { const v8i_t b8_ = PG8_CAT8(Bt[n][0], Bt[n][1]), a8_ = PG8_CAT8(At[m][0], At[m][1]); \
            asm volatile("v_mfma_scale_f32_16x16x128_f8f6f4 %0, %1, %2, %0, %3, %3 op_sel_hi:[0,0,0]" : "+v"(acc[ai][bj][m][n]) : "v"(b8_), "v"(a8_), "v"(f8one)); } \
        else { _Pragma("unroll") for (int k = 0; k < 2; ++k) acc[ai][bj][m][n] = __builtin_amdgcn_mfma_f32_16x16x32_bf16(Bt[n][k], At[m][k], acc[ai][bj][m][n], 0, 0, 0); } } __builtin_amdgcn_s_setprio(0); } while (0)
#define PG8_WAIT_V(n) asm volatile("s_waitcnt vmcnt(" #n ")" ::: "memory")
#define PG8_WAIT_L(n) asm volatile("s_waitcnt lgkmcnt(" #n ")" ::: "memory")
#define PG8_BAR __builtin_amdgcn_s_barrier()
#define PG8_SCHED __builtin_amdgcn_sched_barrier(0)
    Unit cur, nxt; int ui = 0;
    if (!S.next(0, cur)) return;
    const int f8one = 0x7F7F7F7F;
    f32x4 acc[2][2][4][2];
#pragma unroll
    for (int a = 0; a < 2; ++a)
#pragma unroll
        for (int b = 0; b < 2; ++b)
#pragma unroll
            for (int m = 0; m < 4; ++m)
#pragma unroll
                for (int n = 0; n < 2; ++n) acc[a][b][m][n] = (f32x4){0.f, 0.f, 0.f, 0.f};
    bf16x8 At[4][2], B0[2][2], B1[2][2];
    const char* cA = (const char*)(cur.w ? g.A1 : g.A0) + (size_t)cur.pm * tstep; const char* cB = (const char*)(cur.w ? g.B1 : g.B0) + (size_t)cur.pn * tstep;
    PG8_STAGE(PG8_SB(0, 0), cB, voffB); PG8_STAGE(PG8_SB(0, 1), cB + hstep, voffB); PG8_STAGE(PG8_SA(0, 0), cA, voffA); PG8_STAGE(PG8_SA(0, 1), cA + hstep, voffA);
    if (wr == 1) PG8_BAR;
    PG8_WAIT_V(2); PG8_BAR;
    PG8_STAGE(PG8_SB(1, 0), cB + kstep, voffB); PG8_STAGE(PG8_SA(1, 0), cA + kstep, voffA); PG8_STAGE(PG8_SB(1, 1), cB + hstep + kstep, voffB);
    PG8_WAIT_V(6); PG8_BAR;
    for (;;) {
        const bool has_next = S.next(ui + 1, nxt);
        const char* nA = has_next ? (const char*)(nxt.w ? g.A1 : g.A0) + (size_t)nxt.pm * tstep : cA; const char* nB = has_next ? (const char*)(nxt.w ? g.B1 : g.B0) + (size_t)nxt.pn * tstep : cB;
        for (int t = 0; t < nt; t += 2) {
            const bool last = (t == nt - 2);
            const char* a1 = cA + (size_t)(t + 1) * kstep;
            const char* a2 = last ? nA : cA + (size_t)(t + 2) * kstep; const char* b2 = last ? nB : cB + (size_t)(t + 2) * kstep;
            const char* a3 = a2 + kstep; const char* b3 = b2 + kstep;
            PG8_LDB(B0, 0, 0); PG8_LDB(B1, 0, 1); PG8_SCHED; PG8_LDA(At, 0, 0); PG8_STAGE(PG8_SA(1, 1), a1 + hstep, voffA);
            PG8_WAIT_V(8); PG8_WAIT_L(0); PG8_BAR; PG8_MMA(0, 0, At, B0); PG8_MMA(0, 1, At, B1); PG8_BAR; PG8_SCHED;
            PG8_LDA(At, 0, 1); PG8_STAGE(PG8_SB(0, 0), b2, voffB); PG8_STAGE(PG8_SB(0, 1), b2 + hstep, voffB); PG8_STAGE(PG8_SA(0, 0), a2, voffA);
            PG8_WAIT_V(8); PG8_WAIT_L(0); PG8_BAR; PG8_MMA(1, 0, At, B0); PG8_MMA(1, 1, At, B1); PG8_BAR; PG8_SCHED;
            PG8_LDB(B0, 1, 0); PG8_LDB(B1, 1, 1); PG8_SCHED; PG8_LDA(At, 1, 0); PG8_STAGE(PG8_SA(0, 1), a2 + hstep, voffA);
            PG8_WAIT_V(8); PG8_WAIT_L(0); PG8_BAR; PG8_MMA(0, 0, At, B0); PG8_MMA(0, 1, At, B1); PG8_BAR; PG8_SCHED;
            PG8_LDA(At, 1, 1); PG8_STAGE(PG8_SB(1, 0), b3, voffB); PG8_STAGE(PG8_SB(1, 1), b3 + hstep, voffB); PG8_STAGE(PG8_SA(1, 0), a3, voffA);
            PG8_WAIT_V(8); PG8_WAIT_L(0); PG8_BAR; PG8_MMA(1, 0, At, B0); PG8_MMA(1, 1, At, B1); PG8_BAR; PG8_SCHED;
        }
        if constexpr (ALIGN_EPI) { if (wr == 0) PG8_BAR; }
        if constexpr (FP8) asm volatile("s_nop 15\n\ts_nop 15" ::: "memory");
        if constexpr (!Epi::AFTER_DRAIN) E(acc, cur, wr, wc, fr, fq);
        if (!has_next) break;
#pragma unroll
        for (int a = 0; a < 2; ++a)
#pragma unroll
            for (int b = 0; b < 2; ++b)
#pragma unroll
                for (int m = 0; m < 4; ++m)
#pragma unroll
                    for (int n = 0; n < 2; ++n) acc[a][b][m][n] = (f32x4){0.f, 0.f, 0.f, 0.f};
        cur = nxt; cA = nA; cB = nB; ++ui;
        if constexpr (ALIGN_EPI) { if (wr == 1) PG8_BAR; }
    }
    PG8_WAIT_V(0);
    if constexpr (!ALIGN_EPI) { if (wr == 0) PG8_BAR; }
    PG8_BAR;
    if constexpr (Epi::AFTER_DRAIN) E.fused(acc, cur, wr, wc, fr, fq, lds, wid, lane);
#undef PG8_SA
#undef PG8_SB
#undef PG8_STAGE
#undef PG8_LDA
#undef PG8_LDB
#undef PG8_MMA
#undef PG8_WAIT_V
#undef PG8_WAIT_L
#undef PG8_BAR
#undef PG8_SCHED
}

__device__ __forceinline__ int bid_of_row(int row) { return row < MP ? (row >> 11) : (NBP + ((row - MP) >> 3)); }

struct EpiSwiGLU {
    static constexpr bool PERM = true, AFTER_DRAIN = false;
    bf16_t* H; float inv;
    __device__ __forceinline__ void operator()(const f32x4 (&acc)[2][2][4][2], const Unit& u, int wr, int wc, int fr, int fq) const {
        const int row0 = u.pm * BM + wr * 64 + fr, hc0 = u.pn * 128 + wc * 32 + 8 * fq; const float inv_ = inv;
#pragma unroll
        for (int ai = 0; ai < 2; ++ai)
#pragma unroll
            for (int m = 0; m < 4; ++m) { const f32x4 a0 = acc[ai][0][m][0] * inv_, a1 = acc[ai][0][m][1] * inv_, b0 = acc[ai][1][m][0] * inv_, b1 = acc[ai][1][m][1] * inv_;
                u32x4 w; w.x = cvt_pk_bf16(siluf_(a0[0]) * b0[0], siluf_(a0[1]) * b0[1]); w.y = cvt_pk_bf16(siluf_(a0[2]) * b0[2], siluf_(a0[3]) * b0[3]);
                w.z = cvt_pk_bf16(siluf_(a1[0]) * b1[0], siluf_(a1[1]) * b1[1]); w.w = cvt_pk_bf16(siluf_(a1[2]) * b1[2], siluf_(a1[3]) * b1[3]);
                const int row = row0 + ai * HALF + m * 16;
                if (u.pm < MP / BM) *(u32x4*)(H + (size_t)row * DFF + hc0) = w;
                else *(u32x4*)(H + (size_t)MP * DFF + fo_index(row - MP, hc0, DFF)) = w; }
    }
};
struct EpiResid {
    static constexpr bool PERM = false, AFTER_DRAIN = false;
    const float* xin_p; const float* xin_s; float* out; const float* gmod; float coef;
    __device__ __forceinline__ void operator()(const f32x4 (&acc)[2][2][4][2], const Unit& u, int wr, int wc, int fr, int fq) const {
        const int row0 = u.pm * BM + wr * 64 + fr, col0 = u.pn * BM + wc * 32 + 4 * fq;
#pragma unroll
        for (int ai = 0; ai < 2; ++ai)
#pragma unroll
            for (int m = 0; m < 4; ++m) { const int row = row0 + ai * HALF + m * 16;
                const float* xr = (row < MP ? xin_p + (size_t)row * DM : xin_s + (size_t)(row - MP) * DM) + col0;
                const float* gr = gmod + (size_t)bid_of_row(row) * NMOD + col0; float* orow = out + (size_t)row * DM + col0;
#pragma unroll
                for (int bj = 0; bj < 2; ++bj)
#pragma unroll
                    for (int n = 0; n < 2; ++n) { const int o = bj * HALF + n * 16; const f32x4 xv = *(const f32x4*)(xr + o), gv = *(const f32x4*)(gr + o);
                        *(f32x4*)(orow + o) = xv + coef * gv * acc[ai][bj][m][n]; } }
    }
};

__device__ __forceinline__ void panel_wait(unsigned* cnt, unsigned need) {
    unsigned spins = 0;
    while ((unsigned)__builtin_amdgcn_readfirstlane(__hip_atomic_load(cnt, __ATOMIC_RELAXED, __HIP_MEMORY_SCOPE_AGENT)) < need) { if (++spins > (1u << 20)) break; __builtin_amdgcn_s_sleep(2); }
    __builtin_amdgcn_fence(__ATOMIC_ACQUIRE, "agent");
}
template <bool FINAL>
struct EpiResidNorm {
    static constexpr bool PERM = true, AFTER_DRAIN = true;
    const float* xin; float* Xout; const float* gmod; const float* gw; const float* shmod; const float* scmod; bf16_t* Uout; float* Yout; float* XS; unsigned* cnt; float coef; int pad_;
    __device__ __forceinline__ void fused(f32x4 (&acc)[2][2][4][2], const Unit& u, int wr, int wc, int fr, int fq, LAS unsigned char* lds, int wid, int lane) const {
        LAS float* P = (LAS float*)lds; LAS float* S = (LAS float*)(lds + 4096);
        const float* const xin_ = xin; float* const Xout_ = Xout; const float* const gmod_ = gmod; const float coef_ = coef; const float* const gw_ = gw; const float* const shmod_ = shmod; const float* const scmod_ = scmod;
        bf16_t* const Uout_ = Uout; float* const Yout_ = Yout; float* const XS_ = XS; unsigned* const cnt_ = cnt;
        const int b = u.pm >> 3, col0 = u.pn * BM + wc * 32 + 8 * fq, rowt = wr * 64 + fr;
        { f32x4 gv[2][2];
#pragma unroll
          for (int bj = 0; bj < 2; ++bj)
#pragma unroll
              for (int n = 0; n < 2; ++n) gv[bj][n] = coef_ * *(const f32x4*)(gmod_ + (size_t)b * NMOD + col0 + bj * HALF + n * 4);
#pragma unroll
          for (int ai = 0; ai < 2; ++ai)
#pragma unroll
              for (int m = 0; m < 4; ++m) { const int rt = rowt + ai * HALF + m * 16; const float* xr = xin_ + (size_t)(u.pm * BM + rt) * DM + col0; float ss = 0.f;
#pragma unroll
                  for (int bj = 0; bj < 2; ++bj)
#pragma unroll
                      for (int n = 0; n < 2; ++n) { const f32x4 x = *(const f32x4*)(xr + bj * HALF + n * 4) + gv[bj][n] * acc[ai][bj][m][n]; acc[ai][bj][m][n] = x; ss += (x[0] * x[0] + x[1] * x[1]) + (x[2] * x[2] + x[3] * x[3]); }
                  ss += __shfl_xor(ss, 16); ss += __shfl_xor(ss, 32);
                  if (fq == 0) P[rt * 4 + wc] = ss;
                  asm volatile("" ::: "memory"); } }
        __syncthreads();
        const int r32 = wid * 32 + (lane & 31); float* slot = XS_ + (size_t)(u.pm * BM + r32) * 16;
        if (lane < 32) { const f32x4 pp = *(const LAS f32x4*)(P + r32 * 4); __hip_atomic_store(slot + u.pn, (pp[0] + pp[1]) + (pp[2] + pp[3]), __ATOMIC_RELAXED, __HIP_MEMORY_SCOPE_AGENT); }
        asm volatile("s_waitcnt vmcnt(0)" ::: "memory");
        if (lane == 0) __hip_atomic_fetch_add(cnt_ + 64 * u.pm, 1u, __ATOMIC_RELAXED, __HIP_MEMORY_SCOPE_AGENT);
        if (wid == 0) panel_wait(cnt_ + 64 * u.pm, 32u);
        asm volatile("s_waitcnt vmcnt(0) lgkmcnt(0)" ::: "memory");
        __syncthreads();
        if (lane < 32) { float tot = 0.f;
#pragma unroll
            for (int t = 0; t < 4; ++t) tot += __hip_atomic_load(slot + t, __ATOMIC_RELAXED, __HIP_MEMORY_SCOPE_AGENT);
            S[r32] = 1.0f / sqrtf(tot * (1.0f / DM) + EPS); }
        __syncthreads();
        f32x4 fac[2][2], shv[2][2];
#pragma unroll
        for (int bj = 0; bj < 2; ++bj)
#pragma unroll
            for (int n = 0; n < 2; ++n) { const int c = col0 + bj * HALF + n * 4; fac[bj][n] = *(const f32x4*)(gw_ + c);
                if constexpr (!FINAL) { fac[bj][n] = fac[bj][n] * (1.0f + *(const f32x4*)(scmod_ + (size_t)b * NMOD + c)); shv[bj][n] = *(const f32x4*)(shmod_ + (size_t)b * NMOD + c); } }
#pragma unroll
        for (int ai = 0; ai < 2; ++ai)
#pragma unroll
            for (int m = 0; m < 4; ++m) { const int rt = rowt + ai * HALF + m * 16; const size_t off = (size_t)(u.pm * BM + rt) * DM + col0; const float r = S[rt];
#pragma unroll
                for (int bj = 0; bj < 2; ++bj) { const f32x4 x0 = acc[ai][bj][m][0], x1 = acc[ai][bj][m][1]; const int o = bj * HALF;
                    if constexpr (FINAL) { *(f32x4*)(Yout_ + off + o) = x0 * r * fac[bj][0]; *(f32x4*)(Yout_ + off + o + 4) = x1 * r * fac[bj][1]; }
                    else { *(f32x4*)(Xout_ + off + o) = x0; *(f32x4*)(Xout_ + off + o + 4) = x1;
                        const f32x4 y0 = x0 * r * fac[bj][0] + shv[bj][0], y1 = x1 * r * fac[bj][1] + shv[bj][1];
                        if (pad_) *(u32x2*)((unsigned char*)Uout_ + off + o) = (u32x2){pack4_fp8(y0[0], y0[1], y0[2], y0[3], F8_SA), pack4_fp8(y1[0], y1[1], y1[2], y1[3], F8_SA)};
                        else { const u32x2 w0 = pack4(y0), w1 = pack4(y1); *(u32x4*)(Uout_ + off + o) = (u32x4){w0.x, w0.y, w1.x, w1.y}; } } } }
    }
};
struct EpiZin {
    static constexpr bool PERM = true, AFTER_DRAIN = false;
    bf16_t* Z; float* gates;
    __device__ __forceinline__ void operator()(const f32x4 (&acc)[2][2][4][2], const Unit& u, int wr, int wc, int fr, int fq) const {
        const int row0 = u.pm * BM + wr * 64 + fr;
        {
            const int col0 = u.pn * BM + wc * 32 + 8 * fq;
#pragma unroll
            for (int ai = 0; ai < 2; ++ai)
#pragma unroll
                for (int m = 0; m < 4; ++m) { bf16_t* rp = Z + (size_t)(row0 + ai * HALF + m * 16) * ZP + col0;
#pragma unroll
                    for (int bj = 0; bj < 2; ++bj) { const f32x4 v0 = acc[ai][bj][m][0], v1 = acc[ai][bj][m][1];
                        u32x4 w; w.x = cvt_pk_bf16(v0[0], v0[1]); w.y = cvt_pk_bf16(v0[2], v0[3]); w.z = cvt_pk_bf16(v1[0], v1[1]); w.w = cvt_pk_bf16(v1[2], v1[3]);
                        *(u32x4*)(rp + bj * HALF) = w; } }
        }
    }
};
struct EpiMerge {
    static constexpr bool PERM = true, AFTER_DRAIN = false;
    const bf16_t* Z; float* tmp; bf16_t* U;
    __device__ __forceinline__ void operator()(const f32x4 (&acc)[2][2][4][2], const Unit& u, int wr, int wc, int fr, int fq) const {
        const int row0 = u.pm * BM + wr * 64 + fr, col0 = u.pn * BM + wc * 32 + 8 * fq;
        const int zoff = u.w ? ZGB : ZGA;
#pragma unroll
        for (int ai = 0; ai < 2; ++ai)
#pragma unroll
            for (int m = 0; m < 4; ++m) { const int row = row0 + ai * HALF + m * 16;
#pragma unroll
                for (int bj = 0; bj < 2; ++bj) { const int c = col0 + bj * HALF;
                    const u32x4 gz = *(const u32x4*)(Z + (size_t)row * ZP + zoff + c);
                    f32x4 s0, s1; s0[0] = sigmoidf_(bflo(gz.x)); s0[1] = sigmoidf_(bfhi(gz.x)); s0[2] = sigmoidf_(bflo(gz.y)); s0[3] = sigmoidf_(bfhi(gz.y));
                    s1[0] = sigmoidf_(bflo(gz.z)); s1[1] = sigmoidf_(bfhi(gz.z)); s1[2] = sigmoidf_(bflo(gz.w)); s1[3] = sigmoidf_(bfhi(gz.w));
                    f32x4 v0 = s0 * acc[ai][bj][m][0], v1 = s1 * acc[ai][bj][m][1];
                    u32x4* up = (u32x4*)(U + (size_t)row * DM + c);
                    if (u.w != 0) { const u32x4 pv = *up; v0[0] += bflo(pv.x); v0[1] += bfhi(pv.x); v0[2] += bflo(pv.y); v0[3] += bfhi(pv.y); v1[0] += bflo(pv.z); v1[1] += bfhi(pv.z); v1[2] += bflo(pv.w); v1[3] += bfhi(pv.w); }
                    u32x4 w; w.x = cvt_pk_bf16(v0[0], v0[1]); w.y = cvt_pk_bf16(v0[2], v0[3]); w.z = cvt_pk_bf16(v1[0], v1[1]); w.w = cvt_pk_bf16(v1[2], v1[3]);
                    *up = w; } }
    }
};
}


struct Frame {
    LAS unsigned char* lds;
    int tid, lane, wave, G, bx;
    float* out; unsigned char* ws;
};
constexpr int PTAB_OFF = 147072;
__device__ __forceinline__ const float* pin_ld(const Frame& F, const int k) {
    const volatile LAS unsigned* T = (const volatile LAS unsigned*)(F.lds + PTAB_OFF);
    const unsigned lo = (unsigned)__builtin_amdgcn_readfirstlane((int)T[2 * k]), hi = (unsigned)__builtin_amdgcn_readfirstlane((int)T[2 * k + 1]);
    return (const float*)(((uint64_t)hi << 32) | (uint64_t)lo);
}
#define PIN(k) pin_ld(F, (k))

template <int KTOT, bool FOA, bool FOB>
__device__ __forceinline__ void small_gemm_partials(LAS unsigned char* lds, const bf16_t* A, const bf16_t* Bt, int wave, int lane) {
    const int fr = lane & 15, fq = lane >> 4; constexpr int NKS = KTOT / 256; const int T0 = wave * NKS;
    const bf16_t* ap = A + (size_t)fr * KTOT + 8 * fq; const bf16_t* bp = Bt + (size_t)fr * KTOT + 8 * fq;
    f32x4 acc[4][4];
#pragma unroll
    for (int i = 0; i < 4; ++i)
#pragma unroll
        for (int j = 0; j < 4; ++j) acc[i][j] = (f32x4){0.f, 0.f, 0.f, 0.f};
    bf16x8 a[4][4], b[4][4];
#define SG_LOAD(slot, t) do { const int T_ = T0 + (t), ko_ = 32 * T_; _Pragma("unroll") for (int i = 0; i < 4; ++i) { \
        if constexpr (FOA) a[slot][i] = *(const bf16x8*)(A + ((size_t)(i * (KTOT / 32) + T_)) * 512 + 8 * lane); else a[slot][i] = *(const bf16x8*)(ap + (size_t)(16 * i) * KTOT + ko_); \
        if constexpr (FOB) b[slot][i] = *(const bf16x8*)(Bt + ((size_t)(i * (KTOT / 32) + T_)) * 512 + 8 * lane); else b[slot][i] = *(const bf16x8*)(bp + (size_t)(16 * i) * KTOT + ko_); } } while (0)
#pragma unroll
    for (int t = 0; t < 4 && t < NKS; ++t) SG_LOAD(t, t);
    __builtin_amdgcn_sched_barrier(0);
#pragma unroll
    for (int t = 0; t < NKS; ++t) {
#pragma unroll
        for (int tn = 0; tn < 4; ++tn)
#pragma unroll
            for (int tm = 0; tm < 4; ++tm) acc[tn][tm] = __builtin_amdgcn_mfma_f32_16x16x32_bf16(b[t & 3][tn], a[t & 3][tm], acc[tn][tm], 0, 0, 0);
        __builtin_amdgcn_sched_barrier(0);
        if (t + 4 < NKS) { SG_LOAD(t & 3, t + 4); __builtin_amdgcn_sched_barrier(0); } }
#undef SG_LOAD
    LAS f32x4* PART = (LAS f32x4*)lds;
#pragma unroll
    for (int tn = 0; tn < 4; ++tn)
#pragma unroll
        for (int tm = 0; tm < 4; ++tm) PART[(wave * 16 + tn * 4 + tm) * 64 + lane] = acc[tn][tm];
}
__device__ __forceinline__ f32x4 small_gemm_sum(LAS unsigned char* lds, int tid, int j) {
    const LAS f32x4* PART = (const LAS f32x4*)lds; const int tile = 8 * j + (tid >> 6), ln = tid & 63; f32x4 sum = PART[tile * 64 + ln];
#pragma unroll
    for (int wv = 1; wv < 8; ++wv) sum += PART[(wv * 16 + tile) * 64 + ln];
    return sum;
}
template <int KTOT>
__device__ __forceinline__ void small_phase_resid(Frame& F, const bf16_t* A, const bf16_t* Bt, const float* xin_s, float* out, const float* gmod, float coef) {
    for (int st = F.bx; st < 256; st += F.G) { const int x = st & 7, j = st >> 3, sm = 4 * (x >> 1) + (j >> 3), sn = 8 * (x & 1) + (j & 7);
        __syncthreads();
        small_gemm_partials<KTOT, true, true>(F.lds, A + (size_t)(MP + 64 * sm) * KTOT, Bt + (size_t)(64 * sn) * KTOT, F.wave, F.lane);
        __syncthreads();
#pragma unroll
        for (int j = 0; j < 2; ++j) { const f32x4 v = small_gemm_sum(F.lds, F.tid, j); const int tile = 8 * j + (F.tid >> 6), tn = tile >> 2, tm = tile & 3;
            const int ms = 64 * sm + 16 * tm + (F.lane & 15), n = 64 * sn + 16 * tn + 4 * (F.lane >> 4), row = MP + ms;
            const f32x4 xv = *(const f32x4*)(xin_s + (size_t)ms * DM + n), gv = *(const f32x4*)(gmod + (size_t)pg8::bid_of_row(row) * NMOD + n);
            *(f32x4*)(out + (size_t)row * DM + n) = xv + coef * gv * v; } }
}
template <int KTOT, bool FINAL>
__device__ __forceinline__ void small_phase_resid_norm(Frame& F, const bf16_t* A, const bf16_t* Bt, const float* xin_s, float* Xout, const float* gmod, float coef,
                                                       const float* gw, const float* shmod, const float* scmod, bf16_t* Uout, float* Yout, float* XS, unsigned* cnt) {
    LAS float* P2 = (LAS float*)(F.lds + 131072); LAS float* S2 = (LAS float*)(F.lds + 131072 + 512);
    for (int st = F.bx; st < 256; st += F.G) { const int x = st & 7, j0 = st >> 3, sm = 4 * (x >> 1) + (j0 >> 3), sn = 8 * (x & 1) + (j0 & 7);
        __syncthreads();
        small_gemm_partials<KTOT, true, true>(F.lds, A + (size_t)(MP + 64 * sm) * KTOT, Bt + (size_t)(64 * sn) * KTOT, F.wave, F.lane);
        __syncthreads();
        const int fr = F.lane & 15, fq = F.lane >> 4, tm = F.wave & 3, rl = 16 * tm + fr, ms = 64 * sm + rl, row = MP + ms, bid = NBP + (ms >> 3);
        f32x4 xn[2]; float ss = 0.f;
#pragma unroll
        for (int j = 0; j < 2; ++j) { const int n = 64 * sn + 16 * (2 * j + (F.wave >> 2)) + 4 * fq;
            const f32x4 x4 = *(const f32x4*)(xin_s + (size_t)ms * DM + n) + coef * *(const f32x4*)(gmod + (size_t)bid * NMOD + n) * small_gemm_sum(F.lds, F.tid, j);
            xn[j] = x4; ss += (x4[0] * x4[0] + x4[1] * x4[1]) + (x4[2] * x4[2] + x4[3] * x4[3]); }
        ss += __shfl_xor(ss, 16); ss += __shfl_xor(ss, 32);
        if (fq == 0) P2[(F.wave >> 2) * 64 + rl] = ss;
        __syncthreads();
        float* slot = XS + (size_t)(MP + 64 * sm + F.lane) * 16;
        if (F.wave == 0) { __hip_atomic_store(slot + sn, P2[F.lane] + P2[64 + F.lane], __ATOMIC_RELAXED, __HIP_MEMORY_SCOPE_AGENT);
            asm volatile("s_waitcnt vmcnt(0)" ::: "memory");
            if (F.lane == 0) __hip_atomic_fetch_add(cnt + 64 * (64 + sm), 1u, __ATOMIC_RELAXED, __HIP_MEMORY_SCOPE_AGENT);
            pg8::panel_wait(cnt + 64 * (64 + sm), 16u);
            float tot = 0.f;
#pragma unroll
            for (int t = 0; t < 16; ++t) tot += __hip_atomic_load(slot + t, __ATOMIC_RELAXED, __HIP_MEMORY_SCOPE_AGENT);
            S2[F.lane] = 1.0f / sqrtf(tot * (1.0f / DM) + EPS); }
        __syncthreads();
        const float r = S2[rl];
#pragma unroll
        for (int j = 0; j < 2; ++j) { const int n = 64 * sn + 16 * (2 * j + (F.wave >> 2)) + 4 * fq; const f32x4 g4 = *(const f32x4*)(gw + n);
            if constexpr (FINAL) *(f32x4*)(Yout + (size_t)row * DM + n) = xn[j] * r * g4;
            else { *(f32x4*)(Xout + (size_t)row * DM + n) = xn[j];
                const f32x4 yq = xn[j] * r * g4 * (1.0f + *(const f32x4*)(scmod + (size_t)bid * NMOD + n)) + *(const f32x4*)(shmod + (size_t)bid * NMOD + n);
                if constexpr (KTOT == DM) *(unsigned*)((unsigned char*)Uout + (size_t)row * DM + n) = pack4_fp8(yq[0], yq[1], yq[2], yq[3], F8_SA);
                else *(u32x2*)(Uout + (size_t)row * DM + n) = pack4(yq); } } }
}
__device__ __forceinline__ void small_gates_tile(Frame& F, const bf16_t* U, const bf16_t* Wg, float* gates, const int st) {
    {
        __syncthreads();
        small_gemm_partials<DM, false, true>(F.lds, U + (size_t)(64 * st) * DM, Wg, F.wave, F.lane);
        __syncthreads();
#pragma unroll
        for (int j = 0; j < 2; ++j) { const f32x4 v = small_gemm_sum(F.lds, F.tid, j); const int tile = 8 * j + (F.tid >> 6), tn = tile >> 2, tm = tile & 3;
            *(f32x4*)(gates + (size_t)(64 * st + 16 * tm + (F.lane & 15)) * 64 + 16 * tn + 4 * (F.lane >> 4)) = v; } }
}
__device__ __forceinline__ void small_phase_merge(Frame& F, const bf16_t* HA, const bf16_t* HB, const bf16_t* WA, const bf16_t* WB, const bf16_t* Z, bf16_t* U) {
    for (int st = F.bx; st < 256; st += F.G) { const int x = st & 7, j = st >> 3, sm = 4 * (x >> 1) + (j >> 3), sn = 8 * (x & 1) + (j & 7); f32x4 va[2], vb[2];
        __syncthreads();
        small_gemm_partials<2048, true, true>(F.lds, HA + (size_t)(MP + 64 * sm) * 2048, WA + (size_t)(64 * sn) * 2048, F.wave, F.lane);
        __syncthreads();
        va[0] = small_gemm_sum(F.lds, F.tid, 0); va[1] = small_gemm_sum(F.lds, F.tid, 1);
        __syncthreads();
        small_gemm_partials<2048, true, true>(F.lds, HB + (size_t)(MP + 64 * sm) * 2048, WB + (size_t)(64 * sn) * 2048, F.wave, F.lane);
        __syncthreads();
        vb[0] = small_gemm_sum(F.lds, F.tid, 0); vb[1] = small_gemm_sum(F.lds, F.tid, 1);
#pragma unroll
        for (int j = 0; j < 2; ++j) { const int tile = 8 * j + (F.tid >> 6), tn = tile >> 2, tm = tile & 3;
            const int row = MP + 64 * sm + 16 * tm + (F.lane & 15), n = 64 * sn + 16 * tn + 4 * (F.lane >> 4);
            const u32x2 ga = *(const u32x2*)(Z + (size_t)row * ZP + ZGA + n), gb = *(const u32x2*)(Z + (size_t)row * ZP + ZGB + n);
            f32x4 o; o[0] = sigmoidf_(bflo(ga.x)) * va[j][0] + sigmoidf_(bflo(gb.x)) * vb[j][0]; o[1] = sigmoidf_(bfhi(ga.x)) * va[j][1] + sigmoidf_(bfhi(gb.x)) * vb[j][1];
            o[2] = sigmoidf_(bflo(ga.y)) * va[j][2] + sigmoidf_(bflo(gb.y)) * vb[j][2]; o[3] = sigmoidf_(bfhi(ga.y)) * va[j][3] + sigmoidf_(bfhi(gb.y)) * vb[j][3];
            *(u32x2*)(U + (size_t)MP * DM + fo_index(row - MP, n, DM)) = pack4(o); } }
}

#define GAS __attribute__((address_space(1)))
#define XB_TMO      128
#define XB_XCNT(j)  (256  + 64 * (j))
#define XB_XSUB(j)  (1280 + 64 * (j))
#define XB_XGEN(j)  (2304 + 64 * (j))
#define XB_TOP      3328
#define XB_TOPGEN   3392
#define XCD_BAR_WORDS 3456
#define XB_SPIN_CAP (1u << 22)
__device__ __forceinline__ unsigned xb_ld(unsigned* p)              { return __hip_atomic_load(p, __ATOMIC_RELAXED, __HIP_MEMORY_SCOPE_AGENT); }
__device__ __forceinline__ unsigned xb_add(unsigned* p, unsigned v) { return __hip_atomic_fetch_add(p, v, __ATOMIC_RELAXED, __HIP_MEMORY_SCOPE_AGENT); }
__device__ __forceinline__ unsigned xb_xcc_id() { return (unsigned)__builtin_amdgcn_s_getreg((3 << 11) | 20) & 0xFu; }
#define XB_SPIN(cond, bar) do { unsigned _sp = 0; while (cond) { __builtin_amdgcn_s_sleep(1); \
    if ((++_sp & 255u) == 0u) { if (xb_ld(&(bar)[XB_TMO])) break; if (_sp > XB_SPIN_CAP) { atomicAdd(&(bar)[XB_TMO], 1u); break; } } } } while (0)
struct XcdBarrier { unsigned* bar; unsigned x; volatile LAS unsigned* st; };
__device__ __forceinline__ XcdBarrier xcd_barrier_post(unsigned* bar, volatile LAS unsigned* st) {
    XcdBarrier b; b.bar = bar; b.x = xb_xcc_id(); b.st = st;
    if (threadIdx.x == 0) (void)xb_add(&bar[XB_XCNT(b.x)], 1u);
    return b;
}
__device__ __forceinline__ void xcd_barrier_complete(unsigned* bar, unsigned x, unsigned& nloc, unsigned& nx) {
    const unsigned G = gridDim.x * gridDim.y * gridDim.z;
    unsigned sum, cnt, mine, sp = 0u;
    for (;;) {
        sum = 0u; cnt = 0u; mine = 0u;
#pragma unroll
        for (unsigned j = 0; j < 16; ++j) { const unsigned c = xb_ld(&bar[XB_XCNT(j)]); sum += c; cnt += (c > 0u) ? 1u : 0u; mine = (j == x) ? c : mine; }
        if (sum == G) break;
        __builtin_amdgcn_s_sleep(1);
        if ((++sp & 255u) == 0u) { if (xb_ld(&bar[XB_TMO])) break; if (sp > XB_SPIN_CAP) { atomicAdd(&bar[XB_TMO], 1u); break; } }
    }
    nloc = mine > 0u ? mine : 1u; nx = cnt > 0u ? cnt : 1u;
}
__device__ __forceinline__ void xcd_barrier(const XcdBarrier& b) {
    asm volatile("s_waitcnt vmcnt(0)" ::: "memory");
    __syncthreads();
    if (threadIdx.x == 0) {
        unsigned* bar = b.bar;
        __builtin_amdgcn_s_waitcnt(0);
        unsigned nloc = b.st[0], nx = b.st[1];
        if (nloc == 0u) { xcd_barrier_complete(bar, b.x, nloc, nx); b.st[0] = nloc; b.st[1] = nx; }
        const unsigned old = xb_add(&bar[XB_XSUB(b.x)], 1u);
        const unsigned gen = old / nloc;
        if (old + 1u == (gen + 1u) * nloc) {
            __builtin_amdgcn_fence(__ATOMIC_RELEASE, "agent");
            asm volatile("s_waitcnt vmcnt(0)" ::: "memory");
            const unsigned og = xb_add(&bar[XB_TOP], 1u);
            const unsigned tg = og / nx;
            if (og + 1u == (tg + 1u) * nx) xb_add(&bar[XB_TOPGEN], 1u);
            else XB_SPIN(xb_ld(&bar[XB_TOPGEN]) == tg, bar);
            __builtin_amdgcn_fence(__ATOMIC_ACQUIRE, "agent");
            xb_add(&bar[XB_XGEN(b.x)], 1u);
            asm volatile("s_waitcnt vmcnt(0)" ::: "memory");
        } else {
            XB_SPIN(xb_ld(&bar[XB_XGEN(b.x)]) == gen, bar);
            __builtin_amdgcn_fence(__ATOMIC_ACQUIRE, "agent");
            asm volatile("s_waitcnt vmcnt(0)" ::: "memory");
        }
    }
    __syncthreads();
}


template <class SrcFn>
__device__ __forceinline__ void transpose_item(const SrcFn& src, int K, bf16_t* WT, LAS float* scr, int item, int lane, int nblk, bf16_t* WF = nullptr, int fo_row0 = 0) {
    const int kb = item / nblk, nb = item % nblk, k0 = 64 * kb, n0 = 32 * nb;
    const size_t stride = (size_t)src.stride(); const float* colp = src(n0 + (lane & 31));
    float tv[32];
#pragma unroll
    for (int i = 0; i < 32; ++i) { const int kk = 2 * i + (lane >> 5); tv[i] = colp ? colp[(size_t)(k0 + kk) * stride] : 0.f; }
#pragma unroll
    for (int i = 0; i < 32; ++i) { const int kk = 2 * i + (lane >> 5); scr[kk * 33 + (lane & 31)] = tv[i]; }
    asm volatile("s_waitcnt lgkmcnt(0)" ::: "memory");
    const int c = lane & 7;
#pragma unroll
    for (int j = 0; j < 4; ++j) { const int n = (lane >> 3) + 8 * j; const LAS float* s = scr + (8 * c) * 33 + n;
        if constexpr (SrcFn::F8) { *(u32x2*)((unsigned char*)WT + (size_t)(n0 + n) * K + k0 + 8 * c) = (u32x2){pack4_fp8(s[0 * 33], s[1 * 33], s[2 * 33], s[3 * 33], F8_SW), pack4_fp8(s[4 * 33], s[5 * 33], s[6 * 33], s[7 * 33], F8_SW)}; continue; }
        u32x4 o; o.x = cvt_pk_bf16(s[0 * 33], s[1 * 33]); o.y = cvt_pk_bf16(s[2 * 33], s[3 * 33]); o.z = cvt_pk_bf16(s[4 * 33], s[5 * 33]); o.w = cvt_pk_bf16(s[6 * 33], s[7 * 33]);
        *(u32x4*)(WT + (size_t)(n0 + n) * K + k0 + 8 * c) = o;
        if (WF != nullptr && n0 >= fo_row0) *(u32x4*)(WF + fo_index(n0 + n - fo_row0, k0 + 8 * c, K)) = o; }
    asm volatile("s_waitcnt lgkmcnt(0)" ::: "memory");
}
struct SrcPlain { static constexpr bool F8 = false; const float* W; int N; __device__ __forceinline__ int stride() const { return N; } __device__ __forceinline__ const float* operator()(int n) const { return W + n; } };
struct SrcUp { static constexpr bool F8 = true; const float* W1; const float* W3; __device__ __forceinline__ int stride() const { return DFF; } __device__ __forceinline__ const float* operator()(int n) const { const int T = n >> 8, i = n & 255; const uintptr_t a = (uintptr_t)W1, b = (uintptr_t)W3, msk = (uintptr_t)0 - (uintptr_t)(i >> 7);
        return (const float*)((a & ~msk) | (b & msk)) + 128 * T + (i & 127); } };
struct SrcWin { static constexpr bool F8 = false; const float* W; __device__ __forceinline__ int stride() const { return 13352; } __device__ __forceinline__ const float* operator()(int r) const { int o;
        if (r < 6144) o = r; else if (r < 8192) o = 6152 + (r - 6144); else if (r < 11264) o = 8200 + (r - 8192); else if (r < 13312) o = 11304 + (r - 11264);
        else if (r < 13320) o = 6144 + (r - 13312); else if (r < 13352) o = 11272 + (r - 13320); else return nullptr;
        return W + o; } };

template <int PPART>
__device__ __forceinline__ void phase_prep(Frame& F, const Params& p) {
    LAS float* scr = (LAS float*)(F.lds + F.wave * 16384);
    const int gw = (PPART == 0 ? F.bx : F.bx - 192) * 8 + F.wave, NGW = (PPART == 0 ? F.G : 64) * 8;
    bf16_t* wup1 = (bf16_t*)(F.ws + WS_WUP1); bf16_t* wdn1 = (bf16_t*)(F.ws + WS_WDN1); bf16_t* wup2 = (bf16_t*)(F.ws + WS_WUP2); bf16_t* wdn2 = (bf16_t*)(F.ws + WS_WDN2);
    bf16_t* win = (bf16_t*)(F.ws + WS_WIN); bf16_t* wpa = (bf16_t*)(F.ws + WS_WPA); bf16_t* wpb = (bf16_t*)(F.ws + WS_WPB); bf16_t* wout = (bf16_t*)(F.ws + WS_WOUT);
    constexpr int I_UP = (DM / 64) * (2 * DFF / 32), I_DN = (DFF / 64) * (DM / 32), I_IN = (DM / 64) * (ZP / 32), I_P = (2048 / 64) * (DM / 32), I_O = (DM / 64) * (DM / 32);
    constexpr int NITEMS = 2 * I_UP + 2 * I_DN + I_IN + 2 * I_P + I_O;
    for (int it = (PPART == 0 ? 0 : I_UP) + gw; it < (PPART == 0 ? I_UP : NITEMS); it += NGW) {
        int r = it;
        if (r < I_UP) { transpose_item(SrcUp{PIN(13), PIN(14)}, DM, wup1, scr, r, F.lane, 2 * DFF / 32); continue; } r -= I_UP;
        if (r < I_UP) { transpose_item(SrcUp{PIN(32), PIN(33)}, DM, wup2, scr, r, F.lane, 2 * DFF / 32); continue; } r -= I_UP;
        if (r < I_DN) { transpose_item(SrcPlain{PIN(15), DM}, DFF, wdn1, scr, r, F.lane, DM / 32, (bf16_t*)(F.ws + WS_FDN1)); continue; } r -= I_DN;
        if (r < I_DN) { transpose_item(SrcPlain{PIN(34), DM}, DFF, wdn2, scr, r, F.lane, DM / 32, (bf16_t*)(F.ws + WS_FDN2)); continue; } r -= I_DN;
        if (r < I_IN) { transpose_item(SrcWin{PIN(17)}, DM, win, scr, r, F.lane, ZP / 32, (bf16_t*)(F.ws + WS_FG), ZG); continue; } r -= I_IN;
        if (r < I_P) { transpose_item(SrcPlain{PIN(22), DM}, 2048, wpa, scr, r, F.lane, DM / 32, (bf16_t*)(F.ws + WS_FPA)); continue; } r -= I_P;
        if (r < I_P) { transpose_item(SrcPlain{PIN(29), DM}, 2048, wpb, scr, r, F.lane, DM / 32, (bf16_t*)(F.ws + WS_FPB)); continue; } r -= I_P;
        transpose_item(SrcPlain{PIN(30), DM}, DM, wout, scr, r, F.lane, DM / 32, (bf16_t*)(F.ws + WS_FOUT));
    }
    __syncthreads();
}
__device__ __forceinline__ void phase_silu_c(Frame& F, const Params& p) {
    const int ch = F.bx * NTHREADS + F.tid;
    if (ch < 144 * 128) { const int r = ch >> 7, k = 8 * (ch & 127); float x[8];
        if (r < NBID) { const float* cr = (r < NBP ? PIN(2) + (size_t)r * DM : PIN(3) + (size_t)(r - NBP) * DM) + k; const f32x4 c0 = *(const f32x4*)cr, c1 = *(const f32x4*)(cr + 4);
#pragma unroll
            for (int e = 0; e < 4; ++e) { x[e] = siluf_(c0[e]); x[4 + e] = siluf_(c1[e]); } }
        else {
#pragma unroll
            for (int e = 0; e < 8; ++e) x[e] = 0.f; }
        *(u32x4*)((bf16_t*)(F.ws + WS_SC) + fo_index(r, k, DM)) = pack8(x, 1.0f); }
}
__device__ __forceinline__ void phase_adaln(Frame& F, const Params& p) {
    const float* ada_w = PIN(10); const float* ada_b = PIN(11); float* mod = (float*)(F.ws + WS_MOD); const bf16_t* SCF = (const bf16_t*)(F.ws + WS_SC);
    LAS f32x4* PART = (LAS f32x4*)F.lds;
    const int lane = F.lane, w = F.wave, fr = lane & 15, fq = lane >> 4;
    const int t0 = F.bx < 64 ? 3 * F.bx : 192 + 2 * (F.bx - 64), nT = F.bx < 64 ? 3 : 2;
    f32x4 acc[3][9];
#pragma unroll
    for (int t = 0; t < 3; ++t)
#pragma unroll
        for (int rt = 0; rt < 9; ++rt) acc[t][rt] = (f32x4){0.f, 0.f, 0.f, 0.f};
#pragma unroll 1
    for (int ks = 0; ks < 4; ++ks) {
        const int k0 = 128 * w + 32 * ks + 8 * fq, kb = 4 * w + ks;
        bf16x8 af[9];
#pragma unroll
        for (int rt = 0; rt < 9; ++rt) af[rt] = *(const bf16x8*)(SCF + ((size_t)(rt * (DM / 32) + kb)) * 512 + 8 * lane);
#pragma unroll
        for (int t = 0; t < 3; ++t) if (t < nT) {
            float wv[8];
#pragma unroll
            for (int j = 0; j < 8; ++j) wv[j] = ada_w[(size_t)(k0 + j) * NMOD + 16 * (t0 + t) + fr];
            bf16x8 bfr; { const u32x4 tt = pack8(wv, 1.0f); bfr = __builtin_bit_cast(bf16x8, tt); }
#pragma unroll
            for (int rt = 0; rt < 9; ++rt) acc[t][rt] = __builtin_amdgcn_mfma_f32_16x16x32_bf16(af[rt], bfr, acc[t][rt], 0, 0, 0); }
    }
#pragma unroll
    for (int t = 0; t < 3; ++t) if (t < nT) {
        __syncthreads();
#pragma unroll
        for (int rt = 0; rt < 9; ++rt) PART[(w * 9 + rt) * 64 + lane] = acc[t][rt];
        __syncthreads();
        for (int idx = F.tid; idx < 9 * 64; idx += NTHREADS) { const int rt = idx >> 6, ln = idx & 63; f32x4 sum = PART[rt * 64 + ln];
#pragma unroll
            for (int ww = 1; ww < 8; ++ww) sum += PART[(ww * 9 + rt) * 64 + ln];
            const int n = 16 * (t0 + t) + (ln & 15); const float bv = ada_b[n];
#pragma unroll
            for (int r = 0; r < 4; ++r) { const int row = 16 * rt + 4 * (ln >> 4) + r; if (row < NBID) mod[(size_t)row * NMOD + n] = sum[r] + bv; } } }
}

__device__ __forceinline__ void phase_norm_mod(Frame& F, const float* xp, const float* xs, const float* gw, int shoff, int scoff, bf16_t* U) {
    const float* mod = (const float*)(F.ws + WS_MOD);
    const int gwv = F.bx * 8 + F.wave, NGW = F.G * 8;
    f32x4 g[4];
#pragma unroll
    for (int j = 0; j < 4; ++j) g[j] = *(const f32x4*)(gw + 4 * F.lane + 256 * j);
    for (int m = gwv; m < MT; m += NGW) {
        const float* xr = m < MP ? xp + (size_t)m * DM : xs + (size_t)(m - MP) * DM;
        const float* mr = mod + (size_t)pg8::bid_of_row(m) * NMOD;
        f32x4 v[4]; float s = 0.f;
#pragma unroll
        for (int j = 0; j < 4; ++j) { v[j] = *(const f32x4*)(xr + 4 * F.lane + 256 * j); s += (v[j][0] * v[j][0] + v[j][1] * v[j][1]) + (v[j][2] * v[j][2] + v[j][3] * v[j][3]); }
        const float r = 1.0f / sqrtf(wave_sum(s) * (1.0f / DM) + EPS);
#pragma unroll
        for (int j = 0; j < 4; ++j) { const f32x4 sh = *(const f32x4*)(mr + shoff + 4 * F.lane + 256 * j), scv = *(const f32x4*)(mr + scoff + 4 * F.lane + 256 * j);
            const f32x4 o = (v[j] * r * g[j]) * (1.0f + scv) + sh;
            *(unsigned*)((unsigned char*)U + (size_t)m * DM + 4 * F.lane + 256 * j) = pack4_fp8(o[0], o[1], o[2], o[3], F8_SA); }
    }
}
__device__ __forceinline__ void phase_final_norm(Frame& F, float* Y, const float* gw) {
    const int gwv = F.bx * 8 + F.wave, NGW = F.G * 8;
    f32x4 g[4];
#pragma unroll
    for (int j = 0; j < 4; ++j) g[j] = *(const f32x4*)(gw + 4 * F.lane + 256 * j);
    for (int m = gwv; m < MT; m += NGW) {
        float* xr = Y + (size_t)m * DM;
        f32x4 v[4]; float s = 0.f;
#pragma unroll
        for (int j = 0; j < 4; ++j) { v[j] = *(const f32x4*)(xr + 4 * F.lane + 256 * j); s += (v[j][0] * v[j][0] + v[j][1] * v[j][1]) + (v[j][2] * v[j][2] + v[j][3] * v[j][3]); }
        const float r = 1.0f / sqrtf(wave_sum(s) * (1.0f / DM) + EPS);
#pragma unroll
        for (int j = 0; j < 4; ++j) *(f32x4*)(xr + 4 * F.lane + 256 * j) = v[j] * r * g[j];
    }
}

constexpr size_t O_Y = 0, O_PC = 17825792, O_PN = 22020096, O_PM = 22028288, O_PMC = 22028320, O_PSSM = 22077472, O_PSC = 24174624,
                 O_SC = 24248352, O_SN = 91357216, O_SM = 91488288, O_SMC = 91488800, O_SSSM = 92275232, O_SSC = 125829664, O_END = 127009312;
constexpr int CVP = 5120;

__device__ __forceinline__ bf16x8 frag_row(LAS unsigned char* base, int stride, int row0, int k0, int lane) {
    return *(const LAS bf16x8*)(base + (row0 + (lane & 15)) * stride + (k0 + 8 * (lane >> 4)) * 2);
}
__device__ __forceinline__ bf16x8 frag_tr(LAS unsigned char* base, int stride, int krow0, int col0, int lane) {
    const int g = lane >> 4, q = (lane & 15) >> 2, pp = lane & 3;
    LAS unsigned char* a = base + (krow0 + 8 * g + q) * stride + (col0 + 4 * pp) * 2;
    const s16x4 lo = __builtin_amdgcn_ds_read_tr16_b64_v4i16((LAS s16x4*)a);
    const s16x4 hi = __builtin_amdgcn_ds_read_tr16_b64_v4i16((LAS s16x4*)(a + 4 * stride));
    return (bf16x8){lo.x, lo.y, lo.z, lo.w, hi.x, hi.y, hi.z, hi.w};
}
#define MFMA16(a, b, c) __builtin_amdgcn_mfma_f32_16x16x32_bf16((a), (b), (c), 0, 0, 0)

__device__ __forceinline__ float fast_log1pexp_neg(float ax) { return __builtin_amdgcn_logf(1.0f + fast_exp(-ax)) * 0.6931471805599453f; }
__device__ __forceinline__ float logsigmoidf_(float x) { return fminf(x, 0.f) - log1pf(expf(-fabsf(x))); }
__device__ __forceinline__ float softplusf_(float x) { return fmaxf(x, 0.f) + log1pf(expf(-fabsf(x))); }

__device__ __forceinline__ void conv_item(Frame& F, const Params& p, const int it) {
    const bf16_t* Z = (const bf16_t*)(F.ws + WS_ZIN); bf16_t* CV = (bf16_t*)(F.ws + WS_CV);
    const int lane = F.lane;
    {
        int m0, tb, nrows, strip; const float* hist = nullptr;
        if (it < 5120) { const int b = it / 640, r = it % 640; strip = r % 10; tb = (r / 10) * 32; m0 = b * SEQ; nrows = 32; }
        else { const int j = it - 5120, bs = j / 10; strip = j % 10; tb = 0; m0 = MP + bs * TS; nrows = 8; hist = strip < 4 ? PIN(7) + (size_t)bs * 3 * 2048 : PIN(9) + (size_t)bs * 3 * 3072; }
        const bool isM = strip < 4;
        const int c = strip * 512 + 8 * lane, zc = isM ? c : ZX + (c - 2048), cc = isM ? c : c - 2048, cs = isM ? 2048 : 3072;
        const float* cw = isM ? PIN(18) : PIN(23); const float* cb = isM ? PIN(19) : PIN(24);
        const float scl = (strip == 2 || strip == 3) ? 0.0625f : 1.0f;
        float w[4][8], bb[8], x0[8], x1[8], x2[8];
#pragma unroll
        for (int j = 0; j < 4; ++j) { const f32x4 a = *(const f32x4*)(cw + (size_t)j * cs + cc), b = *(const f32x4*)(cw + (size_t)j * cs + cc + 4);
#pragma unroll
            for (int e = 0; e < 4; ++e) { w[j][e] = a[e]; w[j][4 + e] = b[e]; } }
        { const f32x4 a = *(const f32x4*)(cb + cc), b = *(const f32x4*)(cb + cc + 4);
#pragma unroll
            for (int e = 0; e < 4; ++e) { bb[e] = a[e]; bb[4 + e] = b[e]; } }
        if (tb > 0) { unpack8(*(const u32x4*)(Z + (size_t)(m0 + tb - 3) * ZP + zc), x0); unpack8(*(const u32x4*)(Z + (size_t)(m0 + tb - 2) * ZP + zc), x1); unpack8(*(const u32x4*)(Z + (size_t)(m0 + tb - 1) * ZP + zc), x2); }
        else if (hist != nullptr) {
#pragma unroll
            for (int e = 0; e < 8; ++e) { x0[e] = hist[cc + e]; x1[e] = hist[cs + cc + e]; x2[e] = hist[2 * cs + cc + e]; } }
        else {
#pragma unroll
            for (int e = 0; e < 8; ++e) { x0[e] = 0.f; x1[e] = 0.f; x2[e] = 0.f; } }
        for (int t = 0; t < nrows; t += 8) {
            u32x4 raw[8];
#pragma unroll
            for (int i = 0; i < 8; ++i) raw[i] = *(const u32x4*)(Z + (size_t)(m0 + tb + t + i) * ZP + zc);
#pragma unroll
            for (int i = 0; i < 8; ++i) { float x3[8], o[8]; unpack8(raw[i], x3);
#pragma unroll
                for (int e = 0; e < 8; ++e) { o[e] = siluf_(bb[e] + w[0][e] * x0[e] + w[1][e] * x1[e] + w[2][e] * x2[e] + w[3][e] * x3[e]); x0[e] = x1[e]; x1[e] = x2[e]; x2[e] = x3[e]; }
                *(u32x4*)(CV + (size_t)(m0 + tb + t + i) * CVP + c) = pack8(o, scl); }
        }
    }
}
constexpr int NS_EARLY = 64;
__device__ __forceinline__ void phase_conv(Frame& F, const Params& p) {
    const int gw = F.bx * 8 + F.wave, NGW = F.G * 8;
    for (int it = gw; it < 5120 + 1280 - 10 * NS_EARLY; it += NGW) conv_item(F, p, it < 5120 ? it : it + 10 * NS_EARLY);
}

constexpr int QSTR = 528, VSTR = 144;
constexpr int L_QS = 0, L_KS = 33792, L_CT = 67584, L_VS = 101376, L_VW = 110592, L_SB = 119808, L_SCAL = 129024, L_NST = 132096, L_QNP = 133120, L_DENP = 135168, L_NUMB = 135680;

__device__ __forceinline__ float mlstm_scan(float ipre, float fpre, int lane, float mstate, LAS float* sc) {
    const float lf = fminf(fpre, 0.f) - fast_log1pexp_neg(fabsf(fpre));
    const float b = wave_scan_add(lf);
    const float a = ipre - b;
    const float cm = wave_scan_max(a);
    const float A = fmaxf(mstate, cm);
    const float Alast = __shfl(A, 63), blast = __shfl(b, 63);
    sc[lane] = a; sc[64 + lane] = A; sc[128 + lane] = fast_exp(mstate - A); sc[192 + lane] = fast_exp(-(b + A)); sc[256 + lane] = fast_exp(a - Alast);
    if (lane == 0) sc[320] = fast_exp(mstate - Alast);
    return blast + Alast;
}

__device__ __forceinline__ void mlstm_prompt_item(Frame& F, const Params& p, const int b, const int h, const int vs) {
    LAS unsigned char* L = F.lds;
    const int tid = F.tid, lane = F.lane, w = F.wave, fr = lane & 15, fq = lane >> 4;
    const bf16_t* Z = (const bf16_t*)(F.ws + WS_ZIN); const bf16_t* CV = (const bf16_t*)(F.ws + WS_CV); const float* GT = (const float*)(F.ws + WS_GATES);
    bf16_t* NUM = (bf16_t*)(F.ws + WS_NUM); float* DEN = (float*)(F.ws + WS_DEN);
    const float ifbi = PIN(20)[h], ifbf = PIN(20)[4 + h];
    constexpr int nch = SEQ / 64; const int m0 = b * SEQ;
    LAS float* SC = (LAS float*)(L + L_SCAL); LAS unsigned char* NSTB = L + L_NST; LAS float* DENP = (LAS float*)(L + L_DENP);
    f32x4 cacc[2][4];
#pragma unroll
    for (int dt = 0; dt < 2; ++dt)
#pragma unroll
        for (int vi = 0; vi < 4; ++vi) cacc[dt][vi] = (f32x4){0.f, 0.f, 0.f, 0.f};
    f32x4 nacc[2] = {{0.f, 0.f, 0.f, 0.f}, {0.f, 0.f, 0.f, 0.f}};
    float mstate = 0.f;
    u32x4 pq[4], pk[4], pv; float gi = 0.f, gf = 0.f;
    const bf16_t* qsrc = CV + (size_t)(m0 + (tid >> 5)) * CVP + h * 256 + 8 * (tid & 31);
    const bf16_t* vsrc = Z + (size_t)(m0 + (tid >> 3)) * ZP + ZV + h * 512 + vs * 64 + 8 * (tid & 7);
    const float* gsrc = GT + (size_t)(m0 + lane) * 64 + h;
#define ML_LOAD(c) do { _Pragma("unroll") for (int i = 0; i < 4; ++i) { pq[i] = *(const u32x4*)(qsrc + (size_t)((c) * 64 + 16 * i) * CVP); pk[i] = *(const u32x4*)(qsrc + (size_t)((c) * 64 + 16 * i) * CVP + 1024); } \
        pv = *(const u32x4*)(vsrc + (size_t)((c) * 64) * ZP); if (w == 0) { gi = gsrc[(size_t)((c) * 64) * 64]; gf = gsrc[(size_t)((c) * 64) * 64 + 4]; } } while (0)
    u32x4 numst = {0u, 0u, 0u, 0u}; float denst = 0.f;
    bf16_t* numdst = NUM + (size_t)(m0 + (tid >> 3)) * 2048 + h * 512 + vs * 64 + 8 * (tid & 7);
#define ML_STORE(c) do { *(u32x4*)(numdst + (size_t)((c) * 64) * 2048) = numst; \
        if (vs == 0 && w < 4 && fq == 0) DEN[(size_t)(m0 + (c) * 64 + 16 * w + fr) * 4 + h] = denst; } while (0)
    ML_LOAD(0);
    __syncthreads();
#pragma unroll
    for (int dt = 0; dt < 2; ++dt)
#pragma unroll
        for (int vi = 0; vi < 4; ++vi) *(LAS u32x2*)(L + L_CT + (16 * vi + fr) * QSTR + (32 * w + 16 * dt + 4 * fq) * 2) = (u32x2){0u, 0u};
    if (tid < 128) *(LAS unsigned*)(NSTB + 4 * tid) = 0u;
    if (w == 0) mstate = mlstm_scan(gi + ifbi, gf + ifbf, lane, mstate, SC);
    __syncthreads();
    for (int c = 0; c < nch; ++c) {
        const int t0 = 64 * c; LAS float* sc = SC + (c & 1) * 384;
#pragma unroll
        for (int i = 0; i < 4; ++i) { const int v = tid + NTHREADS * i, row = v >> 5, c16 = v & 31; *(LAS u32x4*)(L + L_QS + row * QSTR + 16 * c16) = pq[i]; *(LAS u32x4*)(L + L_KS + row * QSTR + 16 * c16) = pk[i]; }
        { const int row = tid >> 3, c8 = tid & 7; *(LAS u32x4*)(L + L_VS + row * VSTR + 16 * c8) = pv; float x[8]; unpack8(pv, x); *(LAS u32x4*)(L + L_VW + row * VSTR + 16 * c8) = pack8(x, sc[256 + row]); }
        __syncthreads();
        if (c > 0) { ML_STORE(c - 1); }
        if (c + 1 < nch) ML_LOAD(c + 1);
        const int ti = w & 3, hf = w >> 2;
        bf16x8 qf[8];
#pragma unroll
        for (int k = 0; k < 8; ++k) qf[k] = frag_row(L + L_QS, QSTR, 16 * ti, 32 * k, lane);
        { f32x4 sacc[2] = {{0.f, 0.f, 0.f, 0.f}, {0.f, 0.f, 0.f, 0.f}};
#pragma unroll
          for (int j = 0; j < 2; ++j) { const int si = 2 * hf + j; if (si <= ti) {
#pragma unroll
                  for (int k = 0; k < 8; ++k) sacc[j] = MFMA16(frag_row(L + L_KS, QSTR, 16 * si, 32 * k, lane), qf[k], sacc[j]); } }
          const int t = 16 * ti + fr; const float At = sc[64 + t]; float dpart = 0.f;
#pragma unroll
          for (int j = 0; j < 2; ++j) { const int si = 2 * hf + j, s0 = 16 * si + 4 * fq; const f32x4 av = *(const LAS f32x4*)(sc + s0); f32x4 vv;
#pragma unroll
              for (int r = 0; r < 4; ++r) { const float wgt = (s0 + r <= t) ? fast_exp(av[r] - At) : 0.f; vv[r] = (si <= ti) ? sacc[j][r] * wgt : 0.f; dpart += vv[r]; }
              *(LAS u32x2*)(L + L_SB + t * VSTR + s0 * 2) = pack4(vv); }
          dpart += __shfl_xor(dpart, 16); dpart += __shfl_xor(dpart, 32);
          if (lane < 16) DENP[hf * 64 + 16 * ti + lane] = dpart; }
        __syncthreads();
        { f32x4 uacc[2] = {{0.f, 0.f, 0.f, 0.f}, {0.f, 0.f, 0.f, 0.f}};
#pragma unroll
          for (int j = 0; j < 2; ++j) { const int vi = 2 * hf + j;
#pragma unroll
              for (int k = 0; k < 8; ++k) uacc[j] = MFMA16(frag_row(L + L_CT, QSTR, 16 * vi, 32 * k, lane), qf[k], uacc[j]); }
          const float wst = sc[128 + 16 * ti + fr]; uacc[0] *= wst; uacc[1] *= wst;
#pragma unroll
          for (int ks = 0; ks < 2; ++ks) if (32 * ks <= 16 * ti + 15) { const bf16x8 sb = frag_row(L + L_SB, VSTR, 16 * ti, 32 * ks, lane);
#pragma unroll
              for (int j = 0; j < 2; ++j) uacc[j] = MFMA16(frag_tr(L + L_VS, VSTR, 32 * ks, 16 * (2 * hf + j), lane), sb, uacc[j]); }
#pragma unroll
          for (int j = 0; j < 2; ++j) *(LAS u32x2*)(L + L_NUMB + (16 * ti + fr) * VSTR + (16 * (2 * hf + j) + 4 * fq) * 2) = pack4(uacc[j]); }
        if (vs == 0 && hf == 0) {
            f32x4 qn = {0.f, 0.f, 0.f, 0.f};
#pragma unroll
            for (int k = 0; k < 8; ++k) { u32x4 nv = *(const LAS u32x4*)(NSTB + 64 * k + 16 * fq); if (fr != 0) nv = (u32x4){0u, 0u, 0u, 0u};
                qn = MFMA16(__builtin_bit_cast(bf16x8, nv), qf[k], qn); }
            const int t = 16 * ti + fr; const float den = DENP[t] + DENP[64 + t] + sc[128 + t] * qn[0];
            denst = fmaxf(fabsf(den), sc[192 + t]); }
        { const float decay = sc[320];
#pragma unroll
          for (int dt = 0; dt < 2; ++dt)
#pragma unroll
              for (int vi = 0; vi < 4; ++vi) cacc[dt][vi] *= decay;
#pragma unroll
          for (int ks = 0; ks < 2; ++ks) { bf16x8 ka[2];
#pragma unroll
              for (int dt = 0; dt < 2; ++dt) ka[dt] = frag_tr(L + L_KS, QSTR, 32 * ks, 32 * w + 16 * dt, lane);
#pragma unroll
              for (int vi = 0; vi < 4; ++vi) { const bf16x8 vb = frag_tr(L + L_VW, VSTR, 32 * ks, 16 * vi, lane);
#pragma unroll
                  for (int dt = 0; dt < 2; ++dt) cacc[dt][vi] = MFMA16(ka[dt], vb, cacc[dt][vi]); } }
          if (vs == 0) { nacc[0] *= decay; nacc[1] *= decay;
#pragma unroll
              for (int ks = 0; ks < 2; ++ks) { const f32x4 w0 = *(const LAS f32x4*)(sc + 256 + 32 * ks + 8 * fq), w1 = *(const LAS f32x4*)(sc + 256 + 32 * ks + 8 * fq + 4);
                  u32x4 wv; wv.x = cvt_pk_bf16(w0[0], w0[1]); wv.y = cvt_pk_bf16(w0[2], w0[3]); wv.z = cvt_pk_bf16(w1[0], w1[1]); wv.w = cvt_pk_bf16(w1[2], w1[3]);
                  if (fr != 0) wv = (u32x4){0u, 0u, 0u, 0u};
#pragma unroll
                  for (int dt = 0; dt < 2; ++dt) nacc[dt] = MFMA16(frag_tr(L + L_KS, QSTR, 32 * ks, 32 * w + 16 * dt, lane), __builtin_bit_cast(bf16x8, wv), nacc[dt]); } } }
        if (w == 0 && c + 1 < nch) mstate = mlstm_scan(gi + ifbi, gf + ifbf, lane, mstate, SC + ((c + 1) & 1) * 384);
        __syncthreads();
        numst = *(const LAS u32x4*)(L + L_NUMB + (tid >> 3) * VSTR + 16 * (tid & 7));
#pragma unroll
        for (int dt = 0; dt < 2; ++dt)
#pragma unroll
            for (int vi = 0; vi < 4; ++vi) *(LAS u32x2*)(L + L_CT + (16 * vi + fr) * QSTR + (32 * w + 16 * dt + 4 * fq) * 2) = pack4(cacc[dt][vi]);
        if (vs == 0 && fr == 0) {
#pragma unroll
            for (int dt = 0; dt < 2; ++dt) *(LAS u32x2*)(NSTB + (32 * w + 16 * dt + 4 * fq) * 2) = pack4(nacc[dt]); }
    }
    ML_STORE(nch - 1);
#undef ML_LOAD
#undef ML_STORE
    float* Cout = F.out + O_PC + (size_t)(b * 4 + h) * 131072;
#pragma unroll
    for (int dt = 0; dt < 2; ++dt)
#pragma unroll
        for (int vi = 0; vi < 4; ++vi)
#pragma unroll
            for (int r = 0; r < 4; ++r) { const int d = 32 * w + 16 * dt + 4 * fq + r, v = 16 * vi + fr; Cout[(size_t)d * 512 + vs * 64 + v] = cacc[dt][vi][r]; }
    if (vs == 0) { if (fr == 0) {
#pragma unroll
            for (int dt = 0; dt < 2; ++dt)
#pragma unroll
                for (int r = 0; r < 4; ++r) F.out[O_PN + (size_t)(b * 4 + h) * 256 + 32 * w + 16 * dt + 4 * fq + r] = nacc[dt][r]; }
        if (tid == 0) F.out[O_PM + b * 4 + h] = mstate; }
}

constexpr int XSTR = 144, BSTR = 272;
constexpr int S_XS = 0, S_XD = 9216, S_XW = 18432, S_BS = 27648, S_CS = 45056, S_HS = 62464, S_GB = 79872, S_SCAL = 89088, S_YB = 98304;

__device__ __forceinline__ void ssd_scan(float dtp, float Ae, int lane, LAS float* sc) {
    const float dt = fmaxf(dtp, 0.f) + fast_log1pexp_neg(fabsf(dtp));
    const float cum = wave_scan_add(dt * Ae);
    const float cl = __shfl(cum, 63);
    sc[lane] = cum; sc[64 + lane] = dt; sc[128 + lane] = fast_exp(cl - cum); sc[192 + lane] = fast_exp(cum);
    if (lane == 0) sc[256] = fast_exp(cl);
}

__device__ __forceinline__ void ssd_prompt_item(Frame& F, const Params& p, const int b, const int e) {
    LAS unsigned char* L = F.lds;
    const int tid = F.tid, lane = F.lane, w = F.wave, fr = lane & 15, fq = lane >> 4;
    const bf16_t* CV = (const bf16_t*)(F.ws + WS_CV); const float* GT = (const float*)(F.ws + WS_GATES);
    bf16_t* YS = (bf16_t*)(F.ws + WS_YS);
    const int g = e >> 3, m0 = b * SEQ; constexpr int nch = SEQ / 64;
    const float dtb = PIN(25)[e], Ae = -expf(PIN(26)[e]), De = PIN(27)[e];
    LAS float* SC = (LAS float*)(L + S_SCAL);
    f32x4 hacc[4];
#pragma unroll
    for (int pi = 0; pi < 4; ++pi) hacc[pi] = (f32x4){0.f, 0.f, 0.f, 0.f};
    u32x4 px, pb[2], pc[2]; float gd = 0.f;
    const bf16_t* xsrc = CV + (size_t)(m0 + (tid >> 3)) * CVP + 2048 + e * 64 + 8 * (tid & 7);
    const bf16_t* bsrc = CV + (size_t)(m0 + (tid >> 4)) * CVP + 4096 + g * 128 + 8 * (tid & 15);
    const float* gsrc = GT + (size_t)(m0 + lane) * 64 + 8 + e;
#define SD_LOAD(c) do { px = *(const u32x4*)(xsrc + (size_t)((c) * 64) * CVP); _Pragma("unroll") for (int i = 0; i < 2; ++i) { pb[i] = *(const u32x4*)(bsrc + (size_t)((c) * 64 + 32 * i) * CVP); pc[i] = *(const u32x4*)(bsrc + (size_t)((c) * 64 + 32 * i) * CVP + 512); } \
        if (w == 0) gd = gsrc[(size_t)((c) * 64) * 64]; } while (0)
    u32x4 yst = {0u, 0u, 0u, 0u};
    bf16_t* ydst = YS + (size_t)(m0 + (tid >> 3)) * 2048 + e * 64 + 8 * (tid & 7);
#define SD_STORE(c) do { *(u32x4*)(ydst + (size_t)((c) * 64) * 2048) = yst; } while (0)
    SD_LOAD(0);
    __syncthreads();
#pragma unroll
    for (int pi = 0; pi < 4; ++pi) *(LAS u32x2*)(L + S_HS + (16 * pi + fr) * BSTR + (16 * w + 4 * fq) * 2) = (u32x2){0u, 0u};
    if (w == 0) ssd_scan(gd + dtb, Ae, lane, SC);
    __syncthreads();
    for (int c = 0; c < nch; ++c) {
        const int t0 = 64 * c; LAS float* sc = SC + (c & 1) * 320;
        { const int row = tid >> 3, c8 = tid & 7; const float dt = sc[64 + row], ed = sc[128 + row]; float x[8]; unpack8(px, x);
          *(LAS u32x4*)(L + S_XS + row * XSTR + 16 * c8) = px; *(LAS u32x4*)(L + S_XD + row * XSTR + 16 * c8) = pack8(x, dt); *(LAS u32x4*)(L + S_XW + row * XSTR + 16 * c8) = pack8(x, dt * ed); }
#pragma unroll
        for (int i = 0; i < 2; ++i) { const int row = (tid >> 4) + 32 * i, c16 = tid & 15; *(LAS u32x4*)(L + S_BS + row * BSTR + 16 * c16) = pb[i]; *(LAS u32x4*)(L + S_CS + row * BSTR + 16 * c16) = pc[i]; }
        __syncthreads();
        if (c > 0) { SD_STORE(c - 1); }
        if (c + 1 < nch) SD_LOAD(c + 1);
        const int ti = w & 3, hf = w >> 2;
        bf16x8 cf[4];
#pragma unroll
        for (int k = 0; k < 4; ++k) cf[k] = frag_row(L + S_CS, BSTR, 16 * ti, 32 * k, lane);
        { f32x4 gacc[2] = {{0.f, 0.f, 0.f, 0.f}, {0.f, 0.f, 0.f, 0.f}};
#pragma unroll
          for (int j = 0; j < 2; ++j) { const int si = 2 * hf + j; if (si <= ti) {
#pragma unroll
                  for (int k = 0; k < 4; ++k) gacc[j] = MFMA16(frag_row(L + S_BS, BSTR, 16 * si, 32 * k, lane), cf[k], gacc[j]); } }
          const int t = 16 * ti + fr; const float cumt = sc[t];
#pragma unroll
          for (int j = 0; j < 2; ++j) { const int si = 2 * hf + j, s0 = 16 * si + 4 * fq; const f32x4 cs = *(const LAS f32x4*)(sc + s0); f32x4 vv;
#pragma unroll
              for (int r = 0; r < 4; ++r) vv[r] = (si <= ti && s0 + r <= t) ? gacc[j][r] * fast_exp(cumt - cs[r]) : 0.f;
              *(LAS u32x2*)(L + S_GB + t * XSTR + s0 * 2) = pack4(vv); } }
        __syncthreads();
        { f32x4 yacc[2] = {{0.f, 0.f, 0.f, 0.f}, {0.f, 0.f, 0.f, 0.f}};
#pragma unroll
          for (int j = 0; j < 2; ++j) { const int pi = 2 * hf + j;
#pragma unroll
              for (int k = 0; k < 4; ++k) yacc[j] = MFMA16(frag_row(L + S_HS, BSTR, 16 * pi, 32 * k, lane), cf[k], yacc[j]); }
          const int t = 16 * ti + fr; const float ec = sc[192 + t]; yacc[0] *= ec; yacc[1] *= ec;
#pragma unroll
          for (int ks = 0; ks < 2; ++ks) if (32 * ks <= 16 * ti + 15) { const bf16x8 gb = frag_row(L + S_GB, XSTR, 16 * ti, 32 * ks, lane);
#pragma unroll
              for (int j = 0; j < 2; ++j) yacc[j] = MFMA16(frag_tr(L + S_XD, XSTR, 32 * ks, 16 * (2 * hf + j), lane), gb, yacc[j]); }
#pragma unroll
          for (int j = 0; j < 2; ++j) { const int p0 = 16 * (2 * hf + j) + 4 * fq; const u32x2 xv = *(const LAS u32x2*)(L + S_XS + t * XSTR + p0 * 2);
              f32x4 y = yacc[j]; y[0] += De * bflo(xv.x); y[1] += De * bfhi(xv.x); y[2] += De * bflo(xv.y); y[3] += De * bfhi(xv.y);
              *(LAS u32x2*)(L + S_YB + t * XSTR + p0 * 2) = pack4(y); } }
        { const float eall = sc[256];
#pragma unroll
          for (int pi = 0; pi < 4; ++pi) hacc[pi] *= eall;
#pragma unroll
          for (int ks = 0; ks < 2; ++ks) { const bf16x8 ba = frag_tr(L + S_BS, BSTR, 32 * ks, 16 * w, lane);
#pragma unroll
              for (int pi = 0; pi < 4; ++pi) hacc[pi] = MFMA16(ba, frag_tr(L + S_XW, XSTR, 32 * ks, 16 * pi, lane), hacc[pi]); } }
        if (w == 0 && c + 1 < nch) ssd_scan(gd + dtb, Ae, lane, SC + ((c + 1) & 1) * 320);
        __syncthreads();
        yst = *(const LAS u32x4*)(L + S_YB + (tid >> 3) * XSTR + 16 * (tid & 7));
#pragma unroll
        for (int pi = 0; pi < 4; ++pi) *(LAS u32x2*)(L + S_HS + (16 * pi + fr) * BSTR + (16 * w + 4 * fq) * 2) = pack4(hacc[pi]);
    }
    SD_STORE(nch - 1);
#undef SD_LOAD
#undef SD_STORE
    float* hout = F.out + O_PSSM + (size_t)(b * 32 + e) * 8192;
#pragma unroll
    for (int pi = 0; pi < 4; ++pi) *(f32x4*)(hout + (size_t)(16 * pi + fr) * 128 + 16 * w + 4 * fq) = hacc[pi];
}

__device__ __forceinline__ void mlstm_sample_item(Frame& F, const Params& p, const int bs, const int h) {
    LAS unsigned char* L = F.lds; const int tid = F.tid, lane = F.lane, w = F.wave;
    const bf16_t* Z = (const bf16_t*)(F.ws + WS_ZIN); const bf16_t* CV = (const bf16_t*)(F.ws + WS_CV); const float* GT = (const float*)(F.ws + WS_GATES);
    bf16_t* NUM = (bf16_t*)(F.ws + WS_NUM); float* DEN = (float*)(F.ws + WS_DEN);
    const int m0 = MP + bs * TS;
    const float* C0 = PIN(4) + (size_t)(bs * 4 + h) * 131072; float* C1 = F.out + O_SC + (size_t)(bs * 4 + h) * 131072;
    LAS float* QKW = (LAS float*)L; LAS float* RED = (LAS float*)(L + 16384); LAS float* NS = (LAS float*)(L + 81920);
    LAS float* SCs = (LAS float*)(L + 82944); LAS float* SW = (LAS float*)(L + 83200); LAS float* QN = (LAS float*)(L + 83456);
    const int v4 = tid & 127, dp = tid >> 7;
    f32x4 vreg[8];
#pragma unroll
    for (int s = 0; s < 8; ++s) { const u32x2 vv = *(const u32x2*)(Z + (size_t)(m0 + s) * ZP + ZV + h * 512 + 4 * v4); vreg[s] = (f32x4){bflo(vv.x), bfhi(vv.x), bflo(vv.y), bfhi(vv.y)}; }
    const u32x4 qk = *(const u32x4*)(CV + (size_t)(m0 + ((tid >> 5) & 7)) * CVP + (tid >> 8) * 1024 + h * 256 + 8 * (tid & 31));
    const float n0v = tid < 256 ? PIN(5)[(size_t)(bs * 4 + h) * 256 + tid] : 0.f;
    __syncthreads();
    { const int isk = tid >> 8, t = (tid >> 5) & 7, c16 = tid & 31; float x[8]; unpack8(qk, x);
#pragma unroll
      for (int e = 0; e < 8; ++e) QKW[(8 * c16 + e) * 16 + isk * 8 + t] = x[e]; }
    if (tid < 256) NS[tid] = n0v;
    if (w == 0) {
        const bool valid = lane < 8; const float mstate = PIN(6)[bs * 4 + h];
        float ipre = 0.f, fpre = 0.f; if (valid) { ipre = GT[(size_t)(m0 + lane) * 64 + h] + PIN(20)[h]; fpre = GT[(size_t)(m0 + lane) * 64 + 4 + h] + PIN(20)[4 + h]; }
        float bsum = valid ? logsigmoidf_(fpre) : 0.f;
#pragma unroll
        for (int o = 1; o < 8; o <<= 1) { const float u = __shfl_up(bsum, o); if (lane >= o) bsum += u; }
        const float a = valid ? ipre - bsum : -INFINITY;
        float cm = a;
#pragma unroll
        for (int o = 1; o < 8; o <<= 1) { const float u = __shfl_up(cm, o); if (lane >= o) cm = fmaxf(cm, u); }
        const float A = fmaxf(mstate, cm); const float Alast = __shfl(A, 7), blast = __shfl(bsum, 7);
        if (valid) { SCs[lane] = a; SCs[8 + lane] = A; SCs[16 + lane] = expf(mstate - A); SCs[24 + lane] = expf(-(bsum + A)); SCs[32 + lane] = expf(a - Alast); }
        if (lane == 0) { SCs[40] = expf(mstate - Alast); F.out[O_SM + bs * 4 + h] = blast + Alast; }
    }
    __syncthreads();
    { const int pr = tid >> 3, part = tid & 7, t = pr >> 3, s = pr & 7; float acc = 0.f;
#pragma unroll 8
      for (int dd = 0; dd < 32; ++dd) { const int d = part * 32 + dd; acc += QKW[d * 16 + t] * QKW[d * 16 + 8 + s]; }
      acc += __shfl_xor(acc, 1); acc += __shfl_xor(acc, 2); acc += __shfl_xor(acc, 4);
      if (part == 0) SW[t * 8 + s] = (s <= t) ? acc * expf(SCs[s] - SCs[8 + t]) : 0.f; }
    if (tid < 64) { const int t = tid >> 3, part = tid & 7; float acc = 0.f;
#pragma unroll 8
      for (int dd = 0; dd < 32; ++dd) { const int d = part * 32 + dd; acc += QKW[d * 16 + t] * NS[d]; }
      acc += __shfl_xor(acc, 1); acc += __shfl_xor(acc, 2); acc += __shfl_xor(acc, 4);
      if (part == 0) QN[t] = acc; }
    if (tid >= 256) { const int d = tid - 256; float s = 0.f;
#pragma unroll
        for (int si = 0; si < 8; ++si) s += SCs[32 + si] * QKW[d * 16 + 8 + si];
        F.out[O_SN + (size_t)(bs * 4 + h) * 256 + d] = SCs[40] * NS[d] + s; }
    __syncthreads();
    if (tid < 8) { const int t = tid; float den = 0.f;
#pragma unroll
        for (int s = 0; s < 8; ++s) den += SW[t * 8 + s];
        den += SCs[16 + t] * QN[t]; DEN[(size_t)(m0 + t) * 4 + h] = fmaxf(fabsf(den), SCs[24 + t]); }
    if (tid >= 256) { const int d = tid - 256;
#pragma unroll
        for (int si = 0; si < 8; ++si) QKW[d * 16 + 8 + si] *= SCs[32 + si]; }
    __syncthreads();
    { const float decay = SCs[40];
      f32x4 acc[8];
#pragma unroll
      for (int t = 0; t < 8; ++t) acc[t] = (f32x4){0.f, 0.f, 0.f, 0.f};
      const float* cin = C0 + (size_t)(dp * 64) * 512 + 4 * v4; float* cout = C1 + (size_t)(dp * 64) * 512 + 4 * v4;
#pragma unroll 1
      for (int d0 = 0; d0 < 64; d0 += 8) {
          f32x4 cc[8];
#pragma unroll
          for (int i = 0; i < 8; ++i) cc[i] = __builtin_nontemporal_load((const f32x4*)(cin + (size_t)(d0 + i) * 512));
#pragma unroll
          for (int i = 0; i < 8; ++i) { const LAS float* qp = QKW + (dp * 64 + d0 + i) * 16;
              const f32x4 q0 = *(const LAS f32x4*)qp, q1 = *(const LAS f32x4*)(qp + 4), k0 = *(const LAS f32x4*)(qp + 8), k1 = *(const LAS f32x4*)(qp + 12);
              f32x4 cn = decay * cc[i];
#pragma unroll
              for (int t = 0; t < 4; ++t) { acc[t] += q0[t] * cc[i]; acc[4 + t] += q1[t] * cc[i]; cn += k0[t] * vreg[t]; cn += k1[t] * vreg[4 + t]; }
              __builtin_nontemporal_store(cn, (f32x4*)(cout + (size_t)(d0 + i) * 512)); }
      }
#pragma unroll
      for (int t = 0; t < 8; ++t) *(LAS f32x4*)(RED + (size_t)(dp * 8 + t) * 512 + 4 * v4) = acc[t]; }
    __syncthreads();
    { const int t = tid >> 6, v8 = tid & 63; float s[8];
#pragma unroll
      for (int e = 0; e < 8; ++e) s[e] = 0.f;
#pragma unroll
      for (int dpp = 0; dpp < 4; ++dpp) { const f32x4 a = *(const LAS f32x4*)(RED + (size_t)(dpp * 8 + t) * 512 + 8 * v8), b = *(const LAS f32x4*)(RED + (size_t)(dpp * 8 + t) * 512 + 8 * v8 + 4);
#pragma unroll
          for (int e = 0; e < 4; ++e) { s[e] += a[e]; s[4 + e] += b[e]; } }
      const float wst = SCs[16 + t];
#pragma unroll
      for (int e = 0; e < 8; ++e) s[e] *= wst;
      for (int si = 0; si <= t; ++si) { const float sw = SW[t * 8 + si]; float x[8]; unpack8(*(const u32x4*)(Z + (size_t)(m0 + si) * ZP + ZV + h * 512 + 8 * v8), x);
#pragma unroll
          for (int e = 0; e < 8; ++e) s[e] += sw * x[e]; }
      *(u32x4*)(NUM + (size_t)(m0 + t) * 2048 + h * 512 + 8 * v8) = pack8(s, 1.0f); }
}

__device__ __forceinline__ void ssd_sample_item(Frame& F, const Params& p, const int bs, const int g) {
    LAS unsigned char* L = F.lds; const int tid = F.tid, lane = F.lane, w = F.wave;
    const bf16_t* CV = (const bf16_t*)(F.ws + WS_CV); const float* GT = (const float*)(F.ws + WS_GATES); bf16_t* YS = (bf16_t*)(F.ws + WS_YS);
    const int m0 = MP + bs * TS;
    LAS float* BSf = (LAS float*)L; LAS float* CSf = (LAS float*)(L + 4096); LAS float* XF = (LAS float*)(L + 8192); LAS float* XWt = (LAS float*)(L + 24576);
    LAS float* XDt = (LAS float*)(L + 40960); LAS float* SC2 = (LAS float*)(L + 57344); LAS float* CB = (LAS float*)(L + 58432); LAS float* YP = (LAS float*)(L + 59392);
    const u32x4 xr = *(const u32x4*)(CV + (size_t)(m0 + (tid >> 6)) * CVP + 2048 + g * 512 + 8 * (tid & 63));
    u32x4 bcr = {0u, 0u, 0u, 0u};
    if (tid < 256) bcr = *(const u32x4*)(CV + (size_t)(m0 + ((tid >> 4) & 7)) * CVP + 4096 + (tid >> 7) * 512 + g * 128 + 8 * (tid & 15));
    __syncthreads();
    { float x[8]; unpack8(xr, x); const int t = tid >> 6, c8 = tid & 63;
#pragma unroll
      for (int e = 0; e < 8; ++e) XF[t * 512 + 8 * c8 + e] = x[e]; }
    if (tid < 256) { float x[8]; unpack8(bcr, x); const int isC = tid >> 7, t = (tid >> 4) & 7, c16 = tid & 15; LAS float* dst = isC ? CSf : BSf;
#pragma unroll
      for (int e = 0; e < 8; ++e) dst[t * 128 + 8 * c16 + e] = x[e]; }
    { const int e = g * 8 + w; const bool valid = lane < 8; const float Ae = -expf(PIN(26)[e]);
      const float dt = valid ? softplusf_(GT[(size_t)(m0 + lane) * 64 + 8 + e] + PIN(25)[e]) : 0.f;
      float cum = dt * Ae;
#pragma unroll
      for (int o = 1; o < 8; o <<= 1) { const float u = __shfl_up(cum, o); if (lane >= o) cum += u; }
      const float cl = __shfl(cum, 7);
      if (valid) { SC2[w * 32 + lane] = cum; SC2[w * 32 + 8 + lane] = dt; SC2[w * 32 + 16 + lane] = expf(cl - cum); SC2[w * 32 + 24 + lane] = expf(cum); }
      if (lane == 0) SC2[256 + w] = expf(cl); }
    __syncthreads();
    { const int pr = tid >> 3, part = tid & 7, t = pr >> 3, s = pr & 7; float acc = 0.f;
#pragma unroll
      for (int nn = 0; nn < 16; ++nn) { const int n = part * 16 + nn; acc += CSf[t * 128 + n] * BSf[s * 128 + n]; }
      acc += __shfl_xor(acc, 1); acc += __shfl_xor(acc, 2); acc += __shfl_xor(acc, 4);
      if (part == 0) CB[t * 8 + s] = acc; }
    { const int el = tid >> 6;
#pragma unroll
      for (int s = 0; s < 8; ++s) { const float x = XF[s * 512 + tid], dt = SC2[el * 32 + 8 + s], ed = SC2[el * 32 + 16 + s]; XDt[tid * 8 + s] = x * dt; XWt[tid * 8 + s] = x * dt * ed; } }
    __syncthreads();
    { const int n8 = tid & 15, prow = tid >> 4;
      float Bn[8][8], Cn[8][8];
#pragma unroll
      for (int s = 0; s < 8; ++s) { const f32x4 b0 = *(const LAS f32x4*)(BSf + s * 128 + 8 * n8), b1 = *(const LAS f32x4*)(BSf + s * 128 + 8 * n8 + 4), c0 = *(const LAS f32x4*)(CSf + s * 128 + 8 * n8), c1 = *(const LAS f32x4*)(CSf + s * 128 + 8 * n8 + 4);
#pragma unroll
          for (int j = 0; j < 4; ++j) { Bn[s][j] = b0[j]; Bn[s][4 + j] = b1[j]; Cn[s][j] = c0[j]; Cn[s][4 + j] = c1[j]; } }
      const float* hin = PIN(8) + (size_t)(bs * 32 + g * 8) * 8192 + 8 * n8; float* hout = F.out + O_SSSM + (size_t)(bs * 32 + g * 8) * 8192 + 8 * n8;
#pragma unroll 1
      for (int it = 0; it < 16; it += 2) {
          f32x4 hv[2][2];
#pragma unroll
          for (int u = 0; u < 2; ++u) { const int row = (it + u) * 32 + prow; hv[u][0] = __builtin_nontemporal_load((const f32x4*)(hin + (size_t)row * 128)); hv[u][1] = __builtin_nontemporal_load((const f32x4*)(hin + (size_t)row * 128 + 4)); }
#pragma unroll
          for (int u = 0; u < 2; ++u) { const int row = (it + u) * 32 + prow; const float eall = SC2[256 + (row >> 6)];
              const f32x4 xw0 = *(const LAS f32x4*)(XWt + row * 8), xw1 = *(const LAS f32x4*)(XWt + row * 8 + 4);
              float hh[8], hn[8], yp[8];
#pragma unroll
              for (int j = 0; j < 4; ++j) { hh[j] = hv[u][0][j]; hh[4 + j] = hv[u][1][j]; }
#pragma unroll
              for (int j = 0; j < 8; ++j) hn[j] = eall * hh[j];
#pragma unroll
              for (int s = 0; s < 8; ++s) { const float xw = s < 4 ? xw0[s & 3] : xw1[s & 3]; float y = 0.f;
#pragma unroll
                  for (int j = 0; j < 8; ++j) { hn[j] += xw * Bn[s][j]; y += Cn[s][j] * hh[j]; }
                  yp[s] = y; }
              f32x4 o0 = {hn[0], hn[1], hn[2], hn[3]}, o1 = {hn[4], hn[5], hn[6], hn[7]};
              __builtin_nontemporal_store(o0, (f32x4*)(hout + (size_t)row * 128)); __builtin_nontemporal_store(o1, (f32x4*)(hout + (size_t)row * 128 + 4));
#pragma unroll
              for (int s = 0; s < 8; ++s) { float y = yp[s]; y += __shfl_xor(y, 1); y += __shfl_xor(y, 2); y += __shfl_xor(y, 4); y += __shfl_xor(y, 8); yp[s] = y; }
              if (n8 == 0) { *(LAS f32x4*)(YP + row * 8) = (f32x4){yp[0], yp[1], yp[2], yp[3]}; *(LAS f32x4*)(YP + row * 8 + 4) = (f32x4){yp[4], yp[5], yp[6], yp[7]}; } }
      } }
    __syncthreads();
    { const int row = tid, el = row >> 6, pp = row & 63, e = g * 8 + el; const float De = PIN(27)[e];
#pragma unroll
      for (int t = 0; t < 8; ++t) { const float cumt = SC2[el * 32 + t]; float y = SC2[el * 32 + 24 + t] * YP[row * 8 + t];
#pragma unroll
          for (int s = 0; s < 8; ++s) if (s <= t) y += CB[t * 8 + s] * expf(cumt - SC2[el * 32 + s]) * XDt[row * 8 + s];
          y += De * XF[t * 512 + row];
          YS[(size_t)(m0 + t) * 2048 + e * 64 + pp] = (bf16_t)(cvt_pk_bf16(y, 0.f) & 0xffffu); } }
}

#ifndef IT_MASK
#define IT_MASK 15
#endif
__device__ __forceinline__ void phase_mixer(Frame& F, const Params& p, const int itm = IT_MASK) {
    if (itm & 1) { for (int it = F.bx; it < 256; it += F.G) { const int x = it & 7, j = it >> 3, pair = x * 4 + (j >> 3); mlstm_prompt_item(F, p, pair >> 2, pair & 3, j & 7); } }
    if (itm & 2) { for (int it = F.bx; it < 256; it += F.G) { const int x = it & 7, j = it >> 3, grp = x * 4 + (j >> 3); ssd_prompt_item(F, p, grp >> 2, (grp & 3) * 8 + (j & 7)); } }
    if (itm & 4) { for (int it = F.bx; it < 4 * (NBS - NS_EARLY); it += F.G) mlstm_sample_item(F, p, NS_EARLY + (it >> 2), it & 3); }
    if (itm & 8) { for (int it = F.bx; it < 4 * (NBS - NS_EARLY); it += F.G) ssd_sample_item(F, p, NS_EARLY + (it >> 2), it & 3); }
}

__device__ __forceinline__ void phase_finish(Frame& F, const Params& p) {
    const bf16_t* Z = (const bf16_t*)(F.ws + WS_ZIN); const bf16_t* NUM = (const bf16_t*)(F.ws + WS_NUM); const bf16_t* YS = (const bf16_t*)(F.ws + WS_YS);
    const float* DEN = (const float*)(F.ws + WS_DEN); bf16_t* HA = (bf16_t*)(F.ws + WS_HA); bf16_t* HB = (bf16_t*)(F.ws + WS_HB);
    const float* hg = PIN(21); const float* sg = PIN(28);
    const int gwv = F.bx * 8 + F.wave, NGW = F.G * 8, lane = F.lane;
    for (int m = gwv; m < MT; m += NGW) {
#pragma unroll
        for (int h = 0; h < 4; ++h) {
            float x[8], o[8], gz[8]; unpack8(*(const u32x4*)(NUM + (size_t)m * 2048 + h * 512 + 8 * lane), x);
            float s = 0.f;
#pragma unroll
            for (int e = 0; e < 8; ++e) s += x[e];
            const float mu = wave_sum(s) * (1.0f / 512.0f); float q = 0.f;
#pragma unroll
            for (int e = 0; e < 8; ++e) { x[e] -= mu; q += x[e] * x[e]; }
            const float var = wave_sum(q) * (1.0f / 512.0f), Dv = DEN[(size_t)m * 4 + h];
            const float rs = 1.0f / sqrtf(var + EPS * Dv * Dv);
            unpack8(*(const u32x4*)(Z + (size_t)m * ZP + ZO + h * 512 + 8 * lane), gz);
            const f32x4 g0 = *(const f32x4*)(hg + h * 512 + 8 * lane), g1 = *(const f32x4*)(hg + h * 512 + 8 * lane + 4);
#pragma unroll
            for (int e = 0; e < 8; ++e) o[e] = x[e] * rs * (e < 4 ? g0[e & 3] : g1[e & 3]) * sigmoidf_(gz[e]);
            *(u32x4*)(m < MP ? HA + (size_t)m * 2048 + h * 512 + 8 * lane : HA + (size_t)MP * 2048 + fo_index(m - MP, h * 512 + 8 * lane, 2048)) = pack8(o, 1.0f);
        }
#pragma unroll
        for (int gq = 0; gq < 4; ++gq) {
            float y[8], zz[8]; unpack8(*(const u32x4*)(YS + (size_t)m * 2048 + gq * 512 + 8 * lane), y); unpack8(*(const u32x4*)(Z + (size_t)m * ZP + ZZ + gq * 512 + 8 * lane), zz);
            float q = 0.f;
#pragma unroll
            for (int e = 0; e < 8; ++e) { y[e] *= siluf_(zz[e]); q += y[e] * y[e]; }
            const float rs = 1.0f / sqrtf(wave_sum(q) * (1.0f / 512.0f) + EPS);
            const f32x4 g0 = *(const f32x4*)(sg + gq * 512 + 8 * lane), g1 = *(const f32x4*)(sg + gq * 512 + 8 * lane + 4);
#pragma unroll
            for (int e = 0; e < 8; ++e) y[e] = y[e] * rs * (e < 4 ? g0[e & 3] : g1[e & 3]);
            *(u32x4*)(m < MP ? HB + (size_t)m * 2048 + gq * 512 + 8 * lane : HB + (size_t)MP * 2048 + fo_index(m - MP, gq * 512 + 8 * lane, 2048)) = pack8(y, 1.0f);
        }
    }
    const int gt = F.bx * NTHREADS + F.tid, NGT = F.G * NTHREADS;
    constexpr int N1 = NBP * 3 * 2048, N2 = NBS * 3 * 2048, N3 = NBP * 3 * 3072, N4 = NBS * 3 * 3072;
    for (int i = gt; i < N1 + N2 + N3 + N4; i += NGT) {
        int j = i;
        if (j < N1) { const int b = j / 6144, r = (j / 2048) % 3, ch = j % 2048; F.out[O_PMC + j] = bf2f(Z[(size_t)(b * SEQ + SEQ - 3 + r) * ZP + ch]); continue; } j -= N1;
        if (j < N2) { const int b = j / 6144, r = (j / 2048) % 3, ch = j % 2048; F.out[O_SMC + j] = bf2f(Z[(size_t)(MP + b * TS + TS - 3 + r) * ZP + ch]); continue; } j -= N2;
        if (j < N3) { const int b = j / 9216, r = (j / 3072) % 3, ch = j % 3072; F.out[O_PSC + j] = bf2f(Z[(size_t)(b * SEQ + SEQ - 3 + r) * ZP + ZX + ch]); continue; } j -= N3;
        { const int b = j / 9216, r = (j / 3072) % 3, ch = j % 3072; F.out[O_SSC + j] = bf2f(Z[(size_t)(MP + b * TS + TS - 3 + r) * ZP + ZX + ch]); }
    }
}


#ifndef STAG_LEVELS
#define STAG_LEVELS 8
#endif
#ifndef STAG_SLEEP
#define STAG_SLEEP 16
#endif
__device__ __forceinline__ void stagger_start(const Frame& F) { const int sl = (F.bx >> 3) & (STAG_LEVELS - 1); for (int q = 0; q < sl; ++q) __builtin_amdgcn_s_sleep(STAG_SLEEP); }

constexpr int LDS_BYTES = 147456;
constexpr int NPHASE = 15;

__global__ void __launch_bounds__(NTHREADS, 2) fwd_kernel(Params p) {
    extern __shared__ __attribute__((aligned(16))) unsigned char lds_raw[];
    Frame F;
    F.lds = (LAS unsigned char*)lds_raw;
    F.tid = threadIdx.x; F.lane = F.tid & 63; F.wave = __builtin_amdgcn_readfirstlane(F.tid >> 6);
    F.G = gridDim.x; F.bx = blockIdx.x;
    F.out = p.out; F.ws = p.ws;
    unsigned char* ws = p.ws;
    bf16_t* U = (bf16_t*)(ws + WS_U); bf16_t* H = (bf16_t*)(ws + WS_H); float* X1 = (float*)(ws + WS_X1);
    bf16_t* ZIN = (bf16_t*)(ws + WS_ZIN); float* GATES = (float*)(ws + WS_GATES); float* MOD = (float*)(ws + WS_MOD);
    const int lo = p.ph_lo, hi = p.ph_hi;
#ifndef PH_MASK
#define PH_MASK 0xfffff
#endif
#define IN(k) (((PH_MASK >> (k)) & 1) && lo <= (k) && (k) < hi)
#ifndef DUP_MASK
#define DUP_MASK 0
#endif
#define DUP(k) ((DUP_MASK >> (k)) & 1)
    volatile LAS unsigned* MISC = (volatile LAS unsigned*)(F.lds + LDS_BYTES - 64);
    if (F.tid < 16) MISC[F.tid] = 0u;
    if (F.tid == 0) { volatile LAS unsigned* T = (volatile LAS unsigned*)(F.lds + PTAB_OFF);
#pragma unroll
        for (int k = 0; k < 36; ++k) { const uint64_t a = (uint64_t)p.in[k]; T[2 * k] = (unsigned)a; T[2 * k + 1] = (unsigned)(a >> 32); } }
    __syncthreads();
    XcdBarrier bar; bar.bar = (unsigned*)(ws + WS_CTL); bar.x = 0; bar.st = nullptr;
    if (hi - lo > 1) bar = xcd_barrier_post((unsigned*)(ws + WS_CTL), MISC);
#define SEAM(k) do { if (IN(k) && IN((k) + 1)) { xcd_barrier(bar); } } while (0)

    if (IN(0)) { phase_silu_c(F, p); phase_prep<0>(F, p); if (hi - lo > 1) xcd_barrier(bar); phase_adaln(F, p); } SEAM(0);
    if (IN(1)) { phase_norm_mod(F, PIN(0), PIN(1), PIN(12), 0 * DM, 1 * DM, U); if (DUP(1)) phase_norm_mod(F, PIN(0), PIN(1), PIN(12), 0 * DM, 1 * DM, U); } SEAM(1);
    if (IN(2)) { pg8::Gemm g{U, U, (const bf16_t*)(ws + WS_WUP1), (const bf16_t*)(ws + WS_WUP1), DM / 2}; pg8::Order S;
        if (F.bx < 192) { stagger_start(F); S.init_from(MT, 2 * DFF, 192, F.bx, 0, 1344); } else { phase_prep<1>(F, p); S.init_from(MT, 2 * DFF, 64, F.bx - 192, 1344, 1496); }
        pg8::EpiSwiGLU E{H, F8_INV}; pg8::gemm_phase<pg8::EpiSwiGLU, true, pg8::Order, true>(F.lds, g, S, E); } SEAM(2);
    float* XS = (float*)(ws + WS_XS); unsigned* CNT = (unsigned*)(ws + WS_CTL) + CW_CNT; bf16_t* U2 = (bf16_t*)(ws + WS_U2);
    if (IN(3)) { stagger_start(F); pg8::Gemm g{H, H, (const bf16_t*)(ws + WS_WDN1), (const bf16_t*)(ws + WS_WDN1), DFF}; pg8::Order S; S.init(MP, DM, F.G, F.bx, 0);
        pg8::EpiResidNorm<false> E{PIN(0), X1, MOD + 2 * DM, PIN(16), MOD + 3 * DM, MOD + 4 * DM, U, nullptr, XS, CNT, 0.5f, 0}; pg8::gemm_phase(F.lds, g, S, E);
        small_phase_resid_norm<DFF, false>(F, H, (const bf16_t*)(ws + WS_FDN1), PIN(1), X1, MOD + 2 * DM, 0.5f, PIN(16), MOD + 3 * DM, MOD + 4 * DM, U, nullptr, XS, CNT); } SEAM(3);
    if (IN(5)) {
        const pg8::Gemm g{U, U, (const bf16_t*)(ws + WS_WIN), (const bf16_t*)(ws + WS_WIN), DM}; const pg8::EpiZin E{ZIN, GATES};
        { stagger_start(F); const pg8::OrderSample S{F.bx}; pg8::gemm_phase<pg8::EpiZin, true, pg8::OrderSample>(F.lds, g, S, E); }
        if (F.bx >= 208 && F.bx < 224) small_gates_tile(F, U, (const bf16_t*)(ws + WS_FG), GATES, MP / 64 + (F.bx - 208));
        if (F.bx >= 224) { for (int k = 0; k < 4; ++k) small_gates_tile(F, U, (const bf16_t*)(ws + WS_FG), GATES, 4 * (F.bx - 224) + k); }
        xcd_barrier(bar);
        if (F.bx >= 192) {
            const int s0 = F.bx - 192;
            for (int k = F.wave; k < 10; k += 8) conv_item(F, p, 5120 + 10 * s0 + k);
            asm volatile("s_waitcnt vmcnt(0)" ::: "memory"); __syncthreads(); __builtin_amdgcn_fence(__ATOMIC_ACQUIRE, "agent");
#pragma unroll 1
            for (int k = 0; k < 4; ++k) mlstm_sample_item(F, p, s0, k);
#pragma unroll 1
            for (int k = 0; k < 4; ++k) ssd_sample_item(F, p, s0, k);
            for (int k = 0; k < 2; ++k) small_gates_tile(F, U, (const bf16_t*)(ws + WS_FG), GATES, 128 + 2 * s0 + k);
        } else stagger_start(F);
        __syncthreads();
        { const pg8::OrderPrompt S{F.bx}; pg8::gemm_phase<pg8::EpiZin, true, pg8::OrderPrompt>(F.lds, g, S, E); }
        } SEAM(5);
    if (IN(6)) { phase_conv(F, p); if (DUP(6)) phase_conv(F, p); } SEAM(6);
    #ifndef DUP_IT
#define DUP_IT 15
#endif
    if (IN(7)) { phase_mixer(F, p, p.itm); } SEAM(7);
    if (IN(8)) { phase_finish(F, p); if (DUP(8)) phase_finish(F, p); } SEAM(8);
    if (IN(9)) { stagger_start(F); pg8::Gemm g{(const bf16_t*)(ws + WS_HA), (const bf16_t*)(ws + WS_HB), (const bf16_t*)(ws + WS_WPA), (const bf16_t*)(ws + WS_WPB), 2048}; pg8::Order S; S.init(MP, DM, F.G, F.bx, 1);
        pg8::EpiMerge E{ZIN, (float*)(ws + WS_TMP), U}; pg8::gemm_phase(F.lds, g, S, E);
        small_phase_merge(F, (const bf16_t*)(ws + WS_HA), (const bf16_t*)(ws + WS_HB), (const bf16_t*)(ws + WS_FPA), (const bf16_t*)(ws + WS_FPB), ZIN, U); } SEAM(9);
    if (IN(10)) { stagger_start(F); pg8::Gemm g{U, U, (const bf16_t*)(ws + WS_WOUT), (const bf16_t*)(ws + WS_WOUT), DM}; pg8::Order S; S.init(MP, DM, F.G, F.bx, 0);
        pg8::EpiResidNorm<false> E{X1, X1, MOD + 5 * DM, PIN(31), MOD + 6 * DM, MOD + 7 * DM, U2, nullptr, XS + (size_t)MT * 16, CNT + CNT_STRIDE, 1.0f, 1}; pg8::gemm_phase(F.lds, g, S, E);
        small_phase_resid_norm<DM, false>(F, U, (const bf16_t*)(ws + WS_FOUT), X1 + (size_t)MP * DM, X1, MOD + 5 * DM, 1.0f, PIN(31), MOD + 6 * DM, MOD + 7 * DM, U2, nullptr, XS + (size_t)MT * 16, CNT + CNT_STRIDE); } SEAM(10);
    if (IN(12)) { stagger_start(F); pg8::Gemm g{U2, U2, (const bf16_t*)(ws + WS_WUP2), (const bf16_t*)(ws + WS_WUP2), DM / 2}; pg8::Order S; S.init(MT, 2 * DFF, F.G, F.bx, 0);
        pg8::EpiSwiGLU E{H, F8_INV}; pg8::gemm_phase<pg8::EpiSwiGLU, true, pg8::Order, true>(F.lds, g, S, E); } SEAM(12);
    if (IN(13)) { stagger_start(F); pg8::Gemm g{H, H, (const bf16_t*)(ws + WS_WDN2), (const bf16_t*)(ws + WS_WDN2), DFF}; pg8::Order S; S.init(MP, DM, F.G, F.bx, 0);
        pg8::EpiResidNorm<true> E{X1, nullptr, MOD + 8 * DM, PIN(35), nullptr, nullptr, nullptr, p.out, XS + (size_t)2 * MT * 16, CNT + 2 * CNT_STRIDE, 0.5f, 0}; pg8::gemm_phase(F.lds, g, S, E);
        small_phase_resid_norm<DFF, true>(F, H, (const bf16_t*)(ws + WS_FDN2), X1 + (size_t)MP * DM, nullptr, MOD + 8 * DM, 0.5f, PIN(35), nullptr, nullptr, nullptr, p.out, XS + (size_t)2 * MT * 16, CNT + 2 * CNT_STRIDE); }
#undef IN
#undef SEAM
}

extern "C" void kernel_launch(void* const* d_in, const int* in_sizes, int n_in, void* d_out, int out_size, void* d_ws, size_t ws_size, hipStream_t stream) {
    static int grid = 0;
    if (grid == 0) {
        if (n_in != 36 || ws_size < WS_END) { fprintf(stderr, "kernel_launch: expected 36 inputs and >= %zu bytes of workspace (got %d, %zu)\n", (size_t)WS_END, n_in, ws_size); grid = -1; return; }
        int dev = 0, cus = 0, per_cu = 0;
        hipGetDevice(&dev); hipDeviceGetAttribute(&cus, hipDeviceAttributeMultiprocessorCount, dev);
        hipFuncSetAttribute((const void*)fwd_kernel, hipFuncAttributeMaxDynamicSharedMemorySize, LDS_BYTES);
        hipOccupancyMaxActiveBlocksPerMultiprocessor(&per_cu, (const void*)fwd_kernel, NTHREADS, LDS_BYTES);
        if (per_cu < 1) { fprintf(stderr, "kernel_launch: occupancy query says %d blocks per CU\n", per_cu); grid = -1; return; }
        grid = cus;
        if (grid != 256) { fprintf(stderr, "kernel_launch: the fused-norm GEMM epilogues need exactly 256 workgroups (one 256x256 tile each); this device has %d CUs\n", cus); grid = -1; return; }
    }
    if (grid < 0) return;
    Params p{};
    for (int i = 0; i < 36; ++i) p.in[i] = (const float*)d_in[i];
    p.out = (float*)d_out; p.ws = (unsigned char*)d_ws; p.itm = 15;
#if MK_LAUNCH_PER_PHASE
    for (int ph = 0; ph < NPHASE; ++ph) { p.ph_lo = ph; p.ph_hi = ph + 1; hipLaunchKernelGGL(fwd_kernel, dim3(grid), dim3(NTHREADS), LDS_BYTES, stream, p); }
#else
    p.ph_lo = 0; p.ph_hi = NPHASE;
    if (hipMemsetAsync((char*)d_ws + WS_CTL, 0, 98304, stream) != hipSuccess) { fprintf(stderr, "kernel_launch: memset of the barrier words failed\n"); return; }
    void* args[] = {&p};
    hipError_t e = hipLaunchCooperativeKernel((const void*)fwd_kernel, dim3(grid), dim3(NTHREADS), args, LDS_BYTES, stream);
    if (e != hipSuccess) fprintf(stderr, "cooperative launch failed: %s (grid %d)\n", hipGetErrorString(e), grid);
#ifdef PROBE_PH
    for (int r = 0; r < PROBE_REPS; ++r) { Params q = p; q.ph_lo = PROBE_PH; q.ph_hi = PROBE_PH + 1; q.itm = PROBE_ITM; hipLaunchKernelGGL(fwd_kernel, dim3(grid), dim3(NTHREADS), LDS_BYTES, stream, q); }
#endif
#endif
}
```

```cpp
#include <hip/hip_runtime.h>
#include <hip/hip_cooperative_groups.h>
#include <cstdio>
#include <cstdint>
namespace cg = cooperative_groups;

#ifndef MK_LAUNCH_PER_PHASE
#define MK_LAUNCH_PER_PHASE 0
#endif

constexpr int DM = 1024, SEQ = 2048, NBP = 8, NBS = 128, TS = 8;
constexpr int MP = NBP * SEQ, MS = NBS * TS, MT = MP + MS, NBID = NBP + NBS;
constexpr int DFF = 2816, NMOD = 9 * DM;
constexpr int ZP = 13568;
constexpr int ZQ = 0, ZK = 1024, ZV = 2048, ZO = 4096, ZZ = 6144, ZX = 8192, ZGA = 11264, ZGB = 12288, ZG = 13312;
constexpr float EPS = 1e-6f;
constexpr int NTHREADS = 512;

constexpr size_t MiB = 1u << 20;
constexpr size_t WS_CTL = 0;
constexpr size_t WS_WUP1 = 1 * MiB;
constexpr size_t WS_WDN1 = WS_WUP1 + 11 * MiB;
constexpr size_t WS_WUP2 = WS_WDN1 + 6 * MiB;
constexpr size_t WS_WDN2 = WS_WUP2 + 11 * MiB;
constexpr size_t WS_WIN = WS_WDN2 + 6 * MiB;
constexpr size_t WS_WPA = WS_WIN + 27 * MiB;
constexpr size_t WS_WPB = WS_WPA + 4 * MiB;
constexpr size_t WS_WOUT = WS_WPB + 4 * MiB;
constexpr size_t WS_MOD = WS_WOUT + 2 * MiB;
constexpr size_t WS_U = WS_MOD + 5 * MiB;
constexpr size_t WS_H = WS_U + 34 * MiB;
constexpr size_t WS_X1 = WS_H + 94 * MiB;
constexpr size_t WS_ZIN = WS_X1 + 68 * MiB;
constexpr size_t WS_GATES = WS_ZIN + 451 * MiB;
constexpr size_t WS_YS = WS_GATES + 5 * MiB;
constexpr size_t WS_DEN = WS_YS + 68 * MiB;
constexpr size_t WS_HA = WS_DEN + 1 * MiB;
constexpr size_t WS_HB = WS_HA + 68 * MiB;
constexpr size_t WS_CV = WS_HA;
constexpr size_t WS_XS = WS_CV + 170 * MiB;
constexpr size_t WS_U2 = WS_ZIN;
constexpr size_t WS_FDN1 = WS_XS + 4 * MiB;
constexpr size_t WS_FDN2 = WS_FDN1 + 6 * MiB;
constexpr size_t WS_FPA = WS_FDN2 + 6 * MiB;
constexpr size_t WS_FPB = WS_FPA + 4 * MiB;
constexpr size_t WS_FOUT = WS_FPB + 4 * MiB;
constexpr size_t WS_FG = WS_FOUT + 2 * MiB;
constexpr size_t WS_SC = WS_FG + 1 * MiB;
constexpr size_t WS_END = WS_SC + 1 * MiB;
constexpr int CW_CNT = 4096, CNT_STRIDE = 5120;
constexpr size_t WS_NUM = WS_H;
constexpr size_t WS_TMP = WS_YS;
static_assert(WS_END <= 1024 * MiB, "workspace map");

#define LAS __attribute__((address_space(3)))
typedef unsigned short bf16_t;
typedef short bf16x8 __attribute__((ext_vector_type(8)));
typedef short s16x4 __attribute__((ext_vector_type(4)));
typedef float f32x4 __attribute__((ext_vector_type(4)));
typedef float f32x2 __attribute__((ext_vector_type(2)));
typedef unsigned u32x4 __attribute__((ext_vector_type(4)));
typedef int v8i_t __attribute__((ext_vector_type(8)));
typedef unsigned u32x2 __attribute__((ext_vector_type(2)));

typedef __bf16 bf16x2_t __attribute__((ext_vector_type(2)));
__device__ __forceinline__ unsigned cvt_pk_bf16(float lo, float hi) { const bf16x2_t v = {(__bf16)lo, (__bf16)hi}; return __builtin_bit_cast(unsigned, v); }
__device__ __forceinline__ float bf2f(unsigned short b) { return __uint_as_float(((unsigned)b) << 16); }
__device__ __forceinline__ float bflo(unsigned w) { return __uint_as_float(w << 16); }
__device__ __forceinline__ float bfhi(unsigned w) { return __uint_as_float(w & 0xffff0000u); }
constexpr float F8_SA = 8.0f, F8_SW = 1024.0f, F8_INV = 1.0f / (8.0f * 1024.0f);
__device__ __forceinline__ float f8c(float x) { return fminf(fmaxf(x, -448.0f), 448.0f); }
__device__ __forceinline__ unsigned pack4_fp8(float a, float b, float c, float d, float s) {
    int w = 0; w = __builtin_amdgcn_cvt_pk_fp8_f32(f8c(a * s), f8c(b * s), w, false); w = __builtin_amdgcn_cvt_pk_fp8_f32(f8c(c * s), f8c(d * s), w, true); return (unsigned)w; }
__device__ __forceinline__ float fast_exp(float x) { return __builtin_amdgcn_exp2f(x * 1.4426950408889634f); }
__device__ __forceinline__ float sigmoidf_(float x) { return __builtin_amdgcn_rcpf(1.0f + fast_exp(-x)); }
__device__ __forceinline__ float siluf_(float x) { return x * sigmoidf_(x); }
__device__ __forceinline__ u32x4 pack8(const float (&v)[8], float s) {
    u32x4 w; w.x = cvt_pk_bf16(v[0] * s, v[1] * s); w.y = cvt_pk_bf16(v[2] * s, v[3] * s); w.z = cvt_pk_bf16(v[4] * s, v[5] * s); w.w = cvt_pk_bf16(v[6] * s, v[7] * s); return w;
}
__device__ __forceinline__ u32x2 pack4(const f32x4 v) { u32x2 w; w.x = cvt_pk_bf16(v[0], v[1]); w.y = cvt_pk_bf16(v[2], v[3]); return w; }
__device__ __forceinline__ void unpack8(const u32x4 v, float (&x)[8]) { x[0] = bflo(v.x); x[1] = bfhi(v.x); x[2] = bflo(v.y); x[3] = bfhi(v.y); x[4] = bflo(v.z); x[5] = bfhi(v.z); x[6] = bflo(v.w); x[7] = bfhi(v.w); }
__device__ __forceinline__ size_t fo_index(int r, int k, int K) { return ((size_t)((r >> 4) * (K >> 5) + (k >> 5))) * 512 + (size_t)((((r & 15) + 16 * ((k >> 3) & 3)) << 3) + (k & 7)); }
__device__ __forceinline__ float wave_scan_add(float v) {
    v += __builtin_bit_cast(float, __builtin_amdgcn_update_dpp(0, __builtin_bit_cast(int, v), 0x111, 0xf, 0xf, true));
    v += __builtin_bit_cast(float, __builtin_amdgcn_update_dpp(0, __builtin_bit_cast(int, v), 0x112, 0xf, 0xf, true));
    v += __builtin_bit_cast(float, __builtin_amdgcn_update_dpp(0, __builtin_bit_cast(int, v), 0x114, 0xf, 0xf, true));
    v += __builtin_bit_cast(float, __builtin_amdgcn_update_dpp(0, __builtin_bit_cast(int, v), 0x118, 0xf, 0xf, true));
    v += __builtin_bit_cast(float, __builtin_amdgcn_update_dpp(0, __builtin_bit_cast(int, v), 0x142, 0xa, 0xf, true));
    v += __builtin_bit_cast(float, __builtin_amdgcn_update_dpp(0, __builtin_bit_cast(int, v), 0x143, 0xc, 0xf, true));
    return v;
}
__device__ __forceinline__ float wave_scan_max(float v) {
    const int ninf = (int)0xff800000u;
    v = fmaxf(v, __builtin_bit_cast(float, __builtin_amdgcn_update_dpp(ninf, __builtin_bit_cast(int, v), 0x111, 0xf, 0xf, false)));
    v = fmaxf(v, __builtin_bit_cast(float, __builtin_amdgcn_update_dpp(ninf, __builtin_bit_cast(int, v), 0x112, 0xf, 0xf, false)));
    v = fmaxf(v, __builtin_bit_cast(float, __builtin_amdgcn_update_dpp(ninf, __builtin_bit_cast(int, v), 0x114, 0xf, 0xf, false)));
    v = fmaxf(v, __builtin_bit_cast(float, __builtin_amdgcn_update_dpp(ninf, __builtin_bit_cast(int, v), 0x118, 0xf, 0xf, false)));
    v = fmaxf(v, __builtin_bit_cast(float, __builtin_amdgcn_update_dpp(ninf, __builtin_bit_cast(int, v), 0x142, 0xa, 0xf, false)));
    v = fmaxf(v, __builtin_bit_cast(float, __builtin_amdgcn_update_dpp(ninf, __builtin_bit_cast(int, v), 0x143, 0xc, 0xf, false)));
    return v;
}
__device__ __forceinline__ float wave_sum(float v) { return __builtin_bit_cast(float, __builtin_amdgcn_readlane(__builtin_bit_cast(int, wave_scan_add(v)), 63)); }

struct Params {
    const float* in[36];
    float* out;
    unsigned char* ws;
    int ph_lo, ph_hi, itm, pad;
};

namespace pg8 {
constexpr int BM = 256, BK = 64, HALF = 128, HTB = HALF * BK * 2, STAGE_BYTES = 8 * HTB, NXCD = 8, WGM = 8;
__host__ __device__ __forceinline__ int lds_byte(int r, int c) { const int st = (r >> 4) * 2 + (c >> 5), rr = r & 15, cc = c & 31, ob = rr * 64 + cc * 2; return st * 1024 + (ob ^ (((ob >> 9) & 1) << 5)); }
__host__ __device__ __forceinline__ void stage_rc(int b, int& R, int& C) { const int st = b / 1024, sb = b % 1024, swz = sb ^ (((sb >> 9) & 1) << 5); R = (st >> 1) * 16 + swz / 64; C = (st & 1) * 32 + (swz % 64) / 2; }
__host__ __device__ __forceinline__ int perm32(int rho) { const int n = rho >> 4, i = rho & 15; return 8 * (i >> 2) + 4 * n + (i & 3); }

struct Unit { int pm, pn, w; };
struct Gemm { const bf16_t* A0; const bf16_t* A1; const bf16_t* B0; const bf16_t* B1; int K; };
typedef unsigned u32x8_t __attribute__((ext_vector_type(8)));
__device__ __forceinline__ v8i_t cat8(const bf16x8 x0, const bf16x8 x1) { const u32x4 l = __builtin_bit_cast(u32x4, x0), h = __builtin_bit_cast(u32x4, x1); const u32x8_t c = __builtin_shufflevector(l, h, 0, 1, 2, 3, 4, 5, 6, 7); return __builtin_bit_cast(v8i_t, c); }

struct OrderSample { int c;
    __device__ bool next(int i, Unit& u) const { if (i > 0 || c >= 208) return false; const int x = c & 7, j = c >> 3; u.pm = 64 + (x >> 1); u.pn = (x & 1) * 26 + j; u.w = 0; return true; } };
struct OrderPrompt { int c;
    __device__ bool next(int i, Unit& u) const { const int x = c & 7, j = c >> 3; int q; if (j < 24) { if (i >= 17) return false; q = i * 24 + j; } else { if (i >= 1) return false; q = 408 + (j - 24); }
        u.pm = 8 * x + (q & 7); u.pn = q >> 3; u.w = 0; return true; } };
struct Order {
    int nM, nN, nwg, G, c, dual;
    __device__ void init(int M, int N, int G_, int c_, int dual_) { nM = M / BM; nN = N / BM; nwg = nM * nN; G = G_; c = c_; dual = dual_; }
    __device__ void init_from(int M, int N, int G_, int c_, int first, int lim) { nM = M / BM; nN = N / BM; nwg = lim; G = G_; c = first + c_; dual = 0; }
    __device__ bool next(int i, Unit& u) const {
        const int ti = dual ? (i >> 1) : i;
        const long L = (long)ti * G + c; if (L >= nwg) return false;
        int wgid = (int)L; { const int tot = nM * nN, q = tot / NXCD, r = tot % NXCD, xcd = wgid % NXCD, off = wgid / NXCD; wgid = (xcd < r ? xcd * (q + 1) : r * (q + 1) + (xcd - r) * q) + off; }
        const int nig = WGM * nN, gid = wgid / nig, fm = gid * WGM, gsz = (nM - fm) < WGM ? (nM - fm) : WGM;
        u.pm = fm + ((wgid % nig) % gsz); u.pn = (wgid % nig) / gsz; u.w = dual ? (i & 1) : 0; return true;
    }
};

template <class Epi, bool ALIGN_EPI = true, class Ord = Order, bool FP8 = false>
__device__ __forceinline__ void gemm_phase(LAS unsigned char* lds, const Gemm g, const Ord& S, const Epi E) {
    const int tid = threadIdx.x, wid = __builtin_amdgcn_readfirstlane(tid >> 6), lane = tid & 63, wr = wid >> 2, wc = wid & 3, fr = lane & 15, fq = lane >> 4;
    const int K = g.K, nt = K / BK;
    unsigned voffA[2], voffB[2];
#pragma unroll
    for (int i = 0; i < 2; ++i) { int R, C; stage_rc(tid * 16 + i * 8192, R, C); const int Rb = Epi::PERM ? ((R & ~31) + perm32(R & 31)) : R;
        voffA[i] = (unsigned)(R * K + C) * 2u; voffB[i] = (unsigned)(Rb * K + C) * 2u; }
    const size_t kstep = (size_t)(BK * 2);
    const size_t hstep = (size_t)HALF * K * 2;
    const size_t tstep = 2 * hstep;
    const unsigned ldsw = (unsigned)wid * 1024u;
    const int aoff = lds_byte(wr * 64 + fr, fq * 8), boff = lds_byte(wc * 32 + fr, fq * 8);
#define PG8_SA(b, h) (((b) * 2 + (h)) * HTB)
#define PG8_SB(b, h) ((4 + (b) * 2 + (h)) * HTB)
#define PG8_STAGE(bufoff, gbase, voff) do { _Pragma("unroll") for (int _i = 0; _i < 2; ++_i) \
        __builtin_amdgcn_global_load_lds((const unsigned*)((const char*)(gbase) + (voff)[_i]), (LAS unsigned*)(lds + (bufoff) + ldsw + _i * 8192), 16, 0, 0); } while (0)
#define PG8_LDA(dst, b, h) do { _Pragma("unroll") for (int m = 0; m < 4; ++m) _Pragma("unroll") for (int k = 0; k < 2; ++k) dst[m][k] = *(const LAS bf16x8*)(lds + PG8_SA(b, h) + aoff + m * 2048 + k * 1024); } while (0)
#define PG8_LDB(dst, b, h) do { _Pragma("unroll") for (int n = 0; n < 2; ++n) _Pragma("unroll") for (int k = 0; k < 2; ++k) dst[n][k] = *(const LAS bf16x8*)(lds + PG8_SB(b, h) + boff + n * 2048 + k * 1024); } while (0)
#define PG8_CAT8(x0, x1) cat8((x0), (x1))
#define PG8_MMA(ai, bj, At, Bt) do { __builtin_amdgcn_s_setprio(1); _Pragma("unroll") for (int m = 0; m < 4; ++m) _Pragma("unroll") for (int n = 0; n < 2; ++n) { \
        if constexpr (FP8) { const v8i_t b8_ = PG8_CAT8(Bt[n][0], Bt[n][1]), a8_ = PG8_CAT8(At[m][0], At[m][1]); \
            asm volatile("v_mfma_scale_f32_16x16x128_f8f6f4 %0, %1, %2, %0, %3, %3 op_sel_hi:[0,0,0]" : "+v"(acc[ai][bj][m][n]) : "v"(b8_), "v"(a8_), "v"(f8one)); } \
        else { _Pragma("unroll") for (int k = 0; k < 2; ++k) acc[ai][bj][m][n] = __builtin_amdgcn_mfma_f32_16x16x32_bf16(Bt[n][k], At[m][k], acc[ai][bj][m][n], 0, 0, 0); } } __builtin_amdgcn_s_setprio(0); } while (0)
#define PG8_WAIT_V(n) asm volatile("s_waitcnt vmcnt(" #n ")" ::: "memory")
#define PG8_WAIT_L(n) asm volatile("s_waitcnt lgkmcnt(" #n ")" ::: "memory")
#define PG8_BAR __builtin_amdgcn_s_barrier()
#define PG8_SCHED __builtin_amdgcn_sched_barrier(0)
    Unit cur, nxt; int ui = 0;
    if (!S.next(0, cur)) return;
    const int f8one = 0x7F7F7F7F;
    f32x4 acc[2][2][4][2];
#pragma unroll
    for (int a = 0; a < 2; ++a)
#pragma unroll
        for (int b = 0; b < 2; ++b)
#pragma unroll
            for (int m = 0; m < 4; ++m)
#pragma unroll
                for (int n = 0; n < 2; ++n) acc[a][b][m][n] = (f32x4){0.f, 0.f, 0.f, 0.f};
    bf16x8 At[4][2], B0[2][2], B1[2][2];
    const char* cA = (const char*)(cur.w ? g.A1 : g.A0) + (size_t)cur.pm * tstep; const char* cB = (const char*)(cur.w ? g.B1 : g.B0) + (size_t)cur.pn * tstep;
    PG8_STAGE(PG8_SB(0, 0), cB, voffB); PG8_STAGE(PG8_SB(0, 1), cB + hstep, voffB); PG8_STAGE(PG8_SA(0, 0), cA, voffA); PG8_STAGE(PG8_SA(0, 1), cA + hstep, voffA);
    if (wr == 1) PG8_BAR;
    PG8_WAIT_V(2); PG8_BAR;
    PG8_STAGE(PG8_SB(1, 0), cB + kstep, voffB); PG8_STAGE(PG8_SA(1, 0), cA + kstep, voffA); PG8_STAGE(PG8_SB(1, 1), cB + hstep + kstep, voffB);
    PG8_WAIT_V(6); PG8_BAR;
    for (;;) {
        const bool has_next = S.next(ui + 1, nxt);
        const char* nA = has_next ? (const char*)(nxt.w ? g.A1 : g.A0) + (size_t)nxt.pm * tstep : cA; const char* nB = has_next ? (const char*)(nxt.w ? g.B1 : g.B0) + (size_t)nxt.pn * tstep : cB;
        for (int t = 0; t < nt; t += 2) {
            const bool last = (t == nt - 2);
            const char* a1 = cA + (size_t)(t + 1) * kstep;
            const char* a2 = last ? nA : cA + (size_t)(t + 2) * kstep; const char* b2 = last ? nB : cB + (size_t)(t + 2) * kstep;
            const char* a3 = a2 + kstep; const char* b3 = b2 + kstep;
            PG8_LDB(B0, 0, 0); PG8_LDB(B1, 0, 1); PG8_SCHED; PG8_LDA(At, 0, 0); PG8_STAGE(PG8_SA(1, 1), a1 + hstep, voffA);
            PG8_WAIT_V(8); PG8_WAIT_L(0); PG8_BAR; PG8_MMA(0, 0, At, B0); PG8_MMA(0, 1, At, B1); PG8_BAR; PG8_SCHED;
            PG8_LDA(At, 0, 1); PG8_STAGE(PG8_SB(0, 0), b2, voffB); PG8_STAGE(PG8_SB(0, 1), b2 + hstep, voffB); PG8_STAGE(PG8_SA(0, 0), a2, voffA);
            PG8_WAIT_V(8); PG8_WAIT_L(0); PG8_BAR; PG8_MMA(1, 0, At, B0); PG8_MMA(1, 1, At, B1); PG8_BAR; PG8_SCHED;
            PG8_LDB(B0, 1, 0); PG8_LDB(B1, 1, 1); PG8_SCHED; PG8_LDA(At, 1, 0); PG8_STAGE(PG8_SA(0, 1), a2 + hstep, voffA);
            PG8_WAIT_V(8); PG8_WAIT_L(0); PG8_BAR; PG8_MMA(0, 0, At, B0); PG8_MMA(0, 1, At, B1); PG8_BAR; PG8_SCHED;
            PG8_LDA(At, 1, 1); PG8_STAGE(PG8_SB(1, 0), b3, voffB); PG8_STAGE(PG8_SB(1, 1), b3 + hstep, voffB); PG8_STAGE(PG8_SA(1, 0), a3, voffA);
            PG8_WAIT_V(8); PG8_WAIT_L(0); PG8_BAR; PG8_MMA(1, 0, At, B0); PG8_MMA(1, 1, At, B1); PG8_BAR; PG8_SCHED;
        }
        if constexpr (ALIGN_EPI) { if (wr == 0) PG8_BAR; }
        if constexpr (FP8) asm volatile("s_nop 15\n\ts_nop 15" ::: "memory");
        if constexpr (!Epi::AFTER_DRAIN) E(acc, cur, wr, wc, fr, fq);
        if (!has_next) break;
#pragma unroll
        for (int a = 0; a < 2; ++a)
#pragma unroll
            for (int b = 0; b < 2; ++b)
#pragma unroll
                for (int m = 0; m < 4; ++m)
#pragma unroll
                    for (int n = 0; n < 2; ++n) acc[a][b][m][n] = (f32x4){0.f, 0.f, 0.f, 0.f};
        cur = nxt; cA = nA; cB = nB; ++ui;
        if constexpr (ALIGN_EPI) { if (wr == 1) PG8_BAR; }
    }
    PG8_WAIT_V(0);
    if constexpr (!ALIGN_EPI) { if (wr == 0) PG8_BAR; }
    PG8_BAR;
    if constexpr (Epi::AFTER_DRAIN) E.fused(acc, cur, wr, wc, fr, fq, lds, wid, lane);
#undef PG8_SA
#undef PG8_SB
#undef PG8_STAGE
#undef PG8_LDA
#undef PG8_LDB
#undef PG8_MMA
#undef PG8_WAIT_V
#undef PG8_WAIT_L
#undef PG8_BAR
#undef PG8_SCHED
}

__device__ __forceinline__ int bid_of_row(int row) { return row < MP ? (row >> 11) : (NBP + ((row - MP) >> 3)); }

struct EpiSwiGLU {
    static constexpr bool PERM = true, AFTER_DRAIN = false;
    bf16_t* H; float inv;
    __device__ __forceinline__ void operator()(const f32x4 (&acc)[2][2][4][2], const Unit& u, int wr, int wc, int fr, int fq) const {
        const int row0 = u.pm * BM + wr * 64 + fr, hc0 = u.pn * 128 + wc * 32 + 8 * fq; const float inv_ = inv;
#pragma unroll
        for (int ai = 0; ai < 2; ++ai)
#pragma unroll
            for (int m = 0; m < 4; ++m) { const f32x4 a0 = acc[ai][0][m][0] * inv_, a1 = acc[ai][0][m][1] * inv_, b0 = acc[ai][1][m][0] * inv_, b1 = acc[ai][1][m][1] * inv_;
                u32x4 w; w.x = cvt_pk_bf16(siluf_(a0[0]) * b0[0], siluf_(a0[1]) * b0[1]); w.y = cvt_pk_bf16(siluf_(a0[2]) * b0[2], siluf_(a0[3]) * b0[3]);
                w.z = cvt_pk_bf16(siluf_(a1[0]) * b1[0], siluf_(a1[1]) * b1[1]); w.w = cvt_pk_bf16(siluf_(a1[2]) * b1[2], siluf_(a1[3]) * b1[3]);
                const int row = row0 + ai * HALF + m * 16;
                if (u.pm < MP / BM) *(u32x2*)((unsigned char*)H + (size_t)row * DFF + hc0) = (u32x2){pack4_fp8(siluf_(a0[0]) * b0[0], siluf_(a0[1]) * b0[1], siluf_(a0[2]) * b0[2], siluf_(a0[3]) * b0[3], F8_SA), pack4_fp8(siluf_(a1[0]) * b1[0], siluf_(a1[1]) * b1[1], siluf_(a1[2]) * b1[2], siluf_(a1[3]) * b1[3], F8_SA)};
                else *(u32x4*)(H + (size_t)MP * DFF + fo_index(row - MP, hc0, DFF)) = w; }
    }
};
struct EpiResid {
    static constexpr bool PERM = false, AFTER_DRAIN = false;
    const float* xin_p; const float* xin_s; float* out; const float* gmod; float coef;
    __device__ __forceinline__ void operator()(const f32x4 (&acc)[2][2][4][2], const Unit& u, int wr, int wc, int fr, int fq) const {
        const int row0 = u.pm * BM + wr * 64 + fr, col0 = u.pn * BM + wc * 32 + 4 * fq;
#pragma unroll
        for (int ai = 0; ai < 2; ++ai)
#pragma unroll
            for (int m = 0; m < 4; ++m) { const int row = row0 + ai * HALF + m * 16;
                const float* xr = (row < MP ? xin_p + (size_t)row * DM : xin_s + (size_t)(row - MP) * DM) + col0;
                const float* gr = gmod + (size_t)bid_of_row(row) * NMOD + col0; float* orow = out + (size_t)row * DM + col0;
#pragma unroll
                for (int bj = 0; bj < 2; ++bj)
#pragma unroll
                    for (int n = 0; n < 2; ++n) { const int o = bj * HALF + n * 16; const f32x4 xv = *(const f32x4*)(xr + o), gv = *(const f32x4*)(gr + o);
                        *(f32x4*)(orow + o) = xv + coef * gv * acc[ai][bj][m][n]; } }
    }
};

__device__ __forceinline__ void panel_wait(unsigned* cnt, unsigned need) {
    unsigned spins = 0;
    while ((unsigned)__builtin_amdgcn_readfirstlane(__hip_atomic_load(cnt, __ATOMIC_RELAXED, __HIP_MEMORY_SCOPE_AGENT)) < need) { if (++spins > (1u << 20)) break; __builtin_amdgcn_s_sleep(2); }
    __builtin_amdgcn_fence(__ATOMIC_ACQUIRE, "agent");
}
template <bool FINAL>
struct EpiResidNorm {
    static constexpr bool PERM = true, AFTER_DRAIN = true;
    const float* xin; float* Xout; const float* gmod; const float* gw; const float* shmod; const float* scmod; bf16_t* Uout; float* Yout; float* XS; unsigned* cnt; float coef; int pad_;
    __device__ __forceinline__ void fused(f32x4 (&acc)[2][2][4][2], const Unit& u, int wr, int wc, int fr, int fq, LAS unsigned char* lds, int wid, int lane) const {
        LAS float* P = (LAS float*)lds; LAS float* S = (LAS float*)(lds + 4096);
        const float* const xin_ = xin; float* const Xout_ = Xout; const float* const gmod_ = gmod; const float coef_ = coef; const float* const gw_ = gw; const float* const shmod_ = shmod; const float* const scmod_ = scmod;
        bf16_t* const Uout_ = Uout; float* const Yout_ = Yout; float* const XS_ = XS; unsigned* const cnt_ = cnt;
        const int b = u.pm >> 3, col0 = u.pn * BM + wc * 32 + 8 * fq, rowt = wr * 64 + fr;
        { f32x4 gv[2][2];
#pragma unroll
          for (int bj = 0; bj < 2; ++bj)
#pragma unroll
              for (int n = 0; n < 2; ++n) gv[bj][n] = coef_ * *(const f32x4*)(gmod_ + (size_t)b * NMOD + col0 + bj * HALF + n * 4);
#pragma unroll
          for (int ai = 0; ai < 2; ++ai)
#pragma unroll
              for (int m = 0; m < 4; ++m) { const int rt = rowt + ai * HALF + m * 16; const float* xr = xin_ + (size_t)(u.pm * BM + rt) * DM + col0; float ss = 0.f;
#pragma unroll
                  for (int bj = 0; bj < 2; ++bj)
#pragma unroll
                      for (int n = 0; n < 2; ++n) { const f32x4 x = *(const f32x4*)(xr + bj * HALF + n * 4) + gv[bj][n] * acc[ai][bj][m][n]; acc[ai][bj][m][n] = x; ss += (x[0] * x[0] + x[1] * x[1]) + (x[2] * x[2] + x[3] * x[3]); }
                  ss += __shfl_xor(ss, 16); ss += __shfl_xor(ss, 32);
                  if (fq == 0) P[rt * 4 + wc] = ss;
                  asm volatile("" ::: "memory"); } }
        __syncthreads();
        const int r32 = wid * 32 + (lane & 31); float* slot = XS_ + (size_t)(u.pm * BM + r32) * 16;
        if (lane < 32) { const f32x4 pp = *(const LAS f32x4*)(P + r32 * 4); __hip_atomic_store(slot + u.pn, (pp[0] + pp[1]) + (pp[2] + pp[3]), __ATOMIC_RELAXED, __HIP_MEMORY_SCOPE_AGENT); }
        asm volatile("s_waitcnt vmcnt(0)" ::: "memory");
        if (lane == 0) __hip_atomic_fetch_add(cnt_ + 64 * u.pm, 1u, __ATOMIC_RELAXED, __HIP_MEMORY_SCOPE_AGENT);
        if (wid == 0) panel_wait(cnt_ + 64 * u.pm, 32u);
        asm volatile("s_waitcnt vmcnt(0) lgkmcnt(0)" ::: "memory");
        __syncthreads();
        if (lane < 32) { float tot = 0.f;
#pragma unroll
            for (int t = 0; t < 4; ++t) tot += __hip_atomic_load(slot + t, __ATOMIC_RELAXED, __HIP_MEMORY_SCOPE_AGENT);
            S[r32] = 1.0f / sqrtf(tot * (1.0f / DM) + EPS); }
        __syncthreads();
        f32x4 fac[2][2], shv[2][2];
#pragma unroll
        for (int bj = 0; bj < 2; ++bj)
#pragma unroll
            for (int n = 0; n < 2; ++n) { const int c = col0 + bj * HALF + n * 4; fac[bj][n] = *(const f32x4*)(gw_ + c);
                if constexpr (!FINAL) { fac[bj][n] = fac[bj][n] * (1.0f + *(const f32x4*)(scmod_ + (size_t)b * NMOD + c)); shv[bj][n] = *(const f32x4*)(shmod_ + (size_t)b * NMOD + c); } }
#pragma unroll
        for (int ai = 0; ai < 2; ++ai)
#pragma unroll
            for (int m = 0; m < 4; ++m) { const int rt = rowt + ai * HALF + m * 16; const size_t off = (size_t)(u.pm * BM + rt) * DM + col0; const float r = S[rt];
#pragma unroll
                for (int bj = 0; bj < 2; ++bj) { const f32x4 x0 = acc[ai][bj][m][0], x1 = acc[ai][bj][m][1]; const int o = bj * HALF;
                    if constexpr (FINAL) { *(f32x4*)(Yout_ + off + o) = x0 * r * fac[bj][0]; *(f32x4*)(Yout_ + off + o + 4) = x1 * r * fac[bj][1]; }
                    else { *(f32x4*)(Xout_ + off + o) = x0; *(f32x4*)(Xout_ + off + o + 4) = x1;
                        const f32x4 y0 = x0 * r * fac[bj][0] + shv[bj][0], y1 = x1 * r * fac[bj][1] + shv[bj][1];
                        if (pad_) *(u32x2*)((unsigned char*)Uout_ + off + o) = (u32x2){pack4_fp8(y0[0], y0[1], y0[2], y0[3], F8_SA), pack4_fp8(y1[0], y1[1], y1[2], y1[3], F8_SA)};
                        else { const u32x2 w0 = pack4(y0), w1 = pack4(y1); *(u32x4*)(Uout_ + off + o) = (u32x4){w0.x, w0.y, w1.x, w1.y}; } } } }
    }
};
struct EpiZin {
    static constexpr bool PERM = true, AFTER_DRAIN = false;
    bf16_t* Z; float* gates;
    __device__ __forceinline__ void operator()(const f32x4 (&acc)[2][2][4][2], const Unit& u, int wr, int wc, int fr, int fq) const {
        const int row0 = u.pm * BM + wr * 64 + fr;
        {
            const int col0 = u.pn * BM + wc * 32 + 8 * fq;
#pragma unroll
            for (int ai = 0; ai < 2; ++ai)
#pragma unroll
                for (int m = 0; m < 4; ++m) { bf16_t* rp = Z + (size_t)(row0 + ai * HALF + m * 16) * ZP + col0;
#pragma unroll
                    for (int bj = 0; bj < 2; ++bj) { const f32x4 v0 = acc[ai][bj][m][0], v1 = acc[ai][bj][m][1];
                        u32x4 w; w.x = cvt_pk_bf16(v0[0], v0[1]); w.y = cvt_pk_bf16(v0[2], v0[3]); w.z = cvt_pk_bf16(v1[0], v1[1]); w.w = cvt_pk_bf16(v1[2], v1[3]);
                        *(u32x4*)(rp + bj * HALF) = w; } }
        }
    }
};
struct EpiMerge {
    static constexpr bool PERM = true, AFTER_DRAIN = false;
    const bf16_t* Z; float* tmp; bf16_t* U;
    __device__ __forceinline__ void operator()(const f32x4 (&acc)[2][2][4][2], const Unit& u, int wr, int wc, int fr, int fq) const {
        const int row0 = u.pm * BM + wr * 64 + fr, col0 = u.pn * BM + wc * 32 + 8 * fq;
        const int zoff = u.w ? ZGB : ZGA;
#pragma unroll
        for (int ai = 0; ai < 2; ++ai)
#pragma unroll
            for (int m = 0; m < 4; ++m) { const int row = row0 + ai * HALF + m * 16;
#pragma unroll
                for (int bj = 0; bj < 2; ++bj) { const int c = col0 + bj * HALF;
                    const u32x4 gz = *(const u32x4*)(Z + (size_t)row * ZP + zoff + c);
                    f32x4 s0, s1; s0[0] = sigmoidf_(bflo(gz.x)); s0[1] = sigmoidf_(bfhi(gz.x)); s0[2] = sigmoidf_(bflo(gz.y)); s0[3] = sigmoidf_(bfhi(gz.y));
                    s1[0] = sigmoidf_(bflo(gz.z)); s1[1] = sigmoidf_(bfhi(gz.z)); s1[2] = sigmoidf_(bflo(gz.w)); s1[3] = sigmoidf_(bfhi(gz.w));
                    f32x4 v0 = s0 * acc[ai][bj][m][0], v1 = s1 * acc[ai][bj][m][1];
                    u32x4* up = (u32x4*)(U + (size_t)row * DM + c);
                    if (u.w != 0) { const u32x4 pv = *up; v0[0] += bflo(pv.x); v0[1] += bfhi(pv.x); v0[2] += bflo(pv.y); v0[3] += bfhi(pv.y); v1[0] += bflo(pv.z); v1[1] += bfhi(pv.z); v1[2] += bflo(pv.w); v1[3] += bfhi(pv.w); }
                    u32x4 w; w.x = cvt_pk_bf16(v0[0], v0[1]); w.y = cvt_pk_bf16(v0[2], v0[3]); w.z = cvt_pk_bf16(v1[0], v1[1]); w.w = cvt_pk_bf16(v1[2], v1[3]);
                    *up = w; } }
    }
};
}


struct Frame {
    LAS unsigned char* lds;
    int tid, lane, wave, G, bx;
    float* out; unsigned char* ws;
};
constexpr int PTAB_OFF = 147072;
__device__ __forceinline__ const float* pin_ld(const Frame& F, const int k) {
    const volatile LAS unsigned* T = (const volatile LAS unsigned*)(F.lds + PTAB_OFF);
    const unsigned lo = (unsigned)__builtin_amdgcn_readfirstlane((int)T[2 * k]), hi = (unsigned)__builtin_amdgcn_readfirstlane((int)T[2 * k + 1]);
    return (const float*)(((uint64_t)hi << 32) | (uint64_t)lo);
}
#define PIN(k) pin_ld(F, (k))

template <int KTOT, bool FOA, bool FOB>
__device__ __forceinline__ void small_gemm_partials(LAS unsigned char* lds, const bf16_t* A, const bf16_t* Bt, int wave, int lane) {
    const int fr = lane & 15, fq = lane >> 4; constexpr int NKS = KTOT / 256; const int T0 = wave * NKS;
    const bf16_t* ap = A + (size_t)fr * KTOT + 8 * fq; const bf16_t* bp = Bt + (size_t)fr * KTOT + 8 * fq;
    f32x4 acc[4][4];
#pragma unroll
    for (int i = 0; i < 4; ++i)
#pragma unroll
        for (int j = 0; j < 4; ++j) acc[i][j] = (f32x4){0.f, 0.f, 0.f, 0.f};
    bf16x8 a[4][4], b[4][4];
#define SG_LOAD(slot, t) do { const int T_ = T0 + (t), ko_ = 32 * T_; _Pragma("unroll") for (int i = 0; i < 4; ++i) { \
        if constexpr (FOA) a[slot][i] = *(const bf16x8*)(A + ((size_t)(i * (KTOT / 32) + T_)) * 512 + 8 * lane); else a[slot][i] = *(const bf16x8*)(ap + (size_t)(16 * i) * KTOT + ko_); \
        if constexpr (FOB) b[slot][i] = *(const bf16x8*)(Bt + ((size_t)(i * (KTOT / 32) + T_)) * 512 + 8 * lane); else b[slot][i] = *(const bf16x8*)(bp + (size_t)(16 * i) * KTOT + ko_); } } while (0)
#pragma unroll
    for (int t = 0; t < 4 && t < NKS; ++t) SG_LOAD(t, t);
    __builtin_amdgcn_sched_barrier(0);
#pragma unroll
    for (int t = 0; t < NKS; ++t) {
#pragma unroll
        for (int tn = 0; tn < 4; ++tn)
#pragma unroll
            for (int tm = 0; tm < 4; ++tm) acc[tn][tm] = __builtin_amdgcn_mfma_f32_16x16x32_bf16(b[t & 3][tn], a[t & 3][tm], acc[tn][tm], 0, 0, 0);
        __builtin_amdgcn_sched_barrier(0);
        if (t + 4 < NKS) { SG_LOAD(t & 3, t + 4); __builtin_amdgcn_sched_barrier(0); } }
#undef SG_LOAD
    LAS f32x4* PART = (LAS f32x4*)lds;
#pragma unroll
    for (int tn = 0; tn < 4; ++tn)
#pragma unroll
        for (int tm = 0; tm < 4; ++tm) PART[(wave * 16 + tn * 4 + tm) * 64 + lane] = acc[tn][tm];
}
__device__ __forceinline__ f32x4 small_gemm_sum(LAS unsigned char* lds, int tid, int j) {
    const LAS f32x4* PART = (const LAS f32x4*)lds; const int tile = 8 * j + (tid >> 6), ln = tid & 63; f32x4 sum = PART[tile * 64 + ln];
#pragma unroll
    for (int wv = 1; wv < 8; ++wv) sum += PART[(wv * 16 + tile) * 64 + ln];
    return sum;
}
template <int KTOT>
__device__ __forceinline__ void small_phase_resid(Frame& F, const bf16_t* A, const bf16_t* Bt, const float* xin_s, float* out, const float* gmod, float coef) {
    for (int st = F.bx; st < 256; st += F.G) { const int x = st & 7, j = st >> 3, sm = 4 * (x >> 1) + (j >> 3), sn = 8 * (x & 1) + (j & 7);
        __syncthreads();
        small_gemm_partials<KTOT, true, true>(F.lds, A + (size_t)(MP + 64 * sm) * KTOT, Bt + (size_t)(64 * sn) * KTOT, F.wave, F.lane);
        __syncthreads();
#pragma unroll
        for (int j = 0; j < 2; ++j) { const f32x4 v = small_gemm_sum(F.lds, F.tid, j); const int tile = 8 * j + (F.tid >> 6), tn = tile >> 2, tm = tile & 3;
            const int ms = 64 * sm + 16 * tm + (F.lane & 15), n = 64 * sn + 16 * tn + 4 * (F.lane >> 4), row = MP + ms;
            const f32x4 xv = *(const f32x4*)(xin_s + (size_t)ms * DM + n), gv = *(const f32x4*)(gmod + (size_t)pg8::bid_of_row(row) * NMOD + n);
            *(f32x4*)(out + (size_t)row * DM + n) = xv + coef * gv * v; } }
}
template <int KTOT, bool FINAL>
__device__ __forceinline__ void small_phase_resid_norm(Frame& F, const bf16_t* A, const bf16_t* Bt, const float* xin_s, float* Xout, const float* gmod, float coef,
                                                       const float* gw, const float* shmod, const float* scmod, bf16_t* Uout, float* Yout, float* XS, unsigned* cnt) {
    LAS float* P2 = (LAS float*)(F.lds + 131072); LAS float* S2 = (LAS float*)(F.lds + 131072 + 512);
    for (int st = F.bx; st < 256; st += F.G) { const int x = st & 7, j0 = st >> 3, sm = 4 * (x >> 1) + (j0 >> 3), sn = 8 * (x & 1) + (j0 & 7);
        __syncthreads();
        small_gemm_partials<KTOT, true, true>(F.lds, A + (size_t)(MP + 64 * sm) * KTOT, Bt + (size_t)(64 * sn) * KTOT, F.wave, F.lane);
        __syncthreads();
        const int fr = F.lane & 15, fq = F.lane >> 4, tm = F.wave & 3, rl = 16 * tm + fr, ms = 64 * sm + rl, row = MP + ms, bid = NBP + (ms >> 3);
        f32x4 xn[2]; float ss = 0.f;
#pragma unroll
        for (int j = 0; j < 2; ++j) { const int n = 64 * sn + 16 * (2 * j + (F.wave >> 2)) + 4 * fq;
            const f32x4 x4 = *(const f32x4*)(xin_s + (size_t)ms * DM + n) + coef * *(const f32x4*)(gmod + (size_t)bid * NMOD + n) * small_gemm_sum(F.lds, F.tid, j);
            xn[j] = x4; ss += (x4[0] * x4[0] + x4[1] * x4[1]) + (x4[2] * x4[2] + x4[3] * x4[3]); }
        ss += __shfl_xor(ss, 16); ss += __shfl_xor(ss, 32);
        if (fq == 0) P2[(F.wave >> 2) * 64 + rl] = ss;
        __syncthreads();
        float* slot = XS + (size_t)(MP + 64 * sm + F.lane) * 16;
        if (F.wave == 0) { __hip_atomic_store(slot + sn, P2[F.lane] + P2[64 + F.lane], __ATOMIC_RELAXED, __HIP_MEMORY_SCOPE_AGENT);
            asm volatile("s_waitcnt vmcnt(0)" ::: "memory");
            if (F.lane == 0) __hip_atomic_fetch_add(cnt + 64 * (64 + sm), 1u, __ATOMIC_RELAXED, __HIP_MEMORY_SCOPE_AGENT);
            pg8::panel_wait(cnt + 64 * (64 + sm), 16u);
            float tot = 0.f;
#pragma unroll
            for (int t = 0; t < 16; ++t) tot += __hip_atomic_load(slot + t, __ATOMIC_RELAXED, __HIP_MEMORY_SCOPE_AGENT);
            S2[F.lane] = 1.0f / sqrtf(tot * (1.0f / DM) + EPS); }
        __syncthreads();
        const float r = S2[rl];
#pragma unroll
        for (int j = 0; j < 2; ++j) { const int n = 64 * sn + 16 * (2 * j + (F.wave >> 2)) + 4 * fq; const f32x4 g4 = *(const f32x4*)(gw + n);
            if constexpr (FINAL) *(f32x4*)(Yout + (size_t)row * DM + n) = xn[j] * r * g4;
            else { *(f32x4*)(Xout + (size_t)row * DM + n) = xn[j];
                const f32x4 yq = xn[j] * r * g4 * (1.0f + *(const f32x4*)(scmod + (size_t)bid * NMOD + n)) + *(const f32x4*)(shmod + (size_t)bid * NMOD + n);
                if constexpr (KTOT == DM) *(unsigned*)((unsigned char*)Uout + (size_t)row * DM + n) = pack4_fp8(yq[0], yq[1], yq[2], yq[3], F8_SA);
                else *(u32x2*)(Uout + (size_t)row * DM + n) = pack4(yq); } } }
}
__device__ __forceinline__ void small_gates_tile(Frame& F, const bf16_t* U, const bf16_t* Wg, float* gates, const int st) {
    {
        __syncthreads();
        small_gemm_partials<DM, false, true>(F.lds, U + (size_t)(64 * st) * DM, Wg, F.wave, F.lane);
        __syncthreads();
#pragma unroll
        for (int j = 0; j < 2; ++j) { const f32x4 v = small_gemm_sum(F.lds, F.tid, j); const int tile = 8 * j + (F.tid >> 6), tn = tile >> 2, tm = tile & 3;
            *(f32x4*)(gates + (size_t)(64 * st + 16 * tm + (F.lane & 15)) * 64 + 16 * tn + 4 * (F.lane >> 4)) = v; } }
}
__device__ __forceinline__ void small_phase_merge(Frame& F, const bf16_t* HA, const bf16_t* HB, const bf16_t* WA, const bf16_t* WB, const bf16_t* Z, bf16_t* U) {
    for (int st = F.bx; st < 256; st += F.G) { const int x = st & 7, j = st >> 3, sm = 4 * (x >> 1) + (j >> 3), sn = 8 * (x & 1) + (j & 7); f32x4 va[2], vb[2];
        __syncthreads();
        small_gemm_partials<2048, true, true>(F.lds, HA + (size_t)(MP + 64 * sm) * 2048, WA + (size_t)(64 * sn) * 2048, F.wave, F.lane);
        __syncthreads();
        va[0] = small_gemm_sum(F.lds, F.tid, 0); va[1] = small_gemm_sum(F.lds, F.tid, 1);
        __syncthreads();
        small_gemm_partials<2048, true, true>(F.lds, HB + (size_t)(MP + 64 * sm) * 2048, WB + (size_t)(64 * sn) * 2048, F.wave, F.lane);
        __syncthreads();
        vb[0] = small_gemm_sum(F.lds, F.tid, 0); vb[1] = small_gemm_sum(F.lds, F.tid, 1);
#pragma unroll
        for (int j = 0; j < 2; ++j) { const int tile = 8 * j + (F.tid >> 6), tn = tile >> 2, tm = tile & 3;
            const int row = MP + 64 * sm + 16 * tm + (F.lane & 15), n = 64 * sn + 16 * tn + 4 * (F.lane >> 4);
            const u32x2 ga = *(const u32x2*)(Z + (size_t)row * ZP + ZGA + n), gb = *(const u32x2*)(Z + (size_t)row * ZP + ZGB + n);
            f32x4 o; o[0] = sigmoidf_(bflo(ga.x)) * va[j][0] + sigmoidf_(bflo(gb.x)) * vb[j][0]; o[1] = sigmoidf_(bfhi(ga.x)) * va[j][1] + sigmoidf_(bfhi(gb.x)) * vb[j][1];
            o[2] = sigmoidf_(bflo(ga.y)) * va[j][2] + sigmoidf_(bflo(gb.y)) * vb[j][2]; o[3] = sigmoidf_(bfhi(ga.y)) * va[j][3] + sigmoidf_(bfhi(gb.y)) * vb[j][3];
            *(u32x2*)(U + (size_t)MP * DM + fo_index(row - MP, n, DM)) = pack4(o); } }
}

#define GAS __attribute__((address_space(1)))
#define XB_TMO      128
#define XB_XCNT(j)  (256  + 64 * (j))
#define XB_XSUB(j)  (1280 + 64 * (j))
#define XB_XGEN(j)  (2304 + 64 * (j))
#define XB_TOP      3328
#define XB_TOPGEN   3392
#define XCD_BAR_WORDS 3456
#define XB_SPIN_CAP (1u << 22)
__device__ __forceinline__ unsigned xb_ld(unsigned* p)              { return __hip_atomic_load(p, __ATOMIC_RELAXED, __HIP_MEMORY_SCOPE_AGENT); }
__device__ __forceinline__ unsigned xb_add(unsigned* p, unsigned v) { return __hip_atomic_fetch_add(p, v, __ATOMIC_RELAXED, __HIP_MEMORY_SCOPE_AGENT); }
__device__ __forceinline__ unsigned xb_xcc_id() { return (unsigned)__builtin_amdgcn_s_getreg((3 << 11) | 20) & 0xFu; }
#define XB_SPIN(cond, bar) do { unsigned _sp = 0; while (cond) { __builtin_amdgcn_s_sleep(1); \
    if ((++_sp & 255u) == 0u) { if (xb_ld(&(bar)[XB_TMO])) break; if (_sp > XB_SPIN_CAP) { atomicAdd(&(bar)[XB_TMO], 1u); break; } } } } while (0)
struct XcdBarrier { unsigned* bar; unsigned x; volatile LAS unsigned* st; };
__device__ __forceinline__ XcdBarrier xcd_barrier_post(unsigned* bar, volatile LAS unsigned* st) {
    XcdBarrier b; b.bar = bar; b.x = xb_xcc_id(); b.st = st;
    if (threadIdx.x == 0) (void)xb_add(&bar[XB_XCNT(b.x)], 1u);
    return b;
}
__device__ __forceinline__ void xcd_barrier_complete(unsigned* bar, unsigned x, unsigned& nloc, unsigned& nx) {
    const unsigned G = gridDim.x * gridDim.y * gridDim.z;
    unsigned sum, cnt, mine, sp = 0u;
    for (;;) {
        sum = 0u; cnt = 0u; mine = 0u;
#pragma unroll
        for (unsigned j = 0; j < 16; ++j) { const unsigned c = xb_ld(&bar[XB_XCNT(j)]); sum += c; cnt += (c > 0u) ? 1u : 0u; mine = (j == x) ? c : mine; }
        if (sum == G) break;
        __builtin_amdgcn_s_sleep(1);
        if ((++sp & 255u) == 0u) { if (xb_ld(&bar[XB_TMO])) break; if (sp > XB_SPIN_CAP) { atomicAdd(&bar[XB_TMO], 1u); break; } }
    }
    nloc = mine > 0u ? mine : 1u; nx = cnt > 0u ? cnt : 1u;
}
__device__ __forceinline__ void xcd_barrier(const XcdBarrier& b) {
    asm volatile("s_waitcnt vmcnt(0)" ::: "memory");
    __syncthreads();
    if (threadIdx.x == 0) {
        unsigned* bar = b.bar;
        __builtin_amdgcn_s_waitcnt(0);
        unsigned nloc = b.st[0], nx = b.st[1];
        if (nloc == 0u) { xcd_barrier_complete(bar, b.x, nloc, nx); b.st[0] = nloc; b.st[1] = nx; }
        const unsigned old = xb_add(&bar[XB_XSUB(b.x)], 1u);
        const unsigned gen = old / nloc;
        if (old + 1u == (gen + 1u) * nloc) {
            __builtin_amdgcn_fence(__ATOMIC_RELEASE, "agent");
            asm volatile("s_waitcnt vmcnt(0)" ::: "memory");
            const unsigned og = xb_add(&bar[XB_TOP], 1u);
            const unsigned tg = og / nx;
            if (og + 1u == (tg + 1u) * nx) xb_add(&bar[XB_TOPGEN], 1u);
            else XB_SPIN(xb_ld(&bar[XB_TOPGEN]) == tg, bar);
            __builtin_amdgcn_fence(__ATOMIC_ACQUIRE, "agent");
            xb_add(&bar[XB_XGEN(b.x)], 1u);
            asm volatile("s_waitcnt vmcnt(0)" ::: "memory");
        } else {
            XB_SPIN(xb_ld(&bar[XB_XGEN(b.x)]) == gen, bar);
            __builtin_amdgcn_fence(__ATOMIC_ACQUIRE, "agent");
            asm volatile("s_waitcnt vmcnt(0)" ::: "memory");
        }
    }
    __syncthreads();
}


template <class SrcFn>
__device__ __forceinline__ void transpose_item(const SrcFn& src, int K, bf16_t* WT, LAS float* scr, int item, int lane, int nblk, bf16_t* WF = nullptr, int fo_row0 = 0) {
    const int kb = item / nblk, nb = item % nblk, k0 = 64 * kb, n0 = 32 * nb;
    const size_t stride = (size_t)src.stride(); const float* colp = src(n0 + (lane & 31));
    float tv[32];
#pragma unroll
    for (int i = 0; i < 32; ++i) { const int kk = 2 * i + (lane >> 5); tv[i] = colp ? colp[(size_t)(k0 + kk) * stride] : 0.f; }
#pragma unroll
    for (int i = 0; i < 32; ++i) { const int kk = 2 * i + (lane >> 5); scr[kk * 33 + (lane & 31)] = tv[i]; }
    asm volatile("s_waitcnt lgkmcnt(0)" ::: "memory");
    const int c = lane & 7;
#pragma unroll
    for (int j = 0; j < 4; ++j) { const int n = (lane >> 3) + 8 * j; const LAS float* s = scr + (8 * c) * 33 + n;
        if constexpr (SrcFn::F8) *(u32x2*)((unsigned char*)WT + (size_t)(n0 + n) * K + k0 + 8 * c) = (u32x2){pack4_fp8(s[0 * 33], s[1 * 33], s[2 * 33], s[3 * 33], F8_SW), pack4_fp8(s[4 * 33], s[5 * 33], s[6 * 33], s[7 * 33], F8_SW)};
        if constexpr (SrcFn::F8) { if (WF == nullptr) continue; }
        u32x4 o; o.x = cvt_pk_bf16(s[0 * 33], s[1 * 33]); o.y = cvt_pk_bf16(s[2 * 33], s[3 * 33]); o.z = cvt_pk_bf16(s[4 * 33], s[5 * 33]); o.w = cvt_pk_bf16(s[6 * 33], s[7 * 33]);
        if constexpr (!SrcFn::F8) *(u32x4*)(WT + (size_t)(n0 + n) * K + k0 + 8 * c) = o;
        if (WF != nullptr && n0 >= fo_row0) *(u32x4*)(WF + fo_index(n0 + n - fo_row0, k0 + 8 * c, K)) = o; }
    asm volatile("s_waitcnt lgkmcnt(0)" ::: "memory");
}
struct SrcPlain { static constexpr bool F8 = false; const float* W; int N; __device__ __forceinline__ int stride() const { return N; } __device__ __forceinline__ const float* operator()(int n) const { return W + n; } };
struct SrcPlain8 { static constexpr bool F8 = true; const float* W; int N; __device__ __forceinline__ int stride() const { return N; } __device__ __forceinline__ const float* operator()(int n) const { return W + n; } };
struct SrcUp { static constexpr bool F8 = true; const float* W1; const float* W3; __device__ __forceinline__ int stride() const { return DFF; } __device__ __forceinline__ const float* operator()(int n) const { const int T = n >> 8, i = n & 255; const uintptr_t a = (uintptr_t)W1, b = (uintptr_t)W3, msk = (uintptr_t)0 - (uintptr_t)(i >> 7);
        return (const float*)((a & ~msk) | (b & msk)) + 128 * T + (i & 127); } };
struct SrcWin { static constexpr bool F8 = false; const float* W; __device__ __forceinline__ int stride() const { return 13352; } __device__ __forceinline__ const float* operator()(int r) const { int o;
        if (r < 6144) o = r; else if (r < 8192) o = 6152 + (r - 6144); else if (r < 11264) o = 8200 + (r - 8192); else if (r < 13312) o = 11304 + (r - 11264);
        else if (r < 13320) o = 6144 + (r - 13312); else if (r < 13352) o = 11272 + (r - 13320); else return nullptr;
        return W + o; } };

template <int PPART>
__device__ __forceinline__ void phase_prep(Frame& F, const Params& p) {
    LAS float* scr = (LAS float*)(F.lds + F.wave * 16384);
    const int gw = (PPART == 0 ? F.bx : F.bx - 192) * 8 + F.wave, NGW = (PPART == 0 ? F.G : 64) * 8;
    bf16_t* wup1 = (bf16_t*)(F.ws + WS_WUP1); bf16_t* wdn1 = (bf16_t*)(F.ws + WS_WDN1); bf16_t* wup2 = (bf16_t*)(F.ws + WS_WUP2); bf16_t* wdn2 = (bf16_t*)(F.ws + WS_WDN2);
    bf16_t* win = (bf16_t*)(F.ws + WS_WIN); bf16_t* wpa = (bf16_t*)(F.ws + WS_WPA); bf16_t* wpb = (bf16_t*)(F.ws + WS_WPB); bf16_t* wout = (bf16_t*)(F.ws + WS_WOUT);
    constexpr int I_UP = (DM / 64) * (2 * DFF / 32), I_DN = (DFF / 64) * (DM / 32), I_IN = (DM / 64) * (ZP / 32), I_P = (2048 / 64) * (DM / 32), I_O = (DM / 64) * (DM / 32);
    constexpr int NITEMS = 2 * I_UP + 2 * I_DN + I_IN + 2 * I_P + I_O;
    for (int it = (PPART == 0 ? 0 : I_UP) + gw; it < (PPART == 0 ? I_UP : NITEMS); it += NGW) {
        int r = it;
        if (r < I_UP) { transpose_item(SrcUp{PIN(13), PIN(14)}, DM, wup1, scr, r, F.lane, 2 * DFF / 32); continue; } r -= I_UP;
        if (r < I_UP) { transpose_item(SrcUp{PIN(32), PIN(33)}, DM, wup2, scr, r, F.lane, 2 * DFF / 32); continue; } r -= I_UP;
        if (r < I_DN) { transpose_item(SrcPlain8{PIN(15), DM}, DFF, wdn1, scr, r, F.lane, DM / 32, (bf16_t*)(F.ws + WS_FDN1)); continue; } r -= I_DN;
        if (r < I_DN) { transpose_item(SrcPlain8{PIN(34), DM}, DFF, wdn2, scr, r, F.lane, DM / 32, (bf16_t*)(F.ws + WS_FDN2)); continue; } r -= I_DN;
        if (r < I_IN) { transpose_item(SrcWin{PIN(17)}, DM, win, scr, r, F.lane, ZP / 32, (bf16_t*)(F.ws + WS_FG), ZG); continue; } r -= I_IN;
        if (r < I_P) { transpose_item(SrcPlain{PIN(22), DM}, 2048, wpa, scr, r, F.lane, DM / 32, (bf16_t*)(F.ws + WS_FPA)); continue; } r -= I_P;
        if (r < I_P) { transpose_item(SrcPlain{PIN(29), DM}, 2048, wpb, scr, r, F.lane, DM / 32, (bf16_t*)(F.ws + WS_FPB)); continue; } r -= I_P;
        transpose_item(SrcPlain{PIN(30), DM}, DM, wout, scr, r, F.lane, DM / 32, (bf16_t*)(F.ws + WS_FOUT));
    }
    __syncthreads();
}
__device__ __forceinline__ void phase_silu_c(Frame& F, const Params& p) {
    const int ch = F.bx * NTHREADS + F.tid;
    if (ch < 144 * 128) { const int r = ch >> 7, k = 8 * (ch & 127); float x[8];
        if (r < NBID) { const float* cr = (r < NBP ? PIN(2) + (size_t)r * DM : PIN(3) + (size_t)(r - NBP) * DM) + k; const f32x4 c0 = *(const f32x4*)cr, c1 = *(const f32x4*)(cr + 4);
#pragma unroll
            for (int e = 0; e < 4; ++e) { x[e] = siluf_(c0[e]); x[4 + e] = siluf_(c1[e]); } }
        else {
#pragma unroll
            for (int e = 0; e < 8; ++e) x[e] = 0.f; }
        *(u32x4*)((bf16_t*)(F.ws + WS_SC) + fo_index(r, k, DM)) = pack8(x, 1.0f); }
}
__device__ __forceinline__ void phase_adaln(Frame& F, const Params& p) {
    const float* ada_w = PIN(10); const float* ada_b = PIN(11); float* mod = (float*)(F.ws + WS_MOD); const bf16_t* SCF = (const bf16_t*)(F.ws + WS_SC);
    LAS f32x4* PART = (LAS f32x4*)F.lds;
    const int lane = F.lane, w = F.wave, fr = lane & 15, fq = lane >> 4;
    const int t0 = F.bx < 64 ? 3 * F.bx : 192 + 2 * (F.bx - 64), nT = F.bx < 64 ? 3 : 2;
    f32x4 acc[3][9];
#pragma unroll
    for (int t = 0; t < 3; ++t)
#pragma unroll
        for (int rt = 0; rt < 9; ++rt) acc[t][rt] = (f32x4){0.f, 0.f, 0.f, 0.f};
#pragma unroll 1
    for (int ks = 0; ks < 4; ++ks) {
        const int k0 = 128 * w + 32 * ks + 8 * fq, kb = 4 * w + ks;
        bf16x8 af[9];
#pragma unroll
        for (int rt = 0; rt < 9; ++rt) af[rt] = *(const bf16x8*)(SCF + ((size_t)(rt * (DM / 32) + kb)) * 512 + 8 * lane);
#pragma unroll
        for (int t = 0; t < 3; ++t) if (t < nT) {
            float wv[8];
#pragma unroll
            for (int j = 0; j < 8; ++j) wv[j] = ada_w[(size_t)(k0 + j) * NMOD + 16 * (t0 + t) + fr];
            bf16x8 bfr; { const u32x4 tt = pack8(wv, 1.0f); bfr = __builtin_bit_cast(bf16x8, tt); }
#pragma unroll
            for (int rt = 0; rt < 9; ++rt) acc[t][rt] = __builtin_amdgcn_mfma_f32_16x16x32_bf16(af[rt], bfr, acc[t][rt], 0, 0, 0); }
    }
#pragma unroll
    for (int t = 0; t < 3; ++t) if (t < nT) {
        __syncthreads();
#pragma unroll
        for (int rt = 0; rt < 9; ++rt) PART[(w * 9 + rt) * 64 + lane] = acc[t][rt];
        __syncthreads();
        for (int idx = F.tid; idx < 9 * 64; idx += NTHREADS) { const int rt = idx >> 6, ln = idx & 63; f32x4 sum = PART[rt * 64 + ln];
#pragma unroll
            for (int ww = 1; ww < 8; ++ww) sum += PART[(ww * 9 + rt) * 64 + ln];
            const int n = 16 * (t0 + t) + (ln & 15); const float bv = ada_b[n];
#pragma unroll
            for (int r = 0; r < 4; ++r) { const int row = 16 * rt + 4 * (ln >> 4) + r; if (row < NBID) mod[(size_t)row * NMOD + n] = sum[r] + bv; } } }
}

__device__ __forceinline__ void phase_norm_mod(Frame& F, const float* xp, const float* xs, const float* gw, int shoff, int scoff, bf16_t* U) {
    const float* mod = (const float*)(F.ws + WS_MOD);
    const int gwv = F.bx * 8 + F.wave, NGW = F.G * 8;
    f32x4 g[4];
#pragma unroll
    for (int j = 0; j < 4; ++j) g[j] = *(const f32x4*)(gw + 4 * F.lane + 256 * j);
    for (int m = gwv; m < MT; m += NGW) {
        const float* xr = m < MP ? xp + (size_t)m * DM : xs + (size_t)(m - MP) * DM;
        const float* mr = mod + (size_t)pg8::bid_of_row(m) * NMOD;
        f32x4 v[4]; float s = 0.f;
#pragma unroll
        for (int j = 0; j < 4; ++j) { v[j] = *(const f32x4*)(xr + 4 * F.lane + 256 * j); s += (v[j][0] * v[j][0] + v[j][1] * v[j][1]) + (v[j][2] * v[j][2] + v[j][3] * v[j][3]); }
        const float r = 1.0f / sqrtf(wave_sum(s) * (1.0f / DM) + EPS);
#pragma unroll
        for (int j = 0; j < 4; ++j) { const f32x4 sh = *(const f32x4*)(mr + shoff + 4 * F.lane + 256 * j), scv = *(const f32x4*)(mr + scoff + 4 * F.lane + 256 * j);
            const f32x4 o = (v[j] * r * g[j]) * (1.0f + scv) + sh;
            *(unsigned*)((unsigned char*)U + (size_t)m * DM + 4 * F.lane + 256 * j) = pack4_fp8(o[0], o[1], o[2], o[3], F8_SA); }
    }
}
__device__ __forceinline__ void phase_final_norm(Frame& F, float* Y, const float* gw) {
    const int gwv = F.bx * 8 + F.wave, NGW = F.G * 8;
    f32x4 g[4];
#pragma unroll
    for (int j = 0; j < 4; ++j) g[j] = *(const f32x4*)(gw + 4 * F.lane + 256 * j);
    for (int m = gwv; m < MT; m += NGW) {
        float* xr = Y + (size_t)m * DM;
        f32x4 v[4]; float s = 0.f;
#pragma unroll
        for (int j = 0; j < 4; ++j) { v[j] = *(const f32x4*)(xr + 4 * F.lane + 256 * j); s += (v[j][0] * v[j][0] + v[j][1] * v[j][1]) + (v[j][2] * v[j][2] + v[j][3] * v[j][3]); }
        const float r = 1.0f / sqrtf(wave_sum(s) * (1.0f / DM) + EPS);
#pragma unroll
        for (int j = 0; j < 4; ++j) *(f32x4*)(xr + 4 * F.lane + 256 * j) = v[j] * r * g[j];
    }
}

constexpr size_t O_Y = 0, O_PC = 17825792, O_PN = 22020096, O_PM = 22028288, O_PMC = 22028320, O_PSSM = 22077472, O_PSC = 24174624,
                 O_SC = 24248352, O_SN = 91357216, O_SM = 91488288, O_SMC = 91488800, O_SSSM = 92275232, O_SSC = 125829664, O_END = 127009312;
constexpr int CVP = 5120;

__device__ __forceinline__ bf16x8 frag_row(LAS unsigned char* base, int stride, int row0, int k0, int lane) {
    return *(const LAS bf16x8*)(base + (row0 + (lane & 15)) * stride + (k0 + 8 * (lane >> 4)) * 2);
}
__device__ __forceinline__ bf16x8 frag_tr(LAS unsigned char* base, int stride, int krow0, int col0, int lane) {
    const int g = lane >> 4, q = (lane & 15) >> 2, pp = lane & 3;
    LAS unsigned char* a = base + (krow0 + 8 * g + q) * stride + (col0 + 4 * pp) * 2;
    const s16x4 lo = __builtin_amdgcn_ds_read_tr16_b64_v4i16((LAS s16x4*)a);
    const s16x4 hi = __builtin_amdgcn_ds_read_tr16_b64_v4i16((LAS s16x4*)(a + 4 * stride));
    return (bf16x8){lo.x, lo.y, lo.z, lo.w, hi.x, hi.y, hi.z, hi.w};
}
#define MFMA16(a, b, c) __builtin_amdgcn_mfma_f32_16x16x32_bf16((a), (b), (c), 0, 0, 0)

__device__ __forceinline__ float fast_log1pexp_neg(float ax) { return __builtin_amdgcn_logf(1.0f + fast_exp(-ax)) * 0.6931471805599453f; }
__device__ __forceinline__ float logsigmoidf_(float x) { return fminf(x, 0.f) - log1pf(expf(-fabsf(x))); }
__device__ __forceinline__ float softplusf_(float x) { return fmaxf(x, 0.f) + log1pf(expf(-fabsf(x))); }

__device__ __forceinline__ void conv_item(Frame& F, const Params& p, const int it) {
    const bf16_t* Z = (const bf16_t*)(F.ws + WS_ZIN); bf16_t* CV = (bf16_t*)(F.ws + WS_CV);
    const int lane = F.lane;
    {
        int m0, tb, nrows, strip; const float* hist = nullptr;
        if (it < 5120) { const int b = it / 640, r = it % 640; strip = r % 10; tb = (r / 10) * 32; m0 = b * SEQ; nrows = 32; }
        else { const int j = it - 5120, bs = j / 10; strip = j % 10; tb = 0; m0 = MP + bs * TS; nrows = 8; hist = strip < 4 ? PIN(7) + (size_t)bs * 3 * 2048 : PIN(9) + (size_t)bs * 3 * 3072; }
        const bool isM = strip < 4;
        const int c = strip * 512 + 8 * lane, zc = isM ? c : ZX + (c - 2048), cc = isM ? c : c - 2048, cs = isM ? 2048 : 3072;
        const float* cw = isM ? PIN(18) : PIN(23); const float* cb = isM ? PIN(19) : PIN(24);
        const float scl = (strip == 2 || strip == 3) ? 0.0625f : 1.0f;
        float w[4][8], bb[8], x0[8], x1[8], x2[8];
#pragma unroll
        for (int j = 0; j < 4; ++j) { const f32x4 a = *(const f32x4*)(cw + (size_t)j * cs + cc), b = *(const f32x4*)(cw + (size_t)j * cs + cc + 4);
#pragma unroll
            for (int e = 0; e < 4; ++e) { w[j][e] = a[e]; w[j][4 + e] = b[e]; } }
        { const f32x4 a = *(const f32x4*)(cb + cc), b = *(const f32x4*)(cb + cc + 4);
#pragma unroll
            for (int e = 0; e < 4; ++e) { bb[e] = a[e]; bb[4 + e] = b[e]; } }
        if (tb > 0) { unpack8(*(const u32x4*)(Z + (size_t)(m0 + tb - 3) * ZP + zc), x0); unpack8(*(const u32x4*)(Z + (size_t)(m0 + tb - 2) * ZP + zc), x1); unpack8(*(const u32x4*)(Z + (size_t)(m0 + tb - 1) * ZP + zc), x2); }
        else if (hist != nullptr) {
#pragma unroll
            for (int e = 0; e < 8; ++e) { x0[e] = hist[cc + e]; x1[e] = hist[cs + cc + e]; x2[e] = hist[2 * cs + cc + e]; } }
        else {
#pragma unroll
            for (int e = 0; e < 8; ++e) { x0[e] = 0.f; x1[e] = 0.f; x2[e] = 0.f; } }
        for (int t = 0; t < nrows; t += 8) {
            u32x4 raw[8];
#pragma unroll
            for (int i = 0; i < 8; ++i) raw[i] = *(const u32x4*)(Z + (size_t)(m0 + tb + t + i) * ZP + zc);
#pragma unroll
            for (int i = 0; i < 8; ++i) { float x3[8], o[8]; unpack8(raw[i], x3);
#pragma unroll
                for (int e = 0; e < 8; ++e) { o[e] = siluf_(bb[e] + w[0][e] * x0[e] + w[1][e] * x1[e] + w[2][e] * x2[e] + w[3][e] * x3[e]); x0[e] = x1[e]; x1[e] = x2[e]; x2[e] = x3[e]; }
                *(u32x4*)(CV + (size_t)(m0 + tb + t + i) * CVP + c) = pack8(o, scl); }
        }
    }
}
constexpr int NS_EARLY = 64;
__device__ __forceinline__ void phase_conv(Frame& F, const Params& p) {
    const int gw = F.bx * 8 + F.wave, NGW = F.G * 8;
    for (int it = gw; it < 5120 + 1280 - 10 * NS_EARLY; it += NGW) conv_item(F, p, it < 5120 ? it : it + 10 * NS_EARLY);
}

constexpr int QSTR = 528, VSTR = 144;
constexpr int L_QS = 0, L_KS = 33792, L_CT = 67584, L_VS = 101376, L_VW = 110592, L_SB = 119808, L_SCAL = 129024, L_NST = 132096, L_QNP = 133120, L_DENP = 135168, L_NUMB = 135680;

__device__ __forceinline__ float mlstm_scan(float ipre, float fpre, int lane, float mstate, LAS float* sc) {
    const float lf = fminf(fpre, 0.f) - fast_log1pexp_neg(fabsf(fpre));
    const float b = wave_scan_add(lf);
    const float a = ipre - b;
    const float cm = wave_scan_max(a);
    const float A = fmaxf(mstate, cm);
    const float Alast = __shfl(A, 63), blast = __shfl(b, 63);
    sc[lane] = a; sc[64 + lane] = A; sc[128 + lane] = fast_exp(mstate - A); sc[192 + lane] = fast_exp(-(b + A)); sc[256 + lane] = fast_exp(a - Alast);
    if (lane == 0) sc[320] = fast_exp(mstate - Alast);
    return blast + Alast;
}

__device__ __forceinline__ void mlstm_prompt_item(Frame& F, const Params& p, const int b, const int h, const int vs) {
    LAS unsigned char* L = F.lds;
    const int tid = F.tid, lane = F.lane, w = F.wave, fr = lane & 15, fq = lane >> 4;
    const bf16_t* Z = (const bf16_t*)(F.ws + WS_ZIN); const bf16_t* CV = (const bf16_t*)(F.ws + WS_CV); const float* GT = (const float*)(F.ws + WS_GATES);
    bf16_t* NUM = (bf16_t*)(F.ws + WS_NUM); float* DEN = (float*)(F.ws + WS_DEN);
    const float ifbi = PIN(20)[h], ifbf = PIN(20)[4 + h];
    constexpr int nch = SEQ / 64; const int m0 = b * SEQ;
    LAS float* SC = (LAS float*)(L + L_SCAL); LAS unsigned char* NSTB = L + L_NST; LAS float* DENP = (LAS float*)(L + L_DENP);
    f32x4 cacc[2][4];
#pragma unroll
    for (int dt = 0; dt < 2; ++dt)
#pragma unroll
        for (int vi = 0; vi < 4; ++vi) cacc[dt][vi] = (f32x4){0.f, 0.f, 0.f, 0.f};
    f32x4 nacc[2] = {{0.f, 0.f, 0.f, 0.f}, {0.f, 0.f, 0.f, 0.f}};
    float mstate = 0.f;
    u32x4 pq[4], pk[4], pv; float gi = 0.f, gf = 0.f;
    const bf16_t* qsrc = CV + (size_t)(m0 + (tid >> 5)) * CVP + h * 256 + 8 * (tid & 31);
    const bf16_t* vsrc = Z + (size_t)(m0 + (tid >> 3)) * ZP + ZV + h * 512 + vs * 64 + 8 * (tid & 7);
    const float* gsrc = GT + (size_t)(m0 + lane) * 64 + h;
#define ML_LOAD(c) do { _Pragma("unroll") for (int i = 0; i < 4; ++i) { pq[i] = *(const u32x4*)(qsrc + (size_t)((c) * 64 + 16 * i) * CVP); pk[i] = *(const u32x4*)(qsrc + (size_t)((c) * 64 + 16 * i) * CVP + 1024); } \
        pv = *(const u32x4*)(vsrc + (size_t)((c) * 64) * ZP); if (w == 0) { gi = gsrc[(size_t)((c) * 64) * 64]; gf = gsrc[(size_t)((c) * 64) * 64 + 4]; } } while (0)
    u32x4 numst = {0u, 0u, 0u, 0u}; float denst = 0.f;
    bf16_t* numdst = NUM + (size_t)(m0 + (tid >> 3)) * 2048 + h * 512 + vs * 64 + 8 * (tid & 7);
#define ML_STORE(c) do { *(u32x4*)(numdst + (size_t)((c) * 64) * 2048) = numst; \
        if (vs == 0 && w < 4 && fq == 0) DEN[(size_t)(m0 + (c) * 64 + 16 * w + fr) * 4 + h] = denst; } while (0)
    ML_LOAD(0);
    __syncthreads();
#pragma unroll
    for (int dt = 0; dt < 2; ++dt)
#pragma unroll
        for (int vi = 0; vi < 4; ++vi) *(LAS u32x2*)(L + L_CT + (16 * vi + fr) * QSTR + (32 * w + 16 * dt + 4 * fq) * 2) = (u32x2){0u, 0u};
    if (tid < 128) *(LAS unsigned*)(NSTB + 4 * tid) = 0u;
    if (w == 0) mstate = mlstm_scan(gi + ifbi, gf + ifbf, lane, mstate, SC);
    __syncthreads();
    for (int c = 0; c < nch; ++c) {
        const int t0 = 64 * c; LAS float* sc = SC + (c & 1) * 384;
#pragma unroll
        for (int i = 0; i < 4; ++i) { const int v = tid + NTHREADS * i, row = v >> 5, c16 = v & 31; *(LAS u32x4*)(L + L_QS + row * QSTR + 16 * c16) = pq[i]; *(LAS u32x4*)(L + L_KS + row * QSTR + 16 * c16) = pk[i]; }
        { const int row = tid >> 3, c8 = tid & 7; *(LAS u32x4*)(L + L_VS + row * VSTR + 16 * c8) = pv; float x[8]; unpack8(pv, x); *(LAS u32x4*)(L + L_VW + row * VSTR + 16 * c8) = pack8(x, sc[256 + row]); }
        __syncthreads();
        if (c > 0) { ML_STORE(c - 1); }
        if (c + 1 < nch) ML_LOAD(c + 1);
        const int ti = w & 3, hf = w >> 2;
        bf16x8 qf[8];
#pragma unroll
        for (int k = 0; k < 8; ++k) qf[k] = frag_row(L + L_QS, QSTR, 16 * ti, 32 * k, lane);
        { f32x4 sacc[2] = {{0.f, 0.f, 0.f, 0.f}, {0.f, 0.f, 0.f, 0.f}};
#pragma unroll
          for (int j = 0; j < 2; ++j) { const int si = 2 * hf + j; if (si <= ti) {
#pragma unroll
                  for (int k = 0; k < 8; ++k) sacc[j] = MFMA16(frag_row(L + L_KS, QSTR, 16 * si, 32 * k, lane), qf[k], sacc[j]); } }
          const int t = 16 * ti + fr; const float At = sc[64 + t]; float dpart = 0.f;
#pragma unroll
          for (int j = 0; j < 2; ++j) { const int si = 2 * hf + j, s0 = 16 * si + 4 * fq; const f32x4 av = *(const LAS f32x4*)(sc + s0); f32x4 vv;
#pragma unroll
              for (int r = 0; r < 4; ++r) { const float wgt = (s0 + r <= t) ? fast_exp(av[r] - At) : 0.f; vv[r] = (si <= ti) ? sacc[j][r] * wgt : 0.f; dpart += vv[r]; }
              *(LAS u32x2*)(L + L_SB + t * VSTR + s0 * 2) = pack4(vv); }
          dpart += __shfl_xor(dpart, 16); dpart += __shfl_xor(dpart, 32);
          if (lane < 16) DENP[hf * 64 + 16 * ti + lane] = dpart; }
        __syncthreads();
        { f32x4 uacc[2] = {{0.f, 0.f, 0.f, 0.f}, {0.f, 0.f, 0.f, 0.f}};
#pragma unroll
          for (int j = 0; j < 2; ++j) { const int vi = 2 * hf + j;
#pragma unroll
              for (int k = 0; k < 8; ++k) uacc[j] = MFMA16(frag_row(L + L_CT, QSTR, 16 * vi, 32 * k, lane), qf[k], uacc[j]); }
          const float wst = sc[128 + 16 * ti + fr]; uacc[0] *= wst; uacc[1] *= wst;
#pragma unroll
          for (int ks = 0; ks < 2; ++ks) if (32 * ks <= 16 * ti + 15) { const bf16x8 sb = frag_row(L + L_SB, VSTR, 16 * ti, 32 * ks, lane);
#pragma unroll
              for (int j = 0; j < 2; ++j) uacc[j] = MFMA16(frag_tr(L + L_VS, VSTR, 32 * ks, 16 * (2 * hf + j), lane), sb, uacc[j]); }
#pragma unroll
          for (int j = 0; j < 2; ++j) *(LAS u32x2*)(L + L_NUMB + (16 * ti + fr) * VSTR + (16 * (2 * hf + j) + 4 * fq) * 2) = pack4(uacc[j]); }
        if (vs == 0 && hf == 0) {
            f32x4 qn = {0.f, 0.f, 0.f, 0.f};
#pragma unroll
            for (int k = 0; k < 8; ++k) { u32x4 nv = *(const LAS u32x4*)(NSTB + 64 * k + 16 * fq); if (fr != 0) nv = (u32x4){0u, 0u, 0u, 0u};
                qn = MFMA16(__builtin_bit_cast(bf16x8, nv), qf[k], qn); }
            const int t = 16 * ti + fr; const float den = DENP[t] + DENP[64 + t] + sc[128 + t] * qn[0];
            denst = fmaxf(fabsf(den), sc[192 + t]); }
        { const float decay = sc[320];
#pragma unroll
          for (int dt = 0; dt < 2; ++dt)
#pragma unroll
              for (int vi = 0; vi < 4; ++vi) cacc[dt][vi] *= decay;
#pragma unroll
          for (int ks = 0; ks < 2; ++ks) { bf16x8 ka[2];
#pragma unroll
              for (int dt = 0; dt < 2; ++dt) ka[dt] = frag_tr(L + L_KS, QSTR, 32 * ks, 32 * w + 16 * dt, lane);
#pragma unroll
              for (int vi = 0; vi < 4; ++vi) { const bf16x8 vb = frag_tr(L + L_VW, VSTR, 32 * ks, 16 * vi, lane);
#pragma unroll
                  for (int dt = 0; dt < 2; ++dt) cacc[dt][vi] = MFMA16(ka[dt], vb, cacc[dt][vi]); } }
          if (vs == 0) { nacc[0] *= decay; nacc[1] *= decay;
#pragma unroll
              for (int ks = 0; ks < 2; ++ks) { const f32x4 w0 = *(const LAS f32x4*)(sc + 256 + 32 * ks + 8 * fq), w1 = *(const LAS f32x4*)(sc + 256 + 32 * ks + 8 * fq + 4);
                  u32x4 wv; wv.x = cvt_pk_bf16(w0[0], w0[1]); wv.y = cvt_pk_bf16(w0[2], w0[3]); wv.z = cvt_pk_bf16(w1[0], w1[1]); wv.w = cvt_pk_bf16(w1[2], w1[3]);
                  if (fr != 0) wv = (u32x4){0u, 0u, 0u, 0u};
#pragma unroll
                  for (int dt = 0; dt < 2; ++dt) nacc[dt] = MFMA16(frag_tr(L + L_KS, QSTR, 32 * ks, 32 * w + 16 * dt, lane), __builtin_bit_cast(bf16x8, wv), nacc[dt]); } } }
        if (w == 0 && c + 1 < nch) mstate = mlstm_scan(gi + ifbi, gf + ifbf, lane, mstate, SC + ((c + 1) & 1) * 384);
        __syncthreads();
        numst = *(const LAS u32x4*)(L + L_NUMB + (tid >> 3) * VSTR + 16 * (tid & 7));
#pragma unroll
        for (int dt = 0; dt < 2; ++dt)
#pragma unroll
            for (int vi = 0; vi < 4; ++vi) *(LAS u32x2*)(L + L_CT + (16 * vi + fr) * QSTR + (32 * w + 16 * dt + 4 * fq) * 2) = pack4(cacc[dt][vi]);
        if (vs == 0 && fr == 0) {
#pragma unroll
            for (int dt = 0; dt < 2; ++dt) *(LAS u32x2*)(NSTB + (32 * w + 16 * dt + 4 * fq) * 2) = pack4(nacc[dt]); }
    }
    ML_STORE(nch - 1);
#undef ML_LOAD
#undef ML_STORE
    float* Cout = F.out + O_PC + (size_t)(b * 4 + h) * 131072;
#pragma unroll
    for (int dt = 0; dt < 2; ++dt)
#pragma unroll
        for (int vi = 0; vi < 4; ++vi)
#pragma unroll
            for (int r = 0; r < 4; ++r) { const int d = 32 * w + 16 * dt + 4 * fq + r, v = 16 * vi + fr; Cout[(size_t)d * 512 + vs * 64 + v] = cacc[dt][vi][r]; }
    if (vs == 0) { if (fr == 0) {
#pragma unroll
            for (int dt = 0; dt < 2; ++dt)
#pragma unroll
                for (int r = 0; r < 4; ++r) F.out[O_PN + (size_t)(b * 4 + h) * 256 + 32 * w + 16 * dt + 4 * fq + r] = nacc[dt][r]; }
        if (tid == 0) F.out[O_PM + b * 4 + h] = mstate; }
}

constexpr int XSTR = 144, BSTR = 272;
constexpr int S_XS = 0, S_XD = 9216, S_XW = 18432, S_BS = 27648, S_CS = 45056, S_HS = 62464, S_GB = 79872, S_SCAL = 89088, S_YB = 98304;

__device__ __forceinline__ void ssd_scan(float dtp, float Ae, int lane, LAS float* sc) {
    const float dt = fmaxf(dtp, 0.f) + fast_log1pexp_neg(fabsf(dtp));
    const float cum = wave_scan_add(dt * Ae);
    const float cl = __shfl(cum, 63);
    sc[lane] = cum; sc[64 + lane] = dt; sc[128 + lane] = fast_exp(cl - cum); sc[192 + lane] = fast_exp(cum);
    if (lane == 0) sc[256] = fast_exp(cl);
}

__device__ __forceinline__ void ssd_prompt_item(Frame& F, const Params& p, const int b, const int e) {
    LAS unsigned char* L = F.lds;
    const int tid = F.tid, lane = F.lane, w = F.wave, fr = lane & 15, fq = lane >> 4;
    const bf16_t* CV = (const bf16_t*)(F.ws + WS_CV); const float* GT = (const float*)(F.ws + WS_GATES);
    bf16_t* YS = (bf16_t*)(F.ws + WS_YS);
    const int g = e >> 3, m0 = b * SEQ; constexpr int nch = SEQ / 64;
    const float dtb = PIN(25)[e], Ae = -expf(PIN(26)[e]), De = PIN(27)[e];
    LAS float* SC = (LAS float*)(L + S_SCAL);
    f32x4 hacc[4];
#pragma unroll
    for (int pi = 0; pi < 4; ++pi) hacc[pi] = (f32x4){0.f, 0.f, 0.f, 0.f};
    u32x4 px, pb[2], pc[2]; float gd = 0.f;
    const bf16_t* xsrc = CV + (size_t)(m0 + (tid >> 3)) * CVP + 2048 + e * 64 + 8 * (tid & 7);
    const bf16_t* bsrc = CV + (size_t)(m0 + (tid >> 4)) * CVP + 4096 + g * 128 + 8 * (tid & 15);
    const float* gsrc = GT + (size_t)(m0 + lane) * 64 + 8 + e;
#define SD_LOAD(c) do { px = *(const u32x4*)(xsrc + (size_t)((c) * 64) * CVP); _Pragma("unroll") for (int i = 0; i < 2; ++i) { pb[i] = *(const u32x4*)(bsrc + (size_t)((c) * 64 + 32 * i) * CVP); pc[i] = *(const u32x4*)(bsrc + (size_t)((c) * 64 + 32 * i) * CVP + 512); } \
        if (w == 0) gd = gsrc[(size_t)((c) * 64) * 64]; } while (0)
    u32x4 yst = {0u, 0u, 0u, 0u};
    bf16_t* ydst = YS + (size_t)(m0 + (tid >> 3)) * 2048 + e * 64 + 8 * (tid & 7);
#define SD_STORE(c) do { *(u32x4*)(ydst + (size_t)((c) * 64) * 2048) = yst; } while (0)
    SD_LOAD(0);
    __syncthreads();
#pragma unroll
    for (int pi = 0; pi < 4; ++pi) *(LAS u32x2*)(L + S_HS + (16 * pi + fr) * BSTR + (16 * w + 4 * fq) * 2) = (u32x2){0u, 0u};
    if (w == 0) ssd_scan(gd + dtb, Ae, lane, SC);
    __syncthreads();
    for (int c = 0; c < nch; ++c) {
        const int t0 = 64 * c; LAS float* sc = SC + (c & 1) * 320;
        { const int row = tid >> 3, c8 = tid & 7; const float dt = sc[64 + row], ed = sc[128 + row]; float x[8]; unpack8(px, x);
          *(LAS u32x4*)(L + S_XS + row * XSTR + 16 * c8) = px; *(LAS u32x4*)(L + S_XD + row * XSTR + 16 * c8) = pack8(x, dt); *(LAS u32x4*)(L + S_XW + row * XSTR + 16 * c8) = pack8(x, dt * ed); }
#pragma unroll
        for (int i = 0; i < 2; ++i) { const int row = (tid >> 4) + 32 * i, c16 = tid & 15; *(LAS u32x4*)(L + S_BS + row * BSTR + 16 * c16) = pb[i]; *(LAS u32x4*)(L + S_CS + row * BSTR + 16 * c16) = pc[i]; }
        __syncthreads();
        if (c > 0) { SD_STORE(c - 1); }
        if (c + 1 < nch) SD_LOAD(c + 1);
        const int ti = w & 3, hf = w >> 2;
        bf16x8 cf[4];
#pragma unroll
        for (int k = 0; k < 4; ++k) cf[k] = frag_row(L + S_CS, BSTR, 16 * ti, 32 * k, lane);
        { f32x4 gacc[2] = {{0.f, 0.f, 0.f, 0.f}, {0.f, 0.f, 0.f, 0.f}};
#pragma unroll
          for (int j = 0; j < 2; ++j) { const int si = 2 * hf + j; if (si <= ti) {
#pragma unroll
                  for (int k = 0; k < 4; ++k) gacc[j] = MFMA16(frag_row(L + S_BS, BSTR, 16 * si, 32 * k, lane), cf[k], gacc[j]); } }
          const int t = 16 * ti + fr; const float cumt = sc[t];
#pragma unroll
          for (int j = 0; j < 2; ++j) { const int si = 2 * hf + j, s0 = 16 * si + 4 * fq; const f32x4 cs = *(const LAS f32x4*)(sc + s0); f32x4 vv;
#pragma unroll
              for (int r = 0; r < 4; ++r) vv[r] = (si <= ti && s0 + r <= t) ? gacc[j][r] * fast_exp(cumt - cs[r]) : 0.f;
              *(LAS u32x2*)(L + S_GB + t * XSTR + s0 * 2) = pack4(vv); } }
        __syncthreads();
        { f32x4 yacc[2] = {{0.f, 0.f, 0.f, 0.f}, {0.f, 0.f, 0.f, 0.f}};
#pragma unroll
          for (int j = 0; j < 2; ++j) { const int pi = 2 * hf + j;
#pragma unroll
              for (int k = 0; k < 4; ++k) yacc[j] = MFMA16(frag_row(L + S_HS, BSTR, 16 * pi, 32 * k, lane), cf[k], yacc[j]); }
          const int t = 16 * ti + fr; const float ec = sc[192 + t]; yacc[0] *= ec; yacc[1] *= ec;
#pragma unroll
          for (int ks = 0; ks < 2; ++ks) if (32 * ks <= 16 * ti + 15) { const bf16x8 gb = frag_row(L + S_GB, XSTR, 16 * ti, 32 * ks, lane);
#pragma unroll
              for (int j = 0; j < 2; ++j) yacc[j] = MFMA16(frag_tr(L + S_XD, XSTR, 32 * ks, 16 * (2 * hf + j), lane), gb, yacc[j]); }
#pragma unroll
          for (int j = 0; j < 2; ++j) { const int p0 = 16 * (2 * hf + j) + 4 * fq; const u32x2 xv = *(const LAS u32x2*)(L + S_XS + t * XSTR + p0 * 2);
              f32x4 y = yacc[j]; y[0] += De * bflo(xv.x); y[1] += De * bfhi(xv.x); y[2] += De * bflo(xv.y); y[3] += De * bfhi(xv.y);
              *(LAS u32x2*)(L + S_YB + t * XSTR + p0 * 2) = pack4(y); } }
        { const float eall = sc[256];
#pragma unroll
          for (int pi = 0; pi < 4; ++pi) hacc[pi] *= eall;
#pragma unroll
          for (int ks = 0; ks < 2; ++ks) { const bf16x8 ba = frag_tr(L + S_BS, BSTR, 32 * ks, 16 * w, lane);
#pragma unroll
              for (int pi = 0; pi < 4; ++pi) hacc[pi] = MFMA16(ba, frag_tr(L + S_XW, XSTR, 32 * ks, 16 * pi, lane), hacc[pi]); } }
        if (w == 0 && c + 1 < nch) ssd_scan(gd + dtb, Ae, lane, SC + ((c + 1) & 1) * 320);
        __syncthreads();
        yst = *(const LAS u32x4*)(L + S_YB + (tid >> 3) * XSTR + 16 * (tid & 7));
#pragma unroll
        for (int pi = 0; pi < 4; ++pi) *(LAS u32x2*)(L + S_HS + (16 * pi + fr) * BSTR + (16 * w + 4 * fq) * 2) = pack4(hacc[pi]);
    }
    SD_STORE(nch - 1);
#undef SD_LOAD
#undef SD_STORE
    float* hout = F.out + O_PSSM + (size_t)(b * 32 + e) * 8192;
#pragma unroll
    for (int pi = 0; pi < 4; ++pi) *(f32x4*)(hout + (size_t)(16 * pi + fr) * 128 + 16 * w + 4 * fq) = hacc[pi];
}

__device__ __forceinline__ void mlstm_sample_item(Frame& F, const Params& p, const int bs, const int h) {
    LAS unsigned char* L = F.lds; const int tid = F.tid, lane = F.lane, w = F.wave;
    const bf16_t* Z = (const bf16_t*)(F.ws + WS_ZIN); const bf16_t* CV = (const bf16_t*)(F.ws + WS_CV); const float* GT = (const float*)(F.ws + WS_GATES);
    bf16_t* NUM = (bf16_t*)(F.ws + WS_NUM); float* DEN = (float*)(F.ws + WS_DEN);
    const int m0 = MP + bs * TS;
    const float* C0 = PIN(4) + (size_t)(bs * 4 + h) * 131072; float* C1 = F.out + O_SC + (size_t)(bs * 4 + h) * 131072;
    LAS float* QKW = (LAS float*)L; LAS float* RED = (LAS float*)(L + 16384); LAS float* NS = (LAS float*)(L + 81920);
    LAS float* SCs = (LAS float*)(L + 82944); LAS float* SW = (LAS float*)(L + 83200); LAS float* QN = (LAS float*)(L + 83456);
    const int v4 = tid & 127, dp = tid >> 7;
    f32x4 vreg[8];
#pragma unroll
    for (int s = 0; s < 8; ++s) { const u32x2 vv = *(const u32x2*)(Z + (size_t)(m0 + s) * ZP + ZV + h * 512 + 4 * v4); vreg[s] = (f32x4){bflo(vv.x), bfhi(vv.x), bflo(vv.y), bfhi(vv.y)}; }
    const u32x4 qk = *(const u32x4*)(CV + (size_t)(m0 + ((tid >> 5) & 7)) * CVP + (tid >> 8) * 1024 + h * 256 + 8 * (tid & 31));
    const float n0v = tid < 256 ? PIN(5)[(size_t)(bs * 4 + h) * 256 + tid] : 0.f;
    __syncthreads();
    { const int isk = tid >> 8, t = (tid >> 5) & 7, c16 = tid & 31; float x[8]; unpack8(qk, x);
#pragma unroll
      for (int e = 0; e < 8; ++e) QKW[(8 * c16 + e) * 16 + isk * 8 + t] = x[e]; }
    if (tid < 256) NS[tid] = n0v;
    if (w == 0) {
        const bool valid = lane < 8; const float mstate = PIN(6)[bs * 4 + h];
        float ipre = 0.f, fpre = 0.f; if (valid) { ipre = GT[(size_t)(m0 + lane) * 64 + h] + PIN(20)[h]; fpre = GT[(size_t)(m0 + lane) * 64 + 4 + h] + PIN(20)[4 + h]; }
        float bsum = valid ? logsigmoidf_(fpre) : 0.f;
#pragma unroll
        for (int o = 1; o < 8; o <<= 1) { const float u = __shfl_up(bsum, o); if (lane >= o) bsum += u; }
        const float a = valid ? ipre - bsum : -INFINITY;
        float cm = a;
#pragma unroll
        for (int o = 1; o < 8; o <<= 1) { const float u = __shfl_up(cm, o); if (lane >= o) cm = fmaxf(cm, u); }
        const float A = fmaxf(mstate, cm); const float Alast = __shfl(A, 7), blast = __shfl(bsum, 7);
        if (valid) { SCs[lane] = a; SCs[8 + lane] = A; SCs[16 + lane] = expf(mstate - A); SCs[24 + lane] = expf(-(bsum + A)); SCs[32 + lane] = expf(a - Alast); }
        if (lane == 0) { SCs[40] = expf(mstate - Alast); F.out[O_SM + bs * 4 + h] = blast + Alast; }
    }
    __syncthreads();
    { const int pr = tid >> 3, part = tid & 7, t = pr >> 3, s = pr & 7; float acc = 0.f;
#pragma unroll 8
      for (int dd = 0; dd < 32; ++dd) { const int d = part * 32 + dd; acc += QKW[d * 16 + t] * QKW[d * 16 + 8 + s]; }
      acc += __shfl_xor(acc, 1); acc += __shfl_xor(acc, 2); acc += __shfl_xor(acc, 4);
      if (part == 0) SW[t * 8 + s] = (s <= t) ? acc * expf(SCs[s] - SCs[8 + t]) : 0.f; }
    if (tid < 64) { const int t = tid >> 3, part = tid & 7; float acc = 0.f;
#pragma unroll 8
      for (int dd = 0; dd < 32; ++dd) { const int d = part * 32 + dd; acc += QKW[d * 16 + t] * NS[d]; }
      acc += __shfl_xor(acc, 1); acc += __shfl_xor(acc, 2); acc += __shfl_xor(acc, 4);
      if (part == 0) QN[t] = acc; }
    if (tid >= 256) { const int d = tid - 256; float s = 0.f;
#pragma unroll
        for (int si = 0; si < 8; ++si) s += SCs[32 + si] * QKW[d * 16 + 8 + si];
        F.out[O_SN + (size_t)(bs * 4 + h) * 256 + d] = SCs[40] * NS[d] + s; }
    __syncthreads();
    if (tid < 8) { const int t = tid; float den = 0.f;
#pragma unroll
        for (int s = 0; s < 8; ++s) den += SW[t * 8 + s];
        den += SCs[16 + t] * QN[t]; DEN[(size_t)(m0 + t) * 4 + h] = fmaxf(fabsf(den), SCs[24 + t]); }
    if (tid >= 256) { const int d = tid - 256;
#pragma unroll
        for (int si = 0; si < 8; ++si) QKW[d * 16 + 8 + si] *= SCs[32 + si]; }
    __syncthreads();
    { const float decay = SCs[40];
      f32x4 acc[8];
#pragma unroll
      for (int t = 0; t < 8; ++t) acc[t] = (f32x4){0.f, 0.f, 0.f, 0.f};
      const float* cin = C0 + (size_t)(dp * 64) * 512 + 4 * v4; float* cout = C1 + (size_t)(dp * 64) * 512 + 4 * v4;
#pragma unroll 1
      for (int d0 = 0; d0 < 64; d0 += 8) {
          f32x4 cc[8];
#pragma unroll
          for (int i = 0; i < 8; ++i) cc[i] = __builtin_nontemporal_load((const f32x4*)(cin + (size_t)(d0 + i) * 512));
#pragma unroll
          for (int i = 0; i < 8; ++i) { const LAS float* qp = QKW + (dp * 64 + d0 + i) * 16;
              const f32x4 q0 = *(const LAS f32x4*)qp, q1 = *(const LAS f32x4*)(qp + 4), k0 = *(const LAS f32x4*)(qp + 8), k1 = *(const LAS f32x4*)(qp + 12);
              f32x4 cn = decay * cc[i];
#pragma unroll
              for (int t = 0; t < 4; ++t) { acc[t] += q0[t] * cc[i]; acc[4 + t] += q1[t] * cc[i]; cn += k0[t] * vreg[t]; cn += k1[t] * vreg[4 + t]; }
              __builtin_nontemporal_store(cn, (f32x4*)(cout + (size_t)(d0 + i) * 512)); }
      }
#pragma unroll
      for (int t = 0; t < 8; ++t) *(LAS f32x4*)(RED + (size_t)(dp * 8 + t) * 512 + 4 * v4) = acc[t]; }
    __syncthreads();
    { const int t = tid >> 6, v8 = tid & 63; float s[8];
#pragma unroll
      for (int e = 0; e < 8; ++e) s[e] = 0.f;
#pragma unroll
      for (int dpp = 0; dpp < 4; ++dpp) { const f32x4 a = *(const LAS f32x4*)(RED + (size_t)(dpp * 8 + t) * 512 + 8 * v8), b = *(const LAS f32x4*)(RED + (size_t)(dpp * 8 + t) * 512 + 8 * v8 + 4);
#pragma unroll
          for (int e = 0; e < 4; ++e) { s[e] += a[e]; s[4 + e] += b[e]; } }
      const float wst = SCs[16 + t];
#pragma unroll
      for (int e = 0; e < 8; ++e) s[e] *= wst;
      for (int si = 0; si <= t; ++si) { const float sw = SW[t * 8 + si]; float x[8]; unpack8(*(const u32x4*)(Z + (size_t)(m0 + si) * ZP + ZV + h * 512 + 8 * v8), x);
#pragma unroll
          for (int e = 0; e < 8; ++e) s[e] += sw * x[e]; }
      *(u32x4*)(NUM + (size_t)(m0 + t) * 2048 + h * 512 + 8 * v8) = pack8(s, 1.0f); }
}

__device__ __forceinline__ void ssd_sample_item(Frame& F, const Params& p, const int bs, const int g) {
    LAS unsigned char* L = F.lds; const int tid = F.tid, lane = F.lane, w = F.wave;
    const bf16_t* CV = (const bf16_t*)(F.ws + WS_CV); const float* GT = (const float*)(F.ws + WS_GATES); bf16_t* YS = (bf16_t*)(F.ws + WS_YS);
    const int m0 = MP + bs * TS;
    LAS float* BSf = (LAS float*)L; LAS float* CSf = (LAS float*)(L + 4096); LAS float* XF = (LAS float*)(L + 8192); LAS float* XWt = (LAS float*)(L + 24576);
    LAS float* XDt = (LAS float*)(L + 40960); LAS float* SC2 = (LAS float*)(L + 57344); LAS float* CB = (LAS float*)(L + 58432); LAS float* YP = (LAS float*)(L + 59392);
    const u32x4 xr = *(const u32x4*)(CV + (size_t)(m0 + (tid >> 6)) * CVP + 2048 + g * 512 + 8 * (tid & 63));
    u32x4 bcr = {0u, 0u, 0u, 0u};
    if (tid < 256) bcr = *(const u32x4*)(CV + (size_t)(m0 + ((tid >> 4) & 7)) * CVP + 4096 + (tid >> 7) * 512 + g * 128 + 8 * (tid & 15));
    __syncthreads();
    { float x[8]; unpack8(xr, x); const int t = tid >> 6, c8 = tid & 63;
#pragma unroll
      for (int e = 0; e < 8; ++e) XF[t * 512 + 8 * c8 + e] = x[e]; }
    if (tid < 256) { float x[8]; unpack8(bcr, x); const int isC = tid >> 7, t = (tid >> 4) & 7, c16 = tid & 15; LAS float* dst = isC ? CSf : BSf;
#pragma unroll
      for (int e = 0; e < 8; ++e) dst[t * 128 + 8 * c16 + e] = x[e]; }
    { const int e = g * 8 + w; const bool valid = lane < 8; const float Ae = -expf(PIN(26)[e]);
      const float dt = valid ? softplusf_(GT[(size_t)(m0 + lane) * 64 + 8 + e] + PIN(25)[e]) : 0.f;
      float cum = dt * Ae;
#pragma unroll
      for (int o = 1; o < 8; o <<= 1) { const float u = __shfl_up(cum, o); if (lane >= o) cum += u; }
      const float cl = __shfl(cum, 7);
      if (valid) { SC2[w * 32 + lane] = cum; SC2[w * 32 + 8 + lane] = dt; SC2[w * 32 + 16 + lane] = expf(cl - cum); SC2[w * 32 + 24 + lane] = expf(cum); }
      if (lane == 0) SC2[256 + w] = expf(cl); }
    __syncthreads();
    { const int pr = tid >> 3, part = tid & 7, t = pr >> 3, s = pr & 7; float acc = 0.f;
#pragma unroll
      for (int nn = 0; nn < 16; ++nn) { const int n = part * 16 + nn; acc += CSf[t * 128 + n] * BSf[s * 128 + n]; }
      acc += __shfl_xor(acc, 1); acc += __shfl_xor(acc, 2); acc += __shfl_xor(acc, 4);
      if (part == 0) CB[t * 8 + s] = acc; }
    { const int el = tid >> 6;
#pragma unroll
      for (int s = 0; s < 8; ++s) { const float x = XF[s * 512 + tid], dt = SC2[el * 32 + 8 + s], ed = SC2[el * 32 + 16 + s]; XDt[tid * 8 + s] = x * dt; XWt[tid * 8 + s] = x * dt * ed; } }
    __syncthreads();
    { const int n8 = tid & 15, prow = tid >> 4;
      float Bn[8][8], Cn[8][8];
#pragma unroll
      for (int s = 0; s < 8; ++s) { const f32x4 b0 = *(const LAS f32x4*)(BSf + s * 128 + 8 * n8), b1 = *(const LAS f32x4*)(BSf + s * 128 + 8 * n8 + 4), c0 = *(const LAS f32x4*)(CSf + s * 128 + 8 * n8), c1 = *(const LAS f32x4*)(CSf + s * 128 + 8 * n8 + 4);
#pragma unroll
          for (int j = 0; j < 4; ++j) { Bn[s][j] = b0[j]; Bn[s][4 + j] = b1[j]; Cn[s][j] = c0[j]; Cn[s][4 + j] = c1[j]; } }
      const float* hin = PIN(8) + (size_t)(bs * 32 + g * 8) * 8192 + 8 * n8; float* hout = F.out + O_SSSM + (size_t)(bs * 32 + g * 8) * 8192 + 8 * n8;
#pragma unroll 1
      for (int it = 0; it < 16; it += 2) {
          f32x4 hv[2][2];
#pragma unroll
          for (int u = 0; u < 2; ++u) { const int row = (it + u) * 32 + prow; hv[u][0] = __builtin_nontemporal_load((const f32x4*)(hin + (size_t)row * 128)); hv[u][1] = __builtin_nontemporal_load((const f32x4*)(hin + (size_t)row * 128 + 4)); }
#pragma unroll
          for (int u = 0; u < 2; ++u) { const int row = (it + u) * 32 + prow; const float eall = SC2[256 + (row >> 6)];
              const f32x4 xw0 = *(const LAS f32x4*)(XWt + row * 8), xw1 = *(const LAS f32x4*)(XWt + row * 8 + 4);
              float hh[8], hn[8], yp[8];
#pragma unroll
              for (int j = 0; j < 4; ++j) { hh[j] = hv[u][0][j]; hh[4 + j] = hv[u][1][j]; }
#pragma unroll
              for (int j = 0; j < 8; ++j) hn[j] = eall * hh[j];
#pragma unroll
              for (int s = 0; s < 8; ++s) { const float xw = s < 4 ? xw0[s & 3] : xw1[s & 3]; float y = 0.f;
#pragma unroll
                  for (int j = 0; j < 8; ++j) { hn[j] += xw * Bn[s][j]; y += Cn[s][j] * hh[j]; }
                  yp[s] = y; }
              f32x4 o0 = {hn[0], hn[1], hn[2], hn[3]}, o1 = {hn[4], hn[5], hn[6], hn[7]};
              __builtin_nontemporal_store(o0, (f32x4*)(hout + (size_t)row * 128)); __builtin_nontemporal_store(o1, (f32x4*)(hout + (size_t)row * 128 + 4));
#pragma unroll
              for (int s = 0; s < 8; ++s) { float y = yp[s]; y += __shfl_xor(y, 1); y += __shfl_xor(y, 2); y += __shfl_xor(y, 4); y += __shfl_xor(y, 8); yp[s] = y; }
              if (n8 == 0) { *(LAS f32x4*)(YP + row * 8) = (f32x4){yp[0], yp[1], yp[2], yp[3]}; *(LAS f32x4*)(YP + row * 8 + 4) = (f32x4){yp[4], yp[5], yp[6], yp[7]}; } }
      } }
    __syncthreads();
    { const int row = tid, el = row >> 6, pp = row & 63, e = g * 8 + el; const float De = PIN(27)[e];
#pragma unroll
      for (int t = 0; t < 8; ++t) { const float cumt = SC2[el * 32 + t]; float y = SC2[el * 32 + 24 + t] * YP[row * 8 + t];
#pragma unroll
          for (int s = 0; s < 8; ++s) if (s <= t) y += CB[t * 8 + s] * expf(cumt - SC2[el * 32 + s]) * XDt[row * 8 + s];
          y += De * XF[t * 512 + row];
          YS[(size_t)(m0 + t) * 2048 + e * 64 + pp] = (bf16_t)(cvt_pk_bf16(y, 0.f) & 0xffffu); } }
}

#ifndef IT_MASK
#define IT_MASK 15
#endif
__device__ __forceinline__ void phase_mixer(Frame& F, const Params& p, const int itm = IT_MASK) {
    if (itm & 1) { for (int it = F.bx; it < 256; it += F.G) { const int x = it & 7, j = it >> 3, pair = x * 4 + (j >> 3); mlstm_prompt_item(F, p, pair >> 2, pair & 3, j & 7); } }
    if (itm & 2) { for (int it = F.bx; it < 256; it += F.G) { const int x = it & 7, j = it >> 3, grp = x * 4 + (j >> 3); ssd_prompt_item(F, p, grp >> 2, (grp & 3) * 8 + (j & 7)); } }
    if (itm & 4) { for (int it = F.bx; it < 4 * (NBS - NS_EARLY); it += F.G) mlstm_sample_item(F, p, NS_EARLY + (it >> 2), it & 3); }
    if (itm & 8) { for (int it = F.bx; it < 4 * (NBS - NS_EARLY); it += F.G) ssd_sample_item(F, p, NS_EARLY + (it >> 2), it & 3); }
}

__device__ __forceinline__ void phase_finish(Frame& F, const Params& p) {
    const bf16_t* Z = (const bf16_t*)(F.ws + WS_ZIN); const bf16_t* NUM = (const bf16_t*)(F.ws + WS_NUM); const bf16_t* YS = (const bf16_t*)(F.ws + WS_YS);
    const float* DEN = (const float*)(F.ws + WS_DEN); bf16_t* HA = (bf16_t*)(F.ws + WS_HA); bf16_t* HB = (bf16_t*)(F.ws + WS_HB);
    const float* hg = PIN(21); const float* sg = PIN(28);
    const int gwv = F.bx * 8 + F.wave, NGW = F.G * 8, lane = F.lane;
    for (int m = gwv; m < MT; m += NGW) {
#pragma unroll
        for (int h = 0; h < 4; ++h) {
            float x[8], o[8], gz[8]; unpack8(*(const u32x4*)(NUM + (size_t)m * 2048 + h * 512 + 8 * lane), x);
            float s = 0.f;
#pragma unroll
            for (int e = 0; e < 8; ++e) s += x[e];
            const float mu = wave_sum(s) * (1.0f / 512.0f); float q = 0.f;
#pragma unroll
            for (int e = 0; e < 8; ++e) { x[e] -= mu; q += x[e] * x[e]; }
            const float var = wave_sum(q) * (1.0f / 512.0f), Dv = DEN[(size_t)m * 4 + h];
            const float rs = 1.0f / sqrtf(var + EPS * Dv * Dv);
            unpack8(*(const u32x4*)(Z + (size_t)m * ZP + ZO + h * 512 + 8 * lane), gz);
            const f32x4 g0 = *(const f32x4*)(hg + h * 512 + 8 * lane), g1 = *(const f32x4*)(hg + h * 512 + 8 * lane + 4);
#pragma unroll
            for (int e = 0; e < 8; ++e) o[e] = x[e] * rs * (e < 4 ? g0[e & 3] : g1[e & 3]) * sigmoidf_(gz[e]);
            *(u32x4*)(m < MP ? HA + (size_t)m * 2048 + h * 512 + 8 * lane : HA + (size_t)MP * 2048 + fo_index(m - MP, h * 512 + 8 * lane, 2048)) = pack8(o, 1.0f);
        }
#pragma unroll
        for (int gq = 0; gq < 4; ++gq) {
            float y[8], zz[8]; unpack8(*(const u32x4*)(YS + (size_t)m * 2048 + gq * 512 + 8 * lane), y); unpack8(*(const u32x4*)(Z + (size_t)m * ZP + ZZ + gq * 512 + 8 * lane), zz);
            float q = 0.f;
#pragma unroll
            for (int e = 0; e < 8; ++e) { y[e] *= siluf_(zz[e]); q += y[e] * y[e]; }
            const float rs = 1.0f / sqrtf(wave_sum(q) * (1.0f / 512.0f) + EPS);
            const f32x4 g0 = *(const f32x4*)(sg + gq * 512 + 8 * lane), g1 = *(const f32x4*)(sg + gq * 512 + 8 * lane + 4);
#pragma unroll
            for (int e = 0; e < 8; ++e) y[e] = y[e] * rs * (e < 4 ? g0[e & 3] : g1[e & 3]);
            *(u32x4*)(m < MP ? HB + (size_t)m * 2048 + gq * 512 + 8 * lane : HB + (size_t)MP * 2048 + fo_index(m - MP, gq * 512 + 8 * lane, 2048)) = pack8(y, 1.0f);
        }
    }
    const int gt = F.bx * NTHREADS + F.tid, NGT = F.G * NTHREADS;
    constexpr int N1 = NBP * 3 * 2048, N2 = NBS * 3 * 2048, N3 = NBP * 3 * 3072, N4 = NBS * 3 * 3072;
    for (int i = gt; i < N1 + N2 + N3 + N4; i += NGT) {
        int j = i;
        if (j < N1) { const int b = j / 6144, r = (j / 2048) % 3, ch = j % 2048; F.out[O_PMC + j] = bf2f(Z[(size_t)(b * SEQ + SEQ - 3 + r) * ZP + ch]); continue; } j -= N1;
        if (j < N2) { const int b = j / 6144, r = (j / 2048) % 3, ch = j % 2048; F.out[O_SMC + j] = bf2f(Z[(size_t)(MP + b * TS + TS - 3 + r) * ZP + ch]); continue; } j -= N2;
        if (j < N3) { const int b = j / 9216, r = (j / 3072) % 3, ch = j % 3072; F.out[O_PSC + j] = bf2f(Z[(size_t)(b * SEQ + SEQ - 3 + r) * ZP + ZX + ch]); continue; } j -= N3;
        { const int b = j / 9216, r = (j / 3072) % 3, ch = j % 3072; F.out[O_SSC + j] = bf2f(Z[(size_t)(MP + b * TS + TS - 3 + r) * ZP + ZX + ch]); }
    }
}


#ifndef STAG_LEVELS
#define STAG_LEVELS 8
#endif
#ifndef STAG_SLEEP
#define STAG_SLEEP 16
#endif
__device__ __forceinline__ void stagger_start(const Frame& F) { const int sl = (F.bx >> 3) & (STAG_LEVELS - 1); for (int q = 0; q < sl; ++q) __builtin_amdgcn_s_sleep(STAG_SLEEP); }

constexpr int LDS_BYTES = 147456;
constexpr int NPHASE = 15;

__global__ void __launch_bounds__(NTHREADS, 2) fwd_kernel(Params p) {
    extern __shared__ __attribute__((aligned(16))) unsigned char lds_raw[];
    Frame F;
    F.lds = (LAS unsigned char*)lds_raw;
    F.tid = threadIdx.x; F.lane = F.tid & 63; F.wave = __builtin_amdgcn_readfirstlane(F.tid >> 6);
    F.G = gridDim.x; F.bx = blockIdx.x;
    F.out = p.out; F.ws = p.ws;
    unsigned char* ws = p.ws;
    bf16_t* U = (bf16_t*)(ws + WS_U); bf16_t* H = (bf16_t*)(ws + WS_H); float* X1 = (float*)(ws + WS_X1);
    bf16_t* ZIN = (bf16_t*)(ws + WS_ZIN); float* GATES = (float*)(ws + WS_GATES); float* MOD = (float*)(ws + WS_MOD);
    const int lo = p.ph_lo, hi = p.ph_hi;
#ifndef PH_MASK
#define PH_MASK 0xfffff
#endif
#define IN(k) (((PH_MASK >> (k)) & 1) && lo <= (k) && (k) < hi)
#ifndef DUP_MASK
#define DUP_MASK 0
#endif
#define DUP(k) ((DUP_MASK >> (k)) & 1)
    volatile LAS unsigned* MISC = (volatile LAS unsigned*)(F.lds + LDS_BYTES - 64);
    if (F.tid < 16) MISC[F.tid] = 0u;
    if (F.tid == 0) { volatile LAS unsigned* T = (volatile LAS unsigned*)(F.lds + PTAB_OFF);
#pragma unroll
        for (int k = 0; k < 36; ++k) { const uint64_t a = (uint64_t)p.in[k]; T[2 * k] = (unsigned)a; T[2 * k + 1] = (unsigned)(a >> 32); } }
    __syncthreads();
    XcdBarrier bar; bar.bar = (unsigned*)(ws + WS_CTL); bar.x = 0; bar.st = nullptr;
    if (hi - lo > 1) bar = xcd_barrier_post((unsigned*)(ws + WS_CTL), MISC);
#define SEAM(k) do { if (IN(k) && IN((k) + 1)) { xcd_barrier(bar); } } while (0)

    if (IN(0)) { phase_silu_c(F, p); phase_prep<0>(F, p); if (hi - lo > 1) xcd_barrier(bar); phase_adaln(F, p); } SEAM(0);
    if (IN(1)) { phase_norm_mod(F, PIN(0), PIN(1), PIN(12), 0 * DM, 1 * DM, U); if (DUP(1)) phase_norm_mod(F, PIN(0), PIN(1), PIN(12), 0 * DM, 1 * DM, U); } SEAM(1);
    if (IN(2)) { pg8::Gemm g{U, U, (const bf16_t*)(ws + WS_WUP1), (const bf16_t*)(ws + WS_WUP1), DM / 2}; pg8::Order S;
        if (F.bx < 192) { stagger_start(F); S.init_from(MT, 2 * DFF, 192, F.bx, 0, 1344); } else { phase_prep<1>(F, p); S.init_from(MT, 2 * DFF, 64, F.bx - 192, 1344, 1496); }
        pg8::EpiSwiGLU E{H, F8_INV}; pg8::gemm_phase<pg8::EpiSwiGLU, true, pg8::Order, true>(F.lds, g, S, E); } SEAM(2);
    float* XS = (float*)(ws + WS_XS); unsigned* CNT = (unsigned*)(ws + WS_CTL) + CW_CNT; bf16_t* U2 = (bf16_t*)(ws + WS_U2);
    if (IN(3)) { stagger_start(F); pg8::Gemm g{H, H, (const bf16_t*)(ws + WS_WDN1), (const bf16_t*)(ws + WS_WDN1), DFF / 2}; pg8::Order S; S.init(MP, DM, F.G, F.bx, 0);
        pg8::EpiResidNorm<false> E{PIN(0), X1, MOD + 2 * DM, PIN(16), MOD + 3 * DM, MOD + 4 * DM, U, nullptr, XS, CNT, 0.5f * F8_INV, 0}; pg8::gemm_phase<pg8::EpiResidNorm<false>, true, pg8::Order, true>(F.lds, g, S, E);
        small_phase_resid_norm<DFF, false>(F, H, (const bf16_t*)(ws + WS_FDN1), PIN(1), X1, MOD + 2 * DM, 0.5f, PIN(16), MOD + 3 * DM, MOD + 4 * DM, U, nullptr, XS, CNT); } SEAM(3);
    if (IN(5)) {
        const pg8::Gemm g{U, U, (const bf16_t*)(ws + WS_WIN), (const bf16_t*)(ws + WS_WIN), DM}; const pg8::EpiZin E{ZIN, GATES};
        { stagger_start(F); const pg8::OrderSample S{F.bx}; pg8::gemm_phase<pg8::EpiZin, true, pg8::OrderSample>(F.lds, g, S, E); }
        if (F.bx >= 208 && F.bx < 224) small_gates_tile(F, U, (const bf16_t*)(ws + WS_FG), GATES, MP / 64 + (F.bx - 208));
        if (F.bx >= 224) { for (int k = 0; k < 4; ++k) small_gates_tile(F, U, (const bf16_t*)(ws + WS_FG), GATES, 4 * (F.bx - 224) + k); }
        xcd_barrier(bar);
        if (F.bx >= 192) {
            const int s0 = F.bx - 192;
            for (int k = F.wave; k < 10; k += 8) conv_item(F, p, 5120 + 10 * s0 + k);
            asm volatile("s_waitcnt vmcnt(0)" ::: "memory"); __syncthreads(); __builtin_amdgcn_fence(__ATOMIC_ACQUIRE, "agent");
#pragma unroll 1
            for (int k = 0; k < 4; ++k) mlstm_sample_item(F, p, s0, k);
#pragma unroll 1
            for (int k = 0; k < 4; ++k) ssd_sample_item(F, p, s0, k);
            for (int k = 0; k < 2; ++k) small_gates_tile(F, U, (const bf16_t*)(ws + WS_FG), GATES, 128 + 2 * s0 + k);
        } else stagger_start(F);
        __syncthreads();
        { const pg8::OrderPrompt S{F.bx}; pg8::gemm_phase<pg8::EpiZin, true, pg8::OrderPrompt>(F.lds, g, S, E); }
        } SEAM(5);
    if (IN(6)) { phase_conv(F, p); if (DUP(6)) phase_conv(F, p); } SEAM(6);
    #ifndef DUP_IT
#define DUP_IT 15
#endif
    if (IN(7)) { phase_mixer(F, p, p.itm); } SEAM(7);
    if (IN(8)) { phase_finish(F, p); if (DUP(8)) phase_finish(F, p); } SEAM(8);
    if (IN(9)) { stagger_start(F); pg8::Gemm g{(const bf16_t*)(ws + WS_HA), (const bf16_t*)(ws + WS_HB), (const bf16_t*)(ws + WS_WPA), (const bf16_t*)(ws + WS_WPB), 2048}; pg8::Order S; S.init(MP, DM, F.G, F.bx, 1);
        pg8::EpiMerge E{ZIN, (float*)(ws + WS_TMP), U}; pg8::gemm_phase(F.lds, g, S, E);
        small_phase_merge(F, (const bf16_t*)(ws + WS_HA), (const bf16_t*)(ws + WS_HB), (const bf16_t*)(ws + WS_FPA), (const bf16_t*)(ws + WS_FPB), ZIN, U); } SEAM(9);
    if (IN(10)) { stagger_start(F); pg8::Gemm g{U, U, (const bf16_t*)(ws + WS_WOUT), (const bf16_t*)(ws + WS_WOUT), DM}; pg8::Order S; S.init(MP, DM, F.G, F.bx, 0);
        pg8::EpiResidNorm<false> E{X1, X1, MOD + 5 * DM, PIN(31), MOD + 6 * DM, MOD + 7 * DM, U2, nullptr, XS + (size_t)MT * 16, CNT + CNT_STRIDE, 1.0f, 1}; pg8::gemm_phase(F.lds, g, S, E);
        small_phase_resid_norm<DM, false>(F, U, (const bf16_t*)(ws + WS_FOUT), X1 + (size_t)MP * DM, X1, MOD + 5 * DM, 1.0f, PIN(31), MOD + 6 * DM, MOD + 7 * DM, U2, nullptr, XS + (size_t)MT * 16, CNT + CNT_STRIDE); } SEAM(10);
    if (IN(12)) { stagger_start(F); pg8::Gemm g{U2, U2, (const bf16_t*)(ws + WS_WUP2), (const bf16_t*)(ws + WS_WUP2), DM / 2}; pg8::Order S; S.init(MT, 2 * DFF, F.G, F.bx, 0);
        pg8::EpiSwiGLU E{H, F8_INV}; pg8::gemm_phase<pg8::EpiSwiGLU, true, pg8::Order, true>(F.lds, g, S, E); } SEAM(12);
    if (IN(13)) { stagger_start(F); pg8::Gemm g{H, H, (const bf16_t*)(ws + WS_WDN2), (const bf16_t*)(ws + WS_WDN2), DFF / 2}; pg8::Order S; S.init(MP, DM, F.G, F.bx, 0);
        pg8::EpiResidNorm<true> E{X1, nullptr, MOD + 8 * DM, PIN(35), nullptr, nullptr, nullptr, p.out, XS + (size_t)2 * MT * 16, CNT + 2 * CNT_STRIDE, 0.5f * F8_INV, 0}; pg8::gemm_phase<pg8::EpiResidNorm<true>, true, pg8::Order, true>(F.lds, g, S, E);
        small_phase_resid_norm<DFF, true>(F, H, (const bf16_t*)(ws + WS_FDN2), X1 + (size_t)MP * DM, nullptr, MOD + 8 * DM, 0.5f, PIN(35), nullptr, nullptr, nullptr, p.out, XS + (size_t)2 * MT * 16, CNT + 2 * CNT_STRIDE); }
#undef IN
#undef SEAM
}

extern "C" void kernel_launch(void* const* d_in, const int* in_sizes, int n_in, void* d_out, int out_size, void* d_ws, size_t ws_size, hipStream_t stream) {
    static int grid = 0;
    if (grid == 0) {
        if (n_in != 36 || ws_size < WS_END) { fprintf(stderr, "kernel_launch: expected 36 inputs and >= %zu bytes of workspace (got %d, %zu)\n", (size_t)WS_END, n_in, ws_size); grid = -1; return; }
        int dev = 0, cus = 0, per_cu = 0;
        hipGetDevice(&dev); hipDeviceGetAttribute(&cus, hipDeviceAttributeMultiprocessorCount, dev);
        hipFuncSetAttribute((const void*)fwd_kernel, hipFuncAttributeMaxDynamicSharedMemorySize, LDS_BYTES);
        hipOccupancyMaxActiveBlocksPerMultiprocessor(&per_cu, (const void*)fwd_kernel, NTHREADS, LDS_BYTES);
        if (per_cu < 1) { fprintf(stderr, "kernel_launch: occupancy query says %d blocks per CU\n", per_cu); grid = -1; return; }
        grid = cus;
        if (grid != 256) { fprintf(stderr, "kernel_launch: the fused-norm GEMM epilogues need exactly 256 workgroups (one 256x256 tile each); this device has %d CUs\n", cus); grid = -1; return; }
    }
    if (grid < 0) return;
    Params p{};
    for (int i = 0; i < 36; ++i) p.in[i] = (const float*)d_in[i];
    p.out = (float*)d_out; p.ws = (unsigned char*)d_ws; p.itm = 15;
#if MK_LAUNCH_PER_PHASE
    for (int ph = 0; ph < NPHASE; ++ph) { p.ph_lo = ph; p.ph_hi = ph + 1; hipLaunchKernelGGL(fwd_kernel, dim3(grid), dim3(NTHREADS), LDS_BYTES, stream, p); }
#else
    p.ph_lo = 0; p.ph_hi = NPHASE;
    if (hipMemsetAsync((char*)d_ws + WS_CTL, 0, 98304, stream) != hipSuccess) { fprintf(stderr, "kernel_launch: memset of the barrier words failed\n"); return; }
    void* args[] = {&p};
    hipError_t e = hipLaunchCooperativeKernel((const void*)fwd_kernel, dim3(grid), dim3(NTHREADS), args, LDS_BYTES, stream);
    if (e != hipSuccess) fprintf(stderr, "cooperative launch failed: %s (grid %d)\n", hipGetErrorString(e), grid);
#ifdef PROBE_PH
    for (int r = 0; r < PROBE_REPS; ++r) { Params q = p; q.ph_lo = PROBE_PH; q.ph_hi = PROBE_PH + 1; q.itm = PROBE_ITM; hipLaunchKernelGGL(fwd_kernel, dim3(grid), dim3(NTHREADS), LDS_BYTES, stream, q); }
#endif
#endif
}
```

```cpp
#include <hip/hip_runtime.h>
#include <hip/hip_cooperative_groups.h>
#include <cstdio>
#include <cstdint>
namespace cg = cooperative_groups;

#ifndef MK_LAUNCH_PER_PHASE
#define MK_LAUNCH_PER_PHASE 0
#endif

constexpr int DM = 1024, SEQ = 2048, NBP = 8, NBS = 128, TS = 8;
constexpr int MP = NBP * SEQ, MS = NBS * TS, MT = MP + MS, NBID = NBP + NBS;
constexpr int DFF = 2816, NMOD = 9 * DM;
constexpr int ZP = 13568;
constexpr int ZQ = 0, ZK = 1024, ZV = 2048, ZO = 4096, ZZ = 6144, ZX = 8192, ZGA = 11264, ZGB = 12288, ZG = 13312;
constexpr float EPS = 1e-6f;
constexpr int NTHREADS = 512;

constexpr size_t MiB = 1u << 20;
constexpr size_t WS_CTL = 0;
constexpr size_t WS_WUP1 = 1 * MiB;
constexpr size_t WS_WDN1 = WS_WUP1 + 11 * MiB;
constexpr size_t WS_WUP2 = WS_WDN1 + 6 * MiB;
constexpr size_t WS_WDN2 = WS_WUP2 + 11 * MiB;
constexpr size_t WS_WIN = WS_WDN2 + 6 * MiB;
constexpr size_t WS_WPA = WS_WIN + 27 * MiB;
constexpr size_t WS_WPB = WS_WPA + 4 * MiB;
constexpr size_t WS_WOUT = WS_WPB + 4 * MiB;
constexpr size_t WS_MOD = WS_WOUT + 2 * MiB;
constexpr size_t WS_U = WS_MOD + 5 * MiB;
constexpr size_t WS_H = WS_U + 34 * MiB;
constexpr size_t WS_X1 = WS_H + 94 * MiB;
constexpr size_t WS_ZIN = WS_X1 + 68 * MiB;
constexpr size_t WS_GATES = WS_ZIN + 451 * MiB;
constexpr size_t WS_YS = WS_GATES + 5 * MiB;
constexpr size_t WS_DEN = WS_YS + 68 * MiB;
constexpr size_t WS_HA = WS_DEN + 1 * MiB;
constexpr size_t WS_HB = WS_HA + 68 * MiB;
constexpr size_t WS_CV = WS_HA;
constexpr size_t WS_XS = WS_CV + 170 * MiB;
constexpr size_t WS_U2 = WS_ZIN;
constexpr size_t WS_FDN1 = WS_XS + 4 * MiB;
constexpr size_t WS_FDN2 = WS_FDN1 + 6 * MiB;
constexpr size_t WS_FPA = WS_FDN2 + 6 * MiB;
constexpr size_t WS_FPB = WS_FPA + 4 * MiB;
constexpr size_t WS_FOUT = WS_FPB + 4 * MiB;
constexpr size_t WS_FG = WS_FOUT + 2 * MiB;
constexpr size_t WS_SC = WS_FG + 1 * MiB;
constexpr size_t WS_END = WS_SC + 1 * MiB;
constexpr int CW_CNT = 4096, CNT_STRIDE = 5120;
constexpr size_t WS_NUM = WS_H;
constexpr size_t WS_TMP = WS_YS;
static_assert(WS_END <= 1024 * MiB, "workspace map");

#define LAS __attribute__((address_space(3)))
typedef unsigned short bf16_t;
typedef short bf16x8 __attribute__((ext_vector_type(8)));
typedef short s16x4 __attribute__((ext_vector_type(4)));
typedef float f32x4 __attribute__((ext_vector_type(4)));
typedef float f32x2 __attribute__((ext_vector_type(2)));
typedef unsigned u32x4 __attribute__((ext_vector_type(4)));
typedef int v8i_t __attribute__((ext_vector_type(8)));
typedef unsigned u32x2 __attribute__((ext_vector_type(2)));

typedef __bf16 bf16x2_t __attribute__((ext_vector_type(2)));
__device__ __forceinline__ unsigned cvt_pk_bf16(float lo, float hi) { const bf16x2_t v = {(__bf16)lo, (__bf16)hi}; return __builtin_bit_cast(unsigned, v); }
__device__ __forceinline__ float bf2f(unsigned short b) { return __uint_as_float(((unsigned)b) << 16); }
__device__ __forceinline__ float bflo(unsigned w) { return __uint_as_float(w << 16); }
__device__ __forceinline__ float bfhi(unsigned w) { return __uint_as_float(w & 0xffff0000u); }
constexpr float F8_SA = 8.0f, F8_SW = 1024.0f, F8_INV = 1.0f / (8.0f * 1024.0f);
__device__ __forceinline__ float f8c(float x) { return fminf(fmaxf(x, -448.0f), 448.0f); }
__device__ __forceinline__ unsigned pack4_fp8(float a, float b, float c, float d, float s) {
    int w = 0; w = __builtin_amdgcn_cvt_pk_fp8_f32(f8c(a * s), f8c(b * s), w, false); w = __builtin_amdgcn_cvt_pk_fp8_f32(f8c(c * s), f8c(d * s), w, true); return (unsigned)w; }
__device__ __forceinline__ float fast_exp(float x) { return __builtin_amdgcn_exp2f(x * 1.4426950408889634f); }
__device__ __forceinline__ float sigmoidf_(float x) { return __builtin_amdgcn_rcpf(1.0f + fast_exp(-x)); }
__device__ __forceinline__ float siluf_(float x) { return x * sigmoidf_(x); }
__device__ __forceinline__ u32x4 pack8(const float (&v)[8], float s) {
    u32x4 w; w.x = cvt_pk_bf16(v[0] * s, v[1] * s); w.y = cvt_pk_bf16(v[2] * s, v[3] * s); w.z = cvt_pk_bf16(v[4] * s, v[5] * s); w.w = cvt_pk_bf16(v[6] * s, v[7] * s); return w;
}
__device__ __forceinline__ u32x2 pack4(const f32x4 v) { u32x2 w; w.x = cvt_pk_bf16(v[0], v[1]); w.y = cvt_pk_bf16(v[2], v[3]); return w; }
__device__ __forceinline__ void unpack8(const u32x4 v, float (&x)[8]) { x[0] = bflo(v.x); x[1] = bfhi(v.x); x[2] = bflo(v.y); x[3] = bfhi(v.y); x[4] = bflo(v.z); x[5] = bfhi(v.z); x[6] = bflo(v.w); x[7] = bfhi(v.w); }
__device__ __forceinline__ size_t fo_index(int r, int k, int K) { return ((size_t)((r >> 4) * (K >> 5) + (k >> 5))) * 512 + (size_t)((((r & 15) + 16 * ((k >> 3) & 3)) << 3) + (k & 7)); }
__device__ __forceinline__ float wave_scan_add(float v) {
    v += __builtin_bit_cast(float, __builtin_amdgcn_update_dpp(0, __builtin_bit_cast(int, v), 0x111, 0xf, 0xf, true));
    v += __builtin_bit_cast(float, __builtin_amdgcn_update_dpp(0, __builtin_bit_cast(int, v), 0x112, 0xf, 0xf, true));
    v += __builtin_bit_cast(float, __builtin_amdgcn_update_dpp(0, __builtin_bit_cast(int, v), 0x114, 0xf, 0xf, true));
    v += __builtin_bit_cast(float, __builtin_amdgcn_update_dpp(0, __builtin_bit_cast(int, v), 0x118, 0xf, 0xf, true));
    v += __builtin_bit_cast(float, __builtin_amdgcn_update_dpp(0, __builtin_bit_cast(int, v), 0x142, 0xa, 0xf, true));
    v += __builtin_bit_cast(float, __builtin_amdgcn_update_dpp(0, __builtin_bit_cast(int, v), 0x143, 0xc, 0xf, true));
    return v;
}
__device__ __forceinline__ float wave_scan_max(float v) {
    const int ninf = (int)0xff800000u;
    v = fmaxf(v, __builtin_bit_cast(float, __builtin_amdgcn_update_dpp(ninf, __builtin_bit_cast(int, v), 0x111, 0xf, 0xf, false)));
    v = fmaxf(v, __builtin_bit_cast(float, __builtin_amdgcn_update_dpp(ninf, __builtin_bit_cast(int, v), 0x112, 0xf, 0xf, false)));
    v = fmaxf(v, __builtin_bit_cast(float, __builtin_amdgcn_update_dpp(ninf, __builtin_bit_cast(int, v), 0x114, 0xf, 0xf, false)));
    v = fmaxf(v, __builtin_bit_cast(float, __builtin_amdgcn_update_dpp(ninf, __builtin_bit_cast(int, v), 0x118, 0xf, 0xf, false)));
    v = fmaxf(v, __builtin_bit_cast(float, __builtin_amdgcn_update_dpp(ninf, __builtin_bit_cast(int, v), 0x142, 0xa, 0xf, false)));
    v = fmaxf(v, __builtin_bit_cast(float, __builtin_amdgcn_update_dpp(ninf, __builtin_bit_cast(int, v), 0x143, 0xc, 0xf, false)));
    return v;
}
__device__ __forceinline__ float wave_sum(float v) { return __builtin_bit_cast(float, __builtin_amdgcn_readlane(__builtin_bit_cast(int, wave_scan_add(v)), 63)); }

struct Params {
    const float* in[36];
    float* out;
    unsigned char* ws;
    int ph_lo, ph_hi, itm, pad;
};

namespace pg8 {
constexpr int BM = 256, BK = 64, HALF = 128, HTB = HALF * BK * 2, STAGE_BYTES = 8 * HTB, NXCD = 8, WGM = 8;
__host__ __device__ __forceinline__ int lds_byte(int r, int c) { const int st = (r >> 4) * 2 + (c >> 5), rr = r & 15, cc = c & 31, ob = rr * 64 + cc * 2; return st * 1024 + (ob ^ (((ob >> 9) & 1) << 5)); }
__host__ __device__ __forceinline__ void stage_rc(int b, int& R, int& C) { const int st = b / 1024, sb = b % 1024, swz = sb ^ (((sb >> 9) & 1) << 5); R = (st >> 1) * 16 + swz / 64; C = (st & 1) * 32 + (swz % 64) / 2; }
__host__ __device__ __forceinline__ int perm32(int rho) { const int n = rho >> 4, i = rho & 15; return 8 * (i >> 2) + 4 * n + (i & 3); }

struct Unit { int pm, pn, w; };
struct Gemm { const bf16_t* A0; const bf16_t* A1; const bf16_t* B0; const bf16_t* B1; int K; };
typedef unsigned u32x8_t __attribute__((ext_vector_type(8)));
__device__ __forceinline__ v8i_t cat8(const bf16x8 x0, const bf16x8 x1) { const u32x4 l = __builtin_bit_cast(u32x4, x0), h = __builtin_bit_cast(u32x4, x1); const u32x8_t c = __builtin_shufflevector(l, h, 0, 1, 2, 3, 4, 5, 6, 7); return __builtin_bit_cast(v8i_t, c); }

struct OrderSample { int c;
    __device__ bool next(int i, Unit& u) const { if (i > 0 || c >= 208) return false; const int x = c & 7, j = c >> 3; u.pm = 64 + (x >> 1); u.pn = (x & 1) * 26 + j; u.w = 0; return true; } };
struct OrderPrompt { int c;
    __device__ bool next(int i, Unit& u) const { const int x = c & 7, j = c >> 3; int q; if (j < 24) { if (i >= 17) return false; q = i * 24 + j; } else { if (i >= 1) return false; q = 408 + (j - 24); }
        u.pm = 8 * x + (q & 7); u.pn = q >> 3; u.w = 0; return true; } };
struct Order {
    int nM, nN, nwg, G, c, dual;
    __device__ void init(int M, int N, int G_, int c_, int dual_) { nM = M / BM; nN = N / BM; nwg = nM * nN; G = G_; c = c_; dual = dual_; }
    __device__ void init_from(int M, int N, int G_, int c_, int first, int lim) { nM = M / BM; nN = N / BM; nwg = lim; G = G_; c = first + c_; dual = 0; }
    __device__ bool next(int i, Unit& u) const {
        const int ti = dual ? (i >> 1) : i;
        const long L = (long)ti * G + c; if (L >= nwg) return false;
        int wgid = (int)L; { const int tot = nM * nN, q = tot / NXCD, r = tot % NXCD, xcd = wgid % NXCD, off = wgid / NXCD; wgid = (xcd < r ? xcd * (q + 1) : r * (q + 1) + (xcd - r) * q) + off; }
        const int nig = WGM * nN, gid = wgid / nig, fm = gid * WGM, gsz = (nM - fm) < WGM ? (nM - fm) : WGM;
        u.pm = fm + ((wgid % nig) % gsz); u.pn = (wgid % nig) / gsz; u.w = dual ? (i & 1) : 0; return true;
    }
};

template <class Epi, bool ALIGN_EPI = true, class Ord = Order, bool FP8 = false>
__device__ __forceinline__ void gemm_phase(LAS unsigned char* lds, const Gemm g, const Ord& S, const Epi E) {
    const int tid = threadIdx.x, wid = __builtin_amdgcn_readfirstlane(tid >> 6), lane = tid & 63, wr = wid >> 2, wc = wid & 3, fr = lane & 15, fq = lane >> 4;
    const int K = g.K, nt = K / BK;
    unsigned voffA[2], voffB[2];
#pragma unroll
    for (int i = 0; i < 2; ++i) { int R, C; stage_rc(tid * 16 + i * 8192, R, C); const int Rb = Epi::PERM ? ((R & ~31) + perm32(R & 31)) : R;
        voffA[i] = (unsigned)(R * K + C) * 2u; voffB[i] = (unsigned)(Rb * K + C) * 2u; }
    const size_t kstep = (size_t)(BK * 2);
    const size_t hstep = (size_t)HALF * K * 2;
    const size_t tstep = 2 * hstep;
    const unsigned ldsw = (unsigned)wid * 1024u;
    const int aoff = lds_byte(wr * 64 + fr, fq * 8), boff = lds_byte(wc * 32 + fr, fq * 8);
#define PG8_SA(b, h) (((b) * 2 + (h)) * HTB)
#define PG8_SB(b, h) ((4 + (b) * 2 + (h)) * HTB)
#define PG8_STAGE(bufoff, gbase, voff) do { _Pragma("unroll") for (int _i = 0; _i < 2; ++_i) \
        __builtin_amdgcn_global_load_lds((const unsigned*)((const char*)(gbase) + (voff)[_i]), (LAS unsigned*)(lds + (bufoff) + ldsw + _i * 8192), 16, 0, 0); } while (0)
#define PG8_LDA(dst, b, h) do { _Pragma("unroll") for (int m = 0; m < 4; ++m) _Pragma("unroll") for (int k = 0; k < 2; ++k) dst[m][k] = *(const LAS bf16x8*)(lds + PG8_SA(b, h) + aoff + m * 2048 + k * 1024); } while (0)
#define PG8_LDB(dst, b, h) do { _Pragma("unroll") for (int n = 0; n < 2; ++n) _Pragma("unroll") for (int k = 0; k < 2; ++k) dst[n][k] = *(const LAS bf16x8*)(lds + PG8_SB(b, h) + boff + n * 2048 + k * 1024); } while (0)
#define PG8_CAT8(x0, x1) cat8((x0), (x1))
#define PG8_MMA(ai, bj, At, Bt) do { __builtin_amdgcn_s_setprio(1); _Pragma("unroll") for (int m = 0; m < 4; ++m) _Pragma("unroll") for (int n = 0; n < 2; ++n) { \
        if constexpr (FP8) { const v8i_t b8_ = PG8_CAT8(Bt[n][0], Bt[n][1]), a8_ = PG8_CAT8(At[m][0], At[m][1]); \
            asm volatile("v_mfma_scale_f32_16x16x128_f8f6f4 %0, %1, %2, %0, %3, %3 op_sel_hi:[0,0,0]" : "+v"(acc[ai][bj][m][n]) : "v"(b8_), "v"(a8_), "v"(f8one)); } \
        else { _Pragma("unroll") for (int k = 0; k < 2; ++k) acc[ai][bj][m][n] = __builtin_amdgcn_mfma_f32_16x16x32_bf16(Bt[n][k], At[m][k], acc[ai][bj][m][n], 0, 0, 0); } } __builtin_amdgcn_s_setprio(0); } while (0)
#define PG8_WAIT_V(n) asm volatile("s_waitcnt vmcnt(" #n ")" ::: "memory")
#define PG8_WAIT_L(n) asm volatile("s_waitcnt lgkmcnt(" #n ")" ::: "memory")
#define PG8_BAR __builtin_amdgcn_s_barrier()
#define PG8_SCHED __builtin_amdgcn_sched_barrier(0)
    Unit cur, nxt; int ui = 0;
    if (!S.next(0, cur)) return;
    const int f8one = 0x7F7F7F7F;
    f32x4 acc[2][2][4][2];
#pragma unroll
    for (int a = 0; a < 2; ++a)
#pragma unroll
        for (int b = 0; b < 2; ++b)
#pragma unroll
            for (int m = 0; m < 4; ++m)
#pragma unroll
                for (int n = 0; n < 2; ++n) acc[a][b][m][n] = (f32x4){0.f, 0.f, 0.f, 0.f};
    bf16x8 At[4][2], B0[2][2], B1[2][2];
    const char* cA = (const char*)(cur.w ? g.A1 : g.A0) + (size_t)cur.pm * tstep; const char* cB = (const char*)(cur.w ? g.B1 : g.B0) + (size_t)cur.pn * tstep;
    PG8_STAGE(PG8_SB(0, 0), cB, voffB); PG8_STAGE(PG8_SB(0, 1), cB + hstep, voffB); PG8_STAGE(PG8_SA(0, 0), cA, voffA); PG8_STAGE(PG8_SA(0, 1), cA + hstep, voffA);
    if (wr == 1) PG8_BAR;
    PG8_WAIT_V(2); PG8_BAR;
    PG8_STAGE(PG8_SB(1, 0), cB + kstep, voffB); PG8_STAGE(PG8_SA(1, 0), cA + kstep, voffA); PG8_STAGE(PG8_SB(1, 1), cB + hstep + kstep, voffB);
    PG8_WAIT_V(6); PG8_BAR;
    for (;;) {
        const bool has_next = S.next(ui + 1, nxt);
        const char* nA = has_next ? (const char*)(nxt.w ? g.A1 : g.A0) + (size_t)nxt.pm * tstep : cA; const char* nB = has_next ? (const char*)(nxt.w ? g.B1 : g.B0) + (size_t)nxt.pn * tstep : cB;
        for (int t = 0; t < nt; t += 2) {
            const bool last = (t == nt - 2);
            const char* a1 = cA + (size_t)(t + 1) * kstep;
            const char* a2 = last ? nA : cA + (size_t)(t + 2) * kstep; const char* b2 = last ? nB : cB + (size_t)(t + 2) * kstep;
            const char* a3 = a2 + kstep; const char* b3 = b2 + kstep;
            PG8_LDB(B0, 0, 0); PG8_LDB(B1, 0, 1); PG8_SCHED; PG8_LDA(At, 0, 0); PG8_STAGE(PG8_SA(1, 1), a1 + hstep, voffA);
            PG8_WAIT_V(8); PG8_WAIT_L(0); PG8_BAR; PG8_MMA(0, 0, At, B0); PG8_MMA(0, 1, At, B1); PG8_BAR; PG8_SCHED;
            PG8_LDA(At, 0, 1); PG8_STAGE(PG8_SB(0, 0), b2, voffB); PG8_STAGE(PG8_SB(0, 1), b2 + hstep, voffB); PG8_STAGE(PG8_SA(0, 0), a2, voffA);
            PG8_WAIT_V(8); PG8_WAIT_L(0); PG8_BAR; PG8_MMA(1, 0, At, B0); PG8_MMA(1, 1, At, B1); PG8_BAR; PG8_SCHED;
            PG8_LDB(B0, 1, 0); PG8_LDB(B1, 1, 1); PG8_SCHED; PG8_LDA(At, 1, 0); PG8_STAGE(PG8_SA(0, 1), a2 + hstep, voffA);
            PG8_WAIT_V(8); PG8_WAIT_L(0); PG8_BAR; PG8_MMA(0, 0, At, B0); PG8_MMA(0, 1, At, B1); PG8_BAR; PG8_SCHED;
            PG8_LDA(At, 1, 1); PG8_STAGE(PG8_SB(1, 0), b3, voffB); PG8_STAGE(PG8_SB(1, 1), b3 + hstep, voffB); PG8_STAGE(PG8_SA(1, 0), a3, voffA);
            PG8_WAIT_V(8); PG8_WAIT_L(0); PG8_BAR; PG8_MMA(1, 0, At, B0); PG8_MMA(1, 1, At, B1); PG8_BAR; PG8_SCHED;
        }
        if constexpr (ALIGN_EPI) { if (wr == 0) PG8_BAR; }
        if constexpr (FP8) asm volatile("s_nop 15\n\ts_nop 15" ::: "memory");
        if constexpr (!Epi::AFTER_DRAIN) E(acc, cur, wr, wc, fr, fq);
        if (!has_next) break;
#pragma unroll
        for (int a = 0; a < 2; ++a)
#pragma unroll
            for (int b = 0; b < 2; ++b)
#pragma unroll
                for (int m = 0; m < 4; ++m)
#pragma unroll
                    for (int n = 0; n < 2; ++n) acc[a][b][m][n] = (f32x4){0.f, 0.f, 0.f, 0.f};
        cur = nxt; cA = nA; cB = nB; ++ui;
        if constexpr (ALIGN_EPI) { if (wr == 1) PG8_BAR; }
    }
    PG8_WAIT_V(0);
    if constexpr (!ALIGN_EPI) { if (wr == 0) PG8_BAR; }
    PG8_BAR;
    if constexpr (Epi::AFTER_DRAIN) E.fused(acc, cur, wr, wc, fr, fq, lds, wid, lane);
#undef PG8_SA
#undef PG8_SB
#undef PG8_STAGE
#undef PG8_LDA
#undef PG8_LDB
#undef PG8_MMA
#undef PG8_WAIT_V
#undef PG8_WAIT_L
#undef PG8_BAR
#undef PG8_SCHED
}

__device__ __forceinline__ int bid_of_row(int row) { return row < MP ? (row >> 11) : (NBP + ((row - MP) >> 3)); }

struct EpiSwiGLU {
    static constexpr bool PERM = true, AFTER_DRAIN = false;
    bf16_t* H; float inv;
    __device__ __forceinline__ void operator()(const f32x4 (&acc)[2][2][4][2], const Unit& u, int wr, int wc, int fr, int fq) const {
        const int row0 = u.pm * BM + wr * 64 + fr, hc0 = u.pn * 128 + wc * 32 + 8 * fq; const float inv_ = inv;
#pragma unroll
        for (int ai = 0; ai < 2; ++ai)
#pragma unroll
            for (int m = 0; m < 4; ++m) { const f32x4 a0 = acc[ai][0][m][0] * inv_, a1 = acc[ai][0][m][1] * inv_, b0 = acc[ai][1][m][0] * inv_, b1 = acc[ai][1][m][1] * inv_;
                u32x4 w; w.x = cvt_pk_bf16(siluf_(a0[0]) * b0[0], siluf_(a0[1]) * b0[1]); w.y = cvt_pk_bf16(siluf_(a0[2]) * b0[2], siluf_(a0[3]) * b0[3]);
                w.z = cvt_pk_bf16(siluf_(a1[0]) * b1[0], siluf_(a1[1]) * b1[1]); w.w = cvt_pk_bf16(siluf_(a1[2]) * b1[2], siluf_(a1[3]) * b1[3]);
                const int row = row0 + ai * HALF + m * 16;
                if (u.pm < MP / BM) *(u32x2*)((unsigned char*)H + (size_t)row * DFF + hc0) = (u32x2){pack4_fp8(siluf_(a0[0]) * b0[0], siluf_(a0[1]) * b0[1], siluf_(a0[2]) * b0[2], siluf_(a0[3]) * b0[3], F8_SA), pack4_fp8(siluf_(a1[0]) * b1[0], siluf_(a1[1]) * b1[1], siluf_(a1[2]) * b1[2], siluf_(a1[3]) * b1[3], F8_SA)};
                else *(u32x4*)(H + (size_t)MP * DFF + fo_index(row - MP, hc0, DFF)) = w; }
    }
};
struct EpiResid {
    static constexpr bool PERM = false, AFTER_DRAIN = false;
    const float* xin_p; const float* xin_s; float* out; const float* gmod; float coef;
    __device__ __forceinline__ void operator()(const f32x4 (&acc)[2][2][4][2], const Unit& u, int wr, int wc, int fr, int fq) const {
        const int row0 = u.pm * BM + wr * 64 + fr, col0 = u.pn * BM + wc * 32 + 4 * fq;
#pragma unroll
        for (int ai = 0; ai < 2; ++ai)
#pragma unroll
            for (int m = 0; m < 4; ++m) { const int row = row0 + ai * HALF + m * 16;
                const float* xr = (row < MP ? xin_p + (size_t)row * DM : xin_s + (size_t)(row - MP) * DM) + col0;
                const float* gr = gmod + (size_t)bid_of_row(row) * NMOD + col0; float* orow = out + (size_t)row * DM + col0;
#pragma unroll
                for (int bj = 0; bj < 2; ++bj)
#pragma unroll
                    for (int n = 0; n < 2; ++n) { const int o = bj * HALF + n * 16; const f32x4 xv = *(const f32x4*)(xr + o), gv = *(const f32x4*)(gr + o);
                        *(f32x4*)(orow + o) = xv + coef * gv * acc[ai][bj][m][n]; } }
    }
};

__device__ __forceinline__ void panel_wait(unsigned* cnt, unsigned need) {
    unsigned spins = 0;
    while ((unsigned)__builtin_amdgcn_readfirstlane(__hip_atomic_load(cnt, __ATOMIC_RELAXED, __HIP_MEMORY_SCOPE_AGENT)) < need) { if (++spins > (1u << 20)) break; __builtin_amdgcn_s_sleep(2); }
    __builtin_amdgcn_fence(__ATOMIC_ACQUIRE, "agent");
}
template <bool FINAL>
struct EpiResidNorm {
    static constexpr bool PERM = true, AFTER_DRAIN = true;
    const float* xin; float* Xout; const float* gmod; const float* gw; const float* shmod; const float* scmod; bf16_t* Uout; float* Yout; float* XS; unsigned* cnt; float coef; int pad_;
    __device__ __forceinline__ void fused(f32x4 (&acc)[2][2][4][2], const Unit& u, int wr, int wc, int fr, int fq, LAS unsigned char* lds, int wid, int lane) const {
        LAS float* P = (LAS float*)lds; LAS float* S = (LAS float*)(lds + 4096);
        const float* const xin_ = xin; float* const Xout_ = Xout; const float* const gmod_ = gmod; const float coef_ = coef; const float* const gw_ = gw; const float* const shmod_ = shmod; const float* const scmod_ = scmod;
        bf16_t* const Uout_ = Uout; float* const Yout_ = Yout; float* const XS_ = XS; unsigned* const cnt_ = cnt;
        const int b = u.pm >> 3, col0 = u.pn * BM + wc * 32 + 8 * fq, rowt = wr * 64 + fr;
        { f32x4 gv[2][2];
#pragma unroll
          for (int bj = 0; bj < 2; ++bj)
#pragma unroll
              for (int n = 0; n < 2; ++n) gv[bj][n] = coef_ * *(const f32x4*)(gmod_ + (size_t)b * NMOD + col0 + bj * HALF + n * 4);
#pragma unroll
          for (int ai = 0; ai < 2; ++ai)
#pragma unroll
              for (int m = 0; m < 4; ++m) { const int rt = rowt + ai * HALF + m * 16; const float* xr = xin_ + (size_t)(u.pm * BM + rt) * DM + col0; float ss = 0.f;
#pragma unroll
                  for (int bj = 0; bj < 2; ++bj)
#pragma unroll
                      for (int n = 0; n < 2; ++n) { const f32x4 x = *(const f32x4*)(xr + bj * HALF + n * 4) + gv[bj][n] * acc[ai][bj][m][n]; acc[ai][bj][m][n] = x; ss += (x[0] * x[0] + x[1] * x[1]) + (x[2] * x[2] + x[3] * x[3]); }
                  ss += __shfl_xor(ss, 16); ss += __shfl_xor(ss, 32);
                  if (fq == 0) P[rt * 4 + wc] = ss;
                  asm volatile("" ::: "memory"); } }
        __syncthreads();
        const int r32 = wid * 32 + (lane & 31); float* slot = XS_ + (size_t)(u.pm * BM + r32) * 16;
        if (lane < 32) { const f32x4 pp = *(const LAS f32x4*)(P + r32 * 4); __hip_atomic_store(slot + u.pn, (pp[0] + pp[1]) + (pp[2] + pp[3]), __ATOMIC_RELAXED, __HIP_MEMORY_SCOPE_AGENT); }
        asm volatile("s_waitcnt vmcnt(0)" ::: "memory");
        if (lane == 0) __hip_atomic_fetch_add(cnt_ + 64 * u.pm, 1u, __ATOMIC_RELAXED, __HIP_MEMORY_SCOPE_AGENT);
        if (wid == 0) panel_wait(cnt_ + 64 * u.pm, 32u);
        asm volatile("s_waitcnt vmcnt(0) lgkmcnt(0)" ::: "memory");
        __syncthreads();
        if (lane < 32) { float tot = 0.f;
#pragma unroll
            for (int t = 0; t < 4; ++t) tot += __hip_atomic_load(slot + t, __ATOMIC_RELAXED, __HIP_MEMORY_SCOPE_AGENT);
            S[r32] = 1.0f / sqrtf(tot * (1.0f / DM) + EPS); }
        __syncthreads();
        f32x4 fac[2][2], shv[2][2];
#pragma unroll
        for (int bj = 0; bj < 2; ++bj)
#pragma unroll
            for (int n = 0; n < 2; ++n) { const int c = col0 + bj * HALF + n * 4; fac[bj][n] = *(const f32x4*)(gw_ + c);
                if constexpr (!FINAL) { fac[bj][n] = fac[bj][n] * (1.0f + *(const f32x4*)(scmod_ + (size_t)b * NMOD + c)); shv[bj][n] = *(const f32x4*)(shmod_ + (size_t)b * NMOD + c); } }
#pragma unroll
        for (int ai = 0; ai < 2; ++ai)
#pragma unroll
            for (int m = 0; m < 4; ++m) { const int rt = rowt + ai * HALF + m * 16; const size_t off = (size_t)(u.pm * BM + rt) * DM + col0; const float r = S[rt];
#pragma unroll
                for (int bj = 0; bj < 2; ++bj) { const f32x4 x0 = acc[ai][bj][m][0], x1 = acc[ai][bj][m][1]; const int o = bj * HALF;
                    if constexpr (FINAL) { *(f32x4*)(Yout_ + off + o) = x0 * r * fac[bj][0]; *(f32x4*)(Yout_ + off + o + 4) = x1 * r * fac[bj][1]; }
                    else { *(f32x4*)(Xout_ + off + o) = x0; *(f32x4*)(Xout_ + off + o + 4) = x1;
                        const f32x4 y0 = x0 * r * fac[bj][0] + shv[bj][0], y1 = x1 * r * fac[bj][1] + shv[bj][1];
                        if (pad_) *(u32x2*)((unsigned char*)Uout_ + off + o) = (u32x2){pack4_fp8(y0[0], y0[1], y0[2], y0[3], F8_SA), pack4_fp8(y1[0], y1[1], y1[2], y1[3], F8_SA)};
                        else { const u32x2 w0 = pack4(y0), w1 = pack4(y1); *(u32x4*)(Uout_ + off + o) = (u32x4){w0.x, w0.y, w1.x, w1.y}; } } } }
    }
};
struct EpiZin {
    static constexpr bool PERM = true, AFTER_DRAIN = false;
    bf16_t* Z; float* gates;
    __device__ __forceinline__ void operator()(const f32x4 (&acc)[2][2][4][2], const Unit& u, int wr, int wc, int fr, int fq) const {
        const int row0 = u.pm * BM + wr * 64 + fr;
        {
            const int col0 = u.pn * BM + wc * 32 + 8 * fq;
#pragma unroll
            for (int ai = 0; ai < 2; ++ai)
#pragma unroll
                for (int m = 0; m < 4; ++m) { bf16_t* rp = Z + (size_t)(row0 + ai * HALF + m * 16) * ZP + col0;
#pragma unroll
                    for (int bj = 0; bj < 2; ++bj) { const f32x4 v0 = acc[ai][bj][m][0], v1 = acc[ai][bj][m][1];
                        u32x4 w; w.x = cvt_pk_bf16(v0[0], v0[1]); w.y = cvt_pk_bf16(v0[2], v0[3]); w.z = cvt_pk_bf16(v1[0], v1[1]); w.w = cvt_pk_bf16(v1[2], v1[3]);
                        *(u32x4*)(rp + bj * HALF) = w; } }
        }
    }
};
struct EpiMerge {
    static constexpr bool PERM = true, AFTER_DRAIN = false;
    const bf16_t* Z; float* tmp; bf16_t* U; float inv;
    __device__ __forceinline__ void operator()(const f32x4 (&acc)[2][2][4][2], const Unit& u, int wr, int wc, int fr, int fq) const {
        const int row0 = u.pm * BM + wr * 64 + fr, col0 = u.pn * BM + wc * 32 + 8 * fq;
        const int zoff = u.w ? ZGB : ZGA; const float inv_ = inv; bf16_t* const part = (bf16_t*)tmp;
#pragma unroll
        for (int ai = 0; ai < 2; ++ai)
#pragma unroll
            for (int m = 0; m < 4; ++m) { const int row = row0 + ai * HALF + m * 16;
#pragma unroll
                for (int bj = 0; bj < 2; ++bj) { const int c = col0 + bj * HALF;
                    const u32x4 gz = *(const u32x4*)(Z + (size_t)row * ZP + zoff + c);
                    f32x4 s0, s1; s0[0] = sigmoidf_(bflo(gz.x)); s0[1] = sigmoidf_(bfhi(gz.x)); s0[2] = sigmoidf_(bflo(gz.y)); s0[3] = sigmoidf_(bfhi(gz.y));
                    s1[0] = sigmoidf_(bflo(gz.z)); s1[1] = sigmoidf_(bfhi(gz.z)); s1[2] = sigmoidf_(bflo(gz.w)); s1[3] = sigmoidf_(bfhi(gz.w));
                    f32x4 v0 = s0 * (acc[ai][bj][m][0] * inv_), v1 = s1 * (acc[ai][bj][m][1] * inv_);
                    u32x4* pp = (u32x4*)(part + (size_t)row * DM + c);
                    if (u.w == 0) { u32x4 w; w.x = cvt_pk_bf16(v0[0], v0[1]); w.y = cvt_pk_bf16(v0[2], v0[3]); w.z = cvt_pk_bf16(v1[0], v1[1]); w.w = cvt_pk_bf16(v1[2], v1[3]); *pp = w; }
                    else { const u32x4 pv = *pp; v0[0] += bflo(pv.x); v0[1] += bfhi(pv.x); v0[2] += bflo(pv.y); v0[3] += bfhi(pv.y); v1[0] += bflo(pv.z); v1[1] += bfhi(pv.z); v1[2] += bflo(pv.w); v1[3] += bfhi(pv.w);
                        *(u32x2*)((unsigned char*)U + (size_t)row * DM + c) = (u32x2){pack4_fp8(v0[0], v0[1], v0[2], v0[3], F8_SA), pack4_fp8(v1[0], v1[1], v1[2], v1[3], F8_SA)}; } } }
    }
};
}


struct Frame {
    LAS unsigned char* lds;
    int tid, lane, wave, G, bx;
    float* out; unsigned char* ws;
};
constexpr int PTAB_OFF = 147072;
__device__ __forceinline__ const float* pin_ld(const Frame& F, const int k) {
    const volatile LAS unsigned* T = (const volatile LAS unsigned*)(F.lds + PTAB_OFF);
    const unsigned lo = (unsigned)__builtin_amdgcn_readfirstlane((int)T[2 * k]), hi = (unsigned)__builtin_amdgcn_readfirstlane((int)T[2 * k + 1]);
    return (const float*)(((uint64_t)hi << 32) | (uint64_t)lo);
}
#define PIN(k) pin_ld(F, (k))

template <int KTOT, bool FOA, bool FOB>
__device__ __forceinline__ void small_gemm_partials(LAS unsigned char* lds, const bf16_t* A, const bf16_t* Bt, int wave, int lane) {
    const int fr = lane & 15, fq = lane >> 4; constexpr int NKS = KTOT / 256; const int T0 = wave * NKS;
    const bf16_t* ap = A + (size_t)fr * KTOT + 8 * fq; const bf16_t* bp = Bt + (size_t)fr * KTOT + 8 * fq;
    f32x4 acc[4][4];
#pragma unroll
    for (int i = 0; i < 4; ++i)
#pragma unroll
        for (int j = 0; j < 4; ++j) acc[i][j] = (f32x4){0.f, 0.f, 0.f, 0.f};
    bf16x8 a[4][4], b[4][4];
#define SG_LOAD(slot, t) do { const int T_ = T0 + (t), ko_ = 32 * T_; _Pragma("unroll") for (int i = 0; i < 4; ++i) { \
        if constexpr (FOA) a[slot][i] = *(const bf16x8*)(A + ((size_t)(i * (KTOT / 32) + T_)) * 512 + 8 * lane); else a[slot][i] = *(const bf16x8*)(ap + (size_t)(16 * i) * KTOT + ko_); \
        if constexpr (FOB) b[slot][i] = *(const bf16x8*)(Bt + ((size_t)(i * (KTOT / 32) + T_)) * 512 + 8 * lane); else b[slot][i] = *(const bf16x8*)(bp + (size_t)(16 * i) * KTOT + ko_); } } while (0)
#pragma unroll
    for (int t = 0; t < 4 && t < NKS; ++t) SG_LOAD(t, t);
    __builtin_amdgcn_sched_barrier(0);
#pragma unroll
    for (int t = 0; t < NKS; ++t) {
#pragma unroll
        for (int tn = 0; tn < 4; ++tn)
#pragma unroll
            for (int tm = 0; tm < 4; ++tm) acc[tn][tm] = __builtin_amdgcn_mfma_f32_16x16x32_bf16(b[t & 3][tn], a[t & 3][tm], acc[tn][tm], 0, 0, 0);
        __builtin_amdgcn_sched_barrier(0);
        if (t + 4 < NKS) { SG_LOAD(t & 3, t + 4); __builtin_amdgcn_sched_barrier(0); } }
#undef SG_LOAD
    LAS f32x4* PART = (LAS f32x4*)lds;
#pragma unroll
    for (int tn = 0; tn < 4; ++tn)
#pragma unroll
        for (int tm = 0; tm < 4; ++tm) PART[(wave * 16 + tn * 4 + tm) * 64 + lane] = acc[tn][tm];
}
__device__ __forceinline__ f32x4 small_gemm_sum(LAS unsigned char* lds, int tid, int j) {
    const LAS f32x4* PART = (const LAS f32x4*)lds; const int tile = 8 * j + (tid >> 6), ln = tid & 63; f32x4 sum = PART[tile * 64 + ln];
#pragma unroll
    for (int wv = 1; wv < 8; ++wv) sum += PART[(wv * 16 + tile) * 64 + ln];
    return sum;
}
template <int KTOT>
__device__ __forceinline__ void small_phase_resid(Frame& F, const bf16_t* A, const bf16_t* Bt, const float* xin_s, float* out, const float* gmod, float coef) {
    for (int st = F.bx; st < 256; st += F.G) { const int x = st & 7, j = st >> 3, sm = 4 * (x >> 1) + (j >> 3), sn = 8 * (x & 1) + (j & 7);
        __syncthreads();
        small_gemm_partials<KTOT, true, true>(F.lds, A + (size_t)(MP + 64 * sm) * KTOT, Bt + (size_t)(64 * sn) * KTOT, F.wave, F.lane);
        __syncthreads();
#pragma unroll
        for (int j = 0; j < 2; ++j) { const f32x4 v = small_gemm_sum(F.lds, F.tid, j); const int tile = 8 * j + (F.tid >> 6), tn = tile >> 2, tm = tile & 3;
            const int ms = 64 * sm + 16 * tm + (F.lane & 15), n = 64 * sn + 16 * tn + 4 * (F.lane >> 4), row = MP + ms;
            const f32x4 xv = *(const f32x4*)(xin_s + (size_t)ms * DM + n), gv = *(const f32x4*)(gmod + (size_t)pg8::bid_of_row(row) * NMOD + n);
            *(f32x4*)(out + (size_t)row * DM + n) = xv + coef * gv * v; } }
}
template <int KTOT, bool FINAL>
__device__ __forceinline__ void small_phase_resid_norm(Frame& F, const bf16_t* A, const bf16_t* Bt, const float* xin_s, float* Xout, const float* gmod, float coef,
                                                       const float* gw, const float* shmod, const float* scmod, bf16_t* Uout, float* Yout, float* XS, unsigned* cnt) {
    LAS float* P2 = (LAS float*)(F.lds + 131072); LAS float* S2 = (LAS float*)(F.lds + 131072 + 512);
    for (int st = F.bx; st < 256; st += F.G) { const int x = st & 7, j0 = st >> 3, sm = 4 * (x >> 1) + (j0 >> 3), sn = 8 * (x & 1) + (j0 & 7);
        __syncthreads();
        small_gemm_partials<KTOT, true, true>(F.lds, A + (size_t)(MP + 64 * sm) * KTOT, Bt + (size_t)(64 * sn) * KTOT, F.wave, F.lane);
        __syncthreads();
        const int fr = F.lane & 15, fq = F.lane >> 4, tm = F.wave & 3, rl = 16 * tm + fr, ms = 64 * sm + rl, row = MP + ms, bid = NBP + (ms >> 3);
        f32x4 xn[2]; float ss = 0.f;
#pragma unroll
        for (int j = 0; j < 2; ++j) { const int n = 64 * sn + 16 * (2 * j + (F.wave >> 2)) + 4 * fq;
            const f32x4 x4 = *(const f32x4*)(xin_s + (size_t)ms * DM + n) + coef * *(const f32x4*)(gmod + (size_t)bid * NMOD + n) * small_gemm_sum(F.lds, F.tid, j);
            xn[j] = x4; ss += (x4[0] * x4[0] + x4[1] * x4[1]) + (x4[2] * x4[2] + x4[3] * x4[3]); }
        ss += __shfl_xor(ss, 16); ss += __shfl_xor(ss, 32);
        if (fq == 0) P2[(F.wave >> 2) * 64 + rl] = ss;
        __syncthreads();
        float* slot = XS + (size_t)(MP + 64 * sm + F.lane) * 16;
        if (F.wave == 0) { __hip_atomic_store(slot + sn, P2[F.lane] + P2[64 + F.lane], __ATOMIC_RELAXED, __HIP_MEMORY_SCOPE_AGENT);
            asm volatile("s_waitcnt vmcnt(0)" ::: "memory");
            if (F.lane == 0) __hip_atomic_fetch_add(cnt + 64 * (64 + sm), 1u, __ATOMIC_RELAXED, __HIP_MEMORY_SCOPE_AGENT);
            pg8::panel_wait(cnt + 64 * (64 + sm), 16u);
            float tot = 0.f;
#pragma unroll
            for (int t = 0; t < 16; ++t) tot += __hip_atomic_load(slot + t, __ATOMIC_RELAXED, __HIP_MEMORY_SCOPE_AGENT);
            S2[F.lane] = 1.0f / sqrtf(tot * (1.0f / DM) + EPS); }
        __syncthreads();
        const float r = S2[rl];
#pragma unroll
        for (int j = 0; j < 2; ++j) { const int n = 64 * sn + 16 * (2 * j + (F.wave >> 2)) + 4 * fq; const f32x4 g4 = *(const f32x4*)(gw + n);
            if constexpr (FINAL) *(f32x4*)(Yout + (size_t)row * DM + n) = xn[j] * r * g4;
            else { *(f32x4*)(Xout + (size_t)row * DM + n) = xn[j];
                const f32x4 yq = xn[j] * r * g4 * (1.0f + *(const f32x4*)(scmod + (size_t)bid * NMOD + n)) + *(const f32x4*)(shmod + (size_t)bid * NMOD + n);
                if constexpr (KTOT == DM) *(unsigned*)((unsigned char*)Uout + (size_t)row * DM + n) = pack4_fp8(yq[0], yq[1], yq[2], yq[3], F8_SA);
                else *(u32x2*)(Uout + (size_t)row * DM + n) = pack4(yq); } } }
}
__device__ __forceinline__ void small_gates_tile(Frame& F, const bf16_t* U, const bf16_t* Wg, float* gates, const int st) {
    {
        __syncthreads();
        small_gemm_partials<DM, false, true>(F.lds, U + (size_t)(64 * st) * DM, Wg, F.wave, F.lane);
        __syncthreads();
#pragma unroll
        for (int j = 0; j < 2; ++j) { const f32x4 v = small_gemm_sum(F.lds, F.tid, j); const int tile = 8 * j + (F.tid >> 6), tn = tile >> 2, tm = tile & 3;
            *(f32x4*)(gates + (size_t)(64 * st + 16 * tm + (F.lane & 15)) * 64 + 16 * tn + 4 * (F.lane >> 4)) = v; } }
}
__device__ __forceinline__ void small_phase_merge(Frame& F, const bf16_t* HA, const bf16_t* HB, const bf16_t* WA, const bf16_t* WB, const bf16_t* Z, bf16_t* U) {
    for (int st = F.bx; st < 256; st += F.G) { const int x = st & 7, j = st >> 3, sm = 4 * (x >> 1) + (j >> 3), sn = 8 * (x & 1) + (j & 7); f32x4 va[2], vb[2];
        __syncthreads();
        small_gemm_partials<2048, true, true>(F.lds, HA + (size_t)(MP + 64 * sm) * 2048, WA + (size_t)(64 * sn) * 2048, F.wave, F.lane);
        __syncthreads();
        va[0] = small_gemm_sum(F.lds, F.tid, 0); va[1] = small_gemm_sum(F.lds, F.tid, 1);
        __syncthreads();
        small_gemm_partials<2048, true, true>(F.lds, HB + (size_t)(MP + 64 * sm) * 2048, WB + (size_t)(64 * sn) * 2048, F.wave, F.lane);
        __syncthreads();
        vb[0] = small_gemm_sum(F.lds, F.tid, 0); vb[1] = small_gemm_sum(F.lds, F.tid, 1);
#pragma unroll
        for (int j = 0; j < 2; ++j) { const int tile = 8 * j + (F.tid >> 6), tn = tile >> 2, tm = tile & 3;
            const int row = MP + 64 * sm + 16 * tm + (F.lane & 15), n = 64 * sn + 16 * tn + 4 * (F.lane >> 4);
            const u32x2 ga = *(const u32x2*)(Z + (size_t)row * ZP + ZGA + n), gb = *(const u32x2*)(Z + (size_t)row * ZP + ZGB + n);
            f32x4 o; o[0] = sigmoidf_(bflo(ga.x)) * va[j][0] + sigmoidf_(bflo(gb.x)) * vb[j][0]; o[1] = sigmoidf_(bfhi(ga.x)) * va[j][1] + sigmoidf_(bfhi(gb.x)) * vb[j][1];
            o[2] = sigmoidf_(bflo(ga.y)) * va[j][2] + sigmoidf_(bflo(gb.y)) * vb[j][2]; o[3] = sigmoidf_(bfhi(ga.y)) * va[j][3] + sigmoidf_(bfhi(gb.y)) * vb[j][3];
            *(u32x2*)(U + (size_t)MP * DM + fo_index(row - MP, n, DM)) = pack4(o); } }
}

#define GAS __attribute__((address_space(1)))
#define XB_TMO      128
#define XB_XCNT(j)  (256  + 64 * (j))
#define XB_XSUB(j)  (1280 + 64 * (j))
#define XB_XGEN(j)  (2304 + 64 * (j))
#define XB_TOP      3328
#define XB_TOPGEN   3392
#define XCD_BAR_WORDS 3456
#define XB_SPIN_CAP (1u << 22)
__device__ __forceinline__ unsigned xb_ld(unsigned* p)              { return __hip_atomic_load(p, __ATOMIC_RELAXED, __HIP_MEMORY_SCOPE_AGENT); }
__device__ __forceinline__ unsigned xb_add(unsigned* p, unsigned v) { return __hip_atomic_fetch_add(p, v, __ATOMIC_RELAXED, __HIP_MEMORY_SCOPE_AGENT); }
__device__ __forceinline__ unsigned xb_xcc_id() { return (unsigned)__builtin_amdgcn_s_getreg((3 << 11) | 20) & 0xFu; }
#define XB_SPIN(cond, bar) do { unsigned _sp = 0; while (cond) { __builtin_amdgcn_s_sleep(1); \
    if ((++_sp & 255u) == 0u) { if (xb_ld(&(bar)[XB_TMO])) break; if (_sp > XB_SPIN_CAP) { atomicAdd(&(bar)[XB_TMO], 1u); break; } } } } while (0)
struct XcdBarrier { unsigned* bar; unsigned x; volatile LAS unsigned* st; };
__device__ __forceinline__ XcdBarrier xcd_barrier_post(unsigned* bar, volatile LAS unsigned* st) {
    XcdBarrier b; b.bar = bar; b.x = xb_xcc_id(); b.st = st;
    if (threadIdx.x == 0) (void)xb_add(&bar[XB_XCNT(b.x)], 1u);
    return b;
}
__device__ __forceinline__ void xcd_barrier_complete(unsigned* bar, unsigned x, unsigned& nloc, unsigned& nx) {
    const unsigned G = gridDim.x * gridDim.y * gridDim.z;
    unsigned sum, cnt, mine, sp = 0u;
    for (;;) {
        sum = 0u; cnt = 0u; mine = 0u;
#pragma unroll
        for (unsigned j = 0; j < 16; ++j) { const unsigned c = xb_ld(&bar[XB_XCNT(j)]); sum += c; cnt += (c > 0u) ? 1u : 0u; mine = (j == x) ? c : mine; }
        if (sum == G) break;
        __builtin_amdgcn_s_sleep(1);
        if ((++sp & 255u) == 0u) { if (xb_ld(&bar[XB_TMO])) break; if (sp > XB_SPIN_CAP) { atomicAdd(&bar[XB_TMO], 1u); break; } }
    }
    nloc = mine > 0u ? mine : 1u; nx = cnt > 0u ? cnt : 1u;
}
__device__ __forceinline__ void xcd_barrier(const XcdBarrier& b) {
    asm volatile("s_waitcnt vmcnt(0)" ::: "memory");
    __syncthreads();
    if (threadIdx.x == 0) {
        unsigned* bar = b.bar;
        __builtin_amdgcn_s_waitcnt(0);
        unsigned nloc = b.st[0], nx = b.st[1];
        if (nloc == 0u) { xcd_barrier_complete(bar, b.x, nloc, nx); b.st[0] = nloc; b.st[1] = nx; }
        const unsigned old = xb_add(&bar[XB_XSUB(b.x)], 1u);
        const unsigned gen = old / nloc;
        if (old + 1u == (gen + 1u) * nloc) {
            __builtin_amdgcn_fence(__ATOMIC_RELEASE, "agent");
            asm volatile("s_waitcnt vmcnt(0)" ::: "memory");
            const unsigned og = xb_add(&bar[XB_TOP], 1u);
            const unsigned tg = og / nx;
            if (og + 1u == (tg + 1u) * nx) xb_add(&bar[XB_TOPGEN], 1u);
            else XB_SPIN(xb_ld(&bar[XB_TOPGEN]) == tg, bar);
            __builtin_amdgcn_fence(__ATOMIC_ACQUIRE, "agent");
            xb_add(&bar[XB_XGEN(b.x)], 1u);
            asm volatile("s_waitcnt vmcnt(0)" ::: "memory");
        } else {
            XB_SPIN(xb_ld(&bar[XB_XGEN(b.x)]) == gen, bar);
            __builtin_amdgcn_fence(__ATOMIC_ACQUIRE, "agent");
            asm volatile("s_waitcnt vmcnt(0)" ::: "memory");
        }
    }
    __syncthreads();
}


template <class SrcFn>
__device__ __forceinline__ void transpose_item(const SrcFn& src, int K, bf16_t* WT, LAS float* scr, int item, int lane, int nblk, bf16_t* WF = nullptr, int fo_row0 = 0) {
    const int kb = item / nblk, nb = item % nblk, k0 = 64 * kb, n0 = 32 * nb;
    const size_t stride = (size_t)src.stride(); const float* colp = src(n0 + (lane & 31));
    float tv[32];
#pragma unroll
    for (int i = 0; i < 32; ++i) { const int kk = 2 * i + (lane >> 5); tv[i] = colp ? colp[(size_t)(k0 + kk) * stride] : 0.f; }
#pragma unroll
    for (int i = 0; i < 32; ++i) { const int kk = 2 * i + (lane >> 5); scr[kk * 33 + (lane & 31)] = tv[i]; }
    asm volatile("s_waitcnt lgkmcnt(0)" ::: "memory");
    const int c = lane & 7;
#pragma unroll
    for (int j = 0; j < 4; ++j) { const int n = (lane >> 3) + 8 * j; const LAS float* s = scr + (8 * c) * 33 + n;
        if constexpr (SrcFn::F8) *(u32x2*)((unsigned char*)WT + (size_t)(n0 + n) * K + k0 + 8 * c) = (u32x2){pack4_fp8(s[0 * 33], s[1 * 33], s[2 * 33], s[3 * 33], F8_SW), pack4_fp8(s[4 * 33], s[5 * 33], s[6 * 33], s[7 * 33], F8_SW)};
        if constexpr (SrcFn::F8) { if (WF == nullptr) continue; }
        u32x4 o; o.x = cvt_pk_bf16(s[0 * 33], s[1 * 33]); o.y = cvt_pk_bf16(s[2 * 33], s[3 * 33]); o.z = cvt_pk_bf16(s[4 * 33], s[5 * 33]); o.w = cvt_pk_bf16(s[6 * 33], s[7 * 33]);
        if constexpr (!SrcFn::F8) *(u32x4*)(WT + (size_t)(n0 + n) * K + k0 + 8 * c) = o;
        if (WF != nullptr && n0 >= fo_row0) *(u32x4*)(WF + fo_index(n0 + n - fo_row0, k0 + 8 * c, K)) = o; }
    asm volatile("s_waitcnt lgkmcnt(0)" ::: "memory");
}
struct SrcPlain { static constexpr bool F8 = false; const float* W; int N; __device__ __forceinline__ int stride() const { return N; } __device__ __forceinline__ const float* operator()(int n) const { return W + n; } };
struct SrcPlain8 { static constexpr bool F8 = true; const float* W; int N; __device__ __forceinline__ int stride() const { return N; } __device__ __forceinline__ const float* operator()(int n) const { return W + n; } };
struct SrcUp { static constexpr bool F8 = true; const float* W1; const float* W3; __device__ __forceinline__ int stride() const { return DFF; } __device__ __forceinline__ const float* operator()(int n) const { const int T = n >> 8, i = n & 255; const uintptr_t a = (uintptr_t)W1, b = (uintptr_t)W3, msk = (uintptr_t)0 - (uintptr_t)(i >> 7);
        return (const float*)((a & ~msk) | (b & msk)) + 128 * T + (i & 127); } };
struct SrcWin { static constexpr bool F8 = false; const float* W; __device__ __forceinline__ int stride() const { return 13352; } __device__ __forceinline__ const float* operator()(int r) const { int o;
        if (r < 6144) o = r; else if (r < 8192) o = 6152 + (r - 6144); else if (r < 11264) o = 8200 + (r - 8192); else if (r < 13312) o = 11304 + (r - 11264);
        else if (r < 13320) o = 6144 + (r - 13312); else if (r < 13352) o = 11272 + (r - 13320); else return nullptr;
        return W + o; } };

template <int PPART>
__device__ __forceinline__ void phase_prep(Frame& F, const Params& p) {
    LAS float* scr = (LAS float*)(F.lds + F.wave * 16384);
    const int gw = (PPART == 0 ? F.bx : F.bx - 192) * 8 + F.wave, NGW = (PPART == 0 ? F.G : 64) * 8;
    bf16_t* wup1 = (bf16_t*)(F.ws + WS_WUP1); bf16_t* wdn1 = (bf16_t*)(F.ws + WS_WDN1); bf16_t* wup2 = (bf16_t*)(F.ws + WS_WUP2); bf16_t* wdn2 = (bf16_t*)(F.ws + WS_WDN2);
    bf16_t* win = (bf16_t*)(F.ws + WS_WIN); bf16_t* wpa = (bf16_t*)(F.ws + WS_WPA); bf16_t* wpb = (bf16_t*)(F.ws + WS_WPB); bf16_t* wout = (bf16_t*)(F.ws + WS_WOUT);
    constexpr int I_UP = (DM / 64) * (2 * DFF / 32), I_DN = (DFF / 64) * (DM / 32), I_IN = (DM / 64) * (ZP / 32), I_P = (2048 / 64) * (DM / 32), I_O = (DM / 64) * (DM / 32);
    constexpr int NITEMS = 2 * I_UP + 2 * I_DN + I_IN + 2 * I_P + I_O;
    for (int it = (PPART == 0 ? 0 : I_UP) + gw; it < (PPART == 0 ? I_UP : NITEMS); it += NGW) {
        int r = it;
        if (r < I_UP) { transpose_item(SrcUp{PIN(13), PIN(14)}, DM, wup1, scr, r, F.lane, 2 * DFF / 32); continue; } r -= I_UP;
        if (r < I_UP) { transpose_item(SrcUp{PIN(32), PIN(33)}, DM, wup2, scr, r, F.lane, 2 * DFF / 32); continue; } r -= I_UP;
        if (r < I_DN) { transpose_item(SrcPlain8{PIN(15), DM}, DFF, wdn1, scr, r, F.lane, DM / 32, (bf16_t*)(F.ws + WS_FDN1)); continue; } r -= I_DN;
        if (r < I_DN) { transpose_item(SrcPlain8{PIN(34), DM}, DFF, wdn2, scr, r, F.lane, DM / 32, (bf16_t*)(F.ws + WS_FDN2)); continue; } r -= I_DN;
        if (r < I_IN) { transpose_item(SrcWin{PIN(17)}, DM, win, scr, r, F.lane, ZP / 32, (bf16_t*)(F.ws + WS_FG), ZG); continue; } r -= I_IN;
        if (r < I_P) { transpose_item(SrcPlain8{PIN(22), DM}, 2048, wpa, scr, r, F.lane, DM / 32, (bf16_t*)(F.ws + WS_FPA)); continue; } r -= I_P;
        if (r < I_P) { transpose_item(SrcPlain8{PIN(29), DM}, 2048, wpb, scr, r, F.lane, DM / 32, (bf16_t*)(F.ws + WS_FPB)); continue; } r -= I_P;
        transpose_item(SrcPlain8{PIN(30), DM}, DM, wout, scr, r, F.lane, DM / 32, (bf16_t*)(F.ws + WS_FOUT));
    }
    __syncthreads();
}
__device__ __forceinline__ void phase_silu_c(Frame& F, const Params& p) {
    const int ch = F.bx * NTHREADS + F.tid;
    if (ch < 144 * 128) { const int r = ch >> 7, k = 8 * (ch & 127); float x[8];
        if (r < NBID) { const float* cr = (r < NBP ? PIN(2) + (size_t)r * DM : PIN(3) + (size_t)(r - NBP) * DM) + k; const f32x4 c0 = *(const f32x4*)cr, c1 = *(const f32x4*)(cr + 4);
#pragma unroll
            for (int e = 0; e < 4; ++e) { x[e] = siluf_(c0[e]); x[4 + e] = siluf_(c1[e]); } }
        else {
#pragma unroll
            for (int e = 0; e < 8; ++e) x[e] = 0.f; }
        *(u32x4*)((bf16_t*)(F.ws + WS_SC) + fo_index(r, k, DM)) = pack8(x, 1.0f); }
}
__device__ __forceinline__ void phase_adaln(Frame& F, const Params& p) {
    const float* ada_w = PIN(10); const float* ada_b = PIN(11); float* mod = (float*)(F.ws + WS_MOD); const bf16_t* SCF = (const bf16_t*)(F.ws + WS_SC);
    LAS f32x4* PART = (LAS f32x4*)F.lds;
    const int lane = F.lane, w = F.wave, fr = lane & 15, fq = lane >> 4;
    const int t0 = F.bx < 64 ? 3 * F.bx : 192 + 2 * (F.bx - 64), nT = F.bx < 64 ? 3 : 2;
    f32x4 acc[3][9];
#pragma unroll
    for (int t = 0; t < 3; ++t)
#pragma unroll
        for (int rt = 0; rt < 9; ++rt) acc[t][rt] = (f32x4){0.f, 0.f, 0.f, 0.f};
#pragma unroll 1
    for (int ks = 0; ks < 4; ++ks) {
        const int k0 = 128 * w + 32 * ks + 8 * fq, kb = 4 * w + ks;
        bf16x8 af[9];
#pragma unroll
        for (int rt = 0; rt < 9; ++rt) af[rt] = *(const bf16x8*)(SCF + ((size_t)(rt * (DM / 32) + kb)) * 512 + 8 * lane);
#pragma unroll
        for (int t = 0; t < 3; ++t) if (t < nT) {
            float wv[8];
#pragma unroll
            for (int j = 0; j < 8; ++j) wv[j] = ada_w[(size_t)(k0 + j) * NMOD + 16 * (t0 + t) + fr];
            bf16x8 bfr; { const u32x4 tt = pack8(wv, 1.0f); bfr = __builtin_bit_cast(bf16x8, tt); }
#pragma unroll
            for (int rt = 0; rt < 9; ++rt) acc[t][rt] = __builtin_amdgcn_mfma_f32_16x16x32_bf16(af[rt], bfr, acc[t][rt], 0, 0, 0); }
    }
#pragma unroll
    for (int t = 0; t < 3; ++t) if (t < nT) {
        __syncthreads();
#pragma unroll
        for (int rt = 0; rt < 9; ++rt) PART[(w * 9 + rt) * 64 + lane] = acc[t][rt];
        __syncthreads();
        for (int idx = F.tid; idx < 9 * 64; idx += NTHREADS) { const int rt = idx >> 6, ln = idx & 63; f32x4 sum = PART[rt * 64 + ln];
#pragma unroll
            for (int ww = 1; ww < 8; ++ww) sum += PART[(ww * 9 + rt) * 64 + ln];
            const int n = 16 * (t0 + t) + (ln & 15); const float bv = ada_b[n];
#pragma unroll
            for (int r = 0; r < 4; ++r) { const int row = 16 * rt + 4 * (ln >> 4) + r; if (row < NBID) mod[(size_t)row * NMOD + n] = sum[r] + bv; } } }
}

__device__ __forceinline__ void phase_norm_mod(Frame& F, const float* xp, const float* xs, const float* gw, int shoff, int scoff, bf16_t* U) {
    const float* mod = (const float*)(F.ws + WS_MOD);
    const int gwv = F.bx * 8 + F.wave, NGW = F.G * 8;
    f32x4 g[4];
#pragma unroll
    for (int j = 0; j < 4; ++j) g[j] = *(const f32x4*)(gw + 4 * F.lane + 256 * j);
    for (int m = gwv; m < MT; m += NGW) {
        const float* xr = m < MP ? xp + (size_t)m * DM : xs + (size_t)(m - MP) * DM;
        const float* mr = mod + (size_t)pg8::bid_of_row(m) * NMOD;
        f32x4 v[4]; float s = 0.f;
#pragma unroll
        for (int j = 0; j < 4; ++j) { v[j] = *(const f32x4*)(xr + 4 * F.lane + 256 * j); s += (v[j][0] * v[j][0] + v[j][1] * v[j][1]) + (v[j][2] * v[j][2] + v[j][3] * v[j][3]); }
        const float r = 1.0f / sqrtf(wave_sum(s) * (1.0f / DM) + EPS);
#pragma unroll
        for (int j = 0; j < 4; ++j) { const f32x4 sh = *(const f32x4*)(mr + shoff + 4 * F.lane + 256 * j), scv = *(const f32x4*)(mr + scoff + 4 * F.lane + 256 * j);
            const f32x4 o = (v[j] * r * g[j]) * (1.0f + scv) + sh;
            *(unsigned*)((unsigned char*)U + (size_t)m * DM + 4 * F.lane + 256 * j) = pack4_fp8(o[0], o[1], o[2], o[3], F8_SA); }
    }
}
__device__ __forceinline__ void phase_final_norm(Frame& F, float* Y, const float* gw) {
    const int gwv = F.bx * 8 + F.wave, NGW = F.G * 8;
    f32x4 g[4];
#pragma unroll
    for (int j = 0; j < 4; ++j) g[j] = *(const f32x4*)(gw + 4 * F.lane + 256 * j);
    for (int m = gwv; m < MT; m += NGW) {
        float* xr = Y + (size_t)m * DM;
        f32x4 v[4]; float s = 0.f;
#pragma unroll
        for (int j = 0; j < 4; ++j) { v[j] = *(const f32x4*)(xr + 4 * F.lane + 256 * j); s += (v[j][0] * v[j][0] + v[j][1] * v[j][1]) + (v[j][2] * v[j][2] + v[j][3] * v[j][3]); }
        const float r = 1.0f / sqrtf(wave_sum(s) * (1.0f / DM) + EPS);
#pragma unroll
        for (int j = 0; j < 4; ++j) *(f32x4*)(xr + 4 * F.lane + 256 * j) = v[j] * r * g[j];
    }
}

constexpr size_t O_Y = 0, O_PC = 17825792, O_PN = 22020096, O_PM = 22028288, O_PMC = 22028320, O_PSSM = 22077472, O_PSC = 24174624,
                 O_SC = 24248352, O_SN = 91357216, O_SM = 91488288, O_SMC = 91488800, O_SSSM = 92275232, O_SSC = 125829664, O_END = 127009312;
constexpr int CVP = 5120;

__device__ __forceinline__ bf16x8 frag_row(LAS unsigned char* base, int stride, int row0, int k0, int lane) {
    return *(const LAS bf16x8*)(base + (row0 + (lane & 15)) * stride + (k0 + 8 * (lane >> 4)) * 2);
}
__device__ __forceinline__ bf16x8 frag_tr(LAS unsigned char* base, int stride, int krow0, int col0, int lane) {
    const int g = lane >> 4, q = (lane & 15) >> 2, pp = lane & 3;
    LAS unsigned char* a = base + (krow0 + 8 * g + q) * stride + (col0 + 4 * pp) * 2;
    const s16x4 lo = __builtin_amdgcn_ds_read_tr16_b64_v4i16((LAS s16x4*)a);
    const s16x4 hi = __builtin_amdgcn_ds_read_tr16_b64_v4i16((LAS s16x4*)(a + 4 * stride));
    return (bf16x8){lo.x, lo.y, lo.z, lo.w, hi.x, hi.y, hi.z, hi.w};
}
#define MFMA16(a, b, c) __builtin_amdgcn_mfma_f32_16x16x32_bf16((a), (b), (c), 0, 0, 0)

__device__ __forceinline__ float fast_log1pexp_neg(float ax) { return __builtin_amdgcn_logf(1.0f + fast_exp(-ax)) * 0.6931471805599453f; }
__device__ __forceinline__ float logsigmoidf_(float x) { return fminf(x, 0.f) - log1pf(expf(-fabsf(x))); }
__device__ __forceinline__ float softplusf_(float x) { return fmaxf(x, 0.f) + log1pf(expf(-fabsf(x))); }

__device__ __forceinline__ void conv_item(Frame& F, const Params& p, const int it) {
    const bf16_t* Z = (const bf16_t*)(F.ws + WS_ZIN); bf16_t* CV = (bf16_t*)(F.ws + WS_CV);
    const int lane = F.lane;
    {
        int m0, tb, nrows, strip; const float* hist = nullptr;
        if (it < 5120) { const int b = it / 640, r = it % 640; strip = r % 10; tb = (r / 10) * 32; m0 = b * SEQ; nrows = 32; }
        else { const int j = it - 5120, bs = j / 10; strip = j % 10; tb = 0; m0 = MP + bs * TS; nrows = 8; hist = strip < 4 ? PIN(7) + (size_t)bs * 3 * 2048 : PIN(9) + (size_t)bs * 3 * 3072; }
        const bool isM = strip < 4;
        const int c = strip * 512 + 8 * lane, zc = isM ? c : ZX + (c - 2048), cc = isM ? c : c - 2048, cs = isM ? 2048 : 3072;
        const float* cw = isM ? PIN(18) : PIN(23); const float* cb = isM ? PIN(19) : PIN(24);
        const float scl = (strip == 2 || strip == 3) ? 0.0625f : 1.0f;
        float w[4][8], bb[8], x0[8], x1[8], x2[8];
#pragma unroll
        for (int j = 0; j < 4; ++j) { const f32x4 a = *(const f32x4*)(cw + (size_t)j * cs + cc), b = *(const f32x4*)(cw + (size_t)j * cs + cc + 4);
#pragma unroll
            for (int e = 0; e < 4; ++e) { w[j][e] = a[e]; w[j][4 + e] = b[e]; } }
        { const f32x4 a = *(const f32x4*)(cb + cc), b = *(const f32x4*)(cb + cc + 4);
#pragma unroll
            for (int e = 0; e < 4; ++e) { bb[e] = a[e]; bb[4 + e] = b[e]; } }
        if (tb > 0) { unpack8(*(const u32x4*)(Z + (size_t)(m0 + tb - 3) * ZP + zc), x0); unpack8(*(const u32x4*)(Z + (size_t)(m0 + tb - 2) * ZP + zc), x1); unpack8(*(const u32x4*)(Z + (size_t)(m0 + tb - 1) * ZP + zc), x2); }
        else if (hist != nullptr) {
#pragma unroll
            for (int e = 0; e < 8; ++e) { x0[e] = hist[cc + e]; x1[e] = hist[cs + cc + e]; x2[e] = hist[2 * cs + cc + e]; } }
        else {
#pragma unroll
            for (int e = 0; e < 8; ++e) { x0[e] = 0.f; x1[e] = 0.f; x2[e] = 0.f; } }
        for (int t = 0; t < nrows; t += 8) {
            u32x4 raw[8];
#pragma unroll
            for (int i = 0; i < 8; ++i) raw[i] = *(const u32x4*)(Z + (size_t)(m0 + tb + t + i) * ZP + zc);
#pragma unroll
            for (int i = 0; i < 8; ++i) { float x3[8], o[8]; unpack8(raw[i], x3);
#pragma unroll
                for (int e = 0; e < 8; ++e) { o[e] = siluf_(bb[e] + w[0][e] * x0[e] + w[1][e] * x1[e] + w[2][e] * x2[e] + w[3][e] * x3[e]); x0[e] = x1[e]; x1[e] = x2[e]; x2[e] = x3[e]; }
                *(u32x4*)(CV + (size_t)(m0 + tb + t + i) * CVP + c) = pack8(o, scl); }
        }
    }
}
constexpr int NS_EARLY = 64;
__device__ __forceinline__ void phase_conv(Frame& F, const Params& p) {
    const int gw = F.bx * 8 + F.wave, NGW = F.G * 8;
    for (int it = gw; it < 5120 + 1280 - 10 * NS_EARLY; it += NGW) conv_item(F, p, it < 5120 ? it : it + 10 * NS_EARLY);
}

constexpr int QSTR = 528, VSTR = 144;
constexpr int L_QS = 0, L_KS = 33792, L_CT = 67584, L_VS = 101376, L_VW = 110592, L_SB = 119808, L_SCAL = 129024, L_NST = 132096, L_QNP = 133120, L_DENP = 135168, L_NUMB = 135680;

__device__ __forceinline__ float mlstm_scan(float ipre, float fpre, int lane, float mstate, LAS float* sc) {
    const float lf = fminf(fpre, 0.f) - fast_log1pexp_neg(fabsf(fpre));
    const float b = wave_scan_add(lf);
    const float a = ipre - b;
    const float cm = wave_scan_max(a);
    const float A = fmaxf(mstate, cm);
    const float Alast = __shfl(A, 63), blast = __shfl(b, 63);
    sc[lane] = a; sc[64 + lane] = A; sc[128 + lane] = fast_exp(mstate - A); sc[192 + lane] = fast_exp(-(b + A)); sc[256 + lane] = fast_exp(a - Alast);
    if (lane == 0) sc[320] = fast_exp(mstate - Alast);
    return blast + Alast;
}

__device__ __forceinline__ void mlstm_prompt_item(Frame& F, const Params& p, const int b, const int h, const int vs) {
    LAS unsigned char* L = F.lds;
    const int tid = F.tid, lane = F.lane, w = F.wave, fr = lane & 15, fq = lane >> 4;
    const bf16_t* Z = (const bf16_t*)(F.ws + WS_ZIN); const bf16_t* CV = (const bf16_t*)(F.ws + WS_CV); const float* GT = (const float*)(F.ws + WS_GATES);
    bf16_t* NUM = (bf16_t*)(F.ws + WS_NUM); float* DEN = (float*)(F.ws + WS_DEN);
    const float ifbi = PIN(20)[h], ifbf = PIN(20)[4 + h];
    constexpr int nch = SEQ / 64; const int m0 = b * SEQ;
    LAS float* SC = (LAS float*)(L + L_SCAL); LAS unsigned char* NSTB = L + L_NST; LAS float* DENP = (LAS float*)(L + L_DENP);
    f32x4 cacc[2][4];
#pragma unroll
    for (int dt = 0; dt < 2; ++dt)
#pragma unroll
        for (int vi = 0; vi < 4; ++vi) cacc[dt][vi] = (f32x4){0.f, 0.f, 0.f, 0.f};
    f32x4 nacc[2] = {{0.f, 0.f, 0.f, 0.f}, {0.f, 0.f, 0.f, 0.f}};
    float mstate = 0.f;
    u32x4 pq[4], pk[4], pv; float gi = 0.f, gf = 0.f;
    const bf16_t* qsrc = CV + (size_t)(m0 + (tid >> 5)) * CVP + h * 256 + 8 * (tid & 31);
    const bf16_t* vsrc = Z + (size_t)(m0 + (tid >> 3)) * ZP + ZV + h * 512 + vs * 64 + 8 * (tid & 7);
    const float* gsrc = GT + (size_t)(m0 + lane) * 64 + h;
#define ML_LOAD(c) do { _Pragma("unroll") for (int i = 0; i < 4; ++i) { pq[i] = *(const u32x4*)(qsrc + (size_t)((c) * 64 + 16 * i) * CVP); pk[i] = *(const u32x4*)(qsrc + (size_t)((c) * 64 + 16 * i) * CVP + 1024); } \
        pv = *(const u32x4*)(vsrc + (size_t)((c) * 64) * ZP); if (w == 0) { gi = gsrc[(size_t)((c) * 64) * 64]; gf = gsrc[(size_t)((c) * 64) * 64 + 4]; } } while (0)
    u32x4 numst = {0u, 0u, 0u, 0u}; float denst = 0.f;
    bf16_t* numdst = NUM + (size_t)(m0 + (tid >> 3)) * 2048 + h * 512 + vs * 64 + 8 * (tid & 7);
#define ML_STORE(c) do { *(u32x4*)(numdst + (size_t)((c) * 64) * 2048) = numst; \
        if (vs == 0 && w < 4 && fq == 0) DEN[(size_t)(m0 + (c) * 64 + 16 * w + fr) * 4 + h] = denst; } while (0)
    ML_LOAD(0);
    __syncthreads();
#pragma unroll
    for (int dt = 0; dt < 2; ++dt)
#pragma unroll
        for (int vi = 0; vi < 4; ++vi) *(LAS u32x2*)(L + L_CT + (16 * vi + fr) * QSTR + (32 * w + 16 * dt + 4 * fq) * 2) = (u32x2){0u, 0u};
    if (tid < 128) *(LAS unsigned*)(NSTB + 4 * tid) = 0u;
    if (w == 0) mstate = mlstm_scan(gi + ifbi, gf + ifbf, lane, mstate, SC);
    __syncthreads();
    for (int c = 0; c < nch; ++c) {
        const int t0 = 64 * c; LAS float* sc = SC + (c & 1) * 384;
#pragma unroll
        for (int i = 0; i < 4; ++i) { const int v = tid + NTHREADS * i, row = v >> 5, c16 = v & 31; *(LAS u32x4*)(L + L_QS + row * QSTR + 16 * c16) = pq[i]; *(LAS u32x4*)(L + L_KS + row * QSTR + 16 * c16) = pk[i]; }
        { const int row = tid >> 3, c8 = tid & 7; *(LAS u32x4*)(L + L_VS + row * VSTR + 16 * c8) = pv; float x[8]; unpack8(pv, x); *(LAS u32x4*)(L + L_VW + row * VSTR + 16 * c8) = pack8(x, sc[256 + row]); }
        __syncthreads();
        if (c > 0) { ML_STORE(c - 1); }
        if (c + 1 < nch) ML_LOAD(c + 1);
        const int ti = w & 3, hf = w >> 2;
        bf16x8 qf[8];
#pragma unroll
        for (int k = 0; k < 8; ++k) qf[k] = frag_row(L + L_QS, QSTR, 16 * ti, 32 * k, lane);
        { f32x4 sacc[2] = {{0.f, 0.f, 0.f, 0.f}, {0.f, 0.f, 0.f, 0.f}};
#pragma unroll
          for (int j = 0; j < 2; ++j) { const int si = 2 * hf + j; if (si <= ti) {
#pragma unroll
                  for (int k = 0; k < 8; ++k) sacc[j] = MFMA16(frag_row(L + L_KS, QSTR, 16 * si, 32 * k, lane), qf[k], sacc[j]); } }
          const int t = 16 * ti + fr; const float At = sc[64 + t]; float dpart = 0.f;
#pragma unroll
          for (int j = 0; j < 2; ++j) { const int si = 2 * hf + j, s0 = 16 * si + 4 * fq; const f32x4 av = *(const LAS f32x4*)(sc + s0); f32x4 vv;
#pragma unroll
              for (int r = 0; r < 4; ++r) { const float wgt = (s0 + r <= t) ? fast_exp(av[r] - At) : 0.f; vv[r] = (si <= ti) ? sacc[j][r] * wgt : 0.f; dpart += vv[r]; }
              *(LAS u32x2*)(L + L_SB + t * VSTR + s0 * 2) = pack4(vv); }
          dpart += __shfl_xor(dpart, 16); dpart += __shfl_xor(dpart, 32);
          if (lane < 16) DENP[hf * 64 + 16 * ti + lane] = dpart; }
        __syncthreads();
        { f32x4 uacc[2] = {{0.f, 0.f, 0.f, 0.f}, {0.f, 0.f, 0.f, 0.f}};
#pragma unroll
          for (int j = 0; j < 2; ++j) { const int vi = 2 * hf + j;
#pragma unroll
              for (int k = 0; k < 8; ++k) uacc[j] = MFMA16(frag_row(L + L_CT, QSTR, 16 * vi, 32 * k, lane), qf[k], uacc[j]); }
          const float wst = sc[128 + 16 * ti + fr]; uacc[0] *= wst; uacc[1] *= wst;
#pragma unroll
          for (int ks = 0; ks < 2; ++ks) if (32 * ks <= 16 * ti + 15) { const bf16x8 sb = frag_row(L + L_SB, VSTR, 16 * ti, 32 * ks, lane);
#pragma unroll
              for (int j = 0; j < 2; ++j) uacc[j] = MFMA16(frag_tr(L + L_VS, VSTR, 32 * ks, 16 * (2 * hf + j), lane), sb, uacc[j]); }
#pragma unroll
          for (int j = 0; j < 2; ++j) *(LAS u32x2*)(L + L_NUMB + (16 * ti + fr) * VSTR + (16 * (2 * hf + j) + 4 * fq) * 2) = pack4(uacc[j]); }
        if (vs == 0 && hf == 0) {
            f32x4 qn = {0.f, 0.f, 0.f, 0.f};
#pragma unroll
            for (int k = 0; k < 8; ++k) { u32x4 nv = *(const LAS u32x4*)(NSTB + 64 * k + 16 * fq); if (fr != 0) nv = (u32x4){0u, 0u, 0u, 0u};
                qn = MFMA16(__builtin_bit_cast(bf16x8, nv), qf[k], qn); }
            const int t = 16 * ti + fr; const float den = DENP[t] + DENP[64 + t] + sc[128 + t] * qn[0];
            denst = fmaxf(fabsf(den), sc[192 + t]); }
        { const float decay = sc[320];
#pragma unroll
          for (int dt = 0; dt < 2; ++dt)
#pragma unroll
              for (int vi = 0; vi < 4; ++vi) cacc[dt][vi] *= decay;
#pragma unroll
          for (int ks = 0; ks < 2; ++ks) { bf16x8 ka[2];
#pragma unroll
              for (int dt = 0; dt < 2; ++dt) ka[dt] = frag_tr(L + L_KS, QSTR, 32 * ks, 32 * w + 16 * dt, lane);
#pragma unroll
              for (int vi = 0; vi < 4; ++vi) { const bf16x8 vb = frag_tr(L + L_VW, VSTR, 32 * ks, 16 * vi, lane);
#pragma unroll
                  for (int dt = 0; dt < 2; ++dt) cacc[dt][vi] = MFMA16(ka[dt], vb, cacc[dt][vi]); } }
          if (vs == 0) { nacc[0] *= decay; nacc[1] *= decay;
#pragma unroll
              for (int ks = 0; ks < 2; ++ks) { const f32x4 w0 = *(const LAS f32x4*)(sc + 256 + 32 * ks + 8 * fq), w1 = *(const LAS f32x4*)(sc + 256 + 32 * ks + 8 * fq + 4);
                  u32x4 wv; wv.x = cvt_pk_bf16(w0[0], w0[1]); wv.y = cvt_pk_bf16(w0[2], w0[3]); wv.z = cvt_pk_bf16(w1[0], w1[1]); wv.w = cvt_pk_bf16(w1[2], w1[3]);
                  if (fr != 0) wv = (u32x4){0u, 0u, 0u, 0u};
#pragma unroll
                  for (int dt = 0; dt < 2; ++dt) nacc[dt] = MFMA16(frag_tr(L + L_KS, QSTR, 32 * ks, 32 * w + 16 * dt, lane), __builtin_bit_cast(bf16x8, wv), nacc[dt]); } } }
        if (w == 0 && c + 1 < nch) mstate = mlstm_scan(gi + ifbi, gf + ifbf, lane, mstate, SC + ((c + 1) & 1) * 384);
        __syncthreads();
        numst = *(const LAS u32x4*)(L + L_NUMB + (tid >> 3) * VSTR + 16 * (tid & 7));
#pragma unroll
        for (int dt = 0; dt < 2; ++dt)
#pragma unroll
            for (int vi = 0; vi < 4; ++vi) *(LAS u32x2*)(L + L_CT + (16 * vi + fr) * QSTR + (32 * w + 16 * dt + 4 * fq) * 2) = pack4(cacc[dt][vi]);
        if (vs == 0 && fr == 0) {
#pragma unroll
            for (int dt = 0; dt < 2; ++dt) *(LAS u32x2*)(NSTB + (32 * w + 16 * dt + 4 * fq) * 2) = pack4(nacc[dt]); }
    }
    ML_STORE(nch - 1);
#undef ML_LOAD
#undef ML_STORE
    float* Cout = F.out + O_PC + (size_t)(b * 4 + h) * 131072;
#pragma unroll
    for (int dt = 0; dt < 2; ++dt)
#pragma unroll
        for (int vi = 0; vi < 4; ++vi)
#pragma unroll
            for (int r = 0; r < 4; ++r) { const int d = 32 * w + 16 * dt + 4 * fq + r, v = 16 * vi + fr; Cout[(size_t)d * 512 + vs * 64 + v] = cacc[dt][vi][r]; }
    if (vs == 0) { if (fr == 0) {
#pragma unroll
            for (int dt = 0; dt < 2; ++dt)
#pragma unroll
                for (int r = 0; r < 4; ++r) F.out[O_PN + (size_t)(b * 4 + h) * 256 + 32 * w + 16 * dt + 4 * fq + r] = nacc[dt][r]; }
        if (tid == 0) F.out[O_PM + b * 4 + h] = mstate; }
}

constexpr int XSTR = 144, BSTR = 272;
constexpr int S_XS = 0, S_XD = 9216, S_XW = 18432, S_BS = 27648, S_CS = 45056, S_HS = 62464, S_GB = 79872, S_SCAL = 89088, S_YB = 98304;

__device__ __forceinline__ void ssd_scan(float dtp, float Ae, int lane, LAS float* sc) {
    const float dt = fmaxf(dtp, 0.f) + fast_log1pexp_neg(fabsf(dtp));
    const float cum = wave_scan_add(dt * Ae);
    const float cl = __shfl(cum, 63);
    sc[lane] = cum; sc[64 + lane] = dt; sc[128 + lane] = fast_exp(cl - cum); sc[192 + lane] = fast_exp(cum);
    if (lane == 0) sc[256] = fast_exp(cl);
}

__device__ __forceinline__ void ssd_prompt_item(Frame& F, const Params& p, const int b, const int e) {
    LAS unsigned char* L = F.lds;
    const int tid = F.tid, lane = F.lane, w = F.wave, fr = lane & 15, fq = lane >> 4;
    const bf16_t* CV = (const bf16_t*)(F.ws + WS_CV); const float* GT = (const float*)(F.ws + WS_GATES);
    bf16_t* YS = (bf16_t*)(F.ws + WS_YS);
    const int g = e >> 3, m0 = b * SEQ; constexpr int nch = SEQ / 64;
    const float dtb = PIN(25)[e], Ae = -expf(PIN(26)[e]), De = PIN(27)[e];
    LAS float* SC = (LAS float*)(L + S_SCAL);
    f32x4 hacc[4];
#pragma unroll
    for (int pi = 0; pi < 4; ++pi) hacc[pi] = (f32x4){0.f, 0.f, 0.f, 0.f};
    u32x4 px, pb[2], pc[2]; float gd = 0.f;
    const bf16_t* xsrc = CV + (size_t)(m0 + (tid >> 3)) * CVP + 2048 + e * 64 + 8 * (tid & 7);
    const bf16_t* bsrc = CV + (size_t)(m0 + (tid >> 4)) * CVP + 4096 + g * 128 + 8 * (tid & 15);
    const float* gsrc = GT + (size_t)(m0 + lane) * 64 + 8 + e;
#define SD_LOAD(c) do { px = *(const u32x4*)(xsrc + (size_t)((c) * 64) * CVP); _Pragma("unroll") for (int i = 0; i < 2; ++i) { pb[i] = *(const u32x4*)(bsrc + (size_t)((c) * 64 + 32 * i) * CVP); pc[i] = *(const u32x4*)(bsrc + (size_t)((c) * 64 + 32 * i) * CVP + 512); } \
        if (w == 0) gd = gsrc[(size_t)((c) * 64) * 64]; } while (0)
    u32x4 yst = {0u, 0u, 0u, 0u};
    bf16_t* ydst = YS + (size_t)(m0 + (tid >> 3)) * 2048 + e * 64 + 8 * (tid & 7);
#define SD_STORE(c) do { *(u32x4*)(ydst + (size_t)((c) * 64) * 2048) = yst; } while (0)
    SD_LOAD(0);
    __syncthreads();
#pragma unroll
    for (int pi = 0; pi < 4; ++pi) *(LAS u32x2*)(L + S_HS + (16 * pi + fr) * BSTR + (16 * w + 4 * fq) * 2) = (u32x2){0u, 0u};
    if (w == 0) ssd_scan(gd + dtb, Ae, lane, SC);
    __syncthreads();
    for (int c = 0; c < nch; ++c) {
        const int t0 = 64 * c; LAS float* sc = SC + (c & 1) * 320;
        { const int row = tid >> 3, c8 = tid & 7; const float dt = sc[64 + row], ed = sc[128 + row]; float x[8]; unpack8(px, x);
          *(LAS u32x4*)(L + S_XS + row * XSTR + 16 * c8) = px; *(LAS u32x4*)(L + S_XD + row * XSTR + 16 * c8) = pack8(x, dt); *(LAS u32x4*)(L + S_XW + row * XSTR + 16 * c8) = pack8(x, dt * ed); }
#pragma unroll
        for (int i = 0; i < 2; ++i) { const int row = (tid >> 4) + 32 * i, c16 = tid & 15; *(LAS u32x4*)(L + S_BS + row * BSTR + 16 * c16) = pb[i]; *(LAS u32x4*)(L + S_CS + row * BSTR + 16 * c16) = pc[i]; }
        __syncthreads();
        if (c > 0) { SD_STORE(c - 1); }
        if (c + 1 < nch) SD_LOAD(c + 1);
        const int ti = w & 3, hf = w >> 2;
        bf16x8 cf[4];
#pragma unroll
        for (int k = 0; k < 4; ++k) cf[k] = frag_row(L + S_CS, BSTR, 16 * ti, 32 * k, lane);
        { f32x4 gacc[2] = {{0.f, 0.f, 0.f, 0.f}, {0.f, 0.f, 0.f, 0.f}};
#pragma unroll
          for (int j = 0; j < 2; ++j) { const int si = 2 * hf + j; if (si <= ti) {
#pragma unroll
                  for (int k = 0; k < 4; ++k) gacc[j] = MFMA16(frag_row(L + S_BS, BSTR, 16 * si, 32 * k, lane), cf[k], gacc[j]); } }
          const int t = 16 * ti + fr; const float cumt = sc[t];
#pragma unroll
          for (int j = 0; j < 2; ++j) { const int si = 2 * hf + j, s0 = 16 * si + 4 * fq; const f32x4 cs = *(const LAS f32x4*)(sc + s0); f32x4 vv;
#pragma unroll
              for (int r = 0; r < 4; ++r) vv[r] = (si <= ti && s0 + r <= t) ? gacc[j][r] * fast_exp(cumt - cs[r]) : 0.f;
              *(LAS u32x2*)(L + S_GB + t * XSTR + s0 * 2) = pack4(vv); } }
        __syncthreads();
        { f32x4 yacc[2] = {{0.f, 0.f, 0.f, 0.f}, {0.f, 0.f, 0.f, 0.f}};
#pragma unroll
          for (int j = 0; j < 2; ++j) { const int pi = 2 * hf + j;
#pragma unroll
              for (int k = 0; k < 4; ++k) yacc[j] = MFMA16(frag_row(L + S_HS, BSTR, 16 * pi, 32 * k, lane), cf[k], yacc[j]); }
          const int t = 16 * ti + fr; const float ec = sc[192 + t]; yacc[0] *= ec; yacc[1] *= ec;
#pragma unroll
          for (int ks = 0; ks < 2; ++ks) if (32 * ks <= 16 * ti + 15) { const bf16x8 gb = frag_row(L + S_GB, XSTR, 16 * ti, 32 * ks, lane);
#pragma unroll
              for (int j = 0; j < 2; ++j) yacc[j] = MFMA16(frag_tr(L + S_XD, XSTR, 32 * ks, 16 * (2 * hf + j), lane), gb, yacc[j]); }
#pragma unroll
          for (int j = 0; j < 2; ++j) { const int p0 = 16 * (2 * hf + j) + 4 * fq; const u32x2 xv = *(const LAS u32x2*)(L + S_XS + t * XSTR + p0 * 2);
              f32x4 y = yacc[j]; y[0] += De * bflo(xv.x); y[1] += De * bfhi(xv.x); y[2] += De * bflo(xv.y); y[3] += De * bfhi(xv.y);
              *(LAS u32x2*)(L + S_YB + t * XSTR + p0 * 2) = pack4(y); } }
        { const float eall = sc[256];
#pragma unroll
          for (int pi = 0; pi < 4; ++pi) hacc[pi] *= eall;
#pragma unroll
          for (int ks = 0; ks < 2; ++ks) { const bf16x8 ba = frag_tr(L + S_BS, BSTR, 32 * ks, 16 * w, lane);
#pragma unroll
              for (int pi = 0; pi < 4; ++pi) hacc[pi] = MFMA16(ba, frag_tr(L + S_XW, XSTR, 32 * ks, 16 * pi, lane), hacc[pi]); } }
        if (w == 0 && c + 1 < nch) ssd_scan(gd + dtb, Ae, lane, SC + ((c + 1) & 1) * 320);
        __syncthreads();
        yst = *(const LAS u32x4*)(L + S_YB + (tid >> 3) * XSTR + 16 * (tid & 7));
#pragma unroll
        for (int pi = 0; pi < 4; ++pi) *(LAS u32x2*)(L + S_HS + (16 * pi + fr) * BSTR + (16 * w + 4 * fq) * 2) = pack4(hacc[pi]);
    }
    SD_STORE(nch - 1);
#undef SD_LOAD
#undef SD_STORE
    float* hout = F.out + O_PSSM + (size_t)(b * 32 + e) * 8192;
#pragma unroll
    for (int pi = 0; pi < 4; ++pi) *(f32x4*)(hout + (size_t)(16 * pi + fr) * 128 + 16 * w + 4 * fq) = hacc[pi];
}

__device__ __forceinline__ void mlstm_sample_item(Frame& F, const Params& p, const int bs, const int h) {
    LAS unsigned char* L = F.lds; const int tid = F.tid, lane = F.lane, w = F.wave;
    const bf16_t* Z = (const bf16_t*)(F.ws + WS_ZIN); const bf16_t* CV = (const bf16_t*)(F.ws + WS_CV); const float* GT = (const float*)(F.ws + WS_GATES);
    bf16_t* NUM = (bf16_t*)(F.ws + WS_NUM); float* DEN = (float*)(F.ws + WS_DEN);
    const int m0 = MP + bs * TS;
    const float* C0 = PIN(4) + (size_t)(bs * 4 + h) * 131072; float* C1 = F.out + O_SC + (size_t)(bs * 4 + h) * 131072;
    LAS float* QKW = (LAS float*)L; LAS float* RED = (LAS float*)(L + 16384); LAS float* NS = (LAS float*)(L + 81920);
    LAS float* SCs = (LAS float*)(L + 82944); LAS float* SW = (LAS float*)(L + 83200); LAS float* QN = (LAS float*)(L + 83456);
    const int v4 = tid & 127, dp = tid >> 7;
    f32x4 vreg[8];
#pragma unroll
    for (int s = 0; s < 8; ++s) { const u32x2 vv = *(const u32x2*)(Z + (size_t)(m0 + s) * ZP + ZV + h * 512 + 4 * v4); vreg[s] = (f32x4){bflo(vv.x), bfhi(vv.x), bflo(vv.y), bfhi(vv.y)}; }
    const u32x4 qk = *(const u32x4*)(CV + (size_t)(m0 + ((tid >> 5) & 7)) * CVP + (tid >> 8) * 1024 + h * 256 + 8 * (tid & 31));
    const float n0v = tid < 256 ? PIN(5)[(size_t)(bs * 4 + h) * 256 + tid] : 0.f;
    __syncthreads();
    { const int isk = tid >> 8, t = (tid >> 5) & 7, c16 = tid & 31; float x[8]; unpack8(qk, x);
#pragma unroll
      for (int e = 0; e < 8; ++e) QKW[(8 * c16 + e) * 16 + isk * 8 + t] = x[e]; }
    if (tid < 256) NS[tid] = n0v;
    if (w == 0) {
        const bool valid = lane < 8; const float mstate = PIN(6)[bs * 4 + h];
        float ipre = 0.f, fpre = 0.f; if (valid) { ipre = GT[(size_t)(m0 + lane) * 64 + h] + PIN(20)[h]; fpre = GT[(size_t)(m0 + lane) * 64 + 4 + h] + PIN(20)[4 + h]; }
        float bsum = valid ? logsigmoidf_(fpre) : 0.f;
#pragma unroll
        for (int o = 1; o < 8; o <<= 1) { const float u = __shfl_up(bsum, o); if (lane >= o) bsum += u; }
        const float a = valid ? ipre - bsum : -INFINITY;
        float cm = a;
#pragma unroll
        for (int o = 1; o < 8; o <<= 1) { const float u = __shfl_up(cm, o); if (lane >= o) cm = fmaxf(cm, u); }
        const float A = fmaxf(mstate, cm); const float Alast = __shfl(A, 7), blast = __shfl(bsum, 7);
        if (valid) { SCs[lane] = a; SCs[8 + lane] = A; SCs[16 + lane] = expf(mstate - A); SCs[24 + lane] = expf(-(bsum + A)); SCs[32 + lane] = expf(a - Alast); }
        if (lane == 0) { SCs[40] = expf(mstate - Alast); F.out[O_SM + bs * 4 + h] = blast + Alast; }
    }
    __syncthreads();
    { const int pr = tid >> 3, part = tid & 7, t = pr >> 3, s = pr & 7; float acc = 0.f;
#pragma unroll 8
      for (int dd = 0; dd < 32; ++dd) { const int d = part * 32 + dd; acc += QKW[d * 16 + t] * QKW[d * 16 + 8 + s]; }
      acc += __shfl_xor(acc, 1); acc += __shfl_xor(acc, 2); acc += __shfl_xor(acc, 4);
      if (part == 0) SW[t * 8 + s] = (s <= t) ? acc * expf(SCs[s] - SCs[8 + t]) : 0.f; }
    if (tid < 64) { const int t = tid >> 3, part = tid & 7; float acc = 0.f;
#pragma unroll 8
      for (int dd = 0; dd < 32; ++dd) { const int d = part * 32 + dd; acc += QKW[d * 16 + t] * NS[d]; }
      acc += __shfl_xor(acc, 1); acc += __shfl_xor(acc, 2); acc += __shfl_xor(acc, 4);
      if (part == 0) QN[t] = acc; }
    if (tid >= 256) { const int d = tid - 256; float s = 0.f;
#pragma unroll
        for (int si = 0; si < 8; ++si) s += SCs[32 + si] * QKW[d * 16 + 8 + si];
        F.out[O_SN + (size_t)(bs * 4 + h) * 256 + d] = SCs[40] * NS[d] + s; }
    __syncthreads();
    if (tid < 8) { const int t = tid; float den = 0.f;
#pragma unroll
        for (int s = 0; s < 8; ++s) den += SW[t * 8 + s];
        den += SCs[16 + t] * QN[t]; DEN[(size_t)(m0 + t) * 4 + h] = fmaxf(fabsf(den), SCs[24 + t]); }
    if (tid >= 256) { const int d = tid - 256;
#pragma unroll
        for (int si = 0; si < 8; ++si) QKW[d * 16 + 8 + si] *= SCs[32 + si]; }
    __syncthreads();
    { const float decay = SCs[40];
      f32x4 acc[8];
#pragma unroll
      for (int t = 0; t < 8; ++t) acc[t] = (f32x4){0.f, 0.f, 0.f, 0.f};
      const float* cin = C0 + (size_t)(dp * 64) * 512 + 4 * v4; float* cout = C1 + (size_t)(dp * 64) * 512 + 4 * v4;
#pragma unroll 1
      for (int d0 = 0; d0 < 64; d0 += 8) {
          f32x4 cc[8];
#pragma unroll
          for (int i = 0; i < 8; ++i) cc[i] = __builtin_nontemporal_load((const f32x4*)(cin + (size_t)(d0 + i) * 512));
#pragma unroll
          for (int i = 0; i < 8; ++i) { const LAS float* qp = QKW + (dp * 64 + d0 + i) * 16;
              const f32x4 q0 = *(const LAS f32x4*)qp, q1 = *(const LAS f32x4*)(qp + 4), k0 = *(const LAS f32x4*)(qp + 8), k1 = *(const LAS f32x4*)(qp + 12);
              f32x4 cn = decay * cc[i];
#pragma unroll
              for (int t = 0; t < 4; ++t) { acc[t] += q0[t] * cc[i]; acc[4 + t] += q1[t] * cc[i]; cn += k0[t] * vreg[t]; cn += k1[t] * vreg[4 + t]; }
              __builtin_nontemporal_store(cn, (f32x4*)(cout + (size_t)(d0 + i) * 512)); }
      }
#pragma unroll
      for (int t = 0; t < 8; ++t) *(LAS f32x4*)(RED + (size_t)(dp * 8 + t) * 512 + 4 * v4) = acc[t]; }
    __syncthreads();
    { const int t = tid >> 6, v8 = tid & 63; float s[8];
#pragma unroll
      for (int e = 0; e < 8; ++e) s[e] = 0.f;
#pragma unroll
      for (int dpp = 0; dpp < 4; ++dpp) { const f32x4 a = *(const LAS f32x4*)(RED + (size_t)(dpp * 8 + t) * 512 + 8 * v8), b = *(const LAS f32x4*)(RED + (size_t)(dpp * 8 + t) * 512 + 8 * v8 + 4);
#pragma unroll
          for (int e = 0; e < 4; ++e) { s[e] += a[e]; s[4 + e] += b[e]; } }
      const float wst = SCs[16 + t];
#pragma unroll
      for (int e = 0; e < 8; ++e) s[e] *= wst;
      for (int si = 0; si <= t; ++si) { const float sw = SW[t * 8 + si]; float x[8]; unpack8(*(const u32x4*)(Z + (size_t)(m0 + si) * ZP + ZV + h * 512 + 8 * v8), x);
#pragma unroll
          for (int e = 0; e < 8; ++e) s[e] += sw * x[e]; }
      *(u32x4*)(NUM + (size_t)(m0 + t) * 2048 + h * 512 + 8 * v8) = pack8(s, 1.0f); }
}

__device__ __forceinline__ void ssd_sample_item(Frame& F, const Params& p, const int bs, const int g) {
    LAS unsigned char* L = F.lds; const int tid = F.tid, lane = F.lane, w = F.wave;
    const bf16_t* CV = (const bf16_t*)(F.ws + WS_CV); const float* GT = (const float*)(F.ws + WS_GATES); bf16_t* YS = (bf16_t*)(F.ws + WS_YS);
    const int m0 = MP + bs * TS;
    LAS float* BSf = (LAS float*)L; LAS float* CSf = (LAS float*)(L + 4096); LAS float* XF = (LAS float*)(L + 8192); LAS float* XWt = (LAS float*)(L + 24576);
    LAS float* XDt = (LAS float*)(L + 40960); LAS float* SC2 = (LAS float*)(L + 57344); LAS float* CB = (LAS float*)(L + 58432); LAS float* YP = (LAS float*)(L + 59392);
    const u32x4 xr = *(const u32x4*)(CV + (size_t)(m0 + (tid >> 6)) * CVP + 2048 + g * 512 + 8 * (tid & 63));
    u32x4 bcr = {0u, 0u, 0u, 0u};
    if (tid < 256) bcr = *(const u32x4*)(CV + (size_t)(m0 + ((tid >> 4) & 7)) * CVP + 4096 + (tid >> 7) * 512 + g * 128 + 8 * (tid & 15));
    __syncthreads();
    { float x[8]; unpack8(xr, x); const int t = tid >> 6, c8 = tid & 63;
#pragma unroll
      for (int e = 0; e < 8; ++e) XF[t * 512 + 8 * c8 + e] = x[e]; }
    if (tid < 256) { float x[8]; unpack8(bcr, x); const int isC = tid >> 7, t = (tid >> 4) & 7, c16 = tid & 15; LAS float* dst = isC ? CSf : BSf;
#pragma unroll
      for (int e = 0; e < 8; ++e) dst[t * 128 + 8 * c16 + e] = x[e]; }
    { const int e = g * 8 + w; const bool valid = lane < 8; const float Ae = -expf(PIN(26)[e]);
      const float dt = valid ? softplusf_(GT[(size_t)(m0 + lane) * 64 + 8 + e] + PIN(25)[e]) : 0.f;
      float cum = dt * Ae;
#pragma unroll
      for (int o = 1; o < 8; o <<= 1) { const float u = __shfl_up(cum, o); if (lane >= o) cum += u; }
      const float cl = __shfl(cum, 7);
      if (valid) { SC2[w * 32 + lane] = cum; SC2[w * 32 + 8 + lane] = dt; SC2[w * 32 + 16 + lane] = expf(cl - cum); SC2[w * 32 + 24 + lane] = expf(cum); }
      if (lane == 0) SC2[256 + w] = expf(cl); }
    __syncthreads();
    { const int pr = tid >> 3, part = tid & 7, t = pr >> 3, s = pr & 7; float acc = 0.f;
#pragma unroll
      for (int nn = 0; nn < 16; ++nn) { const int n = part * 16 + nn; acc += CSf[t * 128 + n] * BSf[s * 128 + n]; }
      acc += __shfl_xor(acc, 1); acc += __shfl_xor(acc, 2); acc += __shfl_xor(acc, 4);
      if (part == 0) CB[t * 8 + s] = acc; }
    { const int el = tid >> 6;
#pragma unroll
      for (int s = 0; s < 8; ++s) { const float x = XF[s * 512 + tid], dt = SC2[el * 32 + 8 + s], ed = SC2[el * 32 + 16 + s]; XDt[tid * 8 + s] = x * dt; XWt[tid * 8 + s] = x * dt * ed; } }
    __syncthreads();
    { const int n8 = tid & 15, prow = tid >> 4;
      float Bn[8][8], Cn[8][8];
#pragma unroll
      for (int s = 0; s < 8; ++s) { const f32x4 b0 = *(const LAS f32x4*)(BSf + s * 128 + 8 * n8), b1 = *(const LAS f32x4*)(BSf + s * 128 + 8 * n8 + 4), c0 = *(const LAS f32x4*)(CSf + s * 128 + 8 * n8), c1 = *(const LAS f32x4*)(CSf + s * 128 + 8 * n8 + 4);
#pragma unroll
          for (int j = 0; j < 4; ++j) { Bn[s][j] = b0[j]; Bn[s][4 + j] = b1[j]; Cn[s][j] = c0[j]; Cn[s][4 + j] = c1[j]; } }
      const float* hin = PIN(8) + (size_t)(bs * 32 + g * 8) * 8192 + 8 * n8; float* hout = F.out + O_SSSM + (size_t)(bs * 32 + g * 8) * 8192 + 8 * n8;
#pragma unroll 1
      for (int it = 0; it < 16; it += 2) {
          f32x4 hv[2][2];
#pragma unroll
          for (int u = 0; u < 2; ++u) { const int row = (it + u) * 32 + prow; hv[u][0] = __builtin_nontemporal_load((const f32x4*)(hin + (size_t)row * 128)); hv[u][1] = __builtin_nontemporal_load((const f32x4*)(hin + (size_t)row * 128 + 4)); }
#pragma unroll
          for (int u = 0; u < 2; ++u) { const int row = (it + u) * 32 + prow; const float eall = SC2[256 + (row >> 6)];
              const f32x4 xw0 = *(const LAS f32x4*)(XWt + row * 8), xw1 = *(const LAS f32x4*)(XWt + row * 8 + 4);
              float hh[8], hn[8], yp[8];
#pragma unroll
              for (int j = 0; j < 4; ++j) { hh[j] = hv[u][0][j]; hh[4 + j] = hv[u][1][j]; }
#pragma unroll
              for (int j = 0; j < 8; ++j) hn[j] = eall * hh[j];
#pragma unroll
              for (int s = 0; s < 8; ++s) { const float xw = s < 4 ? xw0[s & 3] : xw1[s & 3]; float y = 0.f;
#pragma unroll
                  for (int j = 0; j < 8; ++j) { hn[j] += xw * Bn[s][j]; y += Cn[s][j] * hh[j]; }
                  yp[s] = y; }
              f32x4 o0 = {hn[0], hn[1], hn[2], hn[3]}, o1 = {hn[4], hn[5], hn[6], hn[7]};
              __builtin_nontemporal_store(o0, (f32x4*)(hout + (size_t)row * 128)); __builtin_nontemporal_store(o1, (f32x4*)(hout + (size_t)row * 128 + 4));
#pragma unroll
              for (int s = 0; s < 8; ++s) { float y = yp[s]; y += __shfl_xor(y, 1); y += __shfl_xor(y, 2); y += __shfl_xor(y, 4); y += __shfl_xor(y, 8); yp[s] = y; }
              if (n8 == 0) { *(LAS f32x4*)(YP + row * 8) = (f32x4){yp[0], yp[1], yp[2], yp[3]}; *(LAS f32x4*)(YP + row * 8 + 4) = (f32x4){yp[4], yp[5], yp[6], yp[7]}; } }
      } }
    __syncthreads();
    { const int row = tid, el = row >> 6, pp = row & 63, e = g * 8 + el; const float De = PIN(27)[e];
#pragma unroll
      for (int t = 0; t < 8; ++t) { const float cumt = SC2[el * 32 + t]; float y = SC2[el * 32 + 24 + t] * YP[row * 8 + t];
#pragma unroll
          for (int s = 0; s < 8; ++s) if (s <= t) y += CB[t * 8 + s] * expf(cumt - SC2[el * 32 + s]) * XDt[row * 8 + s];
          y += De * XF[t * 512 + row];
          YS[(size_t)(m0 + t) * 2048 + e * 64 + pp] = (bf16_t)(cvt_pk_bf16(y, 0.f) & 0xffffu); } }
}

#ifndef IT_MASK
#define IT_MASK 15
#endif
__device__ __forceinline__ void phase_mixer(Frame& F, const Params& p, const int itm = IT_MASK) {
    if (itm & 1) { for (int it = F.bx; it < 256; it += F.G) { const int x = it & 7, j = it >> 3, pair = x * 4 + (j >> 3); mlstm_prompt_item(F, p, pair >> 2, pair & 3, j & 7); } }
    if (itm & 2) { for (int it = F.bx; it < 256; it += F.G) { const int x = it & 7, j = it >> 3, grp = x * 4 + (j >> 3); ssd_prompt_item(F, p, grp >> 2, (grp & 3) * 8 + (j & 7)); } }
    if (itm & 4) { for (int it = F.bx; it < 4 * (NBS - NS_EARLY); it += F.G) mlstm_sample_item(F, p, NS_EARLY + (it >> 2), it & 3); }
    if (itm & 8) { for (int it = F.bx; it < 4 * (NBS - NS_EARLY); it += F.G) ssd_sample_item(F, p, NS_EARLY + (it >> 2), it & 3); }
}

__device__ __forceinline__ void phase_finish(Frame& F, const Params& p) {
    const bf16_t* Z = (const bf16_t*)(F.ws + WS_ZIN); const bf16_t* NUM = (const bf16_t*)(F.ws + WS_NUM); const bf16_t* YS = (const bf16_t*)(F.ws + WS_YS);
    const float* DEN = (const float*)(F.ws + WS_DEN); bf16_t* HA = (bf16_t*)(F.ws + WS_HA); bf16_t* HB = (bf16_t*)(F.ws + WS_HB);
    const float* hg = PIN(21); const float* sg = PIN(28);
    const int gwv = F.bx * 8 + F.wave, NGW = F.G * 8, lane = F.lane;
    for (int m = gwv; m < MT; m += NGW) {
#pragma unroll
        for (int h = 0; h < 4; ++h) {
            float x[8], o[8], gz[8]; unpack8(*(const u32x4*)(NUM + (size_t)m * 2048 + h * 512 + 8 * lane), x);
            float s = 0.f;
#pragma unroll
            for (int e = 0; e < 8; ++e) s += x[e];
            const float mu = wave_sum(s) * (1.0f / 512.0f); float q = 0.f;
#pragma unroll
            for (int e = 0; e < 8; ++e) { x[e] -= mu; q += x[e] * x[e]; }
            const float var = wave_sum(q) * (1.0f / 512.0f), Dv = DEN[(size_t)m * 4 + h];
            const float rs = 1.0f / sqrtf(var + EPS * Dv * Dv);
            unpack8(*(const u32x4*)(Z + (size_t)m * ZP + ZO + h * 512 + 8 * lane), gz);
            const f32x4 g0 = *(const f32x4*)(hg + h * 512 + 8 * lane), g1 = *(const f32x4*)(hg + h * 512 + 8 * lane + 4);
#pragma unroll
            for (int e = 0; e < 8; ++e) o[e] = x[e] * rs * (e < 4 ? g0[e & 3] : g1[e & 3]) * sigmoidf_(gz[e]);
            if (m < MP) *(u32x2*)((unsigned char*)HA + (size_t)m * 2048 + h * 512 + 8 * lane) = (u32x2){pack4_fp8(o[0], o[1], o[2], o[3], F8_SA), pack4_fp8(o[4], o[5], o[6], o[7], F8_SA)};
            else *(u32x4*)(HA + (size_t)MP * 2048 + fo_index(m - MP, h * 512 + 8 * lane, 2048)) = pack8(o, 1.0f);
        }
#pragma unroll
        for (int gq = 0; gq < 4; ++gq) {
            float y[8], zz[8]; unpack8(*(const u32x4*)(YS + (size_t)m * 2048 + gq * 512 + 8 * lane), y); unpack8(*(const u32x4*)(Z + (size_t)m * ZP + ZZ + gq * 512 + 8 * lane), zz);
            float q = 0.f;
#pragma unroll
            for (int e = 0; e < 8; ++e) { y[e] *= siluf_(zz[e]); q += y[e] * y[e]; }
            const float rs = 1.0f / sqrtf(wave_sum(q) * (1.0f / 512.0f) + EPS);
            const f32x4 g0 = *(const f32x4*)(sg + gq * 512 + 8 * lane), g1 = *(const f32x4*)(sg + gq * 512 + 8 * lane + 4);
#pragma unroll
            for (int e = 0; e < 8; ++e) y[e] = y[e] * rs * (e < 4 ? g0[e & 3] : g1[e & 3]);
            if (m < MP) *(u32x2*)((unsigned char*)HB + (size_t)m * 2048 + gq * 512 + 8 * lane) = (u32x2){pack4_fp8(y[0], y[1], y[2], y[3], F8_SA), pack4_fp8(y[4], y[5], y[6], y[7], F8_SA)};
            else *(u32x4*)(HB + (size_t)MP * 2048 + fo_index(m - MP, gq * 512 + 8 * lane, 2048)) = pack8(y, 1.0f);
        }
    }
    const int gt = F.bx * NTHREADS + F.tid, NGT = F.G * NTHREADS;
    constexpr int N1 = NBP * 3 * 2048, N2 = NBS * 3 * 2048, N3 = NBP * 3 * 3072, N4 = NBS * 3 * 3072;
    for (int i = gt; i < N1 + N2 + N3 + N4; i += NGT) {
        int j = i;
        if (j < N1) { const int b = j / 6144, r = (j / 2048) % 3, ch = j % 2048; F.out[O_PMC + j] = bf2f(Z[(size_t)(b * SEQ + SEQ - 3 + r) * ZP + ch]); continue; } j -= N1;
        if (j < N2) { const int b = j / 6144, r = (j / 2048) % 3, ch = j % 2048; F.out[O_SMC + j] = bf2f(Z[(size_t)(MP + b * TS + TS - 3 + r) * ZP + ch]); continue; } j -= N2;
        if (j < N3) { const int b = j / 9216, r = (j / 3072) % 3, ch = j % 3072; F.out[O_PSC + j] = bf2f(Z[(size_t)(b * SEQ + SEQ - 3 + r) * ZP + ZX + ch]); continue; } j -= N3;
        { const int b = j / 9216, r = (j / 3072) % 3, ch = j % 3072; F.out[O_SSC + j] = bf2f(Z[(size_t)(MP + b * TS + TS - 3 + r) * ZP + ZX + ch]); }
    }
}


#ifndef STAG_LEVELS
#define STAG_LEVELS 8
#endif
#ifndef STAG_SLEEP
#define STAG_SLEEP 16
#endif
__device__ __forceinline__ void stagger_start(const Frame& F) { const int sl = (F.bx >> 3) & (STAG_LEVELS - 1); for (int q = 0; q < sl; ++q) __builtin_amdgcn_s_sleep(STAG_SLEEP); }

constexpr int LDS_BYTES = 147456;
constexpr int NPHASE = 15;

__global__ void __launch_bounds__(NTHREADS, 2) fwd_kernel(Params p) {
    extern __shared__ __attribute__((aligned(16))) unsigned char lds_raw[];
    Frame F;
    F.lds = (LAS unsigned char*)lds_raw;
    F.tid = threadIdx.x; F.lane = F.tid & 63; F.wave = __builtin_amdgcn_readfirstlane(F.tid >> 6);
    F.G = gridDim.x; F.bx = blockIdx.x;
    F.out = p.out; F.ws = p.ws;
    unsigned char* ws = p.ws;
    bf16_t* U = (bf16_t*)(ws + WS_U); bf16_t* H = (bf16_t*)(ws + WS_H); float* X1 = (float*)(ws + WS_X1);
    bf16_t* ZIN = (bf16_t*)(ws + WS_ZIN); float* GATES = (float*)(ws + WS_GATES); float* MOD = (float*)(ws + WS_MOD);
    const int lo = p.ph_lo, hi = p.ph_hi;
#ifndef PH_MASK
#define PH_MASK 0xfffff
#endif
#define IN(k) (((PH_MASK >> (k)) & 1) && lo <= (k) && (k) < hi)
#ifndef DUP_MASK
#define DUP_MASK 0
#endif
#define DUP(k) ((DUP_MASK >> (k)) & 1)
    volatile LAS unsigned* MISC = (volatile LAS unsigned*)(F.lds + LDS_BYTES - 64);
    if (F.tid < 16) MISC[F.tid] = 0u;
    if (F.tid == 0) { volatile LAS unsigned* T = (volatile LAS unsigned*)(F.lds + PTAB_OFF);
#pragma unroll
        for (int k = 0; k < 36; ++k) { const uint64_t a = (uint64_t)p.in[k]; T[2 * k] = (unsigned)a; T[2 * k + 1] = (unsigned)(a >> 32); } }
    __syncthreads();
    XcdBarrier bar; bar.bar = (unsigned*)(ws + WS_CTL); bar.x = 0; bar.st = nullptr;
    if (hi - lo > 1) bar = xcd_barrier_post((unsigned*)(ws + WS_CTL), MISC);
#define SEAM(k) do { if (IN(k) && IN((k) + 1)) { xcd_barrier(bar); } } while (0)

    if (IN(0)) { phase_silu_c(F, p); phase_prep<0>(F, p); if (hi - lo > 1) xcd_barrier(bar); phase_adaln(F, p); } SEAM(0);
    if (IN(1)) { phase_norm_mod(F, PIN(0), PIN(1), PIN(12), 0 * DM, 1 * DM, U); if (DUP(1)) phase_norm_mod(F, PIN(0), PIN(1), PIN(12), 0 * DM, 1 * DM, U); } SEAM(1);
    if (IN(2)) { pg8::Gemm g{U, U, (const bf16_t*)(ws + WS_WUP1), (const bf16_t*)(ws + WS_WUP1), DM / 2}; pg8::Order S;
        if (F.bx < 192) { stagger_start(F); S.init_from(MT, 2 * DFF, 192, F.bx, 0, 1344); } else { phase_prep<1>(F, p); S.init_from(MT, 2 * DFF, 64, F.bx - 192, 1344, 1496); }
        pg8::EpiSwiGLU E{H, F8_INV}; pg8::gemm_phase<pg8::EpiSwiGLU, true, pg8::Order, true>(F.lds, g, S, E); } SEAM(2);
    float* XS = (float*)(ws + WS_XS); unsigned* CNT = (unsigned*)(ws + WS_CTL) + CW_CNT; bf16_t* U2 = (bf16_t*)(ws + WS_U2);
    if (IN(3)) { stagger_start(F); pg8::Gemm g{H, H, (const bf16_t*)(ws + WS_WDN1), (const bf16_t*)(ws + WS_WDN1), DFF / 2}; pg8::Order S; S.init(MP, DM, F.G, F.bx, 0);
        pg8::EpiResidNorm<false> E{PIN(0), X1, MOD + 2 * DM, PIN(16), MOD + 3 * DM, MOD + 4 * DM, U, nullptr, XS, CNT, 0.5f * F8_INV, 0}; pg8::gemm_phase<pg8::EpiResidNorm<false>, true, pg8::Order, true>(F.lds, g, S, E);
        small_phase_resid_norm<DFF, false>(F, H, (const bf16_t*)(ws + WS_FDN1), PIN(1), X1, MOD + 2 * DM, 0.5f, PIN(16), MOD + 3 * DM, MOD + 4 * DM, U, nullptr, XS, CNT); } SEAM(3);
    if (IN(5)) {
        const pg8::Gemm g{U, U, (const bf16_t*)(ws + WS_WIN), (const bf16_t*)(ws + WS_WIN), DM}; const pg8::EpiZin E{ZIN, GATES};
        { stagger_start(F); const pg8::OrderSample S{F.bx}; pg8::gemm_phase<pg8::EpiZin, true, pg8::OrderSample>(F.lds, g, S, E); }
        if (F.bx >= 208 && F.bx < 224) small_gates_tile(F, U, (const bf16_t*)(ws + WS_FG), GATES, MP / 64 + (F.bx - 208));
        if (F.bx >= 224) { for (int k = 0; k < 4; ++k) small_gates_tile(F, U, (const bf16_t*)(ws + WS_FG), GATES, 4 * (F.bx - 224) + k); }
        xcd_barrier(bar);
        if (F.bx >= 192) {
            const int s0 = F.bx - 192;
            for (int k = F.wave; k < 10; k += 8) conv_item(F, p, 5120 + 10 * s0 + k);
            asm volatile("s_waitcnt vmcnt(0)" ::: "memory"); __syncthreads(); __builtin_amdgcn_fence(__ATOMIC_ACQUIRE, "agent");
#pragma unroll 1
            for (int k = 0; k < 4; ++k) mlstm_sample_item(F, p, s0, k);
#pragma unroll 1
            for (int k = 0; k < 4; ++k) ssd_sample_item(F, p, s0, k);
            for (int k = 0; k < 2; ++k) small_gates_tile(F, U, (const bf16_t*)(ws + WS_FG), GATES, 128 + 2 * s0 + k);
        } else stagger_start(F);
        __syncthreads();
        { const pg8::OrderPrompt S{F.bx}; pg8::gemm_phase<pg8::EpiZin, true, pg8::OrderPrompt>(F.lds, g, S, E); }
        } SEAM(5);
    if (IN(6)) { phase_conv(F, p); if (DUP(6)) phase_conv(F, p); } SEAM(6);
    #ifndef DUP_IT
#define DUP_IT 15
#endif
    if (IN(7)) { phase_mixer(F, p, p.itm); } SEAM(7);
    if (IN(8)) { phase_finish(F, p); if (DUP(8)) phase_finish(F, p); } SEAM(8);
    if (IN(9)) { stagger_start(F); pg8::Gemm g{(const bf16_t*)(ws + WS_HA), (const bf16_t*)(ws + WS_HB), (const bf16_t*)(ws + WS_WPA), (const bf16_t*)(ws + WS_WPB), 2048 / 2}; pg8::Order S; S.init(MP, DM, F.G, F.bx, 1);
        pg8::EpiMerge E{ZIN, (float*)(ws + WS_TMP), U, F8_INV}; pg8::gemm_phase<pg8::EpiMerge, true, pg8::Order, true>(F.lds, g, S, E);
        small_phase_merge(F, (const bf16_t*)(ws + WS_HA), (const bf16_t*)(ws + WS_HB), (const bf16_t*)(ws + WS_FPA), (const bf16_t*)(ws + WS_FPB), ZIN, U); } SEAM(9);
    if (IN(10)) { stagger_start(F); pg8::Gemm g{U, U, (const bf16_t*)(ws + WS_WOUT), (const bf16_t*)(ws + WS_WOUT), DM / 2}; pg8::Order S; S.init(MP, DM, F.G, F.bx, 0);
        pg8::EpiResidNorm<false> E{X1, X1, MOD + 5 * DM, PIN(31), MOD + 6 * DM, MOD + 7 * DM, U2, nullptr, XS + (size_t)MT * 16, CNT + CNT_STRIDE, 1.0f * F8_INV, 1}; pg8::gemm_phase<pg8::EpiResidNorm<false>, true, pg8::Order, true>(F.lds, g, S, E);
        small_phase_resid_norm<DM, false>(F, U, (const bf16_t*)(ws + WS_FOUT), X1 + (size_t)MP * DM, X1, MOD + 5 * DM, 1.0f, PIN(31), MOD + 6 * DM, MOD + 7 * DM, U2, nullptr, XS + (size_t)MT * 16, CNT + CNT_STRIDE); } SEAM(10);
    if (IN(12)) { stagger_start(F); pg8::Gemm g{U2, U2, (const bf16_t*)(ws + WS_WUP2), (const bf16_t*)(ws + WS_WUP2), DM / 2}; pg8::Order S; S.init(MT, 2 * DFF, F.G, F.bx, 0);
        pg8::EpiSwiGLU E{H, F8_INV}; pg8::gemm_phase<pg8::EpiSwiGLU, true, pg8::Order, true>(F.lds, g, S, E); } SEAM(12);
    if (IN(13)) { stagger_start(F); pg8::Gemm g{H, H, (const bf16_t*)(ws + WS_WDN2), (const bf16_t*)(ws + WS_WDN2), DFF / 2}; pg8::Order S; S.init(MP, DM, F.G, F.bx, 0);
        pg8::EpiResidNorm<true> E{X1, nullptr, MOD + 8 * DM, PIN(35), nullptr, nullptr, nullptr, p.out, XS + (size_t)2 * MT * 16, CNT + 2 * CNT_STRIDE, 0.5f * F8_INV, 0}; pg8::gemm_phase<pg8::EpiResidNorm<true>, true, pg8::Order, true>(F.lds, g, S, E);
        small_phase_resid_norm<DFF, true>(F, H, (const bf16_t*)(ws + WS_FDN2), X1 + (size_t)MP * DM, nullptr, MOD + 8 * DM, 0.5f, PIN(35), nullptr, nullptr, nullptr, p.out, XS + (size_t)2 * MT * 16, CNT + 2 * CNT_STRIDE); }
#undef IN
#undef SEAM
}

extern "C" void kernel_launch(void* const* d_in, const int* in_sizes, int n_in, void* d_out, int out_size, void* d_ws, size_t ws_size, hipStream_t stream) {
    static int grid = 0;
    if (grid == 0) {
        if (n_in != 36 || ws_size < WS_END) { fprintf(stderr, "kernel_launch: expected 36 inputs and >= %zu bytes of workspace (got %d, %zu)\n", (size_t)WS_END, n_in, ws_size); grid = -1; return; }
        int dev = 0, cus = 0, per_cu = 0;
        hipGetDevice(&dev); hipDeviceGetAttribute(&cus, hipDeviceAttributeMultiprocessorCount, dev);
        hipFuncSetAttribute((const void*)fwd_kernel, hipFuncAttributeMaxDynamicSharedMemorySize, LDS_BYTES);
        hipOccupancyMaxActiveBlocksPerMultiprocessor(&per_cu, (const void*)fwd_kernel, NTHREADS, LDS_BYTES);
        if (per_cu < 1) { fprintf(stderr, "kernel_launch: occupancy query says %d blocks per CU\n", per_cu); grid = -1; return; }
        grid = cus;
        if (grid != 256) { fprintf(stderr, "kernel_launch: the fused-norm GEMM epilogues need exactly 256 workgroups (one 256x256 tile each); this device has %d CUs\n", cus); grid = -1; return; }
    }
    if (grid < 0) return;
    Params p{};
    for (int i = 0; i < 36; ++i) p.in[i] = (const float*)d_in[i];
    p.out = (float*)d_out; p.ws = (unsigned char*)d_ws; p.itm = 15;
#if MK_LAUNCH_PER_PHASE
    for (int ph = 0; ph < NPHASE; ++ph) { p.ph_lo = ph; p.ph_hi = ph + 1; hipLaunchKernelGGL(fwd_kernel, dim3(grid), dim3(NTHREADS), LDS_BYTES, stream, p); }
#else
    p.ph_lo = 0; p.ph_hi = NPHASE;
    if (hipMemsetAsync((char*)d_ws + WS_CTL, 0, 98304, stream) != hipSuccess) { fprintf(stderr, "kernel_launch: memset of the barrier words failed\n"); return; }
    void* args[] = {&p};
    hipError_t e = hipLaunchCooperativeKernel((const void*)fwd_kernel, dim3(grid), dim3(NTHREADS), args, LDS_BYTES, stream);
    if (e != hipSuccess) fprintf(stderr, "cooperative launch failed: %s (grid %d)\n", hipGetErrorString(e), grid);
#ifdef PROBE_PH
    for (int r = 0; r < PROBE_REPS; ++r) { Params q = p; q.ph_lo = PROBE_PH; q.ph_hi = PROBE_PH + 1; q.itm = PROBE_ITM; hipLaunchKernelGGL(fwd_kernel, dim3(grid), dim3(NTHREADS), LDS_BYTES, stream, q); }
#endif
#endif
}
```

```cpp
#include <hip/hip_runtime.h>
#include <hip/hip_cooperative_groups.h>
#include <cstdio>
#include <cstdint>
namespace cg = cooperative_groups;

#ifndef MK_LAUNCH_PER_PHASE
#define MK_LAUNCH_PER_PHASE 0
#endif

constexpr int DM = 1024, SEQ = 2048, NBP = 8, NBS = 128, TS = 8;
constexpr int MP = NBP * SEQ, MS = NBS * TS, MT = MP + MS, NBID = NBP + NBS;
constexpr int DFF = 2816, NMOD = 9 * DM;
constexpr int ZP = 13568;
constexpr int ZQ = 0, ZK = 1024, ZV = 2048, ZO = 4096, ZZ = 6144, ZX = 8192, ZGA = 11264, ZGB = 12288, ZG = 13312;
constexpr float EPS = 1e-6f;
constexpr int NTHREADS = 512;

constexpr size_t MiB = 1u << 20;
constexpr size_t WS_CTL = 0;
constexpr size_t WS_WUP1 = 1 * MiB;
constexpr size_t WS_WDN1 = WS_WUP1 + 11 * MiB;
constexpr size_t WS_WUP2 = WS_WDN1 + 6 * MiB;
constexpr size_t WS_WDN2 = WS_WUP2 + 11 * MiB;
constexpr size_t WS_WIN = WS_WDN2 + 6 * MiB;
constexpr size_t WS_WPA = WS_WIN + 27 * MiB;
constexpr size_t WS_WPB = WS_WPA + 4 * MiB;
constexpr size_t WS_WOUT = WS_WPB + 4 * MiB;
constexpr size_t WS_MOD = WS_WOUT + 2 * MiB;
constexpr size_t WS_U = WS_MOD + 5 * MiB;
constexpr size_t WS_H = WS_U + 34 * MiB;
constexpr size_t WS_X1 = WS_H + 94 * MiB;
constexpr size_t WS_ZIN = WS_X1 + 68 * MiB;
constexpr size_t WS_GATES = WS_ZIN + 451 * MiB;
constexpr size_t WS_YS = WS_GATES + 5 * MiB;
constexpr size_t WS_DEN = WS_YS + 68 * MiB;
constexpr size_t WS_HA = WS_DEN + 1 * MiB;
constexpr size_t WS_HB = WS_HA + 68 * MiB;
constexpr size_t WS_CV = WS_HA;
constexpr size_t WS_XS = WS_CV + 170 * MiB;
constexpr size_t WS_U2 = WS_ZIN;
constexpr size_t WS_FDN1 = WS_XS + 4 * MiB;
constexpr size_t WS_FDN2 = WS_FDN1 + 6 * MiB;
constexpr size_t WS_FPA = WS_FDN2 + 6 * MiB;
constexpr size_t WS_FPB = WS_FPA + 4 * MiB;
constexpr size_t WS_FOUT = WS_FPB + 4 * MiB;
constexpr size_t WS_FG = WS_FOUT + 2 * MiB;
constexpr size_t WS_SC = WS_FG + 1 * MiB;
constexpr size_t WS_END = WS_SC + 1 * MiB;
constexpr int CW_CNT = 4096, CNT_STRIDE = 5120;
constexpr size_t WS_NUM = WS_H;
constexpr size_t WS_TMP = WS_YS;
static_assert(WS_END <= 1024 * MiB, "workspace map");

#define LAS __attribute__((address_space(3)))
typedef unsigned short bf16_t;
typedef short bf16x8 __attribute__((ext_vector_type(8)));
typedef short s16x4 __attribute__((ext_vector_type(4)));
typedef float f32x4 __attribute__((ext_vector_type(4)));
typedef float f32x2 __attribute__((ext_vector_type(2)));
typedef unsigned u32x4 __attribute__((ext_vector_type(4)));
typedef int v8i_t __attribute__((ext_vector_type(8)));
typedef unsigned u32x2 __attribute__((ext_vector_type(2)));

typedef __bf16 bf16x2_t __attribute__((ext_vector_type(2)));
__device__ __forceinline__ unsigned cvt_pk_bf16(float lo, float hi) { const bf16x2_t v = {(__bf16)lo, (__bf16)hi}; return __builtin_bit_cast(unsigned, v); }
__device__ __forceinline__ float bf2f(unsigned short b) { return __uint_as_float(((unsigned)b) << 16); }
__device__ __forceinline__ float bflo(unsigned w) { return __uint_as_float(w << 16); }
__device__ __forceinline__ float bfhi(unsigned w) { return __uint_as_float(w & 0xffff0000u); }
constexpr float F8_SA = 8.0f, F8_SW = 1024.0f, F8_INV = 1.0f / (8.0f * 1024.0f);
__device__ __forceinline__ float f8c(float x) { return fminf(fmaxf(x, -448.0f), 448.0f); }
__device__ __forceinline__ unsigned pack4_fp8(float a, float b, float c, float d, float s) {
    int w = 0; w = __builtin_amdgcn_cvt_pk_fp8_f32(f8c(a * s), f8c(b * s), w, false); w = __builtin_amdgcn_cvt_pk_fp8_f32(f8c(c * s), f8c(d * s), w, true); return (unsigned)w; }
__device__ __forceinline__ float fast_exp(float x) { return __builtin_amdgcn_exp2f(x * 1.4426950408889634f); }
__device__ __forceinline__ float sigmoidf_(float x) { return __builtin_amdgcn_rcpf(1.0f + fast_exp(-x)); }
__device__ __forceinline__ float siluf_(float x) { return x * sigmoidf_(x); }
__device__ __forceinline__ u32x4 pack8(const float (&v)[8], float s) {
    u32x4 w; w.x = cvt_pk_bf16(v[0] * s, v[1] * s); w.y = cvt_pk_bf16(v[2] * s, v[3] * s); w.z = cvt_pk_bf16(v[4] * s, v[5] * s); w.w = cvt_pk_bf16(v[6] * s, v[7] * s); return w;
}
__device__ __forceinline__ u32x2 pack4(const f32x4 v) { u32x2 w; w.x = cvt_pk_bf16(v[0], v[1]); w.y = cvt_pk_bf16(v[2], v[3]); return w; }
__device__ __forceinline__ void unpack8(const u32x4 v, float (&x)[8]) { x[0] = bflo(v.x); x[1] = bfhi(v.x); x[2] = bflo(v.y); x[3] = bfhi(v.y); x[4] = bflo(v.z); x[5] = bfhi(v.z); x[6] = bflo(v.w); x[7] = bfhi(v.w); }
__device__ __forceinline__ size_t fo_index(int r, int k, int K) { return ((size_t)((r >> 4) * (K >> 5) + (k >> 5))) * 512 + (size_t)((((r & 15) + 16 * ((k >> 3) & 3)) << 3) + (k & 7)); }
__device__ __forceinline__ float wave_scan_add(float v) {
    v += __builtin_bit_cast(float, __builtin_amdgcn_update_dpp(0, __builtin_bit_cast(int, v), 0x111, 0xf, 0xf, true));
    v += __builtin_bit_cast(float, __builtin_amdgcn_update_dpp(0, __builtin_bit_cast(int, v), 0x112, 0xf, 0xf, true));
    v += __builtin_bit_cast(float, __builtin_amdgcn_update_dpp(0, __builtin_bit_cast(int, v), 0x114, 0xf, 0xf, true));
    v += __builtin_bit_cast(float, __builtin_amdgcn_update_dpp(0, __builtin_bit_cast(int, v), 0x118, 0xf, 0xf, true));
    v += __builtin_bit_cast(float, __builtin_amdgcn_update_dpp(0, __builtin_bit_cast(int, v), 0x142, 0xa, 0xf, true));
    v += __builtin_bit_cast(float, __builtin_amdgcn_update_dpp(0, __builtin_bit_cast(int, v), 0x143, 0xc, 0xf, true));
    return v;
}
__device__ __forceinline__ float wave_scan_max(float v) {
    const int ninf = (int)0xff800000u;
    v = fmaxf(v, __builtin_bit_cast(float, __builtin_amdgcn_update_dpp(ninf, __builtin_bit_cast(int, v), 0x111, 0xf, 0xf, false)));
    v = fmaxf(v, __builtin_bit_cast(float, __builtin_amdgcn_update_dpp(ninf, __builtin_bit_cast(int, v), 0x112, 0xf, 0xf, false)));
    v = fmaxf(v, __builtin_bit_cast(float, __builtin_amdgcn_update_dpp(ninf, __builtin_bit_cast(int, v), 0x114, 0xf, 0xf, false)));
    v = fmaxf(v, __builtin_bit_cast(float, __builtin_amdgcn_update_dpp(ninf, __builtin_bit_cast(int, v), 0x118, 0xf, 0xf, false)));
    v = fmaxf(v, __builtin_bit_cast(float, __builtin_amdgcn_update_dpp(ninf, __builtin_bit_cast(int, v), 0x142, 0xa, 0xf, false)));
    v = fmaxf(v, __builtin_bit_cast(float, __builtin_amdgcn_update_dpp(ninf, __builtin_bit_cast(int, v), 0x143, 0xc, 0xf, false)));
    return v;
}
__device__ __forceinline__ float wave_sum(float v) { return __builtin_bit_cast(float, __builtin_amdgcn_readlane(__builtin_bit_cast(int, wave_scan_add(v)), 63)); }

struct Params {
    const float* in[36];
    float* out;
    unsigned char* ws;
    int ph_lo, ph_hi, itm, pad;
};

namespace pg8 {
constexpr int BM = 256, BK = 64, HALF = 128, HTB = HALF * BK * 2, STAGE_BYTES = 8 * HTB, NXCD = 8, WGM = 8;
__host__ __device__ __forceinline__ int lds_byte(int r, int c) { const int st = (r >> 4) * 2 + (c >> 5), rr = r & 15, cc = c & 31, ob = rr * 64 + cc * 2; return st * 1024 + (ob ^ (((ob >> 9) & 1) << 5)); }
__host__ __device__ __forceinline__ void stage_rc(int b, int& R, int& C) { const int st = b / 1024, sb = b % 1024, swz = sb ^ (((sb >> 9) & 1) << 5); R = (st >> 1) * 16 + swz / 64; C = (st & 1) * 32 + (swz % 64) / 2; }
__host__ __device__ __forceinline__ int perm32(int rho) { const int n = rho >> 4, i = rho & 15; return 8 * (i >> 2) + 4 * n + (i & 3); }

struct Unit { int pm, pn, w; };
struct Gemm { const bf16_t* A0; const bf16_t* A1; const bf16_t* B0; const bf16_t* B1; int K; };
typedef unsigned u32x8_t __attribute__((ext_vector_type(8)));
__device__ __forceinline__ v8i_t cat8(const bf16x8 x0, const bf16x8 x1) { const u32x4 l = __builtin_bit_cast(u32x4, x0), h = __builtin_bit_cast(u32x4, x1); const u32x8_t c = __builtin_shufflevector(l, h, 0, 1, 2, 3, 4, 5, 6, 7); return __builtin_bit_cast(v8i_t, c); }

struct OrderSample { int c;
    __device__ bool next(int i, Unit& u) const { if (i > 0 || c >= 208) return false; const int x = c & 7, j = c >> 3; u.pm = 64 + (x >> 1); u.pn = (x & 1) * 26 + j; u.w = 0; return true; } };
struct OrderPrompt { int c;
    __device__ bool next(int i, Unit& u) const { const int x = c & 7, j = c >> 3; int q; if (j < 24) { if (i >= 17) return false; q = i * 24 + j; } else { if (i >= 1) return false; q = 408 + (j - 24); }
        u.pm = 8 * x + (q & 7); u.pn = q >> 3; u.w = 0; return true; } };
struct Order {
    int nM, nN, nwg, G, c, dual;
    __device__ void init(int M, int N, int G_, int c_, int dual_) { nM = M / BM; nN = N / BM; nwg = nM * nN; G = G_; c = c_; dual = dual_; }
    __device__ void init_from(int M, int N, int G_, int c_, int first, int lim) { nM = M / BM; nN = N / BM; nwg = lim; G = G_; c = first + c_; dual = 0; }
    __device__ bool next(int i, Unit& u) const {
        const int ti = dual ? (i >> 1) : i;
        const long L = (long)ti * G + c; if (L >= nwg) return false;
        int wgid = (int)L; { const int tot = nM * nN, q = tot / NXCD, r = tot % NXCD, xcd = wgid % NXCD, off = wgid / NXCD; wgid = (xcd < r ? xcd * (q + 1) : r * (q + 1) + (xcd - r) * q) + off; }
        const int nig = WGM * nN, gid = wgid / nig, fm = gid * WGM, gsz = (nM - fm) < WGM ? (nM - fm) : WGM;
        u.pm = fm + ((wgid % nig) % gsz); u.pn = (wgid % nig) / gsz; u.w = dual ? (i & 1) : 0; return true;
    }
};

template <class Epi, bool ALIGN_EPI = true, class Ord = Order, bool FP8 = false>
__device__ __forceinline__ void gemm_phase(LAS unsigned char* lds, const Gemm g, const Ord& S, const Epi E) {
    const int tid = threadIdx.x, wid = __builtin_amdgcn_readfirstlane(tid >> 6), lane = tid & 63, wr = wid >> 2, wc = wid & 3, fr = lane & 15, fq = lane >> 4;
    const int K = g.K, nt = K / BK;
    unsigned voffA[2], voffB[2];
#pragma unroll
    for (int i = 0; i < 2; ++i) { int R, C; stage_rc(tid * 16 + i * 8192, R, C); const int Rb = Epi::PERM ? ((R & ~31) + perm32(R & 31)) : R;
        voffA[i] = (unsigned)(R * K + C) * 2u; voffB[i] = (unsigned)(Rb * K + C) * 2u; }
    const size_t kstep = (size_t)(BK * 2);
    const size_t hstep = (size_t)HALF * K * 2;
    const size_t tstep = 2 * hstep;
    const unsigned ldsw = (unsigned)wid * 1024u;
    const int aoff = lds_byte(wr * 64 + fr, fq * 8), boff = lds_byte(wc * 32 + fr, fq * 8);
#define PG8_SA(b, h) (((b) * 2 + (h)) * HTB)
#define PG8_SB(b, h) ((4 + (b) * 2 + (h)) * HTB)
#define PG8_STAGE(bufoff, gbase, voff) do { _Pragma("unroll") for (int _i = 0; _i < 2; ++_i) \
        __builtin_amdgcn_global_load_lds((const unsigned*)((const char*)(gbase) + (voff)[_i]), (LAS unsigned*)(lds + (bufoff) + ldsw + _i * 8192), 16, 0, 0); } while (0)
#define PG8_LDA(dst, b, h) do { _Pragma("unroll") for (int m = 0; m < 4; ++m) _Pragma("unroll") for (int k = 0; k < 2; ++k) dst[m][k] = *(const LAS bf16x8*)(lds + PG8_SA(b, h) + aoff + m * 2048 + k * 1024); } while (0)
#define PG8_LDB(dst, b, h) do { _Pragma("unroll") for (int n = 0; n < 2; ++n) _Pragma("unroll") for (int k = 0; k < 2; ++k) dst[n][k] = *(const LAS bf16x8*)(lds + PG8_SB(b, h) + boff + n * 2048 + k * 1024); } while (0)
#define PG8_CAT8(x0, x1) cat8((x0), (x1))
#define PG8_MMA(ai, bj, At, Bt) do { __builtin_amdgcn_s_setprio(1); _Pragma("unroll") for (int m = 0; m < 4; ++m) _Pragma("unroll") for (int n = 0; n < 2; ++n) { \
        if constexpr (FP8) { const v8i_t b8_ = PG8_CAT8(Bt[n][0], Bt[n][1]), a8_ = PG8_CAT8(At[m][0], At[m][1]); \
            asm volatile("v_mfma_scale_f32_16x16x128_f8f6f4 %0, %1, %2, %0, %3, %3 op_sel_hi:[0,0,0]" : "+v"(acc[ai][bj][m][n]) : "v"(b8_), "v"(a8_), "v"(f8one)); } \
        else { _Pragma("unroll") for (int k = 0; k < 2; ++k) acc[ai][bj][m][n] = __builtin_amdgcn_mfma_f32_16x16x32_bf16(Bt[n][k], At[m][k], acc[ai][bj][m][n], 0, 0, 0); } } __builtin_amdgcn_s_setprio(0); } while (0)
#define PG8_WAIT_V(n) asm volatile("s_waitcnt vmcnt(" #n ")" ::: "memory")
#define PG8_WAIT_L(n) asm volatile("s_waitcnt lgkmcnt(" #n ")" ::: "memory")
#define PG8_BAR __builtin_amdgcn_s_barrier()
#define PG8_SCHED __builtin_amdgcn_sched_barrier(0)
    Unit cur, nxt; int ui = 0;
    if (!S.next(0, cur)) return;
    const int f8one = 0x7F7F7F7F;
    f32x4 acc[2][2][4][2];
#pragma unroll
    for (int a = 0; a < 2; ++a)
#pragma unroll
        for (int b = 0; b < 2; ++b)
#pragma unroll
            for (int m = 0; m < 4; ++m)
#pragma unroll
                for (int n = 0; n < 2; ++n) acc[a][b][m][n] = (f32x4){0.f, 0.f, 0.f, 0.f};
    bf16x8 At[4][2], B0[2][2], B1[2][2];
    const char* cA = (const char*)(cur.w ? g.A1 : g.A0) + (size_t)cur.pm * tstep; const char* cB = (const char*)(cur.w ? g.B1 : g.B0) + (size_t)cur.pn * tstep;
    PG8_STAGE(PG8_SB(0, 0), cB, voffB); PG8_STAGE(PG8_SB(0, 1), cB + hstep, voffB); PG8_STAGE(PG8_SA(0, 0), cA, voffA); PG8_STAGE(PG8_SA(0, 1), cA + hstep, voffA);
    if (wr == 1) PG8_BAR;
    PG8_WAIT_V(2); PG8_BAR;
    PG8_STAGE(PG8_SB(1, 0), cB + kstep, voffB); PG8_STAGE(PG8_SA(1, 0), cA + kstep, voffA); PG8_STAGE(PG8_SB(1, 1), cB + hstep + kstep, voffB);
    PG8_WAIT_V(6); PG8_BAR;
    for (;;) {
        const bool has_next = S.next(ui + 1, nxt);
        const char* nA = has_next ? (const char*)(nxt.w ? g.A1 : g.A0) + (size_t)nxt.pm * tstep : cA; const char* nB = has_next ? (const char*)(nxt.w ? g.B1 : g.B0) + (size_t)nxt.pn * tstep : cB;
        for (int t = 0; t < nt; t += 2) {
            const bool last = (t == nt - 2);
            const char* a1 = cA + (size_t)(t + 1) * kstep;
            const char* a2 = last ? nA : cA + (size_t)(t + 2) * kstep; const char* b2 = last ? nB : cB + (size_t)(t + 2) * kstep;
            const char* a3 = a2 + kstep; const char* b3 = b2 + kstep;
            PG8_LDB(B0, 0, 0); PG8_LDB(B1, 0, 1); PG8_SCHED; PG8_LDA(At, 0, 0); PG8_STAGE(PG8_SA(1, 1), a1 + hstep, voffA);
            PG8_WAIT_V(8); PG8_WAIT_L(0); PG8_BAR; PG8_MMA(0, 0, At, B0); PG8_MMA(0, 1, At, B1); PG8_BAR; PG8_SCHED;
            PG8_LDA(At, 0, 1); PG8_STAGE(PG8_SB(0, 0), b2, voffB); PG8_STAGE(PG8_SB(0, 1), b2 + hstep, voffB); PG8_STAGE(PG8_SA(0, 0), a2, voffA);
            PG8_WAIT_V(8); PG8_WAIT_L(0); PG8_BAR; PG8_MMA(1, 0, At, B0); PG8_MMA(1, 1, At, B1); PG8_BAR; PG8_SCHED;
            PG8_LDB(B0, 1, 0); PG8_LDB(B1, 1, 1); PG8_SCHED; PG8_LDA(At, 1, 0); PG8_STAGE(PG8_SA(0, 1), a2 + hstep, voffA);
            PG8_WAIT_V(8); PG8_WAIT_L(0); PG8_BAR; PG8_MMA(0, 0, At, B0); PG8_MMA(0, 1, At, B1); PG8_BAR; PG8_SCHED;
            PG8_LDA(At, 1, 1); PG8_STAGE(PG8_SB(1, 0), b3, voffB); PG8_STAGE(PG8_SB(1, 1), b3 + hstep, voffB); PG8_STAGE(PG8_SA(1, 0), a3, voffA);
            PG8_WAIT_V(8); PG8_WAIT_L(0); PG8_BAR; PG8_MMA(1, 0, At, B0); PG8_MMA(1, 1, At, B1); PG8_BAR; PG8_SCHED;
        }
        if constexpr (ALIGN_EPI) { if (wr == 0) PG8_BAR; }
        if constexpr (FP8) asm volatile("s_nop 15\n\ts_nop 15" ::: "memory");
        if constexpr (!Epi::AFTER_DRAIN) E(acc, cur, wr, wc, fr, fq);
        if (!has_next) break;
#pragma unroll
        for (int a = 0; a < 2; ++a)
#pragma unroll
            for (int b = 0; b < 2; ++b)
#pragma unroll
                for (int m = 0; m < 4; ++m)
#pragma unroll
                    for (int n = 0; n < 2; ++n) acc[a][b][m][n] = (f32x4){0.f, 0.f, 0.f, 0.f};
        cur = nxt; cA = nA; cB = nB; ++ui;
        if constexpr (ALIGN_EPI) { if (wr == 1) PG8_BAR; }
    }
    PG8_WAIT_V(0);
    if constexpr (!ALIGN_EPI) { if (wr == 0) PG8_BAR; }
    PG8_BAR;
    if constexpr (Epi::AFTER_DRAIN) E.fused(acc, cur, wr, wc, fr, fq, lds, wid, lane);
#undef PG8_SA
#undef PG8_SB
#undef PG8_STAGE
#undef PG8_LDA
#undef PG8_LDB
#undef PG8_MMA
#undef PG8_WAIT_V
#undef PG8_WAIT_L
#undef PG8_BAR
#undef PG8_SCHED
}

__device__ __forceinline__ int bid_of_row(int row) { return row < MP ? (row >> 11) : (NBP + ((row - MP) >> 3)); }

struct EpiSwiGLU {
    static constexpr bool PERM = true, AFTER_DRAIN = false;
    bf16_t* H; float inv;
    __device__ __forceinline__ void operator()(const f32x4 (&acc)[2][2][4][2], const Unit& u, int wr, int wc, int fr, int fq) const {
        const int row0 = u.pm * BM + wr * 64 + fr, hc0 = u.pn * 128 + wc * 32 + 8 * fq; const float inv_ = inv;
#pragma unroll
        for (int ai = 0; ai < 2; ++ai)
#pragma unroll
            for (int m = 0; m < 4; ++m) { const f32x4 a0 = acc[ai][0][m][0] * inv_, a1 = acc[ai][0][m][1] * inv_, b0 = acc[ai][1][m][0] * inv_, b1 = acc[ai][1][m][1] * inv_;
                u32x4 w; w.x = cvt_pk_bf16(siluf_(a0[0]) * b0[0], siluf_(a0[1]) * b0[1]); w.y = cvt_pk_bf16(siluf_(a0[2]) * b0[2], siluf_(a0[3]) * b0[3]);
                w.z = cvt_pk_bf16(siluf_(a1[0]) * b1[0], siluf_(a1[1]) * b1[1]); w.w = cvt_pk_bf16(siluf_(a1[2]) * b1[2], siluf_(a1[3]) * b1[3]);
                const int row = row0 + ai * HALF + m * 16;
                if (u.pm < MP / BM) *(u32x2*)((unsigned char*)H + (size_t)row * DFF + hc0) = (u32x2){pack4_fp8(siluf_(a0[0]) * b0[0], siluf_(a0[1]) * b0[1], siluf_(a0[2]) * b0[2], siluf_(a0[3]) * b0[3], F8_SA), pack4_fp8(siluf_(a1[0]) * b1[0], siluf_(a1[1]) * b1[1], siluf_(a1[2]) * b1[2], siluf_(a1[3]) * b1[3], F8_SA)};
                else *(u32x4*)(H + (size_t)MP * DFF + fo_index(row - MP, hc0, DFF)) = w; }
    }
};
struct EpiResid {
    static constexpr bool PERM = false, AFTER_DRAIN = false;
    const float* xin_p; const float* xin_s; float* out; const float* gmod; float coef;
    __device__ __forceinline__ void operator()(const f32x4 (&acc)[2][2][4][2], const Unit& u, int wr, int wc, int fr, int fq) const {
        const int row0 = u.pm * BM + wr * 64 + fr, col0 = u.pn * BM + wc * 32 + 4 * fq;
#pragma unroll
        for (int ai = 0; ai < 2; ++ai)
#pragma unroll
            for (int m = 0; m < 4; ++m) { const int row = row0 + ai * HALF + m * 16;
                const float* xr = (row < MP ? xin_p + (size_t)row * DM : xin_s + (size_t)(row - MP) * DM) + col0;
                const float* gr = gmod + (size_t)bid_of_row(row) * NMOD + col0; float* orow = out + (size_t)row * DM + col0;
#pragma unroll
                for (int bj = 0; bj < 2; ++bj)
#pragma unroll
                    for (int n = 0; n < 2; ++n) { const int o = bj * HALF + n * 16; const f32x4 xv = *(const f32x4*)(xr + o), gv = *(const f32x4*)(gr + o);
                        *(f32x4*)(orow + o) = xv + coef * gv * acc[ai][bj][m][n]; } }
    }
};

__device__ __forceinline__ void panel_wait(unsigned* cnt, unsigned need) {
    unsigned spins = 0;
    while ((unsigned)__builtin_amdgcn_readfirstlane(__hip_atomic_load(cnt, __ATOMIC_RELAXED, __HIP_MEMORY_SCOPE_AGENT)) < need) { if (++spins > (1u << 20)) break; __builtin_amdgcn_s_sleep(2); }
    __builtin_amdgcn_fence(__ATOMIC_ACQUIRE, "agent");
}
template <bool FINAL>
struct EpiResidNorm {
    static constexpr bool PERM = true, AFTER_DRAIN = true;
    const float* xin; float* Xout; const float* gmod; const float* gw; const float* shmod; const float* scmod; bf16_t* Uout; float* Yout; float* XS; unsigned* cnt; float coef; int pad_;
    __device__ __forceinline__ void fused(f32x4 (&acc)[2][2][4][2], const Unit& u, int wr, int wc, int fr, int fq, LAS unsigned char* lds, int wid, int lane) const {
        LAS float* P = (LAS float*)lds; LAS float* S = (LAS float*)(lds + 4096);
        const float* const xin_ = xin; float* const Xout_ = Xout; const float* const gmod_ = gmod; const float coef_ = coef; const float* const gw_ = gw; const float* const shmod_ = shmod; const float* const scmod_ = scmod;
        bf16_t* const Uout_ = Uout; float* const Yout_ = Yout; float* const XS_ = XS; unsigned* const cnt_ = cnt;
        const int b = u.pm >> 3, col0 = u.pn * BM + wc * 32 + 8 * fq, rowt = wr * 64 + fr;
        { f32x4 gv[2][2];
#pragma unroll
          for (int bj = 0; bj < 2; ++bj)
#pragma unroll
              for (int n = 0; n < 2; ++n) gv[bj][n] = coef_ * *(const f32x4*)(gmod_ + (size_t)b * NMOD + col0 + bj * HALF + n * 4);
#pragma unroll
          for (int ai = 0; ai < 2; ++ai)
#pragma unroll
              for (int m = 0; m < 4; ++m) { const int rt = rowt + ai * HALF + m * 16; const float* xr = xin_ + (size_t)(u.pm * BM + rt) * DM + col0; float ss = 0.f;
#pragma unroll
                  for (int bj = 0; bj < 2; ++bj)
#pragma unroll
                      for (int n = 0; n < 2; ++n) { const f32x4 x = *(const f32x4*)(xr + bj * HALF + n * 4) + gv[bj][n] * acc[ai][bj][m][n]; acc[ai][bj][m][n] = x; ss += (x[0] * x[0] + x[1] * x[1]) + (x[2] * x[2] + x[3] * x[3]); }
                  ss += __shfl_xor(ss, 16); ss += __shfl_xor(ss, 32);
                  if (fq == 0) P[rt * 4 + wc] = ss;
                  asm volatile("" ::: "memory"); } }
        __syncthreads();
        const int r32 = wid * 32 + (lane & 31); float* slot = XS_ + (size_t)(u.pm * BM + r32) * 16;
        if (lane < 32) { const f32x4 pp = *(const LAS f32x4*)(P + r32 * 4); __hip_atomic_store(slot + u.pn, (pp[0] + pp[1]) + (pp[2] + pp[3]), __ATOMIC_RELAXED, __HIP_MEMORY_SCOPE_AGENT); }
        asm volatile("s_waitcnt vmcnt(0)" ::: "memory");
        if (lane == 0) __hip_atomic_fetch_add(cnt_ + 64 * u.pm, 1u, __ATOMIC_RELAXED, __HIP_MEMORY_SCOPE_AGENT);
        if (wid == 0) panel_wait(cnt_ + 64 * u.pm, 32u);
        asm volatile("s_waitcnt vmcnt(0) lgkmcnt(0)" ::: "memory");
        __syncthreads();
        if (lane < 32) { float tot = 0.f;
#pragma unroll
            for (int t = 0; t < 4; ++t) tot += __hip_atomic_load(slot + t, __ATOMIC_RELAXED, __HIP_MEMORY_SCOPE_AGENT);
            S[r32] = 1.0f / sqrtf(tot * (1.0f / DM) + EPS); }
        __syncthreads();
        f32x4 fac[2][2], shv[2][2];
#pragma unroll
        for (int bj = 0; bj < 2; ++bj)
#pragma unroll
            for (int n = 0; n < 2; ++n) { const int c = col0 + bj * HALF + n * 4; fac[bj][n] = *(const f32x4*)(gw_ + c);
                if constexpr (!FINAL) { fac[bj][n] = fac[bj][n] * (1.0f + *(const f32x4*)(scmod_ + (size_t)b * NMOD + c)); shv[bj][n] = *(const f32x4*)(shmod_ + (size_t)b * NMOD + c); } }
#pragma unroll
        for (int ai = 0; ai < 2; ++ai)
#pragma unroll
            for (int m = 0; m < 4; ++m) { const int rt = rowt + ai * HALF + m * 16; const size_t off = (size_t)(u.pm * BM + rt) * DM + col0; const float r = S[rt];
#pragma unroll
                for (int bj = 0; bj < 2; ++bj) { const f32x4 x0 = acc[ai][bj][m][0], x1 = acc[ai][bj][m][1]; const int o = bj * HALF;
                    if constexpr (FINAL) { *(f32x4*)(Yout_ + off + o) = x0 * r * fac[bj][0]; *(f32x4*)(Yout_ + off + o + 4) = x1 * r * fac[bj][1]; }
                    else { *(f32x4*)(Xout_ + off + o) = x0; *(f32x4*)(Xout_ + off + o + 4) = x1;
                        const f32x4 y0 = x0 * r * fac[bj][0] + shv[bj][0], y1 = x1 * r * fac[bj][1] + shv[bj][1];
                        if (pad_) *(u32x2*)((unsigned char*)Uout_ + off + o) = (u32x2){pack4_fp8(y0[0], y0[1], y0[2], y0[3], F8_SA), pack4_fp8(y1[0], y1[1], y1[2], y1[3], F8_SA)};
                        else { const u32x2 w0 = pack4(y0), w1 = pack4(y1); *(u32x4*)(Uout_ + off + o) = (u32x4){w0.x, w0.y, w1.x, w1.y}; } } } }
    }
};
struct EpiZin {
    static constexpr bool PERM = true, AFTER_DRAIN = false;
    bf16_t* Z; float* gates;
    __device__ __forceinline__ void operator()(const f32x4 (&acc)[2][2][4][2], const Unit& u, int wr, int wc, int fr, int fq) const {
        const int row0 = u.pm * BM + wr * 64 + fr;
        {
            const int col0 = u.pn * BM + wc * 32 + 8 * fq;
#pragma unroll
            for (int ai = 0; ai < 2; ++ai)
#pragma unroll
                for (int m = 0; m < 4; ++m) { bf16_t* rp = Z + (size_t)(row0 + ai * HALF + m * 16) * ZP + col0;
#pragma unroll
                    for (int bj = 0; bj < 2; ++bj) { const f32x4 v0 = acc[ai][bj][m][0], v1 = acc[ai][bj][m][1];
                        u32x4 w; w.x = cvt_pk_bf16(v0[0], v0[1]); w.y = cvt_pk_bf16(v0[2], v0[3]); w.z = cvt_pk_bf16(v1[0], v1[1]); w.w = cvt_pk_bf16(v1[2], v1[3]);
                        *(u32x4*)(rp + bj * HALF) = w; } }
        }
    }
};
struct EpiMerge {
    static constexpr bool PERM = true, AFTER_DRAIN = false;
    const bf16_t* Z; float* tmp; bf16_t* U; float inv;
    __device__ __forceinline__ void operator()(const f32x4 (&acc)[2][2][4][2], const Unit& u, int wr, int wc, int fr, int fq) const {
        const int row0 = u.pm * BM + wr * 64 + fr, col0 = u.pn * BM + wc * 32 + 8 * fq;
        const int zoff = u.w ? ZGB : ZGA; const float inv_ = inv; bf16_t* const part = (bf16_t*)tmp;
#pragma unroll
        for (int ai = 0; ai < 2; ++ai)
#pragma unroll
            for (int m = 0; m < 4; ++m) { const int row = row0 + ai * HALF + m * 16;
#pragma unroll
                for (int bj = 0; bj < 2; ++bj) { const int c = col0 + bj * HALF;
                    const u32x4 gz = *(const u32x4*)(Z + (size_t)row * ZP + zoff + c);
                    f32x4 s0, s1; s0[0] = sigmoidf_(bflo(gz.x)); s0[1] = sigmoidf_(bfhi(gz.x)); s0[2] = sigmoidf_(bflo(gz.y)); s0[3] = sigmoidf_(bfhi(gz.y));
                    s1[0] = sigmoidf_(bflo(gz.z)); s1[1] = sigmoidf_(bfhi(gz.z)); s1[2] = sigmoidf_(bflo(gz.w)); s1[3] = sigmoidf_(bfhi(gz.w));
                    f32x4 v0 = s0 * (acc[ai][bj][m][0] * inv_), v1 = s1 * (acc[ai][bj][m][1] * inv_);
                    u32x4* pp = (u32x4*)(part + (size_t)row * DM + c);
                    if (u.w == 0) { u32x4 w; w.x = cvt_pk_bf16(v0[0], v0[1]); w.y = cvt_pk_bf16(v0[2], v0[3]); w.z = cvt_pk_bf16(v1[0], v1[1]); w.w = cvt_pk_bf16(v1[2], v1[3]); *pp = w; }
                    else { const u32x4 pv = *pp; v0[0] += bflo(pv.x); v0[1] += bfhi(pv.x); v0[2] += bflo(pv.y); v0[3] += bfhi(pv.y); v1[0] += bflo(pv.z); v1[1] += bfhi(pv.z); v1[2] += bflo(pv.w); v1[3] += bfhi(pv.w);
                        *(u32x2*)((unsigned char*)U + (size_t)row * DM + c) = (u32x2){pack4_fp8(v0[0], v0[1], v0[2], v0[3], F8_SA), pack4_fp8(v1[0], v1[1], v1[2], v1[3], F8_SA)}; } } }
    }
};
}


struct Frame {
    LAS unsigned char* lds;
    int tid, lane, wave, G, bx;
    float* out; unsigned char* ws;
};
constexpr int PTAB_OFF = 147072;
__device__ __forceinline__ const float* pin_ld(const Frame& F, const int k) {
    const volatile LAS unsigned* T = (const volatile LAS unsigned*)(F.lds + PTAB_OFF);
    const unsigned lo = (unsigned)__builtin_amdgcn_readfirstlane((int)T[2 * k]), hi = (unsigned)__builtin_amdgcn_readfirstlane((int)T[2 * k + 1]);
    return (const float*)(((uint64_t)hi << 32) | (uint64_t)lo);
}
#define PIN(k) pin_ld(F, (k))

template <int KTOT, bool FOA, bool FOB>
__device__ __forceinline__ void small_gemm_partials(LAS unsigned char* lds, const bf16_t* A, const bf16_t* Bt, int wave, int lane) {
    const int fr = lane & 15, fq = lane >> 4; constexpr int NKS = KTOT / 256; const int T0 = wave * NKS;
    const bf16_t* ap = A + (size_t)fr * KTOT + 8 * fq; const bf16_t* bp = Bt + (size_t)fr * KTOT + 8 * fq;
    f32x4 acc[4][4];
#pragma unroll
    for (int i = 0; i < 4; ++i)
#pragma unroll
        for (int j = 0; j < 4; ++j) acc[i][j] = (f32x4){0.f, 0.f, 0.f, 0.f};
    bf16x8 a[4][4], b[4][4];
#define SG_LOAD(slot, t) do { const int T_ = T0 + (t), ko_ = 32 * T_; _Pragma("unroll") for (int i = 0; i < 4; ++i) { \
        if constexpr (FOA) a[slot][i] = *(const bf16x8*)(A + ((size_t)(i * (KTOT / 32) + T_)) * 512 + 8 * lane); else a[slot][i] = *(const bf16x8*)(ap + (size_t)(16 * i) * KTOT + ko_); \
        if constexpr (FOB) b[slot][i] = *(const bf16x8*)(Bt + ((size_t)(i * (KTOT / 32) + T_)) * 512 + 8 * lane); else b[slot][i] = *(const bf16x8*)(bp + (size_t)(16 * i) * KTOT + ko_); } } while (0)
#pragma unroll
    for (int t = 0; t < 4 && t < NKS; ++t) SG_LOAD(t, t);
    __builtin_amdgcn_sched_barrier(0);
#pragma unroll
    for (int t = 0; t < NKS; ++t) {
#pragma unroll
        for (int tn = 0; tn < 4; ++tn)
#pragma unroll
            for (int tm = 0; tm < 4; ++tm) acc[tn][tm] = __builtin_amdgcn_mfma_f32_16x16x32_bf16(b[t & 3][tn], a[t & 3][tm], acc[tn][tm], 0, 0, 0);
        __builtin_amdgcn_sched_barrier(0);
        if (t + 4 < NKS) { SG_LOAD(t & 3, t + 4); __builtin_amdgcn_sched_barrier(0); } }
#undef SG_LOAD
    LAS f32x4* PART = (LAS f32x4*)lds;
#pragma unroll
    for (int tn = 0; tn < 4; ++tn)
#pragma unroll
        for (int tm = 0; tm < 4; ++tm) PART[(wave * 16 + tn * 4 + tm) * 64 + lane] = acc[tn][tm];
}
__device__ __forceinline__ f32x4 small_gemm_sum(LAS unsigned char* lds, int tid, int j) {
    const LAS f32x4* PART = (const LAS f32x4*)lds; const int tile = 8 * j + (tid >> 6), ln = tid & 63; f32x4 sum = PART[tile * 64 + ln];
#pragma unroll
    for (int wv = 1; wv < 8; ++wv) sum += PART[(wv * 16 + tile) * 64 + ln];
    return sum;
}
template <int KTOT>
__device__ __forceinline__ void small_phase_resid(Frame& F, const bf16_t* A, const bf16_t* Bt, const float* xin_s, float* out, const float* gmod, float coef) {
    for (int st = F.bx; st < 256; st += F.G) { const int x = st & 7, j = st >> 3, sm = 4 * (x >> 1) + (j >> 3), sn = 8 * (x & 1) + (j & 7);
        __syncthreads();
        small_gemm_partials<KTOT, true, true>(F.lds, A + (size_t)(MP + 64 * sm) * KTOT, Bt + (size_t)(64 * sn) * KTOT, F.wave, F.lane);
        __syncthreads();
#pragma unroll
        for (int j = 0; j < 2; ++j) { const f32x4 v = small_gemm_sum(F.lds, F.tid, j); const int tile = 8 * j + (F.tid >> 6), tn = tile >> 2, tm = tile & 3;
            const int ms = 64 * sm + 16 * tm + (F.lane & 15), n = 64 * sn + 16 * tn + 4 * (F.lane >> 4), row = MP + ms;
            const f32x4 xv = *(const f32x4*)(xin_s + (size_t)ms * DM + n), gv = *(const f32x4*)(gmod + (size_t)pg8::bid_of_row(row) * NMOD + n);
            *(f32x4*)(out + (size_t)row * DM + n) = xv + coef * gv * v; } }
}
template <int KTOT, bool FINAL>
__device__ __forceinline__ void small_phase_resid_norm(Frame& F, const bf16_t* A, const bf16_t* Bt, const float* xin_s, float* Xout, const float* gmod, float coef,
                                                       const float* gw, const float* shmod, const float* scmod, bf16_t* Uout, float* Yout, float* XS, unsigned* cnt) {
    LAS float* P2 = (LAS float*)(F.lds + 131072); LAS float* S2 = (LAS float*)(F.lds + 131072 + 512);
    for (int st = F.bx; st < 256; st += F.G) { const int x = st & 7, j0 = st >> 3, sm = 4 * (x >> 1) + (j0 >> 3), sn = 8 * (x & 1) + (j0 & 7);
        __syncthreads();
        small_gemm_partials<KTOT, true, true>(F.lds, A + (size_t)(MP + 64 * sm) * KTOT, Bt + (size_t)(64 * sn) * KTOT, F.wave, F.lane);
        __syncthreads();
        const int fr = F.lane & 15, fq = F.lane >> 4, tm = F.wave & 3, rl = 16 * tm + fr, ms = 64 * sm + rl, row = MP + ms, bid = NBP + (ms >> 3);
        f32x4 xn[2]; float ss = 0.f;
#pragma unroll
        for (int j = 0; j < 2; ++j) { const int n = 64 * sn + 16 * (2 * j + (F.wave >> 2)) + 4 * fq;
            const f32x4 x4 = *(const f32x4*)(xin_s + (size_t)ms * DM + n) + coef * *(const f32x4*)(gmod + (size_t)bid * NMOD + n) * small_gemm_sum(F.lds, F.tid, j);
            xn[j] = x4; ss += (x4[0] * x4[0] + x4[1] * x4[1]) + (x4[2] * x4[2] + x4[3] * x4[3]); }
        ss += __shfl_xor(ss, 16); ss += __shfl_xor(ss, 32);
        if (fq == 0) P2[(F.wave >> 2) * 64 + rl] = ss;
        __syncthreads();
        float* slot = XS + (size_t)(MP + 64 * sm + F.lane) * 16;
        if (F.wave == 0) { __hip_atomic_store(slot + sn, P2[F.lane] + P2[64 + F.lane], __ATOMIC_RELAXED, __HIP_MEMORY_SCOPE_AGENT);
            asm volatile("s_waitcnt vmcnt(0)" ::: "memory");
            if (F.lane == 0) __hip_atomic_fetch_add(cnt + 64 * (64 + sm), 1u, __ATOMIC_RELAXED, __HIP_MEMORY_SCOPE_AGENT);
            pg8::panel_wait(cnt + 64 * (64 + sm), 16u);
            float tot = 0.f;
#pragma unroll
            for (int t = 0; t < 16; ++t) tot += __hip_atomic_load(slot + t, __ATOMIC_RELAXED, __HIP_MEMORY_SCOPE_AGENT);
            S2[F.lane] = 1.0f / sqrtf(tot * (1.0f / DM) + EPS); }
        __syncthreads();
        const float r = S2[rl];
#pragma unroll
        for (int j = 0; j < 2; ++j) { const int n = 64 * sn + 16 * (2 * j + (F.wave >> 2)) + 4 * fq; const f32x4 g4 = *(const f32x4*)(gw + n);
            if constexpr (FINAL) *(f32x4*)(Yout + (size_t)row * DM + n) = xn[j] * r * g4;
            else { *(f32x4*)(Xout + (size_t)row * DM + n) = xn[j];
                const f32x4 yq = xn[j] * r * g4 * (1.0f + *(const f32x4*)(scmod + (size_t)bid * NMOD + n)) + *(const f32x4*)(shmod + (size_t)bid * NMOD + n);
                if constexpr (KTOT == DM) *(unsigned*)((unsigned char*)Uout + (size_t)row * DM + n) = pack4_fp8(yq[0], yq[1], yq[2], yq[3], F8_SA);
                else *(u32x2*)(Uout + (size_t)row * DM + n) = pack4(yq); } } }
}
__device__ __forceinline__ void small_gates_tile(Frame& F, const bf16_t* U, const bf16_t* Wg, float* gates, const int st) {
    {
        __syncthreads();
        small_gemm_partials<DM, false, true>(F.lds, U + (size_t)(64 * st) * DM, Wg, F.wave, F.lane);
        __syncthreads();
#pragma unroll
        for (int j = 0; j < 2; ++j) { const f32x4 v = small_gemm_sum(F.lds, F.tid, j); const int tile = 8 * j + (F.tid >> 6), tn = tile >> 2, tm = tile & 3;
            *(f32x4*)(gates + (size_t)(64 * st + 16 * tm + (F.lane & 15)) * 64 + 16 * tn + 4 * (F.lane >> 4)) = v; } }
}
__device__ __forceinline__ void small_phase_merge(Frame& F, const bf16_t* HA, const bf16_t* HB, const bf16_t* WA, const bf16_t* WB, const bf16_t* Z, bf16_t* U) {
    for (int st = F.bx; st < 256; st += F.G) { const int x = st & 7, j = st >> 3, sm = 4 * (x >> 1) + (j >> 3), sn = 8 * (x & 1) + (j & 7); f32x4 va[2], vb[2];
        __syncthreads();
        small_gemm_partials<2048, true, true>(F.lds, HA + (size_t)(MP + 64 * sm) * 2048, WA + (size_t)(64 * sn) * 2048, F.wave, F.lane);
        __syncthreads();
        va[0] = small_gemm_sum(F.lds, F.tid, 0); va[1] = small_gemm_sum(F.lds, F.tid, 1);
        __syncthreads();
        small_gemm_partials<2048, true, true>(F.lds, HB + (size_t)(MP + 64 * sm) * 2048, WB + (size_t)(64 * sn) * 2048, F.wave, F.lane);
        __syncthreads();
        vb[0] = small_gemm_sum(F.lds, F.tid, 0); vb[1] = small_gemm_sum(F.lds, F.tid, 1);
#pragma unroll
        for (int j = 0; j < 2; ++j) { const int tile = 8 * j + (F.tid >> 6), tn = tile >> 2, tm = tile & 3;
            const int row = MP + 64 * sm + 16 * tm + (F.lane & 15), n = 64 * sn + 16 * tn + 4 * (F.lane >> 4);
            const u32x2 ga = *(const u32x2*)(Z + (size_t)row * ZP + ZGA + n), gb = *(const u32x2*)(Z + (size_t)row * ZP + ZGB + n);
            f32x4 o; o[0] = sigmoidf_(bflo(ga.x)) * va[j][0] + sigmoidf_(bflo(gb.x)) * vb[j][0]; o[1] = sigmoidf_(bfhi(ga.x)) * va[j][1] + sigmoidf_(bfhi(gb.x)) * vb[j][1];
            o[2] = sigmoidf_(bflo(ga.y)) * va[j][2] + sigmoidf_(bflo(gb.y)) * vb[j][2]; o[3] = sigmoidf_(bfhi(ga.y)) * va[j][3] + sigmoidf_(bfhi(gb.y)) * vb[j][3];
            *(u32x2*)(U + (size_t)MP * DM + fo_index(row - MP, n, DM)) = pack4(o); } }
}

#define GAS __attribute__((address_space(1)))
#define XB_TMO      128
#define XB_XCNT(j)  (256  + 64 * (j))
#define XB_XSUB(j)  (1280 + 64 * (j))
#define XB_XGEN(j)  (2304 + 64 * (j))
#define XB_TOP      3328
#define XB_TOPGEN   3392
#define XCD_BAR_WORDS 3456
#define XB_SPIN_CAP (1u << 22)
__device__ __forceinline__ unsigned xb_ld(unsigned* p)              { return __hip_atomic_load(p, __ATOMIC_RELAXED, __HIP_MEMORY_SCOPE_AGENT); }
__device__ __forceinline__ unsigned xb_add(unsigned* p, unsigned v) { return __hip_atomic_fetch_add(p, v, __ATOMIC_RELAXED, __HIP_MEMORY_SCOPE_AGENT); }
__device__ __forceinline__ unsigned xb_xcc_id() { return (unsigned)__builtin_amdgcn_s_getreg((3 << 11) | 20) & 0xFu; }
#define XB_SPIN(cond, bar) do { unsigned _sp = 0; while (cond) { __builtin_amdgcn_s_sleep(1); \
    if ((++_sp & 255u) == 0u) { if (xb_ld(&(bar)[XB_TMO])) break; if (_sp > XB_SPIN_CAP) { atomicAdd(&(bar)[XB_TMO], 1u); break; } } } } while (0)
struct XcdBarrier { unsigned* bar; unsigned x; volatile LAS unsigned* st; };
__device__ __forceinline__ XcdBarrier xcd_barrier_post(unsigned* bar, volatile LAS unsigned* st) {
    XcdBarrier b; b.bar = bar; b.x = xb_xcc_id(); b.st = st;
    if (threadIdx.x == 0) (void)xb_add(&bar[XB_XCNT(b.x)], 1u);
    return b;
}
__device__ __forceinline__ void xcd_barrier_complete(unsigned* bar, unsigned x, unsigned& nloc, unsigned& nx) {
    const unsigned G = gridDim.x * gridDim.y * gridDim.z;
    unsigned sum, cnt, mine, sp = 0u;
    for (;;) {
        sum = 0u; cnt = 0u; mine = 0u;
#pragma unroll
        for (unsigned j = 0; j < 16; ++j) { const unsigned c = xb_ld(&bar[XB_XCNT(j)]); sum += c; cnt += (c > 0u) ? 1u : 0u; mine = (j == x) ? c : mine; }
        if (sum == G) break;
        __builtin_amdgcn_s_sleep(1);
        if ((++sp & 255u) == 0u) { if (xb_ld(&bar[XB_TMO])) break; if (sp > XB_SPIN_CAP) { atomicAdd(&bar[XB_TMO], 1u); break; } }
    }
    nloc = mine > 0u ? mine : 1u; nx = cnt > 0u ? cnt : 1u;
}
__device__ __forceinline__ void xcd_barrier(const XcdBarrier& b) {
    asm volatile("s_waitcnt vmcnt(0)" ::: "memory");
    __syncthreads();
    if (threadIdx.x == 0) {
        unsigned* bar = b.bar;
        __builtin_amdgcn_s_waitcnt(0);
        unsigned nloc = b.st[0], nx = b.st[1];
        if (nloc == 0u) { xcd_barrier_complete(bar, b.x, nloc, nx); b.st[0] = nloc; b.st[1] = nx; }
        const unsigned old = xb_add(&bar[XB_XSUB(b.x)], 1u);
        const unsigned gen = old / nloc;
        if (old + 1u == (gen + 1u) * nloc) {
            __builtin_amdgcn_fence(__ATOMIC_RELEASE, "agent");
            asm volatile("s_waitcnt vmcnt(0)" ::: "memory");
            const unsigned og = xb_add(&bar[XB_TOP], 1u);
            const unsigned tg = og / nx;
            if (og + 1u == (tg + 1u) * nx) xb_add(&bar[XB_TOPGEN], 1u);
            else XB_SPIN(xb_ld(&bar[XB_TOPGEN]) == tg, bar);
            __builtin_amdgcn_fence(__ATOMIC_ACQUIRE, "agent");
            xb_add(&bar[XB_XGEN(b.x)], 1u);
            asm volatile("s_waitcnt vmcnt(0)" ::: "memory");
        } else {
            XB_SPIN(xb_ld(&bar[XB_XGEN(b.x)]) == gen, bar);
            __builtin_amdgcn_fence(__ATOMIC_ACQUIRE, "agent");
            asm volatile("s_waitcnt vmcnt(0)" ::: "memory");
        }
    }
    __syncthreads();
}


template <class SrcFn>
__device__ __forceinline__ void transpose_item(const SrcFn& src, int K, bf16_t* WT, LAS float* scr, int item, int lane, int nblk, bf16_t* WF = nullptr, int fo_row0 = 0) {
    const int kb = item / nblk, nb = item % nblk, k0 = 64 * kb, n0 = 32 * nb;
    const size_t stride = (size_t)src.stride(); const float* colp = src(n0 + (lane & 31));
    float tv[32];
#pragma unroll
    for (int i = 0; i < 32; ++i) { const int kk = 2 * i + (lane >> 5); tv[i] = colp ? colp[(size_t)(k0 + kk) * stride] : 0.f; }
#pragma unroll
    for (int i = 0; i < 32; ++i) { const int kk = 2 * i + (lane >> 5); scr[kk * 33 + (lane & 31)] = tv[i]; }
    asm volatile("s_waitcnt lgkmcnt(0)" ::: "memory");
    const int c = lane & 7;
#pragma unroll
    for (int j = 0; j < 4; ++j) { const int n = (lane >> 3) + 8 * j; const LAS float* s = scr + (8 * c) * 33 + n;
        if constexpr (SrcFn::F8) *(u32x2*)((unsigned char*)WT + (size_t)(n0 + n) * K + k0 + 8 * c) = (u32x2){pack4_fp8(s[0 * 33], s[1 * 33], s[2 * 33], s[3 * 33], F8_SW), pack4_fp8(s[4 * 33], s[5 * 33], s[6 * 33], s[7 * 33], F8_SW)};
        if constexpr (SrcFn::F8) { if (WF == nullptr) continue; }
        u32x4 o; o.x = cvt_pk_bf16(s[0 * 33], s[1 * 33]); o.y = cvt_pk_bf16(s[2 * 33], s[3 * 33]); o.z = cvt_pk_bf16(s[4 * 33], s[5 * 33]); o.w = cvt_pk_bf16(s[6 * 33], s[7 * 33]);
        if constexpr (!SrcFn::F8) *(u32x4*)(WT + (size_t)(n0 + n) * K + k0 + 8 * c) = o;
        if (WF != nullptr && n0 >= fo_row0) *(u32x4*)(WF + fo_index(n0 + n - fo_row0, k0 + 8 * c, K)) = o; }
    asm volatile("s_waitcnt lgkmcnt(0)" ::: "memory");
}
struct SrcPlain { static constexpr bool F8 = false; const float* W; int N; __device__ __forceinline__ int stride() const { return N; } __device__ __forceinline__ const float* operator()(int n) const { return W + n; } };
struct SrcPlain8 { static constexpr bool F8 = true; const float* W; int N; __device__ __forceinline__ int stride() const { return N; } __device__ __forceinline__ const float* operator()(int n) const { return W + n; } };
struct SrcUp { static constexpr bool F8 = true; const float* W1; const float* W3; __device__ __forceinline__ int stride() const { return DFF; } __device__ __forceinline__ const float* operator()(int n) const { const int T = n >> 8, i = n & 255; const uintptr_t a = (uintptr_t)W1, b = (uintptr_t)W3, msk = (uintptr_t)0 - (uintptr_t)(i >> 7);
        return (const float*)((a & ~msk) | (b & msk)) + 128 * T + (i & 127); } };
struct SrcWin { static constexpr bool F8 = false; const float* W; __device__ __forceinline__ int stride() const { return 13352; } __device__ __forceinline__ const float* operator()(int r) const { int o;
        if (r < 6144) o = r; else if (r < 8192) o = 6152 + (r - 6144); else if (r < 11264) o = 8200 + (r - 8192); else if (r < 13312) o = 11304 + (r - 11264);
        else if (r < 13320) o = 6144 + (r - 13312); else if (r < 13352) o = 11272 + (r - 13320); else return nullptr;
        return W + o; } };

template <int PPART>
__device__ __forceinline__ void phase_prep(Frame& F, const Params& p) {
    LAS float* scr = (LAS float*)(F.lds + F.wave * 16384);
    const int gw = (PPART == 0 ? F.bx : F.bx - 192) * 8 + F.wave, NGW = (PPART == 0 ? F.G : 64) * 8;
    bf16_t* wup1 = (bf16_t*)(F.ws + WS_WUP1); bf16_t* wdn1 = (bf16_t*)(F.ws + WS_WDN1); bf16_t* wup2 = (bf16_t*)(F.ws + WS_WUP2); bf16_t* wdn2 = (bf16_t*)(F.ws + WS_WDN2);
    bf16_t* win = (bf16_t*)(F.ws + WS_WIN); bf16_t* wpa = (bf16_t*)(F.ws + WS_WPA); bf16_t* wpb = (bf16_t*)(F.ws + WS_WPB); bf16_t* wout = (bf16_t*)(F.ws + WS_WOUT);
    constexpr int I_UP = (DM / 64) * (2 * DFF / 32), I_DN = (DFF / 64) * (DM / 32), I_IN = (DM / 64) * (ZP / 32), I_P = (2048 / 64) * (DM / 32), I_O = (DM / 64) * (DM / 32);
    constexpr int NITEMS = 2 * I_UP + 2 * I_DN + I_IN + 2 * I_P + I_O;
    for (int it = (PPART == 0 ? 0 : I_UP) + gw; it < (PPART == 0 ? I_UP : NITEMS); it += NGW) {
        int r = it;
        if (r < I_UP) { transpose_item(SrcUp{PIN(13), PIN(14)}, DM, wup1, scr, r, F.lane, 2 * DFF / 32); continue; } r -= I_UP;
        if (r < I_UP) { transpose_item(SrcUp{PIN(32), PIN(33)}, DM, wup2, scr, r, F.lane, 2 * DFF / 32); continue; } r -= I_UP;
        if (r < I_DN) { transpose_item(SrcPlain8{PIN(15), DM}, DFF, wdn1, scr, r, F.lane, DM / 32, (bf16_t*)(F.ws + WS_FDN1)); continue; } r -= I_DN;
        if (r < I_DN) { transpose_item(SrcPlain8{PIN(34), DM}, DFF, wdn2, scr, r, F.lane, DM / 32, (bf16_t*)(F.ws + WS_FDN2)); continue; } r -= I_DN;
        if (r < I_IN) { transpose_item(SrcWin{PIN(17)}, DM, win, scr, r, F.lane, ZP / 32, (bf16_t*)(F.ws + WS_FG), ZG); continue; } r -= I_IN;
        if (r < I_P) { transpose_item(SrcPlain8{PIN(22), DM}, 2048, wpa, scr, r, F.lane, DM / 32, (bf16_t*)(F.ws + WS_FPA)); continue; } r -= I_P;
        if (r < I_P) { transpose_item(SrcPlain8{PIN(29), DM}, 2048, wpb, scr, r, F.lane, DM / 32, (bf16_t*)(F.ws + WS_FPB)); continue; } r -= I_P;
        transpose_item(SrcPlain8{PIN(30), DM}, DM, wout, scr, r, F.lane, DM / 32, (bf16_t*)(F.ws + WS_FOUT));
    }
    __syncthreads();
}
__device__ __forceinline__ void phase_silu_c(Frame& F, const Params& p) {
    const int ch = F.bx * NTHREADS + F.tid;
    if (ch < 144 * 128) { const int r = ch >> 7, k = 8 * (ch & 127); float x[8];
        if (r < NBID) { const float* cr = (r < NBP ? PIN(2) + (size_t)r * DM : PIN(3) + (size_t)(r - NBP) * DM) + k; const f32x4 c0 = *(const f32x4*)cr, c1 = *(const f32x4*)(cr + 4);
#pragma unroll
            for (int e = 0; e < 4; ++e) { x[e] = siluf_(c0[e]); x[4 + e] = siluf_(c1[e]); } }
        else {
#pragma unroll
            for (int e = 0; e < 8; ++e) x[e] = 0.f; }
        *(u32x4*)((bf16_t*)(F.ws + WS_SC) + fo_index(r, k, DM)) = pack8(x, 1.0f); }
}
__device__ __forceinline__ void phase_adaln(Frame& F, const Params& p) {
    const float* ada_w = PIN(10); const float* ada_b = PIN(11); float* mod = (float*)(F.ws + WS_MOD); const bf16_t* SCF = (const bf16_t*)(F.ws + WS_SC);
    LAS f32x4* PART = (LAS f32x4*)F.lds;
    const int lane = F.lane, w = F.wave, fr = lane & 15, fq = lane >> 4;
    const int t0 = F.bx < 64 ? 3 * F.bx : 192 + 2 * (F.bx - 64), nT = F.bx < 64 ? 3 : 2;
    f32x4 acc[3][9];
#pragma unroll
    for (int t = 0; t < 3; ++t)
#pragma unroll
        for (int rt = 0; rt < 9; ++rt) acc[t][rt] = (f32x4){0.f, 0.f, 0.f, 0.f};
#pragma unroll 1
    for (int ks = 0; ks < 4; ++ks) {
        const int k0 = 128 * w + 32 * ks + 8 * fq, kb = 4 * w + ks;
        bf16x8 af[9];
#pragma unroll
        for (int rt = 0; rt < 9; ++rt) af[rt] = *(const bf16x8*)(SCF + ((size_t)(rt * (DM / 32) + kb)) * 512 + 8 * lane);
#pragma unroll
        for (int t = 0; t < 3; ++t) if (t < nT) {
            float wv[8];
#pragma unroll
            for (int j = 0; j < 8; ++j) wv[j] = ada_w[(size_t)(k0 + j) * NMOD + 16 * (t0 + t) + fr];
            bf16x8 bfr; { const u32x4 tt = pack8(wv, 1.0f); bfr = __builtin_bit_cast(bf16x8, tt); }
#pragma unroll
            for (int rt = 0; rt < 9; ++rt) acc[t][rt] = __builtin_amdgcn_mfma_f32_16x16x32_bf16(af[rt], bfr, acc[t][rt], 0, 0, 0); }
    }
#pragma unroll
    for (int t = 0; t < 3; ++t) if (t < nT) {
        __syncthreads();
#pragma unroll
        for (int rt = 0; rt < 9; ++rt) PART[(w * 9 + rt) * 64 + lane] = acc[t][rt];
        __syncthreads();
        for (int idx = F.tid; idx < 9 * 64; idx += NTHREADS) { const int rt = idx >> 6, ln = idx & 63; f32x4 sum = PART[rt * 64 + ln];
#pragma unroll
            for (int ww = 1; ww < 8; ++ww) sum += PART[(ww * 9 + rt) * 64 + ln];
            const int n = 16 * (t0 + t) + (ln & 15); const float bv = ada_b[n];
#pragma unroll
            for (int r = 0; r < 4; ++r) { const int row = 16 * rt + 4 * (ln >> 4) + r; if (row < NBID) mod[(size_t)row * NMOD + n] = sum[r] + bv; } } }
}

__device__ __forceinline__ void phase_norm_mod(Frame& F, const float* xp, const float* xs, const float* gw, int shoff, int scoff, bf16_t* U) {
    const float* mod = (const float*)(F.ws + WS_MOD);
    const int gwv = F.bx * 8 + F.wave, NGW = F.G * 8;
    f32x4 g[4];
#pragma unroll
    for (int j = 0; j < 4; ++j) g[j] = *(const f32x4*)(gw + 4 * F.lane + 256 * j);
    for (int m = gwv; m < MT; m += NGW) {
        const float* xr = m < MP ? xp + (size_t)m * DM : xs + (size_t)(m - MP) * DM;
        const float* mr = mod + (size_t)pg8::bid_of_row(m) * NMOD;
        f32x4 v[4]; float s = 0.f;
#pragma unroll
        for (int j = 0; j < 4; ++j) { v[j] = *(const f32x4*)(xr + 4 * F.lane + 256 * j); s += (v[j][0] * v[j][0] + v[j][1] * v[j][1]) + (v[j][2] * v[j][2] + v[j][3] * v[j][3]); }
        const float r = 1.0f / sqrtf(wave_sum(s) * (1.0f / DM) + EPS);
#pragma unroll
        for (int j = 0; j < 4; ++j) { const f32x4 sh = *(const f32x4*)(mr + shoff + 4 * F.lane + 256 * j), scv = *(const f32x4*)(mr + scoff + 4 * F.lane + 256 * j);
            const f32x4 o = (v[j] * r * g[j]) * (1.0f + scv) + sh;
            *(unsigned*)((unsigned char*)U + (size_t)m * DM + 4 * F.lane + 256 * j) = pack4_fp8(o[0], o[1], o[2], o[3], F8_SA); }
    }
}
__device__ __forceinline__ void phase_final_norm(Frame& F, float* Y, const float* gw) {
    const int gwv = F.bx * 8 + F.wave, NGW = F.G * 8;
    f32x4 g[4];
#pragma unroll
    for (int j = 0; j < 4; ++j) g[j] = *(const f32x4*)(gw + 4 * F.lane + 256 * j);
    for (int m = gwv; m < MT; m += NGW) {
        float* xr = Y + (size_t)m * DM;
        f32x4 v[4]; float s = 0.f;
#pragma unroll
        for (int j = 0; j < 4; ++j) { v[j] = *(const f32x4*)(xr + 4 * F.lane + 256 * j); s += (v[j][0] * v[j][0] + v[j][1] * v[j][1]) + (v[j][2] * v[j][2] + v[j][3] * v[j][3]); }
        const float r = 1.0f / sqrtf(wave_sum(s) * (1.0f / DM) + EPS);
#pragma unroll
        for (int j = 0; j < 4; ++j) *(f32x4*)(xr + 4 * F.lane + 256 * j) = v[j] * r * g[j];
    }
}

constexpr size_t O_Y = 0, O_PC = 17825792, O_PN = 22020096, O_PM = 22028288, O_PMC = 22028320, O_PSSM = 22077472, O_PSC = 24174624,
                 O_SC = 24248352, O_SN = 91357216, O_SM = 91488288, O_SMC = 91488800, O_SSSM = 92275232, O_SSC = 125829664, O_END = 127009312;
constexpr int CVP = 5120;

__device__ __forceinline__ bf16x8 frag_row(LAS unsigned char* base, int stride, int row0, int k0, int lane) {
    return *(const LAS bf16x8*)(base + (row0 + (lane & 15)) * stride + (k0 + 8 * (lane >> 4)) * 2);
}
__device__ __forceinline__ bf16x8 frag_tr(LAS unsigned char* base, int stride, int krow0, int col0, int lane) {
    const int g = lane >> 4, q = (lane & 15) >> 2, pp = lane & 3;
    LAS unsigned char* a = base + (krow0 + 8 * g + q) * stride + (col0 + 4 * pp) * 2;
    const s16x4 lo = __builtin_amdgcn_ds_read_tr16_b64_v4i16((LAS s16x4*)a);
    const s16x4 hi = __builtin_amdgcn_ds_read_tr16_b64_v4i16((LAS s16x4*)(a + 4 * stride));
    return (bf16x8){lo.x, lo.y, lo.z, lo.w, hi.x, hi.y, hi.z, hi.w};
}
#define MFMA16(a, b, c) __builtin_amdgcn_mfma_f32_16x16x32_bf16((a), (b), (c), 0, 0, 0)

__device__ __forceinline__ float fast_log1pexp_neg(float ax) { return __builtin_amdgcn_logf(1.0f + fast_exp(-ax)) * 0.6931471805599453f; }
__device__ __forceinline__ float logsigmoidf_(float x) { return fminf(x, 0.f) - log1pf(expf(-fabsf(x))); }
__device__ __forceinline__ float softplusf_(float x) { return fmaxf(x, 0.f) + log1pf(expf(-fabsf(x))); }

__device__ __forceinline__ void conv_item(Frame& F, const Params& p, const int it) {
    const bf16_t* Z = (const bf16_t*)(F.ws + WS_ZIN); bf16_t* CV = (bf16_t*)(F.ws + WS_CV);
    const int lane = F.lane;
    {
        int m0, tb, nrows, strip; const float* hist = nullptr;
        if (it < 5120) { const int b = it / 640, r = it % 640; strip = r % 10; tb = (r / 10) * 32; m0 = b * SEQ; nrows = 32; }
        else { const int j = it - 5120, bs = j / 10; strip = j % 10; tb = 0; m0 = MP + bs * TS; nrows = 8; hist = strip < 4 ? PIN(7) + (size_t)bs * 3 * 2048 : PIN(9) + (size_t)bs * 3 * 3072; }
        const bool isM = strip < 4;
        const int c = strip * 512 + 8 * lane, zc = isM ? c : ZX + (c - 2048), cc = isM ? c : c - 2048, cs = isM ? 2048 : 3072;
        const float* cw = isM ? PIN(18) : PIN(23); const float* cb = isM ? PIN(19) : PIN(24);
        const float scl = (strip == 2 || strip == 3) ? 0.0625f : 1.0f;
        float w[4][8], bb[8], x0[8], x1[8], x2[8];
#pragma unroll
        for (int j = 0; j < 4; ++j) { const f32x4 a = *(const f32x4*)(cw + (size_t)j * cs + cc), b = *(const f32x4*)(cw + (size_t)j * cs + cc + 4);
#pragma unroll
            for (int e = 0; e < 4; ++e) { w[j][e] = a[e]; w[j][4 + e] = b[e]; } }
        { const f32x4 a = *(const f32x4*)(cb + cc), b = *(const f32x4*)(cb + cc + 4);
#pragma unroll
            for (int e = 0; e < 4; ++e) { bb[e] = a[e]; bb[4 + e] = b[e]; } }
        if (tb > 0) { unpack8(*(const u32x4*)(Z + (size_t)(m0 + tb - 3) * ZP + zc), x0); unpack8(*(const u32x4*)(Z + (size_t)(m0 + tb - 2) * ZP + zc), x1); unpack8(*(const u32x4*)(Z + (size_t)(m0 + tb - 1) * ZP + zc), x2); }
        else if (hist != nullptr) {
#pragma unroll
            for (int e = 0; e < 8; ++e) { x0[e] = hist[cc + e]; x1[e] = hist[cs + cc + e]; x2[e] = hist[2 * cs + cc + e]; } }
        else {
#pragma unroll
            for (int e = 0; e < 8; ++e) { x0[e] = 0.f; x1[e] = 0.f; x2[e] = 0.f; } }
        for (int t = 0; t < nrows; t += 8) {
            u32x4 raw[8];
#pragma unroll
            for (int i = 0; i < 8; ++i) raw[i] = *(const u32x4*)(Z + (size_t)(m0 + tb + t + i) * ZP + zc);
#pragma unroll
            for (int i = 0; i < 8; ++i) { float x3[8], o[8]; unpack8(raw[i], x3);
#pragma unroll
                for (int e = 0; e < 8; ++e) { o[e] = siluf_(bb[e] + w[0][e] * x0[e] + w[1][e] * x1[e] + w[2][e] * x2[e] + w[3][e] * x3[e]); x0[e] = x1[e]; x1[e] = x2[e]; x2[e] = x3[e]; }
                *(u32x4*)(CV + (size_t)(m0 + tb + t + i) * CVP + c) = pack8(o, scl); }
        }
    }
}
constexpr int NS_EARLY = 64;
__device__ __forceinline__ void phase_conv(Frame& F, const Params& p) {
    const int gw = F.bx * 8 + F.wave, NGW = F.G * 8;
    for (int it = gw; it < 5120 + 1280 - 10 * NS_EARLY; it += NGW) conv_item(F, p, it < 5120 ? it : it + 10 * NS_EARLY);
}

constexpr int QSTR = 528, VSTR = 144;
constexpr int L_QS = 0, L_KS = 33792, L_CT = 67584, L_VS = 101376, L_VW = 110592, L_SB = 119808, L_SCAL = 129024, L_NST = 132096, L_QNP = 133120, L_DENP = 135168, L_NUMB = 135680;

__device__ __forceinline__ float mlstm_scan(float ipre, float fpre, int lane, float mstate, LAS float* sc) {
    const float lf = fminf(fpre, 0.f) - fast_log1pexp_neg(fabsf(fpre));
    const float b = wave_scan_add(lf);
    const float a = ipre - b;
    const float cm = wave_scan_max(a);
    const float A = fmaxf(mstate, cm);
    const float Alast = __shfl(A, 63), blast = __shfl(b, 63);
    sc[lane] = a; sc[64 + lane] = A; sc[128 + lane] = fast_exp(mstate - A); sc[192 + lane] = fast_exp(-(b + A)); sc[256 + lane] = fast_exp(a - Alast);
    if (lane == 0) sc[320] = fast_exp(mstate - Alast);
    return blast + Alast;
}

__device__ __forceinline__ void mlstm_prompt_item(Frame& F, const Params& p, const int b, const int h, const int vs) {
    LAS unsigned char* L = F.lds;
    const int tid = F.tid, lane = F.lane, w = F.wave, fr = lane & 15, fq = lane >> 4;
    const bf16_t* Z = (const bf16_t*)(F.ws + WS_ZIN); const bf16_t* CV = (const bf16_t*)(F.ws + WS_CV); const float* GT = (const float*)(F.ws + WS_GATES);
    bf16_t* NUM = (bf16_t*)(F.ws + WS_NUM); float* DEN = (float*)(F.ws + WS_DEN);
    const float ifbi = PIN(20)[h], ifbf = PIN(20)[4 + h];
    constexpr int nch = SEQ / 64; const int m0 = b * SEQ;
    LAS float* SC = (LAS float*)(L + L_SCAL); LAS unsigned char* NSTB = L + L_NST; LAS float* DENP = (LAS float*)(L + L_DENP);
    f32x4 cacc[2][4];
#pragma unroll
    for (int dt = 0; dt < 2; ++dt)
#pragma unroll
        for (int vi = 0; vi < 4; ++vi) cacc[dt][vi] = (f32x4){0.f, 0.f, 0.f, 0.f};
    f32x4 nacc[2] = {{0.f, 0.f, 0.f, 0.f}, {0.f, 0.f, 0.f, 0.f}};
    float mstate = 0.f;
    u32x4 pq[4], pk[4], pv; float gi = 0.f, gf = 0.f;
    const bf16_t* qsrc = CV + (size_t)(m0 + (tid >> 5)) * CVP + h * 256 + 8 * (tid & 31);
    const bf16_t* vsrc = Z + (size_t)(m0 + (tid >> 3)) * ZP + ZV + h * 512 + vs * 64 + 8 * (tid & 7);
    const float* gsrc = GT + (size_t)(m0 + lane) * 64 + h;
#define ML_LOAD(c) do { _Pragma("unroll") for (int i = 0; i < 4; ++i) { pq[i] = *(const u32x4*)(qsrc + (size_t)((c) * 64 + 16 * i) * CVP); pk[i] = *(const u32x4*)(qsrc + (size_t)((c) * 64 + 16 * i) * CVP + 1024); } \
        pv = *(const u32x4*)(vsrc + (size_t)((c) * 64) * ZP); if (w == 0) { gi = gsrc[(size_t)((c) * 64) * 64]; gf = gsrc[(size_t)((c) * 64) * 64 + 4]; } } while (0)
    u32x4 numst = {0u, 0u, 0u, 0u}; float denst = 0.f;
    bf16_t* numdst = NUM + (size_t)(m0 + (tid >> 3)) * 2048 + h * 512 + vs * 64 + 8 * (tid & 7);
#define ML_STORE(c) do { *(u32x4*)(numdst + (size_t)((c) * 64) * 2048) = numst; \
        if (vs == 0 && w < 4 && fq == 0) DEN[(size_t)(m0 + (c) * 64 + 16 * w + fr) * 4 + h] = denst; } while (0)
    ML_LOAD(0);
    __syncthreads();
#pragma unroll
    for (int dt = 0; dt < 2; ++dt)
#pragma unroll
        for (int vi = 0; vi < 4; ++vi) *(LAS u32x2*)(L + L_CT + (16 * vi + fr) * QSTR + (32 * w + 16 * dt + 4 * fq) * 2) = (u32x2){0u, 0u};
    if (tid < 128) *(LAS unsigned*)(NSTB + 4 * tid) = 0u;
    if (w == 0) mstate = mlstm_scan(gi + ifbi, gf + ifbf, lane, mstate, SC);
    __syncthreads();
    for (int c = 0; c < nch; ++c) {
        const int t0 = 64 * c; LAS float* sc = SC + (c & 1) * 384;
#pragma unroll
        for (int i = 0; i < 4; ++i) { const int v = tid + NTHREADS * i, row = v >> 5, c16 = v & 31; *(LAS u32x4*)(L + L_QS + row * QSTR + 16 * c16) = pq[i]; *(LAS u32x4*)(L + L_KS + row * QSTR + 16 * c16) = pk[i]; }
        { const int row = tid >> 3, c8 = tid & 7; *(LAS u32x4*)(L + L_VS + row * VSTR + 16 * c8) = pv; float x[8]; unpack8(pv, x); *(LAS u32x4*)(L + L_VW + row * VSTR + 16 * c8) = pack8(x, sc[256 + row]); }
        __syncthreads();
        if (c > 0) { ML_STORE(c - 1); }
        if (c + 1 < nch) ML_LOAD(c + 1);
        const int ti = w & 3, hf = w >> 2;
        bf16x8 qf[8];
#pragma unroll
        for (int k = 0; k < 8; ++k) qf[k] = frag_row(L + L_QS, QSTR, 16 * ti, 32 * k, lane);
        { f32x4 sacc[2] = {{0.f, 0.f, 0.f, 0.f}, {0.f, 0.f, 0.f, 0.f}};
#pragma unroll
          for (int j = 0; j < 2; ++j) { const int si = 2 * hf + j; if (si <= ti) {
#pragma unroll
                  for (int k = 0; k < 8; ++k) sacc[j] = MFMA16(frag_row(L + L_KS, QSTR, 16 * si, 32 * k, lane), qf[k], sacc[j]); } }
          const int t = 16 * ti + fr; const float At = sc[64 + t]; float dpart = 0.f;
#pragma unroll
          for (int j = 0; j < 2; ++j) { const int si = 2 * hf + j, s0 = 16 * si + 4 * fq; const f32x4 av = *(const LAS f32x4*)(sc + s0); f32x4 vv;
#pragma unroll
              for (int r = 0; r < 4; ++r) { const float wgt = (s0 + r <= t) ? fast_exp(av[r] - At) : 0.f; vv[r] = (si <= ti) ? sacc[j][r] * wgt : 0.f; dpart += vv[r]; }
              *(LAS u32x2*)(L + L_SB + t * VSTR + s0 * 2) = pack4(vv); }
          dpart += __shfl_xor(dpart, 16); dpart += __shfl_xor(dpart, 32);
          if (lane < 16) DENP[hf * 64 + 16 * ti + lane] = dpart; }
        __syncthreads();
        { f32x4 uacc[2] = {{0.f, 0.f, 0.f, 0.f}, {0.f, 0.f, 0.f, 0.f}};
#pragma unroll
          for (int j = 0; j < 2; ++j) { const int vi = 2 * hf + j;
#pragma unroll
              for (int k = 0; k < 8; ++k) uacc[j] = MFMA16(frag_row(L + L_CT, QSTR, 16 * vi, 32 * k, lane), qf[k], uacc[j]); }
          const float wst = sc[128 + 16 * ti + fr]; uacc[0] *= wst; uacc[1] *= wst;
#pragma unroll
          for (int ks = 0; ks < 2; ++ks) if (32 * ks <= 16 * ti + 15) { const bf16x8 sb = frag_row(L + L_SB, VSTR, 16 * ti, 32 * ks, lane);
#pragma unroll
              for (int j = 0; j < 2; ++j) uacc[j] = MFMA16(frag_tr(L + L_VS, VSTR, 32 * ks, 16 * (2 * hf + j), lane), sb, uacc[j]); }
#pragma unroll
          for (int j = 0; j < 2; ++j) *(LAS u32x2*)(L + L_NUMB + (16 * ti + fr) * VSTR + (16 * (2 * hf + j) + 4 * fq) * 2) = pack4(uacc[j]); }
        if (vs == 0 && hf == 0) {
            f32x4 qn = {0.f, 0.f, 0.f, 0.f};
#pragma unroll
            for (int k = 0; k < 8; ++k) { u32x4 nv = *(const LAS u32x4*)(NSTB + 64 * k + 16 * fq); if (fr != 0) nv = (u32x4){0u, 0u, 0u, 0u};
                qn = MFMA16(__builtin_bit_cast(bf16x8, nv), qf[k], qn); }
            const int t = 16 * ti + fr; const float den = DENP[t] + DENP[64 + t] + sc[128 + t] * qn[0];
            denst = fmaxf(fabsf(den), sc[192 + t]); }
        { const float decay = sc[320];
#pragma unroll
          for (int dt = 0; dt < 2; ++dt)
#pragma unroll
              for (int vi = 0; vi < 4; ++vi) cacc[dt][vi] *= decay;
#pragma unroll
          for (int ks = 0; ks < 2; ++ks) { bf16x8 ka[2];
#pragma unroll
              for (int dt = 0; dt < 2; ++dt) ka[dt] = frag_tr(L + L_KS, QSTR, 32 * ks, 32 * w + 16 * dt, lane);
#pragma unroll
              for (int vi = 0; vi < 4; ++vi) { const bf16x8 vb = frag_tr(L + L_VW, VSTR, 32 * ks, 16 * vi, lane);
#pragma unroll
                  for (int dt = 0; dt < 2; ++dt) cacc[dt][vi] = MFMA16(ka[dt], vb, cacc[dt][vi]); } }
          if (vs == 0) { nacc[0] *= decay; nacc[1] *= decay;
#pragma unroll
              for (int ks = 0; ks < 2; ++ks) { const f32x4 w0 = *(const LAS f32x4*)(sc + 256 + 32 * ks + 8 * fq), w1 = *(const LAS f32x4*)(sc + 256 + 32 * ks + 8 * fq + 4);
                  u32x4 wv; wv.x = cvt_pk_bf16(w0[0], w0[1]); wv.y = cvt_pk_bf16(w0[2], w0[3]); wv.z = cvt_pk_bf16(w1[0], w1[1]); wv.w = cvt_pk_bf16(w1[2], w1[3]);
                  if (fr != 0) wv = (u32x4){0u, 0u, 0u, 0u};
#pragma unroll
                  for (int dt = 0; dt < 2; ++dt) nacc[dt] = MFMA16(frag_tr(L + L_KS, QSTR, 32 * ks, 32 * w + 16 * dt, lane), __builtin_bit_cast(bf16x8, wv), nacc[dt]); } } }
        if (w == 0 && c + 1 < nch) mstate = mlstm_scan(gi + ifbi, gf + ifbf, lane, mstate, SC + ((c + 1) & 1) * 384);
        __syncthreads();
        numst = *(const LAS u32x4*)(L + L_NUMB + (tid >> 3) * VSTR + 16 * (tid & 7));
#pragma unroll
        for (int dt = 0; dt < 2; ++dt)
#pragma unroll
            for (int vi = 0; vi < 4; ++vi) *(LAS u32x2*)(L + L_CT + (16 * vi + fr) * QSTR + (32 * w + 16 * dt + 4 * fq) * 2) = pack4(cacc[dt][vi]);
        if (vs == 0 && fr == 0) {
#pragma unroll
            for (int dt = 0; dt < 2; ++dt) *(LAS u32x2*)(NSTB + (32 * w + 16 * dt + 4 * fq) * 2) = pack4(nacc[dt]); }
    }
    ML_STORE(nch - 1);
#undef ML_LOAD
#undef ML_STORE
    float* Cout = F.out + O_PC + (size_t)(b * 4 + h) * 131072;
#pragma unroll
    for (int dt = 0; dt < 2; ++dt)
#pragma unroll
        for (int vi = 0; vi < 4; ++vi)
#pragma unroll
            for (int r = 0; r < 4; ++r) { const int d = 32 * w + 16 * dt + 4 * fq + r, v = 16 * vi + fr; Cout[(size_t)d * 512 + vs * 64 + v] = cacc[dt][vi][r]; }
    if (vs == 0) { if (fr == 0) {
#pragma unroll
            for (int dt = 0; dt < 2; ++dt)
#pragma unroll
                for (int r = 0; r < 4; ++r) F.out[O_PN + (size_t)(b * 4 + h) * 256 + 32 * w + 16 * dt + 4 * fq + r] = nacc[dt][r]; }
        if (tid == 0) F.out[O_PM + b * 4 + h] = mstate; }
}

constexpr int XSTR = 144, BSTR = 272;
constexpr int S_XS = 0, S_XD = 9216, S_XW = 18432, S_BS = 27648, S_CS = 45056, S_HS = 62464, S_GB = 79872, S_SCAL = 89088, S_YB = 98304;

__device__ __forceinline__ void ssd_scan(float dtp, float Ae, int lane, LAS float* sc) {
    const float dt = fmaxf(dtp, 0.f) + fast_log1pexp_neg(fabsf(dtp));
    const float cum = wave_scan_add(dt * Ae);
    const float cl = __shfl(cum, 63);
    sc[lane] = cum; sc[64 + lane] = dt; sc[128 + lane] = fast_exp(cl - cum); sc[192 + lane] = fast_exp(cum);
    if (lane == 0) sc[256] = fast_exp(cl);
}

__device__ __forceinline__ void ssd_prompt_item(Frame& F, const Params& p, const int b, const int e) {
    LAS unsigned char* L = F.lds;
    const int tid = F.tid, lane = F.lane, w = F.wave, fr = lane & 15, fq = lane >> 4;
    const bf16_t* CV = (const bf16_t*)(F.ws + WS_CV); const float* GT = (const float*)(F.ws + WS_GATES);
    bf16_t* YS = (bf16_t*)(F.ws + WS_YS);
    const int g = e >> 3, m0 = b * SEQ; constexpr int nch = SEQ / 64;
    const float dtb = PIN(25)[e], Ae = -expf(PIN(26)[e]), De = PIN(27)[e];
    LAS float* SC = (LAS float*)(L + S_SCAL);
    f32x4 hacc[4];
#pragma unroll
    for (int pi = 0; pi < 4; ++pi) hacc[pi] = (f32x4){0.f, 0.f, 0.f, 0.f};
    u32x4 px, pb[2], pc[2]; float gd = 0.f;
    const bf16_t* xsrc = CV + (size_t)(m0 + (tid >> 3)) * CVP + 2048 + e * 64 + 8 * (tid & 7);
    const bf16_t* bsrc = CV + (size_t)(m0 + (tid >> 4)) * CVP + 4096 + g * 128 + 8 * (tid & 15);
    const float* gsrc = GT + (size_t)(m0 + lane) * 64 + 8 + e;
#define SD_LOAD(c) do { px = *(const u32x4*)(xsrc + (size_t)((c) * 64) * CVP); _Pragma("unroll") for (int i = 0; i < 2; ++i) { pb[i] = *(const u32x4*)(bsrc + (size_t)((c) * 64 + 32 * i) * CVP); pc[i] = *(const u32x4*)(bsrc + (size_t)((c) * 64 + 32 * i) * CVP + 512); } \
        if (w == 0) gd = gsrc[(size_t)((c) * 64) * 64]; } while (0)
    u32x4 yst = {0u, 0u, 0u, 0u};
    bf16_t* ydst = YS + (size_t)(m0 + (tid >> 3)) * 2048 + e * 64 + 8 * (tid & 7);
#define SD_STORE(c) do { *(u32x4*)(ydst + (size_t)((c) * 64) * 2048) = yst; } while (0)
    SD_LOAD(0);
    __syncthreads();
#pragma unroll
    for (int pi = 0; pi < 4; ++pi) *(LAS u32x2*)(L + S_HS + (16 * pi + fr) * BSTR + (16 * w + 4 * fq) * 2) = (u32x2){0u, 0u};
    if (w == 0) ssd_scan(gd + dtb, Ae, lane, SC);
    __syncthreads();
    for (int c = 0; c < nch; ++c) {
        const int t0 = 64 * c; LAS float* sc = SC + (c & 1) * 320;
        { const int row = tid >> 3, c8 = tid & 7; const float dt = sc[64 + row], ed = sc[128 + row]; float x[8]; unpack8(px, x);
          *(LAS u32x4*)(L + S_XS + row * XSTR + 16 * c8) = px; *(LAS u32x4*)(L + S_XD + row * XSTR + 16 * c8) = pack8(x, dt); *(LAS u32x4*)(L + S_XW + row * XSTR + 16 * c8) = pack8(x, dt * ed); }
#pragma unroll
        for (int i = 0; i < 2; ++i) { const int row = (tid >> 4) + 32 * i, c16 = tid & 15; *(LAS u32x4*)(L + S_BS + row * BSTR + 16 * c16) = pb[i]; *(LAS u32x4*)(L + S_CS + row * BSTR + 16 * c16) = pc[i]; }
        __syncthreads();
        if (c > 0) { SD_STORE(c - 1); }
        if (c + 1 < nch) SD_LOAD(c + 1);
        const int ti = w & 3, hf = w >> 2;
        bf16x8 cf[4];
#pragma unroll
        for (int k = 0; k < 4; ++k) cf[k] = frag_row(L + S_CS, BSTR, 16 * ti, 32 * k, lane);
        { f32x4 gacc[2] = {{0.f, 0.f, 0.f, 0.f}, {0.f, 0.f, 0.f, 0.f}};
#pragma unroll
          for (int j = 0; j < 2; ++j) { const int si = 2 * hf + j; if (si <= ti) {
#pragma unroll
                  for (int k = 0; k < 4; ++k) gacc[j] = MFMA16(frag_row(L + S_BS, BSTR, 16 * si, 32 * k, lane), cf[k], gacc[j]); } }
          const int t = 16 * ti + fr; const float cumt = sc[t];
#pragma unroll
          for (int j = 0; j < 2; ++j) { const int si = 2 * hf + j, s0 = 16 * si + 4 * fq; const f32x4 cs = *(const LAS f32x4*)(sc + s0); f32x4 vv;
#pragma unroll
              for (int r = 0; r < 4; ++r) vv[r] = (si <= ti && s0 + r <= t) ? gacc[j][r] * fast_exp(cumt - cs[r]) : 0.f;
              *(LAS u32x2*)(L + S_GB + t * XSTR + s0 * 2) = pack4(vv); } }
        __syncthreads();
        { f32x4 yacc[2] = {{0.f, 0.f, 0.f, 0.f}, {0.f, 0.f, 0.f, 0.f}};
#pragma unroll
          for (int j = 0; j < 2; ++j) { const int pi = 2 * hf + j;
#pragma unroll
              for (int k = 0; k < 4; ++k) yacc[j] = MFMA16(frag_row(L + S_HS, BSTR, 16 * pi, 32 * k, lane), cf[k], yacc[j]); }
          const int t = 16 * ti + fr; const float ec = sc[192 + t]; yacc[0] *= ec; yacc[1] *= ec;
#pragma unroll
          for (int ks = 0; ks < 2; ++ks) if (32 * ks <= 16 * ti + 15) { const bf16x8 gb = frag_row(L + S_GB, XSTR, 16 * ti, 32 * ks, lane);
#pragma unroll
              for (int j = 0; j < 2; ++j) yacc[j] = MFMA16(frag_tr(L + S_XD, XSTR, 32 * ks, 16 * (2 * hf + j), lane), gb, yacc[j]); }
#pragma unroll
          for (int j = 0; j < 2; ++j) { const int p0 = 16 * (2 * hf + j) + 4 * fq; const u32x2 xv = *(const LAS u32x2*)(L + S_XS + t * XSTR + p0 * 2);
              f32x4 y = yacc[j]; y[0] += De * bflo(xv.x); y[1] += De * bfhi(xv.x); y[2] += De * bflo(xv.y); y[3] += De * bfhi(xv.y);
              *(LAS u32x2*)(L + S_YB + t * XSTR + p0 * 2) = pack4(y); } }
        { const float eall = sc[256];
#pragma unroll
          for (int pi = 0; pi < 4; ++pi) hacc[pi] *= eall;
#pragma unroll
          for (int ks = 0; ks < 2; ++ks) { const bf16x8 ba = frag_tr(L + S_BS, BSTR, 32 * ks, 16 * w, lane);
#pragma unroll
              for (int pi = 0; pi < 4; ++pi) hacc[pi] = MFMA16(ba, frag_tr(L + S_XW, XSTR, 32 * ks, 16 * pi, lane), hacc[pi]); } }
        if (w == 0 && c + 1 < nch) ssd_scan(gd + dtb, Ae, lane, SC + ((c + 1) & 1) * 320);
        __syncthreads();
        yst = *(const LAS u32x4*)(L + S_YB + (tid >> 3) * XSTR + 16 * (tid & 7));
#pragma unroll
        for (int pi = 0; pi < 4; ++pi) *(LAS u32x2*)(L + S_HS + (16 * pi + fr) * BSTR + (16 * w + 4 * fq) * 2) = pack4(hacc[pi]);
    }
    SD_STORE(nch - 1);
#undef SD_LOAD
#undef SD_STORE
    float* hout = F.out + O_PSSM + (size_t)(b * 32 + e) * 8192;
#pragma unroll
    for (int pi = 0; pi < 4; ++pi) *(f32x4*)(hout + (size_t)(16 * pi + fr) * 128 + 16 * w + 4 * fq) = hacc[pi];
}

__device__ __forceinline__ void mlstm_sample_item(Frame& F, const Params& p, const int bs, const int h) {
    LAS unsigned char* L = F.lds; const int tid = F.tid, lane = F.lane, w = F.wave;
    const bf16_t* Z = (const bf16_t*)(F.ws + WS_ZIN); const bf16_t* CV = (const bf16_t*)(F.ws + WS_CV); const float* GT = (const float*)(F.ws + WS_GATES);
    bf16_t* NUM = (bf16_t*)(F.ws + WS_NUM); float* DEN = (float*)(F.ws + WS_DEN);
    const int m0 = MP + bs * TS;
    const float* C0 = PIN(4) + (size_t)(bs * 4 + h) * 131072; float* C1 = F.out + O_SC + (size_t)(bs * 4 + h) * 131072;
    LAS float* QKW = (LAS float*)L; LAS float* RED = (LAS float*)(L + 16384); LAS float* NS = (LAS float*)(L + 81920);
    LAS float* SCs = (LAS float*)(L + 82944); LAS float* SW = (LAS float*)(L + 83200); LAS float* QN = (LAS float*)(L + 83456);
    const int v4 = tid & 127, dp = tid >> 7;
    f32x4 vreg[8];
#pragma unroll
    for (int s = 0; s < 8; ++s) { const u32x2 vv = *(const u32x2*)(Z + (size_t)(m0 + s) * ZP + ZV + h * 512 + 4 * v4); vreg[s] = (f32x4){bflo(vv.x), bfhi(vv.x), bflo(vv.y), bfhi(vv.y)}; }
    const u32x4 qk = *(const u32x4*)(CV + (size_t)(m0 + ((tid >> 5) & 7)) * CVP + (tid >> 8) * 1024 + h * 256 + 8 * (tid & 31));
    const float n0v = tid < 256 ? PIN(5)[(size_t)(bs * 4 + h) * 256 + tid] : 0.f;
    __syncthreads();
    { const int isk = tid >> 8, t = (tid >> 5) & 7, c16 = tid & 31; float x[8]; unpack8(qk, x);
#pragma unroll
      for (int e = 0; e < 8; ++e) QKW[(8 * c16 + e) * 16 + isk * 8 + t] = x[e]; }
    if (tid < 256) NS[tid] = n0v;
    if (w == 0) {
        const bool valid = lane < 8; const float mstate = PIN(6)[bs * 4 + h];
        float ipre = 0.f, fpre = 0.f; if (valid) { ipre = GT[(size_t)(m0 + lane) * 64 + h] + PIN(20)[h]; fpre = GT[(size_t)(m0 + lane) * 64 + 4 + h] + PIN(20)[4 + h]; }
        float bsum = valid ? logsigmoidf_(fpre) : 0.f;
#pragma unroll
        for (int o = 1; o < 8; o <<= 1) { const float u = __shfl_up(bsum, o); if (lane >= o) bsum += u; }
        const float a = valid ? ipre - bsum : -INFINITY;
        float cm = a;
#pragma unroll
        for (int o = 1; o < 8; o <<= 1) { const float u = __shfl_up(cm, o); if (lane >= o) cm = fmaxf(cm, u); }
        const float A = fmaxf(mstate, cm); const float Alast = __shfl(A, 7), blast = __shfl(bsum, 7);
        if (valid) { SCs[lane] = a; SCs[8 + lane] = A; SCs[16 + lane] = expf(mstate - A); SCs[24 + lane] = expf(-(bsum + A)); SCs[32 + lane] = expf(a - Alast); }
        if (lane == 0) { SCs[40] = expf(mstate - Alast); F.out[O_SM + bs * 4 + h] = blast + Alast; }
    }
    __syncthreads();
    { const int pr = tid >> 3, part = tid & 7, t = pr >> 3, s = pr & 7; float acc = 0.f;
#pragma unroll 8
      for (int dd = 0; dd < 32; ++dd) { const int d = part * 32 + dd; acc += QKW[d * 16 + t] * QKW[d * 16 + 8 + s]; }
      acc += __shfl_xor(acc, 1); acc += __shfl_xor(acc, 2); acc += __shfl_xor(acc, 4);
      if (part == 0) SW[t * 8 + s] = (s <= t) ? acc * expf(SCs[s] - SCs[8 + t]) : 0.f; }
    if (tid < 64) { const int t = tid >> 3, part = tid & 7; float acc = 0.f;
#pragma unroll 8
      for (int dd = 0; dd < 32; ++dd) { const int d = part * 32 + dd; acc += QKW[d * 16 + t] * NS[d]; }
      acc += __shfl_xor(acc, 1); acc += __shfl_xor(acc, 2); acc += __shfl_xor(acc, 4);
      if (part == 0) QN[t] = acc; }
    if (tid >= 256) { const int d = tid - 256; float s = 0.f;
#pragma unroll
        for (int si = 0; si < 8; ++si) s += SCs[32 + si] * QKW[d * 16 + 8 + si];
        F.out[O_SN + (size_t)(bs * 4 + h) * 256 + d] = SCs[40] * NS[d] + s; }
    __syncthreads();
    if (tid < 8) { const int t = tid; float den = 0.f;
#pragma unroll
        for (int s = 0; s < 8; ++s) den += SW[t * 8 + s];
        den += SCs[16 + t] * QN[t]; DEN[(size_t)(m0 + t) * 4 + h] = fmaxf(fabsf(den), SCs[24 + t]); }
    if (tid >= 256) { const int d = tid - 256;
#pragma unroll
        for (int si = 0; si < 8; ++si) QKW[d * 16 + 8 + si] *= SCs[32 + si]; }
    __syncthreads();
    { const float decay = SCs[40];
      f32x4 acc[8];
#pragma unroll
      for (int t = 0; t < 8; ++t) acc[t] = (f32x4){0.f, 0.f, 0.f, 0.f};
      const float* cin = C0 + (size_t)(dp * 64) * 512 + 4 * v4; float* cout = C1 + (size_t)(dp * 64) * 512 + 4 * v4;
#pragma unroll 1
      for (int d0 = 0; d0 < 64; d0 += 8) {
          f32x4 cc[8];
#pragma unroll
          for (int i = 0; i < 8; ++i) cc[i] = __builtin_nontemporal_load((const f32x4*)(cin + (size_t)(d0 + i) * 512));
#pragma unroll
          for (int i = 0; i < 8; ++i) { const LAS float* qp = QKW + (dp * 64 + d0 + i) * 16;
              const f32x4 q0 = *(const LAS f32x4*)qp, q1 = *(const LAS f32x4*)(qp + 4), k0 = *(const LAS f32x4*)(qp + 8), k1 = *(const LAS f32x4*)(qp + 12);
              f32x4 cn = decay * cc[i];
#pragma unroll
              for (int t = 0; t < 4; ++t) { acc[t] += q0[t] * cc[i]; acc[4 + t] += q1[t] * cc[i]; cn += k0[t] * vreg[t]; cn += k1[t] * vreg[4 + t]; }
              __builtin_nontemporal_store(cn, (f32x4*)(cout + (size_t)(d0 + i) * 512)); }
      }
#pragma unroll
      for (int t = 0; t < 8; ++t) *(LAS f32x4*)(RED + (size_t)(dp * 8 + t) * 512 + 4 * v4) = acc[t]; }
    __syncthreads();
    { const int t = tid >> 6, v8 = tid & 63; float s[8];
#pragma unroll
      for (int e = 0; e < 8; ++e) s[e] = 0.f;
#pragma unroll
      for (int dpp = 0; dpp < 4; ++dpp) { const f32x4 a = *(const LAS f32x4*)(RED + (size_t)(dpp * 8 + t) * 512 + 8 * v8), b = *(const LAS f32x4*)(RED + (size_t)(dpp * 8 + t) * 512 + 8 * v8 + 4);
#pragma unroll
          for (int e = 0; e < 4; ++e) { s[e] += a[e]; s[4 + e] += b[e]; } }
      const float wst = SCs[16 + t];
#pragma unroll
      for (int e = 0; e < 8; ++e) s[e] *= wst;
      for (int si = 0; si <= t; ++si) { const float sw = SW[t * 8 + si]; float x[8]; unpack8(*(const u32x4*)(Z + (size_t)(m0 + si) * ZP + ZV + h * 512 + 8 * v8), x);
#pragma unroll
          for (int e = 0; e < 8; ++e) s[e] += sw * x[e]; }
      *(u32x4*)(NUM + (size_t)(m0 + t) * 2048 + h * 512 + 8 * v8) = pack8(s, 1.0f); }
}

__device__ __forceinline__ void ssd_sample_item(Frame& F, const Params& p, const int bs, const int g) {
    LAS unsigned char* L = F.lds; const int tid = F.tid, lane = F.lane, w = F.wave;
    const bf16_t* CV = (const bf16_t*)(F.ws + WS_CV); const float* GT = (const float*)(F.ws + WS_GATES); bf16_t* YS = (bf16_t*)(F.ws + WS_YS);
    const int m0 = MP + bs * TS;
    LAS float* BSf = (LAS float*)L; LAS float* CSf = (LAS float*)(L + 4096); LAS float* XF = (LAS float*)(L + 8192); LAS float* XWt = (LAS float*)(L + 24576);
    LAS float* XDt = (LAS float*)(L + 40960); LAS float* SC2 = (LAS float*)(L + 57344); LAS float* CB = (LAS float*)(L + 58432); LAS float* YP = (LAS float*)(L + 59392);
    const u32x4 xr = *(const u32x4*)(CV + (size_t)(m0 + (tid >> 6)) * CVP + 2048 + g * 512 + 8 * (tid & 63));
    u32x4 bcr = {0u, 0u, 0u, 0u};
    if (tid < 256) bcr = *(const u32x4*)(CV + (size_t)(m0 + ((tid >> 4) & 7)) * CVP + 4096 + (tid >> 7) * 512 + g * 128 + 8 * (tid & 15));
    __syncthreads();
    { float x[8]; unpack8(xr, x); const int t = tid >> 6, c8 = tid & 63;
#pragma unroll
      for (int e = 0; e < 8; ++e) XF[t * 512 + 8 * c8 + e] = x[e]; }
    if (tid < 256) { float x[8]; unpack8(bcr, x); const int isC = tid >> 7, t = (tid >> 4) & 7, c16 = tid & 15; LAS float* dst = isC ? CSf : BSf;
#pragma unroll
      for (int e = 0; e < 8; ++e) dst[t * 128 + 8 * c16 + e] = x[e]; }
    { const int e = g * 8 + w; const bool valid = lane < 8; const float Ae = -expf(PIN(26)[e]);
      const float dt = valid ? softplusf_(GT[(size_t)(m0 + lane) * 64 + 8 + e] + PIN(25)[e]) : 0.f;
      float cum = dt * Ae;
#pragma unroll
      for (int o = 1; o < 8; o <<= 1) { const float u = __shfl_up(cum, o); if (lane >= o) cum += u; }
      const float cl = __shfl(cum, 7);
      if (valid) { SC2[w * 32 + lane] = cum; SC2[w * 32 + 8 + lane] = dt; SC2[w * 32 + 16 + lane] = expf(cl - cum); SC2[w * 32 + 24 + lane] = expf(cum); }
      if (lane == 0) SC2[256 + w] = expf(cl); }
    __syncthreads();
    { const int pr = tid >> 3, part = tid & 7, t = pr >> 3, s = pr & 7; float acc = 0.f;
#pragma unroll
      for (int nn = 0; nn < 16; ++nn) { const int n = part * 16 + nn; acc += CSf[t * 128 + n] * BSf[s * 128 + n]; }
      acc += __shfl_xor(acc, 1); acc += __shfl_xor(acc, 2); acc += __shfl_xor(acc, 4);
      if (part == 0) CB[t * 8 + s] = acc; }
    { const int el = tid >> 6;
#pragma unroll
      for (int s = 0; s < 8; ++s) { const float x = XF[s * 512 + tid], dt = SC2[el * 32 + 8 + s], ed = SC2[el * 32 + 16 + s]; XDt[tid * 8 + s] = x * dt; XWt[tid * 8 + s] = x * dt * ed; } }
    __syncthreads();
    { const int n8 = tid & 15, prow = tid >> 4;
      float Bn[8][8], Cn[8][8];
#pragma unroll
      for (int s = 0; s < 8; ++s) { const f32x4 b0 = *(const LAS f32x4*)(BSf + s * 128 + 8 * n8), b1 = *(const LAS f32x4*)(BSf + s * 128 + 8 * n8 + 4), c0 = *(const LAS f32x4*)(CSf + s * 128 + 8 * n8), c1 = *(const LAS f32x4*)(CSf + s * 128 + 8 * n8 + 4);
#pragma unroll
          for (int j = 0; j < 4; ++j) { Bn[s][j] = b0[j]; Bn[s][4 + j] = b1[j]; Cn[s][j] = c0[j]; Cn[s][4 + j] = c1[j]; } }
      const float* hin = PIN(8) + (size_t)(bs * 32 + g * 8) * 8192 + 8 * n8; float* hout = F.out + O_SSSM + (size_t)(bs * 32 + g * 8) * 8192 + 8 * n8;
#pragma unroll 1
      for (int it = 0; it < 16; it += 2) {
          f32x4 hv[2][2];
#pragma unroll
          for (int u = 0; u < 2; ++u) { const int row = (it + u) * 32 + prow; hv[u][0] = __builtin_nontemporal_load((const f32x4*)(hin + (size_t)row * 128)); hv[u][1] = __builtin_nontemporal_load((const f32x4*)(hin + (size_t)row * 128 + 4)); }
#pragma unroll
          for (int u = 0; u < 2; ++u) { const int row = (it + u) * 32 + prow; const float eall = SC2[256 + (row >> 6)];
              const f32x4 xw0 = *(const LAS f32x4*)(XWt + row * 8), xw1 = *(const LAS f32x4*)(XWt + row * 8 + 4);
              float hh[8], hn[8], yp[8];
#pragma unroll
              for (int j = 0; j < 4; ++j) { hh[j] = hv[u][0][j]; hh[4 + j] = hv[u][1][j]; }
#pragma unroll
              for (int j = 0; j < 8; ++j) hn[j] = eall * hh[j];
#pragma unroll
              for (int s = 0; s < 8; ++s) { const float xw = s < 4 ? xw0[s & 3] : xw1[s & 3]; float y = 0.f;
#pragma unroll
                  for (int j = 0; j < 8; ++j) { hn[j] += xw * Bn[s][j]; y += Cn[s][j] * hh[j]; }
                  yp[s] = y; }
              f32x4 o0 = {hn[0], hn[1], hn[2], hn[3]}, o1 = {hn[4], hn[5], hn[6], hn[7]};
              __builtin_nontemporal_store(o0, (f32x4*)(hout + (size_t)row * 128)); __builtin_nontemporal_store(o1, (f32x4*)(hout + (size_t)row * 128 + 4));
#pragma unroll
              for (int s = 0; s < 8; ++s) { float y = yp[s]; y += __shfl_xor(y, 1); y += __shfl_xor(y, 2); y += __shfl_xor(y, 4); y += __shfl_xor(y, 8); yp[s] = y; }
              if (n8 == 0) { *(LAS f32x4*)(YP + row * 8) = (f32x4){yp[0], yp[1], yp[2], yp[3]}; *(LAS f32x4*)(YP + row * 8 + 4) = (f32x4){yp[4], yp[5], yp[6], yp[7]}; } }
      } }
    __syncthreads();
    { const int row = tid, el = row >> 6, pp = row & 63, e = g * 8 + el; const float De = PIN(27)[e];
#pragma unroll
      for (int t = 0; t < 8; ++t) { const float cumt = SC2[el * 32 + t]; float y = SC2[el * 32 + 24 + t] * YP[row * 8 + t];
#pragma unroll
          for (int s = 0; s < 8; ++s) if (s <= t) y += CB[t * 8 + s] * expf(cumt - SC2[el * 32 + s]) * XDt[row * 8 + s];
          y += De * XF[t * 512 + row];
          YS[(size_t)(m0 + t) * 2048 + e * 64 + pp] = (bf16_t)(cvt_pk_bf16(y, 0.f) & 0xffffu); } }
}

#ifndef IT_MASK
#define IT_MASK 15
#endif
__device__ __forceinline__ void phase_mixer(Frame& F, const Params& p, const int itm = IT_MASK) {
    if (itm & 1) { for (int it = F.bx; it < 256; it += F.G) { const int x = it & 7, j = it >> 3, pair = x * 4 + (j >> 3); mlstm_prompt_item(F, p, pair >> 2, pair & 3, j & 7); } }
    if (itm & 2) { for (int it = F.bx; it < 256; it += F.G) { const int x = it & 7, j = it >> 3, grp = x * 4 + (j >> 3); ssd_prompt_item(F, p, grp >> 2, (grp & 3) * 8 + (j & 7)); } }
    if (itm & 4) { for (int it = F.bx; it < 4 * (NBS - NS_EARLY); it += F.G) mlstm_sample_item(F, p, NS_EARLY + (it >> 2), it & 3); }
    if (itm & 8) { for (int it = F.bx; it < 4 * (NBS - NS_EARLY); it += F.G) ssd_sample_item(F, p, NS_EARLY + (it >> 2), it & 3); }
}

__device__ __forceinline__ void phase_finish(Frame& F, const Params& p) {
    const bf16_t* Z = (const bf16_t*)(F.ws + WS_ZIN); const bf16_t* NUM = (const bf16_t*)(F.ws + WS_NUM); const bf16_t* YS = (const bf16_t*)(F.ws + WS_YS);
    const float* DEN = (const float*)(F.ws + WS_DEN); bf16_t* HA = (bf16_t*)(F.ws + WS_HA); bf16_t* HB = (bf16_t*)(F.ws + WS_HB);
    const float* hg = PIN(21); const float* sg = PIN(28);
    const int gwv = F.bx * 8 + F.wave, NGW = F.G * 8, lane = F.lane;
    for (int m = gwv; m < MT; m += NGW) {
#pragma unroll
        for (int h = 0; h < 4; ++h) {
            float x[8], o[8], gz[8]; unpack8(*(const u32x4*)(NUM + (size_t)m * 2048 + h * 512 + 8 * lane), x);
            float s = 0.f;
#pragma unroll
            for (int e = 0; e < 8; ++e) s += x[e];
            const float mu = wave_sum(s) * (1.0f / 512.0f); float q = 0.f;
#pragma unroll
            for (int e = 0; e < 8; ++e) { x[e] -= mu; q += x[e] * x[e]; }
            const float var = wave_sum(q) * (1.0f / 512.0f), Dv = DEN[(size_t)m * 4 + h];
            const float rs = 1.0f / sqrtf(var + EPS * Dv * Dv);
            unpack8(*(const u32x4*)(Z + (size_t)m * ZP + ZO + h * 512 + 8 * lane), gz);
            const f32x4 g0 = *(const f32x4*)(hg + h * 512 + 8 * lane), g1 = *(const f32x4*)(hg + h * 512 + 8 * lane + 4);
#pragma unroll
            for (int e = 0; e < 8; ++e) o[e] = x[e] * rs * (e < 4 ? g0[e & 3] : g1[e & 3]) * sigmoidf_(gz[e]);
            if (m < MP) *(u32x2*)((unsigned char*)HA + (size_t)m * 2048 + h * 512 + 8 * lane) = (u32x2){pack4_fp8(o[0], o[1], o[2], o[3], F8_SA), pack4_fp8(o[4], o[5], o[6], o[7], F8_SA)};
            else *(u32x4*)(HA + (size_t)MP * 2048 + fo_index(m - MP, h * 512 + 8 * lane, 2048)) = pack8(o, 1.0f);
        }
#pragma unroll
        for (int gq = 0; gq < 4; ++gq) {
            float y[8], zz[8]; unpack8(*(const u32x4*)(YS + (size_t)m * 2048 + gq * 512 + 8 * lane), y); unpack8(*(const u32x4*)(Z + (size_t)m * ZP + ZZ + gq * 512 + 8 * lane), zz);
            float q = 0.f;
#pragma unroll
            for (int e = 0; e < 8; ++e) { y[e] *= siluf_(zz[e]); q += y[e] * y[e]; }
            const float rs = 1.0f / sqrtf(wave_sum(q) * (1.0f / 512.0f) + EPS);
            const f32x4 g0 = *(const f32x4*)(sg + gq * 512 + 8 * lane), g1 = *(const f32x4*)(sg + gq * 512 + 8 * lane + 4);
#pragma unroll
            for (int e = 0; e < 8; ++e) y[e] = y[e] * rs * (e < 4 ? g0[e & 3] : g1[e & 3]);
            if (m < MP) *(u32x2*)((unsigned char*)HB + (size_t)m * 2048 + gq * 512 + 8 * lane) = (u32x2){pack4_fp8(y[0], y[1], y[2], y[3], F8_SA), pack4_fp8(y[4], y[5], y[6], y[7], F8_SA)};
            else *(u32x4*)(HB + (size_t)MP * 2048 + fo_index(m - MP, gq * 512 + 8 * lane, 2048)) = pack8(y, 1.0f);
        }
    }
    const int gt = F.bx * NTHREADS + F.tid, NGT = F.G * NTHREADS;
    constexpr int N1 = NBP * 3 * 2048, N2 = NBS * 3 * 2048, N3 = NBP * 3 * 3072, N4 = NBS * 3 * 3072;
    for (int i = gt; i < N1 + N2 + N3 + N4; i += NGT) {
        int j = i;
        if (j < N1) { const int b = j / 6144, r = (j / 2048) % 3, ch = j % 2048; F.out[O_PMC + j] = bf2f(Z[(size_t)(b * SEQ + SEQ - 3 + r) * ZP + ch]); continue; } j -= N1;
        if (j < N2) { const int b = j / 6144, r = (j / 2048) % 3, ch = j % 2048; F.out[O_SMC + j] = bf2f(Z[(size_t)(MP + b * TS + TS - 3 + r) * ZP + ch]); continue; } j -= N2;
        if (j < N3) { const int b = j / 9216, r = (j / 3072) % 3, ch = j % 3072; F.out[O_PSC + j] = bf2f(Z[(size_t)(b * SEQ + SEQ - 3 + r) * ZP + ZX + ch]); continue; } j -= N3;
        { const int b = j / 9216, r = (j / 3072) % 3, ch = j % 3072; F.out[O_SSC + j] = bf2f(Z[(size_t)(MP + b * TS + TS - 3 + r) * ZP + ZX + ch]); }
    }
}


#ifndef STAG_LEVELS
#define STAG_LEVELS 8
#endif
#ifndef STAG_SLEEP
#define STAG_SLEEP 16
#endif
__device__ __forceinline__ void stagger_start(const Frame& F) { const int sl = (F.bx >> 3) & (STAG_LEVELS - 1); for (int q = 0; q < sl; ++q) __builtin_amdgcn_s_sleep(STAG_SLEEP); }

constexpr int LDS_BYTES = 147456;
constexpr int NPHASE = 15;

__global__ void __launch_bounds__(NTHREADS, 2) fwd_kernel(Params p) {
    extern __shared__ __attribute__((aligned(16))) unsigned char lds_raw[];
    Frame F;
    F.lds = (LAS unsigned char*)lds_raw;
    F.tid = threadIdx.x; F.lane = F.tid & 63; F.wave = __builtin_amdgcn_readfirstlane(F.tid >> 6);
    F.G = gridDim.x; F.bx = blockIdx.x;
    F.out = p.out; F.ws = p.ws;
    unsigned char* ws = p.ws;
    bf16_t* U = (bf16_t*)(ws + WS_U); bf16_t* H = (bf16_t*)(ws + WS_H); float* X1 = (float*)(ws + WS_X1);
    bf16_t* ZIN = (bf16_t*)(ws + WS_ZIN); float* GATES = (float*)(ws + WS_GATES); float* MOD = (float*)(ws + WS_MOD);
    const int lo = p.ph_lo, hi = p.ph_hi;
#ifndef PH_MASK
#define PH_MASK 0xfffff
#endif
#define IN(k) (((PH_MASK >> (k)) & 1) && lo <= (k) && (k) < hi)
#ifndef DUP_MASK
#define DUP_MASK 0
#endif
#define DUP(k) ((DUP_MASK >> (k)) & 1)
    volatile LAS unsigned* MISC = (volatile LAS unsigned*)(F.lds + LDS_BYTES - 64);
    if (F.tid < 16) MISC[F.tid] = 0u;
    if (F.tid == 0) { volatile LAS unsigned* T = (volatile LAS unsigned*)(F.lds + PTAB_OFF);
#pragma unroll
        for (int k = 0; k < 36; ++k) { const uint64_t a = (uint64_t)p.in[k]; T[2 * k] = (unsigned)a; T[2 * k + 1] = (unsigned)(a >> 32); } }
    __syncthreads();
    XcdBarrier bar; bar.bar = (unsigned*)(ws + WS_CTL); bar.x = 0; bar.st = nullptr;
    if (hi - lo > 1) bar = xcd_barrier_post((unsigned*)(ws + WS_CTL), MISC);
#define SEAM(k) do { if (IN(k) && IN((k) + 1)) { xcd_barrier(bar); } } while (0)

    if (IN(0)) { phase_silu_c(F, p); phase_prep<0>(F, p); if (hi - lo > 1) xcd_barrier(bar); phase_adaln(F, p); } SEAM(0);
    if (IN(1)) { phase_norm_mod(F, PIN(0), PIN(1), PIN(12), 0 * DM, 1 * DM, U); if (DUP(1)) phase_norm_mod(F, PIN(0), PIN(1), PIN(12), 0 * DM, 1 * DM, U); } SEAM(1);
    if (IN(2)) { pg8::Gemm g{U, U, (const bf16_t*)(ws + WS_WUP1), (const bf16_t*)(ws + WS_WUP1), DM / 2}; pg8::Order S;
        if (F.bx < 192) { stagger_start(F); S.init_from(MT, 2 * DFF, 192, F.bx, 0, 1496); } else { phase_prep<1>(F, p); S.init_from(MT, 2 * DFF, 64, F.bx - 192, 1496, 1496); }
        pg8::EpiSwiGLU E{H, F8_INV}; pg8::gemm_phase<pg8::EpiSwiGLU, true, pg8::Order, true>(F.lds, g, S, E); } SEAM(2);
    float* XS = (float*)(ws + WS_XS); unsigned* CNT = (unsigned*)(ws + WS_CTL) + CW_CNT; bf16_t* U2 = (bf16_t*)(ws + WS_U2);
    if (IN(3)) { stagger_start(F); pg8::Gemm g{H, H, (const bf16_t*)(ws + WS_WDN1), (const bf16_t*)(ws + WS_WDN1), DFF / 2}; pg8::Order S; S.init(MP, DM, F.G, F.bx, 0);
        pg8::EpiResidNorm<false> E{PIN(0), X1, MOD + 2 * DM, PIN(16), MOD + 3 * DM, MOD + 4 * DM, U, nullptr, XS, CNT, 0.5f * F8_INV, 0}; pg8::gemm_phase<pg8::EpiResidNorm<false>, true, pg8::Order, true>(F.lds, g, S, E);
        small_phase_resid_norm<DFF, false>(F, H, (const bf16_t*)(ws + WS_FDN1), PIN(1), X1, MOD + 2 * DM, 0.5f, PIN(16), MOD + 3 * DM, MOD + 4 * DM, U, nullptr, XS, CNT); } SEAM(3);
    if (IN(5)) {
        const pg8::Gemm g{U, U, (const bf16_t*)(ws + WS_WIN), (const bf16_t*)(ws + WS_WIN), DM}; const pg8::EpiZin E{ZIN, GATES};
        { stagger_start(F); const pg8::OrderSample S{F.bx}; pg8::gemm_phase<pg8::EpiZin, true, pg8::OrderSample>(F.lds, g, S, E); }
        if (F.bx >= 208 && F.bx < 224) small_gates_tile(F, U, (const bf16_t*)(ws + WS_FG), GATES, MP / 64 + (F.bx - 208));
        if (F.bx >= 224) { for (int k = 0; k < 4; ++k) small_gates_tile(F, U, (const bf16_t*)(ws + WS_FG), GATES, 4 * (F.bx - 224) + k); }
        xcd_barrier(bar);
        if (F.bx >= 192) {
            const int s0 = F.bx - 192;
            for (int k = F.wave; k < 10; k += 8) conv_item(F, p, 5120 + 10 * s0 + k);
            asm volatile("s_waitcnt vmcnt(0)" ::: "memory"); __syncthreads(); __builtin_amdgcn_fence(__ATOMIC_ACQUIRE, "agent");
#pragma unroll 1
            for (int k = 0; k < 4; ++k) mlstm_sample_item(F, p, s0, k);
#pragma unroll 1
            for (int k = 0; k < 4; ++k) ssd_sample_item(F, p, s0, k);
            for (int k = 0; k < 2; ++k) small_gates_tile(F, U, (const bf16_t*)(ws + WS_FG), GATES, 128 + 2 * s0 + k);
        } else stagger_start(F);
        __syncthreads();
        { const pg8::OrderPrompt S{F.bx}; pg8::gemm_phase<pg8::EpiZin, true, pg8::OrderPrompt>(F.lds, g, S, E); }
        } SEAM(5);
    if (IN(6)) { phase_conv(F, p); if (DUP(6)) phase_conv(F, p); } SEAM(6);
    #ifndef DUP_IT
#define DUP_IT 15
#endif
    if (IN(7)) { phase_mixer(F, p, p.itm); } SEAM(7);
    if (IN(8)) { phase_finish(F, p); if (DUP(8)) phase_finish(F, p); } SEAM(8);
    if (IN(9)) { stagger_start(F); pg8::Gemm g{(const bf16_t*)(ws + WS_HA), (const bf16_t*)(ws + WS_HB), (const bf16_t*)(ws + WS_WPA), (const bf16_t*)(ws + WS_WPB), 2048 / 2}; pg8::Order S; S.init(MP, DM, F.G, F.bx, 1);
        pg8::EpiMerge E{ZIN, (float*)(ws + WS_TMP), U, F8_INV}; pg8::gemm_phase<pg8::EpiMerge, true, pg8::Order, true>(F.lds, g, S, E);
        small_phase_merge(F, (const bf16_t*)(ws + WS_HA), (const bf16_t*)(ws + WS_HB), (const bf16_t*)(ws + WS_FPA), (const bf16_t*)(ws + WS_FPB), ZIN, U); } SEAM(9);
    if (IN(10)) { stagger_start(F); pg8::Gemm g{U, U, (const bf16_t*)(ws + WS_WOUT), (const bf16_t*)(ws + WS_WOUT), DM / 2}; pg8::Order S; S.init(MP, DM, F.G, F.bx, 0);
        pg8::EpiResidNorm<false> E{X1, X1, MOD + 5 * DM, PIN(31), MOD + 6 * DM, MOD + 7 * DM, U2, nullptr, XS + (size_t)MT * 16, CNT + CNT_STRIDE, 1.0f * F8_INV, 1}; pg8::gemm_phase<pg8::EpiResidNorm<false>, true, pg8::Order, true>(F.lds, g, S, E);
        small_phase_resid_norm<DM, false>(F, U, (const bf16_t*)(ws + WS_FOUT), X1 + (size_t)MP * DM, X1, MOD + 5 * DM, 1.0f, PIN(31), MOD + 6 * DM, MOD + 7 * DM, U2, nullptr, XS + (size_t)MT * 16, CNT + CNT_STRIDE); } SEAM(10);
    if (IN(12)) { stagger_start(F); pg8::Gemm g{U2, U2, (const bf16_t*)(ws + WS_WUP2), (const bf16_t*)(ws + WS_WUP2), DM / 2}; pg8::Order S; S.init(MT, 2 * DFF, F.G, F.bx, 0);
        pg8::EpiSwiGLU E{H, F8_INV}; pg8::gemm_phase<pg8::EpiSwiGLU, true, pg8::Order, true>(F.lds, g, S, E); } SEAM(12);
    if (IN(13)) { stagger_start(F); pg8::Gemm g{H, H, (const bf16_t*)(ws + WS_WDN2), (const bf16_t*)(ws + WS_WDN2), DFF / 2}; pg8::Order S; S.init(MP, DM, F.G, F.bx, 0);
        pg8::EpiResidNorm<true> E{X1, nullptr, MOD + 8 * DM, PIN(35), nullptr, nullptr, nullptr, p.out, XS + (size_t)2 * MT * 16, CNT + 2 * CNT_STRIDE, 0.5f * F8_INV, 0}; pg8::gemm_phase<pg8::EpiResidNorm<true>, true, pg8::Order, true>(F.lds, g, S, E);
        small_phase_resid_norm<DFF, true>(F, H, (const bf16_t*)(ws + WS_FDN2), X1 + (size_t)MP * DM, nullptr, MOD + 8 * DM, 0.5f, PIN(35), nullptr, nullptr, nullptr, p.out, XS + (size_t)2 * MT * 16, CNT + 2 * CNT_STRIDE); }
#undef IN
#undef SEAM
}

extern "C" void kernel_launch(void* const* d_in, const int* in_sizes, int n_in, void* d_out, int out_size, void* d_ws, size_t ws_size, hipStream_t stream) {
    static int grid = 0;
    if (grid == 0) {
        if (n_in != 36 || ws_size < WS_END) { fprintf(stderr, "kernel_launch: expected 36 inputs and >= %zu bytes of workspace (got %d, %zu)\n", (size_t)WS_END, n_in, ws_size); grid = -1; return; }
        int dev = 0, cus = 0, per_cu = 0;
        hipGetDevice(&dev); hipDeviceGetAttribute(&cus, hipDeviceAttributeMultiprocessorCount, dev);
        hipFuncSetAttribute((const void*)fwd_kernel, hipFuncAttributeMaxDynamicSharedMemorySize, LDS_BYTES);
        hipOccupancyMaxActiveBlocksPerMultiprocessor(&per_cu, (const void*)fwd_kernel, NTHREADS, LDS_BYTES);
        if (per_cu < 1) { fprintf(stderr, "kernel_launch: occupancy query says %d blocks per CU\n", per_cu); grid = -1; return; }
        grid = cus;
        if (grid != 256) { fprintf(stderr, "kernel_launch: the fused-norm GEMM epilogues need exactly 256 workgroups (one 256x256 tile each); this device has %d CUs\n", cus); grid = -1; return; }
    }
    if (grid < 0) return;
    Params p{};
    for (int i = 0; i < 36; ++i) p.in[i] = (const float*)d_in[i];
    p.out = (float*)d_out; p.ws = (unsigned char*)d_ws; p.itm = 15;
#if MK_LAUNCH_PER_PHASE
    for (int ph = 0; ph < NPHASE; ++ph) { p.ph_lo = ph; p.ph_hi = ph + 1; hipLaunchKernelGGL(fwd_kernel, dim3(grid), dim3(NTHREADS), LDS_BYTES, stream, p); }
#else
    p.ph_lo = 0; p.ph_hi = NPHASE;
    if (hipMemsetAsync((char*)d_ws + WS_CTL, 0, 98304, stream) != hipSuccess) { fprintf(stderr, "kernel_launch: memset of the barrier words failed\n"); return; }
    void* args[] = {&p};
    hipError_t e = hipLaunchCooperativeKernel((const void*)fwd_kernel, dim3(grid), dim3(NTHREADS), args, LDS_BYTES, stream);
    if (e != hipSuccess) fprintf(stderr, "cooperative launch failed: %s (grid %d)\n", hipGetErrorString(e), grid);
#ifdef PROBE_PH
    for (int r = 0; r < PROBE_REPS; ++r) { Params q = p; q.ph_lo = PROBE_PH; q.ph_hi = PROBE_PH + 1; q.itm = PROBE_ITM; hipLaunchKernelGGL(fwd_kernel, dim3(grid), dim3(NTHREADS), LDS_BYTES, stream, q); }
#endif
#endif
}
```

```cpp
#include <hip/hip_runtime.h>
#include <hip/hip_cooperative_groups.h>
#include <cstdio>
#include <cstdint>
namespace cg = cooperative_groups;

#ifndef MK_LAUNCH_PER_PHASE
#define MK_LAUNCH_PER_PHASE 0
#endif

constexpr int DM = 1024, SEQ = 2048, NBP = 8, NBS = 128, TS = 8;
constexpr int MP = NBP * SEQ, MS = NBS * TS, MT = MP + MS, NBID = NBP + NBS;
constexpr int DFF = 2816, NMOD = 9 * DM;
constexpr int ZP = 13568;
constexpr int ZQ = 0, ZK = 1024, ZV = 2048, ZO = 4096, ZZ = 6144, ZX = 8192, ZGA = 11264, ZGB = 12288, ZG = 13312;
constexpr float EPS = 1e-6f;
constexpr int NTHREADS = 512;

constexpr size_t MiB = 1u << 20;
constexpr size_t WS_CTL = 0;
constexpr size_t WS_WUP1 = 1 * MiB;
constexpr size_t WS_WDN1 = WS_WUP1 + 11 * MiB;
constexpr size_t WS_WUP2 = WS_WDN1 + 6 * MiB;
constexpr size_t WS_WDN2 = WS_WUP2 + 11 * MiB;
constexpr size_t WS_WIN = WS_WDN2 + 6 * MiB;
constexpr size_t WS_WPA = WS_WIN + 27 * MiB;
constexpr size_t WS_WPB = WS_WPA + 4 * MiB;
constexpr size_t WS_WOUT = WS_WPB + 4 * MiB;
constexpr size_t WS_MOD = WS_WOUT + 2 * MiB;
constexpr size_t WS_U = WS_MOD + 5 * MiB;
constexpr size_t WS_H = WS_U + 34 * MiB;
constexpr size_t WS_X1 = WS_H + 94 * MiB;
constexpr size_t WS_ZIN = WS_X1 + 68 * MiB;
constexpr size_t WS_GATES = WS_ZIN + 451 * MiB;
constexpr size_t WS_YS = WS_GATES + 5 * MiB;
constexpr size_t WS_DEN = WS_YS + 68 * MiB;
constexpr size_t WS_HA = WS_DEN + 1 * MiB;
constexpr size_t WS_HB = WS_HA + 68 * MiB;
constexpr size_t WS_CV = WS_HA;
constexpr size_t WS_XS = WS_CV + 170 * MiB;
constexpr size_t WS_U2 = WS_ZIN;
constexpr size_t WS_FDN1 = WS_XS + 4 * MiB;
constexpr size_t WS_FDN2 = WS_FDN1 + 6 * MiB;
constexpr size_t WS_FPA = WS_FDN2 + 6 * MiB;
constexpr size_t WS_FPB = WS_FPA + 4 * MiB;
constexpr size_t WS_FOUT = WS_FPB + 4 * MiB;
constexpr size_t WS_FG = WS_FOUT + 2 * MiB;
constexpr size_t WS_SC = WS_FG + 1 * MiB;
constexpr size_t WS_END = WS_SC + 1 * MiB;
constexpr int CW_CNT = 4096, CNT_STRIDE = 5120;
constexpr size_t WS_NUM = WS_H;
constexpr size_t WS_TMP = WS_YS;
static_assert(WS_END <= 1024 * MiB, "workspace map");

#define LAS __attribute__((address_space(3)))
typedef unsigned short bf16_t;
typedef short bf16x8 __attribute__((ext_vector_type(8)));
typedef short s16x4 __attribute__((ext_vector_type(4)));
typedef float f32x4 __attribute__((ext_vector_type(4)));
typedef float f32x2 __attribute__((ext_vector_type(2)));
typedef unsigned u32x4 __attribute__((ext_vector_type(4)));
typedef int v8i_t __attribute__((ext_vector_type(8)));
typedef unsigned u32x2 __attribute__((ext_vector_type(2)));

typedef __bf16 bf16x2_t __attribute__((ext_vector_type(2)));
__device__ __forceinline__ unsigned cvt_pk_bf16(float lo, float hi) { const bf16x2_t v = {(__bf16)lo, (__bf16)hi}; return __builtin_bit_cast(unsigned, v); }
__device__ __forceinline__ float bf2f(unsigned short b) { return __uint_as_float(((unsigned)b) << 16); }
__device__ __forceinline__ float bflo(unsigned w) { return __uint_as_float(w << 16); }
__device__ __forceinline__ float bfhi(unsigned w) { return __uint_as_float(w & 0xffff0000u); }
constexpr float F8_SA = 8.0f, F8_SW = 1024.0f, F8_INV = 1.0f / (8.0f * 1024.0f);
__device__ __forceinline__ float f8c(float x) { return fminf(fmaxf(x, -448.0f), 448.0f); }
__device__ __forceinline__ unsigned pack4_fp8(float a, float b, float c, float d, float s) {
    int w = 0; w = __builtin_amdgcn_cvt_pk_fp8_f32(f8c(a * s), f8c(b * s), w, false); w = __builtin_amdgcn_cvt_pk_fp8_f32(f8c(c * s), f8c(d * s), w, true); return (unsigned)w; }
__device__ __forceinline__ float fast_exp(float x) { return __builtin_amdgcn_exp2f(x * 1.4426950408889634f); }
__device__ __forceinline__ float sigmoidf_(float x) { return __builtin_amdgcn_rcpf(1.0f + fast_exp(-x)); }
__device__ __forceinline__ float siluf_(float x) { return x * sigmoidf_(x); }
__device__ __forceinline__ u32x4 pack8(const float (&v)[8], float s) {
    u32x4 w; w.x = cvt_pk_bf16(v[0] * s, v[1] * s); w.y = cvt_pk_bf16(v[2] * s, v[3] * s); w.z = cvt_pk_bf16(v[4] * s, v[5] * s); w.w = cvt_pk_bf16(v[6] * s, v[7] * s); return w;
}
__device__ __forceinline__ u32x2 pack4(const f32x4 v) { u32x2 w; w.x = cvt_pk_bf16(v[0], v[1]); w.y = cvt_pk_bf16(v[2], v[3]); return w; }
__device__ __forceinline__ void unpack8(const u32x4 v, float (&x)[8]) { x[0] = bflo(v.x); x[1] = bfhi(v.x); x[2] = bflo(v.y); x[3] = bfhi(v.y); x[4] = bflo(v.z); x[5] = bfhi(v.z); x[6] = bflo(v.w); x[7] = bfhi(v.w); }
__device__ __forceinline__ size_t fo_index(int r, int k, int K) { return ((size_t)((r >> 4) * (K >> 5) + (k >> 5))) * 512 + (size_t)((((r & 15) + 16 * ((k >> 3) & 3)) << 3) + (k & 7)); }
__device__ __forceinline__ size_t fo8_index(int r, int k, int K) { return ((size_t)((r >> 4) * (K >> 7) + (k >> 7))) * 2048 + (size_t)((((r & 15) + 16 * ((k >> 5) & 3)) << 5) + (k & 31)); }
__device__ __forceinline__ float wave_scan_add(float v) {
    v += __builtin_bit_cast(float, __builtin_amdgcn_update_dpp(0, __builtin_bit_cast(int, v), 0x111, 0xf, 0xf, true));
    v += __builtin_bit_cast(float, __builtin_amdgcn_update_dpp(0, __builtin_bit_cast(int, v), 0x112, 0xf, 0xf, true));
    v += __builtin_bit_cast(float, __builtin_amdgcn_update_dpp(0, __builtin_bit_cast(int, v), 0x114, 0xf, 0xf, true));
    v += __builtin_bit_cast(float, __builtin_amdgcn_update_dpp(0, __builtin_bit_cast(int, v), 0x118, 0xf, 0xf, true));
    v += __builtin_bit_cast(float, __builtin_amdgcn_update_dpp(0, __builtin_bit_cast(int, v), 0x142, 0xa, 0xf, true));
    v += __builtin_bit_cast(float, __builtin_amdgcn_update_dpp(0, __builtin_bit_cast(int, v), 0x143, 0xc, 0xf, true));
    return v;
}
__device__ __forceinline__ float wave_scan_max(float v) {
    const int ninf = (int)0xff800000u;
    v = fmaxf(v, __builtin_bit_cast(float, __builtin_amdgcn_update_dpp(ninf, __builtin_bit_cast(int, v), 0x111, 0xf, 0xf, false)));
    v = fmaxf(v, __builtin_bit_cast(float, __builtin_amdgcn_update_dpp(ninf, __builtin_bit_cast(int, v), 0x112, 0xf, 0xf, false)));
    v = fmaxf(v, __builtin_bit_cast(float, __builtin_amdgcn_update_dpp(ninf, __builtin_bit_cast(int, v), 0x114, 0xf, 0xf, false)));
    v = fmaxf(v, __builtin_bit_cast(float, __builtin_amdgcn_update_dpp(ninf, __builtin_bit_cast(int, v), 0x118, 0xf, 0xf, false)));
    v = fmaxf(v, __builtin_bit_cast(float, __builtin_amdgcn_update_dpp(ninf, __builtin_bit_cast(int, v), 0x142, 0xa, 0xf, false)));
    v = fmaxf(v, __builtin_bit_cast(float, __builtin_amdgcn_update_dpp(ninf, __builtin_bit_cast(int, v), 0x143, 0xc, 0xf, false)));
    return v;
}
__device__ __forceinline__ float wave_sum(float v) { return __builtin_bit_cast(float, __builtin_amdgcn_readlane(__builtin_bit_cast(int, wave_scan_add(v)), 63)); }

struct Params {
    const float* in[36];
    float* out;
    unsigned char* ws;
    int ph_lo, ph_hi, itm, pad;
};

namespace pg8 {
constexpr int BM = 256, BK = 64, HALF = 128, HTB = HALF * BK * 2, STAGE_BYTES = 8 * HTB, NXCD = 8, WGM = 8;
__host__ __device__ __forceinline__ int lds_byte(int r, int c) { const int st = (r >> 4) * 2 + (c >> 5), rr = r & 15, cc = c & 31, ob = rr * 64 + cc * 2; return st * 1024 + (ob ^ (((ob >> 9) & 1) << 5)); }
__host__ __device__ __forceinline__ void stage_rc(int b, int& R, int& C) { const int st = b / 1024, sb = b % 1024, swz = sb ^ (((sb >> 9) & 1) << 5); R = (st >> 1) * 16 + swz / 64; C = (st & 1) * 32 + (swz % 64) / 2; }
__host__ __device__ __forceinline__ int perm32(int rho) { const int n = rho >> 4, i = rho & 15; return 8 * (i >> 2) + 4 * n + (i & 3); }

struct Unit { int pm, pn, w; };
struct Gemm { const bf16_t* A0; const bf16_t* A1; const bf16_t* B0; const bf16_t* B1; int K; };
typedef unsigned u32x8_t __attribute__((ext_vector_type(8)));
__device__ __forceinline__ v8i_t cat8(const bf16x8 x0, const bf16x8 x1) { const u32x4 l = __builtin_bit_cast(u32x4, x0), h = __builtin_bit_cast(u32x4, x1); const u32x8_t c = __builtin_shufflevector(l, h, 0, 1, 2, 3, 4, 5, 6, 7); return __builtin_bit_cast(v8i_t, c); }

struct OrderSample { int c;
    __device__ bool next(int i, Unit& u) const { if (i > 0 || c >= 208) return false; const int x = c & 7, j = c >> 3; u.pm = 64 + (x >> 1); u.pn = (x & 1) * 26 + j; u.w = 0; return true; } };
struct OrderPrompt { int c;
    __device__ bool next(int i, Unit& u) const { const int x = c & 7, j = c >> 3; int q; if (j < 24) { if (i >= 17) return false; q = i * 24 + j; } else { if (i >= 1) return false; q = 408 + (j - 24); }
        u.pm = 8 * x + (q & 7); u.pn = q >> 3; u.w = 0; return true; } };
struct Order {
    int nM, nN, nwg, G, c, dual;
    __device__ void init(int M, int N, int G_, int c_, int dual_) { nM = M / BM; nN = N / BM; nwg = nM * nN; G = G_; c = c_; dual = dual_; }
    __device__ void init_from(int M, int N, int G_, int c_, int first, int lim) { nM = M / BM; nN = N / BM; nwg = lim; G = G_; c = first + c_; dual = 0; }
    __device__ bool next(int i, Unit& u) const {
        const int ti = dual ? (i >> 1) : i;
        const long L = (long)ti * G + c; if (L >= nwg) return false;
        int wgid = (int)L; { const int tot = nM * nN, q = tot / NXCD, r = tot % NXCD, xcd = wgid % NXCD, off = wgid / NXCD; wgid = (xcd < r ? xcd * (q + 1) : r * (q + 1) + (xcd - r) * q) + off; }
        const int nig = WGM * nN, gid = wgid / nig, fm = gid * WGM, gsz = (nM - fm) < WGM ? (nM - fm) : WGM;
        u.pm = fm + ((wgid % nig) % gsz); u.pn = (wgid % nig) / gsz; u.w = dual ? (i & 1) : 0; return true;
    }
};

template <class Epi, bool ALIGN_EPI = true, class Ord = Order, bool FP8 = false>
__device__ __forceinline__ void gemm_phase(LAS unsigned char* lds, const Gemm g, const Ord& S, const Epi E) {
    const int tid = threadIdx.x, wid = __builtin_amdgcn_readfirstlane(tid >> 6), lane = tid & 63, wr = wid >> 2, wc = wid & 3, fr = lane & 15, fq = lane >> 4;
    const int K = g.K, nt = K / BK;
    unsigned voffA[2], voffB[2];
#pragma unroll
    for (int i = 0; i < 2; ++i) { int R, C; stage_rc(tid * 16 + i * 8192, R, C); const int Rb = Epi::PERM ? ((R & ~31) + perm32(R & 31)) : R;
        voffA[i] = (unsigned)(R * K + C) * 2u; voffB[i] = (unsigned)(Rb * K + C) * 2u; }
    const size_t kstep = (size_t)(BK * 2);
    const size_t hstep = (size_t)HALF * K * 2;
    const size_t tstep = 2 * hstep;
    const unsigned ldsw = (unsigned)wid * 1024u;
    const int aoff = lds_byte(wr * 64 + fr, fq * 8), boff = lds_byte(wc * 32 + fr, fq * 8);
#define PG8_SA(b, h) (((b) * 2 + (h)) * HTB)
#define PG8_SB(b, h) ((4 + (b) * 2 + (h)) * HTB)
#define PG8_STAGE(bufoff, gbase, voff) do { _Pragma("unroll") for (int _i = 0; _i < 2; ++_i) \
        __builtin_amdgcn_global_load_lds((const unsigned*)((const char*)(gbase) + (voff)[_i]), (LAS unsigned*)(lds + (bufoff) + ldsw + _i * 8192), 16, 0, 0); } while (0)
#define PG8_LDA(dst, b, h) do { _Pragma("unroll") for (int m = 0; m < 4; ++m) _Pragma("unroll") for (int k = 0; k < 2; ++k) dst[m][k] = *(const LAS bf16x8*)(lds + PG8_SA(b, h) + aoff + m * 2048 + k * 1024); } while (0)
#define PG8_LDB(dst, b, h) do { _Pragma("unroll") for (int n = 0; n < 2; ++n) _Pragma("unroll") for (int k = 0; k < 2; ++k) dst[n][k] = *(const LAS bf16x8*)(lds + PG8_SB(b, h) + boff + n * 2048 + k * 1024); } while (0)
#define PG8_CAT8(x0, x1) cat8((x0), (x1))
#define PG8_MMA(ai, bj, At, Bt) do { __builtin_amdgcn_s_setprio(1); _Pragma("unroll") for (int m = 0; m < 4; ++m) _Pragma("unroll") for (int n = 0; n < 2; ++n) { \
        if constexpr (FP8) { const v8i_t b8_ = PG8_CAT8(Bt[n][0], Bt[n][1]), a8_ = PG8_CAT8(At[m][0], At[m][1]); \
            asm volatile("v_mfma_scale_f32_16x16x128_f8f6f4 %0, %1, %2, %0, %3, %3 op_sel_hi:[0,0,0]" : "+v"(acc[ai][bj][m][n]) : "v"(b8_), "v"(a8_), "v"(f8one)); } \
        else { _Pragma("unroll") for (int k = 0; k < 2; ++k) acc[ai][bj][m][n] = __builtin_amdgcn_mfma_f32_16x16x32_bf16(Bt[n][k], At[m][k], acc[ai][bj][m][n], 0, 0, 0); } } __builtin_amdgcn_s_setprio(0); } while (0)
#define PG8_WAIT_V(n) asm volatile("s_waitcnt vmcnt(" #n ")" ::: "memory")
#define PG8_WAIT_L(n) asm volatile("s_waitcnt lgkmcnt(" #n ")" ::: "memory")
#define PG8_BAR __builtin_amdgcn_s_barrier()
#define PG8_SCHED __builtin_amdgcn_sched_barrier(0)
    Unit cur, nxt; int ui = 0;
    if (!S.next(0, cur)) return;
    const int f8one = 0x7F7F7F7F;
    f32x4 acc[2][2][4][2];
#pragma unroll
    for (int a = 0; a < 2; ++a)
#pragma unroll
        for (int b = 0; b < 2; ++b)
#pragma unroll
            for (int m = 0; m < 4; ++m)
#pragma unroll
                for (int n = 0; n < 2; ++n) acc[a][b][m][n] = (f32x4){0.f, 0.f, 0.f, 0.f};
    bf16x8 At[4][2], B0[2][2], B1[2][2];
    const char* cA = (const char*)(cur.w ? g.A1 : g.A0) + (size_t)cur.pm * tstep; const char* cB = (const char*)(cur.w ? g.B1 : g.B0) + (size_t)cur.pn * tstep;
    PG8_STAGE(PG8_SB(0, 0), cB, voffB); PG8_STAGE(PG8_SB(0, 1), cB + hstep, voffB); PG8_STAGE(PG8_SA(0, 0), cA, voffA); PG8_STAGE(PG8_SA(0, 1), cA + hstep, voffA);
    if (wr == 1) PG8_BAR;
    PG8_WAIT_V(2); PG8_BAR;
    PG8_STAGE(PG8_SB(1, 0), cB + kstep, voffB); PG8_STAGE(PG8_SA(1, 0), cA + kstep, voffA); PG8_STAGE(PG8_SB(1, 1), cB + hstep + kstep, voffB);
    PG8_WAIT_V(6); PG8_BAR;
    for (;;) {
        const bool has_next = S.next(ui + 1, nxt);
        const char* nA = has_next ? (const char*)(nxt.w ? g.A1 : g.A0) + (size_t)nxt.pm * tstep : cA; const char* nB = has_next ? (const char*)(nxt.w ? g.B1 : g.B0) + (size_t)nxt.pn * tstep : cB;
        for (int t = 0; t < nt; t += 2) {
            const bool last = (t == nt - 2);
            const char* a1 = cA + (size_t)(t + 1) * kstep;
            const char* a2 = last ? nA : cA + (size_t)(t + 2) * kstep; const char* b2 = last ? nB : cB + (size_t)(t + 2) * kstep;
            const char* a3 = a2 + kstep; const char* b3 = b2 + kstep;
            PG8_LDB(B0, 0, 0); PG8_LDB(B1, 0, 1); PG8_SCHED; PG8_LDA(At, 0, 0); PG8_STAGE(PG8_SA(1, 1), a1 + hstep, voffA);
            PG8_WAIT_V(8); PG8_WAIT_L(0); PG8_BAR; PG8_MMA(0, 0, At, B0); PG8_MMA(0, 1, At, B1); PG8_BAR; PG8_SCHED;
            PG8_LDA(At, 0, 1); PG8_STAGE(PG8_SB(0, 0), b2, voffB); PG8_STAGE(PG8_SB(0, 1), b2 + hstep, voffB); PG8_STAGE(PG8_SA(0, 0), a2, voffA);
            PG8_WAIT_V(8); PG8_WAIT_L(0); PG8_BAR; PG8_MMA(1, 0, At, B0); PG8_MMA(1, 1, At, B1); PG8_BAR; PG8_SCHED;
            PG8_LDB(B0, 1, 0); PG8_LDB(B1, 1, 1); PG8_SCHED; PG8_LDA(At, 1, 0); PG8_STAGE(PG8_SA(0, 1), a2 + hstep, voffA);
            PG8_WAIT_V(8); PG8_WAIT_L(0); PG8_BAR; PG8_MMA(0, 0, At, B0); PG8_MMA(0, 1, At, B1); PG8_BAR; PG8_SCHED;
            PG8_LDA(At, 1, 1); PG8_STAGE(PG8_SB(1, 0), b3, voffB); PG8_STAGE(PG8_SB(1, 1), b3 + hstep, voffB); PG8_STAGE(PG8_SA(1, 0), a3, voffA);
            PG8_WAIT_V(8); PG8_WAIT_L(0); PG8_BAR; PG8_MMA(1, 0, At, B0); PG8_MMA(1, 1, At, B1); PG8_BAR; PG8_SCHED;
        }
        if constexpr (ALIGN_EPI) { if (wr == 0) PG8_BAR; }
        if constexpr (FP8) asm volatile("s_nop 15\n\ts_nop 15" ::: "memory");
        if constexpr (!Epi::AFTER_DRAIN) E(acc, cur, wr, wc, fr, fq);
        if (!has_next) break;
#pragma unroll
        for (int a = 0; a < 2; ++a)
#pragma unroll
            for (int b = 0; b < 2; ++b)
#pragma unroll
                for (int m = 0; m < 4; ++m)
#pragma unroll
                    for (int n = 0; n < 2; ++n) acc[a][b][m][n] = (f32x4){0.f, 0.f, 0.f, 0.f};
        cur = nxt; cA = nA; cB = nB; ++ui;
        if constexpr (ALIGN_EPI) { if (wr == 1) PG8_BAR; }
    }
    PG8_WAIT_V(0);
    if constexpr (!ALIGN_EPI) { if (wr == 0) PG8_BAR; }
    PG8_BAR;
    if constexpr (Epi::AFTER_DRAIN) E.fused(acc, cur, wr, wc, fr, fq, lds, wid, lane);
#undef PG8_SA
#undef PG8_SB
#undef PG8_STAGE
#undef PG8_LDA
#undef PG8_LDB
#undef PG8_MMA
#undef PG8_WAIT_V
#undef PG8_WAIT_L
#undef PG8_BAR
#undef PG8_SCHED
}

__device__ __forceinline__ int bid_of_row(int row) { return row < MP ? (row >> 11) : (NBP + ((row - MP) >> 3)); }

struct EpiSwiGLU {
    static constexpr bool PERM = true, AFTER_DRAIN = false;
    bf16_t* H; float inv;
    __device__ __forceinline__ void operator()(const f32x4 (&acc)[2][2][4][2], const Unit& u, int wr, int wc, int fr, int fq) const {
        const int row0 = u.pm * BM + wr * 64 + fr, hc0 = u.pn * 128 + wc * 32 + 8 * fq; const float inv_ = inv;
#pragma unroll
        for (int ai = 0; ai < 2; ++ai)
#pragma unroll
            for (int m = 0; m < 4; ++m) { const f32x4 a0 = acc[ai][0][m][0] * inv_, a1 = acc[ai][0][m][1] * inv_, b0 = acc[ai][1][m][0] * inv_, b1 = acc[ai][1][m][1] * inv_;
                u32x4 w; w.x = cvt_pk_bf16(siluf_(a0[0]) * b0[0], siluf_(a0[1]) * b0[1]); w.y = cvt_pk_bf16(siluf_(a0[2]) * b0[2], siluf_(a0[3]) * b0[3]);
                w.z = cvt_pk_bf16(siluf_(a1[0]) * b1[0], siluf_(a1[1]) * b1[1]); w.w = cvt_pk_bf16(siluf_(a1[2]) * b1[2], siluf_(a1[3]) * b1[3]);
                const int row = row0 + ai * HALF + m * 16;
                if (u.pm < MP / BM) *(u32x2*)((unsigned char*)H + (size_t)row * DFF + hc0) = (u32x2){pack4_fp8(siluf_(a0[0]) * b0[0], siluf_(a0[1]) * b0[1], siluf_(a0[2]) * b0[2], siluf_(a0[3]) * b0[3], F8_SA), pack4_fp8(siluf_(a1[0]) * b1[0], siluf_(a1[1]) * b1[1], siluf_(a1[2]) * b1[2], siluf_(a1[3]) * b1[3], F8_SA)};
                else *(u32x2*)((unsigned char*)H + (size_t)MP * DFF * 2 + fo8_index(row - MP, hc0, DFF)) = (u32x2){pack4_fp8(siluf_(a0[0]) * b0[0], siluf_(a0[1]) * b0[1], siluf_(a0[2]) * b0[2], siluf_(a0[3]) * b0[3], F8_SA), pack4_fp8(siluf_(a1[0]) * b1[0], siluf_(a1[1]) * b1[1], siluf_(a1[2]) * b1[2], siluf_(a1[3]) * b1[3], F8_SA)}; }
    }
};
struct EpiResid {
    static constexpr bool PERM = false, AFTER_DRAIN = false;
    const float* xin_p; const float* xin_s; float* out; const float* gmod; float coef;
    __device__ __forceinline__ void operator()(const f32x4 (&acc)[2][2][4][2], const Unit& u, int wr, int wc, int fr, int fq) const {
        const int row0 = u.pm * BM + wr * 64 + fr, col0 = u.pn * BM + wc * 32 + 4 * fq;
#pragma unroll
        for (int ai = 0; ai < 2; ++ai)
#pragma unroll
            for (int m = 0; m < 4; ++m) { const int row = row0 + ai * HALF + m * 16;
                const float* xr = (row < MP ? xin_p + (size_t)row * DM : xin_s + (size_t)(row - MP) * DM) + col0;
                const float* gr = gmod + (size_t)bid_of_row(row) * NMOD + col0; float* orow = out + (size_t)row * DM + col0;
#pragma unroll
                for (int bj = 0; bj < 2; ++bj)
#pragma unroll
                    for (int n = 0; n < 2; ++n) { const int o = bj * HALF + n * 16; const f32x4 xv = *(const f32x4*)(xr + o), gv = *(const f32x4*)(gr + o);
                        *(f32x4*)(orow + o) = xv + coef * gv * acc[ai][bj][m][n]; } }
    }
};

__device__ __forceinline__ void panel_wait(unsigned* cnt, unsigned need) {
    unsigned spins = 0;
    while ((unsigned)__builtin_amdgcn_readfirstlane(__hip_atomic_load(cnt, __ATOMIC_RELAXED, __HIP_MEMORY_SCOPE_AGENT)) < need) { if (++spins > (1u << 20)) break; __builtin_amdgcn_s_sleep(2); }
    __builtin_amdgcn_fence(__ATOMIC_ACQUIRE, "agent");
}
template <bool FINAL>
struct EpiResidNorm {
    static constexpr bool PERM = true, AFTER_DRAIN = true;
    const float* xin; float* Xout; const float* gmod; const float* gw; const float* shmod; const float* scmod; bf16_t* Uout; float* Yout; float* XS; unsigned* cnt; float coef; int pad_;
    __device__ __forceinline__ void fused(f32x4 (&acc)[2][2][4][2], const Unit& u, int wr, int wc, int fr, int fq, LAS unsigned char* lds, int wid, int lane) const {
        LAS float* P = (LAS float*)lds; LAS float* S = (LAS float*)(lds + 4096);
        const float* const xin_ = xin; float* const Xout_ = Xout; const float* const gmod_ = gmod; const float coef_ = coef; const float* const gw_ = gw; const float* const shmod_ = shmod; const float* const scmod_ = scmod;
        bf16_t* const Uout_ = Uout; float* const Yout_ = Yout; float* const XS_ = XS; unsigned* const cnt_ = cnt;
        const int b = u.pm >> 3, col0 = u.pn * BM + wc * 32 + 8 * fq, rowt = wr * 64 + fr;
        { f32x4 gv[2][2];
#pragma unroll
          for (int bj = 0; bj < 2; ++bj)
#pragma unroll
              for (int n = 0; n < 2; ++n) gv[bj][n] = coef_ * *(const f32x4*)(gmod_ + (size_t)b * NMOD + col0 + bj * HALF + n * 4);
#pragma unroll
          for (int ai = 0; ai < 2; ++ai)
#pragma unroll
              for (int m = 0; m < 4; ++m) { const int rt = rowt + ai * HALF + m * 16; const size_t xo = (size_t)(u.pm * BM + rt) * DM + col0; float ss = 0.f;
#pragma unroll
                  for (int bj = 0; bj < 2; ++bj) { f32x4 xv[2];
                      if (FINAL || pad_) { const u32x4 t = *(const u32x4*)((const bf16_t*)xin_ + xo + bj * HALF);
                          xv[0] = (f32x4){bflo(t.x), bfhi(t.x), bflo(t.y), bfhi(t.y)}; xv[1] = (f32x4){bflo(t.z), bfhi(t.z), bflo(t.w), bfhi(t.w)}; }
                      else { xv[0] = *(const f32x4*)(xin_ + xo + bj * HALF); xv[1] = *(const f32x4*)(xin_ + xo + bj * HALF + 4); }
#pragma unroll
                      for (int n = 0; n < 2; ++n) { const f32x4 x = xv[n] + gv[bj][n] * acc[ai][bj][m][n]; acc[ai][bj][m][n] = x; ss += (x[0] * x[0] + x[1] * x[1]) + (x[2] * x[2] + x[3] * x[3]); } }
                  ss += __shfl_xor(ss, 16); ss += __shfl_xor(ss, 32);
                  if (fq == 0) P[rt * 4 + wc] = ss;
                  asm volatile("" ::: "memory"); } }
        __syncthreads();
        const int r32 = wid * 32 + (lane & 31); float* slot = XS_ + (size_t)(u.pm * BM + r32) * 16;
        if (lane < 32) { const f32x4 pp = *(const LAS f32x4*)(P + r32 * 4); __hip_atomic_store(slot + u.pn, (pp[0] + pp[1]) + (pp[2] + pp[3]), __ATOMIC_RELAXED, __HIP_MEMORY_SCOPE_AGENT); }
        asm volatile("s_waitcnt vmcnt(0)" ::: "memory");
        if (lane == 0) __hip_atomic_fetch_add(cnt_ + 64 * u.pm, 1u, __ATOMIC_RELAXED, __HIP_MEMORY_SCOPE_AGENT);
        if (wid == 0) panel_wait(cnt_ + 64 * u.pm, 32u);
        asm volatile("s_waitcnt vmcnt(0) lgkmcnt(0)" ::: "memory");
        __syncthreads();
        if (lane < 32) { float tot = 0.f;
#pragma unroll
            for (int t = 0; t < 4; ++t) tot += __hip_atomic_load(slot + t, __ATOMIC_RELAXED, __HIP_MEMORY_SCOPE_AGENT);
            S[r32] = 1.0f / sqrtf(tot * (1.0f / DM) + EPS); }
        __syncthreads();
        f32x4 fac[2][2], shv[2][2];
#pragma unroll
        for (int bj = 0; bj < 2; ++bj)
#pragma unroll
            for (int n = 0; n < 2; ++n) { const int c = col0 + bj * HALF + n * 4; fac[bj][n] = *(const f32x4*)(gw_ + c);
                if constexpr (!FINAL) { fac[bj][n] = fac[bj][n] * (1.0f + *(const f32x4*)(scmod_ + (size_t)b * NMOD + c)); shv[bj][n] = *(const f32x4*)(shmod_ + (size_t)b * NMOD + c); } }
#pragma unroll
        for (int ai = 0; ai < 2; ++ai)
#pragma unroll
            for (int m = 0; m < 4; ++m) { const int rt = rowt + ai * HALF + m * 16; const size_t off = (size_t)(u.pm * BM + rt) * DM + col0; const float r = S[rt];
#pragma unroll
                for (int bj = 0; bj < 2; ++bj) { const f32x4 x0 = acc[ai][bj][m][0], x1 = acc[ai][bj][m][1]; const int o = bj * HALF;
                    if constexpr (FINAL) { *(f32x4*)(Yout_ + off + o) = x0 * r * fac[bj][0]; *(f32x4*)(Yout_ + off + o + 4) = x1 * r * fac[bj][1]; }
                    else { { const u32x2 r0 = pack4(x0), r1 = pack4(x1); *(u32x4*)((bf16_t*)Xout_ + off + o) = (u32x4){r0.x, r0.y, r1.x, r1.y}; }
                        const f32x4 y0 = x0 * r * fac[bj][0] + shv[bj][0], y1 = x1 * r * fac[bj][1] + shv[bj][1];
                        if (pad_) *(u32x2*)((unsigned char*)Uout_ + off + o) = (u32x2){pack4_fp8(y0[0], y0[1], y0[2], y0[3], F8_SA), pack4_fp8(y1[0], y1[1], y1[2], y1[3], F8_SA)};
                        else { const u32x2 w0 = pack4(y0), w1 = pack4(y1); *(u32x4*)(Uout_ + off + o) = (u32x4){w0.x, w0.y, w1.x, w1.y}; } } } }
    }
};
struct EpiZin {
    static constexpr bool PERM = true, AFTER_DRAIN = false;
    bf16_t* Z; float* gates;
    __device__ __forceinline__ void operator()(const f32x4 (&acc)[2][2][4][2], const Unit& u, int wr, int wc, int fr, int fq) const {
        const int row0 = u.pm * BM + wr * 64 + fr;
        {
            const int col0 = u.pn * BM + wc * 32 + 8 * fq;
#pragma unroll
            for (int ai = 0; ai < 2; ++ai)
#pragma unroll
                for (int m = 0; m < 4; ++m) { bf16_t* rp = Z + (size_t)(row0 + ai * HALF + m * 16) * ZP + col0;
#pragma unroll
                    for (int bj = 0; bj < 2; ++bj) { const f32x4 v0 = acc[ai][bj][m][0], v1 = acc[ai][bj][m][1];
                        u32x4 w; w.x = cvt_pk_bf16(v0[0], v0[1]); w.y = cvt_pk_bf16(v0[2], v0[3]); w.z = cvt_pk_bf16(v1[0], v1[1]); w.w = cvt_pk_bf16(v1[2], v1[3]);
                        *(u32x4*)(rp + bj * HALF) = w; } }
        }
    }
};
struct EpiMerge {
    static constexpr bool PERM = true, AFTER_DRAIN = false;
    const bf16_t* Z; float* tmp; bf16_t* U; float inv;
    __device__ __forceinline__ void operator()(const f32x4 (&acc)[2][2][4][2], const Unit& u, int wr, int wc, int fr, int fq) const {
        const int row0 = u.pm * BM + wr * 64 + fr, col0 = u.pn * BM + wc * 32 + 8 * fq;
        const int zoff = u.w ? ZGB : ZGA; const float inv_ = inv; bf16_t* const part = (bf16_t*)tmp;
#pragma unroll
        for (int ai = 0; ai < 2; ++ai)
#pragma unroll
            for (int m = 0; m < 4; ++m) { const int row = row0 + ai * HALF + m * 16;
#pragma unroll
                for (int bj = 0; bj < 2; ++bj) { const int c = col0 + bj * HALF;
                    const u32x4 gz = *(const u32x4*)(Z + (size_t)row * ZP + zoff + c);
                    f32x4 s0, s1; s0[0] = sigmoidf_(bflo(gz.x)); s0[1] = sigmoidf_(bfhi(gz.x)); s0[2] = sigmoidf_(bflo(gz.y)); s0[3] = sigmoidf_(bfhi(gz.y));
                    s1[0] = sigmoidf_(bflo(gz.z)); s1[1] = sigmoidf_(bfhi(gz.z)); s1[2] = sigmoidf_(bflo(gz.w)); s1[3] = sigmoidf_(bfhi(gz.w));
                    f32x4 v0 = s0 * (acc[ai][bj][m][0] * inv_), v1 = s1 * (acc[ai][bj][m][1] * inv_);
                    u32x4* pp = (u32x4*)(part + (size_t)row * DM + c);
                    if (u.w == 0) { u32x4 w; w.x = cvt_pk_bf16(v0[0], v0[1]); w.y = cvt_pk_bf16(v0[2], v0[3]); w.z = cvt_pk_bf16(v1[0], v1[1]); w.w = cvt_pk_bf16(v1[2], v1[3]); *pp = w; }
                    else { const u32x4 pv = *pp; v0[0] += bflo(pv.x); v0[1] += bfhi(pv.x); v0[2] += bflo(pv.y); v0[3] += bfhi(pv.y); v1[0] += bflo(pv.z); v1[1] += bfhi(pv.z); v1[2] += bflo(pv.w); v1[3] += bfhi(pv.w);
                        *(u32x2*)((unsigned char*)U + (size_t)row * DM + c) = (u32x2){pack4_fp8(v0[0], v0[1], v0[2], v0[3], F8_SA), pack4_fp8(v1[0], v1[1], v1[2], v1[3], F8_SA)}; } } }
    }
};
}


struct Frame {
    LAS unsigned char* lds;
    int tid, lane, wave, G, bx;
    float* out; unsigned char* ws;
};
constexpr int PTAB_OFF = 147072;
__device__ __forceinline__ const float* pin_ld(const Frame& F, const int k) {
    const volatile LAS unsigned* T = (const volatile LAS unsigned*)(F.lds + PTAB_OFF);
    const unsigned lo = (unsigned)__builtin_amdgcn_readfirstlane((int)T[2 * k]), hi = (unsigned)__builtin_amdgcn_readfirstlane((int)T[2 * k + 1]);
    return (const float*)(((uint64_t)hi << 32) | (uint64_t)lo);
}
#define PIN(k) pin_ld(F, (k))

template <int KTOT, bool FOA, bool FOB>
__device__ __forceinline__ void small_gemm_partials(LAS unsigned char* lds, const bf16_t* A, const bf16_t* Bt, int wave, int lane) {
    const int fr = lane & 15, fq = lane >> 4; constexpr int NKS = KTOT / 256; const int T0 = wave * NKS;
    const bf16_t* ap = A + (size_t)fr * KTOT + 8 * fq; const bf16_t* bp = Bt + (size_t)fr * KTOT + 8 * fq;
    f32x4 acc[4][4];
#pragma unroll
    for (int i = 0; i < 4; ++i)
#pragma unroll
        for (int j = 0; j < 4; ++j) acc[i][j] = (f32x4){0.f, 0.f, 0.f, 0.f};
    bf16x8 a[4][4], b[4][4];
#define SG_LOAD(slot, t) do { const int T_ = T0 + (t), ko_ = 32 * T_; _Pragma("unroll") for (int i = 0; i < 4; ++i) { \
        if constexpr (FOA) a[slot][i] = *(const bf16x8*)(A + ((size_t)(i * (KTOT / 32) + T_)) * 512 + 8 * lane); else a[slot][i] = *(const bf16x8*)(ap + (size_t)(16 * i) * KTOT + ko_); \
        if constexpr (FOB) b[slot][i] = *(const bf16x8*)(Bt + ((size_t)(i * (KTOT / 32) + T_)) * 512 + 8 * lane); else b[slot][i] = *(const bf16x8*)(bp + (size_t)(16 * i) * KTOT + ko_); } } while (0)
#pragma unroll
    for (int t = 0; t < 4 && t < NKS; ++t) SG_LOAD(t, t);
    __builtin_amdgcn_sched_barrier(0);
#pragma unroll
    for (int t = 0; t < NKS; ++t) {
#pragma unroll
        for (int tn = 0; tn < 4; ++tn)
#pragma unroll
            for (int tm = 0; tm < 4; ++tm) acc[tn][tm] = __builtin_amdgcn_mfma_f32_16x16x32_bf16(b[t & 3][tn], a[t & 3][tm], acc[tn][tm], 0, 0, 0);
        __builtin_amdgcn_sched_barrier(0);
        if (t + 4 < NKS) { SG_LOAD(t & 3, t + 4); __builtin_amdgcn_sched_barrier(0); } }
#undef SG_LOAD
    LAS f32x4* PART = (LAS f32x4*)lds;
#pragma unroll
    for (int tn = 0; tn < 4; ++tn)
#pragma unroll
        for (int tm = 0; tm < 4; ++tm) PART[(wave * 16 + tn * 4 + tm) * 64 + lane] = acc[tn][tm];
}
template <int KTOT>
__device__ __forceinline__ void small_gemm_partials8(LAS unsigned char* lds, const unsigned char* A8, const unsigned char* B8, int wave, int lane) {
    constexpr int NST = KTOT / 128; const int s0 = (wave * NST) >> 3, s1 = ((wave + 1) * NST) >> 3; const int one = 0x7F7F7F7F;
    f32x4 acc[4][4];
#pragma unroll
    for (int i = 0; i < 4; ++i)
#pragma unroll
        for (int j = 0; j < 4; ++j) acc[i][j] = (f32x4){0.f, 0.f, 0.f, 0.f};
#pragma unroll 1
    for (int t = s0; t < s1; ++t) { v8i_t a[4], b[4];
#pragma unroll
        for (int i = 0; i < 4; ++i) { a[i] = *(const v8i_t*)(A8 + ((size_t)(i * NST + t)) * 2048 + 32 * lane); b[i] = *(const v8i_t*)(B8 + ((size_t)(i * NST + t)) * 2048 + 32 * lane); }
#pragma unroll
        for (int tn = 0; tn < 4; ++tn)
#pragma unroll
            for (int tm = 0; tm < 4; ++tm) asm volatile("v_mfma_scale_f32_16x16x128_f8f6f4 %0, %1, %2, %0, %3, %3 op_sel_hi:[0,0,0]" : "+v"(acc[tn][tm]) : "v"(b[tn]), "v"(a[tm]), "v"(one)); }
    asm volatile("s_nop 15\n\ts_nop 15" ::: "memory");
    LAS f32x4* PART = (LAS f32x4*)lds;
#pragma unroll
    for (int tn = 0; tn < 4; ++tn)
#pragma unroll
        for (int tm = 0; tm < 4; ++tm) PART[(wave * 16 + tn * 4 + tm) * 64 + lane] = acc[tn][tm];
}
__device__ __forceinline__ f32x4 small_gemm_sum(LAS unsigned char* lds, int tid, int j) {
    const LAS f32x4* PART = (const LAS f32x4*)lds; const int tile = 8 * j + (tid >> 6), ln = tid & 63; f32x4 sum = PART[tile * 64 + ln];
#pragma unroll
    for (int wv = 1; wv < 8; ++wv) sum += PART[(wv * 16 + tile) * 64 + ln];
    return sum;
}
template <int KTOT>
__device__ __forceinline__ void small_phase_resid(Frame& F, const bf16_t* A, const bf16_t* Bt, const float* xin_s, float* out, const float* gmod, float coef) {
    for (int st = F.bx; st < 256; st += F.G) { const int x = st & 7, j = st >> 3, sm = 4 * (x >> 1) + (j >> 3), sn = 8 * (x & 1) + (j & 7);
        __syncthreads();
        small_gemm_partials<KTOT, true, true>(F.lds, A + (size_t)(MP + 64 * sm) * KTOT, Bt + (size_t)(64 * sn) * KTOT, F.wave, F.lane);
        __syncthreads();
#pragma unroll
        for (int j = 0; j < 2; ++j) { const f32x4 v = small_gemm_sum(F.lds, F.tid, j); const int tile = 8 * j + (F.tid >> 6), tn = tile >> 2, tm = tile & 3;
            const int ms = 64 * sm + 16 * tm + (F.lane & 15), n = 64 * sn + 16 * tn + 4 * (F.lane >> 4), row = MP + ms;
            const f32x4 xv = *(const f32x4*)(xin_s + (size_t)ms * DM + n), gv = *(const f32x4*)(gmod + (size_t)pg8::bid_of_row(row) * NMOD + n);
            *(f32x4*)(out + (size_t)row * DM + n) = xv + coef * gv * v; } }
}
template <int KTOT, bool FINAL>
__device__ __forceinline__ void small_phase_resid_norm(Frame& F, const bf16_t* A, const bf16_t* Bt, const float* xin_s, float* Xout, const float* gmod, float coef,
                                                       const float* gw, const float* shmod, const float* scmod, bf16_t* Uout, float* Yout, float* XS, unsigned* cnt) {
    LAS float* P2 = (LAS float*)(F.lds + 131072); LAS float* S2 = (LAS float*)(F.lds + 131072 + 512);
    for (int st = F.bx; st < 256; st += F.G) { const int x = st & 7, j0 = st >> 3, sm = 4 * (x >> 1) + (j0 >> 3), sn = 8 * (x & 1) + (j0 & 7);
        __syncthreads();
        small_gemm_partials8<KTOT>(F.lds, (const unsigned char*)A + (size_t)MP * KTOT * 2 + (size_t)(64 * sm) * KTOT, (const unsigned char*)Bt + (size_t)(64 * sn) * KTOT, F.wave, F.lane);
        __syncthreads();
        const int fr = F.lane & 15, fq = F.lane >> 4, tm = F.wave & 3, rl = 16 * tm + fr, ms = 64 * sm + rl, row = MP + ms, bid = NBP + (ms >> 3);
        f32x4 xn[2]; float ss = 0.f;
#pragma unroll
        for (int j = 0; j < 2; ++j) { const int n = 64 * sn + 16 * (2 * j + (F.wave >> 2)) + 4 * fq;
            f32x4 xi; if constexpr (KTOT == DFF && !FINAL) xi = *(const f32x4*)(xin_s + (size_t)ms * DM + n);
            else { const u32x2 t = *(const u32x2*)((const bf16_t*)xin_s + (size_t)ms * DM + n); xi = (f32x4){bflo(t.x), bfhi(t.x), bflo(t.y), bfhi(t.y)}; }
            const f32x4 x4 = xi + coef * *(const f32x4*)(gmod + (size_t)bid * NMOD + n) * small_gemm_sum(F.lds, F.tid, j);
            xn[j] = x4; ss += (x4[0] * x4[0] + x4[1] * x4[1]) + (x4[2] * x4[2] + x4[3] * x4[3]); }
        ss += __shfl_xor(ss, 16); ss += __shfl_xor(ss, 32);
        if (fq == 0) P2[(F.wave >> 2) * 64 + rl] = ss;
        __syncthreads();
        float* slot = XS + (size_t)(MP + 64 * sm + F.lane) * 16;
        if (F.wave == 0) { __hip_atomic_store(slot + sn, P2[F.lane] + P2[64 + F.lane], __ATOMIC_RELAXED, __HIP_MEMORY_SCOPE_AGENT);
            asm volatile("s_waitcnt vmcnt(0)" ::: "memory");
            if (F.lane == 0) __hip_atomic_fetch_add(cnt + 64 * (64 + sm), 1u, __ATOMIC_RELAXED, __HIP_MEMORY_SCOPE_AGENT);
            pg8::panel_wait(cnt + 64 * (64 + sm), 16u);
            float tot = 0.f;
#pragma unroll
            for (int t = 0; t < 16; ++t) tot += __hip_atomic_load(slot + t, __ATOMIC_RELAXED, __HIP_MEMORY_SCOPE_AGENT);
            S2[F.lane] = 1.0f / sqrtf(tot * (1.0f / DM) + EPS); }
        __syncthreads();
        const float r = S2[rl];
#pragma unroll
        for (int j = 0; j < 2; ++j) { const int n = 64 * sn + 16 * (2 * j + (F.wave >> 2)) + 4 * fq; const f32x4 g4 = *(const f32x4*)(gw + n);
            if constexpr (FINAL) *(f32x4*)(Yout + (size_t)row * DM + n) = xn[j] * r * g4;
            else { *(u32x2*)((bf16_t*)Xout + (size_t)row * DM + n) = pack4(xn[j]);
                const f32x4 yq = xn[j] * r * g4 * (1.0f + *(const f32x4*)(scmod + (size_t)bid * NMOD + n)) + *(const f32x4*)(shmod + (size_t)bid * NMOD + n);
                if constexpr (KTOT == DM) *(unsigned*)((unsigned char*)Uout + (size_t)row * DM + n) = pack4_fp8(yq[0], yq[1], yq[2], yq[3], F8_SA);
                else *(u32x2*)(Uout + (size_t)row * DM + n) = pack4(yq); } } }
}
__device__ __forceinline__ void small_gates_tile(Frame& F, const bf16_t* U, const bf16_t* Wg, float* gates, const int st) {
    {
        __syncthreads();
        small_gemm_partials<DM, false, true>(F.lds, U + (size_t)(64 * st) * DM, Wg, F.wave, F.lane);
        __syncthreads();
#pragma unroll
        for (int j = 0; j < 2; ++j) { const f32x4 v = small_gemm_sum(F.lds, F.tid, j); const int tile = 8 * j + (F.tid >> 6), tn = tile >> 2, tm = tile & 3;
            *(f32x4*)(gates + (size_t)(64 * st + 16 * tm + (F.lane & 15)) * 64 + 16 * tn + 4 * (F.lane >> 4)) = v; } }
}
__device__ __forceinline__ void small_phase_merge(Frame& F, const bf16_t* HA, const bf16_t* HB, const bf16_t* WA, const bf16_t* WB, const bf16_t* Z, bf16_t* U) {
    for (int st = F.bx; st < 256; st += F.G) { const int x = st & 7, j = st >> 3, sm = 4 * (x >> 1) + (j >> 3), sn = 8 * (x & 1) + (j & 7); f32x4 va[2], vb[2];
        __syncthreads();
        small_gemm_partials8<2048>(F.lds, (const unsigned char*)HA + (size_t)MP * 2048 * 2 + (size_t)(64 * sm) * 2048, (const unsigned char*)WA + (size_t)(64 * sn) * 2048, F.wave, F.lane);
        __syncthreads();
        va[0] = small_gemm_sum(F.lds, F.tid, 0) * F8_INV; va[1] = small_gemm_sum(F.lds, F.tid, 1) * F8_INV;
        __syncthreads();
        small_gemm_partials8<2048>(F.lds, (const unsigned char*)HB + (size_t)MP * 2048 * 2 + (size_t)(64 * sm) * 2048, (const unsigned char*)WB + (size_t)(64 * sn) * 2048, F.wave, F.lane);
        __syncthreads();
        vb[0] = small_gemm_sum(F.lds, F.tid, 0) * F8_INV; vb[1] = small_gemm_sum(F.lds, F.tid, 1) * F8_INV;
#pragma unroll
        for (int j = 0; j < 2; ++j) { const int tile = 8 * j + (F.tid >> 6), tn = tile >> 2, tm = tile & 3;
            const int row = MP + 64 * sm + 16 * tm + (F.lane & 15), n = 64 * sn + 16 * tn + 4 * (F.lane >> 4);
            const u32x2 ga = *(const u32x2*)(Z + (size_t)row * ZP + ZGA + n), gb = *(const u32x2*)(Z + (size_t)row * ZP + ZGB + n);
            f32x4 o; o[0] = sigmoidf_(bflo(ga.x)) * va[j][0] + sigmoidf_(bflo(gb.x)) * vb[j][0]; o[1] = sigmoidf_(bfhi(ga.x)) * va[j][1] + sigmoidf_(bfhi(gb.x)) * vb[j][1];
            o[2] = sigmoidf_(bflo(ga.y)) * va[j][2] + sigmoidf_(bflo(gb.y)) * vb[j][2]; o[3] = sigmoidf_(bfhi(ga.y)) * va[j][3] + sigmoidf_(bfhi(gb.y)) * vb[j][3];
            *(unsigned*)((unsigned char*)U + (size_t)MP * DM * 2 + fo8_index(row - MP, n, DM)) = pack4_fp8(o[0], o[1], o[2], o[3], F8_SA); } }
}

#define GAS __attribute__((address_space(1)))
#define XB_TMO      128
#define XB_XCNT(j)  (256  + 64 * (j))
#define XB_XSUB(j)  (1280 + 64 * (j))
#define XB_XGEN(j)  (2304 + 64 * (j))
#define XB_TOP      3328
#define XB_TOPGEN   3392
#define XCD_BAR_WORDS 3456
#define XB_SPIN_CAP (1u << 22)
__device__ __forceinline__ unsigned xb_ld(unsigned* p)              { return __hip_atomic_load(p, __ATOMIC_RELAXED, __HIP_MEMORY_SCOPE_AGENT); }
__device__ __forceinline__ unsigned xb_add(unsigned* p, unsigned v) { return __hip_atomic_fetch_add(p, v, __ATOMIC_RELAXED, __HIP_MEMORY_SCOPE_AGENT); }
__device__ __forceinline__ unsigned xb_xcc_id() { return (unsigned)__builtin_amdgcn_s_getreg((3 << 11) | 20) & 0xFu; }
#define XB_SPIN(cond, bar) do { unsigned _sp = 0; while (cond) { __builtin_amdgcn_s_sleep(1); \
    if ((++_sp & 255u) == 0u) { if (xb_ld(&(bar)[XB_TMO])) break; if (_sp > XB_SPIN_CAP) { atomicAdd(&(bar)[XB_TMO], 1u); break; } } } } while (0)
struct XcdBarrier { unsigned* bar; unsigned x; volatile LAS unsigned* st; };
__device__ __forceinline__ XcdBarrier xcd_barrier_post(unsigned* bar, volatile LAS unsigned* st) {
    XcdBarrier b; b.bar = bar; b.x = xb_xcc_id(); b.st = st;
    if (threadIdx.x == 0) (void)xb_add(&bar[XB_XCNT(b.x)], 1u);
    return b;
}
__device__ __forceinline__ void xcd_barrier_complete(unsigned* bar, unsigned x, unsigned& nloc, unsigned& nx) {
    const unsigned G = gridDim.x * gridDim.y * gridDim.z;
    unsigned sum, cnt, mine, sp = 0u;
    for (;;) {
        sum = 0u; cnt = 0u; mine = 0u;
#pragma unroll
        for (unsigned j = 0; j < 16; ++j) { const unsigned c = xb_ld(&bar[XB_XCNT(j)]); sum += c; cnt += (c > 0u) ? 1u : 0u; mine = (j == x) ? c : mine; }
        if (sum == G) break;
        __builtin_amdgcn_s_sleep(1);
        if ((++sp & 255u) == 0u) { if (xb_ld(&bar[XB_TMO])) break; if (sp > XB_SPIN_CAP) { atomicAdd(&bar[XB_TMO], 1u); break; } }
    }
    nloc = mine > 0u ? mine : 1u; nx = cnt > 0u ? cnt : 1u;
}
__device__ __forceinline__ void xcd_barrier(const XcdBarrier& b) {
    asm volatile("s_waitcnt vmcnt(0)" ::: "memory");
    __syncthreads();
    if (threadIdx.x == 0) {
        unsigned* bar = b.bar;
        __builtin_amdgcn_s_waitcnt(0);
        unsigned nloc = b.st[0], nx = b.st[1];
        if (nloc == 0u) { xcd_barrier_complete(bar, b.x, nloc, nx); b.st[0] = nloc; b.st[1] = nx; }
        const unsigned old = xb_add(&bar[XB_XSUB(b.x)], 1u);
        const unsigned gen = old / nloc;
        if (old + 1u == (gen + 1u) * nloc) {
            __builtin_amdgcn_fence(__ATOMIC_RELEASE, "agent");
            asm volatile("s_waitcnt vmcnt(0)" ::: "memory");
            const unsigned og = xb_add(&bar[XB_TOP], 1u);
            const unsigned tg = og / nx;
            if (og + 1u == (tg + 1u) * nx) xb_add(&bar[XB_TOPGEN], 1u);
            else XB_SPIN(xb_ld(&bar[XB_TOPGEN]) == tg, bar);
            __builtin_amdgcn_fence(__ATOMIC_ACQUIRE, "agent");
            xb_add(&bar[XB_XGEN(b.x)], 1u);
            asm volatile("s_waitcnt vmcnt(0)" ::: "memory");
        } else {
            XB_SPIN(xb_ld(&bar[XB_XGEN(b.x)]) == gen, bar);
            __builtin_amdgcn_fence(__ATOMIC_ACQUIRE, "agent");
            asm volatile("s_waitcnt vmcnt(0)" ::: "memory");
        }
    }
    __syncthreads();
}


template <class SrcFn>
__device__ __forceinline__ void transpose_item(const SrcFn& src, int K, bf16_t* WT, LAS float* scr, int item, int lane, int nblk, bf16_t* WF = nullptr, int fo_row0 = 0) {
    const int kb = item / nblk, nb = item % nblk, k0 = 64 * kb, n0 = 32 * nb;
    const size_t stride = (size_t)src.stride(); const float* colp = src(n0 + (lane & 31));
    float tv[32];
#pragma unroll
    for (int i = 0; i < 32; ++i) { const int kk = 2 * i + (lane >> 5); tv[i] = colp ? colp[(size_t)(k0 + kk) * stride] : 0.f; }
#pragma unroll
    for (int i = 0; i < 32; ++i) { const int kk = 2 * i + (lane >> 5); scr[kk * 33 + (lane & 31)] = tv[i]; }
    asm volatile("s_waitcnt lgkmcnt(0)" ::: "memory");
    const int c = lane & 7;
#pragma unroll
    for (int j = 0; j < 4; ++j) { const int n = (lane >> 3) + 8 * j; const LAS float* s = scr + (8 * c) * 33 + n;
        if constexpr (SrcFn::F8) { const u32x2 f8 = (u32x2){pack4_fp8(s[0 * 33], s[1 * 33], s[2 * 33], s[3 * 33], F8_SW), pack4_fp8(s[4 * 33], s[5 * 33], s[6 * 33], s[7 * 33], F8_SW)};
            *(u32x2*)((unsigned char*)WT + (size_t)(n0 + n) * K + k0 + 8 * c) = f8;
            if (WF != nullptr) *(u32x2*)((unsigned char*)WF + fo8_index(n0 + n, k0 + 8 * c, K)) = f8;
            continue; }
        u32x4 o; o.x = cvt_pk_bf16(s[0 * 33], s[1 * 33]); o.y = cvt_pk_bf16(s[2 * 33], s[3 * 33]); o.z = cvt_pk_bf16(s[4 * 33], s[5 * 33]); o.w = cvt_pk_bf16(s[6 * 33], s[7 * 33]);
        if constexpr (!SrcFn::F8) *(u32x4*)(WT + (size_t)(n0 + n) * K + k0 + 8 * c) = o;
        if (WF != nullptr && n0 >= fo_row0) *(u32x4*)(WF + fo_index(n0 + n - fo_row0, k0 + 8 * c, K)) = o; }
    asm volatile("s_waitcnt lgkmcnt(0)" ::: "memory");
}
struct SrcPlain { static constexpr bool F8 = false; const float* W; int N; __device__ __forceinline__ int stride() const { return N; } __device__ __forceinline__ const float* operator()(int n) const { return W + n; } };
struct SrcPlain8 { static constexpr bool F8 = true; const float* W; int N; __device__ __forceinline__ int stride() const { return N; } __device__ __forceinline__ const float* operator()(int n) const { return W + n; } };
struct SrcUp { static constexpr bool F8 = true; const float* W1; const float* W3; __device__ __forceinline__ int stride() const { return DFF; } __device__ __forceinline__ const float* operator()(int n) const { const int T = n >> 8, i = n & 255; const uintptr_t a = (uintptr_t)W1, b = (uintptr_t)W3, msk = (uintptr_t)0 - (uintptr_t)(i >> 7);
        return (const float*)((a & ~msk) | (b & msk)) + 128 * T + (i & 127); } };
struct SrcWin { static constexpr bool F8 = false; const float* W; __device__ __forceinline__ int stride() const { return 13352; } __device__ __forceinline__ const float* operator()(int r) const { int o;
        if (r < 6144) o = r; else if (r < 8192) o = 6152 + (r - 6144); else if (r < 11264) o = 8200 + (r - 8192); else if (r < 13312) o = 11304 + (r - 11264);
        else if (r < 13320) o = 6144 + (r - 13312); else if (r < 13352) o = 11272 + (r - 13320); else return nullptr;
        return W + o; } };

template <int PPART>
__device__ __forceinline__ void phase_prep(Frame& F, const Params& p) {
    LAS float* scr = (LAS float*)(F.lds + F.wave * 16384);
    const int gw = (PPART == 0 ? F.bx : F.bx - 192) * 8 + F.wave, NGW = (PPART == 0 ? F.G : 64) * 8;
    bf16_t* wup1 = (bf16_t*)(F.ws + WS_WUP1); bf16_t* wdn1 = (bf16_t*)(F.ws + WS_WDN1); bf16_t* wup2 = (bf16_t*)(F.ws + WS_WUP2); bf16_t* wdn2 = (bf16_t*)(F.ws + WS_WDN2);
    bf16_t* win = (bf16_t*)(F.ws + WS_WIN); bf16_t* wpa = (bf16_t*)(F.ws + WS_WPA); bf16_t* wpb = (bf16_t*)(F.ws + WS_WPB); bf16_t* wout = (bf16_t*)(F.ws + WS_WOUT);
    constexpr int I_UP = (DM / 64) * (2 * DFF / 32), I_DN = (DFF / 64) * (DM / 32), I_IN = (DM / 64) * (ZP / 32), I_P = (2048 / 64) * (DM / 32), I_O = (DM / 64) * (DM / 32);
    constexpr int NITEMS = 2 * I_UP + 2 * I_DN + I_IN + 2 * I_P + I_O;
    for (int it = (PPART == 0 ? 0 : I_UP) + gw; it < (PPART == 0 ? I_UP : NITEMS); it += NGW) {
        int r = it;
        if (r < I_UP) { transpose_item(SrcUp{PIN(13), PIN(14)}, DM, wup1, scr, r, F.lane, 2 * DFF / 32); continue; } r -= I_UP;
        if (r < I_UP) { transpose_item(SrcUp{PIN(32), PIN(33)}, DM, wup2, scr, r, F.lane, 2 * DFF / 32); continue; } r -= I_UP;
        if (r < I_DN) { transpose_item(SrcPlain8{PIN(15), DM}, DFF, wdn1, scr, r, F.lane, DM / 32, (bf16_t*)(F.ws + WS_FDN1)); continue; } r -= I_DN;
        if (r < I_DN) { transpose_item(SrcPlain8{PIN(34), DM}, DFF, wdn2, scr, r, F.lane, DM / 32, (bf16_t*)(F.ws + WS_FDN2)); continue; } r -= I_DN;
        if (r < I_IN) { transpose_item(SrcWin{PIN(17)}, DM, win, scr, r, F.lane, ZP / 32, (bf16_t*)(F.ws + WS_FG), ZG); continue; } r -= I_IN;
        if (r < I_P) { transpose_item(SrcPlain8{PIN(22), DM}, 2048, wpa, scr, r, F.lane, DM / 32, (bf16_t*)(F.ws + WS_FPA)); continue; } r -= I_P;
        if (r < I_P) { transpose_item(SrcPlain8{PIN(29), DM}, 2048, wpb, scr, r, F.lane, DM / 32, (bf16_t*)(F.ws + WS_FPB)); continue; } r -= I_P;
        transpose_item(SrcPlain8{PIN(30), DM}, DM, wout, scr, r, F.lane, DM / 32, (bf16_t*)(F.ws + WS_FOUT));
    }
    __syncthreads();
}
__device__ __forceinline__ void phase_silu_c(Frame& F, const Params& p) {
    const int ch = F.bx * NTHREADS + F.tid;
    if (ch < 144 * 128) { const int r = ch >> 7, k = 8 * (ch & 127); float x[8];
        if (r < NBID) { const float* cr = (r < NBP ? PIN(2) + (size_t)r * DM : PIN(3) + (size_t)(r - NBP) * DM) + k; const f32x4 c0 = *(const f32x4*)cr, c1 = *(const f32x4*)(cr + 4);
#pragma unroll
            for (int e = 0; e < 4; ++e) { x[e] = siluf_(c0[e]); x[4 + e] = siluf_(c1[e]); } }
        else {
#pragma unroll
            for (int e = 0; e < 8; ++e) x[e] = 0.f; }
        *(u32x4*)((bf16_t*)(F.ws + WS_SC) + fo_index(r, k, DM)) = pack8(x, 1.0f); }
}
__device__ __forceinline__ void phase_adaln(Frame& F, const Params& p) {
    const float* ada_w = PIN(10); const float* ada_b = PIN(11); float* mod = (float*)(F.ws + WS_MOD); const bf16_t* SCF = (const bf16_t*)(F.ws + WS_SC);
    LAS f32x4* PART = (LAS f32x4*)F.lds;
    const int lane = F.lane, w = F.wave, fr = lane & 15, fq = lane >> 4;
    const int t0 = F.bx < 64 ? 3 * F.bx : 192 + 2 * (F.bx - 64), nT = F.bx < 64 ? 3 : 2;
    f32x4 acc[3][9];
#pragma unroll
    for (int t = 0; t < 3; ++t)
#pragma unroll
        for (int rt = 0; rt < 9; ++rt) acc[t][rt] = (f32x4){0.f, 0.f, 0.f, 0.f};
#pragma unroll 1
    for (int ks = 0; ks < 4; ++ks) {
        const int k0 = 128 * w + 32 * ks + 8 * fq, kb = 4 * w + ks;
        bf16x8 af[9];
#pragma unroll
        for (int rt = 0; rt < 9; ++rt) af[rt] = *(const bf16x8*)(SCF + ((size_t)(rt * (DM / 32) + kb)) * 512 + 8 * lane);
#pragma unroll
        for (int t = 0; t < 3; ++t) if (t < nT) {
            float wv[8];
#pragma unroll
            for (int j = 0; j < 8; ++j) wv[j] = ada_w[(size_t)(k0 + j) * NMOD + 16 * (t0 + t) + fr];
            bf16x8 bfr; { const u32x4 tt = pack8(wv, 1.0f); bfr = __builtin_bit_cast(bf16x8, tt); }
#pragma unroll
            for (int rt = 0; rt < 9; ++rt) acc[t][rt] = __builtin_amdgcn_mfma_f32_16x16x32_bf16(af[rt], bfr, acc[t][rt], 0, 0, 0); }
    }
#pragma unroll
    for (int t = 0; t < 3; ++t) if (t < nT) {
        __syncthreads();
#pragma unroll
        for (int rt = 0; rt < 9; ++rt) PART[(w * 9 + rt) * 64 + lane] = acc[t][rt];
        __syncthreads();
        for (int idx = F.tid; idx < 9 * 64; idx += NTHREADS) { const int rt = idx >> 6, ln = idx & 63; f32x4 sum = PART[rt * 64 + ln];
#pragma unroll
            for (int ww = 1; ww < 8; ++ww) sum += PART[(ww * 9 + rt) * 64 + ln];
            const int n = 16 * (t0 + t) + (ln & 15); const float bv = ada_b[n];
#pragma unroll
            for (int r = 0; r < 4; ++r) { const int row = 16 * rt + 4 * (ln >> 4) + r; if (row < NBID) mod[(size_t)row * NMOD + n] = sum[r] + bv; } } }
}

__device__ __forceinline__ void phase_norm_mod(Frame& F, const float* xp, const float* xs, const float* gw, int shoff, int scoff, bf16_t* U) {
    const float* mod = (const float*)(F.ws + WS_MOD);
    const int gwv = F.bx * 8 + F.wave, NGW = F.G * 8;
    f32x4 g[4];
#pragma unroll
    for (int j = 0; j < 4; ++j) g[j] = *(const f32x4*)(gw + 4 * F.lane + 256 * j);
    for (int m = gwv; m < MT; m += NGW) {
        const float* xr = m < MP ? xp + (size_t)m * DM : xs + (size_t)(m - MP) * DM;
        const float* mr = mod + (size_t)pg8::bid_of_row(m) * NMOD;
        f32x4 v[4]; float s = 0.f;
#pragma unroll
        for (int j = 0; j < 4; ++j) { v[j] = *(const f32x4*)(xr + 4 * F.lane + 256 * j); s += (v[j][0] * v[j][0] + v[j][1] * v[j][1]) + (v[j][2] * v[j][2] + v[j][3] * v[j][3]); }
        const float r = 1.0f / sqrtf(wave_sum(s) * (1.0f / DM) + EPS);
#pragma unroll
        for (int j = 0; j < 4; ++j) { const f32x4 sh = *(const f32x4*)(mr + shoff + 4 * F.lane + 256 * j), scv = *(const f32x4*)(mr + scoff + 4 * F.lane + 256 * j);
            const f32x4 o = (v[j] * r * g[j]) * (1.0f + scv) + sh;
            *(unsigned*)((unsigned char*)U + (size_t)m * DM + 4 * F.lane + 256 * j) = pack4_fp8(o[0], o[1], o[2], o[3], F8_SA); }
    }
}
__device__ __forceinline__ void phase_final_norm(Frame& F, float* Y, const float* gw) {
    const int gwv = F.bx * 8 + F.wave, NGW = F.G * 8;
    f32x4 g[4];
#pragma unroll
    for (int j = 0; j < 4; ++j) g[j] = *(const f32x4*)(gw + 4 * F.lane + 256 * j);
    for (int m = gwv; m < MT; m += NGW) {
        float* xr = Y + (size_t)m * DM;
        f32x4 v[4]; float s = 0.f;
#pragma unroll
        for (int j = 0; j < 4; ++j) { v[j] = *(const f32x4*)(xr + 4 * F.lane + 256 * j); s += (v[j][0] * v[j][0] + v[j][1] * v[j][1]) + (v[j][2] * v[j][2] + v[j][3] * v[j][3]); }
        const float r = 1.0f / sqrtf(wave_sum(s) * (1.0f / DM) + EPS);
#pragma unroll
        for (int j = 0; j < 4; ++j) *(f32x4*)(xr + 4 * F.lane + 256 * j) = v[j] * r * g[j];
    }
}

constexpr size_t O_Y = 0, O_PC = 17825792, O_PN = 22020096, O_PM = 22028288, O_PMC = 22028320, O_PSSM = 22077472, O_PSC = 24174624,
                 O_SC = 24248352, O_SN = 91357216, O_SM = 91488288, O_SMC = 91488800, O_SSSM = 92275232, O_SSC = 125829664, O_END = 127009312;
constexpr int CVP = 5120;

__device__ __forceinline__ bf16x8 frag_row(LAS unsigned char* base, int stride, int row0, int k0, int lane) {
    return *(const LAS bf16x8*)(base + (row0 + (lane & 15)) * stride + (k0 + 8 * (lane >> 4)) * 2);
}
__device__ __forceinline__ bf16x8 frag_tr(LAS unsigned char* base, int stride, int krow0, int col0, int lane) {
    const int g = lane >> 4, q = (lane & 15) >> 2, pp = lane & 3;
    LAS unsigned char* a = base + (krow0 + 8 * g + q) * stride + (col0 + 4 * pp) * 2;
    const s16x4 lo = __builtin_amdgcn_ds_read_tr16_b64_v4i16((LAS s16x4*)a);
    const s16x4 hi = __builtin_amdgcn_ds_read_tr16_b64_v4i16((LAS s16x4*)(a + 4 * stride));
    return (bf16x8){lo.x, lo.y, lo.z, lo.w, hi.x, hi.y, hi.z, hi.w};
}
#define MFMA16(a, b, c) __builtin_amdgcn_mfma_f32_16x16x32_bf16((a), (b), (c), 0, 0, 0)

__device__ __forceinline__ float fast_log1pexp_neg(float ax) { return __builtin_amdgcn_logf(1.0f + fast_exp(-ax)) * 0.6931471805599453f; }
__device__ __forceinline__ float logsigmoidf_(float x) { return fminf(x, 0.f) - log1pf(expf(-fabsf(x))); }
__device__ __forceinline__ float softplusf_(float x) { return fmaxf(x, 0.f) + log1pf(expf(-fabsf(x))); }

__device__ __forceinline__ void conv_item(Frame& F, const Params& p, const int it) {
    const bf16_t* Z = (const bf16_t*)(F.ws + WS_ZIN); bf16_t* CV = (bf16_t*)(F.ws + WS_CV);
    const int lane = F.lane;
    {
        int m0, tb, nrows, strip; const float* hist = nullptr;
        if (it < 5120) { const int b = it / 640, r = it % 640; strip = r % 10; tb = (r / 10) * 32; m0 = b * SEQ; nrows = 32; }
        else { const int j = it - 5120, bs = j / 10; strip = j % 10; tb = 0; m0 = MP + bs * TS; nrows = 8; hist = strip < 4 ? PIN(7) + (size_t)bs * 3 * 2048 : PIN(9) + (size_t)bs * 3 * 3072; }
        const bool isM = strip < 4;
        const int c = strip * 512 + 8 * lane, zc = isM ? c : ZX + (c - 2048), cc = isM ? c : c - 2048, cs = isM ? 2048 : 3072;
        const float* cw = isM ? PIN(18) : PIN(23); const float* cb = isM ? PIN(19) : PIN(24);
        const float scl = (strip == 2 || strip == 3) ? 0.0625f : 1.0f;
        float w[4][8], bb[8], x0[8], x1[8], x2[8];
#pragma unroll
        for (int j = 0; j < 4; ++j) { const f32x4 a = *(const f32x4*)(cw + (size_t)j * cs + cc), b = *(const f32x4*)(cw + (size_t)j * cs + cc + 4);
#pragma unroll
            for (int e = 0; e < 4; ++e) { w[j][e] = a[e]; w[j][4 + e] = b[e]; } }
        { const f32x4 a = *(const f32x4*)(cb + cc), b = *(const f32x4*)(cb + cc + 4);
#pragma unroll
            for (int e = 0; e < 4; ++e) { bb[e] = a[e]; bb[4 + e] = b[e]; } }
        if (tb > 0) { unpack8(*(const u32x4*)(Z + (size_t)(m0 + tb - 3) * ZP + zc), x0); unpack8(*(const u32x4*)(Z + (size_t)(m0 + tb - 2) * ZP + zc), x1); unpack8(*(const u32x4*)(Z + (size_t)(m0 + tb - 1) * ZP + zc), x2); }
        else if (hist != nullptr) {
#pragma unroll
            for (int e = 0; e < 8; ++e) { x0[e] = hist[cc + e]; x1[e] = hist[cs + cc + e]; x2[e] = hist[2 * cs + cc + e]; } }
        else {
#pragma unroll
            for (int e = 0; e < 8; ++e) { x0[e] = 0.f; x1[e] = 0.f; x2[e] = 0.f; } }
        for (int t = 0; t < nrows; t += 8) {
            u32x4 raw[8];
#pragma unroll
            for (int i = 0; i < 8; ++i) raw[i] = *(const u32x4*)(Z + (size_t)(m0 + tb + t + i) * ZP + zc);
#pragma unroll
            for (int i = 0; i < 8; ++i) { float x3[8], o[8]; unpack8(raw[i], x3);
#pragma unroll
                for (int e = 0; e < 8; ++e) { o[e] = siluf_(bb[e] + w[0][e] * x0[e] + w[1][e] * x1[e] + w[2][e] * x2[e] + w[3][e] * x3[e]); x0[e] = x1[e]; x1[e] = x2[e]; x2[e] = x3[e]; }
                *(u32x4*)(CV + (size_t)(m0 + tb + t + i) * CVP + c) = pack8(o, scl); }
        }
    }
}
constexpr int NS_EARLY = 64;
__device__ __forceinline__ void phase_conv(Frame& F, const Params& p) {
    const int gw = F.bx * 8 + F.wave, NGW = F.G * 8;
    for (int it = gw; it < 5120 + 1280 - 10 * NS_EARLY; it += NGW) conv_item(F, p, it < 5120 ? it : it + 10 * NS_EARLY);
}

constexpr int QSTR = 528, VSTR = 144;
constexpr int L_QS = 0, L_KS = 33792, L_CT = 67584, L_VS = 101376, L_VW = 110592, L_SB = 119808, L_SCAL = 129024, L_NST = 132096, L_QNP = 133120, L_DENP = 135168, L_NUMB = 135680;

__device__ __forceinline__ float mlstm_scan(float ipre, float fpre, int lane, float mstate, LAS float* sc) {
    const float lf = fminf(fpre, 0.f) - fast_log1pexp_neg(fabsf(fpre));
    const float b = wave_scan_add(lf);
    const float a = ipre - b;
    const float cm = wave_scan_max(a);
    const float A = fmaxf(mstate, cm);
    const float Alast = __shfl(A, 63), blast = __shfl(b, 63);
    sc[lane] = a; sc[64 + lane] = A; sc[128 + lane] = fast_exp(mstate - A); sc[192 + lane] = fast_exp(-(b + A)); sc[256 + lane] = fast_exp(a - Alast);
    if (lane == 0) sc[320] = fast_exp(mstate - Alast);
    return blast + Alast;
}

__device__ __forceinline__ void mlstm_prompt_item(Frame& F, const Params& p, const int b, const int h, const int vs) {
    LAS unsigned char* L = F.lds;
    const int tid = F.tid, lane = F.lane, w = F.wave, fr = lane & 15, fq = lane >> 4;
    const bf16_t* Z = (const bf16_t*)(F.ws + WS_ZIN); const bf16_t* CV = (const bf16_t*)(F.ws + WS_CV); const float* GT = (const float*)(F.ws + WS_GATES);
    bf16_t* NUM = (bf16_t*)(F.ws + WS_NUM); float* DEN = (float*)(F.ws + WS_DEN);
    const float ifbi = PIN(20)[h], ifbf = PIN(20)[4 + h];
    constexpr int nch = SEQ / 64; const int m0 = b * SEQ;
    LAS float* SC = (LAS float*)(L + L_SCAL); LAS unsigned char* NSTB = L + L_NST; LAS float* DENP = (LAS float*)(L + L_DENP);
    f32x4 cacc[2][4];
#pragma unroll
    for (int dt = 0; dt < 2; ++dt)
#pragma unroll
        for (int vi = 0; vi < 4; ++vi) cacc[dt][vi] = (f32x4){0.f, 0.f, 0.f, 0.f};
    f32x4 nacc[2] = {{0.f, 0.f, 0.f, 0.f}, {0.f, 0.f, 0.f, 0.f}};
    float mstate = 0.f;
    u32x4 pq[4], pk[4], pv; float gi = 0.f, gf = 0.f;
    const bf16_t* qsrc = CV + (size_t)(m0 + (tid >> 5)) * CVP + h * 256 + 8 * (tid & 31);
    const bf16_t* vsrc = Z + (size_t)(m0 + (tid >> 3)) * ZP + ZV + h * 512 + vs * 64 + 8 * (tid & 7);
    const float* gsrc = GT + (size_t)(m0 + lane) * 64 + h;
#define ML_LOAD(c) do { _Pragma("unroll") for (int i = 0; i < 4; ++i) { pq[i] = *(const u32x4*)(qsrc + (size_t)((c) * 64 + 16 * i) * CVP); pk[i] = *(const u32x4*)(qsrc + (size_t)((c) * 64 + 16 * i) * CVP + 1024); } \
        pv = *(const u32x4*)(vsrc + (size_t)((c) * 64) * ZP); if (w == 0) { gi = gsrc[(size_t)((c) * 64) * 64]; gf = gsrc[(size_t)((c) * 64) * 64 + 4]; } } while (0)
    u32x4 numst = {0u, 0u, 0u, 0u}; float denst = 0.f;
    bf16_t* numdst = NUM + (size_t)(m0 + (tid >> 3)) * 2048 + h * 512 + vs * 64 + 8 * (tid & 7);
#define ML_STORE(c) do { *(u32x4*)(numdst + (size_t)((c) * 64) * 2048) = numst; \
        if (vs == 0 && w < 4 && fq == 0) DEN[(size_t)(m0 + (c) * 64 + 16 * w + fr) * 4 + h] = denst; } while (0)
    ML_LOAD(0);
    __syncthreads();
#pragma unroll
    for (int dt = 0; dt < 2; ++dt)
#pragma unroll
        for (int vi = 0; vi < 4; ++vi) *(LAS u32x2*)(L + L_CT + (16 * vi + fr) * QSTR + (32 * w + 16 * dt + 4 * fq) * 2) = (u32x2){0u, 0u};
    if (tid < 128) *(LAS unsigned*)(NSTB + 4 * tid) = 0u;
    if (w == 0) mstate = mlstm_scan(gi + ifbi, gf + ifbf, lane, mstate, SC);
    __syncthreads();
    for (int c = 0; c < nch; ++c) {
        const int t0 = 64 * c; LAS float* sc = SC + (c & 1) * 384;
#pragma unroll
        for (int i = 0; i < 4; ++i) { const int v = tid + NTHREADS * i, row = v >> 5, c16 = v & 31; *(LAS u32x4*)(L + L_QS + row * QSTR + 16 * c16) = pq[i]; *(LAS u32x4*)(L + L_KS + row * QSTR + 16 * c16) = pk[i]; }
        { const int row = tid >> 3, c8 = tid & 7; *(LAS u32x4*)(L + L_VS + row * VSTR + 16 * c8) = pv; float x[8]; unpack8(pv, x); *(LAS u32x4*)(L + L_VW + row * VSTR + 16 * c8) = pack8(x, sc[256 + row]); }
        __syncthreads();
        if (c > 0) { ML_STORE(c - 1); }
        if (c + 1 < nch) ML_LOAD(c + 1);
        const int ti = w & 3, hf = w >> 2;
        bf16x8 qf[8];
#pragma unroll
        for (int k = 0; k < 8; ++k) qf[k] = frag_row(L + L_QS, QSTR, 16 * ti, 32 * k, lane);
        { f32x4 sacc[2] = {{0.f, 0.f, 0.f, 0.f}, {0.f, 0.f, 0.f, 0.f}};
#pragma unroll
          for (int j = 0; j < 2; ++j) { const int si = 2 * hf + j; if (si <= ti) {
#pragma unroll
                  for (int k = 0; k < 8; ++k) sacc[j] = MFMA16(frag_row(L + L_KS, QSTR, 16 * si, 32 * k, lane), qf[k], sacc[j]); } }
          const int t = 16 * ti + fr; const float At = sc[64 + t]; float dpart = 0.f;
#pragma unroll
          for (int j = 0; j < 2; ++j) { const int si = 2 * hf + j, s0 = 16 * si + 4 * fq; const f32x4 av = *(const LAS f32x4*)(sc + s0); f32x4 vv;
#pragma unroll
              for (int r = 0; r < 4; ++r) { const float wgt = (s0 + r <= t) ? fast_exp(av[r] - At) : 0.f; vv[r] = (si <= ti) ? sacc[j][r] * wgt : 0.f; dpart += vv[r]; }
              *(LAS u32x2*)(L + L_SB + t * VSTR + s0 * 2) = pack4(vv); }
          dpart += __shfl_xor(dpart, 16); dpart += __shfl_xor(dpart, 32);
          if (lane < 16) DENP[hf * 64 + 16 * ti + lane] = dpart; }
        __syncthreads();
        { f32x4 uacc[2] = {{0.f, 0.f, 0.f, 0.f}, {0.f, 0.f, 0.f, 0.f}};
#pragma unroll
          for (int j = 0; j < 2; ++j) { const int vi = 2 * hf + j;
#pragma unroll
              for (int k = 0; k < 8; ++k) uacc[j] = MFMA16(frag_row(L + L_CT, QSTR, 16 * vi, 32 * k, lane), qf[k], uacc[j]); }
          const float wst = sc[128 + 16 * ti + fr]; uacc[0] *= wst; uacc[1] *= wst;
#pragma unroll
          for (int ks = 0; ks < 2; ++ks) if (32 * ks <= 16 * ti + 15) { const bf16x8 sb = frag_row(L + L_SB, VSTR, 16 * ti, 32 * ks, lane);
#pragma unroll
              for (int j = 0; j < 2; ++j) uacc[j] = MFMA16(frag_tr(L + L_VS, VSTR, 32 * ks, 16 * (2 * hf + j), lane), sb, uacc[j]); }
#pragma unroll
          for (int j = 0; j < 2; ++j) *(LAS u32x2*)(L + L_NUMB + (16 * ti + fr) * VSTR + (16 * (2 * hf + j) + 4 * fq) * 2) = pack4(uacc[j]); }
        if (vs == 0 && hf == 0) {
            f32x4 qn = {0.f, 0.f, 0.f, 0.f};
#pragma unroll
            for (int k = 0; k < 8; ++k) { u32x4 nv = *(const LAS u32x4*)(NSTB + 64 * k + 16 * fq); if (fr != 0) nv = (u32x4){0u, 0u, 0u, 0u};
                qn = MFMA16(__builtin_bit_cast(bf16x8, nv), qf[k], qn); }
            const int t = 16 * ti + fr; const float den = DENP[t] + DENP[64 + t] + sc[128 + t] * qn[0];
            denst = fmaxf(fabsf(den), sc[192 + t]); }
        { const float decay = sc[320];
#pragma unroll
          for (int dt = 0; dt < 2; ++dt)
#pragma unroll
              for (int vi = 0; vi < 4; ++vi) cacc[dt][vi] *= decay;
#pragma unroll
          for (int ks = 0; ks < 2; ++ks) { bf16x8 ka[2];
#pragma unroll
              for (int dt = 0; dt < 2; ++dt) ka[dt] = frag_tr(L + L_KS, QSTR, 32 * ks, 32 * w + 16 * dt, lane);
#pragma unroll
              for (int vi = 0; vi < 4; ++vi) { const bf16x8 vb = frag_tr(L + L_VW, VSTR, 32 * ks, 16 * vi, lane);
#pragma unroll
                  for (int dt = 0; dt < 2; ++dt) cacc[dt][vi] = MFMA16(ka[dt], vb, cacc[dt][vi]); } }
          if (vs == 0) { nacc[0] *= decay; nacc[1] *= decay;
#pragma unroll
              for (int ks = 0; ks < 2; ++ks) { const f32x4 w0 = *(const LAS f32x4*)(sc + 256 + 32 * ks + 8 * fq), w1 = *(const LAS f32x4*)(sc + 256 + 32 * ks + 8 * fq + 4);
                  u32x4 wv; wv.x = cvt_pk_bf16(w0[0], w0[1]); wv.y = cvt_pk_bf16(w0[2], w0[3]); wv.z = cvt_pk_bf16(w1[0], w1[1]); wv.w = cvt_pk_bf16(w1[2], w1[3]);
                  if (fr != 0) wv = (u32x4){0u, 0u, 0u, 0u};
#pragma unroll
                  for (int dt = 0; dt < 2; ++dt) nacc[dt] = MFMA16(frag_tr(L + L_KS, QSTR, 32 * ks, 32 * w + 16 * dt, lane), __builtin_bit_cast(bf16x8, wv), nacc[dt]); } } }
        if (w == 0 && c + 1 < nch) mstate = mlstm_scan(gi + ifbi, gf + ifbf, lane, mstate, SC + ((c + 1) & 1) * 384);
        __syncthreads();
        numst = *(const LAS u32x4*)(L + L_NUMB + (tid >> 3) * VSTR + 16 * (tid & 7));
#pragma unroll
        for (int dt = 0; dt < 2; ++dt)
#pragma unroll
            for (int vi = 0; vi < 4; ++vi) *(LAS u32x2*)(L + L_CT + (16 * vi + fr) * QSTR + (32 * w + 16 * dt + 4 * fq) * 2) = pack4(cacc[dt][vi]);
        if (vs == 0 && fr == 0) {
#pragma unroll
            for (int dt = 0; dt < 2; ++dt) *(LAS u32x2*)(NSTB + (32 * w + 16 * dt + 4 * fq) * 2) = pack4(nacc[dt]); }
    }
    ML_STORE(nch - 1);
#undef ML_LOAD
#undef ML_STORE
    float* Cout = F.out + O_PC + (size_t)(b * 4 + h) * 131072;
#pragma unroll
    for (int dt = 0; dt < 2; ++dt)
#pragma unroll
        for (int vi = 0; vi < 4; ++vi)
#pragma unroll
            for (int r = 0; r < 4; ++r) { const int d = 32 * w + 16 * dt + 4 * fq + r, v = 16 * vi + fr; Cout[(size_t)d * 512 + vs * 64 + v] = cacc[dt][vi][r]; }
    if (vs == 0) { if (fr == 0) {
#pragma unroll
            for (int dt = 0; dt < 2; ++dt)
#pragma unroll
                for (int r = 0; r < 4; ++r) F.out[O_PN + (size_t)(b * 4 + h) * 256 + 32 * w + 16 * dt + 4 * fq + r] = nacc[dt][r]; }
        if (tid == 0) F.out[O_PM + b * 4 + h] = mstate; }
}

constexpr int XSTR = 144, BSTR = 272;
constexpr int S_XS = 0, S_XD = 9216, S_XW = 18432, S_BS = 27648, S_CS = 45056, S_HS = 62464, S_GB = 79872, S_SCAL = 89088, S_YB = 98304;

__device__ __forceinline__ void ssd_scan(float dtp, float Ae, int lane, LAS float* sc) {
    const float dt = fmaxf(dtp, 0.f) + fast_log1pexp_neg(fabsf(dtp));
    const float cum = wave_scan_add(dt * Ae);
    const float cl = __shfl(cum, 63);
    sc[lane] = cum; sc[64 + lane] = dt; sc[128 + lane] = fast_exp(cl - cum); sc[192 + lane] = fast_exp(cum);
    if (lane == 0) sc[256] = fast_exp(cl);
}

__device__ __forceinline__ void ssd_prompt_item(Frame& F, const Params& p, const int b, const int e) {
    LAS unsigned char* L = F.lds;
    const int tid = F.tid, lane = F.lane, w = F.wave, fr = lane & 15, fq = lane >> 4;
    const bf16_t* CV = (const bf16_t*)(F.ws + WS_CV); const float* GT = (const float*)(F.ws + WS_GATES);
    bf16_t* YS = (bf16_t*)(F.ws + WS_YS);
    const int g = e >> 3, m0 = b * SEQ; constexpr int nch = SEQ / 64;
    const float dtb = PIN(25)[e], Ae = -expf(PIN(26)[e]), De = PIN(27)[e];
    LAS float* SC = (LAS float*)(L + S_SCAL);
    f32x4 hacc[4];
#pragma unroll
    for (int pi = 0; pi < 4; ++pi) hacc[pi] = (f32x4){0.f, 0.f, 0.f, 0.f};
    u32x4 px, pb[2], pc[2]; float gd = 0.f;
    const bf16_t* xsrc = CV + (size_t)(m0 + (tid >> 3)) * CVP + 2048 + e * 64 + 8 * (tid & 7);
    const bf16_t* bsrc = CV + (size_t)(m0 + (tid >> 4)) * CVP + 4096 + g * 128 + 8 * (tid & 15);
    const float* gsrc = GT + (size_t)(m0 + lane) * 64 + 8 + e;
#define SD_LOAD(c) do { px = *(const u32x4*)(xsrc + (size_t)((c) * 64) * CVP); _Pragma("unroll") for (int i = 0; i < 2; ++i) { pb[i] = *(const u32x4*)(bsrc + (size_t)((c) * 64 + 32 * i) * CVP); pc[i] = *(const u32x4*)(bsrc + (size_t)((c) * 64 + 32 * i) * CVP + 512); } \
        if (w == 0) gd = gsrc[(size_t)((c) * 64) * 64]; } while (0)
    u32x4 yst = {0u, 0u, 0u, 0u};
    bf16_t* ydst = YS + (size_t)(m0 + (tid >> 3)) * 2048 + e * 64 + 8 * (tid & 7);
#define SD_STORE(c) do { *(u32x4*)(ydst + (size_t)((c) * 64) * 2048) = yst; } while (0)
    SD_LOAD(0);
    __syncthreads();
#pragma unroll
    for (int pi = 0; pi < 4; ++pi) *(LAS u32x2*)(L + S_HS + (16 * pi + fr) * BSTR + (16 * w + 4 * fq) * 2) = (u32x2){0u, 0u};
    if (w == 0) ssd_scan(gd + dtb, Ae, lane, SC);
    __syncthreads();
    for (int c = 0; c < nch; ++c) {
        const int t0 = 64 * c; LAS float* sc = SC + (c & 1) * 320;
        { const int row = tid >> 3, c8 = tid & 7; const float dt = sc[64 + row], ed = sc[128 + row]; float x[8]; unpack8(px, x);
          *(LAS u32x4*)(L + S_XS + row * XSTR + 16 * c8) = px; *(LAS u32x4*)(L + S_XD + row * XSTR + 16 * c8) = pack8(x, dt); *(LAS u32x4*)(L + S_XW + row * XSTR + 16 * c8) = pack8(x, dt * ed); }
#pragma unroll
        for (int i = 0; i < 2; ++i) { const int row = (tid >> 4) + 32 * i, c16 = tid & 15; *(LAS u32x4*)(L + S_BS + row * BSTR + 16 * c16) = pb[i]; *(LAS u32x4*)(L + S_CS + row * BSTR + 16 * c16) = pc[i]; }
        __syncthreads();
        if (c > 0) { SD_STORE(c - 1); }
        if (c + 1 < nch) SD_LOAD(c + 1);
        const int ti = w & 3, hf = w >> 2;
        bf16x8 cf[4];
#pragma unroll
        for (int k = 0; k < 4; ++k) cf[k] = frag_row(L + S_CS, BSTR, 16 * ti, 32 * k, lane);
        { f32x4 gacc[2] = {{0.f, 0.f, 0.f, 0.f}, {0.f, 0.f, 0.f, 0.f}};
#pragma unroll
          for (int j = 0; j < 2; ++j) { const int si = 2 * hf + j; if (si <= ti) {
#pragma unroll
                  for (int k = 0; k < 4; ++k) gacc[j] = MFMA16(frag_row(L + S_BS, BSTR, 16 * si, 32 * k, lane), cf[k], gacc[j]); } }
          const int t = 16 * ti + fr; const float cumt = sc[t];
#pragma unroll
          for (int j = 0; j < 2; ++j) { const int si = 2 * hf + j, s0 = 16 * si + 4 * fq; const f32x4 cs = *(const LAS f32x4*)(sc + s0); f32x4 vv;
#pragma unroll
              for (int r = 0; r < 4; ++r) vv[r] = (si <= ti && s0 + r <= t) ? gacc[j][r] * fast_exp(cumt - cs[r]) : 0.f;
              *(LAS u32x2*)(L + S_GB + t * XSTR + s0 * 2) = pack4(vv); } }
        __syncthreads();
        { f32x4 yacc[2] = {{0.f, 0.f, 0.f, 0.f}, {0.f, 0.f, 0.f, 0.f}};
#pragma unroll
          for (int j = 0; j < 2; ++j) { const int pi = 2 * hf + j;
#pragma unroll
              for (int k = 0; k < 4; ++k) yacc[j] = MFMA16(frag_row(L + S_HS, BSTR, 16 * pi, 32 * k, lane), cf[k], yacc[j]); }
          const int t = 16 * ti + fr; const float ec = sc[192 + t]; yacc[0] *= ec; yacc[1] *= ec;
#pragma unroll
          for (int ks = 0; ks < 2; ++ks) if (32 * ks <= 16 * ti + 15) { const bf16x8 gb = frag_row(L + S_GB, XSTR, 16 * ti, 32 * ks, lane);
#pragma unroll
              for (int j = 0; j < 2; ++j) yacc[j] = MFMA16(frag_tr(L + S_XD, XSTR, 32 * ks, 16 * (2 * hf + j), lane), gb, yacc[j]); }
#pragma unroll
          for (int j = 0; j < 2; ++j) { const int p0 = 16 * (2 * hf + j) + 4 * fq; const u32x2 xv = *(const LAS u32x2*)(L + S_XS + t * XSTR + p0 * 2);
              f32x4 y = yacc[j]; y[0] += De * bflo(xv.x); y[1] += De * bfhi(xv.x); y[2] += De * bflo(xv.y); y[3] += De * bfhi(xv.y);
              *(LAS u32x2*)(L + S_YB + t * XSTR + p0 * 2) = pack4(y); } }
        { const float eall = sc[256];
#pragma unroll
          for (int pi = 0; pi < 4; ++pi) hacc[pi] *= eall;
#pragma unroll
          for (int ks = 0; ks < 2; ++ks) { const bf16x8 ba = frag_tr(L + S_BS, BSTR, 32 * ks, 16 * w, lane);
#pragma unroll
              for (int pi = 0; pi < 4; ++pi) hacc[pi] = MFMA16(ba, frag_tr(L + S_XW, XSTR, 32 * ks, 16 * pi, lane), hacc[pi]); } }
        if (w == 0 && c + 1 < nch) ssd_scan(gd + dtb, Ae, lane, SC + ((c + 1) & 1) * 320);
        __syncthreads();
        yst = *(const LAS u32x4*)(L + S_YB + (tid >> 3) * XSTR + 16 * (tid & 7));
#pragma unroll
        for (int pi = 0; pi < 4; ++pi) *(LAS u32x2*)(L + S_HS + (16 * pi + fr) * BSTR + (16 * w + 4 * fq) * 2) = pack4(hacc[pi]);
    }
    SD_STORE(nch - 1);
#undef SD_LOAD
#undef SD_STORE
    float* hout = F.out + O_PSSM + (size_t)(b * 32 + e) * 8192;
#pragma unroll
    for (int pi = 0; pi < 4; ++pi) *(f32x4*)(hout + (size_t)(16 * pi + fr) * 128 + 16 * w + 4 * fq) = hacc[pi];
}

__device__ __forceinline__ void mlstm_sample_item(Frame& F, const Params& p, const int bs, const int h) {
    LAS unsigned char* L = F.lds; const int tid = F.tid, lane = F.lane, w = F.wave;
    const bf16_t* Z = (const bf16_t*)(F.ws + WS_ZIN); const bf16_t* CV = (const bf16_t*)(F.ws + WS_CV); const float* GT = (const float*)(F.ws + WS_GATES);
    bf16_t* NUM = (bf16_t*)(F.ws + WS_NUM); float* DEN = (float*)(F.ws + WS_DEN);
    const int m0 = MP + bs * TS;
    const float* C0 = PIN(4) + (size_t)(bs * 4 + h) * 131072; float* C1 = F.out + O_SC + (size_t)(bs * 4 + h) * 131072;
    LAS float* QKW = (LAS float*)L; LAS float* RED = (LAS float*)(L + 16384); LAS float* NS = (LAS float*)(L + 81920);
    LAS float* SCs = (LAS float*)(L + 82944); LAS float* SW = (LAS float*)(L + 83200); LAS float* QN = (LAS float*)(L + 83456);
    const int v4 = tid & 127, dp = tid >> 7;
    f32x4 vreg[8];
#pragma unroll
    for (int s = 0; s < 8; ++s) { const u32x2 vv = *(const u32x2*)(Z + (size_t)(m0 + s) * ZP + ZV + h * 512 + 4 * v4); vreg[s] = (f32x4){bflo(vv.x), bfhi(vv.x), bflo(vv.y), bfhi(vv.y)}; }
    const u32x4 qk = *(const u32x4*)(CV + (size_t)(m0 + ((tid >> 5) & 7)) * CVP + (tid >> 8) * 1024 + h * 256 + 8 * (tid & 31));
    const float n0v = tid < 256 ? PIN(5)[(size_t)(bs * 4 + h) * 256 + tid] : 0.f;
    __syncthreads();
    { const int isk = tid >> 8, t = (tid >> 5) & 7, c16 = tid & 31; float x[8]; unpack8(qk, x);
#pragma unroll
      for (int e = 0; e < 8; ++e) QKW[(8 * c16 + e) * 16 + isk * 8 + t] = x[e]; }
    if (tid < 256) NS[tid] = n0v;
    if (w == 0) {
        const bool valid = lane < 8; const float mstate = PIN(6)[bs * 4 + h];
        float ipre = 0.f, fpre = 0.f; if (valid) { ipre = GT[(size_t)(m0 + lane) * 64 + h] + PIN(20)[h]; fpre = GT[(size_t)(m0 + lane) * 64 + 4 + h] + PIN(20)[4 + h]; }
        float bsum = valid ? logsigmoidf_(fpre) : 0.f;
#pragma unroll
        for (int o = 1; o < 8; o <<= 1) { const float u = __shfl_up(bsum, o); if (lane >= o) bsum += u; }
        const float a = valid ? ipre - bsum : -INFINITY;
        float cm = a;
#pragma unroll
        for (int o = 1; o < 8; o <<= 1) { const float u = __shfl_up(cm, o); if (lane >= o) cm = fmaxf(cm, u); }
        const float A = fmaxf(mstate, cm); const float Alast = __shfl(A, 7), blast = __shfl(bsum, 7);
        if (valid) { SCs[lane] = a; SCs[8 + lane] = A; SCs[16 + lane] = expf(mstate - A); SCs[24 + lane] = expf(-(bsum + A)); SCs[32 + lane] = expf(a - Alast); }
        if (lane == 0) { SCs[40] = expf(mstate - Alast); F.out[O_SM + bs * 4 + h] = blast + Alast; }
    }
    __syncthreads();
    { const int pr = tid >> 3, part = tid & 7, t = pr >> 3, s = pr & 7; float acc = 0.f;
#pragma unroll 8
      for (int dd = 0; dd < 32; ++dd) { const int d = part * 32 + dd; acc += QKW[d * 16 + t] * QKW[d * 16 + 8 + s]; }
      acc += __shfl_xor(acc, 1); acc += __shfl_xor(acc, 2); acc += __shfl_xor(acc, 4);
      if (part == 0) SW[t * 8 + s] = (s <= t) ? acc * expf(SCs[s] - SCs[8 + t]) : 0.f; }
    if (tid < 64) { const int t = tid >> 3, part = tid & 7; float acc = 0.f;
#pragma unroll 8
      for (int dd = 0; dd < 32; ++dd) { const int d = part * 32 + dd; acc += QKW[d * 16 + t] * NS[d]; }
      acc += __shfl_xor(acc, 1); acc += __shfl_xor(acc, 2); acc += __shfl_xor(acc, 4);
      if (part == 0) QN[t] = acc; }
    if (tid >= 256) { const int d = tid - 256; float s = 0.f;
#pragma unroll
        for (int si = 0; si < 8; ++si) s += SCs[32 + si] * QKW[d * 16 + 8 + si];
        F.out[O_SN + (size_t)(bs * 4 + h) * 256 + d] = SCs[40] * NS[d] + s; }
    __syncthreads();
    if (tid < 8) { const int t = tid; float den = 0.f;
#pragma unroll
        for (int s = 0; s < 8; ++s) den += SW[t * 8 + s];
        den += SCs[16 + t] * QN[t]; DEN[(size_t)(m0 + t) * 4 + h] = fmaxf(fabsf(den), SCs[24 + t]); }
    if (tid >= 256) { const int d = tid - 256;
#pragma unroll
        for (int si = 0; si < 8; ++si) QKW[d * 16 + 8 + si] *= SCs[32 + si]; }
    __syncthreads();
    { const float decay = SCs[40];
      f32x4 acc[8];
#pragma unroll
      for (int t = 0; t < 8; ++t) acc[t] = (f32x4){0.f, 0.f, 0.f, 0.f};
      const float* cin = C0 + (size_t)(dp * 64) * 512 + 4 * v4; float* cout = C1 + (size_t)(dp * 64) * 512 + 4 * v4;
#pragma unroll 1
      for (int d0 = 0; d0 < 64; d0 += 8) {
          f32x4 cc[8];
#pragma unroll
          for (int i = 0; i < 8; ++i) cc[i] = __builtin_nontemporal_load((const f32x4*)(cin + (size_t)(d0 + i) * 512));
#pragma unroll
          for (int i = 0; i < 8; ++i) { const LAS float* qp = QKW + (dp * 64 + d0 + i) * 16;
              const f32x4 q0 = *(const LAS f32x4*)qp, q1 = *(const LAS f32x4*)(qp + 4), k0 = *(const LAS f32x4*)(qp + 8), k1 = *(const LAS f32x4*)(qp + 12);
              f32x4 cn = decay * cc[i];
#pragma unroll
              for (int t = 0; t < 4; ++t) { acc[t] += q0[t] * cc[i]; acc[4 + t] += q1[t] * cc[i]; cn += k0[t] * vreg[t]; cn += k1[t] * vreg[4 + t]; }
              __builtin_nontemporal_store(cn, (f32x4*)(cout + (size_t)(d0 + i) * 512)); }
      }
#pragma unroll
      for (int t = 0; t < 8; ++t) *(LAS f32x4*)(RED + (size_t)(dp * 8 + t) * 512 + 4 * v4) = acc[t]; }
    __syncthreads();
    { const int t = tid >> 6, v8 = tid & 63; float s[8];
#pragma unroll
      for (int e = 0; e < 8; ++e) s[e] = 0.f;
#pragma unroll
      for (int dpp = 0; dpp < 4; ++dpp) { const f32x4 a = *(const LAS f32x4*)(RED + (size_t)(dpp * 8 + t) * 512 + 8 * v8), b = *(const LAS f32x4*)(RED + (size_t)(dpp * 8 + t) * 512 + 8 * v8 + 4);
#pragma unroll
          for (int e = 0; e < 4; ++e) { s[e] += a[e]; s[4 + e] += b[e]; } }
      const float wst = SCs[16 + t];
#pragma unroll
      for (int e = 0; e < 8; ++e) s[e] *= wst;
      for (int si = 0; si <= t; ++si) { const float sw = SW[t * 8 + si]; float x[8]; unpack8(*(const u32x4*)(Z + (size_t)(m0 + si) * ZP + ZV + h * 512 + 8 * v8), x);
#pragma unroll
          for (int e = 0; e < 8; ++e) s[e] += sw * x[e]; }
      *(u32x4*)(NUM + (size_t)(m0 + t) * 2048 + h * 512 + 8 * v8) = pack8(s, 1.0f); }
}

__device__ __forceinline__ void ssd_sample_item(Frame& F, const Params& p, const int bs, const int g) {
    LAS unsigned char* L = F.lds; const int tid = F.tid, lane = F.lane, w = F.wave;
    const bf16_t* CV = (const bf16_t*)(F.ws + WS_CV); const float* GT = (const float*)(F.ws + WS_GATES); bf16_t* YS = (bf16_t*)(F.ws + WS_YS);
    const int m0 = MP + bs * TS;
    LAS float* BSf = (LAS float*)L; LAS float* CSf = (LAS float*)(L + 4096); LAS float* XF = (LAS float*)(L + 8192); LAS float* XWt = (LAS float*)(L + 24576);
    LAS float* XDt = (LAS float*)(L + 40960); LAS float* SC2 = (LAS float*)(L + 57344); LAS float* CB = (LAS float*)(L + 58432); LAS float* YP = (LAS float*)(L + 59392);
    const u32x4 xr = *(const u32x4*)(CV + (size_t)(m0 + (tid >> 6)) * CVP + 2048 + g * 512 + 8 * (tid & 63));
    u32x4 bcr = {0u, 0u, 0u, 0u};
    if (tid < 256) bcr = *(const u32x4*)(CV + (size_t)(m0 + ((tid >> 4) & 7)) * CVP + 4096 + (tid >> 7) * 512 + g * 128 + 8 * (tid & 15));
    __syncthreads();
    { float x[8]; unpack8(xr, x); const int t = tid >> 6, c8 = tid & 63;
#pragma unroll
      for (int e = 0; e < 8; ++e) XF[t * 512 + 8 * c8 + e] = x[e]; }
    if (tid < 256) { float x[8]; unpack8(bcr, x); const int isC = tid >> 7, t = (tid >> 4) & 7, c16 = tid & 15; LAS float* dst = isC ? CSf : BSf;
#pragma unroll
      for (int e = 0; e < 8; ++e) dst[t * 128 + 8 * c16 + e] = x[e]; }
    { const int e = g * 8 + w; const bool valid = lane < 8; const float Ae = -expf(PIN(26)[e]);
      const float dt = valid ? softplusf_(GT[(size_t)(m0 + lane) * 64 + 8 + e] + PIN(25)[e]) : 0.f;
      float cum = dt * Ae;
#pragma unroll
      for (int o = 1; o < 8; o <<= 1) { const float u = __shfl_up(cum, o); if (lane >= o) cum += u; }
      const float cl = __shfl(cum, 7);
      if (valid) { SC2[w * 32 + lane] = cum; SC2[w * 32 + 8 + lane] = dt; SC2[w * 32 + 16 + lane] = expf(cl - cum); SC2[w * 32 + 24 + lane] = expf(cum); }
      if (lane == 0) SC2[256 + w] = expf(cl); }
    __syncthreads();
    { const int pr = tid >> 3, part = tid & 7, t = pr >> 3, s = pr & 7; float acc = 0.f;
#pragma unroll
      for (int nn = 0; nn < 16; ++nn) { const int n = part * 16 + nn; acc += CSf[t * 128 + n] * BSf[s * 128 + n]; }
      acc += __shfl_xor(acc, 1); acc += __shfl_xor(acc, 2); acc += __shfl_xor(acc, 4);
      if (part == 0) CB[t * 8 + s] = acc; }
    { const int el = tid >> 6;
#pragma unroll
      for (int s = 0; s < 8; ++s) { const float x = XF[s * 512 + tid], dt = SC2[el * 32 + 8 + s], ed = SC2[el * 32 + 16 + s]; XDt[tid * 8 + s] = x * dt; XWt[tid * 8 + s] = x * dt * ed; } }
    __syncthreads();
    { const int n8 = tid & 15, prow = tid >> 4;
      float Bn[8][8], Cn[8][8];
#pragma unroll
      for (int s = 0; s < 8; ++s) { const f32x4 b0 = *(const LAS f32x4*)(BSf + s * 128 + 8 * n8), b1 = *(const LAS f32x4*)(BSf + s * 128 + 8 * n8 + 4), c0 = *(const LAS f32x4*)(CSf + s * 128 + 8 * n8), c1 = *(const LAS f32x4*)(CSf + s * 128 + 8 * n8 + 4);
#pragma unroll
          for (int j = 0; j < 4; ++j) { Bn[s][j] = b0[j]; Bn[s][4 + j] = b1[j]; Cn[s][j] = c0[j]; Cn[s][4 + j] = c1[j]; } }
      const float* hin = PIN(8) + (size_t)(bs * 32 + g * 8) * 8192 + 8 * n8; float* hout = F.out + O_SSSM + (size_t)(bs * 32 + g * 8) * 8192 + 8 * n8;
#pragma unroll 1
      for (int it = 0; it < 16; it += 2) {
          f32x4 hv[2][2];
#pragma unroll
          for (int u = 0; u < 2; ++u) { const int row = (it + u) * 32 + prow; hv[u][0] = __builtin_nontemporal_load((const f32x4*)(hin + (size_t)row * 128)); hv[u][1] = __builtin_nontemporal_load((const f32x4*)(hin + (size_t)row * 128 + 4)); }
#pragma unroll
          for (int u = 0; u < 2; ++u) { const int row = (it + u) * 32 + prow; const float eall = SC2[256 + (row >> 6)];
              const f32x4 xw0 = *(const LAS f32x4*)(XWt + row * 8), xw1 = *(const LAS f32x4*)(XWt + row * 8 + 4);
              float hh[8], hn[8], yp[8];
#pragma unroll
              for (int j = 0; j < 4; ++j) { hh[j] = hv[u][0][j]; hh[4 + j] = hv[u][1][j]; }
#pragma unroll
              for (int j = 0; j < 8; ++j) hn[j] = eall * hh[j];
#pragma unroll
              for (int s = 0; s < 8; ++s) { const float xw = s < 4 ? xw0[s & 3] : xw1[s & 3]; float y = 0.f;
#pragma unroll
                  for (int j = 0; j < 8; ++j) { hn[j] += xw * Bn[s][j]; y += Cn[s][j] * hh[j]; }
                  yp[s] = y; }
              f32x4 o0 = {hn[0], hn[1], hn[2], hn[3]}, o1 = {hn[4], hn[5], hn[6], hn[7]};
              __builtin_nontemporal_store(o0, (f32x4*)(hout + (size_t)row * 128)); __builtin_nontemporal_store(o1, (f32x4*)(hout + (size_t)row * 128 + 4));
#pragma unroll
              for (int s = 0; s < 8; ++s) { float y = yp[s]; y += __shfl_xor(y, 1); y += __shfl_xor(y, 2); y += __shfl_xor(y, 4); y += __shfl_xor(y, 8); yp[s] = y; }
              if (n8 == 0) { *(LAS f32x4*)(YP + row * 8) = (f32x4){yp[0], yp[1], yp[2], yp[3]}; *(LAS f32x4*)(YP + row * 8 + 4) = (f32x4){yp[4], yp[5], yp[6], yp[7]}; } }
      } }
    __syncthreads();
    { const int row = tid, el = row >> 6, pp = row & 63, e = g * 8 + el; const float De = PIN(27)[e];
#pragma unroll
      for (int t = 0; t < 8; ++t) { const float cumt = SC2[el * 32 + t]; float y = SC2[el * 32 + 24 + t] * YP[row * 8 + t];
#pragma unroll
          for (int s = 0; s < 8; ++s) if (s <= t) y += CB[t * 8 + s] * expf(cumt - SC2[el * 32 + s]) * XDt[row * 8 + s];
          y += De * XF[t * 512 + row];
          YS[(size_t)(m0 + t) * 2048 + e * 64 + pp] = (bf16_t)(cvt_pk_bf16(y, 0.f) & 0xffffu); } }
}

#ifndef IT_MASK
#define IT_MASK 15
#endif
__device__ __forceinline__ void phase_mixer(Frame& F, const Params& p, const int itm = IT_MASK) {
    if (itm & 1) { for (int it = F.bx; it < 256; it += F.G) { const int x = it & 7, j = it >> 3, pair = x * 4 + (j >> 3); mlstm_prompt_item(F, p, pair >> 2, pair & 3, j & 7); } }
    if (itm & 2) { for (int it = F.bx; it < 256; it += F.G) { const int x = it & 7, j = it >> 3, grp = x * 4 + (j >> 3); ssd_prompt_item(F, p, grp >> 2, (grp & 3) * 8 + (j & 7)); } }
    if (itm & 4) { for (int it = F.bx; it < 4 * (NBS - NS_EARLY); it += F.G) mlstm_sample_item(F, p, NS_EARLY + (it >> 2), it & 3); }
    if (itm & 8) { for (int it = F.bx; it < 4 * (NBS - NS_EARLY); it += F.G) ssd_sample_item(F, p, NS_EARLY + (it >> 2), it & 3); }
}

__device__ __forceinline__ void phase_finish(Frame& F, const Params& p) {
    const bf16_t* Z = (const bf16_t*)(F.ws + WS_ZIN); const bf16_t* NUM = (const bf16_t*)(F.ws + WS_NUM); const bf16_t* YS = (const bf16_t*)(F.ws + WS_YS);
    const float* DEN = (const float*)(F.ws + WS_DEN); bf16_t* HA = (bf16_t*)(F.ws + WS_HA); bf16_t* HB = (bf16_t*)(F.ws + WS_HB);
    const float* hg = PIN(21); const float* sg = PIN(28);
    const int gwv = F.bx * 8 + F.wave, NGW = F.G * 8, lane = F.lane;
    for (int m = gwv; m < MT; m += NGW) {
#pragma unroll
        for (int h = 0; h < 4; ++h) {
            float x[8], o[8], gz[8]; unpack8(*(const u32x4*)(NUM + (size_t)m * 2048 + h * 512 + 8 * lane), x);
            float s = 0.f;
#pragma unroll
            for (int e = 0; e < 8; ++e) s += x[e];
            const float mu = wave_sum(s) * (1.0f / 512.0f); float q = 0.f;
#pragma unroll
            for (int e = 0; e < 8; ++e) { x[e] -= mu; q += x[e] * x[e]; }
            const float var = wave_sum(q) * (1.0f / 512.0f), Dv = DEN[(size_t)m * 4 + h];
            const float rs = 1.0f / sqrtf(var + EPS * Dv * Dv);
            unpack8(*(const u32x4*)(Z + (size_t)m * ZP + ZO + h * 512 + 8 * lane), gz);
            const f32x4 g0 = *(const f32x4*)(hg + h * 512 + 8 * lane), g1 = *(const f32x4*)(hg + h * 512 + 8 * lane + 4);
#pragma unroll
            for (int e = 0; e < 8; ++e) o[e] = x[e] * rs * (e < 4 ? g0[e & 3] : g1[e & 3]) * sigmoidf_(gz[e]);
            if (m < MP) *(u32x2*)((unsigned char*)HA + (size_t)m * 2048 + h * 512 + 8 * lane) = (u32x2){pack4_fp8(o[0], o[1], o[2], o[3], F8_SA), pack4_fp8(o[4], o[5], o[6], o[7], F8_SA)};
            else *(u32x2*)((unsigned char*)HA + (size_t)MP * 2048 * 2 + fo8_index(m - MP, h * 512 + 8 * lane, 2048)) = (u32x2){pack4_fp8(o[0], o[1], o[2], o[3], F8_SA), pack4_fp8(o[4], o[5], o[6], o[7], F8_SA)};
        }
#pragma unroll
        for (int gq = 0; gq < 4; ++gq) {
            float y[8], zz[8]; unpack8(*(const u32x4*)(YS + (size_t)m * 2048 + gq * 512 + 8 * lane), y); unpack8(*(const u32x4*)(Z + (size_t)m * ZP + ZZ + gq * 512 + 8 * lane), zz);
            float q = 0.f;
#pragma unroll
            for (int e = 0; e < 8; ++e) { y[e] *= siluf_(zz[e]); q += y[e] * y[e]; }
            const float rs = 1.0f / sqrtf(wave_sum(q) * (1.0f / 512.0f) + EPS);
            const f32x4 g0 = *(const f32x4*)(sg + gq * 512 + 8 * lane), g1 = *(const f32x4*)(sg + gq * 512 + 8 * lane + 4);
#pragma unroll
            for (int e = 0; e < 8; ++e) y[e] = y[e] * rs * (e < 4 ? g0[e & 3] : g1[e & 3]);
            if (m < MP) *(u32x2*)((unsigned char*)HB + (size_t)m * 2048 + gq * 512 + 8 * lane) = (u32x2){pack4_fp8(y[0], y[1], y[2], y[3], F8_SA), pack4_fp8(y[4], y[5], y[6], y[7], F8_SA)};
            else *(u32x2*)((unsigned char*)HB + (size_t)MP * 2048 * 2 + fo8_index(m - MP, gq * 512 + 8 * lane, 2048)) = (u32x2){pack4_fp8(y[0], y[1], y[2], y[3], F8_SA), pack4_fp8(y[4], y[5], y[6], y[7], F8_SA)};
        }
    }
    const int gt = F.bx * NTHREADS + F.tid, NGT = F.G * NTHREADS;
    constexpr int N1 = NBP * 3 * 2048, N2 = NBS * 3 * 2048, N3 = NBP * 3 * 3072, N4 = NBS * 3 * 3072;
    for (int i = gt; i < N1 + N2 + N3 + N4; i += NGT) {
        int j = i;
        if (j < N1) { const int b = j / 6144, r = (j / 2048) % 3, ch = j % 2048; F.out[O_PMC + j] = bf2f(Z[(size_t)(b * SEQ + SEQ - 3 + r) * ZP + ch]); continue; } j -= N1;
        if (j < N2) { const int b = j / 6144, r = (j / 2048) % 3, ch = j % 2048; F.out[O_SMC + j] = bf2f(Z[(size_t)(MP + b * TS + TS - 3 + r) * ZP + ch]); continue; } j -= N2;
        if (j < N3) { const int b = j / 9216, r = (j / 3072) % 3, ch = j % 3072; F.out[O_PSC + j] = bf2f(Z[(size_t)(b * SEQ + SEQ - 3 + r) * ZP + ZX + ch]); continue; } j -= N3;
        { const int b = j / 9216, r = (j / 3072) % 3, ch = j % 3072; F.out[O_SSC + j] = bf2f(Z[(size_t)(MP + b * TS + TS - 3 + r) * ZP + ZX + ch]); }
    }
}


#ifndef STAG_LEVELS
#define STAG_LEVELS 8
#endif
#ifndef STAG_SLEEP
#define STAG_SLEEP 16
#endif
__device__ __forceinline__ void stagger_start(const Frame& F) { const int sl = (F.bx >> 3) & (STAG_LEVELS - 1); for (int q = 0; q < sl; ++q) __builtin_amdgcn_s_sleep(STAG_SLEEP); }

constexpr int LDS_BYTES = 147456;
constexpr int NPHASE = 15;

__global__ void __launch_bounds__(NTHREADS, 2) fwd_kernel(Params p) {
    extern __shared__ __attribute__((aligned(16))) unsigned char lds_raw[];
    Frame F;
    F.lds = (LAS unsigned char*)lds_raw;
    F.tid = threadIdx.x; F.lane = F.tid & 63; F.wave = __builtin_amdgcn_readfirstlane(F.tid >> 6);
    F.G = gridDim.x; F.bx = blockIdx.x;
    F.out = p.out; F.ws = p.ws;
    unsigned char* ws = p.ws;
    bf16_t* U = (bf16_t*)(ws + WS_U); bf16_t* H = (bf16_t*)(ws + WS_H); float* X1 = (float*)(ws + WS_X1);
    bf16_t* ZIN = (bf16_t*)(ws + WS_ZIN); float* GATES = (float*)(ws + WS_GATES); float* MOD = (float*)(ws + WS_MOD);
    const int lo = p.ph_lo, hi = p.ph_hi;
#ifndef PH_MASK
#define PH_MASK 0xfffff
#endif
#define IN(k) (((PH_MASK >> (k)) & 1) && lo <= (k) && (k) < hi)
#ifndef DUP_MASK
#define DUP_MASK 0
#endif
#define DUP(k) ((DUP_MASK >> (k)) & 1)
    volatile LAS unsigned* MISC = (volatile LAS unsigned*)(F.lds + LDS_BYTES - 64);
    if (F.tid < 16) MISC[F.tid] = 0u;
    if (F.tid == 0) { volatile LAS unsigned* T = (volatile LAS unsigned*)(F.lds + PTAB_OFF);
#pragma unroll
        for (int k = 0; k < 36; ++k) { const uint64_t a = (uint64_t)p.in[k]; T[2 * k] = (unsigned)a; T[2 * k + 1] = (unsigned)(a >> 32); } }
    __syncthreads();
    XcdBarrier bar; bar.bar = (unsigned*)(ws + WS_CTL); bar.x = 0; bar.st = nullptr;
    if (hi - lo > 1) bar = xcd_barrier_post((unsigned*)(ws + WS_CTL), MISC);
#define SEAM(k) do { if (IN(k) && IN((k) + 1)) { xcd_barrier(bar); } } while (0)

    if (IN(0)) { phase_silu_c(F, p); phase_prep<0>(F, p); if (hi - lo > 1) xcd_barrier(bar); phase_adaln(F, p); } SEAM(0);
    if (IN(1)) { phase_norm_mod(F, PIN(0), PIN(1), PIN(12), 0 * DM, 1 * DM, U); if (DUP(1)) phase_norm_mod(F, PIN(0), PIN(1), PIN(12), 0 * DM, 1 * DM, U); } SEAM(1);
    if (IN(2)) { pg8::Gemm g{U, U, (const bf16_t*)(ws + WS_WUP1), (const bf16_t*)(ws + WS_WUP1), DM / 2}; pg8::Order S;
        if (F.bx < 192) { stagger_start(F); S.init_from(MT, 2 * DFF, 192, F.bx, 0, 1496); } else { phase_prep<1>(F, p); S.init_from(MT, 2 * DFF, 64, F.bx - 192, 1496, 1496); }
        pg8::EpiSwiGLU E{H, F8_INV}; pg8::gemm_phase<pg8::EpiSwiGLU, true, pg8::Order, true>(F.lds, g, S, E); } SEAM(2);
    float* XS = (float*)(ws + WS_XS); unsigned* CNT = (unsigned*)(ws + WS_CTL) + CW_CNT; bf16_t* U2 = (bf16_t*)(ws + WS_U2);
    if (IN(3)) { stagger_start(F); pg8::Gemm g{H, H, (const bf16_t*)(ws + WS_WDN1), (const bf16_t*)(ws + WS_WDN1), DFF / 2}; pg8::Order S; S.init(MP, DM, F.G, F.bx, 0);
        pg8::EpiResidNorm<false> E{PIN(0), X1, MOD + 2 * DM, PIN(16), MOD + 3 * DM, MOD + 4 * DM, U, nullptr, XS, CNT, 0.5f * F8_INV, 0}; pg8::gemm_phase<pg8::EpiResidNorm<false>, true, pg8::Order, true>(F.lds, g, S, E);
        small_phase_resid_norm<DFF, false>(F, H, (const bf16_t*)(ws + WS_FDN1), PIN(1), X1, MOD + 2 * DM, 0.5f * F8_INV, PIN(16), MOD + 3 * DM, MOD + 4 * DM, U, nullptr, XS, CNT); } SEAM(3);
    if (IN(5)) {
        const pg8::Gemm g{U, U, (const bf16_t*)(ws + WS_WIN), (const bf16_t*)(ws + WS_WIN), DM}; const pg8::EpiZin E{ZIN, GATES};
        { stagger_start(F); const pg8::OrderSample S{F.bx}; pg8::gemm_phase<pg8::EpiZin, true, pg8::OrderSample>(F.lds, g, S, E); }
        if (F.bx >= 208 && F.bx < 224) small_gates_tile(F, U, (const bf16_t*)(ws + WS_FG), GATES, MP / 64 + (F.bx - 208));
        if (F.bx >= 224) { for (int k = 0; k < 4; ++k) small_gates_tile(F, U, (const bf16_t*)(ws + WS_FG), GATES, 4 * (F.bx - 224) + k); }
        xcd_barrier(bar);
        if (F.bx >= 192) {
            const int s0 = F.bx - 192;
            for (int k = F.wave; k < 10; k += 8) conv_item(F, p, 5120 + 10 * s0 + k);
            asm volatile("s_waitcnt vmcnt(0)" ::: "memory"); __syncthreads(); __builtin_amdgcn_fence(__ATOMIC_ACQUIRE, "agent");
#pragma unroll 1
            for (int k = 0; k < 4; ++k) mlstm_sample_item(F, p, s0, k);
#pragma unroll 1
            for (int k = 0; k < 4; ++k) ssd_sample_item(F, p, s0, k);
            for (int k = 0; k < 2; ++k) small_gates_tile(F, U, (const bf16_t*)(ws + WS_FG), GATES, 128 + 2 * s0 + k);
        } else stagger_start(F);
        __syncthreads();
        { const pg8::OrderPrompt S{F.bx}; pg8::gemm_phase<pg8::EpiZin, true, pg8::OrderPrompt>(F.lds, g, S, E); }
        } SEAM(5);
    if (IN(6)) { phase_conv(F, p); if (DUP(6)) phase_conv(F, p); } SEAM(6);
    #ifndef DUP_IT
#define DUP_IT 15
#endif
    if (IN(7)) { phase_mixer(F, p, p.itm); } SEAM(7);
    if (IN(8)) { phase_finish(F, p); if (DUP(8)) phase_finish(F, p); } SEAM(8);
    if (IN(9)) { stagger_start(F); pg8::Gemm g{(const bf16_t*)(ws + WS_HA), (const bf16_t*)(ws + WS_HB), (const bf16_t*)(ws + WS_WPA), (const bf16_t*)(ws + WS_WPB), 2048 / 2}; pg8::Order S; S.init(MP, DM, F.G, F.bx, 1);
        pg8::EpiMerge E{ZIN, (float*)(ws + WS_TMP), U, F8_INV}; pg8::gemm_phase<pg8::EpiMerge, true, pg8::Order, true>(F.lds, g, S, E);
        small_phase_merge(F, (const bf16_t*)(ws + WS_HA), (const bf16_t*)(ws + WS_HB), (const bf16_t*)(ws + WS_FPA), (const bf16_t*)(ws + WS_FPB), ZIN, U); } SEAM(9);
    if (IN(10)) { stagger_start(F); pg8::Gemm g{U, U, (const bf16_t*)(ws + WS_WOUT), (const bf16_t*)(ws + WS_WOUT), DM / 2}; pg8::Order S; S.init(MP, DM, F.G, F.bx, 0);
        pg8::EpiResidNorm<false> E{X1, X1, MOD + 5 * DM, PIN(31), MOD + 6 * DM, MOD + 7 * DM, U2, nullptr, XS + (size_t)MT * 16, CNT + CNT_STRIDE, 1.0f * F8_INV, 1}; pg8::gemm_phase<pg8::EpiResidNorm<false>, true, pg8::Order, true>(F.lds, g, S, E);
        small_phase_resid_norm<DM, false>(F, U, (const bf16_t*)(ws + WS_FOUT), (const float*)((const bf16_t*)X1 + (size_t)MP * DM), X1, MOD + 5 * DM, 1.0f * F8_INV, PIN(31), MOD + 6 * DM, MOD + 7 * DM, U2, nullptr, XS + (size_t)MT * 16, CNT + CNT_STRIDE); } SEAM(10);
    if (IN(12)) { stagger_start(F); pg8::Gemm g{U2, U2, (const bf16_t*)(ws + WS_WUP2), (const bf16_t*)(ws + WS_WUP2), DM / 2}; pg8::Order S; S.init(MT, 2 * DFF, F.G, F.bx, 0);
        pg8::EpiSwiGLU E{H, F8_INV}; pg8::gemm_phase<pg8::EpiSwiGLU, true, pg8::Order, true>(F.lds, g, S, E); } SEAM(12);
    if (IN(13)) { stagger_start(F); pg8::Gemm g{H, H, (const bf16_t*)(ws + WS_WDN2), (const bf16_t*)(ws + WS_WDN2), DFF / 2}; pg8::Order S; S.init(MP, DM, F.G, F.bx, 0);
        pg8::EpiResidNorm<true> E{X1, nullptr, MOD + 8 * DM, PIN(35), nullptr, nullptr, nullptr, p.out, XS + (size_t)2 * MT * 16, CNT + 2 * CNT_STRIDE, 0.5f * F8_INV, 0}; pg8::gemm_phase<pg8::EpiResidNorm<true>, true, pg8::Order, true>(F.lds, g, S, E);
        small_phase_resid_norm<DFF, true>(F, H, (const bf16_t*)(ws + WS_FDN2), (const float*)((const bf16_t*)X1 + (size_t)MP * DM), nullptr, MOD + 8 * DM, 0.5f * F8_INV, PIN(35), nullptr, nullptr, nullptr, p.out, XS + (size_t)2 * MT * 16, CNT + 2 * CNT_STRIDE); }
#undef IN
#undef SEAM
}

extern "C" void kernel_launch(void* const* d_in, const int* in_sizes, int n_in, void* d_out, int out_size, void* d_ws, size_t ws_size, hipStream_t stream) {
    static int grid = 0;
    if (grid == 0) {
        if (n_in != 36 || ws_size < WS_END) { fprintf(stderr, "kernel_launch: expected 36 inputs and >= %zu bytes of workspace (got %d, %zu)\n", (size_t)WS_END, n_in, ws_size); grid = -1; return; }
        int dev = 0, cus = 0, per_cu = 0;
        hipGetDevice(&dev); hipDeviceGetAttribute(&cus, hipDeviceAttributeMultiprocessorCount, dev);
        hipFuncSetAttribute((const void*)fwd_kernel, hipFuncAttributeMaxDynamicSharedMemorySize, LDS_BYTES);
        hipOccupancyMaxActiveBlocksPerMultiprocessor(&per_cu, (const void*)fwd_kernel, NTHREADS, LDS_BYTES);
        if (per_cu < 1) { fprintf(stderr, "kernel_launch: occupancy query says %d blocks per CU\n", per_cu); grid = -1; return; }
        grid = cus;
        if (grid != 256) { fprintf(stderr, "kernel_launch: the fused-norm GEMM epilogues need exactly 256 workgroups (one 256x256 tile each); this device has %d CUs\n", cus); grid = -1; return; }
    }
    if (grid < 0) return;
    Params p{};
    for (int i = 0; i < 36; ++i) p.in[i] = (const float*)d_in[i];
    p.out = (float*)d_out; p.ws = (unsigned char*)d_ws; p.itm = 15;
#if MK_LAUNCH_PER_PHASE
    for (int ph = 0; ph < NPHASE; ++ph) { p.ph_lo = ph; p.ph_hi = ph + 1; hipLaunchKernelGGL(fwd_kernel, dim3(grid), dim3(NTHREADS), LDS_BYTES, stream, p); }
#else
    p.ph_lo = 0; p.ph_hi = NPHASE;
    if (hipMemsetAsync((char*)d_ws + WS_CTL, 0, 98304, stream) != hipSuccess) { fprintf(stderr, "kernel_launch: memset of the barrier words failed\n"); return; }
    void* args[] = {&p};
    hipError_t e = hipLaunchCooperativeKernel((const void*)fwd_kernel, dim3(grid), dim3(NTHREADS), args, LDS_BYTES, stream);
    if (e != hipSuccess) fprintf(stderr, "cooperative launch failed: %s (grid %d)\n", hipGetErrorString(e), grid);
#ifdef PROBE_PH
    for (int r = 0; r < PROBE_REPS; ++r) { Params q = p; q.ph_lo = PROBE_PH; q.ph_hi = PROBE_PH + 1; q.itm = PROBE_ITM; hipLaunchKernelGGL(fwd_kernel, dim3(grid), dim3(NTHREADS), LDS_BYTES, stream, q); }
#endif
#endif
}
```
